# Optimizing an MI355X kernel written in HIP

```python
import math
import jax, jax.numpy as jnp
from jax import lax
import numpy as np

D_MODEL = 1024
BATCH = 32
SEQ = 2048
DEPTH = 2

M_HEADS = 4
M_HEAD_DIM = D_MODEL // 8
M_WIDTH = M_HEADS * M_HEAD_DIM
M_CHUNK = 64
DA_HEADS = 4
DA_HEAD_DIM = D_MODEL // 16
DA_V_DIM = 2 * DA_HEAD_DIM
DA_QK_WIDTH = DA_HEADS * 2 * DA_HEAD_DIM
DA_WIDTH = DA_HEADS * DA_V_DIM
Q_BLOCK = 128
REL_BUCKETS = 32
REL_MAX_DIST = 128
CONV_WIDTH = 3
CONV_DIM = D_MODEL
MOE_GROUPS = 4
EXPERTS_PER_GROUP = 4
N_EXPERTS = MOE_GROUPS * EXPERTS_PER_GROUP
EXPERT_TOP_K = 2
EXPERT_FF = D_MODEL // 2

NORM_EPS = 1e-6
N_EVEN_LAYERS = (DEPTH + 1) // 2
N_ODD_LAYERS = DEPTH // 2
EVEN_SPLITS = [M_WIDTH, M_WIDTH, M_WIDTH, M_WIDTH, M_HEADS, M_HEADS, DA_QK_WIDTH, DA_QK_WIDTH, DA_WIDTH]
EVEN_IN = sum(EVEN_SPLITS)

kernel_name = "hybrid_mlstm_diffattn_shortconv_hmoe"


def rmsnorm(x, g):
    xf = x.astype(jnp.float32)
    y = xf * lax.rsqrt(jnp.mean(xf * xf, axis=-1, keepdims=True) + NORM_EPS)
    return (y * g.astype(jnp.float32)).astype(x.dtype)


def rel_bucket(rel):
    n = jnp.maximum(-rel, 0)
    max_exact = REL_BUCKETS // 2
    nf = jnp.maximum(n, 1).astype(jnp.float32)
    large = max_exact + (jnp.log(nf / max_exact) / math.log(REL_MAX_DIST / max_exact)
                         * (REL_BUCKETS - max_exact)).astype(jnp.int32)
    large = jnp.minimum(large, REL_BUCKETS - 1)
    return jnp.where(n < max_exact, n, large)


def mlstm(q, k, v, ig, fg):
    Bn, S, H, dh = q.shape
    L = M_CHUNK
    nc = S // L
    to_chunks = lambda a: a.reshape(Bn, nc, L, H, dh).transpose(1, 0, 3, 2, 4)
    g_chunks = lambda a: a.reshape(Bn, nc, L, H).transpose(1, 0, 3, 2)
    qc, kc, vc = to_chunks(q), to_chunks(k * (dh ** -0.5)), to_chunks(v)
    ic, lf = g_chunks(ig), g_chunks(jax.nn.log_sigmoid(fg))
    causal = jnp.tril(jnp.ones((L, L), dtype=bool))

    def step(carry, xs):
        C, n, m = carry
        qt, kt, vt, it, lft = xs
        b = jnp.cumsum(lft, axis=-1)
        g = b[..., -1]
        dmat = jnp.where(causal, b[..., :, None] - b[..., None, :] + it[..., None, :], -jnp.inf)
        inter = b + m[..., None]
        mt = jnp.maximum(inter, jnp.max(dmat, axis=-1))
        w = jnp.exp(dmat - mt[..., None])
        sc = jnp.exp(inter - mt)
        qk = jnp.einsum('bhtd,bhsd->bhts', qt, kt) * w
        num = sc[..., None] * jnp.einsum('bhtd,bhde->bhte', qt, C) + jnp.einsum('bhts,bhse->bhte', qk, vt)
        den = sc * jnp.einsum('bhtd,bhd->bht', qt, n) + jnp.sum(qk, axis=-1)
        h = num / jnp.maximum(jnp.abs(den), jnp.exp(-mt))[..., None]
        ws = g[..., None] - b + it
        m_new = jnp.maximum(g + m, jnp.max(ws, axis=-1))
        a = jnp.exp(g + m - m_new)
        wk = jnp.exp(ws - m_new[..., None])[..., None] * kt
        C_new = a[..., None, None] * C + jnp.einsum('bhsd,bhse->bhde', wk, vt)
        n_new = a[..., None] * n + jnp.sum(wk, axis=-2)
        return (C_new, n_new, m_new), h

    init = (jnp.zeros((Bn, H, dh, dh), jnp.float32), jnp.zeros((Bn, H, dh), jnp.float32),
            jnp.zeros((Bn, H), jnp.float32))
    _, hs = lax.scan(step, init, (qc, kc, vc, ic, lf))
    return hs.transpose(1, 0, 3, 2, 4).reshape(Bn, S, H, dh)


def diff_attention(dq, dk, dv, rel_bias, lq1, lk1, lq2, lk2, subln, layer):
    Bn, S, _ = dq.shape
    H, d = DA_HEADS, DA_HEAD_DIM
    nb = S // Q_BLOCK
    q = dq.reshape(Bn, S, H, 2, d)
    k = dk.reshape(Bn, S, H, 2, d)
    q1, q2 = q[..., 0, :].transpose(0, 2, 1, 3), q[..., 1, :].transpose(0, 2, 1, 3)
    k1, k2 = k[..., 0, :].transpose(0, 2, 1, 3), k[..., 1, :].transpose(0, 2, 1, 3)
    v = dv.reshape(Bn, S, H, DA_V_DIM).transpose(0, 2, 1, 3)
    lam_init = 0.8 - 0.6 * math.exp(-0.3 * layer)
    lam = (jnp.exp(jnp.sum(lq1.astype(jnp.float32) * lk1.astype(jnp.float32)))
           - jnp.exp(jnp.sum(lq2.astype(jnp.float32) * lk2.astype(jnp.float32))) + lam_init)
    scale = d ** -0.5
    kpos = jnp.arange(S)
    to_blocks = lambda a: a.reshape(Bn, H, nb, Q_BLOCK, d).transpose(2, 0, 1, 3, 4)

    def block(args):
        q1b, q2b, bi = args
        qpos = bi * Q_BLOCK + jnp.arange(Q_BLOCK)
        rel = kpos[None, :] - qpos[:, None]
        bias = rel_bias[rel_bucket(rel)].astype(jnp.float32).transpose(2, 0, 1)
        mask = rel <= 0
        s1 = jnp.einsum('bhqd,bhkd->bhqk', q1b, k1).astype(jnp.float32) * scale + bias
        s2 = jnp.einsum('bhqd,bhkd->bhqk', q2b, k2).astype(jnp.float32) * scale + bias
        p1 = jax.nn.softmax(jnp.where(mask, s1, -jnp.inf), axis=-1)
        p2 = jax.nn.softmax(jnp.where(mask, s2, -jnp.inf), axis=-1)
        a = p1 - lam * p2
        return jnp.einsum('bhqk,bhke->bhqe', a.astype(v.dtype), v)

    out = lax.map(block, (to_blocks(q1), to_blocks(q2), jnp.arange(nb)))
    out = out.transpose(1, 2, 0, 3, 4).reshape(Bn, H, S, DA_V_DIM)
    out = rmsnorm(out, subln) * (1.0 - lam_init)
    return out.transpose(0, 2, 1, 3).reshape(Bn, S, DA_WIDTH)


def even_mixer(h, w_in, w_out, ig_b, fg_b, head_norm, rel_bias, lq1, lk1, lq2, lk2, subln, layer):
    Bn, S, _ = h.shape
    p = h @ w_in
    idx = [int(c) for c in np.cumsum(EVEN_SPLITS)[:-1]]
    mq, mk, mv, mo, mi, mf, dq, dk, dv = jnp.split(p, idx, axis=-1)
    f32 = jnp.float32
    shp = (Bn, S, M_HEADS, M_HEAD_DIM)
    hm = mlstm(mq.reshape(shp).astype(f32), mk.reshape(shp).astype(f32), mv.reshape(shp).astype(f32),
               mi.astype(f32) + ig_b.astype(f32), mf.astype(f32) + fg_b.astype(f32))
    mu = jnp.mean(hm, axis=-1, keepdims=True)
    var = jnp.mean(jnp.square(hm - mu), axis=-1, keepdims=True)
    hm = (hm - mu) * lax.rsqrt(var + NORM_EPS) * head_norm.astype(f32).reshape(M_HEADS, M_HEAD_DIM)
    hm = hm.reshape(Bn, S, M_WIDTH) * jax.nn.sigmoid(mo.astype(f32))
    ha = diff_attention(dq, dk, dv, rel_bias, lq1, lk1, lq2, lk2, subln, layer)
    return jnp.concatenate([hm.astype(h.dtype), ha.astype(h.dtype)], axis=-1) @ w_out


def conv_mixer(h, w_in, conv_w, w_out):
    bg, cg, u = jnp.split(h @ w_in, 3, axis=-1)
    z = cg * u
    zc = lax.conv_general_dilated(z, conv_w[:, None, :].astype(z.dtype), window_strides=(1,),
                                  padding=[(CONV_WIDTH - 1, 0)],
                                  dimension_numbers=('NWC', 'WIO', 'NWC'),
                                  feature_group_count=CONV_DIM)
    return (bg * zc) @ w_out


def hier_moe(h, wg, bg, we, be, w_gate, w_up, w_down):
    Bn, S, D = h.shape
    t = h.reshape(-1, D)
    T = t.shape[0]
    glog = (t @ wg).astype(jnp.float32) + bg.astype(jnp.float32)
    gprob = jax.nn.softmax(glog, axis=-1)
    _, gsel = lax.top_k(glog, 1)
    pg = jnp.take_along_axis(gprob, gsel, axis=1)[:, 0]
    elog = ((t @ we).astype(jnp.float32) + be.astype(jnp.float32)).reshape(T, MOE_GROUPS, EXPERTS_PER_GROUP)
    elog_g = jnp.take_along_axis(elog, gsel[:, :, None], axis=1)[:, 0]
    top_v, top_i = lax.top_k(elog_g, EXPERT_TOP_K)
    top_w = jax.nn.softmax(top_v, axis=-1)
    eid = gsel * EXPERTS_PER_GROUP + top_i
    combine = jnp.einsum('tk,tke->te', top_w, jax.nn.one_hot(eid, N_EXPERTS, dtype=jnp.float32)) * pg[:, None]
    combine = combine.astype(t.dtype)
    out = jnp.zeros_like(t)
    for e in range(N_EXPERTS):
        y = (jax.nn.silu(t @ w_gate[e]) * (t @ w_up[e])) @ w_down[e]
        out = out + combine[:, e:e + 1] * y
    return out.reshape(Bn, S, D)


def setup_inputs(seed: int = 0) -> dict:
    key = jax.random.key(seed)
    ks = iter(jax.random.split(key, 32))
    nrm = lambda shape, s: jax.random.normal(next(ks), shape, jnp.float32) * s
    D = D_MODEL
    fg_base = jnp.linspace(3.0, 6.0, M_HEADS, dtype=jnp.float32)
    return {
        "x": nrm((BATCH, SEQ, D), 1.0),
        "rel_bias": nrm((REL_BUCKETS, DA_HEADS), 0.5),
        "norm_mix": 1.0 + nrm((DEPTH, D), 0.02),
        "norm_ffn": 1.0 + nrm((DEPTH, D), 0.02),
        "norm_final": 1.0 + nrm((D,), 0.02),
        "w_in_even": nrm((N_EVEN_LAYERS, D, EVEN_IN), D ** -0.5),
        "w_out_even": nrm((N_EVEN_LAYERS, M_WIDTH + DA_WIDTH, D), (M_WIDTH + DA_WIDTH) ** -0.5),
        "m_igate_b": nrm((N_EVEN_LAYERS, M_HEADS), 0.1),
        "m_fgate_b": fg_base[None, :] + nrm((N_EVEN_LAYERS, M_HEADS), 0.1),
        "m_head_norm": 1.0 + nrm((N_EVEN_LAYERS, M_WIDTH), 0.02),
        "lam_q1": nrm((N_EVEN_LAYERS, DA_HEAD_DIM), 0.1),
        "lam_k1": nrm((N_EVEN_LAYERS, DA_HEAD_DIM), 0.1),
        "lam_q2": nrm((N_EVEN_LAYERS, DA_HEAD_DIM), 0.1),
        "lam_k2": nrm((N_EVEN_LAYERS, DA_HEAD_DIM), 0.1),
        "da_subln": 1.0 + nrm((N_EVEN_LAYERS, DA_V_DIM), 0.02),
        "w_in_odd": nrm((N_ODD_LAYERS, D, 3 * CONV_DIM), D ** -0.5),
        "conv_w": nrm((N_ODD_LAYERS, CONV_WIDTH, CONV_DIM), CONV_WIDTH ** -0.5),
        "w_out_odd": nrm((N_ODD_LAYERS, CONV_DIM, D), CONV_DIM ** -0.5),
        "router_group_w": nrm((DEPTH, D, MOE_GROUPS), D ** -0.5),
        "router_group_b": nrm((DEPTH, MOE_GROUPS), 0.01),
        "router_expert_w": nrm((DEPTH, D, N_EXPERTS), D ** -0.5),
        "router_expert_b": nrm((DEPTH, N_EXPERTS), 0.01),
        "exp_w_gate": nrm((DEPTH, N_EXPERTS, D, EXPERT_FF), D ** -0.5),
        "exp_w_up": nrm((DEPTH, N_EXPERTS, D, EXPERT_FF), D ** -0.5),
        "exp_w_down": nrm((DEPTH, N_EXPERTS, EXPERT_FF, D), EXPERT_FF ** -0.5),
    }


def reference(x, rel_bias, norm_mix, norm_ffn, norm_final, w_in_even, w_out_even, m_igate_b, m_fgate_b,
              m_head_norm, lam_q1, lam_k1, lam_q2, lam_k2, da_subln, w_in_odd, conv_w, w_out_odd,
              router_group_w, router_group_b, router_expert_w, router_expert_b,
              exp_w_gate, exp_w_up, exp_w_down):
    for layer in range(DEPTH):
        h = rmsnorm(x, norm_mix[layer])
        if layer % 2 == 0:
            e = layer // 2
            y = even_mixer(h, w_in_even[e], w_out_even[e], m_igate_b[e], m_fgate_b[e], m_head_norm[e],
                           rel_bias, lam_q1[e], lam_k1[e], lam_q2[e], lam_k2[e], da_subln[e], layer)
        else:
            o = layer // 2
            y = conv_mixer(h, w_in_odd[o], conv_w[o], w_out_odd[o])
        x = x + y.astype(x.dtype)
        h = rmsnorm(x, norm_ffn[layer])
        x = x + hier_moe(h, router_group_w[layer], router_group_b[layer], router_expert_w[layer],
                         router_expert_b[layer], exp_w_gate[layer], exp_w_up[layer],
                         exp_w_down[layer]).astype(x.dtype)
    return rmsnorm(x, norm_final)
```

```cpp
#include <hip/hip_runtime.h>
#include <cstdio>
#include <cstdint>

#define LAS __attribute__((address_space(3)))
#define GAS __attribute__((address_space(1)))
typedef unsigned short bf16_t;
typedef short bf16x8 __attribute__((ext_vector_type(8)));
typedef short s16x4 __attribute__((ext_vector_type(4)));
typedef float f32x4 __attribute__((ext_vector_type(4)));
typedef float f32x2 __attribute__((ext_vector_type(2)));
typedef float f32x16 __attribute__((ext_vector_type(16)));
typedef unsigned u32x4 __attribute__((ext_vector_type(4)));
typedef unsigned u32x2 __attribute__((ext_vector_type(2)));
typedef GAS unsigned gu32;

constexpr int D = 1024, NBATCH = 32, SEQ = 2048, T = NBATCH * SEQ;
constexpr int EVEN_IN = 3592, NP = 3584;
constexpr int P_MQ = 0, P_MK = 512, P_MV = 1024, P_MO = 1536, P_DQ = 2048, P_DK = 2560, P_DV = 3072;
constexpr int NE = 16, FF = 512;
constexpr int ECAP = 65536;
constexpr float NORM_EPS = 1e-6f;
constexpr int NWAVES = 8, NTHR = 512;
constexpr int MCH = 256, NCH = SEQ / MCH;
constexpr int WT_I1 = 16 * 112, WT_ITEMS = 28928, WT_UNITS = (WT_ITEMS - WT_I1) / 64;

constexpr size_t MiB = 1u << 20;
constexpr size_t WS_CTL = 0, CTL_ZERO_BYTES = 1 * MiB;
constexpr size_t WS_WT1 = 1 * MiB, WS_WT2 = 8 * MiB, WS_WT3 = 10 * MiB, WS_WT4 = 16 * MiB, WS_WGU = 18 * MiB, WS_WD = 82 * MiB;
constexpr size_t WS_GATES = 114 * MiB, WS_SA = 116 * MiB, WS_SAM = 117 * MiB, WS_SBA = 118 * MiB, WS_UN = 119 * MiB, WS_UR = 119 * MiB + 768 * 1024;
constexpr size_t WS_UT = 120 * MiB;
constexpr size_t WS_ROWTOK = 184 * MiB, WS_CWRAW = 188 * MiB, WS_TOKINFO = 192 * MiB, WS_RSTD = 193 * MiB;
constexpr size_t WS_H = 194 * MiB, WS_CAT = 322 * MiB, WS_P = 450 * MiB;
constexpr size_t WS_XB = WS_H;
constexpr size_t WS_BG = WS_P, WS_Z = WS_P + 128 * MiB, WS_HM = WS_P, WS_YC = WS_P + 136 * MiB;
constexpr size_t WS_END = 898 * MiB;
constexpr int CW_BAR = 4096;
constexpr int CW_CNT = 16384;
constexpr int CW_QUEUE = 32768;

__device__ __forceinline__ unsigned cvt_pk_bf16(float lo, float hi) { unsigned r; asm volatile("v_cvt_pk_bf16_f32 %0, %1, %2" : "=v"(r) : "v"(lo), "v"(hi)); return r; }
__device__ __forceinline__ float bf_lo(unsigned w) { return __uint_as_float(w << 16); }
__device__ __forceinline__ float bf_hi(unsigned w) { return __uint_as_float(w & 0xffff0000u); }
__device__ __forceinline__ float wave_sum(float v) {
#pragma unroll
    for (int o = 1; o < 64; o <<= 1) v += __shfl_xor(v, o);
    return v;
}
__device__ __forceinline__ float fast_exp2(float x) { return __builtin_amdgcn_exp2f(x); }
__device__ __forceinline__ float fast_rcp(float x) { return __builtin_amdgcn_rcpf(x); }
__device__ __forceinline__ int crow(int r, int hi) { return (r & 3) + 8 * (r >> 2) + 4 * hi; }
__device__ __forceinline__ unsigned off_b(unsigned row, unsigned ch) { return 256u * row + 16u * (ch ^ (((row & 3u) << 2) | ((row >> 2) & 3u))); }
__device__ __forceinline__ s16x4 vtr(const LAS unsigned char* p) { return __builtin_bit_cast(s16x4, __builtin_amdgcn_ds_read_tr16_b64_v4i16((LAS s16x4*)p)); }
__device__ __forceinline__ bf16x8 cat8(s16x4 a, s16x4 b) { return (bf16x8){a[0], a[1], a[2], a[3], b[0], b[1], b[2], b[3]}; }

#define XB_TMO      128
#define XB_XCNT(j)  (256  + 64 * (j))
#define XB_XSUB(j)  (1280 + 64 * (j))
#define XB_XGEN(j)  (2304 + 64 * (j))
#define XB_TOP      3328
#define XB_TOPGEN   3392
#define XCD_BAR_WORDS 3456
#define XB_SPIN_CAP (1u << 18)
__device__ __forceinline__ unsigned xb_ld(unsigned* p)              { return __hip_atomic_load(p, __ATOMIC_RELAXED, __HIP_MEMORY_SCOPE_AGENT); }
__device__ __forceinline__ unsigned xb_add(unsigned* p, unsigned v) { return __hip_atomic_fetch_add(p, v, __ATOMIC_RELAXED, __HIP_MEMORY_SCOPE_AGENT); }
__device__ __forceinline__ unsigned xb_xcc_id() { return (unsigned)__builtin_amdgcn_s_getreg((3 << 11) | 20) & 0xFu; }
#define XB_SPIN(cond, bar) do { unsigned _sp = 0; while (cond) { __builtin_amdgcn_s_sleep(1); \
    if ((++_sp & 255u) == 0u) { if (xb_ld(&(bar)[XB_TMO])) break; if (_sp > XB_SPIN_CAP) { atomicAdd(&(bar)[XB_TMO], 1u); break; } } } } while (0)
struct XcdBarrier { unsigned* bar; unsigned x; volatile LAS unsigned* st; };
__device__ __forceinline__ XcdBarrier xcd_barrier_post(unsigned* bar, volatile LAS unsigned* st) {
    XcdBarrier b; b.bar = bar; b.x = xb_xcc_id(); b.st = st;
    if (threadIdx.x == 0) (void)xb_add(&bar[XB_XCNT(b.x)], 1u);
    return b;
}
__device__ __forceinline__ void xcd_barrier_complete(unsigned* bar, unsigned x, unsigned& nloc, unsigned& nx) {
    const unsigned G = gridDim.x * gridDim.y * gridDim.z;
    unsigned sum, cnt, mine, sp = 0u;
    for (;;) {
        sum = 0u; cnt = 0u; mine = 0u;
#pragma unroll
        for (unsigned j = 0; j < 16; ++j) { const unsigned c = xb_ld(&bar[XB_XCNT(j)]); sum += c; cnt += (c > 0u) ? 1u : 0u; mine = (j == x) ? c : mine; }
        if (sum == G) break;
        __builtin_amdgcn_s_sleep(1);
        if ((++sp & 255u) == 0u) { if (xb_ld(&bar[XB_TMO])) break; if (sp > XB_SPIN_CAP) { atomicAdd(&bar[XB_TMO], 1u); break; } }
    }
    nloc = mine > 0u ? mine : 1u; nx = cnt > 0u ? cnt : 1u;
}
__device__ __forceinline__ void xcd_barrier(const XcdBarrier& b) {
    asm volatile("s_waitcnt vmcnt(0)" ::: "memory");
    __syncthreads();
    if (threadIdx.x == 0) {
        unsigned* bar = b.bar;
        __builtin_amdgcn_s_waitcnt(0);
        unsigned nloc = b.st[0], nx = b.st[1];
        if (nloc == 0u) { xcd_barrier_complete(bar, b.x, nloc, nx); b.st[0] = nloc; b.st[1] = nx; }
        const unsigned old = xb_add(&bar[XB_XSUB(b.x)], 1u);
        const unsigned gen = old / nloc;
        if (old + 1u == (gen + 1u) * nloc) {
            __builtin_amdgcn_fence(__ATOMIC_RELEASE, "agent");
            asm volatile("s_waitcnt vmcnt(0)" ::: "memory");
            const unsigned og = xb_add(&bar[XB_TOP], 1u);
            const unsigned tg = og / nx;
            if (og + 1u == (tg + 1u) * nx) xb_add(&bar[XB_TOPGEN], 1u);
            else XB_SPIN(xb_ld(&bar[XB_TOPGEN]) == tg, bar);
            __builtin_amdgcn_fence(__ATOMIC_ACQUIRE, "agent");
            xb_add(&bar[XB_XGEN(b.x)], 1u);
            asm volatile("s_waitcnt vmcnt(0)" ::: "memory");
        } else {
            XB_SPIN(xb_ld(&bar[XB_XGEN(b.x)]) == gen, bar);
            __builtin_amdgcn_fence(__ATOMIC_ACQUIRE, "agent");
            asm volatile("s_waitcnt vmcnt(0)" ::: "memory");
        }
    }
    __syncthreads();
}

namespace pg8 {
constexpr int BM = 256, BK = 64, HALF = 128, HTB = HALF * BK * 2, STAGE_BYTES = 8 * HTB, NXCD = 8, WGM = 8;
__device__ __forceinline__ int lds_byte(int r, int c) { const int st = (r >> 4) * 2 + (c >> 5), rr = r & 15, cc = c & 31, ob = rr * 64 + cc * 2; return st * 1024 + (ob ^ (((ob >> 9) & 1) << 5)); }
__device__ __forceinline__ void stage_rc(int b, int& R, int& C) { const int st = b / 1024, sb = b % 1024, swz = sb ^ (((sb >> 9) & 1) << 5); R = (st >> 1) * 16 + swz / 64; C = (st & 1) * 32 + (swz % 64) / 2; }
__device__ __forceinline__ int perm32(int rho) { const int n = rho >> 4, i = rho & 15; return 8 * (i >> 2) + 4 * n + (i & 3); }
struct Unit { int pm, pn; };

template <class Epi, class Sched, bool GATHER>
__device__ __forceinline__ void gemm_phase(LAS unsigned char* lds, const int K, const Sched& S, const Epi& E) {
    int tid = threadIdx.x; asm volatile("" : "+v"(tid));
    const int wid = __builtin_amdgcn_readfirstlane(tid >> 6), lane = tid & 63, wr = wid >> 2, wc = wid & 3, fr = lane & 15, fq = lane >> 4;
    const int nt = K / BK;
    int Rr[2], Cc[2]; unsigned voffB[2];
#pragma unroll
    for (int i = 0; i < 2; ++i) { stage_rc(tid * 16 + i * 8192, Rr[i], Cc[i]); const int Rb = Epi::PERM ? ((Rr[i] & ~31) + perm32(Rr[i] & 31)) : Rr[i];
        voffB[i] = (unsigned)(Rb * K + Cc[i]) * 2u; }
    const size_t kstep = (size_t)(BK * 2);
    const size_t hstep = (size_t)HALF * K * 2;
    const unsigned ldsw = (unsigned)wid * 1024u;
    const int aoff = lds_byte(wr * 64 + fr, fq * 8), boff = lds_byte(wc * 32 + fr, fq * 8);
#define PG8_SA(b, h) (((b) * 2 + (h)) * HTB)
#define PG8_SB(b, h) ((4 + (b) * 2 + (h)) * HTB)
#define PG8_STAGE(bufoff, gbase, voff) do { _Pragma("unroll") for (int _i = 0; _i < 2; ++_i) \
        __builtin_amdgcn_global_load_lds((const unsigned*)((const char*)(gbase) + (voff)[_i]), (LAS unsigned*)(lds + (bufoff) + ldsw + _i * 8192), 16, 0, 0); } while (0)
#define PG8_LDA(dst, b, h) do { _Pragma("unroll") for (int m = 0; m < 4; ++m) _Pragma("unroll") for (int k = 0; k < 2; ++k) dst[m][k] = *(const LAS bf16x8*)(lds + PG8_SA(b, h) + aoff + m * 2048 + k * 1024); } while (0)
#define PG8_LDB(dst, b, h) do { _Pragma("unroll") for (int n = 0; n < 2; ++n) _Pragma("unroll") for (int k = 0; k < 2; ++k) dst[n][k] = *(const LAS bf16x8*)(lds + PG8_SB(b, h) + boff + n * 2048 + k * 1024); } while (0)
#define PG8_MMA(ai, bj, At, Bt) do { __builtin_amdgcn_s_setprio(1); _Pragma("unroll") for (int m = 0; m < 4; ++m) _Pragma("unroll") for (int n = 0; n < 2; ++n) _Pragma("unroll") for (int k = 0; k < 2; ++k) \
        acc[ai][bj][m][n] = __builtin_amdgcn_mfma_f32_16x16x32_bf16(Bt[n][k], At[m][k], acc[ai][bj][m][n], 0, 0, 0); __builtin_amdgcn_s_setprio(0); } while (0)
#define PG8_WAIT_V(n) asm volatile("s_waitcnt vmcnt(" #n ")" ::: "memory")
#define PG8_WAIT_L(n) asm volatile("s_waitcnt lgkmcnt(" #n ")" ::: "memory")
#define PG8_BAR __builtin_amdgcn_s_barrier()
#define PG8_SCHED __builtin_amdgcn_sched_barrier(0)
#define PG8_VOFF(dst, u) do { _Pragma("unroll") for (int _h = 0; _h < 2; ++_h) _Pragma("unroll") for (int _i = 0; _i < 2; ++_i) { \
        if constexpr (GATHER) dst[_h][_i] = S.arow(u, _h * HALF + Rr[_i]) * (unsigned)(K * 2) + (unsigned)(Cc[_i] * 2); \
        else dst[_h][_i] = (unsigned)((_h * HALF + Rr[_i]) * K + Cc[_i]) * 2u; } } while (0)
    Unit cur, nxt; int ui = 0;
    if (!S.next(0, cur)) return;
    f32x4 acc[2][2][4][2];
#pragma unroll
    for (int a = 0; a < 2; ++a)
#pragma unroll
        for (int b = 0; b < 2; ++b)
#pragma unroll
            for (int m = 0; m < 4; ++m)
#pragma unroll
                for (int n = 0; n < 2; ++n) acc[a][b][m][n] = (f32x4){0.f, 0.f, 0.f, 0.f};
    bf16x8 At[4][2], B0[2][2], B1[2][2];
    unsigned vA[2][2], vN[2][2];
    PG8_VOFF(vA, cur);
    const char* cA = S.abase(cur); const char* cB = S.bbase(cur);
    PG8_STAGE(PG8_SB(0, 0), cB, voffB); PG8_STAGE(PG8_SB(0, 1), cB + hstep, voffB); PG8_STAGE(PG8_SA(0, 0), cA, vA[0]); PG8_STAGE(PG8_SA(0, 1), cA, vA[1]);
    if (wr == 1) PG8_BAR;
    PG8_WAIT_V(2); PG8_BAR;
    PG8_STAGE(PG8_SB(1, 0), cB + kstep, voffB); PG8_STAGE(PG8_SA(1, 0), cA + kstep, vA[0]); PG8_STAGE(PG8_SB(1, 1), cB + hstep + kstep, voffB);
    PG8_WAIT_V(6); PG8_BAR;
    for (;;) {
        const bool has_next = S.next(ui + 1, nxt);
        const char* nA = has_next ? S.abase(nxt) : cA; const char* nB = has_next ? S.bbase(nxt) : cB;
        if (has_next) { PG8_VOFF(vN, nxt); } else {
#pragma unroll
            for (int h = 0; h < 2; ++h)
#pragma unroll
                for (int i = 0; i < 2; ++i) vN[h][i] = vA[h][i]; }
        for (int t = 0; t < nt; t += 2) {
            const bool last = (t == nt - 2);
            const char* a1 = cA + (size_t)(t + 1) * kstep;
            const char* a2 = last ? nA : cA + (size_t)(t + 2) * kstep; const char* b2 = last ? nB : cB + (size_t)(t + 2) * kstep;
            const char* a3 = a2 + kstep; const char* b3 = b2 + kstep;
            unsigned v2[2][2];
#pragma unroll
            for (int h = 0; h < 2; ++h)
#pragma unroll
                for (int i = 0; i < 2; ++i) v2[h][i] = last ? vN[h][i] : vA[h][i];
            PG8_LDB(B0, 0, 0); PG8_LDB(B1, 0, 1); PG8_SCHED; PG8_LDA(At, 0, 0); PG8_STAGE(PG8_SA(1, 1), a1, vA[1]);
            PG8_WAIT_V(8); PG8_WAIT_L(0); PG8_BAR; PG8_MMA(0, 0, At, B0); PG8_MMA(0, 1, At, B1); PG8_BAR; PG8_SCHED;
            PG8_LDA(At, 0, 1); PG8_STAGE(PG8_SB(0, 0), b2, voffB); PG8_STAGE(PG8_SB(0, 1), b2 + hstep, voffB); PG8_STAGE(PG8_SA(0, 0), a2, v2[0]);
            PG8_WAIT_V(8); PG8_WAIT_L(0); PG8_BAR; PG8_MMA(1, 0, At, B0); PG8_MMA(1, 1, At, B1); PG8_BAR; PG8_SCHED;
            PG8_LDB(B0, 1, 0); PG8_LDB(B1, 1, 1); PG8_SCHED; PG8_LDA(At, 1, 0); PG8_STAGE(PG8_SA(0, 1), a2, v2[1]);
            PG8_WAIT_V(8); PG8_WAIT_L(0); PG8_BAR; PG8_MMA(0, 0, At, B0); PG8_MMA(0, 1, At, B1); PG8_BAR; PG8_SCHED;
            PG8_LDA(At, 1, 1); PG8_STAGE(PG8_SB(1, 0), b3, voffB); PG8_STAGE(PG8_SB(1, 1), b3 + hstep, voffB); PG8_STAGE(PG8_SA(1, 0), a3, v2[0]);
            PG8_WAIT_V(8); PG8_WAIT_L(0); PG8_BAR; PG8_MMA(1, 0, At, B0); PG8_MMA(1, 1, At, B1); PG8_BAR; PG8_SCHED;
        }
        if (wr == 0) PG8_BAR;
        E(acc, cur, wr, wc, fr, fq);
        if (!has_next) break;
#pragma unroll
        for (int a = 0; a < 2; ++a)
#pragma unroll
            for (int b = 0; b < 2; ++b)
#pragma unroll
                for (int m = 0; m < 4; ++m)
#pragma unroll
                    for (int n = 0; n < 2; ++n) acc[a][b][m][n] = (f32x4){0.f, 0.f, 0.f, 0.f};
        cur = nxt; cA = nA; cB = nB; ++ui;
#pragma unroll
        for (int h = 0; h < 2; ++h)
#pragma unroll
            for (int i = 0; i < 2; ++i) vA[h][i] = vN[h][i];
        if (wr == 1) PG8_BAR;
    }
    PG8_WAIT_V(0);
    PG8_BAR;
#undef PG8_SA
#undef PG8_SB
#undef PG8_STAGE
#undef PG8_LDA
#undef PG8_LDB
#undef PG8_MMA
#undef PG8_WAIT_V
#undef PG8_WAIT_L
#undef PG8_BAR
#undef PG8_SCHED
#undef PG8_VOFF
}

struct DenseSched {
    const char* A; const char* Bt; int K; int nM, nN, nwg, G, c;
    __device__ __forceinline__ void init(const void* A_, const void* Bt_, int M, int N, int K_, int G_, int c_) { A = (const char*)A_; Bt = (const char*)Bt_; K = K_; nM = M / BM; nN = N / BM; nwg = nM * nN; G = G_; c = c_; }
    __device__ __forceinline__ bool next(int i, Unit& u) const {
        const long L = (long)i * G + c; if (L >= nwg) return false;
        int wgid = (int)L; { const int q = nwg / NXCD, r = nwg % NXCD, xcd = wgid % NXCD, off = wgid / NXCD; wgid = (xcd < r ? xcd * (q + 1) : r * (q + 1) + (xcd - r) * q) + off; }
        const int nig = WGM * nN, gid = wgid / nig, fm = gid * WGM, gsz = (nM - fm) < WGM ? (nM - fm) : WGM;
        u.pm = fm + ((wgid % nig) % gsz); u.pn = (wgid % nig) / gsz; return true;
    }
    __device__ __forceinline__ const char* abase(const Unit& u) const { return A + (size_t)u.pm * BM * K * 2; }
    __device__ __forceinline__ const char* bbase(const Unit& u) const { return Bt + (size_t)u.pn * BM * K * 2; }
    __device__ __forceinline__ unsigned arow(const Unit&, int) const { return 0u; }
};
template <bool GATHER_A>
struct MoeSched {
    const char* A; const char* W; int K; size_t wstride; const LAS int* tb; const LAS int* cn; const unsigned* rowtok; int ntot, vcu, G;
    __device__ __forceinline__ bool next(int i, Unit& u) const { const int L = i * G + vcu; if (L >= ntot * 4) return false; u.pm = L >> 2; u.pn = L & 3; return true; }
    __device__ __forceinline__ int expert(int pm) const { int e = 0;
#pragma unroll
        for (int j = 1; j < 16; ++j) e += (pm >= tb[j]) ? 1 : 0; return e; }
    __device__ __forceinline__ const char* abase(const Unit& u) const { return GATHER_A ? A : A + (size_t)u.pm * BM * K * 2; }
    __device__ __forceinline__ const char* bbase(const Unit& u) const { return W + (size_t)expert(u.pm) * wstride + (size_t)u.pn * BM * K * 2; }
    __device__ __forceinline__ unsigned arow(const Unit& u, int r) const { const int e = expert(u.pm); const int idx = (u.pm - tb[e]) * BM + r; return idx < cn[e] ? rowtok[(size_t)e * ECAP + idx] : 0u; }
};

struct EpiBf16 {
    static constexpr bool PERM = true;
    bf16_t* O; int ldc;
    __device__ __forceinline__ void operator()(const f32x4 (&acc)[2][2][4][2], const Unit& u, int wr, int wc, int fr, int fq) const {
        const int row0 = u.pm * BM + wr * 64 + fr, col0 = u.pn * BM + wc * 32 + 8 * fq;
#pragma unroll
        for (int ai = 0; ai < 2; ++ai)
#pragma unroll
            for (int m = 0; m < 4; ++m) { bf16_t* rowp = O + (size_t)(row0 + ai * HALF + m * 16) * ldc + col0;
#pragma unroll
                for (int bj = 0; bj < 2; ++bj) { const f32x4 v0 = acc[ai][bj][m][0], v1 = acc[ai][bj][m][1];
                    u32x4 w; w.x = cvt_pk_bf16(v0[0], v0[1]); w.y = cvt_pk_bf16(v0[2], v0[3]); w.z = cvt_pk_bf16(v1[0], v1[1]); w.w = cvt_pk_bf16(v1[2], v1[3]);
                    *(u32x4*)(rowp + bj * HALF) = w; } }
    }
};
template <bool XF32>
struct EpiResid {
    static constexpr bool PERM = true;
    const float* xin; bf16_t* XB;
    __device__ __forceinline__ void operator()(const f32x4 (&acc)[2][2][4][2], const Unit& u, int wr, int wc, int fr, int fq) const {
        const int row0 = u.pm * BM + wr * 64 + fr, col0 = u.pn * BM + wc * 32 + 8 * fq;
#pragma unroll
        for (int ai = 0; ai < 2; ++ai)
#pragma unroll
            for (int m = 0; m < 4; ++m) { const size_t off = (size_t)(row0 + ai * HALF + m * 16) * D + col0;
#pragma unroll
                for (int bj = 0; bj < 2; ++bj) { f32x4 r0, r1;
                    if (XF32) { r0 = *(const f32x4*)(xin + off + bj * HALF); r1 = *(const f32x4*)(xin + off + bj * HALF + 4); }
                    else { const u32x4 w = *(const u32x4*)(XB + off + bj * HALF); r0 = (f32x4){bf_lo(w.x), bf_hi(w.x), bf_lo(w.y), bf_hi(w.y)}; r1 = (f32x4){bf_lo(w.z), bf_hi(w.z), bf_lo(w.w), bf_hi(w.w)}; }
                    const f32x4 v0 = r0 + acc[ai][bj][m][0], v1 = r1 + acc[ai][bj][m][1];
                    u32x4 w; w.x = cvt_pk_bf16(v0[0], v0[1]); w.y = cvt_pk_bf16(v0[2], v0[3]); w.z = cvt_pk_bf16(v1[0], v1[1]); w.w = cvt_pk_bf16(v1[2], v1[3]);
                    *(u32x4*)(XB + off + bj * HALF) = w; } }
    }
};
template <int MODE  >
struct EpiPair {
    static constexpr bool PERM = true;
    bf16_t* O0; bf16_t* O1; int ld1;
    const float* rstd; const unsigned* rowtok; const LAS int* tb; const LAS int* cn;
    __device__ __forceinline__ void operator()(const f32x4 (&acc)[2][2][4][2], const Unit& u, int wr, int wc, int fr, int fq) const {
        const int row0 = u.pm * BM + wr * 64 + fr;
        float rs[2][4];
        if (MODE == 0) {
#pragma unroll
            for (int ai = 0; ai < 2; ++ai)
#pragma unroll
                for (int m = 0; m < 4; ++m) rs[ai][m] = rstd[row0 + ai * HALF + m * 16];
        } else {
            int e = 0;
#pragma unroll
            for (int j = 1; j < 16; ++j) e += (u.pm >= tb[j]) ? 1 : 0;
            const int idx0 = (u.pm - tb[e]) * BM + wr * 64 + fr, cne = cn[e];
#pragma unroll
            for (int ai = 0; ai < 2; ++ai)
#pragma unroll
                for (int m = 0; m < 4; ++m) { const int idx = idx0 + ai * HALF + m * 16; const unsigned tok = idx < cne ? rowtok[(size_t)e * ECAP + idx] : 0u; rs[ai][m] = rstd[tok]; }
        }
        if (MODE == 0 && u.pn < 4) {
            const int col0 = u.pn * BM + wc * 32 + 8 * fq;
#pragma unroll
            for (int ai = 0; ai < 2; ++ai)
#pragma unroll
                for (int m = 0; m < 4; ++m) { bf16_t* rowp = O0 + (size_t)(row0 + ai * HALF + m * 16) * D + col0;
#pragma unroll
                    for (int bj = 0; bj < 2; ++bj) { const f32x4 v0 = acc[ai][bj][m][0] * rs[ai][m], v1 = acc[ai][bj][m][1] * rs[ai][m];
                        u32x4 w; w.x = cvt_pk_bf16(v0[0], v0[1]); w.y = cvt_pk_bf16(v0[2], v0[3]); w.z = cvt_pk_bf16(v1[0], v1[1]); w.w = cvt_pk_bf16(v1[2], v1[3]);
                        *(u32x4*)(rowp + bj * HALF) = w; } }
        } else {
            const int pt = (MODE == 0) ? (u.pn - 4) : u.pn;
            const int col0 = pt * HALF + wc * 32 + 8 * fq;
#pragma unroll
            for (int ai = 0; ai < 2; ++ai)
#pragma unroll
                for (int m = 0; m < 4; ++m) { bf16_t* rowp = O1 + (size_t)(row0 + ai * HALF + m * 16) * ld1 + col0;
                    f32x4 r[2];
#pragma unroll
                    for (int n = 0; n < 2; ++n) { const f32x4 g = acc[ai][0][m][n] * rs[ai][m], up = acc[ai][1][m][n] * rs[ai][m];
                        if (MODE == 0) r[n] = g * up;
                        else {
#pragma unroll
                            for (int j = 0; j < 4; ++j) r[n][j] = g[j] * fast_rcp(1.0f + fast_exp2(-1.4426950408889634f * g[j])) * up[j]; } }
                    u32x4 w; w.x = cvt_pk_bf16(r[0][0], r[0][1]); w.y = cvt_pk_bf16(r[0][2], r[0][3]); w.z = cvt_pk_bf16(r[1][0], r[1][1]); w.w = cvt_pk_bf16(r[1][2], r[1][3]);
                    *(u32x4*)rowp = w; }
        }
    }
};
struct EpiDown {
    static constexpr bool PERM = true;
    bf16_t* O; const float* cwraw; const LAS int* tb; const LAS int* cn;
    __device__ __forceinline__ void operator()(const f32x4 (&acc)[2][2][4][2], const Unit& u, int wr, int wc, int fr, int fq) const {
        int e = 0;
#pragma unroll
        for (int j = 1; j < 16; ++j) e += (u.pm >= tb[j]) ? 1 : 0;
        const int idx0 = (u.pm - tb[e]) * BM + wr * 64 + fr, cne = cn[e];
        const int row0 = u.pm * BM + wr * 64 + fr, col0 = u.pn * BM + wc * 32 + 8 * fq;
#pragma unroll
        for (int ai = 0; ai < 2; ++ai)
#pragma unroll
            for (int m = 0; m < 4; ++m) { const int idx = idx0 + ai * HALF + m * 16; const float cw = idx < cne ? cwraw[(size_t)e * ECAP + idx] : 0.f;
                bf16_t* rowp = O + (size_t)(row0 + ai * HALF + m * 16) * D + col0;
#pragma unroll
                for (int bj = 0; bj < 2; ++bj) { const f32x4 v0 = acc[ai][bj][m][0] * cw, v1 = acc[ai][bj][m][1] * cw;
                    u32x4 w; w.x = cvt_pk_bf16(v0[0], v0[1]); w.y = cvt_pk_bf16(v0[2], v0[3]); w.z = cvt_pk_bf16(v1[0], v1[1]); w.w = cvt_pk_bf16(v1[2], v1[3]);
                    *(u32x4*)(rowp + bj * HALF) = w; } }
    }
};
}

constexpr int RING_BYTES = 131072;
constexpr int MISC_OFF = RING_BYTES;
constexpr int LDS_BYTES = 147456;
constexpr int MW_BAR = 0;
constexpr int MW_TB = 16;
constexpr int MW_CN = 40;
constexpr int MW_Q = 60;
constexpr int MW_F = 64;

struct Params {
    const float* in[25]; float* out; unsigned char* ws;
};

__device__ __forceinline__ void transpose_item(const float* W, int ld, int K, int k0, int srccol, bf16_t* WT, int dstrow, LAS float* scr, int lane, const float* gk = nullptr) {
    float tv[32];
#pragma unroll
    for (int i = 0; i < 32; ++i) { const int kk = 2 * i + (lane >> 5); tv[i] = W[(size_t)(k0 + kk) * ld + srccol + (lane & 31)]; }
#pragma unroll
    for (int i = 0; i < 32; ++i) { const int kk = 2 * i + (lane >> 5); scr[kk * 33 + (lane & 31)] = gk ? tv[i] * gk[k0 + kk] : tv[i]; }
    asm volatile("s_waitcnt lgkmcnt(0)" ::: "memory");
    const int c = lane & 7;
#pragma unroll
    for (int j = 0; j < 4; ++j) { const int n = (lane >> 3) + 8 * j; const LAS float* s = scr + (8 * c) * 33 + n;
        u32x4 o; o.x = cvt_pk_bf16(s[0 * 33], s[1 * 33]); o.y = cvt_pk_bf16(s[2 * 33], s[3 * 33]); o.z = cvt_pk_bf16(s[4 * 33], s[5 * 33]); o.w = cvt_pk_bf16(s[6 * 33], s[7 * 33]);
        *(u32x4*)(WT + (size_t)(dstrow + n) * K + k0 + 8 * c) = o; }
    asm volatile("s_waitcnt lgkmcnt(0)" ::: "memory");
}
__device__ __forceinline__ int pair_row(int ch, int up) { return (ch >> 7) * 256 + up * 128 + (ch & 127); }

__device__ __forceinline__ void phase_prologue_weights(const Params& p, LAS unsigned char* lds, int first, int last, int step, int wave, int lane_) {
    int lane = lane_; asm volatile("" : "+v"(lane));
    LAS float* scr = (LAS float*)(lds + wave * 16384);
    unsigned char* ws = p.ws;
    constexpr int I1 = 16 * 112, I2 = 16 * 32, I3 = 16 * 96, I4 = 16 * 32, IE = 768;
    constexpr int NITEMS = I1 + I2 + I3 + I4 + 32 * IE;
    static_assert(NITEMS == 28928, "item count");
    for (int it = first; it < last; it += step) {
        int r = it;
        if (r < I1) { const int kb = r / 112, nb = r % 112; const int sc = nb < 64 ? 32 * nb : 2056 + 32 * (nb - 64), dr = nb < 64 ? 32 * nb : 2048 + 32 * (nb - 64);
            transpose_item(p.in[5], EVEN_IN, 1024, 64 * kb, sc, (bf16_t*)(ws + WS_WT1), dr, scr, lane); continue; } r -= I1;
        if (r < I2) { const int kb = r / 32, nb = r % 32; transpose_item(p.in[6], 1024, 1024, 64 * kb, 32 * nb, (bf16_t*)(ws + WS_WT2), 32 * nb, scr, lane); continue; } r -= I2;
        if (r < I3) { const int kb = r / 96, nb = r % 96; int dr;
            if (nb < 32) dr = 32 * nb; else if (nb < 64) dr = 1024 + pair_row(32 * (nb - 32), 0); else dr = 1024 + pair_row(32 * (nb - 64), 1);
            transpose_item(p.in[15], 3072, 1024, 64 * kb, 32 * nb, (bf16_t*)(ws + WS_WT3), dr, scr, lane, p.in[2] + D); continue; } r -= I3;
        if (r < I4) { const int kb = r / 32, nb = r % 32; transpose_item(p.in[17], 1024, 1024, 64 * kb, 32 * nb, (bf16_t*)(ws + WS_WT4), 32 * nb, scr, lane); continue; } r -= I4;
        const int le = r / IE; r %= IE;
        bf16_t* wgu = (bf16_t*)(ws + WS_WGU) + (size_t)le * 1024 * 1024; bf16_t* wd = (bf16_t*)(ws + WS_WD) + (size_t)le * 1024 * 512;
        if (r < 256) { const int kb = r / 16, nb = r % 16; transpose_item(p.in[22] + (size_t)le * 1024 * 512, 512, 1024, 64 * kb, 32 * nb, wgu, pair_row(32 * nb, 0), scr, lane, p.in[3] + (le >> 4) * D); continue; } r -= 256;
        if (r < 256) { const int kb = r / 16, nb = r % 16; transpose_item(p.in[23] + (size_t)le * 1024 * 512, 512, 1024, 64 * kb, 32 * nb, wgu, pair_row(32 * nb, 1), scr, lane, p.in[3] + (le >> 4) * D); continue; } r -= 256;
        { const int kb = r / 32, nb = r % 32; transpose_item(p.in[24] + (size_t)le * 512 * 1024, 1024, 512, 64 * kb, 32 * nb, wd, 32 * nb, scr, lane); }
    }
}

struct RowV { f32x4 v[4]; };
__device__ __forceinline__ RowV row_load(const float* xr, int lane) { RowV r; const f32x4* p = (const f32x4*)xr + lane;
#pragma unroll
    for (int j = 0; j < 4; ++j) r.v[j] = p[64 * j]; return r; }
__device__ __forceinline__ void row_store(float* xr, int lane, const RowV& r) { f32x4* p = (f32x4*)xr + lane;
#pragma unroll
    for (int j = 0; j < 4; ++j) p[64 * j] = r.v[j]; }
__device__ __forceinline__ RowV row_load_bf16(const bf16_t* yr, int lane) { RowV r; const u32x2* p = (const u32x2*)yr + lane;
#pragma unroll
    for (int j = 0; j < 4; ++j) { const u32x2 w = p[64 * j]; r.v[j] = (f32x4){bf_lo(w.x), bf_hi(w.x), bf_lo(w.y), bf_hi(w.y)}; } return r; }
__device__ __forceinline__ float row_rstd(const RowV& r) { float s = 0.f;
#pragma unroll
    for (int j = 0; j < 4; ++j) s += (r.v[j][0] * r.v[j][0] + r.v[j][1] * r.v[j][1]) + (r.v[j][2] * r.v[j][2] + r.v[j][3] * r.v[j][3]);
    return 1.0f / sqrtf(wave_sum(s) * (1.0f / D) + NORM_EPS); }
__device__ __forceinline__ void row_store_bf16(bf16_t* hr, int lane, const RowV& r) { u32x2* p = (u32x2*)hr + lane;
#pragma unroll
    for (int j = 0; j < 4; ++j) { u32x2 w; w.x = cvt_pk_bf16(r.v[j][0], r.v[j][1]); w.y = cvt_pk_bf16(r.v[j][2], r.v[j][3]); p[64 * j] = w; } }

__device__ __forceinline__ void phase_norm_gates(const Params& p, LAS unsigned char* lds, int tid, int gw, int NGW, int lane) {
    const float* x = p.in[0]; const float* g = p.in[2]; const float* win = p.in[5];
    bf16_t* H = (bf16_t*)(p.ws + WS_H); float* gates = (float*)(p.ws + WS_GATES);
    LAS float* wt = (LAS float*)lds;
    for (int i = tid; i < 8 * 1024; i += NTHR) { const int k = i >> 3, o = i & 7; wt[o * 1024 + k] = win[(size_t)k * EVEN_IN + 2048 + o] * g[k]; }
    __syncthreads();
    RowV gv = row_load(g, lane);
    for (int m0 = gw; m0 < T; m0 += 2 * NGW) {
      RowV rr[2];
#pragma unroll
      for (int u = 0; u < 2; ++u) { const int mm = m0 + u * NGW; rr[u] = row_load(x + (size_t)(mm < T ? mm : m0) * D, lane); }
#pragma unroll
      for (int u = 0; u < 2; ++u) {
        const int m = m0 + u * NGW; if (m >= T) break; RowV r = rr[u];
        const float rstd = row_rstd(r);
        float dots[8];
#pragma unroll
        for (int o = 0; o < 8; ++o) { float s = 0.f;
#pragma unroll
            for (int j = 0; j < 4; ++j) { const f32x4 w = *(const LAS f32x4*)(wt + o * 1024 + 4 * lane + 256 * j); s += (r.v[j][0] * w[0] + r.v[j][1] * w[1]) + (r.v[j][2] * w[2] + r.v[j][3] * w[3]); }
            dots[o] = wave_sum(s) * rstd; }
#pragma unroll
        for (int j = 0; j < 4; ++j) r.v[j] = r.v[j] * rstd * gv.v[j];
        row_store_bf16(H + (size_t)m * D, lane, r);
        if (lane < 8) { float v = dots[0];
#pragma unroll
            for (int o = 1; o < 8; ++o) v = (lane == o) ? dots[o] : v;
            gates[(size_t)m * 8 + lane] = v; }
      }
    }
    __syncthreads();
}

template <int MODE, bool COMBINE>
__device__ __forceinline__ void phase_rows(const Params& p, LAS unsigned char* lds, int tid_, int wave, int lane_, int G,
                                           const float* gvec, const float* wgr, const float* bgr, const float* wer, const float* ber, unsigned* cnt_prev, unsigned* cnt_cur) {
    int tid = tid_; asm volatile("" : "+v"(tid)); const int lane = tid & 63;
    float* OUT = p.out; bf16_t* XB = (bf16_t*)(p.ws + WS_XB); float* RSTD = (float*)(p.ws + WS_RSTD);
    const bf16_t* YC = (const bf16_t*)(p.ws + WS_YC);
    unsigned* tokinfo = (unsigned*)(p.ws + WS_TOKINFO);
    unsigned* rowtok = (unsigned*)(p.ws + WS_ROWTOK); float* cwraw = (float*)(p.ws + WS_CWRAW);
    LAS float* wt = (LAS float*)lds;
    LAS int* misc = (LAS int*)(lds + MISC_OFF);
    LAS int* tbp = misc + MW_TB;
    LAS int* te = misc + 1024;
    LAS float* tc = (LAS float*)(misc + 1536);
    LAS int* trank = misc + 2048;
    LAS int* ebase = misc + 2560;
    if (COMBINE) { if (tid == 0) { int acc = 0; for (int e = 0; e < 16; ++e) { tbp[e] = acc; acc += ((int)__hip_atomic_load(cnt_prev + e * 64, __ATOMIC_RELAXED, __HIP_MEMORY_SCOPE_AGENT) + 255) >> 8; } tbp[16] = acc; } }
    if (MODE == 1) { for (int i = tid; i < 20 * 1024; i += NTHR) { const int o = i >> 10, k = i & 1023; wt[i] = (o < 4 ? wgr[(size_t)k * 4 + o] : wer[(size_t)k * 16 + (o - 4)]) * gvec[k]; } }
    __syncthreads();
    RowV gv; if (MODE == 2) gv = row_load(gvec, lane);
    for (int blk = blockIdx.x; blk < T / 256; blk += G) {
        for (int i2 = 0; i2 < 32; i2 += 2) {
          RowV rr[2];
#pragma unroll
          for (int u = 0; u < 2; ++u) {
            const int m = blk * 256 + wave * 32 + i2 + u;
            rr[u] = row_load_bf16(XB + (size_t)m * D, lane);
            if (COMBINE) {
                const unsigned i0 = tokinfo[(size_t)m * 2], i1 = tokinfo[(size_t)m * 2 + 1];
                const size_t s0 = (size_t)tbp[i0 >> 16] * 256 + (i0 & 0xffffu), s1 = (size_t)tbp[i1 >> 16] * 256 + (i1 & 0xffffu);
                const RowV y0 = row_load_bf16(YC + s0 * D, lane), y1 = row_load_bf16(YC + s1 * D, lane);
#pragma unroll
                for (int j = 0; j < 4; ++j) rr[u].v[j] = rr[u].v[j] + y0.v[j] + y1.v[j];
            }
          }
#pragma unroll
          for (int u = 0; u < 2; ++u) {
            const int i = i2 + u;
            const int rl = wave * 32 + i, m = blk * 256 + rl;
            RowV r = rr[u];
            if (MODE == 0) {
                u32x2* xp = (u32x2*)(XB + (size_t)m * D) + lane;
#pragma unroll
                for (int j = 0; j < 4; ++j) { u32x2 w; w.x = cvt_pk_bf16(r.v[j][0], r.v[j][1]); w.y = cvt_pk_bf16(r.v[j][2], r.v[j][3]); xp[64 * j] = w;
                    r.v[j] = (f32x4){bf_lo(w.x), bf_hi(w.x), bf_lo(w.y), bf_hi(w.y)}; }
            }
            const float rstd = row_rstd(r);
            if (MODE != 2) { if (lane == 0) RSTD[m] = rstd; }
            if (MODE == 1) {
                float lg[20];
#pragma unroll
                for (int o = 0; o < 20; ++o) { float s = 0.f;
#pragma unroll
                    for (int j = 0; j < 4; ++j) { const f32x4 w = *(const LAS f32x4*)(wt + o * 1024 + 4 * lane + 256 * j); s += (r.v[j][0] * w[0] + r.v[j][1] * w[1]) + (r.v[j][2] * w[2] + r.v[j][3] * w[3]); }
                    lg[o] = wave_sum(s) * rstd + (o < 4 ? bgr[o] : ber[o - 4]); }
                int gs = 0; float gm = lg[0];
#pragma unroll
                for (int o = 1; o < 4; ++o) if (lg[o] > gm) { gm = lg[o]; gs = o; }
                float den = 0.f;
#pragma unroll
                for (int o = 0; o < 4; ++o) den += __expf(lg[o] - gm);
                const float pg = 1.0f / den;
                float el[4];
#pragma unroll
                for (int o = 0; o < 4; ++o) { float v = lg[4 + o];
#pragma unroll
                    for (int g2 = 1; g2 < 4; ++g2) v = (gs == g2) ? lg[4 + 4 * g2 + o] : v;
                    el[o] = v; }
                int i0 = 0; float v0 = el[0];
#pragma unroll
                for (int o = 1; o < 4; ++o) if (el[o] > v0) { v0 = el[o]; i0 = o; }
                int i1 = -1; float v1 = -INFINITY;
#pragma unroll
                for (int o = 0; o < 4; ++o) if (o != i0 && el[o] > v1) { v1 = el[o]; i1 = o; }
                const float ex = __expf(v1 - v0); const float w0 = 1.0f / (1.0f + ex), w1 = ex * w0;
                if (lane == 0) { te[rl * 2] = gs * 4 + i0; te[rl * 2 + 1] = gs * 4 + i1; tc[rl * 2] = w0 * pg; tc[rl * 2 + 1] = w1 * pg; }
            }
            if (MODE == 2) {
#pragma unroll
                for (int j = 0; j < 4; ++j) r.v[j] = r.v[j] * rstd * gv.v[j];
                row_store(OUT + (size_t)m * D, lane, r);
            }
          }
        }
        if (MODE == 1) {
            __syncthreads();
            if (tid < 16) { int c = 0; for (int q = 0; q < 512; ++q) if (te[q] == tid) { trank[q] = c; ++c; }
                ebase[tid] = c ? (int)__hip_atomic_fetch_add(cnt_cur + tid * 64, (unsigned)c, __ATOMIC_RELAXED, __HIP_MEMORY_SCOPE_AGENT) : 0; }
            __syncthreads();
            { const int q = tid, e = te[q], pos = ebase[e] + trank[q], tok = blk * 256 + (q >> 1);
              rowtok[(size_t)e * ECAP + pos] = (unsigned)tok; cwraw[(size_t)e * ECAP + pos] = tc[q]; tokinfo[(size_t)tok * 2 + (q & 1)] = ((unsigned)e << 16) | (unsigned)pos; }
            __syncthreads();
        }
    }
    __syncthreads();
}

__device__ __forceinline__ void phase_conv(const Params& p, int gw, int NGW, int lane) {
    const bf16_t* BG = (const bf16_t*)(p.ws + WS_BG); const bf16_t* Z = (const bf16_t*)(p.ws + WS_Z); bf16_t* A2 = (bf16_t*)(p.ws + WS_CAT);
    const float* cw = p.in[16];
    float w0[16], w1[16], w2[16];
#pragma unroll
    for (int h = 0; h < 2; ++h)
#pragma unroll
        for (int j = 0; j < 8; ++j) { const int c = h * 512 + lane * 8 + j; w0[h * 8 + j] = cw[c]; w1[h * 8 + j] = cw[D + c]; w2[h * 8 + j] = cw[2 * D + c]; }
    for (int run = gw; run < T / 32; run += NGW) {
        const int t0 = run * 32;
        float zm1[16], zm2[16];
#pragma unroll
        for (int j = 0; j < 16; ++j) { zm1[j] = 0.f; zm2[j] = 0.f; }
        if ((t0 & (SEQ - 1)) != 0) {
#pragma unroll
            for (int h = 0; h < 2; ++h) { const u32x4 a = *(const u32x4*)(Z + (size_t)(t0 - 1) * D + h * 512 + lane * 8), b = *(const u32x4*)(Z + (size_t)(t0 - 2) * D + h * 512 + lane * 8);
#pragma unroll
                for (int q = 0; q < 4; ++q) { zm1[h * 8 + 2 * q] = bf_lo(a[q]); zm1[h * 8 + 2 * q + 1] = bf_hi(a[q]); zm2[h * 8 + 2 * q] = bf_lo(b[q]); zm2[h * 8 + 2 * q + 1] = bf_hi(b[q]); } }
        }
#pragma unroll 4
        for (int i = 0; i < 32; ++i) {
            const size_t rb = (size_t)(t0 + i) * D;
#pragma unroll
            for (int h = 0; h < 2; ++h) { const u32x4 zz = *(const u32x4*)(Z + rb + h * 512 + lane * 8), bb = *(const u32x4*)(BG + rb + h * 512 + lane * 8);
                float o[8];
#pragma unroll
                for (int q = 0; q < 4; ++q) {
#pragma unroll
                    for (int s = 0; s < 2; ++s) { const int j = h * 8 + 2 * q + s; const float zc = s ? bf_hi(zz[q]) : bf_lo(zz[q]), bg = s ? bf_hi(bb[q]) : bf_lo(bb[q]);
                        o[2 * q + s] = bg * (w0[j] * zm2[j] + w1[j] * zm1[j] + w2[j] * zc); zm2[j] = zm1[j]; zm1[j] = zc; } }
                u32x4 w; w.x = cvt_pk_bf16(o[0], o[1]); w.y = cvt_pk_bf16(o[2], o[3]); w.z = cvt_pk_bf16(o[4], o[5]); w.w = cvt_pk_bf16(o[6], o[7]);
                *(u32x4*)(A2 + rb + h * 512 + lane * 8) = w; }
        }
    }
}

__device__ __forceinline__ void phase_gate_scan(const Params& p, int gw, int NGW, int lane) {
    const float* gates = (const float*)(p.ws + WS_GATES);
    float* SA = (float*)(p.ws + WS_SA); float* SAM = (float*)(p.ws + WS_SAM); float* SBA = (float*)(p.ws + WS_SBA);
    for (int sq = gw; sq < NBATCH * 4; sq += NGW) {
        const int b = sq >> 2, hd = sq & 3; const float ib = p.in[7][hd], fb = p.in[8][hd];
        float lf[32], ig[32];
#pragma unroll
        for (int i = 0; i < 32; ++i) { const size_t t = (size_t)b * SEQ + lane * 32 + i; const float f = gates[t * 8 + 4 + hd] + fb; ig[i] = gates[t * 8 + hd] + ib;
            lf[i] = (f >= 0.f) ? -log1pf(expf(-f)) : (f - log1pf(expf(f))); }
        float run = 0.f;
#pragma unroll
        for (int i = 0; i < 32; ++i) { run += lf[i]; lf[i] = run; }
        float tot = run, pre = 0.f;
#pragma unroll
        for (int o = 1; o < 64; o <<= 1) { const float v = __shfl_up(tot, o); if (lane >= o) tot += v; }
        pre = tot - run;
        float amax = -INFINITY;
#pragma unroll
        for (int i = 0; i < 32; ++i) { lf[i] += pre; ig[i] = ig[i] - lf[i]; amax = fmaxf(amax, ig[i]); }
        float pm = amax;
#pragma unroll
        for (int o = 1; o < 64; o <<= 1) { const float v = __shfl_up(pm, o); if (lane >= o) pm = fmaxf(pm, v); }
        float prev = __shfl_up(pm, 1); if (lane == 0) prev = -INFINITY;
        float rm = prev;
#pragma unroll
        for (int i = 0; i < 32; ++i) { const size_t o = (size_t)sq * SEQ + lane * 32 + i; rm = fmaxf(rm, ig[i]); SA[o] = ig[i]; SAM[o] = rm; SBA[o] = lf[i] + rm; }
    }
}

struct TileRegs { u32x4 v[2]; };
__device__ __forceinline__ TileRegs tile_load(const bf16_t* src, int tid) { TileRegs r;
#pragma unroll
    for (int i = 0; i < 2; ++i) { const int n = tid + 512 * i, row = n >> 4, ch = n & 15; r.v[i] = *(const u32x4*)(src + (size_t)row * NP + ch * 8); } return r; }
__device__ __forceinline__ void tile_write(LAS unsigned char* dst, int tid, const TileRegs& r) {
#pragma unroll
    for (int i = 0; i < 2; ++i) { const int n = tid + 512 * i, row = n >> 4, ch = n & 15; *(LAS u32x4*)(dst + off_b(row, ch)) = r.v[i]; } }

__device__ __forceinline__ void glds16(const void* gsrc, unsigned lds_dst) { unsigned keep;
    asm volatile("s_mov_b32 %0, m0\n\ts_mov_b32 m0, %2\n\ts_nop 0\n\tglobal_load_lds_dwordx4 %1, off\n\ts_mov_b32 m0, %0" : "=&s"(keep) : "v"(gsrc), "s"(lds_dst) : "memory"); }
__device__ __forceinline__ void tile_dma(const bf16_t* src, LAS unsigned char* dst, int wave, int lane) {
#pragma unroll
    for (int i = 0; i < 2; ++i) { const int piece = 2 * wave + i, row = 4 * piece + (lane >> 4); const unsigned ch = (unsigned)(lane & 15) ^ ((((unsigned)lane >> 4) << 2) | ((unsigned)piece & 3u));
        glds16(src + (size_t)row * NP + ch * 8, (unsigned)__builtin_amdgcn_readfirstlane((int)(unsigned)(uintptr_t)(dst + piece * 1024))); }
}
#define WAIT_ALL_BAR() asm volatile("s_waitcnt vmcnt(0) lgkmcnt(0)\n\ts_barrier" ::: "memory")
__device__ __forceinline__ void attn_unit(const Params& p, LAS unsigned char* lds, int bh, int qblk, int tid_, int wave, int lane_) {
    int tid = tid_; asm volatile("" : "+v"(tid)); const int lane = tid & 63;
    const bf16_t* P = (const bf16_t*)(p.ws + WS_P); bf16_t* CAT = (bf16_t*)(p.ws + WS_CAT);
    const int b = bh >> 2, hd = bh & 3, map = wave >> 2, qs = wave & 3, r32 = lane & 31, hi = lane >> 5;
    const size_t rowbase = (size_t)b * SEQ;
    const int q0 = qblk * 128 + qs * 32, qrow = q0 + r32;
    LAS float* fs = (LAS float*)(lds + MISC_OFF) + MW_F;
    LAS float* tbl = fs;
    constexpr float LOG2E = 1.4426950408889634f;
    if (tid < 128) { const int n = tid; int bk;
        if (n < 16) bk = n; else { bk = 16; const int th[15] = {19, 21, 24, 27, 31, 35, 40, 46, 52, 59, 67, 77, 87, 99, 113};
#pragma unroll
            for (int j = 0; j < 15; ++j) bk += (n >= th[j]) ? 1 : 0; }
        tbl[n] = p.in[1][bk * 4 + hd] * LOG2E; }
    bf16x8 qf[4];
    { const bf16_t* qp = P + (rowbase + qrow) * NP + P_DQ + hd * 128 + map * 64 + hi * 8;
#pragma unroll
      for (int ks = 0; ks < 4; ++ks) qf[ks] = *(const bf16x8*)(qp + ks * 16); }
    const bf16_t* Kg = P + rowbase * NP + P_DK + hd * 128; const bf16_t* Vg = P + rowbase * NP + P_DV + hd * 128;
    const int NS = qblk + 1;
    f32x16 o[4];
#pragma unroll
    for (int c = 0; c < 4; ++c) o[c] = (f32x16){};
    float mrun = -INFINITY, lrun = 0.f;
    const float bias_far = p.in[1][31 * 4 + hd] * LOG2E;
    const float sc2 = 0.125f * LOG2E;
    const unsigned xr = ((unsigned)(r32 & 3) << 2) | ((unsigned)(r32 >> 2) & 3u);
    const unsigned q4 = (lane & 15) >> 2, pp = lane & 3, blk = (lane >> 4) & 1;
#ifndef ATT_DMA
#define ATT_DMA 5
#endif
#if ATT_DMA == 2 || ATT_DMA == 4
#elif ATT_DMA
    WAIT_ALL_BAR();
    { tile_dma(Kg, lds, wave, lane); tile_dma(Vg, lds + 16384, wave, lane); tile_dma(Kg + (size_t)64 * NP, lds + 32768, wave, lane); tile_dma(Vg + (size_t)64 * NP, lds + 49152, wave, lane); }
#else
    { TileRegs a0 = tile_load(Kg, tid), a1 = tile_load(Vg, tid), a2 = tile_load(Kg + (size_t)64 * NP, tid), a3 = tile_load(Vg + (size_t)64 * NP, tid);
      tile_write(lds, tid, a0); tile_write(lds + 16384, tid, a1); tile_write(lds + 32768, tid, a2); tile_write(lds + 49152, tid, a3); }
#endif
#if ATT_DMA == 5
    WAIT_ALL_BAR();
#endif
    asm volatile("" :: "v"(qf[0]), "v"(qf[1]), "v"(qf[2]), "v"(qf[3]));
#pragma unroll 1
    for (int st = 0; st < NS; ++st) {
        WAIT_ALL_BAR();
#if ATT_DMA == 2
        { LAS unsigned char* nb = lds + (st & 1) * 65536; const size_t ro = (size_t)st * 128 * NP;
            tile_dma(Kg + ro, nb, wave, lane); tile_dma(Vg + ro, nb + 16384, wave, lane); tile_dma(Kg + ro + (size_t)64 * NP, nb + 32768, wave, lane); tile_dma(Vg + ro + (size_t)64 * NP, nb + 49152, wave, lane); }
        WAIT_ALL_BAR();
#elif ATT_DMA == 3
#elif ATT_DMA
#if ATT_DMA == 4
        if (st == 0) { tile_dma(Kg, lds, wave, lane); tile_dma(Vg, lds + 16384, wave, lane); tile_dma(Kg + (size_t)64 * NP, lds + 32768, wave, lane); tile_dma(Vg + (size_t)64 * NP, lds + 49152, wave, lane); WAIT_ALL_BAR(); }
#endif
        if (st + 1 < NS) { LAS unsigned char* nb = lds + ((st + 1) & 1) * 65536; const size_t ro = (size_t)(st + 1) * 128 * NP;
            tile_dma(Kg + ro, nb, wave, lane); tile_dma(Vg + ro, nb + 16384, wave, lane); tile_dma(Kg + ro + (size_t)64 * NP, nb + 32768, wave, lane); tile_dma(Vg + ro + (size_t)64 * NP, nb + 49152, wave, lane); }
#else
        TileRegs a0, a1;
        if (st + 1 < NS) { const size_t ro = (size_t)(st + 1) * 128 * NP; a0 = tile_load(Kg + ro, tid); a1 = tile_load(Vg + ro, tid); }
#endif
#pragma unroll
        for (int half = 0; half < 2; ++half) {
            const int j = 2 * st + half;
            const LAS unsigned char* Kt = lds + (st & 1) * 65536 + half * 32768; const LAS unsigned char* Vt = Kt + 16384;
            if (64 * j <= q0 + 31) {
                f32x16 p0 = (f32x16){}, p1 = (f32x16){};
#pragma unroll
                for (int ks = 0; ks < 4; ++ks) { const unsigned ch = (unsigned)(8 * map + 2 * ks + hi) ^ xr;
                    const bf16x8 k0 = *(const LAS bf16x8*)(Kt + 256u * r32 + 16u * ch), k1 = *(const LAS bf16x8*)(Kt + 256u * (32 + r32) + 16u * ch);
                    p0 = __builtin_amdgcn_mfma_f32_32x32x16_bf16(k0, qf[ks], p0, 0, 0, 0); p1 = __builtin_amdgcn_mfma_f32_32x32x16_bf16(k1, qf[ks], p1, 0, 0, 0); }
                __builtin_amdgcn_sched_barrier(0);
                const int nmin = q0 - (64 * j + 63);
                float rm;
                if (nmin >= 113) {
                    float a = fmaxf(p0[0], p1[0]);
#pragma unroll
                    for (int r = 1; r < 16; ++r) a = fmaxf(a, fmaxf(p0[r], p1[r]));
                    rm = a * sc2 + bias_far;
#pragma unroll
                    for (int r = 0; r < 16; ++r) { p0[r] = p0[r] * sc2 + bias_far; p1[r] = p1[r] * sc2 + bias_far; }
                } else {
                    const int nb0 = qrow - 64 * j - 4 * hi;
                    float bv0[16], bv1[16];
#pragma unroll
                    for (int r = 0; r < 16; ++r) { const int n0 = nb0 - ((r & 3) + 8 * (r >> 2)), n1 = n0 - 32;
                        bv0[r] = tbl[min(max(n0, 0), 127)]; bv1[r] = tbl[min(max(n1, 0), 127)]; }
                    rm = -INFINITY;
#pragma unroll
                    for (int r = 0; r < 16; ++r) { const int n0 = nb0 - ((r & 3) + 8 * (r >> 2)), n1 = n0 - 32;
                        p0[r] = (n0 >= 0) ? p0[r] * sc2 + bv0[r] : -INFINITY; p1[r] = (n1 >= 0) ? p1[r] * sc2 + bv1[r] : -INFINITY;
                        rm = fmaxf(rm, fmaxf(p0[r], p1[r])); }
                }
                { auto rr = __builtin_amdgcn_permlane32_swap(__float_as_uint(rm), __float_as_uint(rm), false, false); rm = fmaxf(__uint_as_float(rr[0]), __uint_as_float(rr[1])); }
                if (__any(rm > mrun + 8.0f)) {
                    const float mnew = fmaxf(mrun, rm); const float alpha = fast_exp2(mrun - mnew);
                    lrun *= alpha; mrun = mnew;
#pragma unroll
                    for (int c = 0; c < 4; ++c)
#pragma unroll
                        for (int r = 0; r < 16; ++r) o[c][r] *= alpha;
                }
                float ps = 0.f;
#pragma unroll
                for (int r = 0; r < 16; ++r) { p0[r] = fast_exp2(p0[r] - mrun); p1[r] = fast_exp2(p1[r] - mrun); ps += p0[r] + p1[r]; }
                lrun += ps;
                bf16x8 pf[4];
#pragma unroll
                for (int ks = 0; ks < 4; ++ks) { u32x4 w;
#pragma unroll
                    for (int q = 0; q < 4; ++q) { const int r = 8 * (ks & 1) + 2 * q; w[q] = (ks < 2) ? cvt_pk_bf16(p0[r], p0[r + 1]) : cvt_pk_bf16(p1[r], p1[r + 1]); }
                    pf[ks] = __builtin_bit_cast(bf16x8, w); }
                bf16x8 vf[2][4];
#define ATT_LOADV(buf, ks_) do { _Pragma("unroll") for (int c = 0; c < 4; ++c) { const unsigned chv = (unsigned)(4 * c + 2 * blk + (pp >> 1)); const unsigned row0 = 16u * (ks_) + 4u * hi + q4; \
                        vf[buf][c] = cat8(vtr(Vt + off_b(row0, chv) + 8u * (pp & 1)), vtr(Vt + off_b(row0 + 8u, chv) + 8u * (pp & 1))); } } while (0)
                ATT_LOADV(0, 0);
#pragma unroll
                for (int ks = 0; ks < 4; ++ks) {
                    if (ks < 3) ATT_LOADV((ks + 1) & 1, ks + 1);
                    __builtin_amdgcn_sched_barrier(0);
#pragma unroll
                    for (int c = 0; c < 4; ++c) o[c] = __builtin_amdgcn_mfma_f32_32x32x16_bf16(vf[ks & 1][c], pf[ks], o[c], 0, 0, 0);
                    __builtin_amdgcn_sched_barrier(0);
                }
#undef ATT_LOADV
            }
#if ATT_DMA == 5
            if (half == 0) WAIT_ALL_BAR();
#endif
#if !ATT_DMA
            if (st + 1 < NS) { LAS unsigned char* nb = lds + ((st + 1) & 1) * 65536 + half * 32768; tile_write(nb, tid, a0); tile_write(nb + 16384, tid, a1);
                if (half == 0) { const size_t ro = (size_t)(st + 1) * 128 * NP + (size_t)64 * NP; a0 = tile_load(Kg + ro, tid); a1 = tile_load(Vg + ro, tid); } }
#endif
        }
#if ATT_DMA == 3
        WAIT_ALL_BAR();
        if (st + 1 < NS) { LAS unsigned char* nb = lds + ((st + 1) & 1) * 65536; const size_t ro = (size_t)(st + 1) * 128 * NP;
            tile_dma(Kg + ro, nb, wave, lane); tile_dma(Vg + ro, nb + 16384, wave, lane); tile_dma(Kg + ro + (size_t)64 * NP, nb + 32768, wave, lane); tile_dma(Vg + ro + (size_t)64 * NP, nb + 49152, wave, lane); }
#endif

    }
    WAIT_ALL_BAR();
    lrun += __shfl_xor(lrun, 32);
    const float inv = 1.0f / lrun;
    float lam;
    { float s1 = 0.f, s2 = 0.f; const float a1 = p.in[10][lane] * p.in[11][lane], a2 = p.in[12][lane] * p.in[13][lane]; s1 = wave_sum(a1); s2 = wave_sum(a2);
      const float lam_init = 0.8f - 0.6f * 1.0f;
      lam = expf(s1) - expf(s2) + lam_init; }
    LAS float* xch = (LAS float*)lds + qs * 4096;
    if (map == 1) {
#pragma unroll
        for (int c = 0; c < 4; ++c)
#pragma unroll
            for (int r = 0; r < 16; ++r) xch[(32 * c + crow(r, hi)) * 32 + r32] = o[c][r] * inv * lam;
    }
    __syncthreads();
    if (map == 0) {
        float ss = 0.f;
#pragma unroll
        for (int c = 0; c < 4; ++c)
#pragma unroll
            for (int r = 0; r < 16; ++r) { const float v = o[c][r] * inv - xch[(32 * c + crow(r, hi)) * 32 + r32]; o[c][r] = v; ss += v * v; }
        ss += __shfl_xor(ss, 32);
        const float rstd = 1.0f / sqrtf(ss * (1.0f / 128.0f) + NORM_EPS) * 0.8f;
        const float* sub = p.in[14];
        bf16_t* orow = CAT + (rowbase + qrow) * D + 512 + hd * 128;
#pragma unroll
        for (int c = 0; c < 4; ++c)
#pragma unroll
            for (int rq = 0; rq < 4; ++rq) { const int e0 = 32 * c + 8 * rq + 4 * hi; const f32x4 sv = *(const f32x4*)(sub + e0);
                u32x2 w; w.x = cvt_pk_bf16(o[c][4 * rq] * rstd * sv[0], o[c][4 * rq + 1] * rstd * sv[1]); w.y = cvt_pk_bf16(o[c][4 * rq + 2] * rstd * sv[2], o[c][4 * rq + 3] * rstd * sv[3]);
                *(u32x2*)(orow + e0) = w; }
    }
    __syncthreads();
}

__device__ __forceinline__ void mlstm_s1_unit(const Params& p, LAS unsigned char* lds, int bh, int c, int tid_, int wave, int lane_) {
    int tid = tid_; asm volatile("" : "+v"(tid)); const int lane = tid & 63;
    const bf16_t* P = (const bf16_t*)(p.ws + WS_P);
    const int b = bh >> 2, hd = bh & 3, r32 = lane & 31, hi = lane >> 5;
    const size_t t0 = (size_t)b * SEQ + (size_t)c * MCH;
    const float* SA = (const float*)(p.ws + WS_SA) + (size_t)bh * SEQ + c * MCH;
    LAS float* fs = (LAS float*)(lds + MISC_OFF) + MW_F;
    LAS float* wsm = fs;
    LAS float* red = fs + 256;
    float av = (tid < 256) ? SA[tid] : -INFINITY;
    float mx = av;
#pragma unroll
    for (int o = 1; o < 64; o <<= 1) mx = fmaxf(mx, __shfl_xor(mx, o));
    if (lane == 0) red[wave] = mx;
    __syncthreads();
    float R = red[0];
#pragma unroll
    for (int w = 1; w < 4; ++w) R = fmaxf(R, red[w]);
    if (tid < 256) wsm[tid] = __expf(av - R) * 0.08838834764831845f;
    __syncthreads();
    LAS unsigned char* Kl = lds; LAS unsigned char* Vl = lds + 65536;
    const bf16_t* Kg = P + t0 * NP + P_MK + hd * 128; const bf16_t* Vg = P + t0 * NP + P_MV + hd * 128;
#pragma unroll
    for (int i = 0; i < 8; ++i) { const int n = tid + 512 * i, row = n >> 4, ch = n & 15;
        const u32x4 kv = *(const u32x4*)(Kg + (size_t)row * NP + ch * 8); const u32x4 vv = *(const u32x4*)(Vg + (size_t)row * NP + ch * 8);
        const float w = wsm[row]; u32x4 ks;
#pragma unroll
        for (int q = 0; q < 4; ++q) ks[q] = cvt_pk_bf16(bf_lo(kv[q]) * w, bf_hi(kv[q]) * w);
        *(LAS u32x4*)(Kl + off_b(row, ch)) = ks; *(LAS u32x4*)(Vl + off_b(row, ch)) = vv; }
    __syncthreads();
    const int eb = wave >> 1, dh = wave & 1;
    const unsigned q4 = (lane & 15) >> 2, pp = lane & 3, blk = (lane >> 4) & 1;
    f32x16 acc[2]; acc[0] = (f32x16){}; acc[1] = (f32x16){};
    for (int ks = 0; ks < 16; ++ks) {
        const unsigned row0 = 16u * ks + 8u * hi + q4, row1 = row0 + 4u;
        const unsigned cha = (unsigned)(4 * eb + 2 * blk + (pp >> 1));
        const bf16x8 af = cat8(vtr(Vl + off_b(row0, cha) + 8u * (pp & 1)), vtr(Vl + off_b(row1, cha) + 8u * (pp & 1)));
#pragma unroll
        for (int db = 0; db < 2; ++db) { const unsigned chb = (unsigned)(4 * (2 * dh + db) + 2 * blk + (pp >> 1));
            const bf16x8 bfr = cat8(vtr(Kl + off_b(row0, chb) + 8u * (pp & 1)), vtr(Kl + off_b(row1, chb) + 8u * (pp & 1)));
            acc[db] = __builtin_amdgcn_mfma_f32_32x32x16_bf16(af, bfr, acc[db], 0, 0, 0); }
    }
    const int unit = bh * NCH + c;
    float* UT = (float*)(p.ws + WS_UT) + (size_t)unit * 16384;
#pragma unroll
    for (int db = 0; db < 2; ++db)
#pragma unroll
        for (int r = 0; r < 16; ++r) UT[(32 * eb + crow(r, hi)) * 128 + 64 * dh + 32 * db + r32] = acc[db][r];
    if (tid < 128) { float s = 0.f; const int d = tid;
        for (int srow = 0; srow < 256; ++srow) { const unsigned short hv = *(const LAS unsigned short*)(Kl + off_b(srow, d >> 3) + (d & 7) * 2); s += __uint_as_float((unsigned)hv << 16); }
        ((float*)(p.ws + WS_UN))[(size_t)unit * 128 + d] = s; }
    if (tid == 0) ((float*)(p.ws + WS_UR))[unit] = R;
    __syncthreads();
}

__device__ __forceinline__ void mlstm_s3_unit(const Params& p, LAS unsigned char* lds, int bh, int c, int tid_, int wave, int lane_) {
    int tid = tid_; asm volatile("" : "+v"(tid)); const int lane = tid & 63;
    const bf16_t* P = (const bf16_t*)(p.ws + WS_P); bf16_t* CAT = (bf16_t*)(p.ws + WS_CAT);
    const int b = bh >> 2, hd = bh & 3, r32 = lane & 31, hi = lane >> 5;
    const size_t t0 = (size_t)b * SEQ + (size_t)c * MCH;
    const size_t so = (size_t)bh * SEQ + c * MCH;
    const float* SA = (const float*)(p.ws + WS_SA) + so; const float* SAM = (const float*)(p.ws + WS_SAM) + so; const float* SBA = (const float*)(p.ws + WS_SBA) + so;
    LAS float* fs = (LAS float*)(lds + MISC_OFF) + MW_F;
    LAS float* as = fs;
    LAS float* nC = fs + 256;
    LAS unsigned char* Ct = lds + 65536;
    const int qloc = 32 * wave + r32;
    const float Aq = SAM[qloc], BAq = SBA[qloc];
    if (tid < 256) as[tid] = SA[tid];
    bf16x8 qf[8];
    { const bf16_t* qp = P + (t0 + qloc) * NP + P_MQ + hd * 128 + hi * 8;
#pragma unroll
      for (int ks = 0; ks < 8; ++ks) qf[ks] = *(const bf16x8*)(qp + ks * 16); }
    f32x16 o[4];
#pragma unroll
    for (int cb = 0; cb < 4; ++cb) o[cb] = (f32x16){};
    float den = 0.f;
    const unsigned xr = ((unsigned)(r32 & 3) << 2) | ((unsigned)(r32 >> 2) & 3u);
    const bf16_t* Kg = P + t0 * NP + P_MK + hd * 128; const bf16_t* Vg = P + t0 * NP + P_MV + hd * 128;
    if (c > 0) {
        const float* UR = (const float*)(p.ws + WS_UR) + bh * NCH; const float* UT = (const float*)(p.ws + WS_UT) + (size_t)bh * NCH * 16384; const float* UN = (const float*)(p.ws + WS_UN) + (size_t)bh * NCH * 128;
        float Pref = -INFINITY;
        for (int j = 0; j < c; ++j) Pref = fmaxf(Pref, UR[j]);
#pragma unroll 1
        for (int i = 0; i < 4; ++i) { const int n = tid + 512 * i, e = n >> 4, ch = n & 15; f32x4 s0 = (f32x4){0.f, 0.f, 0.f, 0.f}, s1 = s0;
            for (int j = 0; j < c; ++j) { const float cf = __expf(UR[j] - Pref); const f32x4* up = (const f32x4*)(UT + (size_t)j * 16384 + e * 128 + ch * 8); s0 += up[0] * cf; s1 += up[1] * cf; }
            u32x4 w; w.x = cvt_pk_bf16(s0[0], s0[1]); w.y = cvt_pk_bf16(s0[2], s0[3]); w.z = cvt_pk_bf16(s1[0], s1[1]); w.w = cvt_pk_bf16(s1[2], s1[3]);
            *(LAS u32x4*)(Ct + off_b(e, ch)) = w; }
        if (tid < 128) { float s = 0.f; for (int j = 0; j < c; ++j) s += __expf(UR[j] - Pref) * UN[j * 128 + tid]; nC[tid] = s; }
        __syncthreads();
#pragma unroll
        for (int cb = 0; cb < 4; ++cb)
#pragma unroll
            for (int ks = 0; ks < 8; ++ks) { const unsigned ch = (unsigned)(2 * ks + hi) ^ xr;
                const bf16x8 cf = *(const LAS bf16x8*)(Ct + 256u * (32 * cb + r32) + 16u * ch);
                o[cb] = __builtin_amdgcn_mfma_f32_32x32x16_bf16(cf, qf[ks], o[cb], 0, 0, 0); if (ks & 1) __builtin_amdgcn_sched_barrier(0); }
        const float f = __expf(Pref - Aq);
#pragma unroll
        for (int cb = 0; cb < 4; ++cb)
#pragma unroll
            for (int r = 0; r < 16; ++r) o[cb][r] *= f;
        float dq = 0.f;
#pragma unroll
        for (int ks = 0; ks < 8; ++ks)
#pragma unroll
            for (int q = 0; q < 4; ++q) { const unsigned w = ((const unsigned*)&qf[ks])[q]; const int d = 16 * ks + 8 * hi + 2 * q; dq += bf_lo(w) * nC[d] + bf_hi(w) * nC[d + 1]; }
        den = f * dq;
    }
    TileRegs kr = tile_load(Kg, tid), vr = tile_load(Vg, tid);
    tile_write(lds, tid, kr); tile_write(lds + 16384, tid, vr);
    __syncthreads();
    const unsigned q4 = (lane & 15) >> 2, pp = lane & 3, blk = (lane >> 4) & 1;
#pragma unroll 1
    for (int j = 0; j < 4; ++j) {
        const LAS unsigned char* Kt = lds + (j & 1) * 32768; const LAS unsigned char* Vt = Kt + 16384;
        if (j + 1 < 4) { kr = tile_load(Kg + (size_t)(j + 1) * 64 * NP, tid); vr = tile_load(Vg + (size_t)(j + 1) * 64 * NP, tid); }
        if (64 * j <= 32 * wave + 31) {
            f32x16 p0 = (f32x16){}, p1 = (f32x16){};
#pragma unroll
            for (int ks = 0; ks < 8; ++ks) { const unsigned ch = (unsigned)(2 * ks + hi) ^ xr;
                const bf16x8 k0 = *(const LAS bf16x8*)(Kt + 256u * r32 + 16u * ch), k1 = *(const LAS bf16x8*)(Kt + 256u * (32 + r32) + 16u * ch);
                p0 = __builtin_amdgcn_mfma_f32_32x32x16_bf16(k0, qf[ks], p0, 0, 0, 0); p1 = __builtin_amdgcn_mfma_f32_32x32x16_bf16(k1, qf[ks], p1, 0, 0, 0); if (ks & 1) __builtin_amdgcn_sched_barrier(0); }
            float ps = 0.f;
#pragma unroll
            for (int r = 0; r < 16; ++r) { const int kv = 64 * j + crow(r, hi);
                const float w0 = (kv <= qloc) ? __expf(as[kv] - Aq) * 0.08838834764831845f : 0.f, w1 = (kv + 32 <= qloc) ? __expf(as[kv + 32] - Aq) * 0.08838834764831845f : 0.f;
                p0[r] *= w0; p1[r] *= w1; ps += p0[r] + p1[r]; }
            den += ps;
            bf16x8 pf[4];
#pragma unroll
            for (int ks = 0; ks < 4; ++ks) { u32x4 w;
#pragma unroll
                for (int q = 0; q < 4; ++q) { const int r = 8 * (ks & 1) + 2 * q; w[q] = (ks < 2) ? cvt_pk_bf16(p0[r], p0[r + 1]) : cvt_pk_bf16(p1[r], p1[r + 1]); }
                pf[ks] = __builtin_bit_cast(bf16x8, w); }
#pragma unroll
            for (int cb = 0; cb < 4; ++cb)
#pragma unroll
                for (int ks = 0; ks < 4; ++ks) {
                    const unsigned chv = (unsigned)(4 * cb + 2 * blk + (pp >> 1));
                    const unsigned row0 = 16u * ks + 4u * hi + q4, row1 = row0 + 8u;
                    const s16x4 a0 = vtr(Vt + off_b(row0, chv) + 8u * (pp & 1)), a1 = vtr(Vt + off_b(row1, chv) + 8u * (pp & 1));
                    o[cb] = __builtin_amdgcn_mfma_f32_32x32x16_bf16(cat8(a0, a1), pf[ks], o[cb], 0, 0, 0); if (ks & 1) __builtin_amdgcn_sched_barrier(0); }
        }
        if (j + 1 < 4) { LAS unsigned char* nb = lds + ((j + 1) & 1) * 32768; tile_write(nb, tid, kr); tile_write(nb + 16384, tid, vr); }
        __syncthreads();
    }
    den += __shfl_xor(den, 32);
    const float dinv = 1.0f / fmaxf(fabsf(den), __expf(-BAq));
    float s = 0.f;
#pragma unroll
    for (int cb = 0; cb < 4; ++cb)
#pragma unroll
        for (int r = 0; r < 16; ++r) { o[cb][r] *= dinv; s += o[cb][r]; }
    s += __shfl_xor(s, 32);
    const float mu = s * (1.0f / 128.0f);
    float vs = 0.f;
#pragma unroll
    for (int cb = 0; cb < 4; ++cb)
#pragma unroll
        for (int r = 0; r < 16; ++r) { o[cb][r] -= mu; vs += o[cb][r] * o[cb][r]; }
    vs += __shfl_xor(vs, 32);
    const float rstd = 1.0f / sqrtf(vs * (1.0f / 128.0f) + NORM_EPS);
    const float* hn = p.in[9] + hd * 128;
    const bf16_t* mo = P + (t0 + qloc) * NP + P_MO + hd * 128;
    bf16_t* orow = CAT + (t0 + qloc) * D + hd * 128;
#pragma unroll
    for (int cb = 0; cb < 4; ++cb)
#pragma unroll
        for (int rq = 0; rq < 4; ++rq) { const int e0 = 32 * cb + 8 * rq + 4 * hi; const f32x4 hv = *(const f32x4*)(hn + e0); const u32x2 mw = *(const u32x2*)(mo + e0);
            const float g0 = fast_rcp(1.0f + __expf(-bf_lo(mw.x))), g1 = fast_rcp(1.0f + __expf(-bf_hi(mw.x))), g2 = fast_rcp(1.0f + __expf(-bf_lo(mw.y))), g3 = fast_rcp(1.0f + __expf(-bf_hi(mw.y)));
            u32x2 w; w.x = cvt_pk_bf16(o[cb][4 * rq] * rstd * hv[0] * g0, o[cb][4 * rq + 1] * rstd * hv[1] * g1); w.y = cvt_pk_bf16(o[cb][4 * rq + 2] * rstd * hv[2] * g2, o[cb][4 * rq + 3] * rstd * hv[3] * g3);
            *(u32x2*)(orow + e0) = w; __builtin_amdgcn_sched_barrier(0); }
    __syncthreads();
}

__device__ __forceinline__ int moe_table(LAS unsigned char* lds, unsigned* cnt, int tid) {
    LAS int* misc = (LAS int*)(lds + MISC_OFF);
    __syncthreads();
    if (tid == 0) { int acc = 0; for (int e = 0; e < 16; ++e) { const int c = (int)__hip_atomic_load(cnt + e * 64, __ATOMIC_RELAXED, __HIP_MEMORY_SCOPE_AGENT); misc[MW_CN + e] = c; misc[MW_TB + e] = acc; acc += (c + 255) >> 8; } misc[MW_TB + 16] = acc; }
    __syncthreads();
    return misc[MW_TB + 16];
}

#ifndef PHASE_MASK
#define PHASE_MASK 0xffffffffu
#endif
#define PH(k) (((PHASE_MASK) >> (k)) & 1u)
#ifndef PHASE_TWICE
#define PHASE_TWICE 0u
#endif
#define REPS(k) (1 + (int)(((PHASE_TWICE) >> (k)) & 1u))
template <int LAYER>
__device__ __forceinline__ void moe_block(const Params& p, LAS unsigned char* lds, const XcdBarrier& bar, unsigned* ctl, int tid, int wave, int lane, int vcu, int G) {
    unsigned char* ws = p.ws;
    const LAS int* tb = (const LAS int*)(lds + MISC_OFF) + MW_TB; const LAS int* cn = (const LAS int*)(lds + MISC_OFF) + MW_CN;
    unsigned* cnt = ctl + CW_CNT + LAYER * 16 * 64;
    if (PH(12)) phase_rows<1, false>(p, lds, tid, wave, lane, G, p.in[3] + LAYER * D, p.in[18] + (size_t)LAYER * D * 4, p.in[19] + LAYER * 4, p.in[20] + (size_t)LAYER * D * 16, p.in[21] + LAYER * 16, nullptr, cnt);
    xcd_barrier(bar);
    const int ntot = moe_table(lds, cnt, tid);
    for (int rep_ = 0; rep_ < REPS(13); ++rep_) if (PH(13)) { pg8::MoeSched<true> S{(const char*)(ws + WS_XB), (const char*)(ws + WS_WGU) + (size_t)LAYER * 16 * 1024 * 1024 * 2, 1024, (size_t)1024 * 1024 * 2, tb, cn, (const unsigned*)(ws + WS_ROWTOK), ntot, vcu, G};
      pg8::EpiPair<1> E{nullptr, (bf16_t*)(ws + WS_HM), FF, (const float*)(ws + WS_RSTD), (const unsigned*)(ws + WS_ROWTOK), tb, cn};
      pg8::gemm_phase<pg8::EpiPair<1>, pg8::MoeSched<true>, true>(lds, 1024, S, E); }
    xcd_barrier(bar);
    for (int rep_ = 0; rep_ < REPS(14); ++rep_) if (PH(14)) { pg8::MoeSched<false> S{(const char*)(ws + WS_HM), (const char*)(ws + WS_WD) + (size_t)LAYER * 16 * 1024 * 512 * 2, 512, (size_t)1024 * 512 * 2, tb, cn, nullptr, ntot, vcu, G};
      pg8::EpiDown E{(bf16_t*)(ws + WS_YC), (const float*)(ws + WS_CWRAW), tb, cn};
      pg8::gemm_phase<pg8::EpiDown, pg8::MoeSched<false>, false>(lds, 512, S, E); }
    xcd_barrier(bar);
}

__global__ void __launch_bounds__(NTHR, 2) fwd_kernel(Params p) {
    extern __shared__ __attribute__((aligned(16))) unsigned char lds_raw[];
    LAS unsigned char* lds = (LAS unsigned char*)lds_raw;
    const int tid = threadIdx.x, lane = tid & 63, wave = __builtin_amdgcn_readfirstlane(tid >> 6);
    const int G = gridDim.x; const int bx = blockIdx.x;
    const int vcu = (G % 8 == 0) ? (bx % 8) * (G / 8) + bx / 8 : bx;
    const int gw = vcu * NWAVES + wave, NGW = G * NWAVES;
    volatile LAS unsigned* misc = (volatile LAS unsigned*)(lds + MISC_OFF);
    for (int u = tid; u < (LDS_BYTES - MISC_OFF) / 4; u += NTHR) misc[u] = 0u;
    __syncthreads();
    unsigned* ctl = (unsigned*)(p.ws + WS_CTL);
    XcdBarrier bar = xcd_barrier_post(ctl + CW_BAR, misc + MW_BAR);
    unsigned char* ws = p.ws;

    for (int rep_ = 0; rep_ < REPS(0); ++rep_) if (PH(0)) phase_prologue_weights(p, lds, gw, WT_I1, NGW, wave, lane);
    __syncthreads();
    for (int rep_ = 0; rep_ < REPS(1); ++rep_) if (PH(1)) phase_norm_gates(p, lds, tid, gw, NGW, lane);
    xcd_barrier(bar);

    if (PH(2)) phase_gate_scan(p, gw, NGW, lane);
    for (int rep_ = 0; rep_ < REPS(3); ++rep_) if (PH(3)) { pg8::DenseSched S; S.init(ws + WS_H, ws + WS_WT1, T, NP, 1024, G, bx); pg8::EpiBf16 E{(bf16_t*)(ws + WS_P), NP};
      pg8::gemm_phase<pg8::EpiBf16, pg8::DenseSched, false>(lds, 1024, S, E); }
    xcd_barrier(bar);

    {
        constexpr int NS1 = NBATCH * 4 * (NCH - 1), NAT = NBATCH * 4 * 16, NMEM = NS1 + WT_UNITS;
        for (int rep_ = 0; rep_ < REPS(4); ++rep_) {
            bool a_done = false, m_done = false; int sa_cnt = 0, sm_cnt = 0; (void)sa_cnt; (void)sm_cnt;
            for (int it = 0; !(a_done && m_done); ++it) {
                const int r5 = it % 5; bool want_mem = (r5 == 1 || r5 == 3);
                if (want_mem && m_done) want_mem = false; else if (!want_mem && a_done) want_mem = true;
                __syncthreads();
#ifdef STATIC_Q
                if (tid == 0) { misc[MW_Q] = (unsigned)((want_mem ? sm_cnt : sa_cnt) * G + bx); }
                if (want_mem) ++sm_cnt; else ++sa_cnt;
#else
                if (tid == 0) misc[MW_Q] = __hip_atomic_fetch_add(ctl + CW_QUEUE + 64 * (2 * rep_ + (want_mem ? 1 : 0)), 1u, __ATOMIC_RELAXED, __HIP_MEMORY_SCOPE_AGENT);
#endif
                __syncthreads();
                const int u = (int)misc[MW_Q];
                if (want_mem) {
                    if (u >= NMEM) { m_done = true; continue; }
                    if (u < WT_UNITS) { for (int r2 = 0; r2 < REPS(18); ++r2) if (PH(0)) { const int f = WT_I1 + 64 * u + 8 * wave; phase_prologue_weights(p, lds, f, f + 8, 1, wave, lane); } }
                    else { const int v = u - WT_UNITS; for (int r2 = 0; r2 < REPS(16); ++r2) if (PH(4)) mlstm_s1_unit(p, lds, v / (NCH - 1), v % (NCH - 1), tid, wave, lane); }
                } else {
                    if (u >= NAT) { a_done = true; continue; }
                    for (int r2 = 0; r2 < REPS(17); ++r2) if (PH(5)) attn_unit(p, lds, u & 127, 15 - (u >> 7), tid, wave, lane);
                }
            }
        }
    }
    xcd_barrier(bar);
    for (int rep_ = 0; rep_ < REPS(6); ++rep_) if (PH(6)) for (int u = vcu; u < NBATCH * 4 * NCH; u += G) mlstm_s3_unit(p, lds, u >> 3, u & 7, tid, wave, lane);
    xcd_barrier(bar);

    for (int rep_ = 0; rep_ < REPS(7); ++rep_) if (PH(7)) { pg8::DenseSched S; S.init(ws + WS_CAT, ws + WS_WT2, T, 1024, 1024, G, bx); pg8::EpiResid<true> E{p.in[0], (bf16_t*)(ws + WS_XB)};
      pg8::gemm_phase<pg8::EpiResid<true>, pg8::DenseSched, false>(lds, 1024, S, E); }
    xcd_barrier(bar);

    moe_block<0>(p, lds, bar, ctl, tid, wave, lane, vcu, G);
    if (PH(8)) phase_rows<0, true>(p, lds, tid, wave, lane, G, p.in[2] + D, nullptr, nullptr, nullptr, nullptr, ctl + CW_CNT, nullptr);
    xcd_barrier(bar);
    for (int rep_ = 0; rep_ < REPS(9); ++rep_) if (PH(9)) { pg8::DenseSched S; S.init(ws + WS_XB, ws + WS_WT3, T, 3072, 1024, G, bx); pg8::EpiPair<0> E{(bf16_t*)(ws + WS_BG), (bf16_t*)(ws + WS_Z), D, (const float*)(ws + WS_RSTD), nullptr, nullptr, nullptr};
      pg8::gemm_phase<pg8::EpiPair<0>, pg8::DenseSched, false>(lds, 1024, S, E); }
    xcd_barrier(bar);
    for (int rep_ = 0; rep_ < REPS(10); ++rep_) if (PH(10)) phase_conv(p, gw, NGW, lane);
    xcd_barrier(bar);
    if (PH(11)) { pg8::DenseSched S; S.init(ws + WS_CAT, ws + WS_WT4, T, 1024, 1024, G, bx); pg8::EpiResid<false> E{nullptr, (bf16_t*)(ws + WS_XB)};
      pg8::gemm_phase<pg8::EpiResid<false>, pg8::DenseSched, false>(lds, 1024, S, E); }
    xcd_barrier(bar);
    moe_block<1>(p, lds, bar, ctl, tid, wave, lane, vcu, G);
    if (PH(15)) phase_rows<2, true>(p, lds, tid, wave, lane, G, p.in[4], nullptr, nullptr, nullptr, nullptr, ctl + CW_CNT + 16 * 64, nullptr);
}

extern "C" void kernel_launch(void* const* d_in, const int* in_sizes, int n_in, void* d_out, int out_size, void* d_ws, size_t ws_size, hipStream_t stream) {
    static int grid = 0;
    if (grid == 0) {
        if (n_in != 25 || in_sizes[0] != T * D || out_size != T * D || ws_size < WS_END) { fprintf(stderr, "kernel_launch: unexpected shapes (n_in %d, in0 %d, out %d, ws %zu)\n", n_in, n_in > 0 ? in_sizes[0] : -1, out_size, ws_size); grid = -1; return; }
        int dev = 0, cus = 0, per_cu = 0;
        if (hipGetDevice(&dev) != hipSuccess || hipDeviceGetAttribute(&cus, hipDeviceAttributeMultiprocessorCount, dev) != hipSuccess) { grid = -1; return; }
        if (hipFuncSetAttribute((const void*)fwd_kernel, hipFuncAttributeMaxDynamicSharedMemorySize, LDS_BYTES) != hipSuccess) { fprintf(stderr, "kernel_launch: hipFuncSetAttribute failed\n"); grid = -1; return; }
        if (hipOccupancyMaxActiveBlocksPerMultiprocessor(&per_cu, (const void*)fwd_kernel, NTHR, LDS_BYTES) != hipSuccess || per_cu < 1) fprintf(stderr, "kernel_launch: occupancy query reports %d\n", per_cu);
        (void)hipGetLastError();
        grid = cus;
    }
    if (grid < 0) return;
    hipMemsetAsync((char*)d_ws + WS_CTL, 0, CTL_ZERO_BYTES, stream);
    Params p{};
    for (int i = 0; i < 25; ++i) p.in[i] = (const float*)d_in[i];
    p.out = (float*)d_out; p.ws = (unsigned char*)d_ws;
    hipLaunchKernelGGL(fwd_kernel, dim3(grid), dim3(NTHR), LDS_BYTES, stream, p);
}
```

```cpp
#include <hip/hip_runtime.h>
#include <cstdio>
#include <cstdint>
#ifndef PHASE_MASK
#define PHASE_MASK 0xffffffffu
#endif
#define PH(k) (((PHASE_MASK) >> (k)) & 1u)
#ifndef PHASE_TWICE
#define PHASE_TWICE 0u
#endif
#define REPS(k) (1 + (int)(((PHASE_TWICE) >> (k)) & 1u))

#define LAS __attribute__((address_space(3)))
#define GAS __attribute__((address_space(1)))
typedef unsigned short bf16_t;
typedef short bf16x8 __attribute__((ext_vector_type(8)));
typedef short s16x4 __attribute__((ext_vector_type(4)));
typedef float f32x4 __attribute__((ext_vector_type(4)));
typedef float f32x2 __attribute__((ext_vector_type(2)));
typedef float f32x16 __attribute__((ext_vector_type(16)));
typedef unsigned u32x4 __attribute__((ext_vector_type(4)));
typedef unsigned u32x2 __attribute__((ext_vector_type(2)));
typedef GAS unsigned gu32;
typedef int i32x8 __attribute__((ext_vector_type(8)));
typedef int i32x4 __attribute__((ext_vector_type(4)));

constexpr int D = 1024, NBATCH = 32, SEQ = 2048, T = NBATCH * SEQ;
constexpr int EVEN_IN = 3592, NP = 3584;
constexpr int P_MQ = 0, P_MK = 512, P_MV = 1024, P_MO = 1536, P_DQ = 2048, P_DK = 2560, P_DV = 3072;
constexpr int NE = 16, FF = 512;
constexpr int ECAP = 65536;
constexpr float NORM_EPS = 1e-6f;
constexpr int NWAVES = 8, NTHR = 512;
constexpr int MCH = 256, NCH = SEQ / MCH;
constexpr int WT_I1 = 16 * 112, WT_ITEMS = 28928, WT_UNITS = (WT_ITEMS - WT_I1) / 64;

constexpr size_t MiB = 1u << 20;
constexpr size_t WS_CTL = 0, CTL_ZERO_BYTES = 1 * MiB;
constexpr size_t WS_WT1 = 1 * MiB, WS_WT2 = 8 * MiB, WS_WT3 = 10 * MiB, WS_WT4 = 16 * MiB, WS_WGU = 18 * MiB, WS_WD = 82 * MiB;
constexpr size_t WS_GATES = 114 * MiB, WS_SA = 116 * MiB, WS_SAM = 117 * MiB, WS_SBA = 118 * MiB, WS_UN = 119 * MiB, WS_UR = 119 * MiB + 768 * 1024;
constexpr size_t WS_UT = 120 * MiB;
constexpr size_t WS_ROWTOK = 184 * MiB, WS_CWRAW = 188 * MiB, WS_TOKINFO = 192 * MiB, WS_RSTD = 193 * MiB;
constexpr size_t WS_H = 194 * MiB, WS_CAT = 322 * MiB, WS_P = 450 * MiB;
constexpr size_t WS_RSRAW = 120 * MiB;
constexpr size_t WS_XB8 = 720 * MiB;
constexpr size_t WS_XB = WS_H;
constexpr size_t WS_BG = WS_P, WS_Z = WS_P + 128 * MiB, WS_HM = WS_P, WS_YC = WS_P + 136 * MiB;
constexpr size_t WS_END = 898 * MiB;
constexpr int CW_BAR = 4096;
constexpr int CW_CNT = 16384;
constexpr int CW_QUEUE = 32768;

__device__ __forceinline__ unsigned cvt_pk_bf16(float lo, float hi) { unsigned r; asm volatile("v_cvt_pk_bf16_f32 %0, %1, %2" : "=v"(r) : "v"(lo), "v"(hi)); return r; }
__device__ __forceinline__ unsigned cvt_pk4_fp8(float a, float b, float c, float d) { unsigned w = 0; w = (unsigned)__builtin_amdgcn_cvt_pk_fp8_f32(a, b, (int)w, false); w = (unsigned)__builtin_amdgcn_cvt_pk_fp8_f32(c, d, (int)w, true); return w; }
#ifndef G3_F8
#define G3_F8 1
#endif
constexpr float F8_WSCALE = 64.0f, F8_HSCALE = 16.0f, F8_YSCALE = 64.0f;
__device__ __forceinline__ float bf_lo(unsigned w) { return __uint_as_float(w << 16); }
__device__ __forceinline__ float bf_hi(unsigned w) { return __uint_as_float(w & 0xffff0000u); }
__device__ __forceinline__ float wave_sum(float v) {
#pragma unroll
    for (int o = 1; o < 64; o <<= 1) v += __shfl_xor(v, o);
    return v;
}
__device__ __forceinline__ float fast_exp2(float x) { return __builtin_amdgcn_exp2f(x); }
__device__ __forceinline__ float fast_rcp(float x) { return __builtin_amdgcn_rcpf(x); }
__device__ __forceinline__ int crow(int r, int hi) { return (r & 3) + 8 * (r >> 2) + 4 * hi; }
__device__ __forceinline__ unsigned off_b(unsigned row, unsigned ch) { return 256u * row + 16u * (ch ^ (((row & 3u) << 2) | ((row >> 2) & 3u))); }
__device__ __forceinline__ s16x4 vtr(const LAS unsigned char* p) { return __builtin_bit_cast(s16x4, __builtin_amdgcn_ds_read_tr16_b64_v4i16((LAS s16x4*)p)); }
__device__ __forceinline__ bf16x8 cat8(s16x4 a, s16x4 b) { return (bf16x8){a[0], a[1], a[2], a[3], b[0], b[1], b[2], b[3]}; }

#define XB_TMO      128
#define XB_XCNT(j)  (256  + 64 * (j))
#define XB_XSUB(j)  (1280 + 64 * (j))
#define XB_XGEN(j)  (2304 + 64 * (j))
#define XB_TOP      3328
#define XB_TOPGEN   3392
#define XCD_BAR_WORDS 3456
#define XB_SPIN_CAP (1u << 18)
__device__ __forceinline__ unsigned xb_ld(unsigned* p)              { return __hip_atomic_load(p, __ATOMIC_RELAXED, __HIP_MEMORY_SCOPE_AGENT); }
__device__ __forceinline__ unsigned xb_add(unsigned* p, unsigned v) { return __hip_atomic_fetch_add(p, v, __ATOMIC_RELAXED, __HIP_MEMORY_SCOPE_AGENT); }
__device__ __forceinline__ unsigned xb_xcc_id() { return (unsigned)__builtin_amdgcn_s_getreg((3 << 11) | 20) & 0xFu; }
#define XB_SPIN(cond, bar) do { unsigned _sp = 0; while (cond) { __builtin_amdgcn_s_sleep(1); \
    if ((++_sp & 255u) == 0u) { if (xb_ld(&(bar)[XB_TMO])) break; if (_sp > XB_SPIN_CAP) { atomicAdd(&(bar)[XB_TMO], 1u); break; } } } } while (0)
struct XcdBarrier { unsigned* bar; unsigned x; volatile LAS unsigned* st; };
__device__ __forceinline__ XcdBarrier xcd_barrier_post(unsigned* bar, volatile LAS unsigned* st) {
    XcdBarrier b; b.bar = bar; b.x = xb_xcc_id(); b.st = st;
    if (threadIdx.x == 0) (void)xb_add(&bar[XB_XCNT(b.x)], 1u);
    return b;
}
__device__ __forceinline__ void xcd_barrier_complete(unsigned* bar, unsigned x, unsigned& nloc, unsigned& nx) {
    const unsigned G = gridDim.x * gridDim.y * gridDim.z;
    unsigned sum, cnt, mine, sp = 0u;
    for (;;) {
        sum = 0u; cnt = 0u; mine = 0u;
#pragma unroll
        for (unsigned j = 0; j < 16; ++j) { const unsigned c = xb_ld(&bar[XB_XCNT(j)]); sum += c; cnt += (c > 0u) ? 1u : 0u; mine = (j == x) ? c : mine; }
        if (sum == G) break;
        __builtin_amdgcn_s_sleep(1);
        if ((++sp & 255u) == 0u) { if (xb_ld(&bar[XB_TMO])) break; if (sp > XB_SPIN_CAP) { atomicAdd(&bar[XB_TMO], 1u); break; } }
    }
    nloc = mine > 0u ? mine : 1u; nx = cnt > 0u ? cnt : 1u;
}
__device__ __forceinline__ void xcd_barrier(const XcdBarrier& b) {
    asm volatile("s_waitcnt vmcnt(0)" ::: "memory");
    __syncthreads();
    if (threadIdx.x == 0) {
        unsigned* bar = b.bar;
        __builtin_amdgcn_s_waitcnt(0);
        unsigned nloc = b.st[0], nx = b.st[1];
        if (nloc == 0u) { xcd_barrier_complete(bar, b.x, nloc, nx); b.st[0] = nloc; b.st[1] = nx; }
        const unsigned old = xb_add(&bar[XB_XSUB(b.x)], 1u);
        const unsigned gen = old / nloc;
        if (old + 1u == (gen + 1u) * nloc) {
            __builtin_amdgcn_fence(__ATOMIC_RELEASE, "agent");
            asm volatile("s_waitcnt vmcnt(0)" ::: "memory");
            const unsigned og = xb_add(&bar[XB_TOP], 1u);
            const unsigned tg = og / nx;
            if (og + 1u == (tg + 1u) * nx) xb_add(&bar[XB_TOPGEN], 1u);
            else XB_SPIN(xb_ld(&bar[XB_TOPGEN]) == tg, bar);
            __builtin_amdgcn_fence(__ATOMIC_ACQUIRE, "agent");
            xb_add(&bar[XB_XGEN(b.x)], 1u);
            asm volatile("s_waitcnt vmcnt(0)" ::: "memory");
        } else {
            XB_SPIN(xb_ld(&bar[XB_XGEN(b.x)]) == gen, bar);
            __builtin_amdgcn_fence(__ATOMIC_ACQUIRE, "agent");
            asm volatile("s_waitcnt vmcnt(0)" ::: "memory");
        }
    }
    __syncthreads();
}

namespace pg8 {
constexpr int BM = 256, BK = 64, HALF = 128, HTB = HALF * BK * 2, STAGE_BYTES = 8 * HTB, NXCD = 8, WGM = 8;
__device__ __forceinline__ int lds_byte(int r, int c) { const int st = (r >> 4) * 2 + (c >> 5), rr = r & 15, cc = c & 31, ob = rr * 64 + cc * 2; return st * 1024 + (ob ^ (((ob >> 9) & 1) << 5)); }
__device__ __forceinline__ void stage_rc(int b, int& R, int& C) { const int st = b / 1024, sb = b % 1024, swz = sb ^ (((sb >> 9) & 1) << 5); R = (st >> 1) * 16 + swz / 64; C = (st & 1) * 32 + (swz % 64) / 2; }
__device__ __forceinline__ int perm32(int rho) { const int n = rho >> 4, i = rho & 15; return 8 * (i >> 2) + 4 * n + (i & 3); }
struct Unit { int pm, pn; };

template <class Epi, class Sched, bool GATHER, bool F8 = false>
__device__ __forceinline__ void gemm_phase(LAS unsigned char* lds, const int K, const Sched& S, const Epi& E) {
    int tid = threadIdx.x; asm volatile("" : "+v"(tid));
    const int wid = __builtin_amdgcn_readfirstlane(tid >> 6), lane = tid & 63, wr = wid >> 2, wc = wid & 3, fr = lane & 15, fq = lane >> 4;
    const int nt = K / BK;
    int Rr[2], Cc[2]; unsigned voffB[2];
#pragma unroll
    for (int i = 0; i < 2; ++i) { stage_rc(tid * 16 + i * 8192, Rr[i], Cc[i]); const int Rb = Epi::PERM ? ((Rr[i] & ~31) + perm32(Rr[i] & 31)) : Rr[i];
        voffB[i] = (unsigned)(Rb * K + Cc[i]) * 2u; }
    const size_t kstep = (size_t)(BK * 2);
    const size_t hstep = (size_t)HALF * K * 2;
    const unsigned ldsw = (unsigned)wid * 1024u;
    const int aoff = lds_byte(wr * 64 + fr, fq * 8), boff = lds_byte(wc * 32 + fr, fq * 8);
#define PG8_SA(b, h) (((b) * 2 + (h)) * HTB)
#define PG8_SB(b, h) ((4 + (b) * 2 + (h)) * HTB)
#define PG8_STAGE(bufoff, gbase, voff) do { _Pragma("unroll") for (int _i = 0; _i < 2; ++_i) \
        __builtin_amdgcn_global_load_lds((const unsigned*)((const char*)(gbase) + (voff)[_i]), (LAS unsigned*)(lds + (bufoff) + ldsw + _i * 8192), 16, 0, 0); } while (0)
#define PG8_LD8(p) __builtin_shufflevector(*(const LAS i32x4*)(p), *(const LAS i32x4*)((p) + 1024), 0, 1, 2, 3, 4, 5, 6, 7)
#define PG8_LDA(dst, b, h) do { if constexpr (F8) { _Pragma("unroll") for (int m = 0; m < 4; ++m) dst##8[m] = PG8_LD8(lds + PG8_SA(b, h) + aoff + m * 2048); } \
        else { _Pragma("unroll") for (int m = 0; m < 4; ++m) _Pragma("unroll") for (int k = 0; k < 2; ++k) dst[m][k] = *(const LAS bf16x8*)(lds + PG8_SA(b, h) + aoff + m * 2048 + k * 1024); } } while (0)
#define PG8_LDB(dst, b, h) do { if constexpr (F8) { _Pragma("unroll") for (int n = 0; n < 2; ++n) dst##8[n] = PG8_LD8(lds + PG8_SB(b, h) + boff + n * 2048); } \
        else { _Pragma("unroll") for (int n = 0; n < 2; ++n) _Pragma("unroll") for (int k = 0; k < 2; ++k) dst[n][k] = *(const LAS bf16x8*)(lds + PG8_SB(b, h) + boff + n * 2048 + k * 1024); } } while (0)
#define PG8_CAT8(x0, x1) __builtin_shufflevector(__builtin_bit_cast(i32x4, x0), __builtin_bit_cast(i32x4, x1), 0, 1, 2, 3, 4, 5, 6, 7)
#define PG8_MMA(ai, bj, At, Bt) do { __builtin_amdgcn_s_setprio(1); _Pragma("unroll") for (int m = 0; m < 4; ++m) _Pragma("unroll") for (int n = 0; n < 2; ++n) { \
        if constexpr (F8) asm volatile("v_mfma_scale_f32_16x16x128_f8f6f4 %0, %1, %2, %0, %3, %3 op_sel_hi:[0,0,0]" : "+v"(acc[ai][bj][m][n]) : "v"(Bt##8[n]), "v"(At##8[m]), "v"(f8one)); \
        else { _Pragma("unroll") for (int k = 0; k < 2; ++k) acc[ai][bj][m][n] = __builtin_amdgcn_mfma_f32_16x16x32_bf16(Bt[n][k], At[m][k], acc[ai][bj][m][n], 0, 0, 0); } } __builtin_amdgcn_s_setprio(0); } while (0)
#define PG8_WAIT_V(n) asm volatile("s_waitcnt vmcnt(" #n ")" ::: "memory")
#define PG8_WAIT_L(n) asm volatile("s_waitcnt lgkmcnt(" #n ")" ::: "memory")
#define PG8_BAR __builtin_amdgcn_s_barrier()
#define PG8_SCHED __builtin_amdgcn_sched_barrier(0)
#define PG8_VOFF(dst, u) do { _Pragma("unroll") for (int _h = 0; _h < 2; ++_h) _Pragma("unroll") for (int _i = 0; _i < 2; ++_i) { \
        if constexpr (GATHER) dst[_h][_i] = S.arow(u, _h * HALF + Rr[_i]) * (unsigned)(K * 2) + (unsigned)(Cc[_i] * 2); \
        else dst[_h][_i] = (unsigned)((_h * HALF + Rr[_i]) * K + Cc[_i]) * 2u; } } while (0)
    Unit cur, nxt; int ui = 0;
    if (!S.next(0, cur)) return;
    f32x4 acc[2][2][4][2];
    if constexpr (Epi::PRELOAD) E.preload(acc, cur, wr, wc, fr, fq);
    else {
#pragma unroll
    for (int a = 0; a < 2; ++a)
#pragma unroll
        for (int b = 0; b < 2; ++b)
#pragma unroll
            for (int m = 0; m < 4; ++m)
#pragma unroll
                for (int n = 0; n < 2; ++n) acc[a][b][m][n] = (f32x4){0.f, 0.f, 0.f, 0.f};
    }
    float epf[2][4] = {{0.f, 0.f, 0.f, 0.f}, {0.f, 0.f, 0.f, 0.f}};
    bf16x8 At[4][2], B0[2][2], B1[2][2];
    i32x8 At8[4], B08[2], B18[2]; const unsigned f8one = 0x7f7f7f7fu;
    unsigned vA[2][2], vN[2][2];
    PG8_VOFF(vA, cur);
    if constexpr (Epi::PREFETCH) E.prefetch(epf, cur, wr, fr);
    const char* cA = S.abase(cur); const char* cB = S.bbase(cur);
    PG8_STAGE(PG8_SB(0, 0), cB, voffB); PG8_STAGE(PG8_SB(0, 1), cB + hstep, voffB); PG8_STAGE(PG8_SA(0, 0), cA, vA[0]); PG8_STAGE(PG8_SA(0, 1), cA, vA[1]);
    if (wr == 1) PG8_BAR;
    PG8_WAIT_V(2); PG8_BAR;
    PG8_STAGE(PG8_SB(1, 0), cB + kstep, voffB); PG8_STAGE(PG8_SA(1, 0), cA + kstep, vA[0]); PG8_STAGE(PG8_SB(1, 1), cB + hstep + kstep, voffB);
    PG8_WAIT_V(6); PG8_BAR;
    for (;;) {
        const bool has_next = S.next(ui + 1, nxt);
        const char* nA = has_next ? S.abase(nxt) : cA; const char* nB = has_next ? S.bbase(nxt) : cB;
        if constexpr (GATHER) { if (has_next) { PG8_VOFF(vN, nxt); } else {
#pragma unroll
            for (int h = 0; h < 2; ++h)
#pragma unroll
                for (int i = 0; i < 2; ++i) vN[h][i] = vA[h][i]; } }
#pragma unroll 1
        for (int t = 0; t < nt; t += 2) {
            const bool last = (t == nt - 2);
            const char* a1 = cA + (size_t)(t + 1) * kstep;
            const char* a2 = last ? nA : cA + (size_t)(t + 2) * kstep; const char* b2 = last ? nB : cB + (size_t)(t + 2) * kstep;
            const char* a3 = a2 + kstep; const char* b3 = b2 + kstep;
            unsigned v2[2][2]; const unsigned lmask = last ? 0xffffffffu : 0u;
#pragma unroll
            for (int h = 0; h < 2; ++h)
#pragma unroll
                for (int i = 0; i < 2; ++i) { if constexpr (GATHER) v2[h][i] = (vN[h][i] & lmask) | (vA[h][i] & ~lmask); else v2[h][i] = vA[h][i]; }
            PG8_LDB(B0, 0, 0); PG8_LDB(B1, 0, 1); PG8_SCHED; PG8_LDA(At, 0, 0); PG8_STAGE(PG8_SA(1, 1), a1, vA[1]);
            PG8_WAIT_V(8); PG8_WAIT_L(0); PG8_BAR; PG8_MMA(0, 0, At, B0); PG8_MMA(0, 1, At, B1); PG8_BAR; PG8_SCHED;
            PG8_LDA(At, 0, 1); PG8_STAGE(PG8_SB(0, 0), b2, voffB); PG8_STAGE(PG8_SB(0, 1), b2 + hstep, voffB); PG8_STAGE(PG8_SA(0, 0), a2, v2[0]);
            PG8_WAIT_V(8); PG8_WAIT_L(0); PG8_BAR; PG8_MMA(1, 0, At, B0); PG8_MMA(1, 1, At, B1); PG8_BAR; PG8_SCHED;
            PG8_LDB(B0, 1, 0); PG8_LDB(B1, 1, 1); PG8_SCHED; PG8_LDA(At, 1, 0); PG8_STAGE(PG8_SA(0, 1), a2, v2[1]);
            PG8_WAIT_V(8); PG8_WAIT_L(0); PG8_BAR; PG8_MMA(0, 0, At, B0); PG8_MMA(0, 1, At, B1); PG8_BAR; PG8_SCHED;
            PG8_LDA(At, 1, 1); PG8_STAGE(PG8_SB(1, 0), b3, voffB); PG8_STAGE(PG8_SB(1, 1), b3 + hstep, voffB); PG8_STAGE(PG8_SA(1, 0), a3, v2[0]);
            PG8_WAIT_V(8); PG8_WAIT_L(0); PG8_BAR; PG8_MMA(1, 0, At, B0); PG8_MMA(1, 1, At, B1); PG8_BAR; PG8_SCHED;
        }
        if (wr == 0) PG8_BAR;
        if constexpr (F8) asm volatile("s_nop 15\n\ts_nop 15" ::: "memory");
        if constexpr (Epi::PREFETCH) E(acc, cur, wr, wc, fr, fq, epf); else E(acc, cur, wr, wc, fr, fq);
        if (!has_next) break;
        if constexpr (Epi::PREFETCH) E.prefetch(epf, nxt, wr, fr);
        if constexpr (Epi::PRELOAD) E.preload(acc, nxt, wr, wc, fr, fq);
        else {
#pragma unroll
        for (int a = 0; a < 2; ++a)
#pragma unroll
            for (int b = 0; b < 2; ++b)
#pragma unroll
                for (int m = 0; m < 4; ++m)
#pragma unroll
                    for (int n = 0; n < 2; ++n) acc[a][b][m][n] = (f32x4){0.f, 0.f, 0.f, 0.f};
        }
        cur = nxt; cA = nA; cB = nB; ++ui;
        if constexpr (GATHER) {
#pragma unroll
        for (int h = 0; h < 2; ++h)
#pragma unroll
            for (int i = 0; i < 2; ++i) vA[h][i] = vN[h][i]; }
        if (wr == 1) PG8_BAR;
    }
    PG8_WAIT_V(0);
    PG8_BAR;
#undef PG8_SA
#undef PG8_SB
#undef PG8_STAGE
#undef PG8_LDA
#undef PG8_LD8
#undef PG8_LDB
#undef PG8_MMA
#undef PG8_CAT8
#undef PG8_WAIT_V
#undef PG8_WAIT_L
#undef PG8_BAR
#undef PG8_SCHED
#undef PG8_VOFF
}

struct DenseSched {
    const char* A; const char* Bt; int K; int nM, nN, nwg, G, c;
    __device__ __forceinline__ void init(const void* A_, const void* Bt_, int M, int N, int K_, int G_, int c_) { A = (const char*)A_; Bt = (const char*)Bt_; K = K_; nM = M / BM; nN = N / BM; nwg = nM * nN; G = G_; c = c_; }
    __device__ __forceinline__ bool next(int i, Unit& u) const {
        const long L = (long)i * G + c; if (L >= nwg) return false;
        int wgid = (int)L; { const int q = nwg / NXCD, r = nwg % NXCD, xcd = wgid % NXCD, off = wgid / NXCD; wgid = (xcd < r ? xcd * (q + 1) : r * (q + 1) + (xcd - r) * q) + off; }
        const int nig = WGM * nN, gid = wgid / nig, fm = gid * WGM, gsz = (nM - fm) < WGM ? (nM - fm) : WGM;
        u.pm = fm + ((wgid % nig) % gsz); u.pn = (wgid % nig) / gsz; return true;
    }
    __device__ __forceinline__ const char* abase(const Unit& u) const { return A + (size_t)u.pm * BM * K * 2; }
    __device__ __forceinline__ const char* bbase(const Unit& u) const { return Bt + (size_t)u.pn * BM * K * 2; }
    __device__ __forceinline__ unsigned arow(const Unit&, int) const { return 0u; }
};
template <bool GATHER_A>
struct MoeSched {
    const char* A; const char* W; int K; size_t wstride; const LAS int* tb; const LAS int* cn; const unsigned* rowtok; int ntot, vcu, G;
    __device__ __forceinline__ bool next(int i, Unit& u) const { const int L = i * G + vcu; if (L >= ntot * 4) return false; u.pm = L >> 2; u.pn = L & 3; return true; }
    __device__ __forceinline__ int expert(int pm) const { int e = 0;
#pragma unroll
        for (int j = 1; j < 16; ++j) e += (pm >= tb[j]) ? 1 : 0; return e; }
    __device__ __forceinline__ const char* abase(const Unit& u) const { return GATHER_A ? A : A + (size_t)u.pm * BM * K * 2; }
    __device__ __forceinline__ const char* bbase(const Unit& u) const { return W + (size_t)expert(u.pm) * wstride + (size_t)u.pn * BM * K * 2; }
    __device__ __forceinline__ unsigned arow(const Unit& u, int r) const { const int e = expert(u.pm); const int idx = (u.pm - tb[e]) * BM + r; return idx < cn[e] ? rowtok[(size_t)e * ECAP + idx] : 0u; }
};

struct EpiBf16 {
    static constexpr bool PERM = true, PRELOAD = false, PREFETCH = false;
    bf16_t* O; int ldc;
    __device__ __forceinline__ void operator()(const f32x4 (&acc)[2][2][4][2], const Unit& u, int wr, int wc, int fr, int fq) const {
        const int row0 = u.pm * BM + wr * 64 + fr, col0 = u.pn * BM + wc * 32 + 8 * fq;
#pragma unroll
        for (int ai = 0; ai < 2; ++ai)
#pragma unroll
            for (int m = 0; m < 4; ++m) { bf16_t* rowp = O + (size_t)(row0 + ai * HALF + m * 16) * ldc + col0;
#pragma unroll
                for (int bj = 0; bj < 2; ++bj) { const f32x4 v0 = acc[ai][bj][m][0], v1 = acc[ai][bj][m][1];
                    u32x4 w; w.x = cvt_pk_bf16(v0[0], v0[1]); w.y = cvt_pk_bf16(v0[2], v0[3]); w.z = cvt_pk_bf16(v1[0], v1[1]); w.w = cvt_pk_bf16(v1[2], v1[3]);
#ifdef EPI_NT
                    __builtin_nontemporal_store(w, (u32x4*)(rowp + bj * HALF));
#else
                    *(u32x4*)(rowp + bj * HALF) = w;
#endif
                } }
    }
};
template <bool XF32>
struct EpiResid {
    static constexpr bool PERM = true, PRELOAD = true, PREFETCH = false;
    const float* xin; bf16_t* XB; unsigned char* XB8;
    __device__ __forceinline__ void preload(f32x4 (&acc)[2][2][4][2], const Unit& u, int wr, int wc, int fr, int fq) const {
        const int row0 = u.pm * BM + wr * 64 + fr, col0 = u.pn * BM + wc * 32 + 8 * fq;
#pragma unroll
        for (int ai = 0; ai < 2; ++ai)
#pragma unroll
            for (int m = 0; m < 4; ++m) { const size_t off = (size_t)(row0 + ai * HALF + m * 16) * D + col0;
#pragma unroll
                for (int bj = 0; bj < 2; ++bj) {
                    if (XF32) { acc[ai][bj][m][0] = *(const f32x4*)(xin + off + bj * HALF); acc[ai][bj][m][1] = *(const f32x4*)(xin + off + bj * HALF + 4); }
                    else { const u32x4 w = *(const u32x4*)(XB + off + bj * HALF); acc[ai][bj][m][0] = (f32x4){bf_lo(w.x), bf_hi(w.x), bf_lo(w.y), bf_hi(w.y)}; acc[ai][bj][m][1] = (f32x4){bf_lo(w.z), bf_hi(w.z), bf_lo(w.w), bf_hi(w.w)}; } } }
    }
    __device__ __forceinline__ void operator()(const f32x4 (&acc)[2][2][4][2], const Unit& u, int wr, int wc, int fr, int fq) const {
        const int row0 = u.pm * BM + wr * 64 + fr, col0 = u.pn * BM + wc * 32 + 8 * fq;
#pragma unroll
        for (int ai = 0; ai < 2; ++ai)
#pragma unroll
            for (int m = 0; m < 4; ++m) { bf16_t* rowp = XB + (size_t)(row0 + ai * HALF + m * 16) * D + col0;
#pragma unroll
                for (int bj = 0; bj < 2; ++bj) { const f32x4 v0 = acc[ai][bj][m][0], v1 = acc[ai][bj][m][1];
                    u32x4 w; w.x = cvt_pk_bf16(v0[0], v0[1]); w.y = cvt_pk_bf16(v0[2], v0[3]); w.z = cvt_pk_bf16(v1[0], v1[1]); w.w = cvt_pk_bf16(v1[2], v1[3]);
                    *(u32x4*)(rowp + bj * HALF) = w;
                    u32x2 w8; w8.x = cvt_pk4_fp8(bf_lo(w.x), bf_hi(w.x), bf_lo(w.y), bf_hi(w.y)); w8.y = cvt_pk4_fp8(bf_lo(w.z), bf_hi(w.z), bf_lo(w.w), bf_hi(w.w));
                    *(u32x2*)(XB8 + (size_t)(row0 + ai * HALF + m * 16) * D + col0 + bj * HALF) = w8; } }
    }
};
template <int MODE  >
struct EpiPair {
    static constexpr bool PERM = true, PRELOAD = false, PREFETCH = true;
    bf16_t* O0; bf16_t* O1; int ld1;
    const float* rstd; const unsigned* rowtok; const LAS int* tb; const LAS int* cn;
    __device__ __forceinline__ void prefetch(float (&rs)[2][4], const Unit& u, int wr, int fr) const {
        const int row0 = u.pm * BM + wr * 64 + fr;
        if (MODE == 0) {
#pragma unroll
            for (int ai = 0; ai < 2; ++ai)
#pragma unroll
                for (int m = 0; m < 4; ++m) rs[ai][m] = rstd[row0 + ai * HALF + m * 16] * (G3_F8 ? 1.0f / F8_WSCALE : 1.0f);
        } else {
            int e = 0;
#pragma unroll
            for (int j = 1; j < 16; ++j) e += (u.pm >= tb[j]) ? 1 : 0;
            const int idx0 = (u.pm - tb[e]) * BM + wr * 64 + fr, cne = cn[e];
#pragma unroll
            for (int ai = 0; ai < 2; ++ai)
#pragma unroll
                for (int m = 0; m < 4; ++m) { const int idx = idx0 + ai * HALF + m * 16; rs[ai][m] = idx < cne ? rstd[(size_t)e * ECAP + idx] * (1.0f / F8_WSCALE) : 0.f; }
        }
    }
    __device__ __forceinline__ void operator()(const f32x4 (&acc)[2][2][4][2], const Unit& u, int wr, int wc, int fr, int fq, const float (&rs)[2][4]) const {
        const int row0 = u.pm * BM + wr * 64 + fr;
        if (MODE == 0 && u.pn < 4) {
            const int col0 = u.pn * BM + wc * 32 + 8 * fq;
#pragma unroll
            for (int ai = 0; ai < 2; ++ai)
#pragma unroll
                for (int m = 0; m < 4; ++m) { bf16_t* rowp = O0 + (size_t)(row0 + ai * HALF + m * 16) * D + col0;
#pragma unroll
                    for (int bj = 0; bj < 2; ++bj) { const f32x4 v0 = acc[ai][bj][m][0] * rs[ai][m], v1 = acc[ai][bj][m][1] * rs[ai][m];
                        u32x4 w; w.x = cvt_pk_bf16(v0[0], v0[1]); w.y = cvt_pk_bf16(v0[2], v0[3]); w.z = cvt_pk_bf16(v1[0], v1[1]); w.w = cvt_pk_bf16(v1[2], v1[3]);
                        *(u32x4*)(rowp + bj * HALF) = w; } }
        } else {
            const int pt = (MODE == 0) ? (u.pn - 4) : u.pn;
            const int col0 = pt * HALF + wc * 32 + 8 * fq;
#pragma unroll
            for (int ai = 0; ai < 2; ++ai)
#pragma unroll
                for (int m = 0; m < 4; ++m) { bf16_t* rowp = O1 + (size_t)(row0 + ai * HALF + m * 16) * ld1 + col0;
                    f32x4 r[2];
#pragma unroll
                    for (int n = 0; n < 2; ++n) { const f32x4 g = acc[ai][0][m][n] * rs[ai][m], up = acc[ai][1][m][n] * rs[ai][m];
                        if (MODE == 0) r[n] = g * up;
                        else {
#pragma unroll
                            for (int j = 0; j < 4; ++j) r[n][j] = __builtin_amdgcn_fmed3f(g[j] * fast_rcp(1.0f + fast_exp2(-1.4426950408889634f * g[j])) * up[j] * F8_HSCALE, -448.0f, 448.0f); } }
                    if (MODE == 1) { u32x2 w; w.x = cvt_pk4_fp8(r[0][0], r[0][1], r[0][2], r[0][3]); w.y = cvt_pk4_fp8(r[1][0], r[1][1], r[1][2], r[1][3]);
                        *(u32x2*)((unsigned char*)O1 + (size_t)(row0 + ai * HALF + m * 16) * ld1 + col0) = w; }
                    else { u32x4 w; w.x = cvt_pk_bf16(r[0][0], r[0][1]); w.y = cvt_pk_bf16(r[0][2], r[0][3]); w.z = cvt_pk_bf16(r[1][0], r[1][1]); w.w = cvt_pk_bf16(r[1][2], r[1][3]);
                        *(u32x4*)rowp = w; } }
        }
    }
};
struct EpiDown {
    static constexpr bool PERM = true, PRELOAD = false, PREFETCH = true;
    unsigned char* O; const float* cwraw; const LAS int* tb; const LAS int* cn;
    __device__ __forceinline__ void prefetch(float (&cws)[2][4], const Unit& u, int wr, int fr) const {
        int e = 0;
#pragma unroll
        for (int j = 1; j < 16; ++j) e += (u.pm >= tb[j]) ? 1 : 0;
        const int idx0 = (u.pm - tb[e]) * BM + wr * 64 + fr, cne = cn[e];
#pragma unroll
        for (int ai = 0; ai < 2; ++ai)
#pragma unroll
            for (int m = 0; m < 4; ++m) { const int idx = idx0 + ai * HALF + m * 16; cws[ai][m] = idx < cne ? cwraw[(size_t)e * ECAP + idx] * (F8_YSCALE / (F8_WSCALE * F8_HSCALE)) : 0.f; }
    }
    __device__ __forceinline__ void operator()(const f32x4 (&acc)[2][2][4][2], const Unit& u, int wr, int wc, int fr, int fq, const float (&cws)[2][4]) const {
        const int row0 = u.pm * BM + wr * 64 + fr, col0 = u.pn * BM + wc * 32 + 8 * fq;
#pragma unroll
        for (int ai = 0; ai < 2; ++ai)
#pragma unroll
            for (int m = 0; m < 4; ++m) { const float cw = cws[ai][m];
                unsigned char* rowp = O + (size_t)(row0 + ai * HALF + m * 16) * D + col0;
#pragma unroll
                for (int bj = 0; bj < 2; ++bj) { f32x4 v0 = acc[ai][bj][m][0] * cw, v1 = acc[ai][bj][m][1] * cw;
#pragma unroll
                    for (int j = 0; j < 4; ++j) { v0[j] = __builtin_amdgcn_fmed3f(v0[j], -448.0f, 448.0f); v1[j] = __builtin_amdgcn_fmed3f(v1[j], -448.0f, 448.0f); }
                    u32x2 w; w.x = cvt_pk4_fp8(v0[0], v0[1], v0[2], v0[3]); w.y = cvt_pk4_fp8(v1[0], v1[1], v1[2], v1[3]);
                    *(u32x2*)(rowp + bj * HALF) = w; } }
    }
};
}

constexpr int RING_BYTES = 131072;
constexpr int MISC_OFF = RING_BYTES;
constexpr int LDS_BYTES = 163840;
constexpr int MW_BAR = 0;
constexpr int MW_TB = 16;
constexpr int MW_CN = 40;
constexpr int MW_Q = 60;
constexpr int MW_F = 64;

struct Params {
    const float* in[25]; float* out; unsigned char* ws;
};

constexpr float ATT_QSCALE = 0.125f * 1.4426950408889634f;
__device__ __forceinline__ void transpose_item(const float* W, int ld, int K, int k0, int srccol, bf16_t* WT, int dstrow, LAS float* scr, int lane, const float* gk = nullptr, float wsc = 1.0f) {
    float tv[32];
#pragma unroll
    for (int i = 0; i < 32; ++i) { const int kk = 2 * i + (lane >> 5); tv[i] = W[(size_t)(k0 + kk) * ld + srccol + (lane & 31)]; }
#pragma unroll
    for (int i = 0; i < 32; ++i) { const int kk = 2 * i + (lane >> 5); scr[kk * 33 + (lane & 31)] = (gk ? tv[i] * gk[k0 + kk] : tv[i]) * wsc; }
    asm volatile("s_waitcnt lgkmcnt(0)" ::: "memory");
    const int c = lane & 7;
#pragma unroll
    for (int j = 0; j < 4; ++j) { const int n = (lane >> 3) + 8 * j; const LAS float* s = scr + (8 * c) * 33 + n;
        u32x4 o; o.x = cvt_pk_bf16(s[0 * 33], s[1 * 33]); o.y = cvt_pk_bf16(s[2 * 33], s[3 * 33]); o.z = cvt_pk_bf16(s[4 * 33], s[5 * 33]); o.w = cvt_pk_bf16(s[6 * 33], s[7 * 33]);
        *(u32x4*)(WT + (size_t)(dstrow + n) * K + k0 + 8 * c) = o; }
    asm volatile("s_waitcnt lgkmcnt(0)" ::: "memory");
}
__device__ __forceinline__ void transpose_item_f8(const float* W, int ld, int K, int k0, int srccol, unsigned char* WT8, int dstrow, LAS float* scr, int lane, const float* gk, float scale) {
    float tv[32];
#pragma unroll
    for (int i = 0; i < 32; ++i) { const int kk = 2 * i + (lane >> 5); tv[i] = W[(size_t)(k0 + kk) * ld + srccol + (lane & 31)]; }
#pragma unroll
    for (int i = 0; i < 32; ++i) { const int kk = 2 * i + (lane >> 5); scr[kk * 33 + (lane & 31)] = (gk ? tv[i] * gk[k0 + kk] : tv[i]) * scale; }
    asm volatile("s_waitcnt lgkmcnt(0)" ::: "memory");
    const int c = lane & 3;
#pragma unroll
    for (int j = 0; j < 2; ++j) { const int n = (lane >> 2) + 16 * j; const LAS float* q = scr + (16 * c) * 33 + n;
        u32x4 o; o.x = cvt_pk4_fp8(q[0 * 33], q[1 * 33], q[2 * 33], q[3 * 33]); o.y = cvt_pk4_fp8(q[4 * 33], q[5 * 33], q[6 * 33], q[7 * 33]);
        o.z = cvt_pk4_fp8(q[8 * 33], q[9 * 33], q[10 * 33], q[11 * 33]); o.w = cvt_pk4_fp8(q[12 * 33], q[13 * 33], q[14 * 33], q[15 * 33]);
        *(u32x4*)(WT8 + (size_t)(dstrow + n) * K + k0 + 16 * c) = o; }
    asm volatile("s_waitcnt lgkmcnt(0)" ::: "memory");
}
__device__ __forceinline__ int pair_row(int ch, int up) { return (ch >> 7) * 256 + up * 128 + (ch & 127); }

__device__ __forceinline__ void phase_prologue_weights(const Params& p, LAS unsigned char* lds, int first, int last, int step, int wave, int lane_) {
    int lane = lane_; asm volatile("" : "+v"(lane));
    LAS float* scr = (LAS float*)(lds + wave * 16384);
    unsigned char* ws = p.ws;
    constexpr int I1 = 16 * 112, I2 = 16 * 32, I3 = 16 * 96, I4 = 16 * 32, IE = 768;
    constexpr int NITEMS = I1 + I2 + I3 + I4 + 32 * IE;
    static_assert(NITEMS == 28928, "item count");
    for (int it = first; it < last; it += step) {
        int r = it;
        if (r < I1) { const int kb = r / 112, nb = r % 112; const int sc = nb < 64 ? 32 * nb : 2056 + 32 * (nb - 64), dr = nb < 64 ? 32 * nb : 2048 + 32 * (nb - 64);
            transpose_item(p.in[5], EVEN_IN, 1024, 64 * kb, sc, (bf16_t*)(ws + WS_WT1), dr, scr, lane, nullptr, (dr >= P_DQ && dr < P_DK) ? ATT_QSCALE : 1.0f); continue; } r -= I1;
        if (r < I2) { const int kb = r / 32, nb = r % 32; transpose_item(p.in[6], 1024, 1024, 64 * kb, 32 * nb, (bf16_t*)(ws + WS_WT2), 32 * nb, scr, lane); continue; } r -= I2;
        if (r < I3) { const int kb = r / 96, nb = r % 96; int dr;
            if (nb < 32) dr = 32 * nb; else if (nb < 64) dr = 1024 + pair_row(32 * (nb - 32), 0); else dr = 1024 + pair_row(32 * (nb - 64), 1);
            if (G3_F8) transpose_item_f8(p.in[15], 3072, 1024, 64 * kb, 32 * nb, ws + WS_WT3, dr, scr, lane, p.in[2] + D, F8_WSCALE);
            else transpose_item(p.in[15], 3072, 1024, 64 * kb, 32 * nb, (bf16_t*)(ws + WS_WT3), dr, scr, lane, p.in[2] + D);
            continue; } r -= I3;
        if (r < I4) { const int kb = r / 32, nb = r % 32; transpose_item(p.in[17], 1024, 1024, 64 * kb, 32 * nb, (bf16_t*)(ws + WS_WT4), 32 * nb, scr, lane); continue; } r -= I4;
        const int le = r / IE; r %= IE;
        unsigned char* wgu = ws + WS_WGU + (size_t)le * 1024 * 1024; unsigned char* wd = ws + WS_WD + (size_t)le * 1024 * 512;
        if (r < 256) { const int kb = r / 16, nb = r % 16; transpose_item_f8(p.in[22] + (size_t)le * 1024 * 512, 512, 1024, 64 * kb, 32 * nb, wgu, pair_row(32 * nb, 0), scr, lane, p.in[3] + (le >> 4) * D, F8_WSCALE); continue; } r -= 256;
        if (r < 256) { const int kb = r / 16, nb = r % 16; transpose_item_f8(p.in[23] + (size_t)le * 1024 * 512, 512, 1024, 64 * kb, 32 * nb, wgu, pair_row(32 * nb, 1), scr, lane, p.in[3] + (le >> 4) * D, F8_WSCALE); continue; } r -= 256;
        { const int kb = r / 32, nb = r % 32; transpose_item_f8(p.in[24] + (size_t)le * 512 * 1024, 1024, 512, 64 * kb, 32 * nb, wd, 32 * nb, scr, lane, nullptr, F8_WSCALE); }
    }
}

struct RowV { f32x4 v[4]; };
__device__ __forceinline__ RowV row_load(const float* xr, int lane) { RowV r; const f32x4* p = (const f32x4*)xr + lane;
#pragma unroll
    for (int j = 0; j < 4; ++j) r.v[j] = p[64 * j]; return r; }
__device__ __forceinline__ void row_store(float* xr, int lane, const RowV& r) { f32x4* p = (f32x4*)xr + lane;
#pragma unroll
    for (int j = 0; j < 4; ++j) p[64 * j] = r.v[j]; }
__device__ __forceinline__ RowV row_load_bf16(const bf16_t* yr, int lane) { RowV r; const u32x2* p = (const u32x2*)yr + lane;
#pragma unroll
    for (int j = 0; j < 4; ++j) { const u32x2 w = p[64 * j]; r.v[j] = (f32x4){bf_lo(w.x), bf_hi(w.x), bf_lo(w.y), bf_hi(w.y)}; } return r; }
__device__ __forceinline__ RowV row_load_fp8(const unsigned char* yr, int lane, float sc) { RowV r; const unsigned* p = (const unsigned*)yr + lane;
#pragma unroll
    for (int j = 0; j < 4; ++j) { const unsigned w = p[64 * j]; const f32x2 lo = __builtin_amdgcn_cvt_pk_f32_fp8((int)w, false), hi = __builtin_amdgcn_cvt_pk_f32_fp8((int)w, true); r.v[j] = (f32x4){lo.x * sc, lo.y * sc, hi.x * sc, hi.y * sc}; } return r; }
__device__ __forceinline__ float row_rstd(const RowV& r) { float s = 0.f;
#pragma unroll
    for (int j = 0; j < 4; ++j) s += (r.v[j][0] * r.v[j][0] + r.v[j][1] * r.v[j][1]) + (r.v[j][2] * r.v[j][2] + r.v[j][3] * r.v[j][3]);
    return 1.0f / sqrtf(wave_sum(s) * (1.0f / D) + NORM_EPS); }
__device__ __forceinline__ void row_store_bf16(bf16_t* hr, int lane, const RowV& r) { u32x2* p = (u32x2*)hr + lane;
#pragma unroll
    for (int j = 0; j < 4; ++j) { u32x2 w; w.x = cvt_pk_bf16(r.v[j][0], r.v[j][1]); w.y = cvt_pk_bf16(r.v[j][2], r.v[j][3]); p[64 * j] = w; } }

__device__ __forceinline__ void phase_norm_gates(const Params& p, LAS unsigned char* lds, int tid, int gw, int NGW, int lane) {
    const float* x = p.in[0]; const float* g = p.in[2]; const float* win = p.in[5];
    bf16_t* H = (bf16_t*)(p.ws + WS_H); float* gates = (float*)(p.ws + WS_GATES);
    LAS float* wt = (LAS float*)lds;
    for (int i = tid; i < 8 * 1024; i += NTHR) { const int k = i >> 3, o = i & 7; wt[o * 1024 + k] = win[(size_t)k * EVEN_IN + 2048 + o] * g[k]; }
    __syncthreads();
    RowV gv = row_load(g, lane);
    for (int m0 = gw; m0 < T; m0 += 2 * NGW) {
      RowV rr[2];
#pragma unroll
      for (int u = 0; u < 2; ++u) { const int mm = m0 + u * NGW; rr[u] = row_load(x + (size_t)(mm < T ? mm : m0) * D, lane); }
#pragma unroll
      for (int u = 0; u < 2; ++u) {
        const int m = m0 + u * NGW; if (m >= T) break; RowV r = rr[u];
        const float rstd = row_rstd(r);
        float dots[8];
#pragma unroll
        for (int o = 0; o < 8; ++o) { float s = 0.f;
#pragma unroll
            for (int j = 0; j < 4; ++j) { const f32x4 w = *(const LAS f32x4*)(wt + o * 1024 + 4 * lane + 256 * j); s += (r.v[j][0] * w[0] + r.v[j][1] * w[1]) + (r.v[j][2] * w[2] + r.v[j][3] * w[3]); }
            dots[o] = s; }
        float gsum;
        { const bool b5 = (lane & 32) != 0, b4 = (lane & 16) != 0, b3 = (lane & 8) != 0;
          float k4[4];
#pragma unroll
          for (int i = 0; i < 4; ++i) { const float keep = b5 ? dots[4 + i] : dots[i], send = b5 ? dots[i] : dots[4 + i]; k4[i] = keep + __shfl_xor(send, 32); }
          float k2[2];
#pragma unroll
          for (int i = 0; i < 2; ++i) { const float keep = b4 ? k4[2 + i] : k4[i], send = b4 ? k4[i] : k4[2 + i]; k2[i] = keep + __shfl_xor(send, 16); }
          { const float keep = b3 ? k2[1] : k2[0], send = b3 ? k2[0] : k2[1]; gsum = keep + __shfl_xor(send, 8); }
          gsum += __shfl_xor(gsum, 4); gsum += __shfl_xor(gsum, 2); gsum += __shfl_xor(gsum, 1); }
#pragma unroll
        for (int j = 0; j < 4; ++j) r.v[j] = r.v[j] * rstd * gv.v[j];
        row_store_bf16(H + (size_t)m * D, lane, r);
        if ((lane & 7) == 0) gates[(size_t)m * 8 + ((lane >> 3) & 7)] = gsum * rstd;
      }
    }
    __syncthreads();
}

template <int MODE, bool COMBINE>
__device__ __forceinline__ void phase_rows(const Params& p, LAS unsigned char* lds, int tid_, int wave, int lane_, int G,
                                           const float* gvec, const float* wgr, const float* bgr, const float* wer, const float* ber, unsigned* cnt_prev, unsigned* cnt_cur) {
    int tid = tid_; asm volatile("" : "+v"(tid)); const int lane = tid & 63;
    float* OUT = p.out; bf16_t* XB = (bf16_t*)(p.ws + WS_XB); float* RSTD = (float*)(p.ws + WS_RSTD);
    const unsigned char* YC = (const unsigned char*)(p.ws + WS_YC); float* rsraw = (float*)(p.ws + WS_RSRAW);
    unsigned* tokinfo = (unsigned*)(p.ws + WS_TOKINFO);
    unsigned* rowtok = (unsigned*)(p.ws + WS_ROWTOK); float* cwraw = (float*)(p.ws + WS_CWRAW);
    LAS float* wt = (LAS float*)lds;
    LAS int* misc = (LAS int*)(lds + MISC_OFF);
    LAS int* tbp = misc + MW_TB;
    LAS int* te = misc + 1024;
    LAS float* tc = (LAS float*)(misc + 1536);
    LAS int* trank = misc + 2048;
    LAS int* ebase = misc + 2560;
    LAS float* trs = (LAS float*)(misc + 2600);
    if (COMBINE) { if (tid == 0) { int acc = 0; for (int e = 0; e < 16; ++e) { tbp[e] = acc; acc += ((int)__hip_atomic_load(cnt_prev + e * 64, __ATOMIC_RELAXED, __HIP_MEMORY_SCOPE_AGENT) + 255) >> 8; } tbp[16] = acc; } }
    if (MODE == 1) { for (int i = tid; i < 20 * 1024; i += NTHR) { const int o = i >> 10, k = i & 1023; wt[i] = (o < 4 ? wgr[(size_t)k * 4 + o] : wer[(size_t)k * 16 + (o - 4)]) * gvec[k]; } }
    __syncthreads();
    RowV gv; if (MODE == 2) gv = row_load(gvec, lane);
    for (int blk = blockIdx.x; blk < T / 256; blk += G) {
        for (int i2 = 0; i2 < 32; i2 += 2) {
          RowV rr[2];
#pragma unroll
          for (int u = 0; u < 2; ++u) {
            const int m = blk * 256 + wave * 32 + i2 + u;
            rr[u] = row_load_bf16(XB + (size_t)m * D, lane);
            if (COMBINE) {
                const unsigned i0 = tokinfo[(size_t)m * 2], i1 = tokinfo[(size_t)m * 2 + 1];
                const size_t s0 = (size_t)tbp[i0 >> 16] * 256 + (i0 & 0xffffu), s1 = (size_t)tbp[i1 >> 16] * 256 + (i1 & 0xffffu);
                const RowV y0 = row_load_fp8(YC + s0 * D, lane, 1.0f / F8_YSCALE), y1 = row_load_fp8(YC + s1 * D, lane, 1.0f / F8_YSCALE);
#pragma unroll
                for (int j = 0; j < 4; ++j) rr[u].v[j] = rr[u].v[j] + y0.v[j] + y1.v[j];
            }
          }
#pragma unroll
          for (int u = 0; u < 2; ++u) {
            const int i = i2 + u;
            const int rl = wave * 32 + i, m = blk * 256 + rl;
            RowV r = rr[u];
            if (MODE == 0) {
                u32x2* xp = (u32x2*)(XB + (size_t)m * D) + lane;
#pragma unroll
                for (int j = 0; j < 4; ++j) { u32x2 w; w.x = cvt_pk_bf16(r.v[j][0], r.v[j][1]); w.y = cvt_pk_bf16(r.v[j][2], r.v[j][3]); xp[64 * j] = w;
                    r.v[j] = (f32x4){bf_lo(w.x), bf_hi(w.x), bf_lo(w.y), bf_hi(w.y)}; }
            }
            const float rstd = row_rstd(r);
            if (MODE != 2) { if (lane == 0) RSTD[m] = rstd; }
            if (MODE == 1 || (MODE == 0 && G3_F8)) { unsigned* x8 = (unsigned*)(p.ws + WS_XB8 + (size_t)m * D) + lane;
#pragma unroll
                for (int j = 0; j < 4; ++j) x8[64 * j] = cvt_pk4_fp8(r.v[j][0], r.v[j][1], r.v[j][2], r.v[j][3]); }
            if (MODE == 1) {
                float lg[20];
#pragma unroll
                for (int o = 0; o < 20; ++o) { float s = 0.f;
#pragma unroll
                    for (int j = 0; j < 4; ++j) { const f32x4 w = *(const LAS f32x4*)(wt + o * 1024 + 4 * lane + 256 * j); s += (r.v[j][0] * w[0] + r.v[j][1] * w[1]) + (r.v[j][2] * w[2] + r.v[j][3] * w[3]); }
                    lg[o] = wave_sum(s) * rstd + (o < 4 ? bgr[o] : ber[o - 4]); }
                int gs = 0; float gm = lg[0];
#pragma unroll
                for (int o = 1; o < 4; ++o) if (lg[o] > gm) { gm = lg[o]; gs = o; }
                float den = 0.f;
#pragma unroll
                for (int o = 0; o < 4; ++o) den += __expf(lg[o] - gm);
                const float pg = 1.0f / den;
                float el[4];
#pragma unroll
                for (int o = 0; o < 4; ++o) { float v = lg[4 + o];
#pragma unroll
                    for (int g2 = 1; g2 < 4; ++g2) v = (gs == g2) ? lg[4 + 4 * g2 + o] : v;
                    el[o] = v; }
                int i0 = 0; float v0 = el[0];
#pragma unroll
                for (int o = 1; o < 4; ++o) if (el[o] > v0) { v0 = el[o]; i0 = o; }
                int i1 = -1; float v1 = -INFINITY;
#pragma unroll
                for (int o = 0; o < 4; ++o) if (o != i0 && el[o] > v1) { v1 = el[o]; i1 = o; }
                const float ex = __expf(v1 - v0); const float w0 = 1.0f / (1.0f + ex), w1 = ex * w0;
                if (lane == 0) { te[rl * 2] = gs * 4 + i0; te[rl * 2 + 1] = gs * 4 + i1; tc[rl * 2] = w0 * pg; tc[rl * 2 + 1] = w1 * pg; trs[rl] = rstd; }
            }
            if (MODE == 2) {
#pragma unroll
                for (int j = 0; j < 4; ++j) r.v[j] = r.v[j] * rstd * gv.v[j];
                row_store(OUT + (size_t)m * D, lane, r);
            }
          }
        }
        if (MODE == 1) {
            __syncthreads();
            if (tid < 16) { int c = 0; for (int q = 0; q < 512; ++q) if (te[q] == tid) { trank[q] = c; ++c; }
                ebase[tid] = c ? (int)__hip_atomic_fetch_add(cnt_cur + tid * 64, (unsigned)c, __ATOMIC_RELAXED, __HIP_MEMORY_SCOPE_AGENT) : 0; }
            __syncthreads();
            { const int q = tid, e = te[q], pos = ebase[e] + trank[q], tok = blk * 256 + (q >> 1);
              rowtok[(size_t)e * ECAP + pos] = (unsigned)tok; cwraw[(size_t)e * ECAP + pos] = tc[q]; rsraw[(size_t)e * ECAP + pos] = trs[q >> 1]; tokinfo[(size_t)tok * 2 + (q & 1)] = ((unsigned)e << 16) | (unsigned)pos; }
            __syncthreads();
        }
    }
    __syncthreads();
}

__device__ __forceinline__ void phase_router(const Params& p, LAS unsigned char* lds, int tid_, int wave, int G,
                                             const float* gvec, const float* wgr, const float* bgr, const float* wer, const float* ber, unsigned* cnt_cur) {
    int tid = tid_; asm volatile("" : "+v"(tid)); const int lane = tid & 63, r32 = lane & 31, hi = lane >> 5;
    const bf16_t* XB = (const bf16_t*)(p.ws + WS_XB); float* rsraw = (float*)(p.ws + WS_RSRAW);
    unsigned* tokinfo = (unsigned*)(p.ws + WS_TOKINFO);
    unsigned* rowtok = (unsigned*)(p.ws + WS_ROWTOK); float* cwraw = (float*)(p.ws + WS_CWRAW);
    constexpr int WROW = 2048 + 16;
    LAS unsigned char* Whi = lds; LAS unsigned char* Wlo = lds + 24 * WROW;
    LAS int* misc = (LAS int*)(lds + MISC_OFF);
    LAS int* te = misc + 1024; LAS float* tc = (LAS float*)(misc + 1536); LAS int* trank = misc + 2048; LAS int* ebase = misc + 2560; LAS float* trs = (LAS float*)(misc + 2600);
    for (int i = tid; i < 24 * 1024; i += NTHR) { const int sl = i >> 10, k = i & 1023; float w;
        if (sl < 8) w = wgr[(size_t)k * 4 + (sl & 3)]; else { const int q = sl - 8, e = (q & 3) + 8 * ((q >> 2) & 1) + 4 * (q >> 3); w = wer[(size_t)k * 16 + e]; }
        w *= gvec[k];
        const unsigned hb = cvt_pk_bf16(w, 0.f) & 0xffffu; const float wl = w - __uint_as_float(hb << 16); const unsigned lb = cvt_pk_bf16(wl, 0.f) & 0xffffu;
        *(LAS unsigned short*)(Whi + sl * WROW + k * 2) = (unsigned short)hb; *(LAS unsigned short*)(Wlo + sl * WROW + k * 2) = (unsigned short)lb; }
    __syncthreads();
    const int slot_row = r32 < 24 ? r32 : r32 - 8;
    const LAS unsigned char* wh = Whi + slot_row * WROW + hi * 64; const LAS unsigned char* wl_ = Wlo + slot_row * WROW + hi * 64;
    for (int blk = blockIdx.x; blk < T / 256; blk += G) {
        const int rl = wave * 32 + r32, m = blk * 256 + rl;
        const bf16_t* xr = XB + (size_t)m * D + hi * 32;
        f32x16 acc = (f32x16){}; float ss = 0.f;
        bf16x8 xa[4], xb[4];
#pragma unroll
        for (int q = 0; q < 4; ++q) xa[q] = *(const bf16x8*)(xr + q * 8);
#pragma unroll 1
        for (int t = 0; t < 16; t += 2) {
#pragma unroll
            for (int q = 0; q < 4; ++q) xb[q] = *(const bf16x8*)(xr + (t + 1) * 64 + q * 8);
#pragma unroll
            for (int q = 0; q < 4; ++q) { const bf16x8 ah = *(const LAS bf16x8*)(wh + t * 128 + q * 16), al = *(const LAS bf16x8*)(wl_ + t * 128 + q * 16);
                acc = __builtin_amdgcn_mfma_f32_32x32x16_bf16(ah, xa[q], acc, 0, 0, 0); acc = __builtin_amdgcn_mfma_f32_32x32x16_bf16(al, xa[q], acc, 0, 0, 0);
#pragma unroll
                for (int j = 0; j < 4; ++j) { const unsigned w = ((const unsigned*)&xa[q])[j]; const float a = bf_lo(w), b = bf_hi(w); ss += a * a + b * b; } }
            if (t + 2 < 16) {
#pragma unroll
                for (int q = 0; q < 4; ++q) xa[q] = *(const bf16x8*)(xr + (t + 2) * 64 + q * 8); }
#pragma unroll
            for (int q = 0; q < 4; ++q) { const bf16x8 ah = *(const LAS bf16x8*)(wh + (t + 1) * 128 + q * 16), al = *(const LAS bf16x8*)(wl_ + (t + 1) * 128 + q * 16);
                acc = __builtin_amdgcn_mfma_f32_32x32x16_bf16(ah, xb[q], acc, 0, 0, 0); acc = __builtin_amdgcn_mfma_f32_32x32x16_bf16(al, xb[q], acc, 0, 0, 0);
#pragma unroll
                for (int j = 0; j < 4; ++j) { const unsigned w = ((const unsigned*)&xb[q])[j]; const float a = bf_lo(w), b = bf_hi(w); ss += a * a + b * b; } }
        }
        ss += __shfl_xor(ss, 32);
        const float rstd = 1.0f / sqrtf(ss * (1.0f / D) + NORM_EPS);
        float lg[4];
#pragma unroll
        for (int o = 0; o < 4; ++o) lg[o] = acc[o] * rstd + bgr[o];
        int gs = 0; float gm = lg[0];
#pragma unroll
        for (int o = 1; o < 4; ++o) if (lg[o] > gm) { gm = lg[o]; gs = o; }
        float den = 0.f;
#pragma unroll
        for (int o = 0; o < 4; ++o) den += __expf(lg[o] - gm);
        const float pg = 1.0f / den;
        if ((gs >> 1) == hi) {
            float el[4];
#pragma unroll
            for (int o = 0; o < 4; ++o) el[o] = ((gs & 1) ? acc[8 + o] : acc[4 + o]) * rstd + ber[gs * 4 + o];
            int i0 = 0; float v0 = el[0];
#pragma unroll
            for (int o = 1; o < 4; ++o) if (el[o] > v0) { v0 = el[o]; i0 = o; }
            int i1 = -1; float v1 = -INFINITY;
#pragma unroll
            for (int o = 0; o < 4; ++o) if (o != i0 && el[o] > v1) { v1 = el[o]; i1 = o; }
            const float ex = __expf(v1 - v0); const float w0 = 1.0f / (1.0f + ex), w1 = ex * w0;
            te[rl * 2] = gs * 4 + i0; te[rl * 2 + 1] = gs * 4 + i1; tc[rl * 2] = w0 * pg; tc[rl * 2 + 1] = w1 * pg; trs[rl] = rstd;
        }
        __syncthreads();
        if (tid < 16) { int c = 0; for (int q = 0; q < 512; ++q) if (te[q] == tid) { trank[q] = c; ++c; }
            ebase[tid] = c ? (int)__hip_atomic_fetch_add(cnt_cur + tid * 64, (unsigned)c, __ATOMIC_RELAXED, __HIP_MEMORY_SCOPE_AGENT) : 0; }
        __syncthreads();
        { const int q = tid, e = te[q], pos = ebase[e] + trank[q], tok = blk * 256 + (q >> 1);
          rowtok[(size_t)e * ECAP + pos] = (unsigned)tok; cwraw[(size_t)e * ECAP + pos] = tc[q]; rsraw[(size_t)e * ECAP + pos] = trs[q >> 1]; tokinfo[(size_t)tok * 2 + (q & 1)] = ((unsigned)e << 16) | (unsigned)pos; }
        __syncthreads();
    }
    __syncthreads();
}

__device__ __forceinline__ void phase_conv(const Params& p, int gw, int NGW, int lane) {
    const bf16_t* BG = (const bf16_t*)(p.ws + WS_BG); const bf16_t* Z = (const bf16_t*)(p.ws + WS_Z); bf16_t* A2 = (bf16_t*)(p.ws + WS_CAT);
    const float* cw = p.in[16];
    float w0[16], w1[16], w2[16];
#pragma unroll
    for (int h = 0; h < 2; ++h)
#pragma unroll
        for (int j = 0; j < 8; ++j) { const int c = h * 512 + lane * 8 + j; w0[h * 8 + j] = cw[c]; w1[h * 8 + j] = cw[D + c]; w2[h * 8 + j] = cw[2 * D + c]; }
    for (int run = gw; run < T / 32; run += NGW) {
        const int t0 = run * 32;
        float zm1[16], zm2[16];
#pragma unroll
        for (int j = 0; j < 16; ++j) { zm1[j] = 0.f; zm2[j] = 0.f; }
        if ((t0 & (SEQ - 1)) != 0) {
#pragma unroll
            for (int h = 0; h < 2; ++h) { const u32x4 a = *(const u32x4*)(Z + (size_t)(t0 - 1) * D + h * 512 + lane * 8), b = *(const u32x4*)(Z + (size_t)(t0 - 2) * D + h * 512 + lane * 8);
#pragma unroll
                for (int q = 0; q < 4; ++q) { zm1[h * 8 + 2 * q] = bf_lo(a[q]); zm1[h * 8 + 2 * q + 1] = bf_hi(a[q]); zm2[h * 8 + 2 * q] = bf_lo(b[q]); zm2[h * 8 + 2 * q + 1] = bf_hi(b[q]); } }
        }
#pragma unroll 4
        for (int i = 0; i < 32; ++i) {
            const size_t rb = (size_t)(t0 + i) * D;
#pragma unroll
            for (int h = 0; h < 2; ++h) { const u32x4 zz = *(const u32x4*)(Z + rb + h * 512 + lane * 8), bb = *(const u32x4*)(BG + rb + h * 512 + lane * 8);
                float o[8];
#pragma unroll
                for (int q = 0; q < 4; ++q) {
#pragma unroll
                    for (int s = 0; s < 2; ++s) { const int j = h * 8 + 2 * q + s; const float zc = s ? bf_hi(zz[q]) : bf_lo(zz[q]), bg = s ? bf_hi(bb[q]) : bf_lo(bb[q]);
                        o[2 * q + s] = bg * (w0[j] * zm2[j] + w1[j] * zm1[j] + w2[j] * zc); zm2[j] = zm1[j]; zm1[j] = zc; } }
                u32x4 w; w.x = cvt_pk_bf16(o[0], o[1]); w.y = cvt_pk_bf16(o[2], o[3]); w.z = cvt_pk_bf16(o[4], o[5]); w.w = cvt_pk_bf16(o[6], o[7]);
                *(u32x4*)(A2 + rb + h * 512 + lane * 8) = w; }
        }
    }
}

__device__ __forceinline__ void phase_gate_scan(const Params& p, int gw, int NGW, int lane) {
    const float* gates = (const float*)(p.ws + WS_GATES);
    float* SA = (float*)(p.ws + WS_SA); float* SAM = (float*)(p.ws + WS_SAM); float* SBA = (float*)(p.ws + WS_SBA);
    for (int sq = gw; sq < NBATCH * 4; sq += NGW) {
        const int b = sq >> 2, hd = sq & 3; const float ib = p.in[7][hd], fb = p.in[8][hd];
        float lf[32], ig[32];
#pragma unroll
        for (int i = 0; i < 32; ++i) { const size_t t = (size_t)b * SEQ + lane * 32 + i; const float f = gates[t * 8 + 4 + hd] + fb; ig[i] = gates[t * 8 + hd] + ib;
            lf[i] = (f >= 0.f) ? -log1pf(expf(-f)) : (f - log1pf(expf(f))); }
        float run = 0.f;
#pragma unroll
        for (int i = 0; i < 32; ++i) { run += lf[i]; lf[i] = run; }
        float tot = run, pre = 0.f;
#pragma unroll
        for (int o = 1; o < 64; o <<= 1) { const float v = __shfl_up(tot, o); if (lane >= o) tot += v; }
        pre = tot - run;
        float amax = -INFINITY;
#pragma unroll
        for (int i = 0; i < 32; ++i) { lf[i] += pre; ig[i] = ig[i] - lf[i]; amax = fmaxf(amax, ig[i]); }
        float pm = amax;
#pragma unroll
        for (int o = 1; o < 64; o <<= 1) { const float v = __shfl_up(pm, o); if (lane >= o) pm = fmaxf(pm, v); }
        float prev = __shfl_up(pm, 1); if (lane == 0) prev = -INFINITY;
        float rm = prev;
#pragma unroll
        for (int i = 0; i < 32; ++i) { const size_t o = (size_t)sq * SEQ + lane * 32 + i; rm = fmaxf(rm, ig[i]); SA[o] = ig[i]; SAM[o] = rm; SBA[o] = lf[i] + rm; }
    }
}

struct TileRegs { u32x4 v[2]; };
__device__ __forceinline__ TileRegs tile_load(const bf16_t* src, int tid) { TileRegs r;
#pragma unroll
    for (int i = 0; i < 2; ++i) { const int n = tid + 512 * i, row = n >> 4, ch = n & 15; r.v[i] = *(const u32x4*)(src + (size_t)row * NP + ch * 8); } return r; }
__device__ __forceinline__ void tile_write(LAS unsigned char* dst, int tid, const TileRegs& r) {
#pragma unroll
    for (int i = 0; i < 2; ++i) { const int n = tid + 512 * i, row = n >> 4, ch = n & 15; *(LAS u32x4*)(dst + off_b(row, ch)) = r.v[i]; } }

__device__ __forceinline__ void glds16(const void* gsrc, unsigned lds_dst) { unsigned keep;
    asm volatile("s_mov_b32 %0, m0\n\ts_mov_b32 m0, %2\n\ts_nop 0\n\tglobal_load_lds_dwordx4 %1, off\n\ts_mov_b32 m0, %0" : "=&s"(keep) : "v"(gsrc), "s"(lds_dst) : "memory"); }
__device__ __forceinline__ void tile_dma(const bf16_t* src, LAS unsigned char* dst, int wave, int lane) {
#pragma unroll
    for (int i = 0; i < 2; ++i) { const int piece = 2 * wave + i, row = 4 * piece + (lane >> 4); const unsigned ch = (unsigned)(lane & 15) ^ ((((unsigned)lane >> 4) << 2) | ((unsigned)piece & 3u));
        glds16(src + (size_t)row * NP + ch * 8, (unsigned)__builtin_amdgcn_readfirstlane((int)(unsigned)(uintptr_t)(dst + piece * 1024))); }
}
#define WAIT_ALL_BAR() asm volatile("s_waitcnt vmcnt(0) lgkmcnt(0)\n\ts_barrier" ::: "memory")
__device__ __forceinline__ void attn_unit(const Params& p, LAS unsigned char* lds, int bh, int qblk, int tid_, int wave, int lane_) {
    int tid = tid_; asm volatile("" : "+v"(tid)); const int lane = tid & 63;
    const bf16_t* P = (const bf16_t*)(p.ws + WS_P); bf16_t* CAT = (bf16_t*)(p.ws + WS_CAT);
    const int b = bh >> 2, hd = bh & 3, map = wave >> 2, qs = wave & 3, r32 = lane & 31, hi = lane >> 5;
    const size_t rowbase = (size_t)b * SEQ;
    const int q0 = qblk * 128 + qs * 32, qrow = q0 + r32;
    LAS float* fs = (LAS float*)(lds + MISC_OFF) + MW_F;
    LAS float* tbl = fs;
    constexpr float LOG2E = 1.4426950408889634f;
    if (tid < 128) { const int n = tid; int bk;
        if (n < 16) bk = n; else { bk = 16; const int th[15] = {19, 21, 24, 27, 31, 35, 40, 46, 52, 59, 67, 77, 87, 99, 113};
#pragma unroll
            for (int j = 0; j < 15; ++j) bk += (n >= th[j]) ? 1 : 0; }
        tbl[n] = p.in[1][bk * 4 + hd] * LOG2E; }
    bf16x8 qf[4];
    { const bf16_t* qp = P + (rowbase + qrow) * NP + P_DQ + hd * 128 + map * 64 + hi * 8;
#pragma unroll
      for (int ks = 0; ks < 4; ++ks) qf[ks] = *(const bf16x8*)(qp + ks * 16); }
    const bf16_t* Kg = P + rowbase * NP + P_DK + hd * 128; const bf16_t* Vg = P + rowbase * NP + P_DV + hd * 128;
    const int NS = qblk + 1;
    f32x16 o[4];
#pragma unroll
    for (int c = 0; c < 4; ++c) o[c] = (f32x16){};
    float mrun = -INFINITY, lrun = 0.f;
    const float bias_far = p.in[1][31 * 4 + hd] * LOG2E;
    const unsigned xr = ((unsigned)(r32 & 3) << 2) | ((unsigned)(r32 >> 2) & 3u);
    const unsigned q4 = (lane & 15) >> 2, pp = lane & 3, blk = (lane >> 4) & 1;
#ifndef ATT_DMA
#define ATT_DMA 5
#endif
#ifndef ATT_LATE_DMA
#define ATT_LATE_DMA 1
#endif
#if ATT_DMA == 2 || ATT_DMA == 4
#elif ATT_DMA
    WAIT_ALL_BAR();
    { tile_dma(Kg, lds, wave, lane); tile_dma(Vg, lds + 16384, wave, lane); tile_dma(Kg + (size_t)64 * NP, lds + 32768, wave, lane); tile_dma(Vg + (size_t)64 * NP, lds + 49152, wave, lane); }
#else
    { TileRegs a0 = tile_load(Kg, tid), a1 = tile_load(Vg, tid), a2 = tile_load(Kg + (size_t)64 * NP, tid), a3 = tile_load(Vg + (size_t)64 * NP, tid);
      tile_write(lds, tid, a0); tile_write(lds + 16384, tid, a1); tile_write(lds + 32768, tid, a2); tile_write(lds + 49152, tid, a3); }
#endif
#if ATT_DMA == 5
    WAIT_ALL_BAR();
#endif
    asm volatile("" :: "v"(qf[0]), "v"(qf[1]), "v"(qf[2]), "v"(qf[3]));
#pragma unroll 1
    for (int st = 0; st < NS; ++st) {
        WAIT_ALL_BAR();
#if ATT_DMA == 2
        { LAS unsigned char* nb = lds + (st & 1) * 65536; const size_t ro = (size_t)st * 128 * NP;
            tile_dma(Kg + ro, nb, wave, lane); tile_dma(Vg + ro, nb + 16384, wave, lane); tile_dma(Kg + ro + (size_t)64 * NP, nb + 32768, wave, lane); tile_dma(Vg + ro + (size_t)64 * NP, nb + 49152, wave, lane); }
        WAIT_ALL_BAR();
#elif ATT_DMA == 3
#elif ATT_DMA
#if ATT_DMA == 4
        if (st == 0) { tile_dma(Kg, lds, wave, lane); tile_dma(Vg, lds + 16384, wave, lane); tile_dma(Kg + (size_t)64 * NP, lds + 32768, wave, lane); tile_dma(Vg + (size_t)64 * NP, lds + 49152, wave, lane); WAIT_ALL_BAR(); }
#endif
        if (!ATT_LATE_DMA && st + 1 < NS) { LAS unsigned char* nb = lds + ((st + 1) & 1) * 65536; const size_t ro = (size_t)(st + 1) * 128 * NP;
            tile_dma(Kg + ro, nb, wave, lane); tile_dma(Vg + ro, nb + 16384, wave, lane); tile_dma(Kg + ro + (size_t)64 * NP, nb + 32768, wave, lane); tile_dma(Vg + ro + (size_t)64 * NP, nb + 49152, wave, lane); }
#else
        TileRegs a0, a1;
        if (st + 1 < NS) { const size_t ro = (size_t)(st + 1) * 128 * NP; a0 = tile_load(Kg + ro, tid); a1 = tile_load(Vg + ro, tid); }
#endif
#pragma unroll
        for (int half = 0; half < 2; ++half) {
            const int j = 2 * st + half;
            const LAS unsigned char* Kt = lds + (st & 1) * 65536 + half * 32768; const LAS unsigned char* Vt = Kt + 16384;
            if (64 * j <= q0 + 31) {
                const int nmin = q0 - (64 * j + 63);
                const bool first = (mrun == -INFINITY);
                const float cinit = first ? 0.f : (nmin >= 113 ? bias_far - mrun : -mrun);
                f32x16 p0, p1;
#pragma unroll
                for (int r = 0; r < 16; ++r) { p0[r] = cinit; p1[r] = cinit; }
                bf16x8 kf[8];
#pragma unroll
                for (int ks = 0; ks < 4; ++ks) { const unsigned ch = (unsigned)(8 * map + 2 * ks + hi) ^ xr;
                    kf[2 * ks] = *(const LAS bf16x8*)(Kt + 256u * r32 + 16u * ch); kf[2 * ks + 1] = *(const LAS bf16x8*)(Kt + 256u * (32 + r32) + 16u * ch); }
                __builtin_amdgcn_sched_barrier(0);
#pragma unroll
                for (int ks = 0; ks < 4; ++ks) { p0 = __builtin_amdgcn_mfma_f32_32x32x16_bf16(kf[2 * ks], qf[ks], p0, 0, 0, 0); p1 = __builtin_amdgcn_mfma_f32_32x32x16_bf16(kf[2 * ks + 1], qf[ks], p1, 0, 0, 0); }
                __builtin_amdgcn_sched_barrier(0);
                float rm = -INFINITY;
                if (first) {
                    if (nmin >= 113) {
#pragma unroll
                        for (int r = 0; r < 16; ++r) { p0[r] = p0[r] + bias_far; p1[r] = p1[r] + bias_far; rm = fmaxf(rm, fmaxf(p0[r], p1[r])); }
                    } else {
                        const int nb0 = qrow - 64 * j - 4 * hi;
#pragma unroll
                        for (int r = 0; r < 16; ++r) { const int n0 = nb0 - ((r & 3) + 8 * (r >> 2)), n1 = n0 - 32;
                            p0[r] = (n0 >= 0) ? p0[r] + tbl[min(max(n0, 0), 127)] : -INFINITY; p1[r] = (n1 >= 0) ? p1[r] + tbl[min(max(n1, 0), 127)] : -INFINITY;
                            rm = fmaxf(rm, fmaxf(p0[r], p1[r])); }
                    }
                    { auto rr = __builtin_amdgcn_permlane32_swap(__float_as_uint(rm), __float_as_uint(rm), false, false); rm = fmaxf(__uint_as_float(rr[0]), __uint_as_float(rr[1])); }
                    mrun = rm;
#pragma unroll
                    for (int r = 0; r < 16; ++r) { p0[r] -= mrun; p1[r] -= mrun; }
                } else {
                    if (nmin < 113) {
                        const int nb0 = qrow - 64 * j - 4 * hi;
                        float bv0[16], bv1[16];
#pragma unroll
                        for (int r = 0; r < 16; ++r) { const int n0 = nb0 - ((r & 3) + 8 * (r >> 2)), n1 = n0 - 32; bv0[r] = tbl[min(max(n0, 0), 127)]; bv1[r] = tbl[min(max(n1, 0), 127)]; }
#pragma unroll
                        for (int r = 0; r < 16; ++r) { const int n0 = nb0 - ((r & 3) + 8 * (r >> 2)), n1 = n0 - 32;
                            p0[r] = (n0 >= 0) ? p0[r] + bv0[r] : -INFINITY; p1[r] = (n1 >= 0) ? p1[r] + bv1[r] : -INFINITY; }
                    }
                    { float m0 = fmaxf(p0[0], p1[0]), m1 = fmaxf(p0[1], p1[1]);
#pragma unroll
                      for (int r = 2; r < 16; r += 2) { m0 = __builtin_fmaxf(__builtin_fmaxf(m0, p0[r]), p1[r]); m1 = __builtin_fmaxf(__builtin_fmaxf(m1, p0[r + 1]), p1[r + 1]); }
                      rm = fmaxf(m0, m1); }
                    { auto rr = __builtin_amdgcn_permlane32_swap(__float_as_uint(rm), __float_as_uint(rm), false, false); rm = fmaxf(__uint_as_float(rr[0]), __uint_as_float(rr[1])); }
                    if (__any(rm > 8.0f)) {
                        const float dl = fmaxf(rm, 0.f); const float alpha = fast_exp2(-dl);
                        lrun *= alpha; mrun += dl;
#pragma unroll
                        for (int r = 0; r < 16; ++r) { p0[r] -= dl; p1[r] -= dl; }
#pragma unroll
                        for (int c = 0; c < 4; ++c)
#pragma unroll
                            for (int r = 0; r < 16; ++r) o[c][r] *= alpha;
                    }
                }
                float psa = 0.f, psb = 0.f;
                bf16x8 pf[4];
#define ATT_EXPK(ks_) do { u32x4 w_; _Pragma("unroll") for (int q = 0; q < 4; ++q) { const int r = 8 * ((ks_) & 1) + 2 * q; \
                        const float ea = fast_exp2((ks_) < 2 ? p0[r] : p1[r]), eb = fast_exp2((ks_) < 2 ? p0[r + 1] : p1[r + 1]); psa += ea; psb += eb; w_[q] = cvt_pk_bf16(ea, eb); } \
                    pf[ks_] = __builtin_bit_cast(bf16x8, w_); } while (0)
                bf16x8 vf[2][4];
#define ATT_LOADV(buf, ks_) do { _Pragma("unroll") for (int c = 0; c < 4; ++c) { const unsigned chv = (unsigned)(4 * c + 2 * blk + (pp >> 1)); const unsigned row0 = 16u * (ks_) + 4u * hi + q4; \
                        vf[buf][c] = cat8(vtr(Vt + off_b(row0, chv) + 8u * (pp & 1)), vtr(Vt + off_b(row0 + 8u, chv) + 8u * (pp & 1))); } } while (0)
                ATT_LOADV(0, 0);
                ATT_EXPK(0);
                if (ATT_LATE_DMA && half == 0 && st + 1 < NS) {
                    LAS unsigned char* nb = lds + ((st + 1) & 1) * 65536; const size_t ro = (size_t)(st + 1) * 128 * NP;
                    tile_dma(Kg + ro, nb, wave, lane); tile_dma(Vg + ro, nb + 16384, wave, lane); tile_dma(Kg + ro + (size_t)64 * NP, nb + 32768, wave, lane); tile_dma(Vg + ro + (size_t)64 * NP, nb + 49152, wave, lane); }
#pragma unroll
                for (int ks = 0; ks < 4; ++ks) {
                    if (ks < 3) ATT_LOADV((ks + 1) & 1, ks + 1);
                    __builtin_amdgcn_sched_barrier(0);
#pragma unroll
                    for (int c = 0; c < 4; ++c) o[c] = __builtin_amdgcn_mfma_f32_32x32x16_bf16(vf[ks & 1][c], pf[ks], o[c], 0, 0, 0);
                    if (ks < 3) { ATT_EXPK(ks + 1); asm volatile("" : "+v"(pf[(ks + 1) & 3]), "+v"(psa), "+v"(psb)); }
                    __builtin_amdgcn_sched_barrier(0);
                }
                lrun += psa + psb;
#undef ATT_EXPK
#undef ATT_LOADV
            }
#if ATT_DMA == 5
            if (half == 0) WAIT_ALL_BAR();
#endif
#if !ATT_DMA
            if (st + 1 < NS) { LAS unsigned char* nb = lds + ((st + 1) & 1) * 65536 + half * 32768; tile_write(nb, tid, a0); tile_write(nb + 16384, tid, a1);
                if (half == 0) { const size_t ro = (size_t)(st + 1) * 128 * NP + (size_t)64 * NP; a0 = tile_load(Kg + ro, tid); a1 = tile_load(Vg + ro, tid); } }
#endif
        }
#if ATT_DMA == 3
        WAIT_ALL_BAR();
        if (st + 1 < NS) { LAS unsigned char* nb = lds + ((st + 1) & 1) * 65536; const size_t ro = (size_t)(st + 1) * 128 * NP;
            tile_dma(Kg + ro, nb, wave, lane); tile_dma(Vg + ro, nb + 16384, wave, lane); tile_dma(Kg + ro + (size_t)64 * NP, nb + 32768, wave, lane); tile_dma(Vg + ro + (size_t)64 * NP, nb + 49152, wave, lane); }
#endif

    }
    WAIT_ALL_BAR();
    lrun += __shfl_xor(lrun, 32);
    const float inv = 1.0f / lrun;
    float lam;
    { float s1 = 0.f, s2 = 0.f; const float a1 = p.in[10][lane] * p.in[11][lane], a2 = p.in[12][lane] * p.in[13][lane]; s1 = wave_sum(a1); s2 = wave_sum(a2);
      const float lam_init = 0.8f - 0.6f * 1.0f;
      lam = expf(s1) - expf(s2) + lam_init; }
    LAS float* xch = (LAS float*)lds + qs * 4096;
    if (map == 1) {
#pragma unroll
        for (int c = 0; c < 4; ++c)
#pragma unroll
            for (int r = 0; r < 16; ++r) xch[(32 * c + crow(r, hi)) * 32 + r32] = o[c][r] * inv * lam;
    }
    __syncthreads();
    if (map == 0) {
        float ss = 0.f;
#pragma unroll
        for (int c = 0; c < 4; ++c)
#pragma unroll
            for (int r = 0; r < 16; ++r) { const float v = o[c][r] * inv - xch[(32 * c + crow(r, hi)) * 32 + r32]; o[c][r] = v; ss += v * v; }
        ss += __shfl_xor(ss, 32);
        const float rstd = 1.0f / sqrtf(ss * (1.0f / 128.0f) + NORM_EPS) * 0.8f;
        const float* sub = p.in[14];
        bf16_t* orow = CAT + (rowbase + qrow) * D + 512 + hd * 128;
#pragma unroll
        for (int c = 0; c < 4; ++c)
#pragma unroll
            for (int rq = 0; rq < 4; ++rq) { const int e0 = 32 * c + 8 * rq + 4 * hi; const f32x4 sv = *(const f32x4*)(sub + e0);
                u32x2 w; w.x = cvt_pk_bf16(o[c][4 * rq] * rstd * sv[0], o[c][4 * rq + 1] * rstd * sv[1]); w.y = cvt_pk_bf16(o[c][4 * rq + 2] * rstd * sv[2], o[c][4 * rq + 3] * rstd * sv[3]);
                *(u32x2*)(orow + e0) = w; }
    }
    __syncthreads();
}

__device__ __forceinline__ void mlstm_s1_unit(const Params& p, LAS unsigned char* lds, int bh, int c, int tid_, int wave, int lane_) {
    int tid = tid_; asm volatile("" : "+v"(tid)); const int lane = tid & 63;
    const bf16_t* P = (const bf16_t*)(p.ws + WS_P);
    const int b = bh >> 2, hd = bh & 3, r32 = lane & 31, hi = lane >> 5;
    const size_t t0 = (size_t)b * SEQ + (size_t)c * MCH;
    const float* SA = (const float*)(p.ws + WS_SA) + (size_t)bh * SEQ + c * MCH;
    LAS float* fs = (LAS float*)(lds + MISC_OFF) + MW_F;
    LAS float* wsm = fs;
    LAS float* red = fs + 256;
    float av = (tid < 256) ? SA[tid] : -INFINITY;
    float mx = av;
#pragma unroll
    for (int o = 1; o < 64; o <<= 1) mx = fmaxf(mx, __shfl_xor(mx, o));
    if (lane == 0) red[wave] = mx;
    __syncthreads();
    float R = red[0];
#pragma unroll
    for (int w = 1; w < 4; ++w) R = fmaxf(R, red[w]);
    if (tid < 256) wsm[tid] = __expf(av - R) * 0.08838834764831845f;
    __syncthreads();
    LAS unsigned char* Kl = lds; LAS unsigned char* Vl = lds + 65536;
    const bf16_t* Kg = P + t0 * NP + P_MK + hd * 128; const bf16_t* Vg = P + t0 * NP + P_MV + hd * 128;
#pragma unroll
    for (int i = 0; i < 8; ++i) { const int n = tid + 512 * i, row = n >> 4, ch = n & 15;
        const u32x4 kv = *(const u32x4*)(Kg + (size_t)row * NP + ch * 8); const u32x4 vv = *(const u32x4*)(Vg + (size_t)row * NP + ch * 8);
        const float w = wsm[row]; u32x4 ks;
#pragma unroll
        for (int q = 0; q < 4; ++q) ks[q] = cvt_pk_bf16(bf_lo(kv[q]) * w, bf_hi(kv[q]) * w);
        *(LAS u32x4*)(Kl + off_b(row, ch)) = ks; *(LAS u32x4*)(Vl + off_b(row, ch)) = vv; }
    __syncthreads();
    const int eb = wave >> 1, dh = wave & 1;
    const unsigned q4 = (lane & 15) >> 2, pp = lane & 3, blk = (lane >> 4) & 1;
    f32x16 acc[2]; acc[0] = (f32x16){}; acc[1] = (f32x16){};
    for (int ks = 0; ks < 16; ++ks) {
        const unsigned row0 = 16u * ks + 8u * hi + q4, row1 = row0 + 4u;
        const unsigned cha = (unsigned)(4 * eb + 2 * blk + (pp >> 1));
        const bf16x8 af = cat8(vtr(Vl + off_b(row0, cha) + 8u * (pp & 1)), vtr(Vl + off_b(row1, cha) + 8u * (pp & 1)));
#pragma unroll
        for (int db = 0; db < 2; ++db) { const unsigned chb = (unsigned)(4 * (2 * dh + db) + 2 * blk + (pp >> 1));
            const bf16x8 bfr = cat8(vtr(Kl + off_b(row0, chb) + 8u * (pp & 1)), vtr(Kl + off_b(row1, chb) + 8u * (pp & 1)));
            acc[db] = __builtin_amdgcn_mfma_f32_32x32x16_bf16(af, bfr, acc[db], 0, 0, 0); }
    }
    const int unit = bh * NCH + c;
    float* UT = (float*)(p.ws + WS_UT) + (size_t)unit * 16384;
#pragma unroll
    for (int db = 0; db < 2; ++db)
#pragma unroll
        for (int r = 0; r < 16; ++r) UT[(32 * eb + crow(r, hi)) * 128 + 64 * dh + 32 * db + r32] = acc[db][r];
    if (tid < 128) { float s = 0.f; const int d = tid;
        for (int srow = 0; srow < 256; ++srow) { const unsigned short hv = *(const LAS unsigned short*)(Kl + off_b(srow, d >> 3) + (d & 7) * 2); s += __uint_as_float((unsigned)hv << 16); }
        ((float*)(p.ws + WS_UN))[(size_t)unit * 128 + d] = s; }
    if (tid == 0) ((float*)(p.ws + WS_UR))[unit] = R;
    __syncthreads();
}

__device__ __forceinline__ void mlstm_s3_unit(const Params& p, LAS unsigned char* lds, int bh, int c, int tid_, int wave, int lane_) {
    int tid = tid_; asm volatile("" : "+v"(tid)); const int lane = tid & 63;
    const bf16_t* P = (const bf16_t*)(p.ws + WS_P); bf16_t* CAT = (bf16_t*)(p.ws + WS_CAT);
    const int b = bh >> 2, hd = bh & 3, r32 = lane & 31, hi = lane >> 5;
    const size_t t0 = (size_t)b * SEQ + (size_t)c * MCH;
    const size_t so = (size_t)bh * SEQ + c * MCH;
    const float* SA = (const float*)(p.ws + WS_SA) + so; const float* SAM = (const float*)(p.ws + WS_SAM) + so; const float* SBA = (const float*)(p.ws + WS_SBA) + so;
    LAS float* fs = (LAS float*)(lds + MISC_OFF) + MW_F;
    LAS float* as = fs;
    LAS float* nC = fs + 256;
    LAS unsigned char* Ct = lds + 65536;
    const int qloc = 32 * wave + r32;
    const float Aq = SAM[qloc], BAq = SBA[qloc];
    if (tid < 256) as[tid] = SA[tid];
    bf16x8 qf[8];
    { const bf16_t* qp = P + (t0 + qloc) * NP + P_MQ + hd * 128 + hi * 8;
#pragma unroll
      for (int ks = 0; ks < 8; ++ks) qf[ks] = *(const bf16x8*)(qp + ks * 16); }
    const bf16_t* Kg = P + t0 * NP + P_MK + hd * 128; const bf16_t* Vg = P + t0 * NP + P_MV + hd * 128;
#if defined(S3_REGSTAGE)
    { TileRegs k0 = tile_load(Kg, tid), v0 = tile_load(Vg, tid); tile_write(lds, tid, k0); tile_write(lds + 16384, tid, v0); }
#elif !defined(S3_SERIAL)
    tile_dma(Kg, lds, wave, lane); tile_dma(Vg, lds + 16384, wave, lane);
#endif
    f32x16 o[4];
#pragma unroll
    for (int cb = 0; cb < 4; ++cb) o[cb] = (f32x16){};
    float den = 0.f, fst = 0.f;
    const unsigned xr = ((unsigned)(r32 & 3) << 2) | ((unsigned)(r32 >> 2) & 3u);
    if (c > 0) {
        const float* UR = (const float*)(p.ws + WS_UR) + bh * NCH; const float* UT = (const float*)(p.ws + WS_UT) + (size_t)bh * NCH * 16384; const float* UN = (const float*)(p.ws + WS_UN) + (size_t)bh * NCH * 128;
        float Pref = -INFINITY, ur[7];
#pragma unroll
        for (int j = 0; j < 7; ++j) { ur[j] = UR[j]; if (j < c) Pref = fmaxf(Pref, ur[j]); }
        float cf[7];
#pragma unroll
        for (int j = 0; j < 7; ++j) cf[j] = (j < c) ? __expf(ur[j] - Pref) : 0.f;
#pragma unroll 1
        for (int i = 0; i < 4; ++i) { const int n = tid + 512 * i, e = n >> 4, ch = n & 15; f32x4 u0[7], u1[7];
#pragma unroll
            for (int j = 0; j < 7; ++j) { const f32x4* up = (const f32x4*)(UT + (size_t)j * 16384 + e * 128 + ch * 8); u0[j] = up[0]; u1[j] = up[1]; }
            f32x4 s0 = (f32x4){0.f, 0.f, 0.f, 0.f}, s1 = s0;
#pragma unroll
            for (int j = 0; j < 7; ++j) { s0 += u0[j] * cf[j]; s1 += u1[j] * cf[j]; }
            u32x4 w; w.x = cvt_pk_bf16(s0[0], s0[1]); w.y = cvt_pk_bf16(s0[2], s0[3]); w.z = cvt_pk_bf16(s1[0], s1[1]); w.w = cvt_pk_bf16(s1[2], s1[3]);
            *(LAS u32x4*)(Ct + off_b(e, ch)) = w; }
        if (tid < 128) { float sN = 0.f;
#pragma unroll
            for (int j = 0; j < 7; ++j) sN += cf[j] * UN[j * 128 + tid];
            nC[tid] = sN; }
        fst = __expf(Pref - Aq);
    }
    asm volatile("" :: "v"(qf[0]), "v"(qf[1]), "v"(qf[2]), "v"(qf[3]), "v"(qf[4]), "v"(qf[5]), "v"(qf[6]), "v"(qf[7]), "v"(Aq), "v"(BAq));
    WAIT_ALL_BAR();
    if (c > 0) {
#pragma unroll
        for (int cb = 0; cb < 4; ++cb) {
#pragma unroll
            for (int ks = 0; ks < 8; ++ks) { const unsigned ch = (unsigned)(2 * ks + hi) ^ xr;
                const bf16x8 cfr = *(const LAS bf16x8*)(Ct + 256u * (32 * cb + r32) + 16u * ch);
                o[cb] = __builtin_amdgcn_mfma_f32_32x32x16_bf16(cfr, qf[ks], o[cb], 0, 0, 0); }
            __builtin_amdgcn_sched_barrier(0); }
#pragma unroll
        for (int cb = 0; cb < 4; ++cb)
#pragma unroll
            for (int r = 0; r < 16; ++r) o[cb][r] *= fst;
        float dq = 0.f;
#pragma unroll
        for (int ks = 0; ks < 8; ++ks)
#pragma unroll
            for (int q = 0; q < 4; ++q) { const unsigned w = ((const unsigned*)&qf[ks])[q]; const int d = 16 * ks + 8 * hi + 2 * q; dq += bf_lo(w) * nC[d] + bf_hi(w) * nC[d + 1]; }
        den = fst * dq;
    }
    const unsigned q4 = (lane & 15) >> 2, pp = lane & 3, blk = (lane >> 4) & 1;
#pragma unroll 1
    for (int j = 0; j < 4; ++j) {
        WAIT_ALL_BAR();
        const LAS unsigned char* Kt = lds + (j & 1) * 32768; const LAS unsigned char* Vt = Kt + 16384;
#if defined(S3_REGSTAGE)
        TileRegs kr, vr; if (j + 1 < 4) { kr = tile_load(Kg + (size_t)(j + 1) * 64 * NP, tid); vr = tile_load(Vg + (size_t)(j + 1) * 64 * NP, tid); }
#elif defined(S3_SERIAL)
        { LAS unsigned char* nb = lds + (j & 1) * 32768; tile_dma(Kg + (size_t)j * 64 * NP, nb, wave, lane); tile_dma(Vg + (size_t)j * 64 * NP, nb + 16384, wave, lane); }
        WAIT_ALL_BAR();
#else
        if (j + 1 < 4) { LAS unsigned char* nb = lds + ((j + 1) & 1) * 32768; tile_dma(Kg + (size_t)(j + 1) * 64 * NP, nb, wave, lane); tile_dma(Vg + (size_t)(j + 1) * 64 * NP, nb + 16384, wave, lane); }
#endif
        const bool doit = (64 * j <= 32 * wave + 31);
        bf16x8 pf[4];
        if (doit) {
            f32x16 p0 = (f32x16){}, p1 = (f32x16){};
#pragma unroll
            for (int ks = 0; ks < 8; ++ks) { const unsigned ch = (unsigned)(2 * ks + hi) ^ xr;
                const bf16x8 k0 = *(const LAS bf16x8*)(Kt + 256u * r32 + 16u * ch), k1 = *(const LAS bf16x8*)(Kt + 256u * (32 + r32) + 16u * ch);
                p0 = __builtin_amdgcn_mfma_f32_32x32x16_bf16(k0, qf[ks], p0, 0, 0, 0); p1 = __builtin_amdgcn_mfma_f32_32x32x16_bf16(k1, qf[ks], p1, 0, 0, 0); if ((ks & 3) == 3) __builtin_amdgcn_sched_barrier(0); }
            float ps = 0.f;
#pragma unroll
            for (int r = 0; r < 16; ++r) { const int kv = 64 * j + crow(r, hi);
                const float w0 = (kv <= qloc) ? __expf(as[kv] - Aq) * 0.08838834764831845f : 0.f, w1 = (kv + 32 <= qloc) ? __expf(as[kv + 32] - Aq) * 0.08838834764831845f : 0.f;
                p0[r] *= w0; p1[r] *= w1; ps += p0[r] + p1[r]; }
            den += ps;
#pragma unroll
            for (int ks = 0; ks < 4; ++ks) { u32x4 w;
#pragma unroll
                for (int q = 0; q < 4; ++q) { const int r = 8 * (ks & 1) + 2 * q; w[q] = (ks < 2) ? cvt_pk_bf16(p0[r], p0[r + 1]) : cvt_pk_bf16(p1[r], p1[r + 1]); }
                pf[ks] = __builtin_bit_cast(bf16x8, w); }
        }
        WAIT_ALL_BAR();
        if (doit) {
            bf16x8 vf[2][4];
#define S3_LOADV(buf, ks_) do { _Pragma("unroll") for (int cb = 0; cb < 4; ++cb) { const unsigned chv = (unsigned)(4 * cb + 2 * blk + (pp >> 1)); const unsigned row0 = 16u * (ks_) + 4u * hi + q4; \
                vf[buf][cb] = cat8(vtr(Vt + off_b(row0, chv) + 8u * (pp & 1)), vtr(Vt + off_b(row0 + 8u, chv) + 8u * (pp & 1))); } } while (0)
            S3_LOADV(0, 0);
#pragma unroll
            for (int ks = 0; ks < 4; ++ks) {
                if (ks < 3) S3_LOADV((ks + 1) & 1, ks + 1);
                __builtin_amdgcn_sched_barrier(0);
#pragma unroll
                for (int cb = 0; cb < 4; ++cb) o[cb] = __builtin_amdgcn_mfma_f32_32x32x16_bf16(vf[ks & 1][cb], pf[ks], o[cb], 0, 0, 0);
                __builtin_amdgcn_sched_barrier(0);
            }
#undef S3_LOADV
        }
#if defined(S3_REGSTAGE)
        if (j + 1 < 4) { LAS unsigned char* nb = lds + ((j + 1) & 1) * 32768; tile_write(nb, tid, kr); tile_write(nb + 16384, tid, vr); }
#endif
    }
    den += __shfl_xor(den, 32);
    const float dinv = 1.0f / fmaxf(fabsf(den), __expf(-BAq));
    float sm = 0.f;
#pragma unroll
    for (int cb = 0; cb < 4; ++cb)
#pragma unroll
        for (int r = 0; r < 16; ++r) { o[cb][r] *= dinv; sm += o[cb][r]; }
    sm += __shfl_xor(sm, 32);
    const float mu = sm * (1.0f / 128.0f);
    float vs = 0.f;
#pragma unroll
    for (int cb = 0; cb < 4; ++cb)
#pragma unroll
        for (int r = 0; r < 16; ++r) { o[cb][r] -= mu; vs += o[cb][r] * o[cb][r]; }
    vs += __shfl_xor(vs, 32);
    const float rstd = 1.0f / sqrtf(vs * (1.0f / 128.0f) + NORM_EPS);
    const float* hn = p.in[9] + hd * 128;
    const bf16_t* mo = P + (t0 + qloc) * NP + P_MO + hd * 128;
    bf16_t* orow = CAT + (t0 + qloc) * D + hd * 128;
    u32x2 mw[4][4];
#pragma unroll
    for (int cb = 0; cb < 4; ++cb)
#pragma unroll
        for (int rq = 0; rq < 4; ++rq) mw[cb][rq] = *(const u32x2*)(mo + 32 * cb + 8 * rq + 4 * hi);
#pragma unroll
    for (int cb = 0; cb < 4; ++cb)
#pragma unroll
        for (int rq = 0; rq < 4; ++rq) { const int e0 = 32 * cb + 8 * rq + 4 * hi; const f32x4 hv = *(const f32x4*)(hn + e0); const u32x2 m2 = mw[cb][rq];
            const float g0 = fast_rcp(1.0f + __expf(-bf_lo(m2.x))), g1 = fast_rcp(1.0f + __expf(-bf_hi(m2.x))), g2 = fast_rcp(1.0f + __expf(-bf_lo(m2.y))), g3 = fast_rcp(1.0f + __expf(-bf_hi(m2.y)));
            u32x2 w; w.x = cvt_pk_bf16(o[cb][4 * rq] * rstd * hv[0] * g0, o[cb][4 * rq + 1] * rstd * hv[1] * g1); w.y = cvt_pk_bf16(o[cb][4 * rq + 2] * rstd * hv[2] * g2, o[cb][4 * rq + 3] * rstd * hv[3] * g3);
            *(u32x2*)(orow + e0) = w; }
    WAIT_ALL_BAR();
}

__device__ __forceinline__ void mlstm_seq_unit(const Params& p, LAS unsigned char* lds, int bh, int tid_, int wave, int lane_) {
    int tid = tid_; asm volatile("" : "+v"(tid)); const int lane = tid & 63;
    const bf16_t* P = (const bf16_t*)(p.ws + WS_P); bf16_t* CAT = (bf16_t*)(p.ws + WS_CAT);
    const int b = bh >> 2, hd = bh & 3, r32 = lane & 31, hi = lane >> 5;
    LAS float* fs = (LAS float*)(lds + MISC_OFF) + MW_F;
    LAS float* as = fs;
    LAS float* nC = fs + 256;
    LAS float* wsc = fs + 384;
    LAS unsigned char* Ct = lds + 65536;
    const unsigned xr = ((unsigned)(r32 & 3) << 2) | ((unsigned)(r32 >> 2) & 3u);
    const unsigned q4 = (lane & 15) >> 2, pp = lane & 3, blk = (lane >> 4) & 1;
    const int eb = wave >> 1, dh = wave & 1;
    f32x16 cacc[2]; cacc[0] = (f32x16){}; cacc[1] = (f32x16){};
    float nrun = 0.f;
    float Prun = -INFINITY;
    LAS float* hnl = fs + 896;
    if (tid < 128) hnl[tid] = p.in[9][hd * 128 + tid];
#pragma unroll 1
    for (int c = 0; c < NCH; ++c) {
        const size_t t0 = (size_t)b * SEQ + (size_t)c * MCH;
        const size_t so = (size_t)bh * SEQ + c * MCH;
        const float* SA = (const float*)(p.ws + WS_SA) + so; const float* SAM = (const float*)(p.ws + WS_SAM) + so; const float* SBA = (const float*)(p.ws + WS_SBA) + so;
        const int qloc = 32 * wave + r32;
        const float Aq2 = SAM[qloc] * 1.4426950408889634f;
        if (tid < 256) as[tid] = SA[tid] * 1.4426950408889634f;
        bf16x8 qf[2];
        LAS bf16x8* qpark = (LAS bf16x8*)(lds + 98304 + tid * 64);
        LAS bf16x8* qpark2 = (LAS bf16x8*)(lds + 147456 + tid * 32);
        { const bf16_t* qp = P + (t0 + qloc) * NP + P_MQ + hd * 128 + hi * 8;
#pragma unroll
          for (int ks = 0; ks < 2; ++ks) qf[ks] = *(const bf16x8*)(qp + ks * 16);
#pragma unroll
          for (int ks = 2; ks < 6; ++ks) qpark[ks - 2] = *(const bf16x8*)(qp + ks * 16);
#pragma unroll
          for (int ks = 6; ks < 8; ++ks) qpark2[ks - 6] = *(const bf16x8*)(qp + ks * 16); }
#define QFRAG(ks) ((ks) < 2 ? qf[(ks) & 1] : ((ks) < 6 ? qpark[((ks) - 2) & 3] : qpark2[((ks) - 6) & 1]))
        const bf16_t* Kg = P + t0 * NP + P_MK + hd * 128; const bf16_t* Vg = P + t0 * NP + P_MV + hd * 128;
        tile_dma(Kg, lds, wave, lane); tile_dma(Vg, lds + 16384, wave, lane);
        asm volatile("" :: "v"(qf[0]), "v"(qf[1]), "v"(Aq2));
        WAIT_ALL_BAR();
        float R = fmaxf(fmaxf(as[lane], as[lane + 64]), fmaxf(as[lane + 128], as[lane + 192]));
#pragma unroll
        for (int o = 1; o < 64; o <<= 1) R = fmaxf(R, __shfl_xor(R, o));
        R *= (1.0f / 1.4426950408889634f);
        const float Pnew = fmaxf(Prun, R);
        const float scC = (c > 0) ? __expf(Prun - Pnew) : 0.f;
        if (tid < 256) wsc[tid] = fast_exp2(as[tid] - Pnew * 1.4426950408889634f) * 0.08838834764831845f;
        f32x16 o[4];
#pragma unroll
        for (int cb = 0; cb < 4; ++cb) o[cb] = (f32x16){};
        float den = 0.f;
        if (c > 0) {
#pragma unroll
            for (int cb = 0; cb < 4; ++cb) {
#pragma unroll
                for (int ks = 0; ks < 8; ++ks) { const unsigned ch = (unsigned)(2 * ks + hi) ^ xr;
                    const bf16x8 cfr = *(const LAS bf16x8*)(Ct + 256u * (32 * cb + r32) + 16u * ch);
                    const bf16x8 qv = QFRAG(ks);
                    o[cb] = __builtin_amdgcn_mfma_f32_32x32x16_bf16(cfr, qv, o[cb], 0, 0, 0); }
                __builtin_amdgcn_sched_barrier(0); }
            const float fst = fast_exp2(Prun * 1.4426950408889634f - Aq2);
#pragma unroll
            for (int cb = 0; cb < 4; ++cb)
#pragma unroll
                for (int r = 0; r < 16; ++r) o[cb][r] *= fst;
            float dq = 0.f;
#pragma unroll
            for (int ks = 0; ks < 8; ++ks) { const bf16x8 qv = QFRAG(ks);
#pragma unroll
                for (int q = 0; q < 4; ++q) { const unsigned w = ((const unsigned*)&qv)[q]; const int d = 16 * ks + 8 * hi + 2 * q; dq += bf_lo(w) * nC[d] + bf_hi(w) * nC[d + 1]; } }
            den = fst * dq;
#pragma unroll
            for (int r = 0; r < 16; ++r) { cacc[0][r] *= scC; cacc[1][r] *= scC; }
        }
        nrun *= scC;
#pragma unroll 1
        for (int j = 0; j < 4; ++j) {
            WAIT_ALL_BAR();
            const LAS unsigned char* Kt = lds + (j & 1) * 32768; const LAS unsigned char* Vt = Kt + 16384;
            if (j + 1 < 4) { LAS unsigned char* nb = lds + ((j + 1) & 1) * 32768; tile_dma(Kg + (size_t)(j + 1) * 64 * NP, nb, wave, lane); tile_dma(Vg + (size_t)(j + 1) * 64 * NP, nb + 16384, wave, lane); }
            const bool doit = (64 * j <= 32 * wave + 31);
            if (doit) {
                float ps = 0.f;
#pragma unroll
                for (int hf = 0; hf < 2; ++hf) {
                    f32x16 pp0 = (f32x16){};
#pragma unroll
                    for (int ks = 0; ks < 8; ++ks) { const unsigned ch = (unsigned)(2 * ks + hi) ^ xr;
                        const bf16x8 k0 = *(const LAS bf16x8*)(Kt + 256u * (32 * hf + r32) + 16u * ch);
                        const bf16x8 qv = QFRAG(ks);
                        pp0 = __builtin_amdgcn_mfma_f32_32x32x16_bf16(k0, qv, pp0, 0, 0, 0); }
#pragma unroll
                    for (int r = 0; r < 16; ++r) { const int kv = 64 * j + 32 * hf + crow(r, hi);
                        const float w0 = (kv <= qloc) ? fast_exp2(as[kv] - Aq2) * 0.08838834764831845f : 0.f;
                        pp0[r] *= w0; ps += pp0[r]; }
                    bf16x8 pfh[2];
#pragma unroll
                    for (int k2 = 0; k2 < 2; ++k2) { u32x4 w;
#pragma unroll
                        for (int q = 0; q < 4; ++q) { const int r = 8 * k2 + 2 * q; w[q] = cvt_pk_bf16(pp0[r], pp0[r + 1]); }
                        pfh[k2] = __builtin_bit_cast(bf16x8, w); }
                    __builtin_amdgcn_sched_barrier(0);
#pragma unroll
                    for (int k2 = 0; k2 < 2; ++k2)
#pragma unroll
                        for (int c2 = 0; c2 < 2; ++c2) {
                            bf16x8 vf[2];
#pragma unroll
                            for (int u = 0; u < 2; ++u) { const int cb = 2 * c2 + u; const unsigned chv = (unsigned)(4 * cb + 2 * blk + (pp >> 1)); const unsigned row0 = 16u * (2 * hf + k2) + 4u * hi + q4;
                                vf[u] = cat8(vtr(Vt + off_b(row0, chv) + 8u * (pp & 1)), vtr(Vt + off_b(row0 + 8u, chv) + 8u * (pp & 1))); }
                            o[2 * c2] = __builtin_amdgcn_mfma_f32_32x32x16_bf16(vf[0], pfh[k2], o[2 * c2], 0, 0, 0); o[2 * c2 + 1] = __builtin_amdgcn_mfma_f32_32x32x16_bf16(vf[1], pfh[k2], o[2 * c2 + 1], 0, 0, 0);
                            __builtin_amdgcn_sched_barrier(0);
                        }
                }
                den += ps;
            }
#pragma unroll
            for (int ks = 0; ks < 4; ++ks) {
                const unsigned row0 = 16u * ks + 8u * hi + q4, row1 = row0 + 4u;
                const unsigned cha = (unsigned)(4 * eb + 2 * blk + (pp >> 1));
                const bf16x8 af = cat8(vtr(Vt + off_b(row0, cha) + 8u * (pp & 1)), vtr(Vt + off_b(row1, cha) + 8u * (pp & 1)));
                const f32x4 wa = *(const LAS f32x4*)(wsc + 64 * j + 16 * ks + 8 * hi), wb = *(const LAS f32x4*)(wsc + 64 * j + 16 * ks + 8 * hi + 4);
#pragma unroll
                for (int db = 0; db < 2; ++db) { const unsigned chb = (unsigned)(4 * (2 * dh + db) + 2 * blk + (pp >> 1));
                    const s16x4 k0 = vtr(Kt + off_b(row0, chb) + 8u * (pp & 1)), k1 = vtr(Kt + off_b(row1, chb) + 8u * (pp & 1));
                    const u32x2 u0 = __builtin_bit_cast(u32x2, k0), u1 = __builtin_bit_cast(u32x2, k1);
                    u32x4 kw; kw.x = cvt_pk_bf16(bf_lo(u0.x) * wa[0], bf_hi(u0.x) * wa[1]); kw.y = cvt_pk_bf16(bf_lo(u0.y) * wa[2], bf_hi(u0.y) * wa[3]);
                    kw.z = cvt_pk_bf16(bf_lo(u1.x) * wb[0], bf_hi(u1.x) * wb[1]); kw.w = cvt_pk_bf16(bf_lo(u1.y) * wb[2], bf_hi(u1.y) * wb[3]);
                    cacc[db] = __builtin_amdgcn_mfma_f32_32x32x16_bf16(af, __builtin_bit_cast(bf16x8, kw), cacc[db], 0, 0, 0); }
                __builtin_amdgcn_sched_barrier(0);
            }
            { const int d = tid & 127, sq = tid >> 7; float sN = 0.f;
#pragma unroll 4
                for (int s2 = 0; s2 < 16; ++s2) { const int srow = 16 * sq + s2; const unsigned short hv = *(const LAS unsigned short*)(Kt + off_b(srow, d >> 3) + (d & 7) * 2); sN += __uint_as_float((unsigned)hv << 16) * wsc[64 * j + srow]; }
                nrun += sN; }
            WAIT_ALL_BAR();
        }
        int tid2 = tid_; asm volatile("" : "+v"(tid2));
        const int qloc2 = 32 * wave + (tid2 & 31), hi2 = (tid2 >> 5) & 1;
        const float BAq = SBA[qloc2];
        den += __shfl_xor(den, 32);
        const float dinv = 1.0f / fmaxf(fabsf(den), __expf(-BAq));
        float sm = 0.f;
#pragma unroll
        for (int cb = 0; cb < 4; ++cb)
#pragma unroll
            for (int r = 0; r < 16; ++r) { o[cb][r] *= dinv; sm += o[cb][r]; }
        sm += __shfl_xor(sm, 32);
        const float mu = sm * (1.0f / 128.0f);
        float vs = 0.f;
#pragma unroll
        for (int cb = 0; cb < 4; ++cb)
#pragma unroll
            for (int r = 0; r < 16; ++r) { o[cb][r] -= mu; vs += o[cb][r] * o[cb][r]; }
        vs += __shfl_xor(vs, 32);
        const float rstd = 1.0f / sqrtf(vs * (1.0f / 128.0f) + NORM_EPS);
        const bf16_t* mo = P + (t0 + qloc2) * NP + P_MO + hd * 128 + 4 * hi2;
        bf16_t* orow = CAT + (t0 + qloc2) * D + hd * 128 + 4 * hi2;
#pragma unroll
        for (int c2 = 0; c2 < 2; ++c2) {
            u32x2 mw[8];
#pragma unroll
            for (int u = 0; u < 8; ++u) mw[u] = *(const u32x2*)(mo + 32 * (2 * c2 + (u >> 2)) + 8 * (u & 3));
#pragma unroll
            for (int u = 0; u < 8; ++u) { const int cb = 2 * c2 + (u >> 2), rq = u & 3; const int e0 = 32 * cb + 8 * rq; const u32x2 m2 = mw[u]; const f32x4 hv = *(const LAS f32x4*)(hnl + e0 + 4 * hi2);
                const float g0 = fast_rcp(1.0f + fast_exp2(-1.4426950408889634f * bf_lo(m2.x))), g1 = fast_rcp(1.0f + fast_exp2(-1.4426950408889634f * bf_hi(m2.x))), g2 = fast_rcp(1.0f + fast_exp2(-1.4426950408889634f * bf_lo(m2.y))), g3 = fast_rcp(1.0f + fast_exp2(-1.4426950408889634f * bf_hi(m2.y)));
                u32x2 w; w.x = cvt_pk_bf16(o[cb][4 * rq] * rstd * hv[0] * g0, o[cb][4 * rq + 1] * rstd * hv[1] * g1); w.y = cvt_pk_bf16(o[cb][4 * rq + 2] * rstd * hv[2] * g2, o[cb][4 * rq + 3] * rstd * hv[3] * g3);
                *(u32x2*)(orow + e0) = w; }
            __builtin_amdgcn_sched_barrier(0); }
        if (c + 1 < NCH) {
#pragma unroll
            for (int db = 0; db < 2; ++db)
#pragma unroll
                for (int r = 0; r < 16; ++r) { const int e = 32 * eb + crow(r, hi), d = 64 * dh + 32 * db + r32;
                    *(LAS unsigned short*)(Ct + off_b(e, d >> 3) + (d & 7) * 2) = (unsigned short)(cvt_pk_bf16(cacc[db][r], 0.f) & 0xffffu); }
            wsc[tid] = nrun;
        }
        Prun = Pnew;
        WAIT_ALL_BAR();
        if (c + 1 < NCH) { if (tid < 128) nC[tid] = (wsc[tid] + wsc[tid + 128]) + (wsc[tid + 256] + wsc[tid + 384]); }
    }
#undef QFRAG
}

__device__ __forceinline__ int moe_table(LAS unsigned char* lds, unsigned* cnt, int tid) {
    LAS int* misc = (LAS int*)(lds + MISC_OFF);
    __syncthreads();
    if (tid == 0) { int acc = 0; for (int e = 0; e < 16; ++e) { const int c = (int)__hip_atomic_load(cnt + e * 64, __ATOMIC_RELAXED, __HIP_MEMORY_SCOPE_AGENT); misc[MW_CN + e] = c; misc[MW_TB + e] = acc; acc += (c + 255) >> 8; } misc[MW_TB + 16] = acc; }
    __syncthreads();
    return misc[MW_TB + 16];
}

#ifndef STAGGER_MASK
#define STAGGER_MASK 0u
#endif
#ifndef STAGGER_GROUPS
#define STAGGER_GROUPS 4
#endif
#ifndef STAGGER_TICKS
#define STAGGER_TICKS 700
#endif
__device__ __forceinline__ void stagger(int vcu, int phase_bit) {
    if (!((STAGGER_MASK >> phase_bit) & 1u)) return;
    const int g = vcu & (STAGGER_GROUPS - 1); if (g == 0) return;
    const unsigned long long t0 = __builtin_amdgcn_s_memrealtime(); const unsigned long long w = (unsigned long long)g * STAGGER_TICKS;
    while (__builtin_amdgcn_s_memrealtime() - t0 < w) __builtin_amdgcn_s_sleep(8);
}
template <int LAYER>
__device__ __forceinline__ void moe_block(const Params& p, LAS unsigned char* lds, const XcdBarrier& bar, unsigned* ctl, int tid, int wave, int lane, int vcu, int G) {
    unsigned char* ws = p.ws;
    const LAS int* tb = (const LAS int*)(lds + MISC_OFF) + MW_TB; const LAS int* cn = (const LAS int*)(lds + MISC_OFF) + MW_CN;
    unsigned* cnt = ctl + CW_CNT + LAYER * 16 * 64;
    if (PH(12)) phase_router(p, lds, tid, wave, G, p.in[3] + LAYER * D, p.in[18] + (size_t)LAYER * D * 4, p.in[19] + LAYER * 4, p.in[20] + (size_t)LAYER * D * 16, p.in[21] + LAYER * 16, cnt);
    xcd_barrier(bar);
    const int ntot = moe_table(lds, cnt, tid);
    stagger(vcu, 13);
    for (int rep_ = 0; rep_ < REPS(13); ++rep_) if (PH(13)) { pg8::MoeSched<true> S{(const char*)(ws + WS_XB8), (const char*)(ws + WS_WGU) + (size_t)LAYER * 16 * 1024 * 1024, 512, (size_t)1024 * 1024, tb, cn, (const unsigned*)(ws + WS_ROWTOK), ntot, vcu, G};
      pg8::EpiPair<1> E{nullptr, (bf16_t*)(ws + WS_HM), FF, (const float*)(ws + WS_RSRAW), (const unsigned*)(ws + WS_ROWTOK), tb, cn};
      pg8::gemm_phase<pg8::EpiPair<1>, pg8::MoeSched<true>, true, true>(lds, 512, S, E); }
    xcd_barrier(bar);
    stagger(vcu, 14);
    for (int rep_ = 0; rep_ < REPS(14); ++rep_) if (PH(14)) { pg8::MoeSched<false> S{(const char*)(ws + WS_HM), (const char*)(ws + WS_WD) + (size_t)LAYER * 16 * 1024 * 512, 256, (size_t)1024 * 512, tb, cn, nullptr, ntot, vcu, G};
      pg8::EpiDown E{(unsigned char*)(ws + WS_YC), (const float*)(ws + WS_CWRAW), tb, cn};
      pg8::gemm_phase<pg8::EpiDown, pg8::MoeSched<false>, false, true>(lds, 256, S, E); }
    xcd_barrier(bar);
}

__global__ void __launch_bounds__(NTHR, 2) fwd_kernel(Params p) {
    extern __shared__ __attribute__((aligned(16))) unsigned char lds_raw[];
    LAS unsigned char* lds = (LAS unsigned char*)lds_raw;
    const int tid = threadIdx.x, lane = tid & 63, wave = __builtin_amdgcn_readfirstlane(tid >> 6);
    const int G = gridDim.x; const int bx = blockIdx.x;
    const int vcu = (G % 8 == 0) ? (bx % 8) * (G / 8) + bx / 8 : bx;
    const int gw = vcu * NWAVES + wave, NGW = G * NWAVES;
    volatile LAS unsigned* misc = (volatile LAS unsigned*)(lds + MISC_OFF);
    for (int u = tid; u < (LDS_BYTES - MISC_OFF) / 4; u += NTHR) misc[u] = 0u;
    __syncthreads();
    unsigned* ctl = (unsigned*)(p.ws + WS_CTL);
    XcdBarrier bar = xcd_barrier_post(ctl + CW_BAR, misc + MW_BAR);
    unsigned char* ws = p.ws;

    for (int rep_ = 0; rep_ < REPS(0); ++rep_) if (PH(0)) phase_prologue_weights(p, lds, gw, WT_I1, NGW, wave, lane);
    __syncthreads();
    for (int rep_ = 0; rep_ < REPS(1); ++rep_) if (PH(1)) phase_norm_gates(p, lds, tid, gw, NGW, lane);
    xcd_barrier(bar);

    if (PH(2)) phase_gate_scan(p, gw, NGW, lane);
    stagger(vcu, 3);
    for (int rep_ = 0; rep_ < REPS(3); ++rep_) if (PH(3)) { pg8::DenseSched S; S.init(ws + WS_H, ws + WS_WT1, T, NP, 1024, G, bx); pg8::EpiBf16 E{(bf16_t*)(ws + WS_P), NP};
      pg8::gemm_phase<pg8::EpiBf16, pg8::DenseSched, false>(lds, 1024, S, E); }
    xcd_barrier(bar);

    {
        constexpr int NSEQ = NBATCH * 4, NAT = NBATCH * 4 * 16, NMEM = WT_UNITS;
        for (int u = bx; u < NSEQ; u += G) { for (int r2 = 0; r2 < REPS(16); ++r2) if (PH(4)) mlstm_seq_unit(p, lds, u, tid, wave, lane); }
        for (int rep_ = 0; rep_ < REPS(4); ++rep_) {
            bool a_done = false, m_done = false; int sa_cnt = 0, sm_cnt = 0; (void)sa_cnt; (void)sm_cnt;
            for (int it = 0; !(a_done && m_done); ++it) {
                const int r5 = it % 5; bool want_mem = (r5 == 1 || r5 == 3);
                if (want_mem && m_done) want_mem = false; else if (!want_mem && a_done) want_mem = true;
                __syncthreads();
#ifdef STATIC_Q
                if (tid == 0) { misc[MW_Q] = (unsigned)((want_mem ? sm_cnt : sa_cnt) * G + bx); }
                if (want_mem) ++sm_cnt; else ++sa_cnt;
#else
                if (tid == 0) misc[MW_Q] = __hip_atomic_fetch_add(ctl + CW_QUEUE + 64 * (2 * rep_ + (want_mem ? 1 : 0)), 1u, __ATOMIC_RELAXED, __HIP_MEMORY_SCOPE_AGENT);
#endif
                __syncthreads();
                const int u = (int)misc[MW_Q];
                if (want_mem) {
                    if (u >= NMEM) { m_done = true; continue; }
                    { const int v = u; for (int r2 = 0; r2 < REPS(18); ++r2) if (PH(0)) { const int f = WT_I1 + 64 * v + 8 * wave; phase_prologue_weights(p, lds, f, f + 8, 1, wave, lane); } }
                } else {
                    if (u >= NAT) { a_done = true; continue; }
                    for (int r2 = 0; r2 < REPS(17); ++r2) if (PH(5)) attn_unit(p, lds, u & 127, 15 - (u >> 7), tid, wave, lane);
                }
            }
        }
    }
    xcd_barrier(bar);

    for (int rep_ = 0; rep_ < REPS(7); ++rep_) if (PH(7)) { pg8::DenseSched S; S.init(ws + WS_CAT, ws + WS_WT2, T, 1024, 1024, G, bx); pg8::EpiResid<true> E{p.in[0], (bf16_t*)(ws + WS_XB), ws + WS_XB8};
      pg8::gemm_phase<pg8::EpiResid<true>, pg8::DenseSched, false>(lds, 1024, S, E); }
    xcd_barrier(bar);

    moe_block<0>(p, lds, bar, ctl, tid, wave, lane, vcu, G);
    if (PH(8)) phase_rows<0, true>(p, lds, tid, wave, lane, G, p.in[2] + D, nullptr, nullptr, nullptr, nullptr, ctl + CW_CNT, nullptr);
    xcd_barrier(bar);
    stagger(vcu, 9);
    for (int rep_ = 0; rep_ < REPS(9); ++rep_) if (PH(9)) { pg8::DenseSched S; S.init(G3_F8 ? ws + WS_XB8 : ws + WS_XB, ws + WS_WT3, T, 3072, G3_F8 ? 512 : 1024, G, bx); pg8::EpiPair<0> E{(bf16_t*)(ws + WS_BG), (bf16_t*)(ws + WS_Z), D, (const float*)(ws + WS_RSTD), nullptr, nullptr, nullptr};
      pg8::gemm_phase<pg8::EpiPair<0>, pg8::DenseSched, false, G3_F8 != 0>(lds, G3_F8 ? 512 : 1024, S, E); }
    xcd_barrier(bar);
    for (int rep_ = 0; rep_ < REPS(10); ++rep_) if (PH(10)) phase_conv(p, gw, NGW, lane);
    xcd_barrier(bar);
    if (PH(11)) { pg8::DenseSched S; S.init(ws + WS_CAT, ws + WS_WT4, T, 1024, 1024, G, bx); pg8::EpiResid<false> E{nullptr, (bf16_t*)(ws + WS_XB), ws + WS_XB8};
      pg8::gemm_phase<pg8::EpiResid<false>, pg8::DenseSched, false>(lds, 1024, S, E); }
    xcd_barrier(bar);
    moe_block<1>(p, lds, bar, ctl, tid, wave, lane, vcu, G);
    if (PH(15)) phase_rows<2, true>(p, lds, tid, wave, lane, G, p.in[4], nullptr, nullptr, nullptr, nullptr, ctl + CW_CNT + 16 * 64, nullptr);
}

extern "C" void kernel_launch(void* const* d_in, const int* in_sizes, int n_in, void* d_out, int out_size, void* d_ws, size_t ws_size, hipStream_t stream) {
    static int grid = 0;
    if (grid == 0) {
        if (n_in != 25 || in_sizes[0] != T * D || out_size != T * D || ws_size < WS_END) { fprintf(stderr, "kernel_launch: unexpected shapes (n_in %d, in0 %d, out %d, ws %zu)\n", n_in, n_in > 0 ? in_sizes[0] : -1, out_size, ws_size); grid = -1; return; }
        int dev = 0, cus = 0, per_cu = 0;
        if (hipGetDevice(&dev) != hipSuccess || hipDeviceGetAttribute(&cus, hipDeviceAttributeMultiprocessorCount, dev) != hipSuccess) { grid = -1; return; }
        if (hipFuncSetAttribute((const void*)fwd_kernel, hipFuncAttributeMaxDynamicSharedMemorySize, LDS_BYTES) != hipSuccess) { fprintf(stderr, "kernel_launch: hipFuncSetAttribute failed\n"); grid = -1; return; }
        if (hipOccupancyMaxActiveBlocksPerMultiprocessor(&per_cu, (const void*)fwd_kernel, NTHR, LDS_BYTES) != hipSuccess || per_cu < 1) fprintf(stderr, "kernel_launch: occupancy query reports %d\n", per_cu);
        (void)hipGetLastError();
        grid = cus;
    }
    if (grid < 0) return;
    hipMemsetAsync((char*)d_ws + WS_CTL, 0, CTL_ZERO_BYTES, stream);
    Params p{};
    for (int i = 0; i < 25; ++i) p.in[i] = (const float*)d_in[i];
    p.out = (float*)d_out; p.ws = (unsigned char*)d_ws;
    hipLaunchKernelGGL(fwd_kernel, dim3(grid), dim3(NTHR), LDS_BYTES, stream, p);
}
```

```cpp
#include <hip/hip_runtime.h>
#include <cstdio>
#include <cstdint>
#ifndef PHASE_MASK
#define PHASE_MASK 0xffffffffu
#endif
#define PH(k) (((PHASE_MASK) >> (k)) & 1u)
#ifndef PHASE_TWICE
#define PHASE_TWICE 0u
#endif
#define REPS(k) (1 + (int)(((PHASE_TWICE) >> (k)) & 1u))

#define LAS __attribute__((address_space(3)))
#define GAS __attribute__((address_space(1)))
typedef unsigned short bf16_t;
typedef short bf16x8 __attribute__((ext_vector_type(8)));
typedef short s16x4 __attribute__((ext_vector_type(4)));
typedef float f32x4 __attribute__((ext_vector_type(4)));
typedef float f32x2 __attribute__((ext_vector_type(2)));
typedef float f32x16 __attribute__((ext_vector_type(16)));
typedef unsigned u32x4 __attribute__((ext_vector_type(4)));
typedef unsigned u32x2 __attribute__((ext_vector_type(2)));
typedef GAS unsigned gu32;
typedef int i32x8 __attribute__((ext_vector_type(8)));
typedef int i32x4 __attribute__((ext_vector_type(4)));

constexpr int D = 1024, NBATCH = 32, SEQ = 2048, T = NBATCH * SEQ;
constexpr int EVEN_IN = 3592, NP = 3584;
constexpr int P_MQ = 0, P_MK = 512, P_MV = 1024, P_MO = 1536, P_DQ = 2048, P_DK = 2560, P_DV = 3072;
constexpr int NE = 16, FF = 512;
constexpr int ECAP = 65536;
constexpr float NORM_EPS = 1e-6f;
constexpr int NWAVES = 8, NTHR = 512;
constexpr int MCH = 256, NCH = SEQ / MCH;
constexpr int WT_I1 = 16 * 112, WT_ITEMS = 28928, WT_UNITS = (WT_ITEMS - WT_I1) / 64;

constexpr size_t MiB = 1u << 20;
constexpr size_t WS_CTL = 0, CTL_ZERO_BYTES = 1 * MiB;
constexpr size_t WS_WT1 = 1 * MiB, WS_WT2 = 8 * MiB, WS_WT3 = 10 * MiB, WS_WT4 = 16 * MiB, WS_WGU = 18 * MiB, WS_WD = 82 * MiB;
constexpr size_t WS_GATES = 114 * MiB, WS_SA = 116 * MiB, WS_SAM = 117 * MiB, WS_SBA = 118 * MiB, WS_UN = 119 * MiB, WS_UR = 119 * MiB + 768 * 1024;
constexpr size_t WS_UT = 120 * MiB;
constexpr size_t WS_ROWTOK = 184 * MiB, WS_CWRAW = 188 * MiB, WS_TOKINFO = 192 * MiB, WS_RSTD = 193 * MiB;
constexpr size_t WS_H = 194 * MiB, WS_CAT = 322 * MiB, WS_P = 450 * MiB;
constexpr size_t WS_RSRAW = 120 * MiB;
constexpr size_t WS_XB8 = 720 * MiB;
constexpr size_t WS_XB = WS_H;
constexpr size_t WS_BG = WS_P, WS_Z = WS_P + 128 * MiB, WS_HM = WS_P, WS_YC = WS_P + 136 * MiB;
constexpr size_t WS_END = 898 * MiB;
constexpr int CW_BAR = 4096;
constexpr int CW_CNT = 16384;
constexpr int CW_QUEUE = 32768;

__device__ __forceinline__ unsigned cvt_pk_bf16(float lo, float hi) { unsigned r; asm volatile("v_cvt_pk_bf16_f32 %0, %1, %2" : "=v"(r) : "v"(lo), "v"(hi)); return r; }
__device__ __forceinline__ unsigned cvt_pk4_fp8(float a, float b, float c, float d) { unsigned w = 0; w = (unsigned)__builtin_amdgcn_cvt_pk_fp8_f32(a, b, (int)w, false); w = (unsigned)__builtin_amdgcn_cvt_pk_fp8_f32(c, d, (int)w, true); return w; }
#ifndef G3_F8
#define G3_F8 1
#endif
constexpr float F8_WSCALE = 64.0f, F8_HSCALE = 16.0f, F8_YSCALE = 64.0f;
__device__ __forceinline__ float bf_lo(unsigned w) { return __uint_as_float(w << 16); }
__device__ __forceinline__ float bf_hi(unsigned w) { return __uint_as_float(w & 0xffff0000u); }
__device__ __forceinline__ float wave_sum(float v) {
#pragma unroll
    for (int o = 1; o < 64; o <<= 1) v += __shfl_xor(v, o);
    return v;
}
__device__ __forceinline__ float fast_exp2(float x) { return __builtin_amdgcn_exp2f(x); }
__device__ __forceinline__ float fast_rcp(float x) { return __builtin_amdgcn_rcpf(x); }
__device__ __forceinline__ int crow(int r, int hi) { return (r & 3) + 8 * (r >> 2) + 4 * hi; }
__device__ __forceinline__ unsigned off_b(unsigned row, unsigned ch) { return 256u * row + 16u * (ch ^ (((row & 3u) << 2) | ((row >> 2) & 3u))); }
__device__ __forceinline__ s16x4 vtr(const LAS unsigned char* p) { return __builtin_bit_cast(s16x4, __builtin_amdgcn_ds_read_tr16_b64_v4i16((LAS s16x4*)p)); }
__device__ __forceinline__ bf16x8 cat8(s16x4 a, s16x4 b) { return (bf16x8){a[0], a[1], a[2], a[3], b[0], b[1], b[2], b[3]}; }

#define XB_TMO      128
#define XB_XCNT(j)  (256  + 64 * (j))
#define XB_XSUB(j)  (1280 + 64 * (j))
#define XB_XGEN(j)  (2304 + 64 * (j))
#define XB_TOP      3328
#define XB_TOPGEN   3392
#define XCD_BAR_WORDS 3456
#define XB_SPIN_CAP (1u << 18)
__device__ __forceinline__ unsigned xb_ld(unsigned* p)              { return __hip_atomic_load(p, __ATOMIC_RELAXED, __HIP_MEMORY_SCOPE_AGENT); }
__device__ __forceinline__ unsigned xb_add(unsigned* p, unsigned v) { return __hip_atomic_fetch_add(p, v, __ATOMIC_RELAXED, __HIP_MEMORY_SCOPE_AGENT); }
__device__ __forceinline__ unsigned xb_xcc_id() { return (unsigned)__builtin_amdgcn_s_getreg((3 << 11) | 20) & 0xFu; }
#define XB_SPIN(cond, bar) do { unsigned _sp = 0; while (cond) { __builtin_amdgcn_s_sleep(1); \
    if ((++_sp & 255u) == 0u) { if (xb_ld(&(bar)[XB_TMO])) break; if (_sp > XB_SPIN_CAP) { atomicAdd(&(bar)[XB_TMO], 1u); break; } } } } while (0)
struct XcdBarrier { unsigned* bar; unsigned x; volatile LAS unsigned* st; };
__device__ __forceinline__ XcdBarrier xcd_barrier_post(unsigned* bar, volatile LAS unsigned* st) {
    XcdBarrier b; b.bar = bar; b.x = xb_xcc_id(); b.st = st;
    if (threadIdx.x == 0) (void)xb_add(&bar[XB_XCNT(b.x)], 1u);
    return b;
}
__device__ __forceinline__ void xcd_barrier_complete(unsigned* bar, unsigned x, unsigned& nloc, unsigned& nx) {
    const unsigned G = gridDim.x * gridDim.y * gridDim.z;
    unsigned sum, cnt, mine, sp = 0u;
    for (;;) {
        sum = 0u; cnt = 0u; mine = 0u;
#pragma unroll
        for (unsigned j = 0; j < 16; ++j) { const unsigned c = xb_ld(&bar[XB_XCNT(j)]); sum += c; cnt += (c > 0u) ? 1u : 0u; mine = (j == x) ? c : mine; }
        if (sum == G) break;
        __builtin_amdgcn_s_sleep(1);
        if ((++sp & 255u) == 0u) { if (xb_ld(&bar[XB_TMO])) break; if (sp > XB_SPIN_CAP) { atomicAdd(&bar[XB_TMO], 1u); break; } }
    }
    nloc = mine > 0u ? mine : 1u; nx = cnt > 0u ? cnt : 1u;
}
__device__ __forceinline__ void xcd_barrier(const XcdBarrier& b) {
    asm volatile("s_waitcnt vmcnt(0)" ::: "memory");
    __syncthreads();
    if (threadIdx.x == 0) {
        unsigned* bar = b.bar;
        __builtin_amdgcn_s_waitcnt(0);
        unsigned nloc = b.st[0], nx = b.st[1];
        if (nloc == 0u) { xcd_barrier_complete(bar, b.x, nloc, nx); b.st[0] = nloc; b.st[1] = nx; }
        const unsigned old = xb_add(&bar[XB_XSUB(b.x)], 1u);
        const unsigned gen = old / nloc;
        if (old + 1u == (gen + 1u) * nloc) {
            __builtin_amdgcn_fence(__ATOMIC_RELEASE, "agent");
            asm volatile("s_waitcnt vmcnt(0)" ::: "memory");
            const unsigned og = xb_add(&bar[XB_TOP], 1u);
            const unsigned tg = og / nx;
            if (og + 1u == (tg + 1u) * nx) xb_add(&bar[XB_TOPGEN], 1u);
            else XB_SPIN(xb_ld(&bar[XB_TOPGEN]) == tg, bar);
            __builtin_amdgcn_fence(__ATOMIC_ACQUIRE, "agent");
            xb_add(&bar[XB_XGEN(b.x)], 1u);
            asm volatile("s_waitcnt vmcnt(0)" ::: "memory");
        } else {
            XB_SPIN(xb_ld(&bar[XB_XGEN(b.x)]) == gen, bar);
            __builtin_amdgcn_fence(__ATOMIC_ACQUIRE, "agent");
            asm volatile("s_waitcnt vmcnt(0)" ::: "memory");
        }
    }
    __syncthreads();
}

namespace pg8 {
constexpr int BM = 256, BK = 64, HALF = 128, HTB = HALF * BK * 2, STAGE_BYTES = 8 * HTB, NXCD = 8, WGM = 8;
__device__ __forceinline__ int lds_byte(int r, int c) { const int st = (r >> 4) * 2 + (c >> 5), rr = r & 15, cc = c & 31, ob = rr * 64 + cc * 2; return st * 1024 + (ob ^ (((ob >> 9) & 1) << 5)); }
__device__ __forceinline__ void stage_rc(int b, int& R, int& C) { const int st = b / 1024, sb = b % 1024, swz = sb ^ (((sb >> 9) & 1) << 5); R = (st >> 1) * 16 + swz / 64; C = (st & 1) * 32 + (swz % 64) / 2; }
__device__ __forceinline__ int perm32(int rho) { const int n = rho >> 4, i = rho & 15; return 8 * (i >> 2) + 4 * n + (i & 3); }
struct Unit { int pm, pn; };

template <class Epi, class Sched, bool GATHER, bool F8 = false>
__device__ __forceinline__ void gemm_phase(LAS unsigned char* lds, const int K, const Sched& S, const Epi& E) {
    int tid = threadIdx.x; asm volatile("" : "+v"(tid));
    const int wid = __builtin_amdgcn_readfirstlane(tid >> 6), lane = tid & 63, wr = wid >> 2, wc = wid & 3, fr = lane & 15, fq = lane >> 4;
    const int nt = K / BK;
    int Rr[2], Cc[2]; unsigned voffB[2];
#pragma unroll
    for (int i = 0; i < 2; ++i) { stage_rc(tid * 16 + i * 8192, Rr[i], Cc[i]); const int Rb = Epi::PERM ? ((Rr[i] & ~31) + perm32(Rr[i] & 31)) : Rr[i];
        voffB[i] = (unsigned)(Rb * K + Cc[i]) * 2u; }
    const size_t kstep = (size_t)(BK * 2);
    const size_t hstep = (size_t)HALF * K * 2;
    const unsigned ldsw = (unsigned)wid * 1024u;
    const int aoff = lds_byte(wr * 64 + fr, fq * 8), boff = lds_byte(wc * 32 + fr, fq * 8);
#define PG8_SA(b, h) (((b) * 2 + (h)) * HTB)
#define PG8_SB(b, h) ((4 + (b) * 2 + (h)) * HTB)
#define PG8_STAGE(bufoff, gbase, voff) do { _Pragma("unroll") for (int _i = 0; _i < 2; ++_i) \
        __builtin_amdgcn_global_load_lds((const unsigned*)((const char*)(gbase) + (voff)[_i]), (LAS unsigned*)(lds + (bufoff) + ldsw + _i * 8192), 16, 0, 0); } while (0)
#define PG8_LD8(p) __builtin_shufflevector(*(const LAS i32x4*)(p), *(const LAS i32x4*)((p) + 1024), 0, 1, 2, 3, 4, 5, 6, 7)
#define PG8_LDA(dst, b, h) do { if constexpr (F8) { _Pragma("unroll") for (int m = 0; m < 4; ++m) dst##8[m] = PG8_LD8(lds + PG8_SA(b, h) + aoff + m * 2048); } \
        else { _Pragma("unroll") for (int m = 0; m < 4; ++m) _Pragma("unroll") for (int k = 0; k < 2; ++k) dst[m][k] = *(const LAS bf16x8*)(lds + PG8_SA(b, h) + aoff + m * 2048 + k * 1024); } } while (0)
#define PG8_LDB(dst, b, h) do { if constexpr (F8) { _Pragma("unroll") for (int n = 0; n < 2; ++n) dst##8[n] = PG8_LD8(lds + PG8_SB(b, h) + boff + n * 2048); } \
        else { _Pragma("unroll") for (int n = 0; n < 2; ++n) _Pragma("unroll") for (int k = 0; k < 2; ++k) dst[n][k] = *(const LAS bf16x8*)(lds + PG8_SB(b, h) + boff + n * 2048 + k * 1024); } } while (0)
#define PG8_CAT8(x0, x1) __builtin_shufflevector(__builtin_bit_cast(i32x4, x0), __builtin_bit_cast(i32x4, x1), 0, 1, 2, 3, 4, 5, 6, 7)
#define PG8_MMA(ai, bj, At, Bt) do { __builtin_amdgcn_s_setprio(1); _Pragma("unroll") for (int m = 0; m < 4; ++m) _Pragma("unroll") for (int n = 0; n < 2; ++n) { \
        if constexpr (F8) asm volatile("v_mfma_scale_f32_16x16x128_f8f6f4 %0, %1, %2, %0, %3, %3 op_sel_hi:[0,0,0]" : "+v"(acc[ai][bj][m][n]) : "v"(Bt##8[n]), "v"(At##8[m]), "v"(f8one)); \
        else { _Pragma("unroll") for (int k = 0; k < 2; ++k) acc[ai][bj][m][n] = __builtin_amdgcn_mfma_f32_16x16x32_bf16(Bt[n][k], At[m][k], acc[ai][bj][m][n], 0, 0, 0); } } __builtin_amdgcn_s_setprio(0); } while (0)
#define PG8_WAIT_V(n) asm volatile("s_waitcnt vmcnt(" #n ")" ::: "memory")
#define PG8_WAIT_L(n) asm volatile("s_waitcnt lgkmcnt(" #n ")" ::: "memory")
#define PG8_BAR __builtin_amdgcn_s_barrier()
#define PG8_SCHED __builtin_amdgcn_sched_barrier(0)
#define PG8_VOFF(dst, u) do { _Pragma("unroll") for (int _h = 0; _h < 2; ++_h) _Pragma("unroll") for (int _i = 0; _i < 2; ++_i) { \
        if constexpr (GATHER) dst[_h][_i] = S.arow(u, _h * HALF + Rr[_i]) * (unsigned)(K * 2) + (unsigned)(Cc[_i] * 2); \
        else dst[_h][_i] = (unsigned)((_h * HALF + Rr[_i]) * K + Cc[_i]) * 2u; } } while (0)
    Unit cur, nxt; int ui = 0;
    if (!S.next(0, cur)) return;
    f32x4 acc[2][2][4][2];
    if constexpr (Epi::PRELOAD) E.preload(acc, cur, wr, wc, fr, fq);
    else {
#pragma unroll
    for (int a = 0; a < 2; ++a)
#pragma unroll
        for (int b = 0; b < 2; ++b)
#pragma unroll
            for (int m = 0; m < 4; ++m)
#pragma unroll
                for (int n = 0; n < 2; ++n) acc[a][b][m][n] = (f32x4){0.f, 0.f, 0.f, 0.f};
    }
    float epf[2][4] = {{0.f, 0.f, 0.f, 0.f}, {0.f, 0.f, 0.f, 0.f}};
    bf16x8 At[4][2], B0[2][2], B1[2][2];
    i32x8 At8[4], B08[2], B18[2]; const unsigned f8one = 0x7f7f7f7fu;
    unsigned vA[2][2], vN[2][2];
    PG8_VOFF(vA, cur);
    if constexpr (Epi::PREFETCH) E.prefetch(epf, cur, wr, fr);
    const char* cA = S.abase(cur); const char* cB = S.bbase(cur);
    PG8_STAGE(PG8_SB(0, 0), cB, voffB); PG8_STAGE(PG8_SB(0, 1), cB + hstep, voffB); PG8_STAGE(PG8_SA(0, 0), cA, vA[0]); PG8_STAGE(PG8_SA(0, 1), cA, vA[1]);
    if (wr == 1) PG8_BAR;
    PG8_WAIT_V(2); PG8_BAR;
    PG8_STAGE(PG8_SB(1, 0), cB + kstep, voffB); PG8_STAGE(PG8_SA(1, 0), cA + kstep, vA[0]); PG8_STAGE(PG8_SB(1, 1), cB + hstep + kstep, voffB);
    PG8_WAIT_V(6); PG8_BAR;
    for (;;) {
        const bool has_next = S.next(ui + 1, nxt);
        const char* nA = has_next ? S.abase(nxt) : cA; const char* nB = has_next ? S.bbase(nxt) : cB;
        if constexpr (GATHER) { if (has_next) { PG8_VOFF(vN, nxt); } else {
#pragma unroll
            for (int h = 0; h < 2; ++h)
#pragma unroll
                for (int i = 0; i < 2; ++i) vN[h][i] = vA[h][i]; } }
#pragma unroll 1
        for (int t = 0; t < nt; t += 2) {
            const bool last = (t == nt - 2);
            const char* a1 = cA + (size_t)(t + 1) * kstep;
            const char* a2 = last ? nA : cA + (size_t)(t + 2) * kstep; const char* b2 = last ? nB : cB + (size_t)(t + 2) * kstep;
            const char* a3 = a2 + kstep; const char* b3 = b2 + kstep;
            unsigned v2[2][2]; const unsigned lmask = last ? 0xffffffffu : 0u;
#pragma unroll
            for (int h = 0; h < 2; ++h)
#pragma unroll
                for (int i = 0; i < 2; ++i) { if constexpr (GATHER) v2[h][i] = (vN[h][i] & lmask) | (vA[h][i] & ~lmask); else v2[h][i] = vA[h][i]; }
            PG8_LDB(B0, 0, 0); PG8_LDB(B1, 0, 1); PG8_SCHED; PG8_LDA(At, 0, 0); PG8_STAGE(PG8_SA(1, 1), a1, vA[1]);
            PG8_WAIT_V(8); PG8_WAIT_L(0); PG8_BAR; PG8_MMA(0, 0, At, B0); PG8_MMA(0, 1, At, B1); PG8_BAR; PG8_SCHED;
            PG8_LDA(At, 0, 1); PG8_STAGE(PG8_SB(0, 0), b2, voffB); PG8_STAGE(PG8_SB(0, 1), b2 + hstep, voffB); PG8_STAGE(PG8_SA(0, 0), a2, v2[0]);
            PG8_WAIT_V(8); PG8_WAIT_L(0); PG8_BAR; PG8_MMA(1, 0, At, B0); PG8_MMA(1, 1, At, B1); PG8_BAR; PG8_SCHED;
            PG8_LDB(B0, 1, 0); PG8_LDB(B1, 1, 1); PG8_SCHED; PG8_LDA(At, 1, 0); PG8_STAGE(PG8_SA(0, 1), a2, v2[1]);
            PG8_WAIT_V(8); PG8_WAIT_L(0); PG8_BAR; PG8_MMA(0, 0, At, B0); PG8_MMA(0, 1, At, B1); PG8_BAR; PG8_SCHED;
            PG8_LDA(At, 1, 1); PG8_STAGE(PG8_SB(1, 0), b3, voffB); PG8_STAGE(PG8_SB(1, 1), b3 + hstep, voffB); PG8_STAGE(PG8_SA(1, 0), a3, v2[0]);
            PG8_WAIT_V(8); PG8_WAIT_L(0); PG8_BAR; PG8_MMA(1, 0, At, B0); PG8_MMA(1, 1, At, B1); PG8_BAR; PG8_SCHED;
        }
        if (wr == 0) PG8_BAR;
        if constexpr (F8) asm volatile("s_nop 15\n\ts_nop 15" ::: "memory");
        if constexpr (Epi::PREFETCH) E(acc, cur, wr, wc, fr, fq, epf); else E(acc, cur, wr, wc, fr, fq);
        if (!has_next) break;
        if constexpr (Epi::PREFETCH) E.prefetch(epf, nxt, wr, fr);
        if constexpr (Epi::PRELOAD) E.preload(acc, nxt, wr, wc, fr, fq);
        else {
#pragma unroll
        for (int a = 0; a < 2; ++a)
#pragma unroll
            for (int b = 0; b < 2; ++b)
#pragma unroll
                for (int m = 0; m < 4; ++m)
#pragma unroll
                    for (int n = 0; n < 2; ++n) acc[a][b][m][n] = (f32x4){0.f, 0.f, 0.f, 0.f};
        }
        cur = nxt; cA = nA; cB = nB; ++ui;
        if constexpr (GATHER) {
#pragma unroll
        for (int h = 0; h < 2; ++h)
#pragma unroll
            for (int i = 0; i < 2; ++i) vA[h][i] = vN[h][i]; }
        if (wr == 1) PG8_BAR;
    }
    PG8_WAIT_V(0);
    PG8_BAR;
#undef PG8_SA
#undef PG8_SB
#undef PG8_STAGE
#undef PG8_LDA
#undef PG8_LD8
#undef PG8_LDB
#undef PG8_MMA
#undef PG8_CAT8
#undef PG8_WAIT_V
#undef PG8_WAIT_L
#undef PG8_BAR
#undef PG8_SCHED
#undef PG8_VOFF
}

struct DenseSched {
    const char* A; const char* Bt; int K; int nM, nN, nwg, G, c;
    __device__ __forceinline__ void init(const void* A_, const void* Bt_, int M, int N, int K_, int G_, int c_) { A = (const char*)A_; Bt = (const char*)Bt_; K = K_; nM = M / BM; nN = N / BM; nwg = nM * nN; G = G_; c = c_; }
    __device__ __forceinline__ bool next(int i, Unit& u) const {
        const long L = (long)i * G + c; if (L >= nwg) return false;
        int wgid = (int)L; { const int q = nwg / NXCD, r = nwg % NXCD, xcd = wgid % NXCD, off = wgid / NXCD; wgid = (xcd < r ? xcd * (q + 1) : r * (q + 1) + (xcd - r) * q) + off; }
        const int nig = WGM * nN, gid = wgid / nig, fm = gid * WGM, gsz = (nM - fm) < WGM ? (nM - fm) : WGM;
        u.pm = fm + ((wgid % nig) % gsz); u.pn = (wgid % nig) / gsz; return true;
    }
    __device__ __forceinline__ const char* abase(const Unit& u) const { return A + (size_t)u.pm * BM * K * 2; }
    __device__ __forceinline__ const char* bbase(const Unit& u) const { return Bt + (size_t)u.pn * BM * K * 2; }
    __device__ __forceinline__ unsigned arow(const Unit&, int) const { return 0u; }
};
template <bool GATHER_A>
struct MoeSched {
    const char* A; const char* W; int K; size_t wstride; const LAS int* tb; const LAS int* cn; const unsigned* rowtok; int ntot, vcu, G;
    __device__ __forceinline__ bool next(int i, Unit& u) const { const int L = i * G + vcu; if (L >= ntot * 4) return false; u.pm = L >> 2; u.pn = L & 3; return true; }
    __device__ __forceinline__ int expert(int pm) const { int e = 0;
#pragma unroll
        for (int j = 1; j < 16; ++j) e += (pm >= tb[j]) ? 1 : 0; return e; }
    __device__ __forceinline__ const char* abase(const Unit& u) const { return GATHER_A ? A : A + (size_t)u.pm * BM * K * 2; }
    __device__ __forceinline__ const char* bbase(const Unit& u) const { return W + (size_t)expert(u.pm) * wstride + (size_t)u.pn * BM * K * 2; }
    __device__ __forceinline__ unsigned arow(const Unit& u, int r) const { const int e = expert(u.pm); const int idx = (u.pm - tb[e]) * BM + r; return idx < cn[e] ? rowtok[(size_t)e * ECAP + idx] : 0u; }
};

struct EpiBf16 {
    static constexpr bool PERM = true, PRELOAD = false, PREFETCH = false;
    bf16_t* O; int ldc;
    __device__ __forceinline__ void operator()(const f32x4 (&acc)[2][2][4][2], const Unit& u, int wr, int wc, int fr, int fq) const {
        const int row0 = u.pm * BM + wr * 64 + fr, col0 = u.pn * BM + wc * 32 + 8 * fq;
#pragma unroll
        for (int ai = 0; ai < 2; ++ai)
#pragma unroll
            for (int m = 0; m < 4; ++m) { bf16_t* rowp = O + (size_t)(row0 + ai * HALF + m * 16) * ldc + col0;
#pragma unroll
                for (int bj = 0; bj < 2; ++bj) { const f32x4 v0 = acc[ai][bj][m][0], v1 = acc[ai][bj][m][1];
                    u32x4 w; w.x = cvt_pk_bf16(v0[0], v0[1]); w.y = cvt_pk_bf16(v0[2], v0[3]); w.z = cvt_pk_bf16(v1[0], v1[1]); w.w = cvt_pk_bf16(v1[2], v1[3]);
#ifdef EPI_NT
                    __builtin_nontemporal_store(w, (u32x4*)(rowp + bj * HALF));
#else
                    *(u32x4*)(rowp + bj * HALF) = w;
#endif
                } }
    }
};
template <bool XF32>
struct EpiResid {
    static constexpr bool PERM = true, PRELOAD = true, PREFETCH = false;
    const float* xin; bf16_t* XB; unsigned char* XB8;
    __device__ __forceinline__ void preload(f32x4 (&acc)[2][2][4][2], const Unit& u, int wr, int wc, int fr, int fq) const {
        const int row0 = u.pm * BM + wr * 64 + fr, col0 = u.pn * BM + wc * 32 + 8 * fq;
#pragma unroll
        for (int ai = 0; ai < 2; ++ai)
#pragma unroll
            for (int m = 0; m < 4; ++m) { const size_t off = (size_t)(row0 + ai * HALF + m * 16) * D + col0;
#pragma unroll
                for (int bj = 0; bj < 2; ++bj) {
                    if (XF32) { acc[ai][bj][m][0] = *(const f32x4*)(xin + off + bj * HALF); acc[ai][bj][m][1] = *(const f32x4*)(xin + off + bj * HALF + 4); }
                    else { const u32x4 w = *(const u32x4*)(XB + off + bj * HALF); acc[ai][bj][m][0] = (f32x4){bf_lo(w.x), bf_hi(w.x), bf_lo(w.y), bf_hi(w.y)}; acc[ai][bj][m][1] = (f32x4){bf_lo(w.z), bf_hi(w.z), bf_lo(w.w), bf_hi(w.w)}; } } }
    }
    __device__ __forceinline__ void operator()(const f32x4 (&acc)[2][2][4][2], const Unit& u, int wr, int wc, int fr, int fq) const {
        const int row0 = u.pm * BM + wr * 64 + fr, col0 = u.pn * BM + wc * 32 + 8 * fq;
#pragma unroll
        for (int ai = 0; ai < 2; ++ai)
#pragma unroll
            for (int m = 0; m < 4; ++m) { bf16_t* rowp = XB + (size_t)(row0 + ai * HALF + m * 16) * D + col0;
#pragma unroll
                for (int bj = 0; bj < 2; ++bj) { const f32x4 v0 = acc[ai][bj][m][0], v1 = acc[ai][bj][m][1];
                    u32x4 w; w.x = cvt_pk_bf16(v0[0], v0[1]); w.y = cvt_pk_bf16(v0[2], v0[3]); w.z = cvt_pk_bf16(v1[0], v1[1]); w.w = cvt_pk_bf16(v1[2], v1[3]);
                    *(u32x4*)(rowp + bj * HALF) = w;
                    u32x2 w8; w8.x = cvt_pk4_fp8(bf_lo(w.x), bf_hi(w.x), bf_lo(w.y), bf_hi(w.y)); w8.y = cvt_pk4_fp8(bf_lo(w.z), bf_hi(w.z), bf_lo(w.w), bf_hi(w.w));
                    *(u32x2*)(XB8 + (size_t)(row0 + ai * HALF + m * 16) * D + col0 + bj * HALF) = w8; } }
    }
};
template <int MODE  >
struct EpiPair {
    static constexpr bool PERM = true, PRELOAD = false, PREFETCH = true;
    bf16_t* O0; bf16_t* O1; int ld1;
    const float* rstd; const unsigned* rowtok; const LAS int* tb; const LAS int* cn;
    __device__ __forceinline__ void prefetch(float (&rs)[2][4], const Unit& u, int wr, int fr) const {
        const int row0 = u.pm * BM + wr * 64 + fr;
        if (MODE == 0) {
#pragma unroll
            for (int ai = 0; ai < 2; ++ai)
#pragma unroll
                for (int m = 0; m < 4; ++m) rs[ai][m] = rstd[row0 + ai * HALF + m * 16] * (G3_F8 ? 1.0f / F8_WSCALE : 1.0f);
        } else {
            int e = 0;
#pragma unroll
            for (int j = 1; j < 16; ++j) e += (u.pm >= tb[j]) ? 1 : 0;
            const int idx0 = (u.pm - tb[e]) * BM + wr * 64 + fr, cne = cn[e];
#pragma unroll
            for (int ai = 0; ai < 2; ++ai)
#pragma unroll
                for (int m = 0; m < 4; ++m) { const int idx = idx0 + ai * HALF + m * 16; rs[ai][m] = idx < cne ? rstd[(size_t)e * ECAP + idx] * (1.0f / F8_WSCALE) : 0.f; }
        }
    }
    __device__ __forceinline__ void operator()(const f32x4 (&acc)[2][2][4][2], const Unit& u, int wr, int wc, int fr, int fq, const float (&rs)[2][4]) const {
        const int row0 = u.pm * BM + wr * 64 + fr;
        if (MODE == 0 && u.pn < 4) {
            const int col0 = u.pn * BM + wc * 32 + 8 * fq;
#pragma unroll
            for (int ai = 0; ai < 2; ++ai)
#pragma unroll
                for (int m = 0; m < 4; ++m) { bf16_t* rowp = O0 + (size_t)(row0 + ai * HALF + m * 16) * D + col0;
#pragma unroll
                    for (int bj = 0; bj < 2; ++bj) { const f32x4 v0 = acc[ai][bj][m][0] * rs[ai][m], v1 = acc[ai][bj][m][1] * rs[ai][m];
                        u32x4 w; w.x = cvt_pk_bf16(v0[0], v0[1]); w.y = cvt_pk_bf16(v0[2], v0[3]); w.z = cvt_pk_bf16(v1[0], v1[1]); w.w = cvt_pk_bf16(v1[2], v1[3]);
                        *(u32x4*)(rowp + bj * HALF) = w; } }
        } else {
            const int pt = (MODE == 0) ? (u.pn - 4) : u.pn;
            const int col0 = pt * HALF + wc * 32 + 8 * fq;
#pragma unroll
            for (int ai = 0; ai < 2; ++ai)
#pragma unroll
                for (int m = 0; m < 4; ++m) { bf16_t* rowp = O1 + (size_t)(row0 + ai * HALF + m * 16) * ld1 + col0;
                    f32x4 r[2];
#pragma unroll
                    for (int n = 0; n < 2; ++n) { const f32x4 g = acc[ai][0][m][n] * rs[ai][m], up = acc[ai][1][m][n] * rs[ai][m];
                        if (MODE == 0) r[n] = g * up;
                        else {
#pragma unroll
                            for (int j = 0; j < 4; ++j) r[n][j] = __builtin_amdgcn_fmed3f(g[j] * fast_rcp(1.0f + fast_exp2(-1.4426950408889634f * g[j])) * up[j] * F8_HSCALE, -448.0f, 448.0f); } }
                    if (MODE == 1) { u32x2 w; w.x = cvt_pk4_fp8(r[0][0], r[0][1], r[0][2], r[0][3]); w.y = cvt_pk4_fp8(r[1][0], r[1][1], r[1][2], r[1][3]);
                        *(u32x2*)((unsigned char*)O1 + (size_t)(row0 + ai * HALF + m * 16) * ld1 + col0) = w; }
                    else { u32x4 w; w.x = cvt_pk_bf16(r[0][0], r[0][1]); w.y = cvt_pk_bf16(r[0][2], r[0][3]); w.z = cvt_pk_bf16(r[1][0], r[1][1]); w.w = cvt_pk_bf16(r[1][2], r[1][3]);
                        *(u32x4*)rowp = w; } }
        }
    }
};
struct EpiDown {
    static constexpr bool PERM = true, PRELOAD = false, PREFETCH = true;
    unsigned char* O; const float* cwraw; const LAS int* tb; const LAS int* cn;
    __device__ __forceinline__ void prefetch(float (&cws)[2][4], const Unit& u, int wr, int fr) const {
        int e = 0;
#pragma unroll
        for (int j = 1; j < 16; ++j) e += (u.pm >= tb[j]) ? 1 : 0;
        const int idx0 = (u.pm - tb[e]) * BM + wr * 64 + fr, cne = cn[e];
#pragma unroll
        for (int ai = 0; ai < 2; ++ai)
#pragma unroll
            for (int m = 0; m < 4; ++m) { const int idx = idx0 + ai * HALF + m * 16; cws[ai][m] = idx < cne ? cwraw[(size_t)e * ECAP + idx] * (F8_YSCALE / (F8_WSCALE * F8_HSCALE)) : 0.f; }
    }
    __device__ __forceinline__ void operator()(const f32x4 (&acc)[2][2][4][2], const Unit& u, int wr, int wc, int fr, int fq, const float (&cws)[2][4]) const {
        const int row0 = u.pm * BM + wr * 64 + fr, col0 = u.pn * BM + wc * 32 + 8 * fq;
#pragma unroll
        for (int ai = 0; ai < 2; ++ai)
#pragma unroll
            for (int m = 0; m < 4; ++m) { const float cw = cws[ai][m];
                unsigned char* rowp = O + (size_t)(row0 + ai * HALF + m * 16) * D + col0;
#pragma unroll
                for (int bj = 0; bj < 2; ++bj) { f32x4 v0 = acc[ai][bj][m][0] * cw, v1 = acc[ai][bj][m][1] * cw;
#pragma unroll
                    for (int j = 0; j < 4; ++j) { v0[j] = __builtin_amdgcn_fmed3f(v0[j], -448.0f, 448.0f); v1[j] = __builtin_amdgcn_fmed3f(v1[j], -448.0f, 448.0f); }
                    u32x2 w; w.x = cvt_pk4_fp8(v0[0], v0[1], v0[2], v0[3]); w.y = cvt_pk4_fp8(v1[0], v1[1], v1[2], v1[3]);
                    *(u32x2*)(rowp + bj * HALF) = w; } }
    }
};
}

constexpr int RING_BYTES = 131072;
constexpr int MISC_OFF = RING_BYTES;
constexpr int LDS_BYTES = 163840;
constexpr int MW_BAR = 0;
constexpr int MW_TB = 16;
constexpr int MW_CN = 40;
constexpr int MW_Q = 60;
constexpr int MW_F = 64;

struct Params {
    const float* in[25]; float* out; unsigned char* ws;
};

constexpr float ATT_QSCALE = 0.125f * 1.4426950408889634f;
__device__ __forceinline__ void transpose_item(const float* W, int ld, int K, int k0, int srccol, bf16_t* WT, int dstrow, LAS float* scr, int lane, const float* gk = nullptr, float wsc = 1.0f) {
    float tv[32];
#pragma unroll
    for (int i = 0; i < 32; ++i) { const int kk = 2 * i + (lane >> 5); tv[i] = W[(size_t)(k0 + kk) * ld + srccol + (lane & 31)]; }
#pragma unroll
    for (int i = 0; i < 32; ++i) { const int kk = 2 * i + (lane >> 5); scr[kk * 33 + (lane & 31)] = (gk ? tv[i] * gk[k0 + kk] : tv[i]) * wsc; }
    asm volatile("s_waitcnt lgkmcnt(0)" ::: "memory");
    const int c = lane & 7;
#pragma unroll
    for (int j = 0; j < 4; ++j) { const int n = (lane >> 3) + 8 * j; const LAS float* s = scr + (8 * c) * 33 + n;
        u32x4 o; o.x = cvt_pk_bf16(s[0 * 33], s[1 * 33]); o.y = cvt_pk_bf16(s[2 * 33], s[3 * 33]); o.z = cvt_pk_bf16(s[4 * 33], s[5 * 33]); o.w = cvt_pk_bf16(s[6 * 33], s[7 * 33]);
        *(u32x4*)(WT + (size_t)(dstrow + n) * K + k0 + 8 * c) = o; }
    asm volatile("s_waitcnt lgkmcnt(0)" ::: "memory");
}
__device__ __forceinline__ void transpose_item_f8(const float* W, int ld, int K, int k0, int srccol, unsigned char* WT8, int dstrow, LAS float* scr, int lane, const float* gk, float scale) {
    float tv[32];
#pragma unroll
    for (int i = 0; i < 32; ++i) { const int kk = 2 * i + (lane >> 5); tv[i] = W[(size_t)(k0 + kk) * ld + srccol + (lane & 31)]; }
#pragma unroll
    for (int i = 0; i < 32; ++i) { const int kk = 2 * i + (lane >> 5); scr[kk * 33 + (lane & 31)] = (gk ? tv[i] * gk[k0 + kk] : tv[i]) * scale; }
    asm volatile("s_waitcnt lgkmcnt(0)" ::: "memory");
    const int c = lane & 3;
#pragma unroll
    for (int j = 0; j < 2; ++j) { const int n = (lane >> 2) + 16 * j; const LAS float* q = scr + (16 * c) * 33 + n;
        u32x4 o; o.x = cvt_pk4_fp8(q[0 * 33], q[1 * 33], q[2 * 33], q[3 * 33]); o.y = cvt_pk4_fp8(q[4 * 33], q[5 * 33], q[6 * 33], q[7 * 33]);
        o.z = cvt_pk4_fp8(q[8 * 33], q[9 * 33], q[10 * 33], q[11 * 33]); o.w = cvt_pk4_fp8(q[12 * 33], q[13 * 33], q[14 * 33], q[15 * 33]);
        *(u32x4*)(WT8 + (size_t)(dstrow + n) * K + k0 + 16 * c) = o; }
    asm volatile("s_waitcnt lgkmcnt(0)" ::: "memory");
}
__device__ __forceinline__ int pair_row(int ch, int up) { return (ch >> 7) * 256 + up * 128 + (ch & 127); }

__device__ __forceinline__ void phase_prologue_weights(const Params& p, LAS unsigned char* lds, int first, int last, int step, int wave, int lane_) {
    int lane = lane_; asm volatile("" : "+v"(lane));
    LAS float* scr = (LAS float*)(lds + wave * 16384);
    unsigned char* ws = p.ws;
    constexpr int I1 = 16 * 112, I2 = 16 * 32, I3 = 16 * 96, I4 = 16 * 32, IE = 768;
    constexpr int NITEMS = I1 + I2 + I3 + I4 + 32 * IE;
    static_assert(NITEMS == 28928, "item count");
    for (int it = first; it < last; it += step) {
        int r = it;
        if (r < I1) { const int kb = r / 112, nb = r % 112; const int sc = nb < 64 ? 32 * nb : 2056 + 32 * (nb - 64), dr = nb < 64 ? 32 * nb : 2048 + 32 * (nb - 64);
            transpose_item(p.in[5], EVEN_IN, 1024, 64 * kb, sc, (bf16_t*)(ws + WS_WT1), dr, scr, lane, nullptr, (dr >= P_DQ && dr < P_DK) ? ATT_QSCALE : 1.0f); continue; } r -= I1;
        if (r < I2) { const int kb = r / 32, nb = r % 32; transpose_item(p.in[6], 1024, 1024, 64 * kb, 32 * nb, (bf16_t*)(ws + WS_WT2), 32 * nb, scr, lane); continue; } r -= I2;
        if (r < I3) { const int kb = r / 96, nb = r % 96; int dr;
            if (nb < 32) dr = 32 * nb; else if (nb < 64) dr = 1024 + pair_row(32 * (nb - 32), 0); else dr = 1024 + pair_row(32 * (nb - 64), 1);
            if (G3_F8) transpose_item_f8(p.in[15], 3072, 1024, 64 * kb, 32 * nb, ws + WS_WT3, dr, scr, lane, p.in[2] + D, F8_WSCALE);
            else transpose_item(p.in[15], 3072, 1024, 64 * kb, 32 * nb, (bf16_t*)(ws + WS_WT3), dr, scr, lane, p.in[2] + D);
            continue; } r -= I3;
        if (r < I4) { const int kb = r / 32, nb = r % 32; transpose_item(p.in[17], 1024, 1024, 64 * kb, 32 * nb, (bf16_t*)(ws + WS_WT4), 32 * nb, scr, lane); continue; } r -= I4;
        const int le = r / IE; r %= IE;
        unsigned char* wgu = ws + WS_WGU + (size_t)le * 1024 * 1024; unsigned char* wd = ws + WS_WD + (size_t)le * 1024 * 512;
        if (r < 256) { const int kb = r / 16, nb = r % 16; transpose_item_f8(p.in[22] + (size_t)le * 1024 * 512, 512, 1024, 64 * kb, 32 * nb, wgu, pair_row(32 * nb, 0), scr, lane, p.in[3] + (le >> 4) * D, F8_WSCALE); continue; } r -= 256;
        if (r < 256) { const int kb = r / 16, nb = r % 16; transpose_item_f8(p.in[23] + (size_t)le * 1024 * 512, 512, 1024, 64 * kb, 32 * nb, wgu, pair_row(32 * nb, 1), scr, lane, p.in[3] + (le >> 4) * D, F8_WSCALE); continue; } r -= 256;
        { const int kb = r / 32, nb = r % 32; transpose_item_f8(p.in[24] + (size_t)le * 512 * 1024, 1024, 512, 64 * kb, 32 * nb, wd, 32 * nb, scr, lane, nullptr, F8_WSCALE); }
    }
}

struct RowV { f32x4 v[4]; };
__device__ __forceinline__ RowV row_load(const float* xr, int lane) { RowV r; const f32x4* p = (const f32x4*)xr + lane;
#pragma unroll
    for (int j = 0; j < 4; ++j) r.v[j] = p[64 * j]; return r; }
__device__ __forceinline__ void row_store(float* xr, int lane, const RowV& r) { f32x4* p = (f32x4*)xr + lane;
#pragma unroll
    for (int j = 0; j < 4; ++j) p[64 * j] = r.v[j]; }
__device__ __forceinline__ RowV row_load_bf16(const bf16_t* yr, int lane) { RowV r; const u32x2* p = (const u32x2*)yr + lane;
#pragma unroll
    for (int j = 0; j < 4; ++j) { const u32x2 w = p[64 * j]; r.v[j] = (f32x4){bf_lo(w.x), bf_hi(w.x), bf_lo(w.y), bf_hi(w.y)}; } return r; }
__device__ __forceinline__ RowV row_load_fp8(const unsigned char* yr, int lane, float sc) { RowV r; const unsigned* p = (const unsigned*)yr + lane;
#pragma unroll
    for (int j = 0; j < 4; ++j) { const unsigned w = p[64 * j]; const f32x2 lo = __builtin_amdgcn_cvt_pk_f32_fp8((int)w, false), hi = __builtin_amdgcn_cvt_pk_f32_fp8((int)w, true); r.v[j] = (f32x4){lo.x * sc, lo.y * sc, hi.x * sc, hi.y * sc}; } return r; }
__device__ __forceinline__ float row_rstd(const RowV& r) { float s = 0.f;
#pragma unroll
    for (int j = 0; j < 4; ++j) s += (r.v[j][0] * r.v[j][0] + r.v[j][1] * r.v[j][1]) + (r.v[j][2] * r.v[j][2] + r.v[j][3] * r.v[j][3]);
    return 1.0f / sqrtf(wave_sum(s) * (1.0f / D) + NORM_EPS); }
__device__ __forceinline__ void row_store_bf16(bf16_t* hr, int lane, const RowV& r) { u32x2* p = (u32x2*)hr + lane;
#pragma unroll
    for (int j = 0; j < 4; ++j) { u32x2 w; w.x = cvt_pk_bf16(r.v[j][0], r.v[j][1]); w.y = cvt_pk_bf16(r.v[j][2], r.v[j][3]); p[64 * j] = w; } }

__device__ __forceinline__ void phase_norm_gates(const Params& p, LAS unsigned char* lds, int tid, int gw, int NGW, int lane) {
    const float* x = p.in[0]; const float* g = p.in[2]; const float* win = p.in[5];
    bf16_t* H = (bf16_t*)(p.ws + WS_H); float* gates = (float*)(p.ws + WS_GATES);
    LAS float* wt = (LAS float*)lds;
    for (int i = tid; i < 8 * 1024; i += NTHR) { const int k = i >> 3, o = i & 7; wt[o * 1024 + k] = win[(size_t)k * EVEN_IN + 2048 + o] * g[k]; }
    __syncthreads();
    RowV gv = row_load(g, lane);
    for (int m0 = gw; m0 < T; m0 += 2 * NGW) {
      RowV rr[2];
#pragma unroll
      for (int u = 0; u < 2; ++u) { const int mm = m0 + u * NGW; rr[u] = row_load(x + (size_t)(mm < T ? mm : m0) * D, lane); }
#pragma unroll
      for (int u = 0; u < 2; ++u) {
        const int m = m0 + u * NGW; if (m >= T) break; RowV r = rr[u];
        const float rstd = row_rstd(r);
        float dots[8];
#pragma unroll
        for (int o = 0; o < 8; ++o) { float s = 0.f;
#pragma unroll
            for (int j = 0; j < 4; ++j) { const f32x4 w = *(const LAS f32x4*)(wt + o * 1024 + 4 * lane + 256 * j); s += (r.v[j][0] * w[0] + r.v[j][1] * w[1]) + (r.v[j][2] * w[2] + r.v[j][3] * w[3]); }
            dots[o] = s; }
        float gsum;
        { const bool b5 = (lane & 32) != 0, b4 = (lane & 16) != 0, b3 = (lane & 8) != 0;
          float k4[4];
#pragma unroll
          for (int i = 0; i < 4; ++i) { const float keep = b5 ? dots[4 + i] : dots[i], send = b5 ? dots[i] : dots[4 + i]; k4[i] = keep + __shfl_xor(send, 32); }
          float k2[2];
#pragma unroll
          for (int i = 0; i < 2; ++i) { const float keep = b4 ? k4[2 + i] : k4[i], send = b4 ? k4[i] : k4[2 + i]; k2[i] = keep + __shfl_xor(send, 16); }
          { const float keep = b3 ? k2[1] : k2[0], send = b3 ? k2[0] : k2[1]; gsum = keep + __shfl_xor(send, 8); }
          gsum += __shfl_xor(gsum, 4); gsum += __shfl_xor(gsum, 2); gsum += __shfl_xor(gsum, 1); }
#pragma unroll
        for (int j = 0; j < 4; ++j) r.v[j] = r.v[j] * rstd * gv.v[j];
        row_store_bf16(H + (size_t)m * D, lane, r);
        if ((lane & 7) == 0) gates[(size_t)m * 8 + ((lane >> 3) & 7)] = gsum * rstd;
      }
    }
    __syncthreads();
}

template <int MODE, bool COMBINE>
__device__ __forceinline__ void phase_rows(const Params& p, LAS unsigned char* lds, int tid_, int wave, int lane_, int G,
                                           const float* gvec, const float* wgr, const float* bgr, const float* wer, const float* ber, unsigned* cnt_prev, unsigned* cnt_cur) {
    int tid = tid_; asm volatile("" : "+v"(tid)); const int lane = tid & 63;
    float* OUT = p.out; bf16_t* XB = (bf16_t*)(p.ws + WS_XB); float* RSTD = (float*)(p.ws + WS_RSTD);
    const unsigned char* YC = (const unsigned char*)(p.ws + WS_YC); float* rsraw = (float*)(p.ws + WS_RSRAW);
    unsigned* tokinfo = (unsigned*)(p.ws + WS_TOKINFO);
    unsigned* rowtok = (unsigned*)(p.ws + WS_ROWTOK); float* cwraw = (float*)(p.ws + WS_CWRAW);
    LAS float* wt = (LAS float*)lds;
    LAS int* misc = (LAS int*)(lds + MISC_OFF);
    LAS int* tbp = misc + MW_TB;
    LAS int* te = misc + 1024;
    LAS float* tc = (LAS float*)(misc + 1536);
    LAS int* trank = misc + 2048;
    LAS int* ebase = misc + 2560;
    LAS float* trs = (LAS float*)(misc + 2600);
    if (COMBINE) { if (tid == 0) { int acc = 0; for (int e = 0; e < 16; ++e) { tbp[e] = acc; acc += ((int)__hip_atomic_load(cnt_prev + e * 64, __ATOMIC_RELAXED, __HIP_MEMORY_SCOPE_AGENT) + 255) >> 8; } tbp[16] = acc; } }
    if (MODE == 1) { for (int i = tid; i < 20 * 1024; i += NTHR) { const int o = i >> 10, k = i & 1023; wt[i] = (o < 4 ? wgr[(size_t)k * 4 + o] : wer[(size_t)k * 16 + (o - 4)]) * gvec[k]; } }
    __syncthreads();
    RowV gv; if (MODE == 2) gv = row_load(gvec, lane);
    for (int blk = blockIdx.x; blk < T / 256; blk += G) {
        for (int i2 = 0; i2 < 32; i2 += 2) {
          RowV rr[2];
#pragma unroll
          for (int u = 0; u < 2; ++u) {
            const int m = blk * 256 + wave * 32 + i2 + u;
            rr[u] = row_load_bf16(XB + (size_t)m * D, lane);
            if (COMBINE) {
                const unsigned i0 = tokinfo[(size_t)m * 2], i1 = tokinfo[(size_t)m * 2 + 1];
                const size_t s0 = (size_t)tbp[i0 >> 16] * 256 + (i0 & 0xffffu), s1 = (size_t)tbp[i1 >> 16] * 256 + (i1 & 0xffffu);
                const RowV y0 = row_load_fp8(YC + s0 * D, lane, 1.0f / F8_YSCALE), y1 = row_load_fp8(YC + s1 * D, lane, 1.0f / F8_YSCALE);
#pragma unroll
                for (int j = 0; j < 4; ++j) rr[u].v[j] = rr[u].v[j] + y0.v[j] + y1.v[j];
            }
          }
#pragma unroll
          for (int u = 0; u < 2; ++u) {
            const int i = i2 + u;
            const int rl = wave * 32 + i, m = blk * 256 + rl;
            RowV r = rr[u];
            if (MODE == 0) {
                u32x2* xp = (u32x2*)(XB + (size_t)m * D) + lane;
#pragma unroll
                for (int j = 0; j < 4; ++j) { u32x2 w; w.x = cvt_pk_bf16(r.v[j][0], r.v[j][1]); w.y = cvt_pk_bf16(r.v[j][2], r.v[j][3]); xp[64 * j] = w;
                    r.v[j] = (f32x4){bf_lo(w.x), bf_hi(w.x), bf_lo(w.y), bf_hi(w.y)}; }
            }
            const float rstd = row_rstd(r);
            if (MODE != 2) { if (lane == 0) RSTD[m] = rstd; }
            if (MODE == 1 || (MODE == 0 && G3_F8)) { unsigned* x8 = (unsigned*)(p.ws + WS_XB8 + (size_t)m * D) + lane;
#pragma unroll
                for (int j = 0; j < 4; ++j) x8[64 * j] = cvt_pk4_fp8(r.v[j][0], r.v[j][1], r.v[j][2], r.v[j][3]); }
            if (MODE == 1) {
                float lg[20];
#pragma unroll
                for (int o = 0; o < 20; ++o) { float s = 0.f;
#pragma unroll
                    for (int j = 0; j < 4; ++j) { const f32x4 w = *(const LAS f32x4*)(wt + o * 1024 + 4 * lane + 256 * j); s += (r.v[j][0] * w[0] + r.v[j][1] * w[1]) + (r.v[j][2] * w[2] + r.v[j][3] * w[3]); }
                    lg[o] = wave_sum(s) * rstd + (o < 4 ? bgr[o] : ber[o - 4]); }
                int gs = 0; float gm = lg[0];
#pragma unroll
                for (int o = 1; o < 4; ++o) if (lg[o] > gm) { gm = lg[o]; gs = o; }
                float den = 0.f;
#pragma unroll
                for (int o = 0; o < 4; ++o) den += __expf(lg[o] - gm);
                const float pg = 1.0f / den;
                float el[4];
#pragma unroll
                for (int o = 0; o < 4; ++o) { float v = lg[4 + o];
#pragma unroll
                    for (int g2 = 1; g2 < 4; ++g2) v = (gs == g2) ? lg[4 + 4 * g2 + o] : v;
                    el[o] = v; }
                int i0 = 0; float v0 = el[0];
#pragma unroll
                for (int o = 1; o < 4; ++o) if (el[o] > v0) { v0 = el[o]; i0 = o; }
                int i1 = -1; float v1 = -INFINITY;
#pragma unroll
                for (int o = 0; o < 4; ++o) if (o != i0 && el[o] > v1) { v1 = el[o]; i1 = o; }
                const float ex = __expf(v1 - v0); const float w0 = 1.0f / (1.0f + ex), w1 = ex * w0;
                if (lane == 0) { te[rl * 2] = gs * 4 + i0; te[rl * 2 + 1] = gs * 4 + i1; tc[rl * 2] = w0 * pg; tc[rl * 2 + 1] = w1 * pg; trs[rl] = rstd; }
            }
            if (MODE == 2) {
#pragma unroll
                for (int j = 0; j < 4; ++j) r.v[j] = r.v[j] * rstd * gv.v[j];
                row_store(OUT + (size_t)m * D, lane, r);
            }
          }
        }
        if (MODE == 1) {
            __syncthreads();
            if (tid < 16) { int c = 0; for (int q = 0; q < 512; ++q) if (te[q] == tid) { trank[q] = c; ++c; }
                ebase[tid] = c ? (int)__hip_atomic_fetch_add(cnt_cur + tid * 64, (unsigned)c, __ATOMIC_RELAXED, __HIP_MEMORY_SCOPE_AGENT) : 0; }
            __syncthreads();
            { const int q = tid, e = te[q], pos = ebase[e] + trank[q], tok = blk * 256 + (q >> 1);
              rowtok[(size_t)e * ECAP + pos] = (unsigned)tok; cwraw[(size_t)e * ECAP + pos] = tc[q]; rsraw[(size_t)e * ECAP + pos] = trs[q >> 1]; tokinfo[(size_t)tok * 2 + (q & 1)] = ((unsigned)e << 16) | (unsigned)pos; }
            __syncthreads();
        }
    }
    __syncthreads();
}

__device__ __forceinline__ void phase_router(const Params& p, LAS unsigned char* lds, int tid_, int wave, int G,
                                             const float* gvec, const float* wgr, const float* bgr, const float* wer, const float* ber, unsigned* cnt_cur) {
    int tid = tid_; asm volatile("" : "+v"(tid)); const int lane = tid & 63, r32 = lane & 31, hi = lane >> 5;
    const bf16_t* XB = (const bf16_t*)(p.ws + WS_XB); float* rsraw = (float*)(p.ws + WS_RSRAW);
    unsigned* tokinfo = (unsigned*)(p.ws + WS_TOKINFO);
    unsigned* rowtok = (unsigned*)(p.ws + WS_ROWTOK); float* cwraw = (float*)(p.ws + WS_CWRAW);
    constexpr int WROW = 2048 + 16;
    LAS unsigned char* Whi = lds; LAS unsigned char* Wlo = lds + 24 * WROW;
    LAS int* misc = (LAS int*)(lds + MISC_OFF);
    LAS int* te = misc + 1024; LAS float* tc = (LAS float*)(misc + 1536); LAS int* trank = misc + 2048; LAS int* ebase = misc + 2560; LAS float* trs = (LAS float*)(misc + 2600);
    for (int i = tid; i < 24 * 1024; i += NTHR) { const int sl = i >> 10, k = i & 1023; float w;
        if (sl < 8) w = wgr[(size_t)k * 4 + (sl & 3)]; else { const int q = sl - 8, e = (q & 3) + 8 * ((q >> 2) & 1) + 4 * (q >> 3); w = wer[(size_t)k * 16 + e]; }
        w *= gvec[k];
        const unsigned hb = cvt_pk_bf16(w, 0.f) & 0xffffu; const float wl = w - __uint_as_float(hb << 16); const unsigned lb = cvt_pk_bf16(wl, 0.f) & 0xffffu;
        *(LAS unsigned short*)(Whi + sl * WROW + k * 2) = (unsigned short)hb; *(LAS unsigned short*)(Wlo + sl * WROW + k * 2) = (unsigned short)lb; }
    __syncthreads();
    const int slot_row = r32 < 24 ? r32 : r32 - 8;
    const LAS unsigned char* wh = Whi + slot_row * WROW + hi * 64; const LAS unsigned char* wl_ = Wlo + slot_row * WROW + hi * 64;
    for (int blk = blockIdx.x; blk < T / 256; blk += G) {
        const int rl = wave * 32 + r32, m = blk * 256 + rl;
        const bf16_t* xr = XB + (size_t)m * D + hi * 32;
        f32x16 acc = (f32x16){}; float ss = 0.f;
        bf16x8 xa[4], xb[4];
#pragma unroll
        for (int q = 0; q < 4; ++q) xa[q] = *(const bf16x8*)(xr + q * 8);
#pragma unroll 1
        for (int t = 0; t < 16; t += 2) {
#pragma unroll
            for (int q = 0; q < 4; ++q) xb[q] = *(const bf16x8*)(xr + (t + 1) * 64 + q * 8);
#pragma unroll
            for (int q = 0; q < 4; ++q) { const bf16x8 ah = *(const LAS bf16x8*)(wh + t * 128 + q * 16), al = *(const LAS bf16x8*)(wl_ + t * 128 + q * 16);
                acc = __builtin_amdgcn_mfma_f32_32x32x16_bf16(ah, xa[q], acc, 0, 0, 0); acc = __builtin_amdgcn_mfma_f32_32x32x16_bf16(al, xa[q], acc, 0, 0, 0);
#pragma unroll
                for (int j = 0; j < 4; ++j) { const unsigned w = ((const unsigned*)&xa[q])[j]; const float a = bf_lo(w), b = bf_hi(w); ss += a * a + b * b; } }
            if (t + 2 < 16) {
#pragma unroll
                for (int q = 0; q < 4; ++q) xa[q] = *(const bf16x8*)(xr + (t + 2) * 64 + q * 8); }
#pragma unroll
            for (int q = 0; q < 4; ++q) { const bf16x8 ah = *(const LAS bf16x8*)(wh + (t + 1) * 128 + q * 16), al = *(const LAS bf16x8*)(wl_ + (t + 1) * 128 + q * 16);
                acc = __builtin_amdgcn_mfma_f32_32x32x16_bf16(ah, xb[q], acc, 0, 0, 0); acc = __builtin_amdgcn_mfma_f32_32x32x16_bf16(al, xb[q], acc, 0, 0, 0);
#pragma unroll
                for (int j = 0; j < 4; ++j) { const unsigned w = ((const unsigned*)&xb[q])[j]; const float a = bf_lo(w), b = bf_hi(w); ss += a * a + b * b; } }
        }
        ss += __shfl_xor(ss, 32);
        const float rstd = 1.0f / sqrtf(ss * (1.0f / D) + NORM_EPS);
        float lg[4];
#pragma unroll
        for (int o = 0; o < 4; ++o) lg[o] = acc[o] * rstd + bgr[o];
        int gs = 0; float gm = lg[0];
#pragma unroll
        for (int o = 1; o < 4; ++o) if (lg[o] > gm) { gm = lg[o]; gs = o; }
        float den = 0.f;
#pragma unroll
        for (int o = 0; o < 4; ++o) den += __expf(lg[o] - gm);
        const float pg = 1.0f / den;
        if ((gs >> 1) == hi) {
            float el[4];
#pragma unroll
            for (int o = 0; o < 4; ++o) el[o] = ((gs & 1) ? acc[8 + o] : acc[4 + o]) * rstd + ber[gs * 4 + o];
            int i0 = 0; float v0 = el[0];
#pragma unroll
            for (int o = 1; o < 4; ++o) if (el[o] > v0) { v0 = el[o]; i0 = o; }
            int i1 = -1; float v1 = -INFINITY;
#pragma unroll
            for (int o = 0; o < 4; ++o) if (o != i0 && el[o] > v1) { v1 = el[o]; i1 = o; }
            const float ex = __expf(v1 - v0); const float w0 = 1.0f / (1.0f + ex), w1 = ex * w0;
            te[rl * 2] = gs * 4 + i0; te[rl * 2 + 1] = gs * 4 + i1; tc[rl * 2] = w0 * pg; tc[rl * 2 + 1] = w1 * pg; trs[rl] = rstd;
        }
        __syncthreads();
        if (tid < 16) { int c = 0; for (int q = 0; q < 512; ++q) if (te[q] == tid) { trank[q] = c; ++c; }
            ebase[tid] = c ? (int)__hip_atomic_fetch_add(cnt_cur + tid * 64, (unsigned)c, __ATOMIC_RELAXED, __HIP_MEMORY_SCOPE_AGENT) : 0; }
        __syncthreads();
        { const int q = tid, e = te[q], pos = ebase[e] + trank[q], tok = blk * 256 + (q >> 1);
          rowtok[(size_t)e * ECAP + pos] = (unsigned)tok; cwraw[(size_t)e * ECAP + pos] = tc[q]; rsraw[(size_t)e * ECAP + pos] = trs[q >> 1]; tokinfo[(size_t)tok * 2 + (q & 1)] = ((unsigned)e << 16) | (unsigned)pos; }
        __syncthreads();
    }
    __syncthreads();
}

__device__ __forceinline__ void phase_conv(const Params& p, int gw, int NGW, int lane) {
    const bf16_t* BG = (const bf16_t*)(p.ws + WS_BG); const bf16_t* Z = (const bf16_t*)(p.ws + WS_Z); bf16_t* A2 = (bf16_t*)(p.ws + WS_CAT);
    const float* cw = p.in[16];
    float w0[16], w1[16], w2[16];
#pragma unroll
    for (int h = 0; h < 2; ++h)
#pragma unroll
        for (int j = 0; j < 8; ++j) { const int c = h * 512 + lane * 8 + j; w0[h * 8 + j] = cw[c]; w1[h * 8 + j] = cw[D + c]; w2[h * 8 + j] = cw[2 * D + c]; }
    for (int run = gw; run < T / 32; run += NGW) {
        const int t0 = run * 32;
        float zm1[16], zm2[16];
#pragma unroll
        for (int j = 0; j < 16; ++j) { zm1[j] = 0.f; zm2[j] = 0.f; }
        if ((t0 & (SEQ - 1)) != 0) {
#pragma unroll
            for (int h = 0; h < 2; ++h) { const u32x4 a = *(const u32x4*)(Z + (size_t)(t0 - 1) * D + h * 512 + lane * 8), b = *(const u32x4*)(Z + (size_t)(t0 - 2) * D + h * 512 + lane * 8);
#pragma unroll
                for (int q = 0; q < 4; ++q) { zm1[h * 8 + 2 * q] = bf_lo(a[q]); zm1[h * 8 + 2 * q + 1] = bf_hi(a[q]); zm2[h * 8 + 2 * q] = bf_lo(b[q]); zm2[h * 8 + 2 * q + 1] = bf_hi(b[q]); } }
        }
#pragma unroll 4
        for (int i = 0; i < 32; ++i) {
            const size_t rb = (size_t)(t0 + i) * D;
#pragma unroll
            for (int h = 0; h < 2; ++h) { const u32x4 zz = *(const u32x4*)(Z + rb + h * 512 + lane * 8), bb = *(const u32x4*)(BG + rb + h * 512 + lane * 8);
                float o[8];
#pragma unroll
                for (int q = 0; q < 4; ++q) {
#pragma unroll
                    for (int s = 0; s < 2; ++s) { const int j = h * 8 + 2 * q + s; const float zc = s ? bf_hi(zz[q]) : bf_lo(zz[q]), bg = s ? bf_hi(bb[q]) : bf_lo(bb[q]);
                        o[2 * q + s] = bg * (w0[j] * zm2[j] + w1[j] * zm1[j] + w2[j] * zc); zm2[j] = zm1[j]; zm1[j] = zc; } }
                u32x4 w; w.x = cvt_pk_bf16(o[0], o[1]); w.y = cvt_pk_bf16(o[2], o[3]); w.z = cvt_pk_bf16(o[4], o[5]); w.w = cvt_pk_bf16(o[6], o[7]);
                *(u32x4*)(A2 + rb + h * 512 + lane * 8) = w; }
        }
    }
}

__device__ __forceinline__ void phase_gate_scan(const Params& p, int gw, int NGW, int lane) {
    const float* gates = (const float*)(p.ws + WS_GATES);
    float* SA = (float*)(p.ws + WS_SA); float* SAM = (float*)(p.ws + WS_SAM); float* SBA = (float*)(p.ws + WS_SBA);
    for (int sq = gw; sq < NBATCH * 4; sq += NGW) {
        const int b = sq >> 2, hd = sq & 3; const float ib = p.in[7][hd], fb = p.in[8][hd];
        float lf[32], ig[32];
#pragma unroll
        for (int i = 0; i < 32; ++i) { const size_t t = (size_t)b * SEQ + lane * 32 + i; const float f = gates[t * 8 + 4 + hd] + fb; ig[i] = gates[t * 8 + hd] + ib;
            lf[i] = (f >= 0.f) ? -log1pf(expf(-f)) : (f - log1pf(expf(f))); }
        float run = 0.f;
#pragma unroll
        for (int i = 0; i < 32; ++i) { run += lf[i]; lf[i] = run; }
        float tot = run, pre = 0.f;
#pragma unroll
        for (int o = 1; o < 64; o <<= 1) { const float v = __shfl_up(tot, o); if (lane >= o) tot += v; }
        pre = tot - run;
        float amax = -INFINITY;
#pragma unroll
        for (int i = 0; i < 32; ++i) { lf[i] += pre; ig[i] = ig[i] - lf[i]; amax = fmaxf(amax, ig[i]); }
        float pm = amax;
#pragma unroll
        for (int o = 1; o < 64; o <<= 1) { const float v = __shfl_up(pm, o); if (lane >= o) pm = fmaxf(pm, v); }
        float prev = __shfl_up(pm, 1); if (lane == 0) prev = -INFINITY;
        float rm = prev;
#pragma unroll
        for (int i = 0; i < 32; ++i) { const size_t o = (size_t)sq * SEQ + lane * 32 + i; rm = fmaxf(rm, ig[i]); SA[o] = ig[i]; SAM[o] = rm; SBA[o] = lf[i] + rm; }
    }
}

struct TileRegs { u32x4 v[2]; };
__device__ __forceinline__ TileRegs tile_load(const bf16_t* src, int tid) { TileRegs r;
#pragma unroll
    for (int i = 0; i < 2; ++i) { const int n = tid + 512 * i, row = n >> 4, ch = n & 15; r.v[i] = *(const u32x4*)(src + (size_t)row * NP + ch * 8); } return r; }
__device__ __forceinline__ void tile_write(LAS unsigned char* dst, int tid, const TileRegs& r) {
#pragma unroll
    for (int i = 0; i < 2; ++i) { const int n = tid + 512 * i, row = n >> 4, ch = n & 15; *(LAS u32x4*)(dst + off_b(row, ch)) = r.v[i]; } }

__device__ __forceinline__ void glds16(const void* gsrc, unsigned lds_dst) { unsigned keep;
    asm volatile("s_mov_b32 %0, m0\n\ts_mov_b32 m0, %2\n\ts_nop 0\n\tglobal_load_lds_dwordx4 %1, off\n\ts_mov_b32 m0, %0" : "=&s"(keep) : "v"(gsrc), "s"(lds_dst) : "memory"); }
__device__ __forceinline__ void tile_dma(const bf16_t* src, LAS unsigned char* dst, int wave, int lane) {
#pragma unroll
    for (int i = 0; i < 2; ++i) { const int piece = 2 * wave + i, row = 4 * piece + (lane >> 4); const unsigned ch = (unsigned)(lane & 15) ^ ((((unsigned)lane >> 4) << 2) | ((unsigned)piece & 3u));
        glds16(src + (size_t)row * NP + ch * 8, (unsigned)__builtin_amdgcn_readfirstlane((int)(unsigned)(uintptr_t)(dst + piece * 1024))); }
}
#define WAIT_ALL_BAR() asm volatile("s_waitcnt vmcnt(0) lgkmcnt(0)\n\ts_barrier" ::: "memory")
__device__ __forceinline__ void attn_unit(const Params& p, LAS unsigned char* lds, int bh, int qblk, int tid_, int wave, int lane_) {
    int tid = tid_; asm volatile("" : "+v"(tid)); const int lane = tid & 63;
    const bf16_t* P = (const bf16_t*)(p.ws + WS_P); bf16_t* CAT = (bf16_t*)(p.ws + WS_CAT);
    const int b = bh >> 2, hd = bh & 3, map = wave >> 2, qs = wave & 3, r32 = lane & 31, hi = lane >> 5;
    const size_t rowbase = (size_t)b * SEQ;
    const int q0 = qblk * 128 + qs * 32, qrow = q0 + r32;
    LAS float* fs = (LAS float*)(lds + MISC_OFF) + MW_F;
    LAS float* tbl = fs;
    constexpr float LOG2E = 1.4426950408889634f;
    if (tid < 272) { const int n = tid - 64; int bk;
        if (n < 16) bk = n < 0 ? 0 : n; else { bk = 16; const int th[15] = {19, 21, 24, 27, 31, 35, 40, 46, 52, 59, 67, 77, 87, 99, 113};
#pragma unroll
            for (int j = 0; j < 15; ++j) bk += (n >= th[j]) ? 1 : 0; }
        tbl[tid] = n < 0 ? -INFINITY : p.in[1][bk * 4 + hd] * LOG2E; }
    bf16x8 qf[4];
    { const bf16_t* qp = P + (rowbase + qrow) * NP + P_DQ + hd * 128 + map * 64 + hi * 8;
#pragma unroll
      for (int ks = 0; ks < 4; ++ks) qf[ks] = *(const bf16x8*)(qp + ks * 16); }
    const bf16_t* Kg = P + rowbase * NP + P_DK + hd * 128; const bf16_t* Vg = P + rowbase * NP + P_DV + hd * 128;
    const int NS = qblk + 1;
    f32x16 o[4];
#pragma unroll
    for (int c = 0; c < 4; ++c) o[c] = (f32x16){};
    float mrun = -INFINITY, lrun = 0.f;
    const float bias_far = p.in[1][31 * 4 + hd] * LOG2E;
    const unsigned xr = ((unsigned)(r32 & 3) << 2) | ((unsigned)(r32 >> 2) & 3u);
    const unsigned q4 = (lane & 15) >> 2, pp = lane & 3, blk = (lane >> 4) & 1;
#ifndef ATT_DMA
#define ATT_DMA 5
#endif
#ifndef ATT_LATE_DMA
#define ATT_LATE_DMA 1
#endif
#if ATT_DMA == 2 || ATT_DMA == 4
#elif ATT_DMA
    WAIT_ALL_BAR();
    { tile_dma(Kg, lds, wave, lane); tile_dma(Vg, lds + 16384, wave, lane); tile_dma(Kg + (size_t)64 * NP, lds + 32768, wave, lane); tile_dma(Vg + (size_t)64 * NP, lds + 49152, wave, lane); }
#else
    { TileRegs a0 = tile_load(Kg, tid), a1 = tile_load(Vg, tid), a2 = tile_load(Kg + (size_t)64 * NP, tid), a3 = tile_load(Vg + (size_t)64 * NP, tid);
      tile_write(lds, tid, a0); tile_write(lds + 16384, tid, a1); tile_write(lds + 32768, tid, a2); tile_write(lds + 49152, tid, a3); }
#endif
#if ATT_DMA == 5
    WAIT_ALL_BAR();
#endif
    asm volatile("" :: "v"(qf[0]), "v"(qf[1]), "v"(qf[2]), "v"(qf[3]));
#pragma unroll 1
    for (int st = 0; st < NS; ++st) {
        WAIT_ALL_BAR();
#if ATT_DMA == 2
        { LAS unsigned char* nb = lds + (st & 1) * 65536; const size_t ro = (size_t)st * 128 * NP;
            tile_dma(Kg + ro, nb, wave, lane); tile_dma(Vg + ro, nb + 16384, wave, lane); tile_dma(Kg + ro + (size_t)64 * NP, nb + 32768, wave, lane); tile_dma(Vg + ro + (size_t)64 * NP, nb + 49152, wave, lane); }
        WAIT_ALL_BAR();
#elif ATT_DMA == 3
#elif ATT_DMA
#if ATT_DMA == 4
        if (st == 0) { tile_dma(Kg, lds, wave, lane); tile_dma(Vg, lds + 16384, wave, lane); tile_dma(Kg + (size_t)64 * NP, lds + 32768, wave, lane); tile_dma(Vg + (size_t)64 * NP, lds + 49152, wave, lane); WAIT_ALL_BAR(); }
#endif
        if (!ATT_LATE_DMA && st + 1 < NS) { LAS unsigned char* nb = lds + ((st + 1) & 1) * 65536; const size_t ro = (size_t)(st + 1) * 128 * NP;
            tile_dma(Kg + ro, nb, wave, lane); tile_dma(Vg + ro, nb + 16384, wave, lane); tile_dma(Kg + ro + (size_t)64 * NP, nb + 32768, wave, lane); tile_dma(Vg + ro + (size_t)64 * NP, nb + 49152, wave, lane); }
#else
        TileRegs a0, a1;
        if (st + 1 < NS) { const size_t ro = (size_t)(st + 1) * 128 * NP; a0 = tile_load(Kg + ro, tid); a1 = tile_load(Vg + ro, tid); }
#endif
#pragma unroll
        for (int half = 0; half < 2; ++half) {
            const int j = 2 * st + half;
            const LAS unsigned char* Kt = lds + (st & 1) * 65536 + half * 32768; const LAS unsigned char* Vt = Kt + 16384;
            if (64 * j <= q0 + 31) {
                const int nmin = q0 - (64 * j + 63);
                const bool first = (mrun == -INFINITY);
                const float cinit = first ? 0.f : (nmin >= 113 ? bias_far - mrun : -mrun);
                f32x16 p0, p1;
#pragma unroll
                for (int r = 0; r < 16; ++r) { p0[r] = cinit; p1[r] = cinit; }
#pragma unroll
                for (int ks = 0; ks < 4; ++ks) { const unsigned ch = (unsigned)(8 * map + 2 * ks + hi) ^ xr;
                    const bf16x8 k0 = *(const LAS bf16x8*)(Kt + 256u * r32 + 16u * ch), k1 = *(const LAS bf16x8*)(Kt + 256u * (32 + r32) + 16u * ch);
                    p0 = __builtin_amdgcn_mfma_f32_32x32x16_bf16(k0, qf[ks], p0, 0, 0, 0); p1 = __builtin_amdgcn_mfma_f32_32x32x16_bf16(k1, qf[ks], p1, 0, 0, 0); }
                __builtin_amdgcn_sched_barrier(0);
                float rm = -INFINITY;
                if (first) {
                    if (nmin >= 113) {
#pragma unroll
                        for (int r = 0; r < 16; ++r) { p0[r] = p0[r] + bias_far; p1[r] = p1[r] + bias_far; rm = fmaxf(rm, fmaxf(p0[r], p1[r])); }
                    } else {
                        const LAS float* tb = tbl + (qrow - 64 * j - 4 * hi + 5);
#pragma unroll
                        for (int r = 0; r < 16; ++r) { const int e = (r & 3) + 8 * (r >> 2);
                            p0[r] += tb[59 - e]; p1[r] += tb[27 - e];
                            rm = fmaxf(rm, fmaxf(p0[r], p1[r])); }
                    }
                    { auto rr = __builtin_amdgcn_permlane32_swap(__float_as_uint(rm), __float_as_uint(rm), false, false); rm = fmaxf(__uint_as_float(rr[0]), __uint_as_float(rr[1])); }
                    mrun = rm;
#pragma unroll
                    for (int r = 0; r < 16; ++r) { p0[r] -= mrun; p1[r] -= mrun; }
                } else {
                    if (nmin < 113) {
                        const LAS float* tb = tbl + (qrow - 64 * j - 4 * hi + 5);
                        float bv0[16], bv1[16];
#pragma unroll
                        for (int r = 0; r < 16; ++r) { const int e = (r & 3) + 8 * (r >> 2); bv0[r] = tb[59 - e]; bv1[r] = tb[27 - e]; }
#pragma unroll
                        for (int r = 0; r < 16; ++r) { p0[r] += bv0[r]; p1[r] += bv1[r]; }
                    }
                    { float m0 = fmaxf(p0[0], p1[0]), m1 = fmaxf(p0[1], p1[1]);
#pragma unroll
                      for (int r = 2; r < 16; r += 2) { m0 = __builtin_fmaxf(__builtin_fmaxf(m0, p0[r]), p1[r]); m1 = __builtin_fmaxf(__builtin_fmaxf(m1, p0[r + 1]), p1[r + 1]); }
                      rm = fmaxf(m0, m1); }
                    { auto rr = __builtin_amdgcn_permlane32_swap(__float_as_uint(rm), __float_as_uint(rm), false, false); rm = fmaxf(__uint_as_float(rr[0]), __uint_as_float(rr[1])); }
                    if (__any(rm > 8.0f)) {
                        const float dl = fmaxf(rm, 0.f); const float alpha = fast_exp2(-dl);
                        lrun *= alpha; mrun += dl;
#pragma unroll
                        for (int r = 0; r < 16; ++r) { p0[r] -= dl; p1[r] -= dl; }
#pragma unroll
                        for (int c = 0; c < 4; ++c)
#pragma unroll
                            for (int r = 0; r < 16; ++r) o[c][r] *= alpha;
                    }
                }
                float psa = 0.f, psb = 0.f;
                bf16x8 pf[4];
#define ATT_EXPK(ks_) do { u32x4 w_; _Pragma("unroll") for (int q = 0; q < 4; ++q) { const int r = 8 * ((ks_) & 1) + 2 * q; \
                        const float ea = fast_exp2((ks_) < 2 ? p0[r] : p1[r]), eb = fast_exp2((ks_) < 2 ? p0[r + 1] : p1[r + 1]); psa += ea; psb += eb; w_[q] = cvt_pk_bf16(ea, eb); } \
                    pf[ks_] = __builtin_bit_cast(bf16x8, w_); } while (0)
                bf16x8 vf[2][4];
#define ATT_LOADV(buf, ks_) do { _Pragma("unroll") for (int c = 0; c < 4; ++c) { const unsigned chv = (unsigned)(4 * c + 2 * blk + (pp >> 1)); const unsigned row0 = 16u * (ks_) + 4u * hi + q4; \
                        vf[buf][c] = cat8(vtr(Vt + off_b(row0, chv) + 8u * (pp & 1)), vtr(Vt + off_b(row0 + 8u, chv) + 8u * (pp & 1))); } } while (0)
                ATT_LOADV(0, 0);
                ATT_EXPK(0);
                if (ATT_LATE_DMA && half == 0 && st + 1 < NS) {
                    LAS unsigned char* nb = lds + ((st + 1) & 1) * 65536; const size_t ro = (size_t)(st + 1) * 128 * NP;
                    tile_dma(Kg + ro, nb, wave, lane); tile_dma(Vg + ro, nb + 16384, wave, lane); tile_dma(Kg + ro + (size_t)64 * NP, nb + 32768, wave, lane); tile_dma(Vg + ro + (size_t)64 * NP, nb + 49152, wave, lane); }
#pragma unroll
                for (int ks = 0; ks < 4; ++ks) {
                    if (ks < 3) ATT_LOADV((ks + 1) & 1, ks + 1);
                    __builtin_amdgcn_sched_barrier(0);
#pragma unroll
                    for (int c = 0; c < 4; ++c) o[c] = __builtin_amdgcn_mfma_f32_32x32x16_bf16(vf[ks & 1][c], pf[ks], o[c], 0, 0, 0);
                    if (ks < 3) { ATT_EXPK(ks + 1); asm volatile("" : "+v"(pf[(ks + 1) & 3]), "+v"(psa), "+v"(psb)); }
                    __builtin_amdgcn_sched_barrier(0);
                }
                lrun += psa + psb;
#undef ATT_EXPK
#undef ATT_LOADV
            }
#if ATT_DMA == 5
            if (half == 0) WAIT_ALL_BAR();
#endif
#if !ATT_DMA
            if (st + 1 < NS) { LAS unsigned char* nb = lds + ((st + 1) & 1) * 65536 + half * 32768; tile_write(nb, tid, a0); tile_write(nb + 16384, tid, a1);
                if (half == 0) { const size_t ro = (size_t)(st + 1) * 128 * NP + (size_t)64 * NP; a0 = tile_load(Kg + ro, tid); a1 = tile_load(Vg + ro, tid); } }
#endif
        }
#if ATT_DMA == 3
        WAIT_ALL_BAR();
        if (st + 1 < NS) { LAS unsigned char* nb = lds + ((st + 1) & 1) * 65536; const size_t ro = (size_t)(st + 1) * 128 * NP;
            tile_dma(Kg + ro, nb, wave, lane); tile_dma(Vg + ro, nb + 16384, wave, lane); tile_dma(Kg + ro + (size_t)64 * NP, nb + 32768, wave, lane); tile_dma(Vg + ro + (size_t)64 * NP, nb + 49152, wave, lane); }
#endif

    }
    WAIT_ALL_BAR();
    lrun += __shfl_xor(lrun, 32);
    const float inv = 1.0f / lrun;
    float lam;
    { float s1 = 0.f, s2 = 0.f; const float a1 = p.in[10][lane] * p.in[11][lane], a2 = p.in[12][lane] * p.in[13][lane]; s1 = wave_sum(a1); s2 = wave_sum(a2);
      const float lam_init = 0.8f - 0.6f * 1.0f;
      lam = expf(s1) - expf(s2) + lam_init; }
    LAS float* xch = (LAS float*)lds + qs * 4096;
    if (map == 1) {
#pragma unroll
        for (int c = 0; c < 4; ++c)
#pragma unroll
            for (int r = 0; r < 16; ++r) xch[(32 * c + crow(r, hi)) * 32 + r32] = o[c][r] * inv * lam;
    }
    __syncthreads();
    if (map == 0) {
        float ss = 0.f;
#pragma unroll
        for (int c = 0; c < 4; ++c)
#pragma unroll
            for (int r = 0; r < 16; ++r) { const float v = o[c][r] * inv - xch[(32 * c + crow(r, hi)) * 32 + r32]; o[c][r] = v; ss += v * v; }
        ss += __shfl_xor(ss, 32);
        const float rstd = 1.0f / sqrtf(ss * (1.0f / 128.0f) + NORM_EPS) * 0.8f;
        const float* sub = p.in[14];
        bf16_t* orow = CAT + (rowbase + qrow) * D + 512 + hd * 128;
#pragma unroll
        for (int c = 0; c < 4; ++c)
#pragma unroll
            for (int rq = 0; rq < 4; ++rq) { const int e0 = 32 * c + 8 * rq + 4 * hi; const f32x4 sv = *(const f32x4*)(sub + e0);
                u32x2 w; w.x = cvt_pk_bf16(o[c][4 * rq] * rstd * sv[0], o[c][4 * rq + 1] * rstd * sv[1]); w.y = cvt_pk_bf16(o[c][4 * rq + 2] * rstd * sv[2], o[c][4 * rq + 3] * rstd * sv[3]);
                *(u32x2*)(orow + e0) = w; }
    }
    __syncthreads();
}

__device__ __forceinline__ void mlstm_s1_unit(const Params& p, LAS unsigned char* lds, int bh, int c, int tid_, int wave, int lane_) {
    int tid = tid_; asm volatile("" : "+v"(tid)); const int lane = tid & 63;
    const bf16_t* P = (const bf16_t*)(p.ws + WS_P);
    const int b = bh >> 2, hd = bh & 3, r32 = lane & 31, hi = lane >> 5;
    const size_t t0 = (size_t)b * SEQ + (size_t)c * MCH;
    const float* SA = (const float*)(p.ws + WS_SA) + (size_t)bh * SEQ + c * MCH;
    LAS float* fs = (LAS float*)(lds + MISC_OFF) + MW_F;
    LAS float* wsm = fs;
    LAS float* red = fs + 256;
    float av = (tid < 256) ? SA[tid] : -INFINITY;
    float mx = av;
#pragma unroll
    for (int o = 1; o < 64; o <<= 1) mx = fmaxf(mx, __shfl_xor(mx, o));
    if (lane == 0) red[wave] = mx;
    __syncthreads();
    float R = red[0];
#pragma unroll
    for (int w = 1; w < 4; ++w) R = fmaxf(R, red[w]);
    if (tid < 256) wsm[tid] = __expf(av - R) * 0.08838834764831845f;
    __syncthreads();
    LAS unsigned char* Kl = lds; LAS unsigned char* Vl = lds + 65536;
    const bf16_t* Kg = P + t0 * NP + P_MK + hd * 128; const bf16_t* Vg = P + t0 * NP + P_MV + hd * 128;
#pragma unroll
    for (int i = 0; i < 8; ++i) { const int n = tid + 512 * i, row = n >> 4, ch = n & 15;
        const u32x4 kv = *(const u32x4*)(Kg + (size_t)row * NP + ch * 8); const u32x4 vv = *(const u32x4*)(Vg + (size_t)row * NP + ch * 8);
        const float w = wsm[row]; u32x4 ks;
#pragma unroll
        for (int q = 0; q < 4; ++q) ks[q] = cvt_pk_bf16(bf_lo(kv[q]) * w, bf_hi(kv[q]) * w);
        *(LAS u32x4*)(Kl + off_b(row, ch)) = ks; *(LAS u32x4*)(Vl + off_b(row, ch)) = vv; }
    __syncthreads();
    const int eb = wave >> 1, dh = wave & 1;
    const unsigned q4 = (lane & 15) >> 2, pp = lane & 3, blk = (lane >> 4) & 1;
    f32x16 acc[2]; acc[0] = (f32x16){}; acc[1] = (f32x16){};
    for (int ks = 0; ks < 16; ++ks) {
        const unsigned row0 = 16u * ks + 8u * hi + q4, row1 = row0 + 4u;
        const unsigned cha = (unsigned)(4 * eb + 2 * blk + (pp >> 1));
        const bf16x8 af = cat8(vtr(Vl + off_b(row0, cha) + 8u * (pp & 1)), vtr(Vl + off_b(row1, cha) + 8u * (pp & 1)));
#pragma unroll
        for (int db = 0; db < 2; ++db) { const unsigned chb = (unsigned)(4 * (2 * dh + db) + 2 * blk + (pp >> 1));
            const bf16x8 bfr = cat8(vtr(Kl + off_b(row0, chb) + 8u * (pp & 1)), vtr(Kl + off_b(row1, chb) + 8u * (pp & 1)));
            acc[db] = __builtin_amdgcn_mfma_f32_32x32x16_bf16(af, bfr, acc[db], 0, 0, 0); }
    }
    const int unit = bh * NCH + c;
    float* UT = (float*)(p.ws + WS_UT) + (size_t)unit * 16384;
#pragma unroll
    for (int db = 0; db < 2; ++db)
#pragma unroll
        for (int r = 0; r < 16; ++r) UT[(32 * eb + crow(r, hi)) * 128 + 64 * dh + 32 * db + r32] = acc[db][r];
    if (tid < 128) { float s = 0.f; const int d = tid;
        for (int srow = 0; srow < 256; ++srow) { const unsigned short hv = *(const LAS unsigned short*)(Kl + off_b(srow, d >> 3) + (d & 7) * 2); s += __uint_as_float((unsigned)hv << 16); }
        ((float*)(p.ws + WS_UN))[(size_t)unit * 128 + d] = s; }
    if (tid == 0) ((float*)(p.ws + WS_UR))[unit] = R;
    __syncthreads();
}

__device__ __forceinline__ void mlstm_s3_unit(const Params& p, LAS unsigned char* lds, int bh, int c, int tid_, int wave, int lane_) {
    int tid = tid_; asm volatile("" : "+v"(tid)); const int lane = tid & 63;
    const bf16_t* P = (const bf16_t*)(p.ws + WS_P); bf16_t* CAT = (bf16_t*)(p.ws + WS_CAT);
    const int b = bh >> 2, hd = bh & 3, r32 = lane & 31, hi = lane >> 5;
    const size_t t0 = (size_t)b * SEQ + (size_t)c * MCH;
    const size_t so = (size_t)bh * SEQ + c * MCH;
    const float* SA = (const float*)(p.ws + WS_SA) + so; const float* SAM = (const float*)(p.ws + WS_SAM) + so; const float* SBA = (const float*)(p.ws + WS_SBA) + so;
    LAS float* fs = (LAS float*)(lds + MISC_OFF) + MW_F;
    LAS float* as = fs;
    LAS float* nC = fs + 256;
    LAS unsigned char* Ct = lds + 65536;
    const int qloc = 32 * wave + r32;
    const float Aq = SAM[qloc], BAq = SBA[qloc];
    if (tid < 256) as[tid] = SA[tid];
    bf16x8 qf[8];
    { const bf16_t* qp = P + (t0 + qloc) * NP + P_MQ + hd * 128 + hi * 8;
#pragma unroll
      for (int ks = 0; ks < 8; ++ks) qf[ks] = *(const bf16x8*)(qp + ks * 16); }
    const bf16_t* Kg = P + t0 * NP + P_MK + hd * 128; const bf16_t* Vg = P + t0 * NP + P_MV + hd * 128;
#if defined(S3_REGSTAGE)
    { TileRegs k0 = tile_load(Kg, tid), v0 = tile_load(Vg, tid); tile_write(lds, tid, k0); tile_write(lds + 16384, tid, v0); }
#elif !defined(S3_SERIAL)
    tile_dma(Kg, lds, wave, lane); tile_dma(Vg, lds + 16384, wave, lane);
#endif
    f32x16 o[4];
#pragma unroll
    for (int cb = 0; cb < 4; ++cb) o[cb] = (f32x16){};
    float den = 0.f, fst = 0.f;
    const unsigned xr = ((unsigned)(r32 & 3) << 2) | ((unsigned)(r32 >> 2) & 3u);
    if (c > 0) {
        const float* UR = (const float*)(p.ws + WS_UR) + bh * NCH; const float* UT = (const float*)(p.ws + WS_UT) + (size_t)bh * NCH * 16384; const float* UN = (const float*)(p.ws + WS_UN) + (size_t)bh * NCH * 128;
        float Pref = -INFINITY, ur[7];
#pragma unroll
        for (int j = 0; j < 7; ++j) { ur[j] = UR[j]; if (j < c) Pref = fmaxf(Pref, ur[j]); }
        float cf[7];
#pragma unroll
        for (int j = 0; j < 7; ++j) cf[j] = (j < c) ? __expf(ur[j] - Pref) : 0.f;
#pragma unroll 1
        for (int i = 0; i < 4; ++i) { const int n = tid + 512 * i, e = n >> 4, ch = n & 15; f32x4 u0[7], u1[7];
#pragma unroll
            for (int j = 0; j < 7; ++j) { const f32x4* up = (const f32x4*)(UT + (size_t)j * 16384 + e * 128 + ch * 8); u0[j] = up[0]; u1[j] = up[1]; }
            f32x4 s0 = (f32x4){0.f, 0.f, 0.f, 0.f}, s1 = s0;
#pragma unroll
            for (int j = 0; j < 7; ++j) { s0 += u0[j] * cf[j]; s1 += u1[j] * cf[j]; }
            u32x4 w; w.x = cvt_pk_bf16(s0[0], s0[1]); w.y = cvt_pk_bf16(s0[2], s0[3]); w.z = cvt_pk_bf16(s1[0], s1[1]); w.w = cvt_pk_bf16(s1[2], s1[3]);
            *(LAS u32x4*)(Ct + off_b(e, ch)) = w; }
        if (tid < 128) { float sN = 0.f;
#pragma unroll
            for (int j = 0; j < 7; ++j) sN += cf[j] * UN[j * 128 + tid];
            nC[tid] = sN; }
        fst = __expf(Pref - Aq);
    }
    asm volatile("" :: "v"(qf[0]), "v"(qf[1]), "v"(qf[2]), "v"(qf[3]), "v"(qf[4]), "v"(qf[5]), "v"(qf[6]), "v"(qf[7]), "v"(Aq), "v"(BAq));
    WAIT_ALL_BAR();
    if (c > 0) {
#pragma unroll
        for (int cb = 0; cb < 4; ++cb) {
#pragma unroll
            for (int ks = 0; ks < 8; ++ks) { const unsigned ch = (unsigned)(2 * ks + hi) ^ xr;
                const bf16x8 cfr = *(const LAS bf16x8*)(Ct + 256u * (32 * cb + r32) + 16u * ch);
                o[cb] = __builtin_amdgcn_mfma_f32_32x32x16_bf16(cfr, qf[ks], o[cb], 0, 0, 0); }
            __builtin_amdgcn_sched_barrier(0); }
#pragma unroll
        for (int cb = 0; cb < 4; ++cb)
#pragma unroll
            for (int r = 0; r < 16; ++r) o[cb][r] *= fst;
        float dq = 0.f;
#pragma unroll
        for (int ks = 0; ks < 8; ++ks)
#pragma unroll
            for (int q = 0; q < 4; ++q) { const unsigned w = ((const unsigned*)&qf[ks])[q]; const int d = 16 * ks + 8 * hi + 2 * q; dq += bf_lo(w) * nC[d] + bf_hi(w) * nC[d + 1]; }
        den = fst * dq;
    }
    const unsigned q4 = (lane & 15) >> 2, pp = lane & 3, blk = (lane >> 4) & 1;
#pragma unroll 1
    for (int j = 0; j < 4; ++j) {
        WAIT_ALL_BAR();
        const LAS unsigned char* Kt = lds + (j & 1) * 32768; const LAS unsigned char* Vt = Kt + 16384;
#if defined(S3_REGSTAGE)
        TileRegs kr, vr; if (j + 1 < 4) { kr = tile_load(Kg + (size_t)(j + 1) * 64 * NP, tid); vr = tile_load(Vg + (size_t)(j + 1) * 64 * NP, tid); }
#elif defined(S3_SERIAL)
        { LAS unsigned char* nb = lds + (j & 1) * 32768; tile_dma(Kg + (size_t)j * 64 * NP, nb, wave, lane); tile_dma(Vg + (size_t)j * 64 * NP, nb + 16384, wave, lane); }
        WAIT_ALL_BAR();
#else
        if (j + 1 < 4) { LAS unsigned char* nb = lds + ((j + 1) & 1) * 32768; tile_dma(Kg + (size_t)(j + 1) * 64 * NP, nb, wave, lane); tile_dma(Vg + (size_t)(j + 1) * 64 * NP, nb + 16384, wave, lane); }
#endif
        const bool doit = (64 * j <= 32 * wave + 31);
        bf16x8 pf[4];
        if (doit) {
            f32x16 p0 = (f32x16){}, p1 = (f32x16){};
#pragma unroll
            for (int ks = 0; ks < 8; ++ks) { const unsigned ch = (unsigned)(2 * ks + hi) ^ xr;
                const bf16x8 k0 = *(const LAS bf16x8*)(Kt + 256u * r32 + 16u * ch), k1 = *(const LAS bf16x8*)(Kt + 256u * (32 + r32) + 16u * ch);
                p0 = __builtin_amdgcn_mfma_f32_32x32x16_bf16(k0, qf[ks], p0, 0, 0, 0); p1 = __builtin_amdgcn_mfma_f32_32x32x16_bf16(k1, qf[ks], p1, 0, 0, 0); if ((ks & 3) == 3) __builtin_amdgcn_sched_barrier(0); }
            float ps = 0.f;
#pragma unroll
            for (int r = 0; r < 16; ++r) { const int kv = 64 * j + crow(r, hi);
                const float w0 = (kv <= qloc) ? __expf(as[kv] - Aq) * 0.08838834764831845f : 0.f, w1 = (kv + 32 <= qloc) ? __expf(as[kv + 32] - Aq) * 0.08838834764831845f : 0.f;
                p0[r] *= w0; p1[r] *= w1; ps += p0[r] + p1[r]; }
            den += ps;
#pragma unroll
            for (int ks = 0; ks < 4; ++ks) { u32x4 w;
#pragma unroll
                for (int q = 0; q < 4; ++q) { const int r = 8 * (ks & 1) + 2 * q; w[q] = (ks < 2) ? cvt_pk_bf16(p0[r], p0[r + 1]) : cvt_pk_bf16(p1[r], p1[r + 1]); }
                pf[ks] = __builtin_bit_cast(bf16x8, w); }
        }
        WAIT_ALL_BAR();
        if (doit) {
            bf16x8 vf[2][4];
#define S3_LOADV(buf, ks_) do { _Pragma("unroll") for (int cb = 0; cb < 4; ++cb) { const unsigned chv = (unsigned)(4 * cb + 2 * blk + (pp >> 1)); const unsigned row0 = 16u * (ks_) + 4u * hi + q4; \
                vf[buf][cb] = cat8(vtr(Vt + off_b(row0, chv) + 8u * (pp & 1)), vtr(Vt + off_b(row0 + 8u, chv) + 8u * (pp & 1))); } } while (0)
            S3_LOADV(0, 0);
#pragma unroll
            for (int ks = 0; ks < 4; ++ks) {
                if (ks < 3) S3_LOADV((ks + 1) & 1, ks + 1);
                __builtin_amdgcn_sched_barrier(0);
#pragma unroll
                for (int cb = 0; cb < 4; ++cb) o[cb] = __builtin_amdgcn_mfma_f32_32x32x16_bf16(vf[ks & 1][cb], pf[ks], o[cb], 0, 0, 0);
                __builtin_amdgcn_sched_barrier(0);
            }
#undef S3_LOADV
        }
#if defined(S3_REGSTAGE)
        if (j + 1 < 4) { LAS unsigned char* nb = lds + ((j + 1) & 1) * 32768; tile_write(nb, tid, kr); tile_write(nb + 16384, tid, vr); }
#endif
    }
    den += __shfl_xor(den, 32);
    const float dinv = 1.0f / fmaxf(fabsf(den), __expf(-BAq));
    float sm = 0.f;
#pragma unroll
    for (int cb = 0; cb < 4; ++cb)
#pragma unroll
        for (int r = 0; r < 16; ++r) { o[cb][r] *= dinv; sm += o[cb][r]; }
    sm += __shfl_xor(sm, 32);
    const float mu = sm * (1.0f / 128.0f);
    float vs = 0.f;
#pragma unroll
    for (int cb = 0; cb < 4; ++cb)
#pragma unroll
        for (int r = 0; r < 16; ++r) { o[cb][r] -= mu; vs += o[cb][r] * o[cb][r]; }
    vs += __shfl_xor(vs, 32);
    const float rstd = 1.0f / sqrtf(vs * (1.0f / 128.0f) + NORM_EPS);
    const float* hn = p.in[9] + hd * 128;
    const bf16_t* mo = P + (t0 + qloc) * NP + P_MO + hd * 128;
    bf16_t* orow = CAT + (t0 + qloc) * D + hd * 128;
    u32x2 mw[4][4];
#pragma unroll
    for (int cb = 0; cb < 4; ++cb)
#pragma unroll
        for (int rq = 0; rq < 4; ++rq) mw[cb][rq] = *(const u32x2*)(mo + 32 * cb + 8 * rq + 4 * hi);
#pragma unroll
    for (int cb = 0; cb < 4; ++cb)
#pragma unroll
        for (int rq = 0; rq < 4; ++rq) { const int e0 = 32 * cb + 8 * rq + 4 * hi; const f32x4 hv = *(const f32x4*)(hn + e0); const u32x2 m2 = mw[cb][rq];
            const float g0 = fast_rcp(1.0f + __expf(-bf_lo(m2.x))), g1 = fast_rcp(1.0f + __expf(-bf_hi(m2.x))), g2 = fast_rcp(1.0f + __expf(-bf_lo(m2.y))), g3 = fast_rcp(1.0f + __expf(-bf_hi(m2.y)));
            u32x2 w; w.x = cvt_pk_bf16(o[cb][4 * rq] * rstd * hv[0] * g0, o[cb][4 * rq + 1] * rstd * hv[1] * g1); w.y = cvt_pk_bf16(o[cb][4 * rq + 2] * rstd * hv[2] * g2, o[cb][4 * rq + 3] * rstd * hv[3] * g3);
            *(u32x2*)(orow + e0) = w; }
    WAIT_ALL_BAR();
}

__device__ __forceinline__ void mlstm_seq_unit(const Params& p, LAS unsigned char* lds, int bh, int tid_, int wave, int lane_) {
    int tid = tid_; asm volatile("" : "+v"(tid)); const int lane = tid & 63;
    const bf16_t* P = (const bf16_t*)(p.ws + WS_P); bf16_t* CAT = (bf16_t*)(p.ws + WS_CAT);
    const int b = bh >> 2, hd = bh & 3, r32 = lane & 31, hi = lane >> 5;
    LAS float* fs = (LAS float*)(lds + MISC_OFF) + MW_F;
    LAS float* as = fs;
    LAS float* nC = fs + 256;
    LAS float* wsc = fs + 384;
    LAS unsigned char* Ct = lds + 65536;
    const unsigned xr = ((unsigned)(r32 & 3) << 2) | ((unsigned)(r32 >> 2) & 3u);
    const unsigned q4 = (lane & 15) >> 2, pp = lane & 3, blk = (lane >> 4) & 1;
    const int eb = wave >> 1, dh = wave & 1;
    f32x16 cacc[2]; cacc[0] = (f32x16){}; cacc[1] = (f32x16){};
    float nrun = 0.f;
    float Prun = -INFINITY;
    LAS float* hnl = fs + 896;
    if (tid < 128) hnl[tid] = p.in[9][hd * 128 + tid];
#pragma unroll 1
    for (int c = 0; c < NCH; ++c) {
        const size_t t0 = (size_t)b * SEQ + (size_t)c * MCH;
        const size_t so = (size_t)bh * SEQ + c * MCH;
        const float* SA = (const float*)(p.ws + WS_SA) + so; const float* SAM = (const float*)(p.ws + WS_SAM) + so; const float* SBA = (const float*)(p.ws + WS_SBA) + so;
        const int qloc = 32 * wave + r32;
        const float Aq2 = SAM[qloc] * 1.4426950408889634f;
        if (tid < 256) as[tid] = SA[tid] * 1.4426950408889634f;
        bf16x8 qf[2];
        LAS bf16x8* qpark = (LAS bf16x8*)(lds + 98304 + tid * 64);
        LAS bf16x8* qpark2 = (LAS bf16x8*)(lds + 147456 + tid * 32);
        { const bf16_t* qp = P + (t0 + qloc) * NP + P_MQ + hd * 128 + hi * 8;
#pragma unroll
          for (int ks = 0; ks < 2; ++ks) qf[ks] = *(const bf16x8*)(qp + ks * 16);
#pragma unroll
          for (int ks = 2; ks < 6; ++ks) qpark[ks - 2] = *(const bf16x8*)(qp + ks * 16);
#pragma unroll
          for (int ks = 6; ks < 8; ++ks) qpark2[ks - 6] = *(const bf16x8*)(qp + ks * 16); }
#define QFRAG(ks) ((ks) < 2 ? qf[(ks) & 1] : ((ks) < 6 ? qpark[((ks) - 2) & 3] : qpark2[((ks) - 6) & 1]))
        const bf16_t* Kg = P + t0 * NP + P_MK + hd * 128; const bf16_t* Vg = P + t0 * NP + P_MV + hd * 128;
        tile_dma(Kg, lds, wave, lane); tile_dma(Vg, lds + 16384, wave, lane);
        asm volatile("" :: "v"(qf[0]), "v"(qf[1]), "v"(Aq2));
        WAIT_ALL_BAR();
        float R = fmaxf(fmaxf(as[lane], as[lane + 64]), fmaxf(as[lane + 128], as[lane + 192]));
#pragma unroll
        for (int o = 1; o < 64; o <<= 1) R = fmaxf(R, __shfl_xor(R, o));
        R *= (1.0f / 1.4426950408889634f);
        const float Pnew = fmaxf(Prun, R);
        const float scC = (c > 0) ? __expf(Prun - Pnew) : 0.f;
        if (tid < 256) wsc[tid] = fast_exp2(as[tid] - Pnew * 1.4426950408889634f) * 0.08838834764831845f;
        f32x16 o[4];
#pragma unroll
        for (int cb = 0; cb < 4; ++cb) o[cb] = (f32x16){};
        float den = 0.f;
        if (c > 0) {
#pragma unroll
            for (int cb = 0; cb < 4; ++cb) {
#pragma unroll
                for (int ks = 0; ks < 8; ++ks) { const unsigned ch = (unsigned)(2 * ks + hi) ^ xr;
                    const bf16x8 cfr = *(const LAS bf16x8*)(Ct + 256u * (32 * cb + r32) + 16u * ch);
                    const bf16x8 qv = QFRAG(ks);
                    o[cb] = __builtin_amdgcn_mfma_f32_32x32x16_bf16(cfr, qv, o[cb], 0, 0, 0); }
                __builtin_amdgcn_sched_barrier(0); }
            const float fst = fast_exp2(Prun * 1.4426950408889634f - Aq2);
#pragma unroll
            for (int cb = 0; cb < 4; ++cb)
#pragma unroll
                for (int r = 0; r < 16; ++r) o[cb][r] *= fst;
            float dq = 0.f;
#pragma unroll
            for (int ks = 0; ks < 8; ++ks) { const bf16x8 qv = QFRAG(ks);
#pragma unroll
                for (int q = 0; q < 4; ++q) { const unsigned w = ((const unsigned*)&qv)[q]; const int d = 16 * ks + 8 * hi + 2 * q; dq += bf_lo(w) * nC[d] + bf_hi(w) * nC[d + 1]; } }
            den = fst * dq;
#pragma unroll
            for (int r = 0; r < 16; ++r) { cacc[0][r] *= scC; cacc[1][r] *= scC; }
        }
        nrun *= scC;
#pragma unroll 1
        for (int j = 0; j < 4; ++j) {
            WAIT_ALL_BAR();
            const LAS unsigned char* Kt = lds + (j & 1) * 32768; const LAS unsigned char* Vt = Kt + 16384;
            if (j + 1 < 4) { LAS unsigned char* nb = lds + ((j + 1) & 1) * 32768; tile_dma(Kg + (size_t)(j + 1) * 64 * NP, nb, wave, lane); tile_dma(Vg + (size_t)(j + 1) * 64 * NP, nb + 16384, wave, lane); }
            const bool doit = (64 * j <= 32 * wave + 31);
            if (doit) {
                float ps = 0.f;
#pragma unroll
                for (int hf = 0; hf < 2; ++hf) {
                    f32x16 pp0 = (f32x16){};
#pragma unroll
                    for (int ks = 0; ks < 8; ++ks) { const unsigned ch = (unsigned)(2 * ks + hi) ^ xr;
                        const bf16x8 k0 = *(const LAS bf16x8*)(Kt + 256u * (32 * hf + r32) + 16u * ch);
                        const bf16x8 qv = QFRAG(ks);
                        pp0 = __builtin_amdgcn_mfma_f32_32x32x16_bf16(k0, qv, pp0, 0, 0, 0); }
#pragma unroll
                    for (int r = 0; r < 16; ++r) { const int kv = 64 * j + 32 * hf + crow(r, hi);
                        const float w0 = (kv <= qloc) ? fast_exp2(as[kv] - Aq2) * 0.08838834764831845f : 0.f;
                        pp0[r] *= w0; ps += pp0[r]; }
                    bf16x8 pfh[2];
#pragma unroll
                    for (int k2 = 0; k2 < 2; ++k2) { u32x4 w;
#pragma unroll
                        for (int q = 0; q < 4; ++q) { const int r = 8 * k2 + 2 * q; w[q] = cvt_pk_bf16(pp0[r], pp0[r + 1]); }
                        pfh[k2] = __builtin_bit_cast(bf16x8, w); }
                    __builtin_amdgcn_sched_barrier(0);
#pragma unroll
                    for (int k2 = 0; k2 < 2; ++k2)
#pragma unroll
                        for (int c2 = 0; c2 < 2; ++c2) {
                            bf16x8 vf[2];
#pragma unroll
                            for (int u = 0; u < 2; ++u) { const int cb = 2 * c2 + u; const unsigned chv = (unsigned)(4 * cb + 2 * blk + (pp >> 1)); const unsigned row0 = 16u * (2 * hf + k2) + 4u * hi + q4;
                                vf[u] = cat8(vtr(Vt + off_b(row0, chv) + 8u * (pp & 1)), vtr(Vt + off_b(row0 + 8u, chv) + 8u * (pp & 1))); }
                            o[2 * c2] = __builtin_amdgcn_mfma_f32_32x32x16_bf16(vf[0], pfh[k2], o[2 * c2], 0, 0, 0); o[2 * c2 + 1] = __builtin_amdgcn_mfma_f32_32x32x16_bf16(vf[1], pfh[k2], o[2 * c2 + 1], 0, 0, 0);
                            __builtin_amdgcn_sched_barrier(0);
                        }
                }
                den += ps;
            }
#pragma unroll
            for (int ks = 0; ks < 4; ++ks) {
                const unsigned row0 = 16u * ks + 8u * hi + q4, row1 = row0 + 4u;
                const unsigned cha = (unsigned)(4 * eb + 2 * blk + (pp >> 1));
                const bf16x8 af = cat8(vtr(Vt + off_b(row0, cha) + 8u * (pp & 1)), vtr(Vt + off_b(row1, cha) + 8u * (pp & 1)));
                const f32x4 wa = *(const LAS f32x4*)(wsc + 64 * j + 16 * ks + 8 * hi), wb = *(const LAS f32x4*)(wsc + 64 * j + 16 * ks + 8 * hi + 4);
#pragma unroll
                for (int db = 0; db < 2; ++db) { const unsigned chb = (unsigned)(4 * (2 * dh + db) + 2 * blk + (pp >> 1));
                    const s16x4 k0 = vtr(Kt + off_b(row0, chb) + 8u * (pp & 1)), k1 = vtr(Kt + off_b(row1, chb) + 8u * (pp & 1));
                    const u32x2 u0 = __builtin_bit_cast(u32x2, k0), u1 = __builtin_bit_cast(u32x2, k1);
                    u32x4 kw; kw.x = cvt_pk_bf16(bf_lo(u0.x) * wa[0], bf_hi(u0.x) * wa[1]); kw.y = cvt_pk_bf16(bf_lo(u0.y) * wa[2], bf_hi(u0.y) * wa[3]);
                    kw.z = cvt_pk_bf16(bf_lo(u1.x) * wb[0], bf_hi(u1.x) * wb[1]); kw.w = cvt_pk_bf16(bf_lo(u1.y) * wb[2], bf_hi(u1.y) * wb[3]);
                    cacc[db] = __builtin_amdgcn_mfma_f32_32x32x16_bf16(af, __builtin_bit_cast(bf16x8, kw), cacc[db], 0, 0, 0); }
                __builtin_amdgcn_sched_barrier(0);
            }
            { const int d = tid & 127, sq = tid >> 7; float sN = 0.f;
#pragma unroll 4
                for (int s2 = 0; s2 < 16; ++s2) { const int srow = 16 * sq + s2; const unsigned short hv = *(const LAS unsigned short*)(Kt + off_b(srow, d >> 3) + (d & 7) * 2); sN += __uint_as_float((unsigned)hv << 16) * wsc[64 * j + srow]; }
                nrun += sN; }
            WAIT_ALL_BAR();
        }
        int tid2 = tid_; asm volatile("" : "+v"(tid2));
        const int qloc2 = 32 * wave + (tid2 & 31), hi2 = (tid2 >> 5) & 1;
        const float BAq = SBA[qloc2];
        den += __shfl_xor(den, 32);
        const float dinv = 1.0f / fmaxf(fabsf(den), __expf(-BAq));
        float sm = 0.f;
#pragma unroll
        for (int cb = 0; cb < 4; ++cb)
#pragma unroll
            for (int r = 0; r < 16; ++r) { o[cb][r] *= dinv; sm += o[cb][r]; }
        sm += __shfl_xor(sm, 32);
        const float mu = sm * (1.0f / 128.0f);
        float vs = 0.f;
#pragma unroll
        for (int cb = 0; cb < 4; ++cb)
#pragma unroll
            for (int r = 0; r < 16; ++r) { o[cb][r] -= mu; vs += o[cb][r] * o[cb][r]; }
        vs += __shfl_xor(vs, 32);
        const float rstd = 1.0f / sqrtf(vs * (1.0f / 128.0f) + NORM_EPS);
        const bf16_t* mo = P + (t0 + qloc2) * NP + P_MO + hd * 128 + 4 * hi2;
        bf16_t* orow = CAT + (t0 + qloc2) * D + hd * 128 + 4 * hi2;
#pragma unroll
        for (int c2 = 0; c2 < 2; ++c2) {
            u32x2 mw[8];
#pragma unroll
            for (int u = 0; u < 8; ++u) mw[u] = *(const u32x2*)(mo + 32 * (2 * c2 + (u >> 2)) + 8 * (u & 3));
#pragma unroll
            for (int u = 0; u < 8; ++u) { const int cb = 2 * c2 + (u >> 2), rq = u & 3; const int e0 = 32 * cb + 8 * rq; const u32x2 m2 = mw[u]; const f32x4 hv = *(const LAS f32x4*)(hnl + e0 + 4 * hi2);
                const float g0 = fast_rcp(1.0f + fast_exp2(-1.4426950408889634f * bf_lo(m2.x))), g1 = fast_rcp(1.0f + fast_exp2(-1.4426950408889634f * bf_hi(m2.x))), g2 = fast_rcp(1.0f + fast_exp2(-1.4426950408889634f * bf_lo(m2.y))), g3 = fast_rcp(1.0f + fast_exp2(-1.4426950408889634f * bf_hi(m2.y)));
                u32x2 w; w.x = cvt_pk_bf16(o[cb][4 * rq] * rstd * hv[0] * g0, o[cb][4 * rq + 1] * rstd * hv[1] * g1); w.y = cvt_pk_bf16(o[cb][4 * rq + 2] * rstd * hv[2] * g2, o[cb][4 * rq + 3] * rstd * hv[3] * g3);
                *(u32x2*)(orow + e0) = w; }
            __builtin_amdgcn_sched_barrier(0); }
        if (c + 1 < NCH) {
#pragma unroll
            for (int db = 0; db < 2; ++db)
#pragma unroll
                for (int r = 0; r < 16; ++r) { const int e = 32 * eb + crow(r, hi), d = 64 * dh + 32 * db + r32;
                    *(LAS unsigned short*)(Ct + off_b(e, d >> 3) + (d & 7) * 2) = (unsigned short)(cvt_pk_bf16(cacc[db][r], 0.f) & 0xffffu); }
            wsc[tid] = nrun;
        }
        Prun = Pnew;
        WAIT_ALL_BAR();
        if (c + 1 < NCH) { if (tid < 128) nC[tid] = (wsc[tid] + wsc[tid + 128]) + (wsc[tid + 256] + wsc[tid + 384]); }
    }
#undef QFRAG
}

__device__ __forceinline__ int moe_table(LAS unsigned char* lds, unsigned* cnt, int tid) {
    LAS int* misc = (LAS int*)(lds + MISC_OFF);
    __syncthreads();
    if (tid == 0) { int acc = 0; for (int e = 0; e < 16; ++e) { const int c = (int)__hip_atomic_load(cnt + e * 64, __ATOMIC_RELAXED, __HIP_MEMORY_SCOPE_AGENT); misc[MW_CN + e] = c; misc[MW_TB + e] = acc; acc += (c + 255) >> 8; } misc[MW_TB + 16] = acc; }
    __syncthreads();
    return misc[MW_TB + 16];
}

#ifndef STAGGER_MASK
#define STAGGER_MASK 0u
#endif
#ifndef STAGGER_GROUPS
#define STAGGER_GROUPS 4
#endif
#ifndef STAGGER_TICKS
#define STAGGER_TICKS 700
#endif
__device__ __forceinline__ void stagger(int vcu, int phase_bit) {
    if (!((STAGGER_MASK >> phase_bit) & 1u)) return;
    const int g = vcu & (STAGGER_GROUPS - 1); if (g == 0) return;
    const unsigned long long t0 = __builtin_amdgcn_s_memrealtime(); const unsigned long long w = (unsigned long long)g * STAGGER_TICKS;
    while (__builtin_amdgcn_s_memrealtime() - t0 < w) __builtin_amdgcn_s_sleep(8);
}
template <int LAYER>
__device__ __forceinline__ void moe_block(const Params& p, LAS unsigned char* lds, const XcdBarrier& bar, unsigned* ctl, int tid, int wave, int lane, int vcu, int G) {
    unsigned char* ws = p.ws;
    const LAS int* tb = (const LAS int*)(lds + MISC_OFF) + MW_TB; const LAS int* cn = (const LAS int*)(lds + MISC_OFF) + MW_CN;
    unsigned* cnt = ctl + CW_CNT + LAYER * 16 * 64;
    if (PH(12)) phase_router(p, lds, tid, wave, G, p.in[3] + LAYER * D, p.in[18] + (size_t)LAYER * D * 4, p.in[19] + LAYER * 4, p.in[20] + (size_t)LAYER * D * 16, p.in[21] + LAYER * 16, cnt);
    xcd_barrier(bar);
    const int ntot = moe_table(lds, cnt, tid);
    stagger(vcu, 13);
    for (int rep_ = 0; rep_ < REPS(13); ++rep_) if (PH(13)) { pg8::MoeSched<true> S{(const char*)(ws + WS_XB8), (const char*)(ws + WS_WGU) + (size_t)LAYER * 16 * 1024 * 1024, 512, (size_t)1024 * 1024, tb, cn, (const unsigned*)(ws + WS_ROWTOK), ntot, vcu, G};
      pg8::EpiPair<1> E{nullptr, (bf16_t*)(ws + WS_HM), FF, (const float*)(ws + WS_RSRAW), (const unsigned*)(ws + WS_ROWTOK), tb, cn};
      pg8::gemm_phase<pg8::EpiPair<1>, pg8::MoeSched<true>, true, true>(lds, 512, S, E); }
    xcd_barrier(bar);
    stagger(vcu, 14);
    for (int rep_ = 0; rep_ < REPS(14); ++rep_) if (PH(14)) { pg8::MoeSched<false> S{(const char*)(ws + WS_HM), (const char*)(ws + WS_WD) + (size_t)LAYER * 16 * 1024 * 512, 256, (size_t)1024 * 512, tb, cn, nullptr, ntot, vcu, G};
      pg8::EpiDown E{(unsigned char*)(ws + WS_YC), (const float*)(ws + WS_CWRAW), tb, cn};
      pg8::gemm_phase<pg8::EpiDown, pg8::MoeSched<false>, false, true>(lds, 256, S, E); }
    xcd_barrier(bar);
}

__global__ void __launch_bounds__(NTHR, 2) fwd_kernel(Params p) {
    extern __shared__ __attribute__((aligned(16))) unsigned char lds_raw[];
    LAS unsigned char* lds = (LAS unsigned char*)lds_raw;
    const int tid = threadIdx.x, lane = tid & 63, wave = __builtin_amdgcn_readfirstlane(tid >> 6);
    const int G = gridDim.x; const int bx = blockIdx.x;
    const int vcu = (G % 8 == 0) ? (bx % 8) * (G / 8) + bx / 8 : bx;
    const int gw = vcu * NWAVES + wave, NGW = G * NWAVES;
    volatile LAS unsigned* misc = (volatile LAS unsigned*)(lds + MISC_OFF);
    for (int u = tid; u < (LDS_BYTES - MISC_OFF) / 4; u += NTHR) misc[u] = 0u;
    __syncthreads();
    unsigned* ctl = (unsigned*)(p.ws + WS_CTL);
    XcdBarrier bar = xcd_barrier_post(ctl + CW_BAR, misc + MW_BAR);
    unsigned char* ws = p.ws;

    for (int rep_ = 0; rep_ < REPS(0); ++rep_) if (PH(0)) phase_prologue_weights(p, lds, gw, WT_I1, NGW, wave, lane);
    __syncthreads();
    for (int rep_ = 0; rep_ < REPS(1); ++rep_) if (PH(1)) phase_norm_gates(p, lds, tid, gw, NGW, lane);
    xcd_barrier(bar);

    if (PH(2)) phase_gate_scan(p, gw, NGW, lane);
    stagger(vcu, 3);
    for (int rep_ = 0; rep_ < REPS(3); ++rep_) if (PH(3)) { pg8::DenseSched S; S.init(ws + WS_H, ws + WS_WT1, T, NP, 1024, G, bx); pg8::EpiBf16 E{(bf16_t*)(ws + WS_P), NP};
      pg8::gemm_phase<pg8::EpiBf16, pg8::DenseSched, false>(lds, 1024, S, E); }
    xcd_barrier(bar);

    {
        constexpr int NSEQ = NBATCH * 4, NAT = NBATCH * 4 * 16, NMEM = WT_UNITS;
        for (int u = bx; u < NSEQ; u += G) { for (int r2 = 0; r2 < REPS(16); ++r2) if (PH(4)) mlstm_seq_unit(p, lds, u, tid, wave, lane); }
        for (int rep_ = 0; rep_ < REPS(4); ++rep_) {
            bool a_done = false, m_done = false; int sa_cnt = 0, sm_cnt = 0; (void)sa_cnt; (void)sm_cnt;
            for (int it = 0; !(a_done && m_done); ++it) {
                const int r5 = it % 5; bool want_mem = (r5 == 1 || r5 == 3);
                if (want_mem && m_done) want_mem = false; else if (!want_mem && a_done) want_mem = true;
                __syncthreads();
#ifdef STATIC_Q
                if (tid == 0) { misc[MW_Q] = (unsigned)((want_mem ? sm_cnt : sa_cnt) * G + bx); }
                if (want_mem) ++sm_cnt; else ++sa_cnt;
#else
                if (tid == 0) misc[MW_Q] = __hip_atomic_fetch_add(ctl + CW_QUEUE + 64 * (2 * rep_ + (want_mem ? 1 : 0)), 1u, __ATOMIC_RELAXED, __HIP_MEMORY_SCOPE_AGENT);
#endif
                __syncthreads();
                const int u = (int)misc[MW_Q];
                if (want_mem) {
                    if (u >= NMEM) { m_done = true; continue; }
                    { const int v = u; for (int r2 = 0; r2 < REPS(18); ++r2) if (PH(0)) { const int f = WT_I1 + 64 * v + 8 * wave; phase_prologue_weights(p, lds, f, f + 8, 1, wave, lane); } }
                } else {
                    if (u >= NAT) { a_done = true; continue; }
                    for (int r2 = 0; r2 < REPS(17); ++r2) if (PH(5)) attn_unit(p, lds, u & 127, 15 - (u >> 7), tid, wave, lane);
                }
            }
        }
    }
    xcd_barrier(bar);

    for (int rep_ = 0; rep_ < REPS(7); ++rep_) if (PH(7)) { pg8::DenseSched S; S.init(ws + WS_CAT, ws + WS_WT2, T, 1024, 1024, G, bx); pg8::EpiResid<true> E{p.in[0], (bf16_t*)(ws + WS_XB), ws + WS_XB8};
      pg8::gemm_phase<pg8::EpiResid<true>, pg8::DenseSched, false>(lds, 1024, S, E); }
    xcd_barrier(bar);

    moe_block<0>(p, lds, bar, ctl, tid, wave, lane, vcu, G);
    if (PH(8)) phase_rows<0, true>(p, lds, tid, wave, lane, G, p.in[2] + D, nullptr, nullptr, nullptr, nullptr, ctl + CW_CNT, nullptr);
    xcd_barrier(bar);
    stagger(vcu, 9);
    for (int rep_ = 0; rep_ < REPS(9); ++rep_) if (PH(9)) { pg8::DenseSched S; S.init(G3_F8 ? ws + WS_XB8 : ws + WS_XB, ws + WS_WT3, T, 3072, G3_F8 ? 512 : 1024, G, bx); pg8::EpiPair<0> E{(bf16_t*)(ws + WS_BG), (bf16_t*)(ws + WS_Z), D, (const float*)(ws + WS_RSTD), nullptr, nullptr, nullptr};
      pg8::gemm_phase<pg8::EpiPair<0>, pg8::DenseSched, false, G3_F8 != 0>(lds, G3_F8 ? 512 : 1024, S, E); }
    xcd_barrier(bar);
    for (int rep_ = 0; rep_ < REPS(10); ++rep_) if (PH(10)) phase_conv(p, gw, NGW, lane);
    xcd_barrier(bar);
    if (PH(11)) { pg8::DenseSched S; S.init(ws + WS_CAT, ws + WS_WT4, T, 1024, 1024, G, bx); pg8::EpiResid<false> E{nullptr, (bf16_t*)(ws + WS_XB), ws + WS_XB8};
      pg8::gemm_phase<pg8::EpiResid<false>, pg8::DenseSched, false>(lds, 1024, S, E); }
    xcd_barrier(bar);
    moe_block<1>(p, lds, bar, ctl, tid, wave, lane, vcu, G);
    if (PH(15)) phase_rows<2, true>(p, lds, tid, wave, lane, G, p.in[4], nullptr, nullptr, nullptr, nullptr, ctl + CW_CNT + 16 * 64, nullptr);
}

extern "C" void kernel_launch(void* const* d_in, const int* in_sizes, int n_in, void* d_out, int out_size, void* d_ws, size_t ws_size, hipStream_t stream) {
    static int grid = 0;
    if (grid == 0) {
        if (n_in != 25 || in_sizes[0] != T * D || out_size != T * D || ws_size < WS_END) { fprintf(stderr, "kernel_launch: unexpected shapes (n_in %d, in0 %d, out %d, ws %zu)\n", n_in, n_in > 0 ? in_sizes[0] : -1, out_size, ws_size); grid = -1; return; }
        int dev = 0, cus = 0, per_cu = 0;
        if (hipGetDevice(&dev) != hipSuccess || hipDeviceGetAttribute(&cus, hipDeviceAttributeMultiprocessorCount, dev) != hipSuccess) { grid = -1; return; }
        if (hipFuncSetAttribute((const void*)fwd_kernel, hipFuncAttributeMaxDynamicSharedMemorySize, LDS_BYTES) != hipSuccess) { fprintf(stderr, "kernel_launch: hipFuncSetAttribute failed\n"); grid = -1; return; }
        if (hipOccupancyMaxActiveBlocksPerMultiprocessor(&per_cu, (const void*)fwd_kernel, NTHR, LDS_BYTES) != hipSuccess || per_cu < 1) fprintf(stderr, "kernel_launch: occupancy query reports %d\n", per_cu);
        (void)hipGetLastError();
        grid = cus;
    }
    if (grid < 0) return;
    hipMemsetAsync((char*)d_ws + WS_CTL, 0, CTL_ZERO_BYTES, stream);
    Params p{};
    for (int i = 0; i < 25; ++i) p.in[i] = (const float*)d_in[i];
    p.out = (float*)d_out; p.ws = (unsigned char*)d_ws;
    hipLaunchKernelGGL(fwd_kernel, dim3(grid), dim3(NTHR), LDS_BYTES, stream, p);
}
```

```cpp
#include <hip/hip_runtime.h>
#include <cstdio>
#include <cstdint>
#ifndef PHASE_MASK
#define PHASE_MASK 0xffffffffu
#endif
#define PH(k) (((PHASE_MASK) >> (k)) & 1u)
#ifndef PHASE_TWICE
#define PHASE_TWICE 0u
#endif
#define REPS(k) (1 + (int)(((PHASE_TWICE) >> (k)) & 1u))

#define LAS __attribute__((address_space(3)))
#define GAS __attribute__((address_space(1)))
typedef unsigned short bf16_t;
typedef short bf16x8 __attribute__((ext_vector_type(8)));
typedef short s16x4 __attribute__((ext_vector_type(4)));
typedef float f32x4 __attribute__((ext_vector_type(4)));
typedef float f32x2 __attribute__((ext_vector_type(2)));
typedef float f32x16 __attribute__((ext_vector_type(16)));
typedef unsigned u32x4 __attribute__((ext_vector_type(4)));
typedef unsigned u32x2 __attribute__((ext_vector_type(2)));
typedef GAS unsigned gu32;
typedef int i32x8 __attribute__((ext_vector_type(8)));
typedef int i32x4 __attribute__((ext_vector_type(4)));

constexpr int D = 1024, NBATCH = 32, SEQ = 2048, T = NBATCH * SEQ;
constexpr int EVEN_IN = 3592, NP = 3584;
constexpr int P_MQ = 0, P_MK = 512, P_MV = 1024, P_MO = 1536, P_DQ = 2048, P_DK = 2560, P_DV = 3072;
constexpr int NE = 16, FF = 512;
constexpr int ECAP = 65536;
constexpr float NORM_EPS = 1e-6f;
constexpr int NWAVES = 8, NTHR = 512;
constexpr int MCH = 256, NCH = SEQ / MCH;
constexpr int WT_I1 = 16 * 112, WT_ITEMS = 28928, WT_UNITS = (WT_ITEMS - WT_I1) / 64;

constexpr size_t MiB = 1u << 20;
constexpr size_t WS_CTL = 0, CTL_ZERO_BYTES = 1 * MiB;
constexpr size_t WS_WT1 = 1 * MiB, WS_WT2 = 8 * MiB, WS_WT3 = 10 * MiB, WS_WT4 = 16 * MiB, WS_WGU = 18 * MiB, WS_WD = 82 * MiB;
constexpr size_t WS_GATES = 114 * MiB, WS_SA = 116 * MiB, WS_SAM = 117 * MiB, WS_SBA = 118 * MiB, WS_UN = 119 * MiB, WS_UR = 119 * MiB + 768 * 1024;
constexpr size_t WS_UT = 120 * MiB;
constexpr size_t WS_ROWTOK = 184 * MiB, WS_CWRAW = 188 * MiB, WS_TOKINFO = 192 * MiB, WS_RSTD = 193 * MiB;
constexpr size_t WS_H = 194 * MiB, WS_CAT = 322 * MiB, WS_P = 450 * MiB;
constexpr size_t WS_RSRAW = 120 * MiB;
constexpr size_t WS_XB8 = 720 * MiB;
constexpr size_t WS_XB = WS_H;
constexpr size_t WS_BG = WS_P, WS_Z = WS_P + 128 * MiB, WS_HM = WS_P, WS_YC = WS_P + 136 * MiB;
constexpr size_t WS_END = 898 * MiB;
constexpr int CW_BAR = 4096;
constexpr int CW_CNT = 16384;
constexpr int CW_QUEUE = 32768;

__device__ __forceinline__ unsigned cvt_pk_bf16(float lo, float hi) { unsigned r; asm volatile("v_cvt_pk_bf16_f32 %0, %1, %2" : "=v"(r) : "v"(lo), "v"(hi)); return r; }
__device__ __forceinline__ unsigned cvt_pk4_fp8(float a, float b, float c, float d) { unsigned w = 0; w = (unsigned)__builtin_amdgcn_cvt_pk_fp8_f32(a, b, (int)w, false); w = (unsigned)__builtin_amdgcn_cvt_pk_fp8_f32(c, d, (int)w, true); return w; }
#ifndef LATE_CV
#define LATE_CV 1
#endif
#ifndef G3_F8
#define G3_F8 1
#endif
constexpr float F8_WSCALE = 64.0f, F8_HSCALE = 16.0f, F8_YSCALE = 64.0f;
__device__ __forceinline__ float bf_lo(unsigned w) { return __uint_as_float(w << 16); }
__device__ __forceinline__ float bf_hi(unsigned w) { return __uint_as_float(w & 0xffff0000u); }
__device__ __forceinline__ float wave_sum(float v) {
#pragma unroll
    for (int o = 1; o < 64; o <<= 1) v += __shfl_xor(v, o);
    return v;
}
__device__ __forceinline__ float fast_exp2(float x) { return __builtin_amdgcn_exp2f(x); }
__device__ __forceinline__ float fast_rcp(float x) { return __builtin_amdgcn_rcpf(x); }
__device__ __forceinline__ int crow(int r, int hi) { return (r & 3) + 8 * (r >> 2) + 4 * hi; }
__device__ __forceinline__ unsigned off_b(unsigned row, unsigned ch) { return 256u * row + 16u * (ch ^ (((row & 3u) << 2) | ((row >> 2) & 3u))); }
__device__ __forceinline__ s16x4 vtr(const LAS unsigned char* p) { return __builtin_bit_cast(s16x4, __builtin_amdgcn_ds_read_tr16_b64_v4i16((LAS s16x4*)p)); }
__device__ __forceinline__ bf16x8 cat8(s16x4 a, s16x4 b) { return (bf16x8){a[0], a[1], a[2], a[3], b[0], b[1], b[2], b[3]}; }

#define XB_TMO      128
#define XB_XCNT(j)  (256  + 64 * (j))
#define XB_XSUB(j)  (1280 + 64 * (j))
#define XB_XGEN(j)  (2304 + 64 * (j))
#define XB_TOP      3328
#define XB_TOPGEN   3392
#define XCD_BAR_WORDS 3456
#define XB_SPIN_CAP (1u << 18)
__device__ __forceinline__ unsigned xb_ld(unsigned* p)              { return __hip_atomic_load(p, __ATOMIC_RELAXED, __HIP_MEMORY_SCOPE_AGENT); }
__device__ __forceinline__ unsigned xb_add(unsigned* p, unsigned v) { return __hip_atomic_fetch_add(p, v, __ATOMIC_RELAXED, __HIP_MEMORY_SCOPE_AGENT); }
__device__ __forceinline__ unsigned xb_xcc_id() { return (unsigned)__builtin_amdgcn_s_getreg((3 << 11) | 20) & 0xFu; }
#define XB_SPIN(cond, bar) do { unsigned _sp = 0; while (cond) { __builtin_amdgcn_s_sleep(1); \
    if ((++_sp & 255u) == 0u) { if (xb_ld(&(bar)[XB_TMO])) break; if (_sp > XB_SPIN_CAP) { atomicAdd(&(bar)[XB_TMO], 1u); break; } } } } while (0)
struct XcdBarrier { unsigned* bar; unsigned x; volatile LAS unsigned* st; };
__device__ __forceinline__ XcdBarrier xcd_barrier_post(unsigned* bar, volatile LAS unsigned* st) {
    XcdBarrier b; b.bar = bar; b.x = xb_xcc_id(); b.st = st;
    if (threadIdx.x == 0) (void)xb_add(&bar[XB_XCNT(b.x)], 1u);
    return b;
}
__device__ __forceinline__ void xcd_barrier_complete(unsigned* bar, unsigned x, unsigned& nloc, unsigned& nx) {
    const unsigned G = gridDim.x * gridDim.y * gridDim.z;
    unsigned sum, cnt, mine, sp = 0u;
    for (;;) {
        sum = 0u; cnt = 0u; mine = 0u;
#pragma unroll
        for (unsigned j = 0; j < 16; ++j) { const unsigned c = xb_ld(&bar[XB_XCNT(j)]); sum += c; cnt += (c > 0u) ? 1u : 0u; mine = (j == x) ? c : mine; }
        if (sum == G) break;
        __builtin_amdgcn_s_sleep(1);
        if ((++sp & 255u) == 0u) { if (xb_ld(&bar[XB_TMO])) break; if (sp > XB_SPIN_CAP) { atomicAdd(&bar[XB_TMO], 1u); break; } }
    }
    nloc = mine > 0u ? mine : 1u; nx = cnt > 0u ? cnt : 1u;
}
__device__ __forceinline__ void xcd_barrier(const XcdBarrier& b) {
    asm volatile("s_waitcnt vmcnt(0)" ::: "memory");
    __syncthreads();
    if (threadIdx.x == 0) {
        unsigned* bar = b.bar;
        __builtin_amdgcn_s_waitcnt(0);
        unsigned nloc = b.st[0], nx = b.st[1];
        if (nloc == 0u) { xcd_barrier_complete(bar, b.x, nloc, nx); b.st[0] = nloc; b.st[1] = nx; }
        const unsigned old = xb_add(&bar[XB_XSUB(b.x)], 1u);
        const unsigned gen = old / nloc;
        if (old + 1u == (gen + 1u) * nloc) {
            __builtin_amdgcn_fence(__ATOMIC_RELEASE, "agent");
            asm volatile("s_waitcnt vmcnt(0)" ::: "memory");
            const unsigned og = xb_add(&bar[XB_TOP], 1u);
            const unsigned tg = og / nx;
            if (og + 1u == (tg + 1u) * nx) xb_add(&bar[XB_TOPGEN], 1u);
            else XB_SPIN(xb_ld(&bar[XB_TOPGEN]) == tg, bar);
            __builtin_amdgcn_fence(__ATOMIC_ACQUIRE, "agent");
            xb_add(&bar[XB_XGEN(b.x)], 1u);
            asm volatile("s_waitcnt vmcnt(0)" ::: "memory");
        } else {
            XB_SPIN(xb_ld(&bar[XB_XGEN(b.x)]) == gen, bar);
            __builtin_amdgcn_fence(__ATOMIC_ACQUIRE, "agent");
            asm volatile("s_waitcnt vmcnt(0)" ::: "memory");
        }
    }
    __syncthreads();
}

namespace pg8 {
constexpr int BM = 256, BK = 64, HALF = 128, HTB = HALF * BK * 2, STAGE_BYTES = 8 * HTB, NXCD = 8, WGM = 8;
__device__ __forceinline__ int lds_byte(int r, int c) { const int st = (r >> 4) * 2 + (c >> 5), rr = r & 15, cc = c & 31, ob = rr * 64 + cc * 2; return st * 1024 + (ob ^ (((ob >> 9) & 1) << 5)); }
__device__ __forceinline__ void stage_rc(int b, int& R, int& C) { const int st = b / 1024, sb = b % 1024, swz = sb ^ (((sb >> 9) & 1) << 5); R = (st >> 1) * 16 + swz / 64; C = (st & 1) * 32 + (swz % 64) / 2; }
__device__ __forceinline__ int perm32(int rho) { const int n = rho >> 4, i = rho & 15; return 8 * (i >> 2) + 4 * n + (i & 3); }
struct Unit { int pm, pn; };

template <class Epi, class Sched, bool GATHER, bool F8 = false>
__device__ __forceinline__ void gemm_phase(LAS unsigned char* lds, const int K, const Sched& S, const Epi& E) {
    int tid = threadIdx.x; asm volatile("" : "+v"(tid));
    const int wid = __builtin_amdgcn_readfirstlane(tid >> 6), lane = tid & 63, wr = wid >> 2, wc = wid & 3, fr = lane & 15, fq = lane >> 4;
    const int nt = K / BK;
    int Rr[2], Cc[2]; unsigned voffB[2];
#pragma unroll
    for (int i = 0; i < 2; ++i) { stage_rc(tid * 16 + i * 8192, Rr[i], Cc[i]); const int Rb = Epi::PERM ? ((Rr[i] & ~31) + perm32(Rr[i] & 31)) : Rr[i];
        voffB[i] = (unsigned)(Rb * K + Cc[i]) * 2u; }
    const size_t kstep = (size_t)(BK * 2);
    const size_t hstep = (size_t)HALF * K * 2;
    const unsigned ldsw = (unsigned)wid * 1024u;
    const int aoff = lds_byte(wr * 64 + fr, fq * 8), boff = lds_byte(wc * 32 + fr, fq * 8);
#define PG8_SA(b, h) (((b) * 2 + (h)) * HTB)
#define PG8_SB(b, h) ((4 + (b) * 2 + (h)) * HTB)
#define PG8_STAGE(bufoff, gbase, voff) do { _Pragma("unroll") for (int _i = 0; _i < 2; ++_i) \
        __builtin_amdgcn_global_load_lds((const unsigned*)((const char*)(gbase) + (voff)[_i]), (LAS unsigned*)(lds + (bufoff) + ldsw + _i * 8192), 16, 0, 0); } while (0)
#define PG8_LD8(p) __builtin_shufflevector(*(const LAS i32x4*)(p), *(const LAS i32x4*)((p) + 1024), 0, 1, 2, 3, 4, 5, 6, 7)
#define PG8_LDA(dst, b, h) do { if constexpr (F8) { _Pragma("unroll") for (int m = 0; m < 4; ++m) dst##8[m] = PG8_LD8(lds + PG8_SA(b, h) + aoff + m * 2048); } \
        else { _Pragma("unroll") for (int m = 0; m < 4; ++m) _Pragma("unroll") for (int k = 0; k < 2; ++k) dst[m][k] = *(const LAS bf16x8*)(lds + PG8_SA(b, h) + aoff + m * 2048 + k * 1024); } } while (0)
#define PG8_LDB(dst, b, h) do { if constexpr (F8) { _Pragma("unroll") for (int n = 0; n < 2; ++n) dst##8[n] = PG8_LD8(lds + PG8_SB(b, h) + boff + n * 2048); } \
        else { _Pragma("unroll") for (int n = 0; n < 2; ++n) _Pragma("unroll") for (int k = 0; k < 2; ++k) dst[n][k] = *(const LAS bf16x8*)(lds + PG8_SB(b, h) + boff + n * 2048 + k * 1024); } } while (0)
#define PG8_CAT8(x0, x1) __builtin_shufflevector(__builtin_bit_cast(i32x4, x0), __builtin_bit_cast(i32x4, x1), 0, 1, 2, 3, 4, 5, 6, 7)
#define PG8_MMA(ai, bj, At, Bt) do { __builtin_amdgcn_s_setprio(1); _Pragma("unroll") for (int m = 0; m < 4; ++m) _Pragma("unroll") for (int n = 0; n < 2; ++n) { \
        if constexpr (F8) asm volatile("v_mfma_scale_f32_16x16x128_f8f6f4 %0, %1, %2, %0, %3, %3 op_sel_hi:[0,0,0]" : "+v"(acc[ai][bj][m][n]) : "v"(Bt##8[n]), "v"(At##8[m]), "v"(f8one)); \
        else { _Pragma("unroll") for (int k = 0; k < 2; ++k) acc[ai][bj][m][n] = __builtin_amdgcn_mfma_f32_16x16x32_bf16(Bt[n][k], At[m][k], acc[ai][bj][m][n], 0, 0, 0); } } __builtin_amdgcn_s_setprio(0); } while (0)
#define PG8_WAIT_V(n) asm volatile("s_waitcnt vmcnt(" #n ")" ::: "memory")
#define PG8_WAIT_L(n) asm volatile("s_waitcnt lgkmcnt(" #n ")" ::: "memory")
#define PG8_BAR __builtin_amdgcn_s_barrier()
#define PG8_SCHED __builtin_amdgcn_sched_barrier(0)
#define PG8_VOFF(dst, u) do { _Pragma("unroll") for (int _h = 0; _h < 2; ++_h) _Pragma("unroll") for (int _i = 0; _i < 2; ++_i) { \
        if constexpr (GATHER) dst[_h][_i] = S.arow(u, _h * HALF + Rr[_i]) * (unsigned)(K * 2) + (unsigned)(Cc[_i] * 2); \
        else dst[_h][_i] = (unsigned)((_h * HALF + Rr[_i]) * K + Cc[_i]) * 2u; } } while (0)
    Unit cur, nxt; int ui = 0;
    if (!S.next(0, cur)) return;
    f32x4 acc[2][2][4][2];
    if constexpr (Epi::PRELOAD) E.preload(acc, cur, wr, wc, fr, fq);
    else {
#pragma unroll
    for (int a = 0; a < 2; ++a)
#pragma unroll
        for (int b = 0; b < 2; ++b)
#pragma unroll
            for (int m = 0; m < 4; ++m)
#pragma unroll
                for (int n = 0; n < 2; ++n) acc[a][b][m][n] = (f32x4){0.f, 0.f, 0.f, 0.f};
    }
    float epf[2][4] = {{0.f, 0.f, 0.f, 0.f}, {0.f, 0.f, 0.f, 0.f}};
    bf16x8 At[4][2], B0[2][2], B1[2][2];
    i32x8 At8[4], B08[2], B18[2]; const unsigned f8one = 0x7f7f7f7fu;
    unsigned vA[2][2], vN[2][2];
    PG8_VOFF(vA, cur);
    if constexpr (Epi::PREFETCH) E.prefetch(epf, cur, wr, fr);
    const char* cA = S.abase(cur); const char* cB = S.bbase(cur);
    PG8_STAGE(PG8_SB(0, 0), cB, voffB); PG8_STAGE(PG8_SB(0, 1), cB + hstep, voffB); PG8_STAGE(PG8_SA(0, 0), cA, vA[0]); PG8_STAGE(PG8_SA(0, 1), cA, vA[1]);
    if (wr == 1) PG8_BAR;
    PG8_WAIT_V(2); PG8_BAR;
    PG8_STAGE(PG8_SB(1, 0), cB + kstep, voffB); PG8_STAGE(PG8_SA(1, 0), cA + kstep, vA[0]); PG8_STAGE(PG8_SB(1, 1), cB + hstep + kstep, voffB);
    PG8_WAIT_V(6); PG8_BAR;
    for (;;) {
        const bool has_next = S.next(ui + 1, nxt);
        const char* nA = has_next ? S.abase(nxt) : cA; const char* nB = has_next ? S.bbase(nxt) : cB;
        if constexpr (GATHER) { if (has_next) { PG8_VOFF(vN, nxt); } else {
#pragma unroll
            for (int h = 0; h < 2; ++h)
#pragma unroll
                for (int i = 0; i < 2; ++i) vN[h][i] = vA[h][i]; } }
#pragma unroll 1
        for (int t = 0; t < nt; t += 2) {
            const bool last = (t == nt - 2);
            const char* a1 = cA + (size_t)(t + 1) * kstep;
            const char* a2 = last ? nA : cA + (size_t)(t + 2) * kstep; const char* b2 = last ? nB : cB + (size_t)(t + 2) * kstep;
            const char* a3 = a2 + kstep; const char* b3 = b2 + kstep;
            unsigned v2[2][2]; const unsigned lmask = last ? 0xffffffffu : 0u;
#pragma unroll
            for (int h = 0; h < 2; ++h)
#pragma unroll
                for (int i = 0; i < 2; ++i) { if constexpr (GATHER) v2[h][i] = (vN[h][i] & lmask) | (vA[h][i] & ~lmask); else v2[h][i] = vA[h][i]; }
            PG8_LDB(B0, 0, 0); PG8_LDB(B1, 0, 1); PG8_SCHED; PG8_LDA(At, 0, 0); PG8_STAGE(PG8_SA(1, 1), a1, vA[1]);
            PG8_WAIT_V(8); PG8_WAIT_L(0); PG8_BAR; PG8_MMA(0, 0, At, B0); PG8_MMA(0, 1, At, B1); PG8_BAR; PG8_SCHED;
            PG8_LDA(At, 0, 1); PG8_STAGE(PG8_SB(0, 0), b2, voffB); PG8_STAGE(PG8_SB(0, 1), b2 + hstep, voffB); PG8_STAGE(PG8_SA(0, 0), a2, v2[0]);
            PG8_WAIT_V(8); PG8_WAIT_L(0); PG8_BAR; PG8_MMA(1, 0, At, B0); PG8_MMA(1, 1, At, B1); PG8_BAR; PG8_SCHED;
            PG8_LDB(B0, 1, 0); PG8_LDB(B1, 1, 1); PG8_SCHED; PG8_LDA(At, 1, 0); PG8_STAGE(PG8_SA(0, 1), a2, v2[1]);
            PG8_WAIT_V(8); PG8_WAIT_L(0); PG8_BAR; PG8_MMA(0, 0, At, B0); PG8_MMA(0, 1, At, B1); PG8_BAR; PG8_SCHED;
            PG8_LDA(At, 1, 1); PG8_STAGE(PG8_SB(1, 0), b3, voffB); PG8_STAGE(PG8_SB(1, 1), b3 + hstep, voffB); PG8_STAGE(PG8_SA(1, 0), a3, v2[0]);
            PG8_WAIT_V(8); PG8_WAIT_L(0); PG8_BAR; PG8_MMA(1, 0, At, B0); PG8_MMA(1, 1, At, B1); PG8_BAR; PG8_SCHED;
        }
        if (wr == 0) PG8_BAR;
        if constexpr (F8) asm volatile("s_nop 15\n\ts_nop 15" ::: "memory");
        if constexpr (Epi::PREFETCH) E(acc, cur, wr, wc, fr, fq, epf); else E(acc, cur, wr, wc, fr, fq);
        if (!has_next) break;
        if constexpr (Epi::PREFETCH) E.prefetch(epf, nxt, wr, fr);
        if constexpr (Epi::PRELOAD) E.preload(acc, nxt, wr, wc, fr, fq);
        else {
#pragma unroll
        for (int a = 0; a < 2; ++a)
#pragma unroll
            for (int b = 0; b < 2; ++b)
#pragma unroll
                for (int m = 0; m < 4; ++m)
#pragma unroll
                    for (int n = 0; n < 2; ++n) acc[a][b][m][n] = (f32x4){0.f, 0.f, 0.f, 0.f};
        }
        cur = nxt; cA = nA; cB = nB; ++ui;
        if constexpr (GATHER) {
#pragma unroll
        for (int h = 0; h < 2; ++h)
#pragma unroll
            for (int i = 0; i < 2; ++i) vA[h][i] = vN[h][i]; }
        if (wr == 1) PG8_BAR;
    }
    PG8_WAIT_V(0);
    PG8_BAR;
#undef PG8_SA
#undef PG8_SB
#undef PG8_STAGE
#undef PG8_LDA
#undef PG8_LD8
#undef PG8_LDB
#undef PG8_MMA
#undef PG8_CAT8
#undef PG8_WAIT_V
#undef PG8_WAIT_L
#undef PG8_BAR
#undef PG8_SCHED
#undef PG8_VOFF
}

struct DenseSched {
    const char* A; const char* Bt; int K; int nM, nN, nwg, G, c;
    __device__ __forceinline__ void init(const void* A_, const void* Bt_, int M, int N, int K_, int G_, int c_) { A = (const char*)A_; Bt = (const char*)Bt_; K = K_; nM = M / BM; nN = N / BM; nwg = nM * nN; G = G_; c = c_; }
    __device__ __forceinline__ bool next(int i, Unit& u) const {
        const long L = (long)i * G + c; if (L >= nwg) return false;
        int wgid = (int)L; { const int q = nwg / NXCD, r = nwg % NXCD, xcd = wgid % NXCD, off = wgid / NXCD; wgid = (xcd < r ? xcd * (q + 1) : r * (q + 1) + (xcd - r) * q) + off; }
        const int nig = WGM * nN, gid = wgid / nig, fm = gid * WGM, gsz = (nM - fm) < WGM ? (nM - fm) : WGM;
        u.pm = fm + ((wgid % nig) % gsz); u.pn = (wgid % nig) / gsz; return true;
    }
    __device__ __forceinline__ const char* abase(const Unit& u) const { return A + (size_t)u.pm * BM * K * 2; }
    __device__ __forceinline__ const char* bbase(const Unit& u) const { return Bt + (size_t)u.pn * BM * K * 2; }
    __device__ __forceinline__ unsigned arow(const Unit&, int) const { return 0u; }
};
template <bool GATHER_A>
struct MoeSched {
    const char* A; const char* W; int K; size_t wstride; const LAS int* tb; const LAS int* cn; const unsigned* rowtok; int ntot, vcu, G;
    __device__ __forceinline__ bool next(int i, Unit& u) const { const int L = i * G + vcu; if (L >= ntot * 4) return false; u.pm = L >> 2; u.pn = L & 3; return true; }
    __device__ __forceinline__ int expert(int pm) const { int e = 0;
#pragma unroll
        for (int j = 1; j < 16; ++j) e += (pm >= tb[j]) ? 1 : 0; return e; }
    __device__ __forceinline__ const char* abase(const Unit& u) const { return GATHER_A ? A : A + (size_t)u.pm * BM * K * 2; }
    __device__ __forceinline__ const char* bbase(const Unit& u) const { return W + (size_t)expert(u.pm) * wstride + (size_t)u.pn * BM * K * 2; }
    __device__ __forceinline__ unsigned arow(const Unit& u, int r) const { const int e = expert(u.pm); const int idx = (u.pm - tb[e]) * BM + r; return idx < cn[e] ? rowtok[(size_t)e * ECAP + idx] : 0u; }
};

struct EpiBf16 {
    static constexpr bool PERM = true, PRELOAD = false, PREFETCH = false;
    bf16_t* O; int ldc;
    __device__ __forceinline__ void operator()(const f32x4 (&acc)[2][2][4][2], const Unit& u, int wr, int wc, int fr, int fq) const {
        const int row0 = u.pm * BM + wr * 64 + fr, col0 = u.pn * BM + wc * 32 + 8 * fq;
#pragma unroll
        for (int ai = 0; ai < 2; ++ai)
#pragma unroll
            for (int m = 0; m < 4; ++m) { bf16_t* rowp = O + (size_t)(row0 + ai * HALF + m * 16) * ldc + col0;
#pragma unroll
                for (int bj = 0; bj < 2; ++bj) { const f32x4 v0 = acc[ai][bj][m][0], v1 = acc[ai][bj][m][1];
                    u32x4 w; w.x = cvt_pk_bf16(v0[0], v0[1]); w.y = cvt_pk_bf16(v0[2], v0[3]); w.z = cvt_pk_bf16(v1[0], v1[1]); w.w = cvt_pk_bf16(v1[2], v1[3]);
#ifdef EPI_NT
                    __builtin_nontemporal_store(w, (u32x4*)(rowp + bj * HALF));
#else
                    *(u32x4*)(rowp + bj * HALF) = w;
#endif
                } }
    }
};
template <bool XF32>
struct EpiResid {
    static constexpr bool PERM = true, PRELOAD = true, PREFETCH = false;
    const float* xin; bf16_t* XB; unsigned char* XB8;
    __device__ __forceinline__ void preload(f32x4 (&acc)[2][2][4][2], const Unit& u, int wr, int wc, int fr, int fq) const {
        const int row0 = u.pm * BM + wr * 64 + fr, col0 = u.pn * BM + wc * 32 + 8 * fq;
#pragma unroll
        for (int ai = 0; ai < 2; ++ai)
#pragma unroll
            for (int m = 0; m < 4; ++m) { const size_t off = (size_t)(row0 + ai * HALF + m * 16) * D + col0;
#pragma unroll
                for (int bj = 0; bj < 2; ++bj) {
                    if (XF32) { acc[ai][bj][m][0] = *(const f32x4*)(xin + off + bj * HALF); acc[ai][bj][m][1] = *(const f32x4*)(xin + off + bj * HALF + 4); }
                    else { const u32x4 w = *(const u32x4*)(XB + off + bj * HALF); acc[ai][bj][m][0] = (f32x4){bf_lo(w.x), bf_hi(w.x), bf_lo(w.y), bf_hi(w.y)}; acc[ai][bj][m][1] = (f32x4){bf_lo(w.z), bf_hi(w.z), bf_lo(w.w), bf_hi(w.w)}; } } }
    }
    __device__ __forceinline__ void operator()(const f32x4 (&acc)[2][2][4][2], const Unit& u, int wr, int wc, int fr, int fq) const {
        const int row0 = u.pm * BM + wr * 64 + fr, col0 = u.pn * BM + wc * 32 + 8 * fq;
#pragma unroll
        for (int ai = 0; ai < 2; ++ai)
#pragma unroll
            for (int m = 0; m < 4; ++m) { bf16_t* rowp = XB + (size_t)(row0 + ai * HALF + m * 16) * D + col0;
#pragma unroll
                for (int bj = 0; bj < 2; ++bj) { const f32x4 v0 = acc[ai][bj][m][0], v1 = acc[ai][bj][m][1];
                    u32x4 w; w.x = cvt_pk_bf16(v0[0], v0[1]); w.y = cvt_pk_bf16(v0[2], v0[3]); w.z = cvt_pk_bf16(v1[0], v1[1]); w.w = cvt_pk_bf16(v1[2], v1[3]);
                    *(u32x4*)(rowp + bj * HALF) = w;
                    u32x2 w8; w8.x = cvt_pk4_fp8(bf_lo(w.x), bf_hi(w.x), bf_lo(w.y), bf_hi(w.y)); w8.y = cvt_pk4_fp8(bf_lo(w.z), bf_hi(w.z), bf_lo(w.w), bf_hi(w.w));
                    *(u32x2*)(XB8 + (size_t)(row0 + ai * HALF + m * 16) * D + col0 + bj * HALF) = w8; } }
    }
};
template <int MODE  >
struct EpiPair {
    static constexpr bool PERM = true, PRELOAD = false, PREFETCH = true;
    bf16_t* O0; bf16_t* O1; int ld1;
    const float* rstd; const unsigned* rowtok; const LAS int* tb; const LAS int* cn;
    __device__ __forceinline__ void prefetch(float (&rs)[2][4], const Unit& u, int wr, int fr) const {
        const int row0 = u.pm * BM + wr * 64 + fr;
        if (MODE == 0) {
#pragma unroll
            for (int ai = 0; ai < 2; ++ai)
#pragma unroll
                for (int m = 0; m < 4; ++m) rs[ai][m] = rstd[row0 + ai * HALF + m * 16] * (G3_F8 ? 1.0f / F8_WSCALE : 1.0f);
        } else {
            int e = 0;
#pragma unroll
            for (int j = 1; j < 16; ++j) e += (u.pm >= tb[j]) ? 1 : 0;
            const int idx0 = (u.pm - tb[e]) * BM + wr * 64 + fr, cne = cn[e];
#pragma unroll
            for (int ai = 0; ai < 2; ++ai)
#pragma unroll
                for (int m = 0; m < 4; ++m) { const int idx = idx0 + ai * HALF + m * 16; rs[ai][m] = idx < cne ? rstd[(size_t)e * ECAP + idx] * (1.0f / F8_WSCALE) : 0.f; }
        }
    }
    __device__ __forceinline__ void operator()(const f32x4 (&acc)[2][2][4][2], const Unit& u, int wr, int wc, int fr, int fq, const float (&rs)[2][4]) const {
        const int row0 = u.pm * BM + wr * 64 + fr;
        if (MODE == 0 && u.pn < 4) {
            const int col0 = u.pn * BM + wc * 32 + 8 * fq;
#pragma unroll
            for (int ai = 0; ai < 2; ++ai)
#pragma unroll
                for (int m = 0; m < 4; ++m) { bf16_t* rowp = O0 + (size_t)(row0 + ai * HALF + m * 16) * D + col0;
#pragma unroll
                    for (int bj = 0; bj < 2; ++bj) { const f32x4 v0 = acc[ai][bj][m][0] * rs[ai][m], v1 = acc[ai][bj][m][1] * rs[ai][m];
                        u32x4 w; w.x = cvt_pk_bf16(v0[0], v0[1]); w.y = cvt_pk_bf16(v0[2], v0[3]); w.z = cvt_pk_bf16(v1[0], v1[1]); w.w = cvt_pk_bf16(v1[2], v1[3]);
                        *(u32x4*)(rowp + bj * HALF) = w; } }
        } else {
            const int pt = (MODE == 0) ? (u.pn - 4) : u.pn;
            const int col0 = pt * HALF + wc * 32 + 8 * fq;
#pragma unroll
            for (int ai = 0; ai < 2; ++ai)
#pragma unroll
                for (int m = 0; m < 4; ++m) { bf16_t* rowp = O1 + (size_t)(row0 + ai * HALF + m * 16) * ld1 + col0;
                    f32x4 r[2];
#pragma unroll
                    for (int n = 0; n < 2; ++n) { const f32x4 g = acc[ai][0][m][n] * rs[ai][m], up = acc[ai][1][m][n] * rs[ai][m];
                        if (MODE == 0) r[n] = g * up;
                        else {
#pragma unroll
                            for (int j = 0; j < 4; ++j) r[n][j] = __builtin_amdgcn_fmed3f(g[j] * fast_rcp(1.0f + fast_exp2(-1.4426950408889634f * g[j])) * up[j] * F8_HSCALE, -448.0f, 448.0f); } }
                    if (MODE == 1) { u32x2 w; w.x = cvt_pk4_fp8(r[0][0], r[0][1], r[0][2], r[0][3]); w.y = cvt_pk4_fp8(r[1][0], r[1][1], r[1][2], r[1][3]);
                        *(u32x2*)((unsigned char*)O1 + (size_t)(row0 + ai * HALF + m * 16) * ld1 + col0) = w; }
                    else { u32x4 w; w.x = cvt_pk_bf16(r[0][0], r[0][1]); w.y = cvt_pk_bf16(r[0][2], r[0][3]); w.z = cvt_pk_bf16(r[1][0], r[1][1]); w.w = cvt_pk_bf16(r[1][2], r[1][3]);
                        *(u32x4*)rowp = w; } }
        }
    }
};
struct EpiDown {
    static constexpr bool PERM = true, PRELOAD = false, PREFETCH = true;
    unsigned char* O; const float* cwraw; const LAS int* tb; const LAS int* cn;
    __device__ __forceinline__ void prefetch(float (&cws)[2][4], const Unit& u, int wr, int fr) const {
        int e = 0;
#pragma unroll
        for (int j = 1; j < 16; ++j) e += (u.pm >= tb[j]) ? 1 : 0;
        const int idx0 = (u.pm - tb[e]) * BM + wr * 64 + fr, cne = cn[e];
#pragma unroll
        for (int ai = 0; ai < 2; ++ai)
#pragma unroll
            for (int m = 0; m < 4; ++m) { const int idx = idx0 + ai * HALF + m * 16; cws[ai][m] = idx < cne ? cwraw[(size_t)e * ECAP + idx] * (F8_YSCALE / (F8_WSCALE * F8_HSCALE)) : 0.f; }
    }
    __device__ __forceinline__ void operator()(const f32x4 (&acc)[2][2][4][2], const Unit& u, int wr, int wc, int fr, int fq, const float (&cws)[2][4]) const {
        const int row0 = u.pm * BM + wr * 64 + fr, col0 = u.pn * BM + wc * 32 + 8 * fq;
#pragma unroll
        for (int ai = 0; ai < 2; ++ai)
#pragma unroll
            for (int m = 0; m < 4; ++m) { const float cw = cws[ai][m];
                unsigned char* rowp = O + (size_t)(row0 + ai * HALF + m * 16) * D + col0;
#pragma unroll
                for (int bj = 0; bj < 2; ++bj) { f32x4 v0 = acc[ai][bj][m][0] * cw, v1 = acc[ai][bj][m][1] * cw;
#pragma unroll
                    for (int j = 0; j < 4; ++j) { v0[j] = __builtin_amdgcn_fmed3f(v0[j], -448.0f, 448.0f); v1[j] = __builtin_amdgcn_fmed3f(v1[j], -448.0f, 448.0f); }
                    u32x2 w; w.x = cvt_pk4_fp8(v0[0], v0[1], v0[2], v0[3]); w.y = cvt_pk4_fp8(v1[0], v1[1], v1[2], v1[3]);
                    *(u32x2*)(rowp + bj * HALF) = w; } }
    }
};
}

constexpr int RING_BYTES = 131072;
constexpr int MISC_OFF = RING_BYTES;
constexpr int LDS_BYTES = 163840;
constexpr int MW_BAR = 0;
constexpr int MW_TB = 16;
constexpr int MW_CN = 40;
constexpr int MW_Q = 60;
constexpr int MW_F = 64;

struct Params {
    const float* in[25]; float* out; unsigned char* ws;
};

constexpr float ATT_QSCALE = 0.125f * 1.4426950408889634f;
__device__ __forceinline__ void transpose_item(const float* W, int ld, int K, int k0, int srccol, bf16_t* WT, int dstrow, LAS float* scr, int lane, const float* gk = nullptr, float wsc = 1.0f) {
    float tv[32];
#pragma unroll
    for (int i = 0; i < 32; ++i) { const int kk = 2 * i + (lane >> 5); tv[i] = W[(size_t)(k0 + kk) * ld + srccol + (lane & 31)]; }
#pragma unroll
    for (int i = 0; i < 32; ++i) { const int kk = 2 * i + (lane >> 5); scr[kk * 33 + (lane & 31)] = (gk ? tv[i] * gk[k0 + kk] : tv[i]) * wsc; }
    asm volatile("s_waitcnt lgkmcnt(0)" ::: "memory");
    const int c = lane & 7;
#pragma unroll
    for (int j = 0; j < 4; ++j) { const int n = (lane >> 3) + 8 * j; const LAS float* s = scr + (8 * c) * 33 + n;
        u32x4 o; o.x = cvt_pk_bf16(s[0 * 33], s[1 * 33]); o.y = cvt_pk_bf16(s[2 * 33], s[3 * 33]); o.z = cvt_pk_bf16(s[4 * 33], s[5 * 33]); o.w = cvt_pk_bf16(s[6 * 33], s[7 * 33]);
        *(u32x4*)(WT + (size_t)(dstrow + n) * K + k0 + 8 * c) = o; }
    asm volatile("s_waitcnt lgkmcnt(0)" ::: "memory");
}
__device__ __forceinline__ void transpose_item_f8(const float* W, int ld, int K, int k0, int srccol, unsigned char* WT8, int dstrow, LAS float* scr, int lane, const float* gk, float scale) {
    float tv[32];
#pragma unroll
    for (int i = 0; i < 32; ++i) { const int kk = 2 * i + (lane >> 5); tv[i] = W[(size_t)(k0 + kk) * ld + srccol + (lane & 31)]; }
#pragma unroll
    for (int i = 0; i < 32; ++i) { const int kk = 2 * i + (lane >> 5); scr[kk * 33 + (lane & 31)] = (gk ? tv[i] * gk[k0 + kk] : tv[i]) * scale; }
    asm volatile("s_waitcnt lgkmcnt(0)" ::: "memory");
    const int c = lane & 3;
#pragma unroll
    for (int j = 0; j < 2; ++j) { const int n = (lane >> 2) + 16 * j; const LAS float* q = scr + (16 * c) * 33 + n;
        u32x4 o; o.x = cvt_pk4_fp8(q[0 * 33], q[1 * 33], q[2 * 33], q[3 * 33]); o.y = cvt_pk4_fp8(q[4 * 33], q[5 * 33], q[6 * 33], q[7 * 33]);
        o.z = cvt_pk4_fp8(q[8 * 33], q[9 * 33], q[10 * 33], q[11 * 33]); o.w = cvt_pk4_fp8(q[12 * 33], q[13 * 33], q[14 * 33], q[15 * 33]);
        *(u32x4*)(WT8 + (size_t)(dstrow + n) * K + k0 + 16 * c) = o; }
    asm volatile("s_waitcnt lgkmcnt(0)" ::: "memory");
}
__device__ __forceinline__ int pair_row(int ch, int up) { return (ch >> 7) * 256 + up * 128 + (ch & 127); }

__device__ __forceinline__ void phase_prologue_weights(const Params& p, LAS unsigned char* lds, int first, int last, int step, int wave, int lane_) {
    int lane = lane_; asm volatile("" : "+v"(lane));
    LAS float* scr = (LAS float*)(lds + wave * 16384);
    unsigned char* ws = p.ws;
    constexpr int I1 = 16 * 112, I2 = 16 * 32, I3 = 16 * 96, I4 = 16 * 32, IE = 768;
    constexpr int NITEMS = I1 + I2 + I3 + I4 + 32 * IE;
    static_assert(NITEMS == 28928, "item count");
    for (int it = first; it < last; it += step) {
        int r = it;
        if (r < I1) { const int kb = r / 112, nb = r % 112; const int sc = nb < 64 ? 32 * nb : 2056 + 32 * (nb - 64), dr = nb < 64 ? 32 * nb : 2048 + 32 * (nb - 64);
            transpose_item(p.in[5], EVEN_IN, 1024, 64 * kb, sc, (bf16_t*)(ws + WS_WT1), dr, scr, lane, nullptr, (dr >= P_DQ && dr < P_DK) ? ATT_QSCALE : 1.0f); continue; } r -= I1;
        if (r < I2) { const int kb = r / 32, nb = r % 32; transpose_item(p.in[6], 1024, 1024, 64 * kb, 32 * nb, (bf16_t*)(ws + WS_WT2), 32 * nb, scr, lane); continue; } r -= I2;
        if (r < I3) { const int kb = r / 96, nb = r % 96; int dr;
            if (nb < 32) dr = 32 * nb; else if (nb < 64) dr = 1024 + pair_row(32 * (nb - 32), 0); else dr = 1024 + pair_row(32 * (nb - 64), 1);
            if (G3_F8) transpose_item_f8(p.in[15], 3072, 1024, 64 * kb, 32 * nb, ws + WS_WT3, dr, scr, lane, p.in[2] + D, F8_WSCALE);
            else transpose_item(p.in[15], 3072, 1024, 64 * kb, 32 * nb, (bf16_t*)(ws + WS_WT3), dr, scr, lane, p.in[2] + D);
            continue; } r -= I3;
        if (r < I4) { const int kb = r / 32, nb = r % 32; transpose_item(p.in[17], 1024, 1024, 64 * kb, 32 * nb, (bf16_t*)(ws + WS_WT4), 32 * nb, scr, lane); continue; } r -= I4;
        const int le = r / IE; r %= IE;
        unsigned char* wgu = ws + WS_WGU + (size_t)le * 1024 * 1024; unsigned char* wd = ws + WS_WD + (size_t)le * 1024 * 512;
        if (r < 256) { const int kb = r / 16, nb = r % 16; transpose_item_f8(p.in[22] + (size_t)le * 1024 * 512, 512, 1024, 64 * kb, 32 * nb, wgu, pair_row(32 * nb, 0), scr, lane, p.in[3] + (le >> 4) * D, F8_WSCALE); continue; } r -= 256;
        if (r < 256) { const int kb = r / 16, nb = r % 16; transpose_item_f8(p.in[23] + (size_t)le * 1024 * 512, 512, 1024, 64 * kb, 32 * nb, wgu, pair_row(32 * nb, 1), scr, lane, p.in[3] + (le >> 4) * D, F8_WSCALE); continue; } r -= 256;
        { const int kb = r / 32, nb = r % 32; transpose_item_f8(p.in[24] + (size_t)le * 512 * 1024, 1024, 512, 64 * kb, 32 * nb, wd, 32 * nb, scr, lane, nullptr, F8_WSCALE); }
    }
}

struct RowV { f32x4 v[4]; };
__device__ __forceinline__ RowV row_load(const float* xr, int lane) { RowV r; const f32x4* p = (const f32x4*)xr + lane;
#pragma unroll
    for (int j = 0; j < 4; ++j) r.v[j] = p[64 * j]; return r; }
__device__ __forceinline__ void row_store(float* xr, int lane, const RowV& r) { f32x4* p = (f32x4*)xr + lane;
#pragma unroll
    for (int j = 0; j < 4; ++j) p[64 * j] = r.v[j]; }
__device__ __forceinline__ RowV row_load_bf16(const bf16_t* yr, int lane) { RowV r; const u32x2* p = (const u32x2*)yr + lane;
#pragma unroll
    for (int j = 0; j < 4; ++j) { const u32x2 w = p[64 * j]; r.v[j] = (f32x4){bf_lo(w.x), bf_hi(w.x), bf_lo(w.y), bf_hi(w.y)}; } return r; }
__device__ __forceinline__ RowV row_load_fp8(const unsigned char* yr, int lane, float sc) { RowV r; const unsigned* p = (const unsigned*)yr + lane;
#pragma unroll
    for (int j = 0; j < 4; ++j) { const unsigned w = p[64 * j]; const f32x2 lo = __builtin_amdgcn_cvt_pk_f32_fp8((int)w, false), hi = __builtin_amdgcn_cvt_pk_f32_fp8((int)w, true); r.v[j] = (f32x4){lo.x * sc, lo.y * sc, hi.x * sc, hi.y * sc}; } return r; }
__device__ __forceinline__ float row_rstd(const RowV& r) { float s = 0.f;
#pragma unroll
    for (int j = 0; j < 4; ++j) s += (r.v[j][0] * r.v[j][0] + r.v[j][1] * r.v[j][1]) + (r.v[j][2] * r.v[j][2] + r.v[j][3] * r.v[j][3]);
    return 1.0f / sqrtf(wave_sum(s) * (1.0f / D) + NORM_EPS); }
__device__ __forceinline__ void row_store_bf16(bf16_t* hr, int lane, const RowV& r) { u32x2* p = (u32x2*)hr + lane;
#pragma unroll
    for (int j = 0; j < 4; ++j) { u32x2 w; w.x = cvt_pk_bf16(r.v[j][0], r.v[j][1]); w.y = cvt_pk_bf16(r.v[j][2], r.v[j][3]); p[64 * j] = w; } }

__device__ __forceinline__ void phase_norm_gates(const Params& p, LAS unsigned char* lds, int tid, int gw, int NGW, int lane) {
    const float* x = p.in[0]; const float* g = p.in[2]; const float* win = p.in[5];
    bf16_t* H = (bf16_t*)(p.ws + WS_H); float* gates = (float*)(p.ws + WS_GATES);
    LAS float* wt = (LAS float*)lds;
    for (int i = tid; i < 8 * 1024; i += NTHR) { const int k = i >> 3, o = i & 7; wt[o * 1024 + k] = win[(size_t)k * EVEN_IN + 2048 + o] * g[k]; }
    __syncthreads();
    RowV gv = row_load(g, lane);
    for (int m0 = gw; m0 < T; m0 += 2 * NGW) {
      RowV rr[2];
#pragma unroll
      for (int u = 0; u < 2; ++u) { const int mm = m0 + u * NGW; rr[u] = row_load(x + (size_t)(mm < T ? mm : m0) * D, lane); }
#pragma unroll
      for (int u = 0; u < 2; ++u) {
        const int m = m0 + u * NGW; if (m >= T) break; RowV r = rr[u];
        const float rstd = row_rstd(r);
        float dots[8];
#pragma unroll
        for (int o = 0; o < 8; ++o) { float s = 0.f;
#pragma unroll
            for (int j = 0; j < 4; ++j) { const f32x4 w = *(const LAS f32x4*)(wt + o * 1024 + 4 * lane + 256 * j); s += (r.v[j][0] * w[0] + r.v[j][1] * w[1]) + (r.v[j][2] * w[2] + r.v[j][3] * w[3]); }
            dots[o] = s; }
        float gsum;
        { const bool b5 = (lane & 32) != 0, b4 = (lane & 16) != 0, b3 = (lane & 8) != 0;
          float k4[4];
#pragma unroll
          for (int i = 0; i < 4; ++i) { const float keep = b5 ? dots[4 + i] : dots[i], send = b5 ? dots[i] : dots[4 + i]; k4[i] = keep + __shfl_xor(send, 32); }
          float k2[2];
#pragma unroll
          for (int i = 0; i < 2; ++i) { const float keep = b4 ? k4[2 + i] : k4[i], send = b4 ? k4[i] : k4[2 + i]; k2[i] = keep + __shfl_xor(send, 16); }
          { const float keep = b3 ? k2[1] : k2[0], send = b3 ? k2[0] : k2[1]; gsum = keep + __shfl_xor(send, 8); }
          gsum += __shfl_xor(gsum, 4); gsum += __shfl_xor(gsum, 2); gsum += __shfl_xor(gsum, 1); }
#pragma unroll
        for (int j = 0; j < 4; ++j) r.v[j] = r.v[j] * rstd * gv.v[j];
        row_store_bf16(H + (size_t)m * D, lane, r);
        if ((lane & 7) == 0) gates[(size_t)m * 8 + ((lane >> 3) & 7)] = gsum * rstd;
      }
    }
    __syncthreads();
}

template <int MODE, bool COMBINE>
__device__ __forceinline__ void phase_rows(const Params& p, LAS unsigned char* lds, int tid_, int wave, int lane_, int G,
                                           const float* gvec, const float* wgr, const float* bgr, const float* wer, const float* ber, unsigned* cnt_prev, unsigned* cnt_cur) {
    int tid = tid_; asm volatile("" : "+v"(tid)); const int lane = tid & 63;
    float* OUT = p.out; bf16_t* XB = (bf16_t*)(p.ws + WS_XB); float* RSTD = (float*)(p.ws + WS_RSTD);
    const unsigned char* YC = (const unsigned char*)(p.ws + WS_YC); float* rsraw = (float*)(p.ws + WS_RSRAW);
    unsigned* tokinfo = (unsigned*)(p.ws + WS_TOKINFO);
    unsigned* rowtok = (unsigned*)(p.ws + WS_ROWTOK); float* cwraw = (float*)(p.ws + WS_CWRAW);
    LAS float* wt = (LAS float*)lds;
    LAS int* misc = (LAS int*)(lds + MISC_OFF);
    LAS int* tbp = misc + MW_TB;
    LAS int* te = misc + 1024;
    LAS float* tc = (LAS float*)(misc + 1536);
    LAS int* trank = misc + 2048;
    LAS int* ebase = misc + 2560;
    LAS float* trs = (LAS float*)(misc + 2600);
    if (COMBINE) { if (tid == 0) { int acc = 0; for (int e = 0; e < 16; ++e) { tbp[e] = acc; acc += ((int)__hip_atomic_load(cnt_prev + e * 64, __ATOMIC_RELAXED, __HIP_MEMORY_SCOPE_AGENT) + 255) >> 8; } tbp[16] = acc; } }
    if (MODE == 1) { for (int i = tid; i < 20 * 1024; i += NTHR) { const int o = i >> 10, k = i & 1023; wt[i] = (o < 4 ? wgr[(size_t)k * 4 + o] : wer[(size_t)k * 16 + (o - 4)]) * gvec[k]; } }
    __syncthreads();
    RowV gv; if (MODE == 2) gv = row_load(gvec, lane);
    for (int blk = blockIdx.x; blk < T / 256; blk += G) {
        for (int i2 = 0; i2 < 32; i2 += 2) {
          RowV rr[2];
#pragma unroll
          for (int u = 0; u < 2; ++u) {
            const int m = blk * 256 + wave * 32 + i2 + u;
            rr[u] = row_load_bf16(XB + (size_t)m * D, lane);
            if (COMBINE) {
                const unsigned i0 = tokinfo[(size_t)m * 2], i1 = tokinfo[(size_t)m * 2 + 1];
                const size_t s0 = (size_t)tbp[i0 >> 16] * 256 + (i0 & 0xffffu), s1 = (size_t)tbp[i1 >> 16] * 256 + (i1 & 0xffffu);
                const RowV y0 = row_load_fp8(YC + s0 * D, lane, 1.0f / F8_YSCALE), y1 = row_load_fp8(YC + s1 * D, lane, 1.0f / F8_YSCALE);
#pragma unroll
                for (int j = 0; j < 4; ++j) rr[u].v[j] = rr[u].v[j] + y0.v[j] + y1.v[j];
            }
          }
#pragma unroll
          for (int u = 0; u < 2; ++u) {
            const int i = i2 + u;
            const int rl = wave * 32 + i, m = blk * 256 + rl;
            RowV r = rr[u];
            if (MODE == 0) {
                u32x2* xp = (u32x2*)(XB + (size_t)m * D) + lane;
#pragma unroll
                for (int j = 0; j < 4; ++j) { u32x2 w; w.x = cvt_pk_bf16(r.v[j][0], r.v[j][1]); w.y = cvt_pk_bf16(r.v[j][2], r.v[j][3]); xp[64 * j] = w;
                    r.v[j] = (f32x4){bf_lo(w.x), bf_hi(w.x), bf_lo(w.y), bf_hi(w.y)}; }
            }
            const float rstd = row_rstd(r);
            if (MODE != 2) { if (lane == 0) RSTD[m] = rstd; }
            if (MODE == 1 || (MODE == 0 && G3_F8)) { unsigned* x8 = (unsigned*)(p.ws + WS_XB8 + (size_t)m * D) + lane;
#pragma unroll
                for (int j = 0; j < 4; ++j) x8[64 * j] = cvt_pk4_fp8(r.v[j][0], r.v[j][1], r.v[j][2], r.v[j][3]); }
            if (MODE == 1) {
                float lg[20];
#pragma unroll
                for (int o = 0; o < 20; ++o) { float s = 0.f;
#pragma unroll
                    for (int j = 0; j < 4; ++j) { const f32x4 w = *(const LAS f32x4*)(wt + o * 1024 + 4 * lane + 256 * j); s += (r.v[j][0] * w[0] + r.v[j][1] * w[1]) + (r.v[j][2] * w[2] + r.v[j][3] * w[3]); }
                    lg[o] = wave_sum(s) * rstd + (o < 4 ? bgr[o] : ber[o - 4]); }
                int gs = 0; float gm = lg[0];
#pragma unroll
                for (int o = 1; o < 4; ++o) if (lg[o] > gm) { gm = lg[o]; gs = o; }
                float den = 0.f;
#pragma unroll
                for (int o = 0; o < 4; ++o) den += __expf(lg[o] - gm);
                const float pg = 1.0f / den;
                float el[4];
#pragma unroll
                for (int o = 0; o < 4; ++o) { float v = lg[4 + o];
#pragma unroll
                    for (int g2 = 1; g2 < 4; ++g2) v = (gs == g2) ? lg[4 + 4 * g2 + o] : v;
                    el[o] = v; }
                int i0 = 0; float v0 = el[0];
#pragma unroll
                for (int o = 1; o < 4; ++o) if (el[o] > v0) { v0 = el[o]; i0 = o; }
                int i1 = -1; float v1 = -INFINITY;
#pragma unroll
                for (int o = 0; o < 4; ++o) if (o != i0 && el[o] > v1) { v1 = el[o]; i1 = o; }
                const float ex = __expf(v1 - v0); const float w0 = 1.0f / (1.0f + ex), w1 = ex * w0;
                if (lane == 0) { te[rl * 2] = gs * 4 + i0; te[rl * 2 + 1] = gs * 4 + i1; tc[rl * 2] = w0 * pg; tc[rl * 2 + 1] = w1 * pg; trs[rl] = rstd; }
            }
            if (MODE == 2) {
#pragma unroll
                for (int j = 0; j < 4; ++j) r.v[j] = r.v[j] * rstd * gv.v[j];
                row_store(OUT + (size_t)m * D, lane, r);
            }
          }
        }
        if (MODE == 1) {
            __syncthreads();
            if (tid < 16) { int c = 0; for (int q = 0; q < 512; ++q) if (te[q] == tid) { trank[q] = c; ++c; }
                ebase[tid] = c ? (int)__hip_atomic_fetch_add(cnt_cur + tid * 64, (unsigned)c, __ATOMIC_RELAXED, __HIP_MEMORY_SCOPE_AGENT) : 0; }
            __syncthreads();
            { const int q = tid, e = te[q], pos = ebase[e] + trank[q], tok = blk * 256 + (q >> 1);
              rowtok[(size_t)e * ECAP + pos] = (unsigned)tok; cwraw[(size_t)e * ECAP + pos] = tc[q]; rsraw[(size_t)e * ECAP + pos] = trs[q >> 1]; tokinfo[(size_t)tok * 2 + (q & 1)] = ((unsigned)e << 16) | (unsigned)pos; }
            __syncthreads();
        }
    }
    __syncthreads();
}

__device__ __forceinline__ void phase_router(const Params& p, LAS unsigned char* lds, int tid_, int wave, int G,
                                             const float* gvec, const float* wgr, const float* bgr, const float* wer, const float* ber, unsigned* cnt_cur) {
    int tid = tid_; asm volatile("" : "+v"(tid)); const int lane = tid & 63, r32 = lane & 31, hi = lane >> 5;
    const bf16_t* XB = (const bf16_t*)(p.ws + WS_XB); float* rsraw = (float*)(p.ws + WS_RSRAW);
    unsigned* tokinfo = (unsigned*)(p.ws + WS_TOKINFO);
    unsigned* rowtok = (unsigned*)(p.ws + WS_ROWTOK); float* cwraw = (float*)(p.ws + WS_CWRAW);
    constexpr int WROW = 2048 + 16;
    LAS unsigned char* Whi = lds; LAS unsigned char* Wlo = lds + 24 * WROW;
    LAS int* misc = (LAS int*)(lds + MISC_OFF);
    LAS int* te = misc + 1024; LAS float* tc = (LAS float*)(misc + 1536); LAS int* trank = misc + 2048; LAS int* ebase = misc + 2560; LAS float* trs = (LAS float*)(misc + 2600);
    for (int i = tid; i < 24 * 1024; i += NTHR) { const int sl = i >> 10, k = i & 1023; float w;
        if (sl < 8) w = wgr[(size_t)k * 4 + (sl & 3)]; else { const int q = sl - 8, e = (q & 3) + 8 * ((q >> 2) & 1) + 4 * (q >> 3); w = wer[(size_t)k * 16 + e]; }
        w *= gvec[k];
        const unsigned hb = cvt_pk_bf16(w, 0.f) & 0xffffu; const float wl = w - __uint_as_float(hb << 16); const unsigned lb = cvt_pk_bf16(wl, 0.f) & 0xffffu;
        *(LAS unsigned short*)(Whi + sl * WROW + k * 2) = (unsigned short)hb; *(LAS unsigned short*)(Wlo + sl * WROW + k * 2) = (unsigned short)lb; }
    __syncthreads();
    const int slot_row = r32 < 24 ? r32 : r32 - 8;
    const LAS unsigned char* wh = Whi + slot_row * WROW + hi * 64; const LAS unsigned char* wl_ = Wlo + slot_row * WROW + hi * 64;
    for (int blk = blockIdx.x; blk < T / 256; blk += G) {
        const int rl = wave * 32 + r32, m = blk * 256 + rl;
        const bf16_t* xr = XB + (size_t)m * D + hi * 32;
        f32x16 acc = (f32x16){}; float ss = 0.f;
        bf16x8 xa[4], xb[4];
#pragma unroll
        for (int q = 0; q < 4; ++q) xa[q] = *(const bf16x8*)(xr + q * 8);
#pragma unroll 1
        for (int t = 0; t < 16; t += 2) {
#pragma unroll
            for (int q = 0; q < 4; ++q) xb[q] = *(const bf16x8*)(xr + (t + 1) * 64 + q * 8);
#pragma unroll
            for (int q = 0; q < 4; ++q) { const bf16x8 ah = *(const LAS bf16x8*)(wh + t * 128 + q * 16), al = *(const LAS bf16x8*)(wl_ + t * 128 + q * 16);
                acc = __builtin_amdgcn_mfma_f32_32x32x16_bf16(ah, xa[q], acc, 0, 0, 0); acc = __builtin_amdgcn_mfma_f32_32x32x16_bf16(al, xa[q], acc, 0, 0, 0);
#pragma unroll
                for (int j = 0; j < 4; ++j) { const unsigned w = ((const unsigned*)&xa[q])[j]; const float a = bf_lo(w), b = bf_hi(w); ss += a * a + b * b; } }
            if (t + 2 < 16) {
#pragma unroll
                for (int q = 0; q < 4; ++q) xa[q] = *(const bf16x8*)(xr + (t + 2) * 64 + q * 8); }
#pragma unroll
            for (int q = 0; q < 4; ++q) { const bf16x8 ah = *(const LAS bf16x8*)(wh + (t + 1) * 128 + q * 16), al = *(const LAS bf16x8*)(wl_ + (t + 1) * 128 + q * 16);
                acc = __builtin_amdgcn_mfma_f32_32x32x16_bf16(ah, xb[q], acc, 0, 0, 0); acc = __builtin_amdgcn_mfma_f32_32x32x16_bf16(al, xb[q], acc, 0, 0, 0);
#pragma unroll
                for (int j = 0; j < 4; ++j) { const unsigned w = ((const unsigned*)&xb[q])[j]; const float a = bf_lo(w), b = bf_hi(w); ss += a * a + b * b; } }
        }
        ss += __shfl_xor(ss, 32);
        const float rstd = 1.0f / sqrtf(ss * (1.0f / D) + NORM_EPS);
        float lg[4];
#pragma unroll
        for (int o = 0; o < 4; ++o) lg[o] = acc[o] * rstd + bgr[o];
        int gs = 0; float gm = lg[0];
#pragma unroll
        for (int o = 1; o < 4; ++o) if (lg[o] > gm) { gm = lg[o]; gs = o; }
        float den = 0.f;
#pragma unroll
        for (int o = 0; o < 4; ++o) den += __expf(lg[o] - gm);
        const float pg = 1.0f / den;
        if ((gs >> 1) == hi) {
            float el[4];
#pragma unroll
            for (int o = 0; o < 4; ++o) el[o] = ((gs & 1) ? acc[8 + o] : acc[4 + o]) * rstd + ber[gs * 4 + o];
            int i0 = 0; float v0 = el[0];
#pragma unroll
            for (int o = 1; o < 4; ++o) if (el[o] > v0) { v0 = el[o]; i0 = o; }
            int i1 = -1; float v1 = -INFINITY;
#pragma unroll
            for (int o = 0; o < 4; ++o) if (o != i0 && el[o] > v1) { v1 = el[o]; i1 = o; }
            const float ex = __expf(v1 - v0); const float w0 = 1.0f / (1.0f + ex), w1 = ex * w0;
            te[rl * 2] = gs * 4 + i0; te[rl * 2 + 1] = gs * 4 + i1; tc[rl * 2] = w0 * pg; tc[rl * 2 + 1] = w1 * pg; trs[rl] = rstd;
        }
        __syncthreads();
        if (tid < 16) { int c = 0; for (int q = 0; q < 512; ++q) if (te[q] == tid) { trank[q] = c; ++c; }
            ebase[tid] = c ? (int)__hip_atomic_fetch_add(cnt_cur + tid * 64, (unsigned)c, __ATOMIC_RELAXED, __HIP_MEMORY_SCOPE_AGENT) : 0; }
        __syncthreads();
        { const int q = tid, e = te[q], pos = ebase[e] + trank[q], tok = blk * 256 + (q >> 1);
          rowtok[(size_t)e * ECAP + pos] = (unsigned)tok; cwraw[(size_t)e * ECAP + pos] = tc[q]; rsraw[(size_t)e * ECAP + pos] = trs[q >> 1]; tokinfo[(size_t)tok * 2 + (q & 1)] = ((unsigned)e << 16) | (unsigned)pos; }
        __syncthreads();
    }
    __syncthreads();
}

__device__ __forceinline__ void phase_conv(const Params& p, int gw, int NGW, int lane) {
    const bf16_t* BG = (const bf16_t*)(p.ws + WS_BG); const bf16_t* Z = (const bf16_t*)(p.ws + WS_Z); bf16_t* A2 = (bf16_t*)(p.ws + WS_CAT);
    const float* cw = p.in[16];
    float w0[16], w1[16], w2[16];
#pragma unroll
    for (int h = 0; h < 2; ++h)
#pragma unroll
        for (int j = 0; j < 8; ++j) { const int c = h * 512 + lane * 8 + j; w0[h * 8 + j] = cw[c]; w1[h * 8 + j] = cw[D + c]; w2[h * 8 + j] = cw[2 * D + c]; }
    for (int run = gw; run < T / 32; run += NGW) {
        const int t0 = run * 32;
        float zm1[16], zm2[16];
#pragma unroll
        for (int j = 0; j < 16; ++j) { zm1[j] = 0.f; zm2[j] = 0.f; }
        if ((t0 & (SEQ - 1)) != 0) {
#pragma unroll
            for (int h = 0; h < 2; ++h) { const u32x4 a = *(const u32x4*)(Z + (size_t)(t0 - 1) * D + h * 512 + lane * 8), b = *(const u32x4*)(Z + (size_t)(t0 - 2) * D + h * 512 + lane * 8);
#pragma unroll
                for (int q = 0; q < 4; ++q) { zm1[h * 8 + 2 * q] = bf_lo(a[q]); zm1[h * 8 + 2 * q + 1] = bf_hi(a[q]); zm2[h * 8 + 2 * q] = bf_lo(b[q]); zm2[h * 8 + 2 * q + 1] = bf_hi(b[q]); } }
        }
#pragma unroll 4
        for (int i = 0; i < 32; ++i) {
            const size_t rb = (size_t)(t0 + i) * D;
#pragma unroll
            for (int h = 0; h < 2; ++h) { const u32x4 zz = *(const u32x4*)(Z + rb + h * 512 + lane * 8), bb = *(const u32x4*)(BG + rb + h * 512 + lane * 8);
                float o[8];
#pragma unroll
                for (int q = 0; q < 4; ++q) {
#pragma unroll
                    for (int s = 0; s < 2; ++s) { const int j = h * 8 + 2 * q + s; const float zc = s ? bf_hi(zz[q]) : bf_lo(zz[q]), bg = s ? bf_hi(bb[q]) : bf_lo(bb[q]);
                        o[2 * q + s] = bg * (w0[j] * zm2[j] + w1[j] * zm1[j] + w2[j] * zc); zm2[j] = zm1[j]; zm1[j] = zc; } }
                u32x4 w; w.x = cvt_pk_bf16(o[0], o[1]); w.y = cvt_pk_bf16(o[2], o[3]); w.z = cvt_pk_bf16(o[4], o[5]); w.w = cvt_pk_bf16(o[6], o[7]);
                *(u32x4*)(A2 + rb + h * 512 + lane * 8) = w; }
        }
    }
}

__device__ __forceinline__ void phase_gate_scan(const Params& p, int gw, int NGW, int lane) {
    const float* gates = (const float*)(p.ws + WS_GATES);
    float* SA = (float*)(p.ws + WS_SA); float* SAM = (float*)(p.ws + WS_SAM); float* SBA = (float*)(p.ws + WS_SBA);
    for (int sq = gw; sq < NBATCH * 4; sq += NGW) {
        const int b = sq >> 2, hd = sq & 3; const float ib = p.in[7][hd], fb = p.in[8][hd];
        float lf[32], ig[32];
#pragma unroll
        for (int i = 0; i < 32; ++i) { const size_t t = (size_t)b * SEQ + lane * 32 + i; const float f = gates[t * 8 + 4 + hd] + fb; ig[i] = gates[t * 8 + hd] + ib;
            lf[i] = (f >= 0.f) ? -log1pf(expf(-f)) : (f - log1pf(expf(f))); }
        float run = 0.f;
#pragma unroll
        for (int i = 0; i < 32; ++i) { run += lf[i]; lf[i] = run; }
        float tot = run, pre = 0.f;
#pragma unroll
        for (int o = 1; o < 64; o <<= 1) { const float v = __shfl_up(tot, o); if (lane >= o) tot += v; }
        pre = tot - run;
        float amax = -INFINITY;
#pragma unroll
        for (int i = 0; i < 32; ++i) { lf[i] += pre; ig[i] = ig[i] - lf[i]; amax = fmaxf(amax, ig[i]); }
        float pm = amax;
#pragma unroll
        for (int o = 1; o < 64; o <<= 1) { const float v = __shfl_up(pm, o); if (lane >= o) pm = fmaxf(pm, v); }
        float prev = __shfl_up(pm, 1); if (lane == 0) prev = -INFINITY;
        float rm = prev;
#pragma unroll
        for (int i = 0; i < 32; ++i) { const size_t o = (size_t)sq * SEQ + lane * 32 + i; rm = fmaxf(rm, ig[i]); SA[o] = ig[i]; SAM[o] = rm; SBA[o] = lf[i] + rm; }
    }
}

struct TileRegs { u32x4 v[2]; };
__device__ __forceinline__ TileRegs tile_load(const bf16_t* src, int tid) { TileRegs r;
#pragma unroll
    for (int i = 0; i < 2; ++i) { const int n = tid + 512 * i, row = n >> 4, ch = n & 15; r.v[i] = *(const u32x4*)(src + (size_t)row * NP + ch * 8); } return r; }
__device__ __forceinline__ void tile_write(LAS unsigned char* dst, int tid, const TileRegs& r) {
#pragma unroll
    for (int i = 0; i < 2; ++i) { const int n = tid + 512 * i, row = n >> 4, ch = n & 15; *(LAS u32x4*)(dst + off_b(row, ch)) = r.v[i]; } }

__device__ __forceinline__ void glds16(const void* gsrc, unsigned lds_dst) { unsigned keep;
    asm volatile("s_mov_b32 %0, m0\n\ts_mov_b32 m0, %2\n\ts_nop 0\n\tglobal_load_lds_dwordx4 %1, off\n\ts_mov_b32 m0, %0" : "=&s"(keep) : "v"(gsrc), "s"(lds_dst) : "memory"); }
__device__ __forceinline__ void tile_dma(const bf16_t* src, LAS unsigned char* dst, int wave, int lane) {
#pragma unroll
    for (int i = 0; i < 2; ++i) { const int piece = 2 * wave + i, row = 4 * piece + (lane >> 4); const unsigned ch = (unsigned)(lane & 15) ^ ((((unsigned)lane >> 4) << 2) | ((unsigned)piece & 3u));
        glds16(src + (size_t)row * NP + ch * 8, (unsigned)__builtin_amdgcn_readfirstlane((int)(unsigned)(uintptr_t)(dst + piece * 1024))); }
}
#define WAIT_ALL_BAR() asm volatile("s_waitcnt vmcnt(0) lgkmcnt(0)\n\ts_barrier" ::: "memory")
__device__ __forceinline__ void attn_unit(const Params& p, LAS unsigned char* lds, int bh, int qblk, int tid_, int wave, int lane_) {
    int tid = tid_; asm volatile("" : "+v"(tid)); const int lane = tid & 63;
    const bf16_t* P = (const bf16_t*)(p.ws + WS_P); bf16_t* CAT = (bf16_t*)(p.ws + WS_CAT);
    const int b = bh >> 2, hd = bh & 3, map = wave >> 2, qs = wave & 3, r32 = lane & 31, hi = lane >> 5;
    const size_t rowbase = (size_t)b * SEQ;
    const int q0 = qblk * 128 + qs * 32, qrow = q0 + r32;
    LAS float* fs = (LAS float*)(lds + MISC_OFF) + MW_F;
    LAS float* tbl = fs;
    constexpr float LOG2E = 1.4426950408889634f;
    if (tid < 272) { const int n = tid - 64; int bk;
        if (n < 16) bk = n < 0 ? 0 : n; else { bk = 16; const int th[15] = {19, 21, 24, 27, 31, 35, 40, 46, 52, 59, 67, 77, 87, 99, 113};
#pragma unroll
            for (int j = 0; j < 15; ++j) bk += (n >= th[j]) ? 1 : 0; }
        tbl[tid] = n < 0 ? -INFINITY : p.in[1][bk * 4 + hd] * LOG2E; }
    bf16x8 qf[4];
    { const bf16_t* qp = P + (rowbase + qrow) * NP + P_DQ + hd * 128 + map * 64 + hi * 8;
#pragma unroll
      for (int ks = 0; ks < 4; ++ks) qf[ks] = *(const bf16x8*)(qp + ks * 16); }
    const bf16_t* Kg = P + rowbase * NP + P_DK + hd * 128; const bf16_t* Vg = P + rowbase * NP + P_DV + hd * 128;
    const int NS = qblk + 1;
    f32x16 o[4];
#pragma unroll
    for (int c = 0; c < 4; ++c) o[c] = (f32x16){};
    float mrun = -INFINITY, lrun = 0.f;
    const float bias_far = p.in[1][31 * 4 + hd] * LOG2E;
    const unsigned xr = ((unsigned)(r32 & 3) << 2) | ((unsigned)(r32 >> 2) & 3u);
    const unsigned q4 = (lane & 15) >> 2, pp = lane & 3, blk = (lane >> 4) & 1;
#ifndef ATT_DMA
#define ATT_DMA 5
#endif
#ifndef ATT_LATE_DMA
#define ATT_LATE_DMA 1
#endif
#if ATT_DMA == 2 || ATT_DMA == 4
#elif ATT_DMA
    WAIT_ALL_BAR();
    { tile_dma(Kg, lds, wave, lane); tile_dma(Vg, lds + 16384, wave, lane); tile_dma(Kg + (size_t)64 * NP, lds + 32768, wave, lane); tile_dma(Vg + (size_t)64 * NP, lds + 49152, wave, lane); }
#else
    { TileRegs a0 = tile_load(Kg, tid), a1 = tile_load(Vg, tid), a2 = tile_load(Kg + (size_t)64 * NP, tid), a3 = tile_load(Vg + (size_t)64 * NP, tid);
      tile_write(lds, tid, a0); tile_write(lds + 16384, tid, a1); tile_write(lds + 32768, tid, a2); tile_write(lds + 49152, tid, a3); }
#endif
#if ATT_DMA == 5
    WAIT_ALL_BAR();
#endif
    asm volatile("" :: "v"(qf[0]), "v"(qf[1]), "v"(qf[2]), "v"(qf[3]));
#pragma unroll 1
    for (int st = 0; st < NS; ++st) {
        WAIT_ALL_BAR();
#if ATT_DMA == 2
        { LAS unsigned char* nb = lds + (st & 1) * 65536; const size_t ro = (size_t)st * 128 * NP;
            tile_dma(Kg + ro, nb, wave, lane); tile_dma(Vg + ro, nb + 16384, wave, lane); tile_dma(Kg + ro + (size_t)64 * NP, nb + 32768, wave, lane); tile_dma(Vg + ro + (size_t)64 * NP, nb + 49152, wave, lane); }
        WAIT_ALL_BAR();
#elif ATT_DMA == 3
#elif ATT_DMA
#if ATT_DMA == 4
        if (st == 0) { tile_dma(Kg, lds, wave, lane); tile_dma(Vg, lds + 16384, wave, lane); tile_dma(Kg + (size_t)64 * NP, lds + 32768, wave, lane); tile_dma(Vg + (size_t)64 * NP, lds + 49152, wave, lane); WAIT_ALL_BAR(); }
#endif
        if (!ATT_LATE_DMA && st + 1 < NS) { LAS unsigned char* nb = lds + ((st + 1) & 1) * 65536; const size_t ro = (size_t)(st + 1) * 128 * NP;
            tile_dma(Kg + ro, nb, wave, lane); tile_dma(Vg + ro, nb + 16384, wave, lane); tile_dma(Kg + ro + (size_t)64 * NP, nb + 32768, wave, lane); tile_dma(Vg + ro + (size_t)64 * NP, nb + 49152, wave, lane); }
#else
        TileRegs a0, a1;
        if (st + 1 < NS) { const size_t ro = (size_t)(st + 1) * 128 * NP; a0 = tile_load(Kg + ro, tid); a1 = tile_load(Vg + ro, tid); }
#endif
#pragma unroll
        for (int half = 0; half < 2; ++half) {
            const int j = 2 * st + half;
            const LAS unsigned char* Kt = lds + (st & 1) * 65536 + half * 32768; const LAS unsigned char* Vt = Kt + 16384;
            if (64 * j <= q0 + 31) {
                const int nmin = q0 - (64 * j + 63);
                const bool first = (mrun == -INFINITY);
                const float cinit = first ? 0.f : (nmin >= 113 ? bias_far - mrun : -mrun);
                f32x16 p0, p1;
#pragma unroll
                for (int r = 0; r < 16; ++r) { p0[r] = cinit; p1[r] = cinit; }
#pragma unroll
                for (int ks = 0; ks < 4; ++ks) { const unsigned ch = (unsigned)(8 * map + 2 * ks + hi) ^ xr;
                    const bf16x8 k0 = *(const LAS bf16x8*)(Kt + 256u * r32 + 16u * ch), k1 = *(const LAS bf16x8*)(Kt + 256u * (32 + r32) + 16u * ch);
                    p0 = __builtin_amdgcn_mfma_f32_32x32x16_bf16(k0, qf[ks], p0, 0, 0, 0); p1 = __builtin_amdgcn_mfma_f32_32x32x16_bf16(k1, qf[ks], p1, 0, 0, 0); }
                __builtin_amdgcn_sched_barrier(0);
                float rm = -INFINITY;
                if (first) {
                    if (nmin >= 113) {
#pragma unroll
                        for (int r = 0; r < 16; ++r) { p0[r] = p0[r] + bias_far; p1[r] = p1[r] + bias_far; rm = fmaxf(rm, fmaxf(p0[r], p1[r])); }
                    } else {
                        const LAS float* tb = tbl + (qrow - 64 * j - 4 * hi + 5);
#pragma unroll
                        for (int r = 0; r < 16; ++r) { const int e = (r & 3) + 8 * (r >> 2);
                            p0[r] += tb[59 - e]; p1[r] += tb[27 - e];
                            rm = fmaxf(rm, fmaxf(p0[r], p1[r])); }
                    }
                    { auto rr = __builtin_amdgcn_permlane32_swap(__float_as_uint(rm), __float_as_uint(rm), false, false); rm = fmaxf(__uint_as_float(rr[0]), __uint_as_float(rr[1])); }
                    mrun = rm;
#pragma unroll
                    for (int r = 0; r < 16; ++r) { p0[r] -= mrun; p1[r] -= mrun; }
                } else {
                    if (nmin < 113) {
                        const LAS float* tb = tbl + (qrow - 64 * j - 4 * hi + 5);
                        float bv0[16], bv1[16];
#pragma unroll
                        for (int r = 0; r < 16; ++r) { const int e = (r & 3) + 8 * (r >> 2); bv0[r] = tb[59 - e]; bv1[r] = tb[27 - e]; }
#pragma unroll
                        for (int r = 0; r < 16; ++r) { p0[r] += bv0[r]; p1[r] += bv1[r]; }
                    }
                    { float m0 = fmaxf(p0[0], p1[0]), m1 = fmaxf(p0[1], p1[1]);
#pragma unroll
                      for (int r = 2; r < 16; r += 2) { m0 = __builtin_fmaxf(__builtin_fmaxf(m0, p0[r]), p1[r]); m1 = __builtin_fmaxf(__builtin_fmaxf(m1, p0[r + 1]), p1[r + 1]); }
                      rm = fmaxf(m0, m1); }
                    { auto rr = __builtin_amdgcn_permlane32_swap(__float_as_uint(rm), __float_as_uint(rm), false, false); rm = fmaxf(__uint_as_float(rr[0]), __uint_as_float(rr[1])); }
                    if (__any(rm > 8.0f)) {
                        const float dl = fmaxf(rm, 0.f); const float alpha = fast_exp2(-dl);
                        lrun *= alpha; mrun += dl;
#pragma unroll
                        for (int r = 0; r < 16; ++r) { p0[r] -= dl; p1[r] -= dl; }
#pragma unroll
                        for (int c = 0; c < 4; ++c)
#pragma unroll
                            for (int r = 0; r < 16; ++r) o[c][r] *= alpha;
                    }
                }
                float psa = 0.f, psb = 0.f;
                bf16x8 pf[4];
#define ATT_EXPK(ks_) do { u32x4 w_; _Pragma("unroll") for (int q = 0; q < 4; ++q) { const int r = 8 * ((ks_) & 1) + 2 * q; \
                        const float ea = fast_exp2((ks_) < 2 ? p0[r] : p1[r]), eb = fast_exp2((ks_) < 2 ? p0[r + 1] : p1[r + 1]); psa += ea; psb += eb; w_[q] = cvt_pk_bf16(ea, eb); } \
                    pf[ks_] = __builtin_bit_cast(bf16x8, w_); } while (0)
                bf16x8 vf[2][4];
#define ATT_LOADV(buf, ks_) do { _Pragma("unroll") for (int c = 0; c < 4; ++c) { const unsigned chv = (unsigned)(4 * c + 2 * blk + (pp >> 1)); const unsigned row0 = 16u * (ks_) + 4u * hi + q4; \
                        vf[buf][c] = cat8(vtr(Vt + off_b(row0, chv) + 8u * (pp & 1)), vtr(Vt + off_b(row0 + 8u, chv) + 8u * (pp & 1))); } } while (0)
                ATT_LOADV(0, 0);
                ATT_EXPK(0);
                if (ATT_LATE_DMA && half == 0 && st + 1 < NS) {
                    LAS unsigned char* nb = lds + ((st + 1) & 1) * 65536; const size_t ro = (size_t)(st + 1) * 128 * NP;
                    tile_dma(Kg + ro, nb, wave, lane); tile_dma(Vg + ro, nb + 16384, wave, lane); tile_dma(Kg + ro + (size_t)64 * NP, nb + 32768, wave, lane); tile_dma(Vg + ro + (size_t)64 * NP, nb + 49152, wave, lane); }
#pragma unroll
                for (int ks = 0; ks < 4; ++ks) {
                    if (ks < 3) ATT_LOADV((ks + 1) & 1, ks + 1);
                    __builtin_amdgcn_sched_barrier(0);
#pragma unroll
                    for (int c = 0; c < 4; ++c) o[c] = __builtin_amdgcn_mfma_f32_32x32x16_bf16(vf[ks & 1][c], pf[ks], o[c], 0, 0, 0);
                    if (ks < 3) { ATT_EXPK(ks + 1); asm volatile("" : "+v"(pf[(ks + 1) & 3]), "+v"(psa), "+v"(psb)); }
                    __builtin_amdgcn_sched_barrier(0);
                }
                lrun += psa + psb;
#undef ATT_EXPK
#undef ATT_LOADV
            }
#if ATT_DMA == 5
            if (half == 0) WAIT_ALL_BAR();
#endif
#if !ATT_DMA
            if (st + 1 < NS) { LAS unsigned char* nb = lds + ((st + 1) & 1) * 65536 + half * 32768; tile_write(nb, tid, a0); tile_write(nb + 16384, tid, a1);
                if (half == 0) { const size_t ro = (size_t)(st + 1) * 128 * NP + (size_t)64 * NP; a0 = tile_load(Kg + ro, tid); a1 = tile_load(Vg + ro, tid); } }
#endif
        }
#if ATT_DMA == 3
        WAIT_ALL_BAR();
        if (st + 1 < NS) { LAS unsigned char* nb = lds + ((st + 1) & 1) * 65536; const size_t ro = (size_t)(st + 1) * 128 * NP;
            tile_dma(Kg + ro, nb, wave, lane); tile_dma(Vg + ro, nb + 16384, wave, lane); tile_dma(Kg + ro + (size_t)64 * NP, nb + 32768, wave, lane); tile_dma(Vg + ro + (size_t)64 * NP, nb + 49152, wave, lane); }
#endif

    }
    WAIT_ALL_BAR();
    lrun += __shfl_xor(lrun, 32);
    const float inv = 1.0f / lrun;
    float lam;
    { float s1 = 0.f, s2 = 0.f; const float a1 = p.in[10][lane] * p.in[11][lane], a2 = p.in[12][lane] * p.in[13][lane]; s1 = wave_sum(a1); s2 = wave_sum(a2);
      const float lam_init = 0.8f - 0.6f * 1.0f;
      lam = expf(s1) - expf(s2) + lam_init; }
    LAS float* xch = (LAS float*)lds + qs * 4096;
    if (map == 1) {
#pragma unroll
        for (int c = 0; c < 4; ++c)
#pragma unroll
            for (int r = 0; r < 16; ++r) xch[(32 * c + crow(r, hi)) * 32 + r32] = o[c][r] * inv * lam;
    }
    __syncthreads();
    if (map == 0) {
        float ss = 0.f;
#pragma unroll
        for (int c = 0; c < 4; ++c)
#pragma unroll
            for (int r = 0; r < 16; ++r) { const float v = o[c][r] * inv - xch[(32 * c + crow(r, hi)) * 32 + r32]; o[c][r] = v; ss += v * v; }
        ss += __shfl_xor(ss, 32);
        const float rstd = 1.0f / sqrtf(ss * (1.0f / 128.0f) + NORM_EPS) * 0.8f;
        const float* sub = p.in[14];
        bf16_t* orow = CAT + (rowbase + qrow) * D + 512 + hd * 128;
#pragma unroll
        for (int c = 0; c < 4; ++c)
#pragma unroll
            for (int rq = 0; rq < 4; ++rq) { const int e0 = 32 * c + 8 * rq + 4 * hi; const f32x4 sv = *(const f32x4*)(sub + e0);
                u32x2 w; w.x = cvt_pk_bf16(o[c][4 * rq] * rstd * sv[0], o[c][4 * rq + 1] * rstd * sv[1]); w.y = cvt_pk_bf16(o[c][4 * rq + 2] * rstd * sv[2], o[c][4 * rq + 3] * rstd * sv[3]);
                *(u32x2*)(orow + e0) = w; }
    }
    __syncthreads();
}

__device__ __forceinline__ void mlstm_s1_unit(const Params& p, LAS unsigned char* lds, int bh, int c, int tid_, int wave, int lane_) {
    int tid = tid_; asm volatile("" : "+v"(tid)); const int lane = tid & 63;
    const bf16_t* P = (const bf16_t*)(p.ws + WS_P);
    const int b = bh >> 2, hd = bh & 3, r32 = lane & 31, hi = lane >> 5;
    const size_t t0 = (size_t)b * SEQ + (size_t)c * MCH;
    const float* SA = (const float*)(p.ws + WS_SA) + (size_t)bh * SEQ + c * MCH;
    LAS float* fs = (LAS float*)(lds + MISC_OFF) + MW_F;
    LAS float* wsm = fs;
    LAS float* red = fs + 256;
    float av = (tid < 256) ? SA[tid] : -INFINITY;
    float mx = av;
#pragma unroll
    for (int o = 1; o < 64; o <<= 1) mx = fmaxf(mx, __shfl_xor(mx, o));
    if (lane == 0) red[wave] = mx;
    __syncthreads();
    float R = red[0];
#pragma unroll
    for (int w = 1; w < 4; ++w) R = fmaxf(R, red[w]);
    if (tid < 256) wsm[tid] = __expf(av - R) * 0.08838834764831845f;
    __syncthreads();
    LAS unsigned char* Kl = lds; LAS unsigned char* Vl = lds + 65536;
    const bf16_t* Kg = P + t0 * NP + P_MK + hd * 128; const bf16_t* Vg = P + t0 * NP + P_MV + hd * 128;
#pragma unroll
    for (int i = 0; i < 8; ++i) { const int n = tid + 512 * i, row = n >> 4, ch = n & 15;
        const u32x4 kv = *(const u32x4*)(Kg + (size_t)row * NP + ch * 8); const u32x4 vv = *(const u32x4*)(Vg + (size_t)row * NP + ch * 8);
        const float w = wsm[row]; u32x4 ks;
#pragma unroll
        for (int q = 0; q < 4; ++q) ks[q] = cvt_pk_bf16(bf_lo(kv[q]) * w, bf_hi(kv[q]) * w);
        *(LAS u32x4*)(Kl + off_b(row, ch)) = ks; *(LAS u32x4*)(Vl + off_b(row, ch)) = vv; }
    __syncthreads();
    const int eb = wave >> 1, dh = wave & 1;
    const unsigned q4 = (lane & 15) >> 2, pp = lane & 3, blk = (lane >> 4) & 1;
    f32x16 acc[2]; acc[0] = (f32x16){}; acc[1] = (f32x16){};
    for (int ks = 0; ks < 16; ++ks) {
        const unsigned row0 = 16u * ks + 8u * hi + q4, row1 = row0 + 4u;
        const unsigned cha = (unsigned)(4 * eb + 2 * blk + (pp >> 1));
        const bf16x8 af = cat8(vtr(Vl + off_b(row0, cha) + 8u * (pp & 1)), vtr(Vl + off_b(row1, cha) + 8u * (pp & 1)));
#pragma unroll
        for (int db = 0; db < 2; ++db) { const unsigned chb = (unsigned)(4 * (2 * dh + db) + 2 * blk + (pp >> 1));
            const bf16x8 bfr = cat8(vtr(Kl + off_b(row0, chb) + 8u * (pp & 1)), vtr(Kl + off_b(row1, chb) + 8u * (pp & 1)));
            acc[db] = __builtin_amdgcn_mfma_f32_32x32x16_bf16(af, bfr, acc[db], 0, 0, 0); }
    }
    const int unit = bh * NCH + c;
    float* UT = (float*)(p.ws + WS_UT) + (size_t)unit * 16384;
#pragma unroll
    for (int db = 0; db < 2; ++db)
#pragma unroll
        for (int r = 0; r < 16; ++r) UT[(32 * eb + crow(r, hi)) * 128 + 64 * dh + 32 * db + r32] = acc[db][r];
    if (tid < 128) { float s = 0.f; const int d = tid;
        for (int srow = 0; srow < 256; ++srow) { const unsigned short hv = *(const LAS unsigned short*)(Kl + off_b(srow, d >> 3) + (d & 7) * 2); s += __uint_as_float((unsigned)hv << 16); }
        ((float*)(p.ws + WS_UN))[(size_t)unit * 128 + d] = s; }
    if (tid == 0) ((float*)(p.ws + WS_UR))[unit] = R;
    __syncthreads();
}

__device__ __forceinline__ void mlstm_s3_unit(const Params& p, LAS unsigned char* lds, int bh, int c, int tid_, int wave, int lane_) {
    int tid = tid_; asm volatile("" : "+v"(tid)); const int lane = tid & 63;
    const bf16_t* P = (const bf16_t*)(p.ws + WS_P); bf16_t* CAT = (bf16_t*)(p.ws + WS_CAT);
    const int b = bh >> 2, hd = bh & 3, r32 = lane & 31, hi = lane >> 5;
    const size_t t0 = (size_t)b * SEQ + (size_t)c * MCH;
    const size_t so = (size_t)bh * SEQ + c * MCH;
    const float* SA = (const float*)(p.ws + WS_SA) + so; const float* SAM = (const float*)(p.ws + WS_SAM) + so; const float* SBA = (const float*)(p.ws + WS_SBA) + so;
    LAS float* fs = (LAS float*)(lds + MISC_OFF) + MW_F;
    LAS float* as = fs;
    LAS float* nC = fs + 256;
    LAS unsigned char* Ct = lds + 65536;
    const int qloc = 32 * wave + r32;
    const float Aq = SAM[qloc], BAq = SBA[qloc];
    if (tid < 256) as[tid] = SA[tid];
    bf16x8 qf[8];
    { const bf16_t* qp = P + (t0 + qloc) * NP + P_MQ + hd * 128 + hi * 8;
#pragma unroll
      for (int ks = 0; ks < 8; ++ks) qf[ks] = *(const bf16x8*)(qp + ks * 16); }
    const bf16_t* Kg = P + t0 * NP + P_MK + hd * 128; const bf16_t* Vg = P + t0 * NP + P_MV + hd * 128;
#if defined(S3_REGSTAGE)
    { TileRegs k0 = tile_load(Kg, tid), v0 = tile_load(Vg, tid); tile_write(lds, tid, k0); tile_write(lds + 16384, tid, v0); }
#elif !defined(S3_SERIAL)
    tile_dma(Kg, lds, wave, lane); tile_dma(Vg, lds + 16384, wave, lane);
#endif
    f32x16 o[4];
#pragma unroll
    for (int cb = 0; cb < 4; ++cb) o[cb] = (f32x16){};
    float den = 0.f, fst = 0.f;
    const unsigned xr = ((unsigned)(r32 & 3) << 2) | ((unsigned)(r32 >> 2) & 3u);
    if (c > 0) {
        const float* UR = (const float*)(p.ws + WS_UR) + bh * NCH; const float* UT = (const float*)(p.ws + WS_UT) + (size_t)bh * NCH * 16384; const float* UN = (const float*)(p.ws + WS_UN) + (size_t)bh * NCH * 128;
        float Pref = -INFINITY, ur[7];
#pragma unroll
        for (int j = 0; j < 7; ++j) { ur[j] = UR[j]; if (j < c) Pref = fmaxf(Pref, ur[j]); }
        float cf[7];
#pragma unroll
        for (int j = 0; j < 7; ++j) cf[j] = (j < c) ? __expf(ur[j] - Pref) : 0.f;
#pragma unroll 1
        for (int i = 0; i < 4; ++i) { const int n = tid + 512 * i, e = n >> 4, ch = n & 15; f32x4 u0[7], u1[7];
#pragma unroll
            for (int j = 0; j < 7; ++j) { const f32x4* up = (const f32x4*)(UT + (size_t)j * 16384 + e * 128 + ch * 8); u0[j] = up[0]; u1[j] = up[1]; }
            f32x4 s0 = (f32x4){0.f, 0.f, 0.f, 0.f}, s1 = s0;
#pragma unroll
            for (int j = 0; j < 7; ++j) { s0 += u0[j] * cf[j]; s1 += u1[j] * cf[j]; }
            u32x4 w; w.x = cvt_pk_bf16(s0[0], s0[1]); w.y = cvt_pk_bf16(s0[2], s0[3]); w.z = cvt_pk_bf16(s1[0], s1[1]); w.w = cvt_pk_bf16(s1[2], s1[3]);
            *(LAS u32x4*)(Ct + off_b(e, ch)) = w; }
        if (tid < 128) { float sN = 0.f;
#pragma unroll
            for (int j = 0; j < 7; ++j) sN += cf[j] * UN[j * 128 + tid];
            nC[tid] = sN; }
        fst = __expf(Pref - Aq);
    }
    asm volatile("" :: "v"(qf[0]), "v"(qf[1]), "v"(qf[2]), "v"(qf[3]), "v"(qf[4]), "v"(qf[5]), "v"(qf[6]), "v"(qf[7]), "v"(Aq), "v"(BAq));
    WAIT_ALL_BAR();
    if (c > 0) {
#pragma unroll
        for (int cb = 0; cb < 4; ++cb) {
#pragma unroll
            for (int ks = 0; ks < 8; ++ks) { const unsigned ch = (unsigned)(2 * ks + hi) ^ xr;
                const bf16x8 cfr = *(const LAS bf16x8*)(Ct + 256u * (32 * cb + r32) + 16u * ch);
                o[cb] = __builtin_amdgcn_mfma_f32_32x32x16_bf16(cfr, qf[ks], o[cb], 0, 0, 0); }
            __builtin_amdgcn_sched_barrier(0); }
#pragma unroll
        for (int cb = 0; cb < 4; ++cb)
#pragma unroll
            for (int r = 0; r < 16; ++r) o[cb][r] *= fst;
        float dq = 0.f;
#pragma unroll
        for (int ks = 0; ks < 8; ++ks)
#pragma unroll
            for (int q = 0; q < 4; ++q) { const unsigned w = ((const unsigned*)&qf[ks])[q]; const int d = 16 * ks + 8 * hi + 2 * q; dq += bf_lo(w) * nC[d] + bf_hi(w) * nC[d + 1]; }
        den = fst * dq;
    }
    const unsigned q4 = (lane & 15) >> 2, pp = lane & 3, blk = (lane >> 4) & 1;
#pragma unroll 1
    for (int j = 0; j < 4; ++j) {
        WAIT_ALL_BAR();
        const LAS unsigned char* Kt = lds + (j & 1) * 32768; const LAS unsigned char* Vt = Kt + 16384;
#if defined(S3_REGSTAGE)
        TileRegs kr, vr; if (j + 1 < 4) { kr = tile_load(Kg + (size_t)(j + 1) * 64 * NP, tid); vr = tile_load(Vg + (size_t)(j + 1) * 64 * NP, tid); }
#elif defined(S3_SERIAL)
        { LAS unsigned char* nb = lds + (j & 1) * 32768; tile_dma(Kg + (size_t)j * 64 * NP, nb, wave, lane); tile_dma(Vg + (size_t)j * 64 * NP, nb + 16384, wave, lane); }
        WAIT_ALL_BAR();
#else
        if (j + 1 < 4) { LAS unsigned char* nb = lds + ((j + 1) & 1) * 32768; tile_dma(Kg + (size_t)(j + 1) * 64 * NP, nb, wave, lane); tile_dma(Vg + (size_t)(j + 1) * 64 * NP, nb + 16384, wave, lane); }
#endif
        const bool doit = (64 * j <= 32 * wave + 31);
        bf16x8 pf[4];
        if (doit) {
            f32x16 p0 = (f32x16){}, p1 = (f32x16){};
#pragma unroll
            for (int ks = 0; ks < 8; ++ks) { const unsigned ch = (unsigned)(2 * ks + hi) ^ xr;
                const bf16x8 k0 = *(const LAS bf16x8*)(Kt + 256u * r32 + 16u * ch), k1 = *(const LAS bf16x8*)(Kt + 256u * (32 + r32) + 16u * ch);
                p0 = __builtin_amdgcn_mfma_f32_32x32x16_bf16(k0, qf[ks], p0, 0, 0, 0); p1 = __builtin_amdgcn_mfma_f32_32x32x16_bf16(k1, qf[ks], p1, 0, 0, 0); if ((ks & 3) == 3) __builtin_amdgcn_sched_barrier(0); }
            float ps = 0.f;
#pragma unroll
            for (int r = 0; r < 16; ++r) { const int kv = 64 * j + crow(r, hi);
                const float w0 = (kv <= qloc) ? __expf(as[kv] - Aq) * 0.08838834764831845f : 0.f, w1 = (kv + 32 <= qloc) ? __expf(as[kv + 32] - Aq) * 0.08838834764831845f : 0.f;
                p0[r] *= w0; p1[r] *= w1; ps += p0[r] + p1[r]; }
            den += ps;
#pragma unroll
            for (int ks = 0; ks < 4; ++ks) { u32x4 w;
#pragma unroll
                for (int q = 0; q < 4; ++q) { const int r = 8 * (ks & 1) + 2 * q; w[q] = (ks < 2) ? cvt_pk_bf16(p0[r], p0[r + 1]) : cvt_pk_bf16(p1[r], p1[r + 1]); }
                pf[ks] = __builtin_bit_cast(bf16x8, w); }
        }
        WAIT_ALL_BAR();
        if (doit) {
            bf16x8 vf[2][4];
#define S3_LOADV(buf, ks_) do { _Pragma("unroll") for (int cb = 0; cb < 4; ++cb) { const unsigned chv = (unsigned)(4 * cb + 2 * blk + (pp >> 1)); const unsigned row0 = 16u * (ks_) + 4u * hi + q4; \
                vf[buf][cb] = cat8(vtr(Vt + off_b(row0, chv) + 8u * (pp & 1)), vtr(Vt + off_b(row0 + 8u, chv) + 8u * (pp & 1))); } } while (0)
            S3_LOADV(0, 0);
#pragma unroll
            for (int ks = 0; ks < 4; ++ks) {
                if (ks < 3) S3_LOADV((ks + 1) & 1, ks + 1);
                __builtin_amdgcn_sched_barrier(0);
#pragma unroll
                for (int cb = 0; cb < 4; ++cb) o[cb] = __builtin_amdgcn_mfma_f32_32x32x16_bf16(vf[ks & 1][cb], pf[ks], o[cb], 0, 0, 0);
                __builtin_amdgcn_sched_barrier(0);
            }
#undef S3_LOADV
        }
#if defined(S3_REGSTAGE)
        if (j + 1 < 4) { LAS unsigned char* nb = lds + ((j + 1) & 1) * 32768; tile_write(nb, tid, kr); tile_write(nb + 16384, tid, vr); }
#endif
    }
    den += __shfl_xor(den, 32);
    const float dinv = 1.0f / fmaxf(fabsf(den), __expf(-BAq));
    float sm = 0.f;
#pragma unroll
    for (int cb = 0; cb < 4; ++cb)
#pragma unroll
        for (int r = 0; r < 16; ++r) { o[cb][r] *= dinv; sm += o[cb][r]; }
    sm += __shfl_xor(sm, 32);
    const float mu = sm * (1.0f / 128.0f);
    float vs = 0.f;
#pragma unroll
    for (int cb = 0; cb < 4; ++cb)
#pragma unroll
        for (int r = 0; r < 16; ++r) { o[cb][r] -= mu; vs += o[cb][r] * o[cb][r]; }
    vs += __shfl_xor(vs, 32);
    const float rstd = 1.0f / sqrtf(vs * (1.0f / 128.0f) + NORM_EPS);
    const float* hn = p.in[9] + hd * 128;
    const bf16_t* mo = P + (t0 + qloc) * NP + P_MO + hd * 128;
    bf16_t* orow = CAT + (t0 + qloc) * D + hd * 128;
    u32x2 mw[4][4];
#pragma unroll
    for (int cb = 0; cb < 4; ++cb)
#pragma unroll
        for (int rq = 0; rq < 4; ++rq) mw[cb][rq] = *(const u32x2*)(mo + 32 * cb + 8 * rq + 4 * hi);
#pragma unroll
    for (int cb = 0; cb < 4; ++cb)
#pragma unroll
        for (int rq = 0; rq < 4; ++rq) { const int e0 = 32 * cb + 8 * rq + 4 * hi; const f32x4 hv = *(const f32x4*)(hn + e0); const u32x2 m2 = mw[cb][rq];
            const float g0 = fast_rcp(1.0f + __expf(-bf_lo(m2.x))), g1 = fast_rcp(1.0f + __expf(-bf_hi(m2.x))), g2 = fast_rcp(1.0f + __expf(-bf_lo(m2.y))), g3 = fast_rcp(1.0f + __expf(-bf_hi(m2.y)));
            u32x2 w; w.x = cvt_pk_bf16(o[cb][4 * rq] * rstd * hv[0] * g0, o[cb][4 * rq + 1] * rstd * hv[1] * g1); w.y = cvt_pk_bf16(o[cb][4 * rq + 2] * rstd * hv[2] * g2, o[cb][4 * rq + 3] * rstd * hv[3] * g3);
            *(u32x2*)(orow + e0) = w; }
    WAIT_ALL_BAR();
}

__device__ __forceinline__ void mlstm_seq_unit(const Params& p, LAS unsigned char* lds, int bh, int tid_, int wave, int lane_) {
    int tid = tid_; asm volatile("" : "+v"(tid)); const int lane = tid & 63;
    const bf16_t* P = (const bf16_t*)(p.ws + WS_P); bf16_t* CAT = (bf16_t*)(p.ws + WS_CAT);
    const int b = bh >> 2, hd = bh & 3, r32 = lane & 31, hi = lane >> 5;
    LAS float* fs = (LAS float*)(lds + MISC_OFF) + MW_F;
    LAS float* as = fs;
    LAS float* nC = fs + 256;
    LAS float* wsc = fs + 384;
    LAS unsigned char* Ct = lds + 65536;
    const unsigned xr = ((unsigned)(r32 & 3) << 2) | ((unsigned)(r32 >> 2) & 3u);
    const unsigned q4 = (lane & 15) >> 2, pp = lane & 3, blk = (lane >> 4) & 1;
    const int eb = wave >> 1, dh = wave & 1;
    f32x16 cacc[2]; cacc[0] = (f32x16){}; cacc[1] = (f32x16){};
    float nrun = 0.f;
    float Prun = -INFINITY;
    LAS float* hnl = fs + 896;
    if (tid < 128) hnl[tid] = p.in[9][hd * 128 + tid];
#pragma unroll 1
    for (int c = 0; c < NCH; ++c) {
        const size_t t0 = (size_t)b * SEQ + (size_t)c * MCH;
        const size_t so = (size_t)bh * SEQ + c * MCH;
        const float* SA = (const float*)(p.ws + WS_SA) + so; const float* SAM = (const float*)(p.ws + WS_SAM) + so; const float* SBA = (const float*)(p.ws + WS_SBA) + so;
        const int qloc = 32 * wave + r32;
        const float Aq2 = SAM[qloc] * 1.4426950408889634f;
        if (tid < 256) as[tid] = SA[tid] * 1.4426950408889634f;
        bf16x8 qf[2];
        LAS bf16x8* qpark = (LAS bf16x8*)(lds + 98304 + tid * 64);
        LAS bf16x8* qpark2 = (LAS bf16x8*)(lds + 147456 + tid * 32);
        { const bf16_t* qp = P + (t0 + qloc) * NP + P_MQ + hd * 128 + hi * 8;
#pragma unroll
          for (int ks = 0; ks < 2; ++ks) qf[ks] = *(const bf16x8*)(qp + ks * 16);
#pragma unroll
          for (int ks = 2; ks < 6; ++ks) qpark[ks - 2] = *(const bf16x8*)(qp + ks * 16);
#pragma unroll
          for (int ks = 6; ks < 8; ++ks) qpark2[ks - 6] = *(const bf16x8*)(qp + ks * 16); }
#define QFRAG(ks) ((ks) < 2 ? qf[(ks) & 1] : ((ks) < 6 ? qpark[((ks) - 2) & 3] : qpark2[((ks) - 6) & 1]))
        const bf16_t* Kg = P + t0 * NP + P_MK + hd * 128; const bf16_t* Vg = P + t0 * NP + P_MV + hd * 128;
        tile_dma(Kg, lds, wave, lane); tile_dma(Vg, lds + 16384, wave, lane);
        asm volatile("" :: "v"(qf[0]), "v"(qf[1]), "v"(Aq2));
        WAIT_ALL_BAR();
        float R = fmaxf(fmaxf(as[lane], as[lane + 64]), fmaxf(as[lane + 128], as[lane + 192]));
#pragma unroll
        for (int o = 1; o < 64; o <<= 1) R = fmaxf(R, __shfl_xor(R, o));
        R *= (1.0f / 1.4426950408889634f);
        const float Pnew = fmaxf(Prun, R);
        const float scC = (c > 0) ? __expf(Prun - Pnew) : 0.f;
        if (tid < 256) wsc[tid] = fast_exp2(as[tid] - Pnew * 1.4426950408889634f) * 0.08838834764831845f;
        f32x16 o[4];
#pragma unroll
        for (int cb = 0; cb < 4; ++cb) o[cb] = (f32x16){};
        float den = 0.f;
        if (c > 0) {
#pragma unroll
            for (int cb = 0; cb < 4; ++cb) {
#pragma unroll
                for (int ks = 0; ks < 8; ++ks) { const unsigned ch = (unsigned)(2 * ks + hi) ^ xr;
                    const bf16x8 cfr = *(const LAS bf16x8*)(Ct + 256u * (32 * cb + r32) + 16u * ch);
                    const bf16x8 qv = QFRAG(ks);
                    o[cb] = __builtin_amdgcn_mfma_f32_32x32x16_bf16(cfr, qv, o[cb], 0, 0, 0); }
                __builtin_amdgcn_sched_barrier(0); }
            const float fst = fast_exp2(Prun * 1.4426950408889634f - Aq2);
#pragma unroll
            for (int cb = 0; cb < 4; ++cb)
#pragma unroll
                for (int r = 0; r < 16; ++r) o[cb][r] *= fst;
            float dq = 0.f;
#pragma unroll
            for (int ks = 0; ks < 8; ++ks) { const bf16x8 qv = QFRAG(ks);
#pragma unroll
                for (int q = 0; q < 4; ++q) { const unsigned w = ((const unsigned*)&qv)[q]; const int d = 16 * ks + 8 * hi + 2 * q; dq += bf_lo(w) * nC[d] + bf_hi(w) * nC[d + 1]; } }
            den = fst * dq;
#pragma unroll
            for (int r = 0; r < 16; ++r) { cacc[0][r] *= scC; cacc[1][r] *= scC; }
        }
        nrun *= scC;
#pragma unroll 1
        for (int j = 0; j < 4; ++j) {
            WAIT_ALL_BAR();
            const LAS unsigned char* Kt = lds + (j & 1) * 32768; const LAS unsigned char* Vt = Kt + 16384;
            if (j + 1 < 4) { LAS unsigned char* nb = lds + ((j + 1) & 1) * 32768; tile_dma(Kg + (size_t)(j + 1) * 64 * NP, nb, wave, lane); tile_dma(Vg + (size_t)(j + 1) * 64 * NP, nb + 16384, wave, lane); }
            const bool doit = (64 * j <= 32 * wave + 31);
            if (doit) {
                float ps = 0.f;
#pragma unroll
                for (int hf = 0; hf < 2; ++hf) {
                    f32x16 pp0 = (f32x16){};
#pragma unroll
                    for (int ks = 0; ks < 8; ++ks) { const unsigned ch = (unsigned)(2 * ks + hi) ^ xr;
                        const bf16x8 k0 = *(const LAS bf16x8*)(Kt + 256u * (32 * hf + r32) + 16u * ch);
                        const bf16x8 qv = QFRAG(ks);
                        pp0 = __builtin_amdgcn_mfma_f32_32x32x16_bf16(k0, qv, pp0, 0, 0, 0); }
#pragma unroll
                    for (int r = 0; r < 16; ++r) { const int kv = 64 * j + 32 * hf + crow(r, hi);
                        const float w0 = (kv <= qloc) ? fast_exp2(as[kv] - Aq2) * 0.08838834764831845f : 0.f;
                        pp0[r] *= w0; ps += pp0[r]; }
                    bf16x8 pfh[2];
#pragma unroll
                    for (int k2 = 0; k2 < 2; ++k2) { u32x4 w;
#pragma unroll
                        for (int q = 0; q < 4; ++q) { const int r = 8 * k2 + 2 * q; w[q] = cvt_pk_bf16(pp0[r], pp0[r + 1]); }
                        pfh[k2] = __builtin_bit_cast(bf16x8, w); }
                    __builtin_amdgcn_sched_barrier(0);
#pragma unroll
                    for (int k2 = 0; k2 < 2; ++k2)
#pragma unroll
                        for (int c2 = 0; c2 < 2; ++c2) {
                            bf16x8 vf[2];
#pragma unroll
                            for (int u = 0; u < 2; ++u) { const int cb = 2 * c2 + u; const unsigned chv = (unsigned)(4 * cb + 2 * blk + (pp >> 1)); const unsigned row0 = 16u * (2 * hf + k2) + 4u * hi + q4;
                                vf[u] = cat8(vtr(Vt + off_b(row0, chv) + 8u * (pp & 1)), vtr(Vt + off_b(row0 + 8u, chv) + 8u * (pp & 1))); }
                            o[2 * c2] = __builtin_amdgcn_mfma_f32_32x32x16_bf16(vf[0], pfh[k2], o[2 * c2], 0, 0, 0); o[2 * c2 + 1] = __builtin_amdgcn_mfma_f32_32x32x16_bf16(vf[1], pfh[k2], o[2 * c2 + 1], 0, 0, 0);
                            __builtin_amdgcn_sched_barrier(0);
                        }
                }
                den += ps;
            }
#pragma unroll
            for (int ks = 0; ks < 4; ++ks) {
                const unsigned row0 = 16u * ks + 8u * hi + q4, row1 = row0 + 4u;
                const unsigned cha = (unsigned)(4 * eb + 2 * blk + (pp >> 1));
                const bf16x8 af = cat8(vtr(Vt + off_b(row0, cha) + 8u * (pp & 1)), vtr(Vt + off_b(row1, cha) + 8u * (pp & 1)));
                const f32x4 wa = *(const LAS f32x4*)(wsc + 64 * j + 16 * ks + 8 * hi), wb = *(const LAS f32x4*)(wsc + 64 * j + 16 * ks + 8 * hi + 4);
#pragma unroll
                for (int db = 0; db < 2; ++db) { const unsigned chb = (unsigned)(4 * (2 * dh + db) + 2 * blk + (pp >> 1));
                    const s16x4 k0 = vtr(Kt + off_b(row0, chb) + 8u * (pp & 1)), k1 = vtr(Kt + off_b(row1, chb) + 8u * (pp & 1));
                    const u32x2 u0 = __builtin_bit_cast(u32x2, k0), u1 = __builtin_bit_cast(u32x2, k1);
                    u32x4 kw; kw.x = cvt_pk_bf16(bf_lo(u0.x) * wa[0], bf_hi(u0.x) * wa[1]); kw.y = cvt_pk_bf16(bf_lo(u0.y) * wa[2], bf_hi(u0.y) * wa[3]);
                    kw.z = cvt_pk_bf16(bf_lo(u1.x) * wb[0], bf_hi(u1.x) * wb[1]); kw.w = cvt_pk_bf16(bf_lo(u1.y) * wb[2], bf_hi(u1.y) * wb[3]);
                    cacc[db] = __builtin_amdgcn_mfma_f32_32x32x16_bf16(af, __builtin_bit_cast(bf16x8, kw), cacc[db], 0, 0, 0); }
                __builtin_amdgcn_sched_barrier(0);
            }
            { const int d = tid & 127, sq = tid >> 7; float sN = 0.f;
#pragma unroll 4
                for (int s2 = 0; s2 < 16; ++s2) { const int srow = 16 * sq + s2; const unsigned short hv = *(const LAS unsigned short*)(Kt + off_b(srow, d >> 3) + (d & 7) * 2); sN += __uint_as_float((unsigned)hv << 16) * wsc[64 * j + srow]; }
                nrun += sN; }
            WAIT_ALL_BAR();
        }
        int tid2 = tid_; asm volatile("" : "+v"(tid2));
        const int qloc2 = 32 * wave + (tid2 & 31), hi2 = (tid2 >> 5) & 1;
        const float BAq = SBA[qloc2];
        den += __shfl_xor(den, 32);
        const float dinv = 1.0f / fmaxf(fabsf(den), __expf(-BAq));
        float sm = 0.f;
#pragma unroll
        for (int cb = 0; cb < 4; ++cb)
#pragma unroll
            for (int r = 0; r < 16; ++r) { o[cb][r] *= dinv; sm += o[cb][r]; }
        sm += __shfl_xor(sm, 32);
        const float mu = sm * (1.0f / 128.0f);
        float vs = 0.f;
#pragma unroll
        for (int cb = 0; cb < 4; ++cb)
#pragma unroll
            for (int r = 0; r < 16; ++r) { o[cb][r] -= mu; vs += o[cb][r] * o[cb][r]; }
        vs += __shfl_xor(vs, 32);
        const float rstd = 1.0f / sqrtf(vs * (1.0f / 128.0f) + NORM_EPS);
        const bf16_t* mo = P + (t0 + qloc2) * NP + P_MO + hd * 128 + 4 * hi2;
        bf16_t* orow = CAT + (t0 + qloc2) * D + hd * 128 + 4 * hi2;
#pragma unroll
        for (int c2 = 0; c2 < 2; ++c2) {
            u32x2 mw[8];
#pragma unroll
            for (int u = 0; u < 8; ++u) mw[u] = *(const u32x2*)(mo + 32 * (2 * c2 + (u >> 2)) + 8 * (u & 3));
#pragma unroll
            for (int u = 0; u < 8; ++u) { const int cb = 2 * c2 + (u >> 2), rq = u & 3; const int e0 = 32 * cb + 8 * rq; const u32x2 m2 = mw[u]; const f32x4 hv = *(const LAS f32x4*)(hnl + e0 + 4 * hi2);
                const float g0 = fast_rcp(1.0f + fast_exp2(-1.4426950408889634f * bf_lo(m2.x))), g1 = fast_rcp(1.0f + fast_exp2(-1.4426950408889634f * bf_hi(m2.x))), g2 = fast_rcp(1.0f + fast_exp2(-1.4426950408889634f * bf_lo(m2.y))), g3 = fast_rcp(1.0f + fast_exp2(-1.4426950408889634f * bf_hi(m2.y)));
                u32x2 w; w.x = cvt_pk_bf16(o[cb][4 * rq] * rstd * hv[0] * g0, o[cb][4 * rq + 1] * rstd * hv[1] * g1); w.y = cvt_pk_bf16(o[cb][4 * rq + 2] * rstd * hv[2] * g2, o[cb][4 * rq + 3] * rstd * hv[3] * g3);
                *(u32x2*)(orow + e0) = w; }
            __builtin_amdgcn_sched_barrier(0); }
        if (c + 1 < NCH) {
#pragma unroll
            for (int db = 0; db < 2; ++db)
#pragma unroll
                for (int r = 0; r < 16; ++r) { const int e = 32 * eb + crow(r, hi), d = 64 * dh + 32 * db + r32;
                    *(LAS unsigned short*)(Ct + off_b(e, d >> 3) + (d & 7) * 2) = (unsigned short)(cvt_pk_bf16(cacc[db][r], 0.f) & 0xffffu); }
            wsc[tid] = nrun;
        }
        Prun = Pnew;
        WAIT_ALL_BAR();
        if (c + 1 < NCH) { if (tid < 128) nC[tid] = (wsc[tid] + wsc[tid + 128]) + (wsc[tid + 256] + wsc[tid + 384]); }
    }
#undef QFRAG
}

__device__ __forceinline__ int moe_table(LAS unsigned char* lds, unsigned* cnt, int tid) {
    LAS int* misc = (LAS int*)(lds + MISC_OFF);
    __syncthreads();
    if (tid == 0) { int acc = 0; for (int e = 0; e < 16; ++e) { const int c = (int)__hip_atomic_load(cnt + e * 64, __ATOMIC_RELAXED, __HIP_MEMORY_SCOPE_AGENT); misc[MW_CN + e] = c; misc[MW_TB + e] = acc; acc += (c + 255) >> 8; } misc[MW_TB + 16] = acc; }
    __syncthreads();
    return misc[MW_TB + 16];
}

#ifndef STAGGER_MASK
#define STAGGER_MASK 0u
#endif
#ifndef STAGGER_GROUPS
#define STAGGER_GROUPS 4
#endif
#ifndef STAGGER_TICKS
#define STAGGER_TICKS 700
#endif
__device__ __forceinline__ void stagger(int vcu, int phase_bit) {
    if (!((STAGGER_MASK >> phase_bit) & 1u)) return;
    const int g = vcu & (STAGGER_GROUPS - 1); if (g == 0) return;
    const unsigned long long t0 = __builtin_amdgcn_s_memrealtime(); const unsigned long long w = (unsigned long long)g * STAGGER_TICKS;
    while (__builtin_amdgcn_s_memrealtime() - t0 < w) __builtin_amdgcn_s_sleep(8);
}
constexpr int LATE_UNITS = 224, LATE_PIECES = LATE_UNITS * 4, CW_LATEQ = CW_QUEUE + 64 * 8;
__device__ __forceinline__ void late_convert(const Params& p, LAS unsigned char* lds, unsigned* ctl, int quota, int tid, int wave, int lane) {
    volatile LAS unsigned* misc = (volatile LAS unsigned*)(lds + MISC_OFF);
    for (int k = 0; k < quota; ++k) {
        __syncthreads();
        if (tid == 0) misc[MW_Q] = __hip_atomic_fetch_add(ctl + CW_LATEQ, 1u, __ATOMIC_RELAXED, __HIP_MEMORY_SCOPE_AGENT);
        __syncthreads();
        const int q = (int)misc[MW_Q];
        if (q >= LATE_PIECES) break;
        const int c = q >> 2, sub = q & 3, v = c < 32 ? 8 + c : 232 + (c - 32);
        const int f = WT_I1 + 64 * v + 16 * sub + 2 * wave;
        phase_prologue_weights(p, lds, f, f + 2, 1, wave, lane);
    }
    __syncthreads();
}
template <int LAYER>
__device__ __forceinline__ void moe_block(const Params& p, LAS unsigned char* lds, const XcdBarrier& bar, unsigned* ctl, int tid, int wave, int lane, int vcu, int G) {
    unsigned char* ws = p.ws;
    const LAS int* tb = (const LAS int*)(lds + MISC_OFF) + MW_TB; const LAS int* cn = (const LAS int*)(lds + MISC_OFF) + MW_CN;
    unsigned* cnt = ctl + CW_CNT + LAYER * 16 * 64;
    if (PH(12)) phase_router(p, lds, tid, wave, G, p.in[3] + LAYER * D, p.in[18] + (size_t)LAYER * D * 4, p.in[19] + LAYER * 4, p.in[20] + (size_t)LAYER * D * 16, p.in[21] + LAYER * 16, cnt);
    xcd_barrier(bar);
    const int ntot = moe_table(lds, cnt, tid);
    stagger(vcu, 13);
    for (int rep_ = 0; rep_ < REPS(13); ++rep_) if (PH(13)) { pg8::MoeSched<true> S{(const char*)(ws + WS_XB8), (const char*)(ws + WS_WGU) + (size_t)LAYER * 16 * 1024 * 1024, 512, (size_t)1024 * 1024, tb, cn, (const unsigned*)(ws + WS_ROWTOK), ntot, vcu, G};
      pg8::EpiPair<1> E{nullptr, (bf16_t*)(ws + WS_HM), FF, (const float*)(ws + WS_RSRAW), (const unsigned*)(ws + WS_ROWTOK), tb, cn};
      pg8::gemm_phase<pg8::EpiPair<1>, pg8::MoeSched<true>, true, true>(lds, 512, S, E); }
    const int nun = ntot * 4, rounds_max = (nun + G - 1) / G, rounds_mine = nun > vcu ? (nun - vcu + G - 1) / G : 0;
    if (LATE_CV && LAYER == 0 && PH(0)) late_convert(p, lds, ctl, 2 * (rounds_max - rounds_mine), tid, wave, lane);
    xcd_barrier(bar);
    stagger(vcu, 14);
    for (int rep_ = 0; rep_ < REPS(14); ++rep_) if (PH(14)) { pg8::MoeSched<false> S{(const char*)(ws + WS_HM), (const char*)(ws + WS_WD) + (size_t)LAYER * 16 * 1024 * 512, 256, (size_t)1024 * 512, tb, cn, nullptr, ntot, vcu, G};
      pg8::EpiDown E{(unsigned char*)(ws + WS_YC), (const float*)(ws + WS_CWRAW), tb, cn};
      pg8::gemm_phase<pg8::EpiDown, pg8::MoeSched<false>, false, true>(lds, 256, S, E); }
    if (LATE_CV && LAYER == 0 && PH(0)) { late_convert(p, lds, ctl, rounds_max - rounds_mine, tid, wave, lane); late_convert(p, lds, ctl, 1 << 20, tid, wave, lane); }
    xcd_barrier(bar);
}

__global__ void __launch_bounds__(NTHR, 2) fwd_kernel(Params p) {
    extern __shared__ __attribute__((aligned(16))) unsigned char lds_raw[];
    LAS unsigned char* lds = (LAS unsigned char*)lds_raw;
    const int tid = threadIdx.x, lane = tid & 63, wave = __builtin_amdgcn_readfirstlane(tid >> 6);
    const int G = gridDim.x; const int bx = blockIdx.x;
    const int vcu = (G % 8 == 0) ? (bx % 8) * (G / 8) + bx / 8 : bx;
    const int gw = vcu * NWAVES + wave, NGW = G * NWAVES;
    volatile LAS unsigned* misc = (volatile LAS unsigned*)(lds + MISC_OFF);
    for (int u = tid; u < (LDS_BYTES - MISC_OFF) / 4; u += NTHR) misc[u] = 0u;
    __syncthreads();
    unsigned* ctl = (unsigned*)(p.ws + WS_CTL);
    XcdBarrier bar = xcd_barrier_post(ctl + CW_BAR, misc + MW_BAR);
    unsigned char* ws = p.ws;

    for (int rep_ = 0; rep_ < REPS(0); ++rep_) if (PH(0)) phase_prologue_weights(p, lds, gw, WT_I1, NGW, wave, lane);
    __syncthreads();
    for (int rep_ = 0; rep_ < REPS(1); ++rep_) if (PH(1)) phase_norm_gates(p, lds, tid, gw, NGW, lane);
    xcd_barrier(bar);

    if (PH(2)) phase_gate_scan(p, gw, NGW, lane);
    stagger(vcu, 3);
    for (int rep_ = 0; rep_ < REPS(3); ++rep_) if (PH(3)) { pg8::DenseSched S; S.init(ws + WS_H, ws + WS_WT1, T, NP, 1024, G, bx); pg8::EpiBf16 E{(bf16_t*)(ws + WS_P), NP};
      pg8::gemm_phase<pg8::EpiBf16, pg8::DenseSched, false>(lds, 1024, S, E); }
    xcd_barrier(bar);

    {
        constexpr int NSEQ = NBATCH * 4, NAT = NBATCH * 4 * 16, NMEM = LATE_CV ? WT_UNITS - LATE_UNITS : WT_UNITS;
        for (int u = bx; u < NSEQ; u += G) { for (int r2 = 0; r2 < REPS(16); ++r2) if (PH(4)) mlstm_seq_unit(p, lds, u, tid, wave, lane); }
        for (int rep_ = 0; rep_ < REPS(4); ++rep_) {
            bool a_done = false, m_done = false; int sa_cnt = 0, sm_cnt = 0; (void)sa_cnt; (void)sm_cnt;
            for (int it = 0; !(a_done && m_done); ++it) {
                const int r5 = it % 5; bool want_mem = (r5 == 1 || r5 == 3);
                if (want_mem && m_done) want_mem = false; else if (!want_mem && a_done) want_mem = true;
                __syncthreads();
#ifdef STATIC_Q
                if (tid == 0) { misc[MW_Q] = (unsigned)((want_mem ? sm_cnt : sa_cnt) * G + bx); }
                if (want_mem) ++sm_cnt; else ++sa_cnt;
#else
                if (tid == 0) misc[MW_Q] = __hip_atomic_fetch_add(ctl + CW_QUEUE + 64 * (2 * rep_ + (want_mem ? 1 : 0)), 1u, __ATOMIC_RELAXED, __HIP_MEMORY_SCOPE_AGENT);
#endif
                __syncthreads();
                const int u = (int)misc[MW_Q];
                if (want_mem) {
                    if (u >= NMEM) { m_done = true; continue; }
                    { const int v = LATE_CV ? (u < 8 ? u : u + 32) : u;        for (int r2 = 0; r2 < REPS(18); ++r2) if (PH(0)) { const int f = WT_I1 + 64 * v + 8 * wave; phase_prologue_weights(p, lds, f, f + 8, 1, wave, lane); } }
                } else {
                    if (u >= NAT) { a_done = true; continue; }
                    for (int r2 = 0; r2 < REPS(17); ++r2) if (PH(5)) attn_unit(p, lds, u & 127, 15 - (u >> 7), tid, wave, lane);
                }
            }
        }
    }
    xcd_barrier(bar);

    for (int rep_ = 0; rep_ < REPS(7); ++rep_) if (PH(7)) { pg8::DenseSched S; S.init(ws + WS_CAT, ws + WS_WT2, T, 1024, 1024, G, bx); pg8::EpiResid<true> E{p.in[0], (bf16_t*)(ws + WS_XB), ws + WS_XB8};
      pg8::gemm_phase<pg8::EpiResid<true>, pg8::DenseSched, false>(lds, 1024, S, E); }
    xcd_barrier(bar);

    moe_block<0>(p, lds, bar, ctl, tid, wave, lane, vcu, G);
    if (PH(8)) phase_rows<0, true>(p, lds, tid, wave, lane, G, p.in[2] + D, nullptr, nullptr, nullptr, nullptr, ctl + CW_CNT, nullptr);
    xcd_barrier(bar);
    stagger(vcu, 9);
    for (int rep_ = 0; rep_ < REPS(9); ++rep_) if (PH(9)) { pg8::DenseSched S; S.init(G3_F8 ? ws + WS_XB8 : ws + WS_XB, ws + WS_WT3, T, 3072, G3_F8 ? 512 : 1024, G, bx); pg8::EpiPair<0> E{(bf16_t*)(ws + WS_BG), (bf16_t*)(ws + WS_Z), D, (const float*)(ws + WS_RSTD), nullptr, nullptr, nullptr};
      pg8::gemm_phase<pg8::EpiPair<0>, pg8::DenseSched, false, G3_F8 != 0>(lds, G3_F8 ? 512 : 1024, S, E); }
    xcd_barrier(bar);
    for (int rep_ = 0; rep_ < REPS(10); ++rep_) if (PH(10)) phase_conv(p, gw, NGW, lane);
    xcd_barrier(bar);
    if (PH(11)) { pg8::DenseSched S; S.init(ws + WS_CAT, ws + WS_WT4, T, 1024, 1024, G, bx); pg8::EpiResid<false> E{nullptr, (bf16_t*)(ws + WS_XB), ws + WS_XB8};
      pg8::gemm_phase<pg8::EpiResid<false>, pg8::DenseSched, false>(lds, 1024, S, E); }
    xcd_barrier(bar);
    moe_block<1>(p, lds, bar, ctl, tid, wave, lane, vcu, G);
    if (PH(15)) phase_rows<2, true>(p, lds, tid, wave, lane, G, p.in[4], nullptr, nullptr, nullptr, nullptr, ctl + CW_CNT + 16 * 64, nullptr);
}

extern "C" void kernel_launch(void* const* d_in, const int* in_sizes, int n_in, void* d_out, int out_size, void* d_ws, size_t ws_size, hipStream_t stream) {
    static int grid = 0;
    if (grid == 0) {
        if (n_in != 25 || in_sizes[0] != T * D || out_size != T * D || ws_size < WS_END) { fprintf(stderr, "kernel_launch: unexpected shapes (n_in %d, in0 %d, out %d, ws %zu)\n", n_in, n_in > 0 ? in_sizes[0] : -1, out_size, ws_size); grid = -1; return; }
        int dev = 0, cus = 0, per_cu = 0;
        if (hipGetDevice(&dev) != hipSuccess || hipDeviceGetAttribute(&cus, hipDeviceAttributeMultiprocessorCount, dev) != hipSuccess) { grid = -1; return; }
        if (hipFuncSetAttribute((const void*)fwd_kernel, hipFuncAttributeMaxDynamicSharedMemorySize, LDS_BYTES) != hipSuccess) { fprintf(stderr, "kernel_launch: hipFuncSetAttribute failed\n"); grid = -1; return; }
        if (hipOccupancyMaxActiveBlocksPerMultiprocessor(&per_cu, (const void*)fwd_kernel, NTHR, LDS_BYTES) != hipSuccess || per_cu < 1) fprintf(stderr, "kernel_launch: occupancy query reports %d\n", per_cu);
        (void)hipGetLastError();
        grid = cus;
    }
    if (grid < 0) return;
    hipMemsetAsync((char*)d_ws + WS_CTL, 0, CTL_ZERO_BYTES, stream);
    Params p{};
    for (int i = 0; i < 25; ++i) p.in[i] = (const float*)d_in[i];
    p.out = (float*)d_out; p.ws = (unsigned char*)d_ws;
    hipLaunchKernelGGL(fwd_kernel, dim3(grid), dim3(NTHR), LDS_BYTES, stream, p);
}
```

```cpp
#include <hip/hip_runtime.h>
#include <cstdio>
#include <cstdint>
#ifndef PHASE_MASK
#define PHASE_MASK 0xffffffffu
#endif
#define PH(k) (((PHASE_MASK) >> (k)) & 1u)
#ifndef PHASE_TWICE
#define PHASE_TWICE 0u
#endif
#define REPS(k) (1 + (int)(((PHASE_TWICE) >> (k)) & 1u))

#define LAS __attribute__((address_space(3)))
#define GAS __attribute__((address_space(1)))
typedef unsigned short bf16_t;
typedef short bf16x8 __attribute__((ext_vector_type(8)));
typedef short s16x4 __attribute__((ext_vector_type(4)));
typedef float f32x4 __attribute__((ext_vector_type(4)));
typedef float f32x2 __attribute__((ext_vector_type(2)));
typedef float f32x16 __attribute__((ext_vector_type(16)));
typedef unsigned u32x4 __attribute__((ext_vector_type(4)));
typedef unsigned u32x2 __attribute__((ext_vector_type(2)));
typedef GAS unsigned gu32;
typedef int i32x8 __attribute__((ext_vector_type(8)));
typedef int i32x4 __attribute__((ext_vector_type(4)));

constexpr int D = 1024, NBATCH = 32, SEQ = 2048, T = NBATCH * SEQ;
constexpr int EVEN_IN = 3592, NP = 3584;
constexpr int P_MQ = 0, P_MK = 512, P_MV = 1024, P_MO = 1536, P_DQ = 2048, P_DK = 2560, P_DV = 3072;
constexpr int NE = 16, FF = 512;
constexpr int ECAP = 65536;
constexpr float NORM_EPS = 1e-6f;
constexpr int NWAVES = 8, NTHR = 512;
constexpr int MCH = 256, NCH = SEQ / MCH;
constexpr int WT_I1 = 16 * 112, WT_ITEMS = 28928, WT_UNITS = (WT_ITEMS - WT_I1) / 64;

constexpr size_t MiB = 1u << 20;
constexpr size_t WS_CTL = 0, CTL_ZERO_BYTES = 1 * MiB;
constexpr size_t WS_WT1 = 1 * MiB, WS_WT2 = 8 * MiB, WS_WT3 = 10 * MiB, WS_WT4 = 16 * MiB, WS_WGU = 18 * MiB, WS_WD = 82 * MiB;
constexpr size_t WS_GATES = 114 * MiB, WS_SA = 116 * MiB, WS_SAM = 117 * MiB, WS_SBA = 118 * MiB, WS_UN = 119 * MiB, WS_UR = 119 * MiB + 768 * 1024;
constexpr size_t WS_UT = 120 * MiB;
constexpr size_t WS_ROWTOK = 184 * MiB, WS_CWRAW = 188 * MiB, WS_TOKINFO = 192 * MiB, WS_RSTD = 193 * MiB;
constexpr size_t WS_H = 194 * MiB, WS_CAT = 322 * MiB, WS_P = 450 * MiB;
constexpr size_t WS_RSRAW = 120 * MiB;
constexpr size_t WS_XB8 = 720 * MiB;
constexpr size_t WS_XB = WS_H;
constexpr size_t WS_BG = WS_P, WS_Z = WS_P + 128 * MiB, WS_HM = WS_P, WS_YC = WS_P + 136 * MiB;
constexpr size_t WS_END = 898 * MiB;
constexpr int CW_BAR = 4096;
constexpr int CW_CNT = 16384;
constexpr int CW_QUEUE = 32768;

__device__ __forceinline__ unsigned cvt_pk_bf16(float lo, float hi) { unsigned r; asm volatile("v_cvt_pk_bf16_f32 %0, %1, %2" : "=v"(r) : "v"(lo), "v"(hi)); return r; }
__device__ __forceinline__ unsigned cvt_pk4_fp8(float a, float b, float c, float d) { unsigned w = 0; w = (unsigned)__builtin_amdgcn_cvt_pk_fp8_f32(a, b, (int)w, false); w = (unsigned)__builtin_amdgcn_cvt_pk_fp8_f32(c, d, (int)w, true); return w; }
#ifndef LATE_CV
#define LATE_CV 1
#endif
#ifndef G3_F8
#define G3_F8 1
#endif
constexpr float F8_WSCALE = 64.0f, F8_HSCALE = 16.0f, F8_YSCALE = 64.0f;
__device__ __forceinline__ float bf_lo(unsigned w) { return __uint_as_float(w << 16); }
__device__ __forceinline__ float bf_hi(unsigned w) { return __uint_as_float(w & 0xffff0000u); }
__device__ __forceinline__ float wave_sum(float v) {
#pragma unroll
    for (int o = 1; o < 64; o <<= 1) v += __shfl_xor(v, o);
    return v;
}
__device__ __forceinline__ float fast_exp2(float x) { return __builtin_amdgcn_exp2f(x); }
__device__ __forceinline__ float fast_rcp(float x) { return __builtin_amdgcn_rcpf(x); }
__device__ __forceinline__ int crow(int r, int hi) { return (r & 3) + 8 * (r >> 2) + 4 * hi; }
__device__ __forceinline__ unsigned off_b(unsigned row, unsigned ch) { return 256u * row + 16u * (ch ^ (((row & 3u) << 2) | ((row >> 2) & 3u))); }
__device__ __forceinline__ s16x4 vtr(const LAS unsigned char* p) { return __builtin_bit_cast(s16x4, __builtin_amdgcn_ds_read_tr16_b64_v4i16((LAS s16x4*)p)); }
__device__ __forceinline__ bf16x8 cat8(s16x4 a, s16x4 b) { return (bf16x8){a[0], a[1], a[2], a[3], b[0], b[1], b[2], b[3]}; }

#define XB_TMO      128
#define XB_XCNT(j)  (256  + 64 * (j))
#define XB_XSUB(j)  (1280 + 64 * (j))
#define XB_XGEN(j)  (2304 + 64 * (j))
#define XB_TOP      3328
#define XB_TOPGEN   3392
#define XCD_BAR_WORDS 3456
#define XB_SPIN_CAP (1u << 18)
__device__ __forceinline__ unsigned xb_ld(unsigned* p)              { return __hip_atomic_load(p, __ATOMIC_RELAXED, __HIP_MEMORY_SCOPE_AGENT); }
__device__ __forceinline__ unsigned xb_add(unsigned* p, unsigned v) { return __hip_atomic_fetch_add(p, v, __ATOMIC_RELAXED, __HIP_MEMORY_SCOPE_AGENT); }
__device__ __forceinline__ unsigned xb_xcc_id() { return (unsigned)__builtin_amdgcn_s_getreg((3 << 11) | 20) & 0xFu; }
#define XB_SPIN(cond, bar) do { unsigned _sp = 0; while (cond) { __builtin_amdgcn_s_sleep(1); \
    if ((++_sp & 255u) == 0u) { if (xb_ld(&(bar)[XB_TMO])) break; if (_sp > XB_SPIN_CAP) { atomicAdd(&(bar)[XB_TMO], 1u); break; } } } } while (0)
struct XcdBarrier { unsigned* bar; unsigned x; volatile LAS unsigned* st; };
__device__ __forceinline__ XcdBarrier xcd_barrier_post(unsigned* bar, volatile LAS unsigned* st) {
    XcdBarrier b; b.bar = bar; b.x = xb_xcc_id(); b.st = st;
    if (threadIdx.x == 0) (void)xb_add(&bar[XB_XCNT(b.x)], 1u);
    return b;
}
__device__ __forceinline__ void xcd_barrier_complete(unsigned* bar, unsigned x, unsigned& nloc, unsigned& nx) {
    const unsigned G = gridDim.x * gridDim.y * gridDim.z;
    unsigned sum, cnt, mine, sp = 0u;
    for (;;) {
        sum = 0u; cnt = 0u; mine = 0u;
#pragma unroll
        for (unsigned j = 0; j < 16; ++j) { const unsigned c = xb_ld(&bar[XB_XCNT(j)]); sum += c; cnt += (c > 0u) ? 1u : 0u; mine = (j == x) ? c : mine; }
        if (sum == G) break;
        __builtin_amdgcn_s_sleep(1);
        if ((++sp & 255u) == 0u) { if (xb_ld(&bar[XB_TMO])) break; if (sp > XB_SPIN_CAP) { atomicAdd(&bar[XB_TMO], 1u); break; } }
    }
    nloc = mine > 0u ? mine : 1u; nx = cnt > 0u ? cnt : 1u;
}
__device__ __forceinline__ void xcd_barrier(const XcdBarrier& b) {
    asm volatile("s_waitcnt vmcnt(0)" ::: "memory");
    __syncthreads();
    if (threadIdx.x == 0) {
        unsigned* bar = b.bar;
        __builtin_amdgcn_s_waitcnt(0);
        unsigned nloc = b.st[0], nx = b.st[1];
        if (nloc == 0u) { xcd_barrier_complete(bar, b.x, nloc, nx); b.st[0] = nloc; b.st[1] = nx; }
        const unsigned old = xb_add(&bar[XB_XSUB(b.x)], 1u);
        const unsigned gen = old / nloc;
        if (old + 1u == (gen + 1u) * nloc) {
            __builtin_amdgcn_fence(__ATOMIC_RELEASE, "agent");
            asm volatile("s_waitcnt vmcnt(0)" ::: "memory");
            const unsigned og = xb_add(&bar[XB_TOP], 1u);
            const unsigned tg = og / nx;
            if (og + 1u == (tg + 1u) * nx) xb_add(&bar[XB_TOPGEN], 1u);
            else XB_SPIN(xb_ld(&bar[XB_TOPGEN]) == tg, bar);
            __builtin_amdgcn_fence(__ATOMIC_ACQUIRE, "agent");
            xb_add(&bar[XB_XGEN(b.x)], 1u);
            asm volatile("s_waitcnt vmcnt(0)" ::: "memory");
        } else {
            XB_SPIN(xb_ld(&bar[XB_XGEN(b.x)]) == gen, bar);
            __builtin_amdgcn_fence(__ATOMIC_ACQUIRE, "agent");
            asm volatile("s_waitcnt vmcnt(0)" ::: "memory");
        }
    }
    __syncthreads();
}

namespace pg8 {
constexpr int BM = 256, BK = 64, HALF = 128, HTB = HALF * BK * 2, STAGE_BYTES = 8 * HTB, NXCD = 8, WGM = 8;
__device__ __forceinline__ int lds_byte(int r, int c) { const int st = (r >> 4) * 2 + (c >> 5), rr = r & 15, cc = c & 31, ob = rr * 64 + cc * 2; return st * 1024 + (ob ^ (((ob >> 9) & 1) << 5)); }
__device__ __forceinline__ void stage_rc(int b, int& R, int& C) { const int st = b / 1024, sb = b % 1024, swz = sb ^ (((sb >> 9) & 1) << 5); R = (st >> 1) * 16 + swz / 64; C = (st & 1) * 32 + (swz % 64) / 2; }
__device__ __forceinline__ int perm32(int rho) { const int n = rho >> 4, i = rho & 15; return 8 * (i >> 2) + 4 * n + (i & 3); }
struct Unit { int pm, pn; };

template <class Epi, class Sched, bool GATHER, bool F8 = false>
__device__ __forceinline__ void gemm_phase(LAS unsigned char* lds, const int K, const Sched& S, const Epi& E) {
    int tid = threadIdx.x; asm volatile("" : "+v"(tid));
    const int wid = __builtin_amdgcn_readfirstlane(tid >> 6), lane = tid & 63, wr = wid >> 2, wc = wid & 3, fr = lane & 15, fq = lane >> 4;
    const int nt = K / BK;
    int Rr[2], Cc[2]; unsigned voffB[2];
#pragma unroll
    for (int i = 0; i < 2; ++i) { stage_rc(tid * 16 + i * 8192, Rr[i], Cc[i]); const int Rb = Epi::PERM ? ((Rr[i] & ~31) + perm32(Rr[i] & 31)) : Rr[i];
        voffB[i] = (unsigned)(Rb * K + Cc[i]) * 2u; }
    const size_t kstep = (size_t)(BK * 2);
    const size_t hstep = (size_t)HALF * K * 2;
    const unsigned ldsw = (unsigned)wid * 1024u;
    const int aoff = lds_byte(wr * 64 + fr, fq * 8), boff = lds_byte(wc * 32 + fr, fq * 8);
#define PG8_SA(b, h) (((b) * 2 + (h)) * HTB)
#define PG8_SB(b, h) ((4 + (b) * 2 + (h)) * HTB)
#define PG8_STAGE(bufoff, gbase, voff) do { _Pragma("unroll") for (int _i = 0; _i < 2; ++_i) \
        __builtin_amdgcn_global_load_lds((const unsigned*)((const char*)(gbase) + (voff)[_i]), (LAS unsigned*)(lds + (bufoff) + ldsw + _i * 8192), 16, 0, 0); } while (0)
#define PG8_LD8(p) __builtin_shufflevector(*(const LAS i32x4*)(p), *(const LAS i32x4*)((p) + 1024), 0, 1, 2, 3, 4, 5, 6, 7)
#define PG8_LDA(dst, b, h) do { if constexpr (F8) { _Pragma("unroll") for (int m = 0; m < 4; ++m) dst##8[m] = PG8_LD8(lds + PG8_SA(b, h) + aoff + m * 2048); } \
        else { _Pragma("unroll") for (int m = 0; m < 4; ++m) _Pragma("unroll") for (int k = 0; k < 2; ++k) dst[m][k] = *(const LAS bf16x8*)(lds + PG8_SA(b, h) + aoff + m * 2048 + k * 1024); } } while (0)
#define PG8_LDB(dst, b, h) do { if constexpr (F8) { _Pragma("unroll") for (int n = 0; n < 2; ++n) dst##8[n] = PG8_LD8(lds + PG8_SB(b, h) + boff + n * 2048); } \
        else { _Pragma("unroll") for (int n = 0; n < 2; ++n) _Pragma("unroll") for (int k = 0; k < 2; ++k) dst[n][k] = *(const LAS bf16x8*)(lds + PG8_SB(b, h) + boff + n * 2048 + k * 1024); } } while (0)
#define PG8_CAT8(x0, x1) __builtin_shufflevector(__builtin_bit_cast(i32x4, x0), __builtin_bit_cast(i32x4, x1), 0, 1, 2, 3, 4, 5, 6, 7)
#define PG8_MMA(ai, bj, At, Bt) do { __builtin_amdgcn_s_setprio(1); _Pragma("unroll") for (int m = 0; m < 4; ++m) _Pragma("unroll") for (int n = 0; n < 2; ++n) { \
        if constexpr (F8) asm volatile("v_mfma_scale_f32_16x16x128_f8f6f4 %0, %1, %2, %0, %3, %3 op_sel_hi:[0,0,0]" : "+v"(acc[ai][bj][m][n]) : "v"(Bt##8[n]), "v"(At##8[m]), "v"(f8one)); \
        else { _Pragma("unroll") for (int k = 0; k < 2; ++k) acc[ai][bj][m][n] = __builtin_amdgcn_mfma_f32_16x16x32_bf16(Bt[n][k], At[m][k], acc[ai][bj][m][n], 0, 0, 0); } } __builtin_amdgcn_s_setprio(0); } while (0)
#define PG8_WAIT_V(n) asm volatile("s_waitcnt vmcnt(" #n ")" ::: "memory")
#define PG8_WAIT_L(n) asm volatile("s_waitcnt lgkmcnt(" #n ")" ::: "memory")
#define PG8_BAR __builtin_amdgcn_s_barrier()
#define PG8_SCHED __builtin_amdgcn_sched_barrier(0)
#define PG8_VOFF(dst, u) do { _Pragma("unroll") for (int _h = 0; _h < 2; ++_h) _Pragma("unroll") for (int _i = 0; _i < 2; ++_i) { \
        if constexpr (GATHER) dst[_h][_i] = S.arow(u, _h * HALF + Rr[_i]) * (unsigned)(K * 2) + (unsigned)(Cc[_i] * 2); \
        else dst[_h][_i] = (unsigned)((_h * HALF + Rr[_i]) * K + Cc[_i]) * 2u; } } while (0)
    Unit cur, nxt; int ui = 0;
    if (!S.next(0, cur)) return;
    f32x4 acc[2][2][4][2];
    if constexpr (Epi::PRELOAD) E.preload(acc, cur, wr, wc, fr, fq);
    else {
#pragma unroll
    for (int a = 0; a < 2; ++a)
#pragma unroll
        for (int b = 0; b < 2; ++b)
#pragma unroll
            for (int m = 0; m < 4; ++m)
#pragma unroll
                for (int n = 0; n < 2; ++n) acc[a][b][m][n] = (f32x4){0.f, 0.f, 0.f, 0.f};
    }
    float epf[2][4] = {{0.f, 0.f, 0.f, 0.f}, {0.f, 0.f, 0.f, 0.f}};
    bf16x8 At[4][2], B0[2][2], B1[2][2];
    i32x8 At8[4], B08[2], B18[2]; const unsigned f8one = 0x7f7f7f7fu;
    unsigned vA[2][2], vN[2][2];
    PG8_VOFF(vA, cur);
    if constexpr (Epi::PREFETCH) E.prefetch(epf, cur, wr, fr);
    const char* cA = S.abase(cur); const char* cB = S.bbase(cur);
    PG8_STAGE(PG8_SB(0, 0), cB, voffB); PG8_STAGE(PG8_SB(0, 1), cB + hstep, voffB); PG8_STAGE(PG8_SA(0, 0), cA, vA[0]); PG8_STAGE(PG8_SA(0, 1), cA, vA[1]);
    if (wr == 1) PG8_BAR;
    PG8_WAIT_V(2); PG8_BAR;
    PG8_STAGE(PG8_SB(1, 0), cB + kstep, voffB); PG8_STAGE(PG8_SA(1, 0), cA + kstep, vA[0]); PG8_STAGE(PG8_SB(1, 1), cB + hstep + kstep, voffB);
    PG8_WAIT_V(6); PG8_BAR;
    for (;;) {
        const bool has_next = S.next(ui + 1, nxt);
        const char* nA = has_next ? S.abase(nxt) : cA; const char* nB = has_next ? S.bbase(nxt) : cB;
        if constexpr (GATHER) { if (has_next) { PG8_VOFF(vN, nxt); } else {
#pragma unroll
            for (int h = 0; h < 2; ++h)
#pragma unroll
                for (int i = 0; i < 2; ++i) vN[h][i] = vA[h][i]; } }
#pragma unroll 1
        for (int t = 0; t < nt; t += 2) {
            const bool last = (t == nt - 2);
            const char* a1 = cA + (size_t)(t + 1) * kstep;
            const char* a2 = last ? nA : cA + (size_t)(t + 2) * kstep; const char* b2 = last ? nB : cB + (size_t)(t + 2) * kstep;
            const char* a3 = a2 + kstep; const char* b3 = b2 + kstep;
            unsigned v2[2][2]; const unsigned lmask = last ? 0xffffffffu : 0u;
#pragma unroll
            for (int h = 0; h < 2; ++h)
#pragma unroll
                for (int i = 0; i < 2; ++i) { if constexpr (GATHER) v2[h][i] = (vN[h][i] & lmask) | (vA[h][i] & ~lmask); else v2[h][i] = vA[h][i]; }
            PG8_LDB(B0, 0, 0); PG8_LDB(B1, 0, 1); PG8_SCHED; PG8_LDA(At, 0, 0); PG8_STAGE(PG8_SA(1, 1), a1, vA[1]);
            PG8_WAIT_V(8); PG8_WAIT_L(0); PG8_BAR; PG8_MMA(0, 0, At, B0); PG8_MMA(0, 1, At, B1); PG8_BAR; PG8_SCHED;
            PG8_LDA(At, 0, 1); PG8_STAGE(PG8_SB(0, 0), b2, voffB); PG8_STAGE(PG8_SB(0, 1), b2 + hstep, voffB); PG8_STAGE(PG8_SA(0, 0), a2, v2[0]);
            PG8_WAIT_V(8); PG8_WAIT_L(0); PG8_BAR; PG8_MMA(1, 0, At, B0); PG8_MMA(1, 1, At, B1); PG8_BAR; PG8_SCHED;
            PG8_LDB(B0, 1, 0); PG8_LDB(B1, 1, 1); PG8_SCHED; PG8_LDA(At, 1, 0); PG8_STAGE(PG8_SA(0, 1), a2, v2[1]);
            PG8_WAIT_V(8); PG8_WAIT_L(0); PG8_BAR; PG8_MMA(0, 0, At, B0); PG8_MMA(0, 1, At, B1); PG8_BAR; PG8_SCHED;
            PG8_LDA(At, 1, 1); PG8_STAGE(PG8_SB(1, 0), b3, voffB); PG8_STAGE(PG8_SB(1, 1), b3 + hstep, voffB); PG8_STAGE(PG8_SA(1, 0), a3, v2[0]);
            PG8_WAIT_V(8); PG8_WAIT_L(0); PG8_BAR; PG8_MMA(1, 0, At, B0); PG8_MMA(1, 1, At, B1); PG8_BAR; PG8_SCHED;
        }
        if (wr == 0) PG8_BAR;
        if constexpr (F8) asm volatile("s_nop 15\n\ts_nop 15" ::: "memory");
        if constexpr (Epi::PREFETCH) E(acc, cur, wr, wc, fr, fq, epf); else E(acc, cur, wr, wc, fr, fq);
        if (!has_next) break;
        if constexpr (Epi::PREFETCH) E.prefetch(epf, nxt, wr, fr);
        if constexpr (Epi::PRELOAD) E.preload(acc, nxt, wr, wc, fr, fq);
        else {
#pragma unroll
        for (int a = 0; a < 2; ++a)
#pragma unroll
            for (int b = 0; b < 2; ++b)
#pragma unroll
                for (int m = 0; m < 4; ++m)
#pragma unroll
                    for (int n = 0; n < 2; ++n) acc[a][b][m][n] = (f32x4){0.f, 0.f, 0.f, 0.f};
        }
        cur = nxt; cA = nA; cB = nB; ++ui;
        if constexpr (GATHER) {
#pragma unroll
        for (int h = 0; h < 2; ++h)
#pragma unroll
            for (int i = 0; i < 2; ++i) vA[h][i] = vN[h][i]; }
        if (wr == 1) PG8_BAR;
    }
    PG8_WAIT_V(0);
    PG8_BAR;
#undef PG8_SA
#undef PG8_SB
#undef PG8_STAGE
#undef PG8_LDA
#undef PG8_LD8
#undef PG8_LDB
#undef PG8_MMA
#undef PG8_CAT8
#undef PG8_WAIT_V
#undef PG8_WAIT_L
#undef PG8_BAR
#undef PG8_SCHED
#undef PG8_VOFF
}

struct DenseSched {
    const char* A; const char* Bt; int K; int nM, nN, nwg, G, c;
    __device__ __forceinline__ void init(const void* A_, const void* Bt_, int M, int N, int K_, int G_, int c_) { A = (const char*)A_; Bt = (const char*)Bt_; K = K_; nM = M / BM; nN = N / BM; nwg = nM * nN; G = G_; c = c_; }
    __device__ __forceinline__ bool next(int i, Unit& u) const {
        const long L = (long)i * G + c; if (L >= nwg) return false;
        int wgid = (int)L; { const int q = nwg / NXCD, r = nwg % NXCD, xcd = wgid % NXCD, off = wgid / NXCD; wgid = (xcd < r ? xcd * (q + 1) : r * (q + 1) + (xcd - r) * q) + off; }
        const int nig = WGM * nN, gid = wgid / nig, fm = gid * WGM, gsz = (nM - fm) < WGM ? (nM - fm) : WGM;
        u.pm = fm + ((wgid % nig) % gsz); u.pn = (wgid % nig) / gsz; return true;
    }
    __device__ __forceinline__ const char* abase(const Unit& u) const { return A + (size_t)u.pm * BM * K * 2; }
    __device__ __forceinline__ const char* bbase(const Unit& u) const { return Bt + (size_t)u.pn * BM * K * 2; }
    __device__ __forceinline__ unsigned arow(const Unit&, int) const { return 0u; }
};
template <bool GATHER_A>
struct MoeSched {
    const char* A; const char* W; int K; size_t wstride; const LAS int* tb; const LAS int* cn; const unsigned* rowtok; int ntot, vcu, G;
    __device__ __forceinline__ bool next(int i, Unit& u) const { const int L = i * G + vcu; if (L >= ntot * 4) return false; u.pm = L >> 2; u.pn = L & 3; return true; }
    __device__ __forceinline__ int expert(int pm) const { int e = 0;
#pragma unroll
        for (int j = 1; j < 16; ++j) e += (pm >= tb[j]) ? 1 : 0; return e; }
    __device__ __forceinline__ const char* abase(const Unit& u) const { return GATHER_A ? A : A + (size_t)u.pm * BM * K * 2; }
    __device__ __forceinline__ const char* bbase(const Unit& u) const { return W + (size_t)expert(u.pm) * wstride + (size_t)u.pn * BM * K * 2; }
    __device__ __forceinline__ unsigned arow(const Unit& u, int r) const { const int e = expert(u.pm); const int idx = (u.pm - tb[e]) * BM + r; return idx < cn[e] ? rowtok[(size_t)e * ECAP + idx] : 0u; }
};

struct EpiBf16 {
    static constexpr bool PERM = true, PRELOAD = false, PREFETCH = false;
    bf16_t* O; int ldc;
    __device__ __forceinline__ void operator()(const f32x4 (&acc)[2][2][4][2], const Unit& u, int wr, int wc, int fr, int fq) const {
        const int row0 = u.pm * BM + wr * 64 + fr, col0 = u.pn * BM + wc * 32 + 8 * fq;
#pragma unroll
        for (int ai = 0; ai < 2; ++ai)
#pragma unroll
            for (int m = 0; m < 4; ++m) { bf16_t* rowp = O + (size_t)(row0 + ai * HALF + m * 16) * ldc + col0;
#pragma unroll
                for (int bj = 0; bj < 2; ++bj) { const f32x4 v0 = acc[ai][bj][m][0], v1 = acc[ai][bj][m][1];
                    u32x4 w; w.x = cvt_pk_bf16(v0[0], v0[1]); w.y = cvt_pk_bf16(v0[2], v0[3]); w.z = cvt_pk_bf16(v1[0], v1[1]); w.w = cvt_pk_bf16(v1[2], v1[3]);
#ifdef EPI_NT
                    __builtin_nontemporal_store(w, (u32x4*)(rowp + bj * HALF));
#else
                    *(u32x4*)(rowp + bj * HALF) = w;
#endif
                } }
    }
};
template <bool XF32>
struct EpiResid {
    static constexpr bool PERM = true, PRELOAD = true, PREFETCH = false;
    const float* xin; bf16_t* XB; unsigned char* XB8;
    __device__ __forceinline__ void preload(f32x4 (&acc)[2][2][4][2], const Unit& u, int wr, int wc, int fr, int fq) const {
        const int row0 = u.pm * BM + wr * 64 + fr, col0 = u.pn * BM + wc * 32 + 8 * fq;
#pragma unroll
        for (int ai = 0; ai < 2; ++ai)
#pragma unroll
            for (int m = 0; m < 4; ++m) { const size_t off = (size_t)(row0 + ai * HALF + m * 16) * D + col0;
#pragma unroll
                for (int bj = 0; bj < 2; ++bj) {
                    if (XF32) { acc[ai][bj][m][0] = *(const f32x4*)(xin + off + bj * HALF); acc[ai][bj][m][1] = *(const f32x4*)(xin + off + bj * HALF + 4); }
                    else { const u32x4 w = *(const u32x4*)(XB + off + bj * HALF); acc[ai][bj][m][0] = (f32x4){bf_lo(w.x), bf_hi(w.x), bf_lo(w.y), bf_hi(w.y)}; acc[ai][bj][m][1] = (f32x4){bf_lo(w.z), bf_hi(w.z), bf_lo(w.w), bf_hi(w.w)}; } } }
    }
    __device__ __forceinline__ void operator()(const f32x4 (&acc)[2][2][4][2], const Unit& u, int wr, int wc, int fr, int fq) const {
        const int row0 = u.pm * BM + wr * 64 + fr, col0 = u.pn * BM + wc * 32 + 8 * fq;
#pragma unroll
        for (int ai = 0; ai < 2; ++ai)
#pragma unroll
            for (int m = 0; m < 4; ++m) { bf16_t* rowp = XB + (size_t)(row0 + ai * HALF + m * 16) * D + col0;
#pragma unroll
                for (int bj = 0; bj < 2; ++bj) { const f32x4 v0 = acc[ai][bj][m][0], v1 = acc[ai][bj][m][1];
                    u32x4 w; w.x = cvt_pk_bf16(v0[0], v0[1]); w.y = cvt_pk_bf16(v0[2], v0[3]); w.z = cvt_pk_bf16(v1[0], v1[1]); w.w = cvt_pk_bf16(v1[2], v1[3]);
                    *(u32x4*)(rowp + bj * HALF) = w;
                    u32x2 w8; w8.x = cvt_pk4_fp8(bf_lo(w.x), bf_hi(w.x), bf_lo(w.y), bf_hi(w.y)); w8.y = cvt_pk4_fp8(bf_lo(w.z), bf_hi(w.z), bf_lo(w.w), bf_hi(w.w));
                    *(u32x2*)(XB8 + (size_t)(row0 + ai * HALF + m * 16) * D + col0 + bj * HALF) = w8; } }
    }
};
template <int MODE  >
struct EpiPair {
    static constexpr bool PERM = true, PRELOAD = false, PREFETCH = true;
    bf16_t* O0; bf16_t* O1; int ld1;
    const float* rstd; const unsigned* rowtok; const LAS int* tb; const LAS int* cn;
    __device__ __forceinline__ void prefetch(float (&rs)[2][4], const Unit& u, int wr, int fr) const {
        const int row0 = u.pm * BM + wr * 64 + fr;
        if (MODE == 0) {
#pragma unroll
            for (int ai = 0; ai < 2; ++ai)
#pragma unroll
                for (int m = 0; m < 4; ++m) rs[ai][m] = rstd[row0 + ai * HALF + m * 16] * (G3_F8 ? 1.0f / F8_WSCALE : 1.0f);
        } else {
            int e = 0;
#pragma unroll
            for (int j = 1; j < 16; ++j) e += (u.pm >= tb[j]) ? 1 : 0;
            const int idx0 = (u.pm - tb[e]) * BM + wr * 64 + fr, cne = cn[e];
#pragma unroll
            for (int ai = 0; ai < 2; ++ai)
#pragma unroll
                for (int m = 0; m < 4; ++m) { const int idx = idx0 + ai * HALF + m * 16; rs[ai][m] = idx < cne ? rstd[(size_t)e * ECAP + idx] * (1.0f / F8_WSCALE) : 0.f; }
        }
    }
    __device__ __forceinline__ void operator()(const f32x4 (&acc)[2][2][4][2], const Unit& u, int wr, int wc, int fr, int fq, const float (&rs)[2][4]) const {
        const int row0 = u.pm * BM + wr * 64 + fr;
        if (MODE == 0 && u.pn < 4) {
            const int col0 = u.pn * BM + wc * 32 + 8 * fq;
#pragma unroll
            for (int ai = 0; ai < 2; ++ai)
#pragma unroll
                for (int m = 0; m < 4; ++m) { bf16_t* rowp = O0 + (size_t)(row0 + ai * HALF + m * 16) * D + col0;
#pragma unroll
                    for (int bj = 0; bj < 2; ++bj) { const f32x4 v0 = acc[ai][bj][m][0] * rs[ai][m], v1 = acc[ai][bj][m][1] * rs[ai][m];
                        u32x4 w; w.x = cvt_pk_bf16(v0[0], v0[1]); w.y = cvt_pk_bf16(v0[2], v0[3]); w.z = cvt_pk_bf16(v1[0], v1[1]); w.w = cvt_pk_bf16(v1[2], v1[3]);
                        *(u32x4*)(rowp + bj * HALF) = w; } }
        } else {
            const int pt = (MODE == 0) ? (u.pn - 4) : u.pn;
            const int col0 = pt * HALF + wc * 32 + 8 * fq;
#pragma unroll
            for (int ai = 0; ai < 2; ++ai)
#pragma unroll
                for (int m = 0; m < 4; ++m) { bf16_t* rowp = O1 + (size_t)(row0 + ai * HALF + m * 16) * ld1 + col0;
                    f32x4 r[2];
#pragma unroll
                    for (int n = 0; n < 2; ++n) { const f32x4 g = acc[ai][0][m][n] * rs[ai][m], up = acc[ai][1][m][n] * rs[ai][m];
                        if (MODE == 0) r[n] = g * up;
                        else {
#pragma unroll
                            for (int j = 0; j < 4; ++j) r[n][j] = __builtin_amdgcn_fmed3f(g[j] * fast_rcp(1.0f + fast_exp2(-1.4426950408889634f * g[j])) * up[j] * F8_HSCALE, -448.0f, 448.0f); } }
                    if (MODE == 1) { u32x2 w; w.x = cvt_pk4_fp8(r[0][0], r[0][1], r[0][2], r[0][3]); w.y = cvt_pk4_fp8(r[1][0], r[1][1], r[1][2], r[1][3]);
                        *(u32x2*)((unsigned char*)O1 + (size_t)(row0 + ai * HALF + m * 16) * ld1 + col0) = w; }
                    else { u32x4 w; w.x = cvt_pk_bf16(r[0][0], r[0][1]); w.y = cvt_pk_bf16(r[0][2], r[0][3]); w.z = cvt_pk_bf16(r[1][0], r[1][1]); w.w = cvt_pk_bf16(r[1][2], r[1][3]);
                        *(u32x4*)rowp = w; } }
        }
    }
};
struct EpiDown {
    static constexpr bool PERM = true, PRELOAD = false, PREFETCH = true;
    unsigned char* O; const float* cwraw; const LAS int* tb; const LAS int* cn;
    __device__ __forceinline__ void prefetch(float (&cws)[2][4], const Unit& u, int wr, int fr) const {
        int e = 0;
#pragma unroll
        for (int j = 1; j < 16; ++j) e += (u.pm >= tb[j]) ? 1 : 0;
        const int idx0 = (u.pm - tb[e]) * BM + wr * 64 + fr, cne = cn[e];
#pragma unroll
        for (int ai = 0; ai < 2; ++ai)
#pragma unroll
            for (int m = 0; m < 4; ++m) { const int idx = idx0 + ai * HALF + m * 16; cws[ai][m] = idx < cne ? cwraw[(size_t)e * ECAP + idx] * (F8_YSCALE / (F8_WSCALE * F8_HSCALE)) : 0.f; }
    }
    __device__ __forceinline__ void operator()(const f32x4 (&acc)[2][2][4][2], const Unit& u, int wr, int wc, int fr, int fq, const float (&cws)[2][4]) const {
        const int row0 = u.pm * BM + wr * 64 + fr, col0 = u.pn * BM + wc * 32 + 8 * fq;
#pragma unroll
        for (int ai = 0; ai < 2; ++ai)
#pragma unroll
            for (int m = 0; m < 4; ++m) { const float cw = cws[ai][m];
                unsigned char* rowp = O + (size_t)(row0 + ai * HALF + m * 16) * D + col0;
#pragma unroll
                for (int bj = 0; bj < 2; ++bj) { f32x4 v0 = acc[ai][bj][m][0] * cw, v1 = acc[ai][bj][m][1] * cw;
#pragma unroll
                    for (int j = 0; j < 4; ++j) { v0[j] = __builtin_amdgcn_fmed3f(v0[j], -448.0f, 448.0f); v1[j] = __builtin_amdgcn_fmed3f(v1[j], -448.0f, 448.0f); }
                    u32x2 w; w.x = cvt_pk4_fp8(v0[0], v0[1], v0[2], v0[3]); w.y = cvt_pk4_fp8(v1[0], v1[1], v1[2], v1[3]);
                    *(u32x2*)(rowp + bj * HALF) = w; } }
    }
};
}

constexpr int RING_BYTES = 131072;
constexpr int MISC_OFF = RING_BYTES;
constexpr int LDS_BYTES = 163840;
constexpr int MW_BAR = 0;
constexpr int MW_TB = 16;
constexpr int MW_CN = 40;
constexpr int MW_Q = 60;
constexpr int MW_F = 64;

struct Params {
    const float* in[25]; float* out; unsigned char* ws;
};

constexpr float ATT_QSCALE = 0.125f * 1.4426950408889634f;
__device__ __forceinline__ void transpose_item(const float* W, int ld, int K, int k0, int srccol, bf16_t* WT, int dstrow, LAS float* scr, int lane, const float* gk = nullptr, float wsc = 1.0f) {
    float tv[32];
#pragma unroll
    for (int i = 0; i < 32; ++i) { const int kk = 2 * i + (lane >> 5); tv[i] = W[(size_t)(k0 + kk) * ld + srccol + (lane & 31)]; }
#pragma unroll
    for (int i = 0; i < 32; ++i) { const int kk = 2 * i + (lane >> 5); scr[kk * 33 + (lane & 31)] = (gk ? tv[i] * gk[k0 + kk] : tv[i]) * wsc; }
    asm volatile("s_waitcnt lgkmcnt(0)" ::: "memory");
    const int c = lane & 7;
#pragma unroll
    for (int j = 0; j < 4; ++j) { const int n = (lane >> 3) + 8 * j; const LAS float* s = scr + (8 * c) * 33 + n;
        u32x4 o; o.x = cvt_pk_bf16(s[0 * 33], s[1 * 33]); o.y = cvt_pk_bf16(s[2 * 33], s[3 * 33]); o.z = cvt_pk_bf16(s[4 * 33], s[5 * 33]); o.w = cvt_pk_bf16(s[6 * 33], s[7 * 33]);
        *(u32x4*)(WT + (size_t)(dstrow + n) * K + k0 + 8 * c) = o; }
    asm volatile("s_waitcnt lgkmcnt(0)" ::: "memory");
}
__device__ __forceinline__ void transpose_item_f8(const float* W, int ld, int K, int k0, int srccol, unsigned char* WT8, int dstrow, LAS float* scr, int lane, const float* gk, float scale) {
    float tv[32];
#pragma unroll
    for (int i = 0; i < 32; ++i) { const int kk = 2 * i + (lane >> 5); tv[i] = W[(size_t)(k0 + kk) * ld + srccol + (lane & 31)]; }
#pragma unroll
    for (int i = 0; i < 32; ++i) { const int kk = 2 * i + (lane >> 5); scr[kk * 33 + (lane & 31)] = (gk ? tv[i] * gk[k0 + kk] : tv[i]) * scale; }
    asm volatile("s_waitcnt lgkmcnt(0)" ::: "memory");
    const int c = lane & 3;
#pragma unroll
    for (int j = 0; j < 2; ++j) { const int n = (lane >> 2) + 16 * j; const LAS float* q = scr + (16 * c) * 33 + n;
        u32x4 o; o.x = cvt_pk4_fp8(q[0 * 33], q[1 * 33], q[2 * 33], q[3 * 33]); o.y = cvt_pk4_fp8(q[4 * 33], q[5 * 33], q[6 * 33], q[7 * 33]);
        o.z = cvt_pk4_fp8(q[8 * 33], q[9 * 33], q[10 * 33], q[11 * 33]); o.w = cvt_pk4_fp8(q[12 * 33], q[13 * 33], q[14 * 33], q[15 * 33]);
        *(u32x4*)(WT8 + (size_t)(dstrow + n) * K + k0 + 16 * c) = o; }
    asm volatile("s_waitcnt lgkmcnt(0)" ::: "memory");
}
__device__ __forceinline__ int pair_row(int ch, int up) { return (ch >> 7) * 256 + up * 128 + (ch & 127); }

__device__ __forceinline__ void phase_prologue_weights(const Params& p, LAS unsigned char* lds, int first, int last, int step, int wave, int lane_) {
    int lane = lane_; asm volatile("" : "+v"(lane));
    LAS float* scr = (LAS float*)(lds + wave * 16384);
    unsigned char* ws = p.ws;
    constexpr int I1 = 16 * 112, I2 = 16 * 32, I3 = 16 * 96, I4 = 16 * 32, IE = 768;
    constexpr int NITEMS = I1 + I2 + I3 + I4 + 32 * IE;
    static_assert(NITEMS == 28928, "item count");
    for (int it = first; it < last; it += step) {
        int r = it;
        if (r < I1) { const int kb = r / 112, nb = r % 112; const int sc = nb < 64 ? 32 * nb : 2056 + 32 * (nb - 64), dr = nb < 64 ? 32 * nb : 2048 + 32 * (nb - 64);
            transpose_item(p.in[5], EVEN_IN, 1024, 64 * kb, sc, (bf16_t*)(ws + WS_WT1), dr, scr, lane, nullptr, (dr >= P_DQ && dr < P_DK) ? ATT_QSCALE : 1.0f); continue; } r -= I1;
        if (r < I2) { const int kb = r / 32, nb = r % 32; transpose_item(p.in[6], 1024, 1024, 64 * kb, 32 * nb, (bf16_t*)(ws + WS_WT2), 32 * nb, scr, lane); continue; } r -= I2;
        if (r < I3) { const int kb = r / 96, nb = r % 96; int dr;
            if (nb < 32) dr = 32 * nb; else if (nb < 64) dr = 1024 + pair_row(32 * (nb - 32), 0); else dr = 1024 + pair_row(32 * (nb - 64), 1);
            if (G3_F8) transpose_item_f8(p.in[15], 3072, 1024, 64 * kb, 32 * nb, ws + WS_WT3, dr, scr, lane, p.in[2] + D, F8_WSCALE);
            else transpose_item(p.in[15], 3072, 1024, 64 * kb, 32 * nb, (bf16_t*)(ws + WS_WT3), dr, scr, lane, p.in[2] + D);
            continue; } r -= I3;
        if (r < I4) { const int kb = r / 32, nb = r % 32; transpose_item(p.in[17], 1024, 1024, 64 * kb, 32 * nb, (bf16_t*)(ws + WS_WT4), 32 * nb, scr, lane); continue; } r -= I4;
        const int le = r / IE; r %= IE;
        unsigned char* wgu = ws + WS_WGU + (size_t)le * 1024 * 1024; unsigned char* wd = ws + WS_WD + (size_t)le * 1024 * 512;
        if (r < 256) { const int kb = r / 16, nb = r % 16; transpose_item_f8(p.in[22] + (size_t)le * 1024 * 512, 512, 1024, 64 * kb, 32 * nb, wgu, pair_row(32 * nb, 0), scr, lane, p.in[3] + (le >> 4) * D, F8_WSCALE); continue; } r -= 256;
        if (r < 256) { const int kb = r / 16, nb = r % 16; transpose_item_f8(p.in[23] + (size_t)le * 1024 * 512, 512, 1024, 64 * kb, 32 * nb, wgu, pair_row(32 * nb, 1), scr, lane, p.in[3] + (le >> 4) * D, F8_WSCALE); continue; } r -= 256;
        { const int kb = r / 32, nb = r % 32; transpose_item_f8(p.in[24] + (size_t)le * 512 * 1024, 1024, 512, 64 * kb, 32 * nb, wd, 32 * nb, scr, lane, nullptr, F8_WSCALE); }
    }
}

struct RowV { f32x4 v[4]; };
__device__ __forceinline__ RowV row_load(const float* xr, int lane) { RowV r; const f32x4* p = (const f32x4*)xr + lane;
#pragma unroll
    for (int j = 0; j < 4; ++j) r.v[j] = p[64 * j]; return r; }
__device__ __forceinline__ void row_store(float* xr, int lane, const RowV& r) { f32x4* p = (f32x4*)xr + lane;
#pragma unroll
    for (int j = 0; j < 4; ++j) p[64 * j] = r.v[j]; }
__device__ __forceinline__ RowV row_load_bf16(const bf16_t* yr, int lane) { RowV r; const u32x2* p = (const u32x2*)yr + lane;
#pragma unroll
    for (int j = 0; j < 4; ++j) { const u32x2 w = p[64 * j]; r.v[j] = (f32x4){bf_lo(w.x), bf_hi(w.x), bf_lo(w.y), bf_hi(w.y)}; } return r; }
__device__ __forceinline__ RowV row_load_fp8(const unsigned char* yr, int lane, float sc) { RowV r; const unsigned* p = (const unsigned*)yr + lane;
#pragma unroll
    for (int j = 0; j < 4; ++j) { const unsigned w = p[64 * j]; const f32x2 lo = __builtin_amdgcn_cvt_pk_f32_fp8((int)w, false), hi = __builtin_amdgcn_cvt_pk_f32_fp8((int)w, true); r.v[j] = (f32x4){lo.x * sc, lo.y * sc, hi.x * sc, hi.y * sc}; } return r; }
__device__ __forceinline__ float row_rstd(const RowV& r) { float s = 0.f;
#pragma unroll
    for (int j = 0; j < 4; ++j) s += (r.v[j][0] * r.v[j][0] + r.v[j][1] * r.v[j][1]) + (r.v[j][2] * r.v[j][2] + r.v[j][3] * r.v[j][3]);
    return 1.0f / sqrtf(wave_sum(s) * (1.0f / D) + NORM_EPS); }
__device__ __forceinline__ void row_store_bf16(bf16_t* hr, int lane, const RowV& r) { u32x2* p = (u32x2*)hr + lane;
#pragma unroll
    for (int j = 0; j < 4; ++j) { u32x2 w; w.x = cvt_pk_bf16(r.v[j][0], r.v[j][1]); w.y = cvt_pk_bf16(r.v[j][2], r.v[j][3]); p[64 * j] = w; } }

__device__ __forceinline__ void phase_norm_gates(const Params& p, LAS unsigned char* lds, int tid, int gw, int NGW, int lane) {
    const float* x = p.in[0]; const float* g = p.in[2]; const float* win = p.in[5];
    bf16_t* H = (bf16_t*)(p.ws + WS_H); float* gates = (float*)(p.ws + WS_GATES);
    LAS float* wt = (LAS float*)lds;
    for (int i = tid; i < 8 * 1024; i += NTHR) { const int k = i >> 3, o = i & 7; wt[o * 1024 + k] = win[(size_t)k * EVEN_IN + 2048 + o] * g[k]; }
    __syncthreads();
    RowV gv = row_load(g, lane);
    for (int m0 = gw; m0 < T; m0 += 2 * NGW) {
      RowV rr[2];
#pragma unroll
      for (int u = 0; u < 2; ++u) { const int mm = m0 + u * NGW; rr[u] = row_load(x + (size_t)(mm < T ? mm : m0) * D, lane); }
#pragma unroll
      for (int u = 0; u < 2; ++u) {
        const int m = m0 + u * NGW; if (m >= T) break; RowV r = rr[u];
        const float rstd = row_rstd(r);
        float dots[8];
#pragma unroll
        for (int o = 0; o < 8; ++o) { float s = 0.f;
#pragma unroll
            for (int j = 0; j < 4; ++j) { const f32x4 w = *(const LAS f32x4*)(wt + o * 1024 + 4 * lane + 256 * j); s += (r.v[j][0] * w[0] + r.v[j][1] * w[1]) + (r.v[j][2] * w[2] + r.v[j][3] * w[3]); }
            dots[o] = s; }
        float gsum;
        { const bool b5 = (lane & 32) != 0, b4 = (lane & 16) != 0, b3 = (lane & 8) != 0;
          float k4[4];
#pragma unroll
          for (int i = 0; i < 4; ++i) { const float keep = b5 ? dots[4 + i] : dots[i], send = b5 ? dots[i] : dots[4 + i]; k4[i] = keep + __shfl_xor(send, 32); }
          float k2[2];
#pragma unroll
          for (int i = 0; i < 2; ++i) { const float keep = b4 ? k4[2 + i] : k4[i], send = b4 ? k4[i] : k4[2 + i]; k2[i] = keep + __shfl_xor(send, 16); }
          { const float keep = b3 ? k2[1] : k2[0], send = b3 ? k2[0] : k2[1]; gsum = keep + __shfl_xor(send, 8); }
          gsum += __shfl_xor(gsum, 4); gsum += __shfl_xor(gsum, 2); gsum += __shfl_xor(gsum, 1); }
#pragma unroll
        for (int j = 0; j < 4; ++j) r.v[j] = r.v[j] * rstd * gv.v[j];
        row_store_bf16(H + (size_t)m * D, lane, r);
        if ((lane & 7) == 0) gates[(size_t)m * 8 + ((lane >> 3) & 7)] = gsum * rstd;
      }
    }
    __syncthreads();
}

template <int MODE, bool COMBINE>
__device__ __forceinline__ void phase_rows(const Params& p, LAS unsigned char* lds, int tid_, int wave, int lane_, int G,
                                           const float* gvec, const float* wgr, const float* bgr, const float* wer, const float* ber, unsigned* cnt_prev, unsigned* cnt_cur) {
    int tid = tid_; asm volatile("" : "+v"(tid)); const int lane = tid & 63;
    float* OUT = p.out; bf16_t* XB = (bf16_t*)(p.ws + WS_XB); float* RSTD = (float*)(p.ws + WS_RSTD);
    const unsigned char* YC = (const unsigned char*)(p.ws + WS_YC); float* rsraw = (float*)(p.ws + WS_RSRAW);
    unsigned* tokinfo = (unsigned*)(p.ws + WS_TOKINFO);
    unsigned* rowtok = (unsigned*)(p.ws + WS_ROWTOK); float* cwraw = (float*)(p.ws + WS_CWRAW);
    LAS float* wt = (LAS float*)lds;
    LAS int* misc = (LAS int*)(lds + MISC_OFF);
    LAS int* tbp = misc + MW_TB;
    LAS int* te = misc + 1024;
    LAS float* tc = (LAS float*)(misc + 1536);
    LAS int* trank = misc + 2048;
    LAS int* ebase = misc + 2560;
    LAS float* trs = (LAS float*)(misc + 2600);
    if (COMBINE) { if (tid == 0) { int acc = 0; for (int e = 0; e < 16; ++e) { tbp[e] = acc; acc += ((int)__hip_atomic_load(cnt_prev + e * 64, __ATOMIC_RELAXED, __HIP_MEMORY_SCOPE_AGENT) + 255) >> 8; } tbp[16] = acc; } }
    if (MODE == 1) { for (int i = tid; i < 20 * 1024; i += NTHR) { const int o = i >> 10, k = i & 1023; wt[i] = (o < 4 ? wgr[(size_t)k * 4 + o] : wer[(size_t)k * 16 + (o - 4)]) * gvec[k]; } }
    __syncthreads();
    RowV gv; if (MODE == 2) gv = row_load(gvec, lane);
    for (int blk = blockIdx.x; blk < T / 256; blk += G) {
        for (int i2 = 0; i2 < 32; i2 += 2) {
          RowV rr[2];
#pragma unroll
          for (int u = 0; u < 2; ++u) {
            const int m = blk * 256 + wave * 32 + i2 + u;
            rr[u] = row_load_bf16(XB + (size_t)m * D, lane);
            if (COMBINE) {
                const unsigned i0 = tokinfo[(size_t)m * 2], i1 = tokinfo[(size_t)m * 2 + 1];
                const size_t s0 = (size_t)tbp[i0 >> 16] * 256 + (i0 & 0xffffu), s1 = (size_t)tbp[i1 >> 16] * 256 + (i1 & 0xffffu);
                const RowV y0 = row_load_fp8(YC + s0 * D, lane, 1.0f / F8_YSCALE), y1 = row_load_fp8(YC + s1 * D, lane, 1.0f / F8_YSCALE);
#pragma unroll
                for (int j = 0; j < 4; ++j) rr[u].v[j] = rr[u].v[j] + y0.v[j] + y1.v[j];
            }
          }
#pragma unroll
          for (int u = 0; u < 2; ++u) {
            const int i = i2 + u;
            const int rl = wave * 32 + i, m = blk * 256 + rl;
            RowV r = rr[u];
            if (MODE == 0) {
                u32x2* xp = (u32x2*)(XB + (size_t)m * D) + lane;
#pragma unroll
                for (int j = 0; j < 4; ++j) { u32x2 w; w.x = cvt_pk_bf16(r.v[j][0], r.v[j][1]); w.y = cvt_pk_bf16(r.v[j][2], r.v[j][3]); xp[64 * j] = w;
                    r.v[j] = (f32x4){bf_lo(w.x), bf_hi(w.x), bf_lo(w.y), bf_hi(w.y)}; }
            }
            const float rstd = row_rstd(r);
            if (MODE != 2) { if (lane == 0) RSTD[m] = rstd; }
            if (MODE == 1 || (MODE == 0 && G3_F8)) { unsigned* x8 = (unsigned*)(p.ws + WS_XB8 + (size_t)m * D) + lane;
#pragma unroll
                for (int j = 0; j < 4; ++j) x8[64 * j] = cvt_pk4_fp8(r.v[j][0], r.v[j][1], r.v[j][2], r.v[j][3]); }
            if (MODE == 1) {
                float lg[20];
#pragma unroll
                for (int o = 0; o < 20; ++o) { float s = 0.f;
#pragma unroll
                    for (int j = 0; j < 4; ++j) { const f32x4 w = *(const LAS f32x4*)(wt + o * 1024 + 4 * lane + 256 * j); s += (r.v[j][0] * w[0] + r.v[j][1] * w[1]) + (r.v[j][2] * w[2] + r.v[j][3] * w[3]); }
                    lg[o] = wave_sum(s) * rstd + (o < 4 ? bgr[o] : ber[o - 4]); }
                int gs = 0; float gm = lg[0];
#pragma unroll
                for (int o = 1; o < 4; ++o) if (lg[o] > gm) { gm = lg[o]; gs = o; }
                float den = 0.f;
#pragma unroll
                for (int o = 0; o < 4; ++o) den += __expf(lg[o] - gm);
                const float pg = 1.0f / den;
                float el[4];
#pragma unroll
                for (int o = 0; o < 4; ++o) { float v = lg[4 + o];
#pragma unroll
                    for (int g2 = 1; g2 < 4; ++g2) v = (gs == g2) ? lg[4 + 4 * g2 + o] : v;
                    el[o] = v; }
                int i0 = 0; float v0 = el[0];
#pragma unroll
                for (int o = 1; o < 4; ++o) if (el[o] > v0) { v0 = el[o]; i0 = o; }
                int i1 = -1; float v1 = -INFINITY;
#pragma unroll
                for (int o = 0; o < 4; ++o) if (o != i0 && el[o] > v1) { v1 = el[o]; i1 = o; }
                const float ex = __expf(v1 - v0); const float w0 = 1.0f / (1.0f + ex), w1 = ex * w0;
                if (lane == 0) { te[rl * 2] = gs * 4 + i0; te[rl * 2 + 1] = gs * 4 + i1; tc[rl * 2] = w0 * pg; tc[rl * 2 + 1] = w1 * pg; trs[rl] = rstd; }
            }
            if (MODE == 2) {
#pragma unroll
                for (int j = 0; j < 4; ++j) r.v[j] = r.v[j] * rstd * gv.v[j];
                row_store(OUT + (size_t)m * D, lane, r);
            }
          }
        }
        if (MODE == 1) {
            __syncthreads();
            if (tid < 16) { int c = 0; for (int q = 0; q < 512; ++q) if (te[q] == tid) { trank[q] = c; ++c; }
                ebase[tid] = c ? (int)__hip_atomic_fetch_add(cnt_cur + tid * 64, (unsigned)c, __ATOMIC_RELAXED, __HIP_MEMORY_SCOPE_AGENT) : 0; }
            __syncthreads();
            { const int q = tid, e = te[q], pos = ebase[e] + trank[q], tok = blk * 256 + (q >> 1);
              rowtok[(size_t)e * ECAP + pos] = (unsigned)tok; cwraw[(size_t)e * ECAP + pos] = tc[q]; rsraw[(size_t)e * ECAP + pos] = trs[q >> 1]; tokinfo[(size_t)tok * 2 + (q & 1)] = ((unsigned)e << 16) | (unsigned)pos; }
            __syncthreads();
        }
    }
    __syncthreads();
}

__device__ __forceinline__ void phase_router(const Params& p, LAS unsigned char* lds, int tid_, int wave, int G,
                                             const float* gvec, const float* wgr, const float* bgr, const float* wer, const float* ber, unsigned* cnt_cur) {
    int tid = tid_; asm volatile("" : "+v"(tid)); const int lane = tid & 63, r32 = lane & 31, hi = lane >> 5;
    const bf16_t* XB = (const bf16_t*)(p.ws + WS_XB); float* rsraw = (float*)(p.ws + WS_RSRAW);
    unsigned* tokinfo = (unsigned*)(p.ws + WS_TOKINFO);
    unsigned* rowtok = (unsigned*)(p.ws + WS_ROWTOK); float* cwraw = (float*)(p.ws + WS_CWRAW);
    constexpr int WROW = 2048 + 16;
    LAS unsigned char* Whi = lds; LAS unsigned char* Wlo = lds + 24 * WROW;
    LAS int* misc = (LAS int*)(lds + MISC_OFF);
    LAS int* te = misc + 1024; LAS float* tc = (LAS float*)(misc + 1536); LAS int* trank = misc + 2048; LAS int* ebase = misc + 2560; LAS float* trs = (LAS float*)(misc + 2600);
    for (int i = tid; i < 24 * 1024; i += NTHR) { const int sl = i >> 10, k = i & 1023; float w;
        if (sl < 8) w = wgr[(size_t)k * 4 + (sl & 3)]; else { const int q = sl - 8, e = (q & 3) + 8 * ((q >> 2) & 1) + 4 * (q >> 3); w = wer[(size_t)k * 16 + e]; }
        w *= gvec[k];
        const unsigned hb = cvt_pk_bf16(w, 0.f) & 0xffffu; const float wl = w - __uint_as_float(hb << 16); const unsigned lb = cvt_pk_bf16(wl, 0.f) & 0xffffu;
        *(LAS unsigned short*)(Whi + sl * WROW + k * 2) = (unsigned short)hb; *(LAS unsigned short*)(Wlo + sl * WROW + k * 2) = (unsigned short)lb; }
    __syncthreads();
    const int slot_row = r32 < 24 ? r32 : r32 - 8;
    const LAS unsigned char* wh = Whi + slot_row * WROW + hi * 64; const LAS unsigned char* wl_ = Wlo + slot_row * WROW + hi * 64;
    for (int blk = blockIdx.x; blk < T / 256; blk += G) {
        const int rl = wave * 32 + r32, m = blk * 256 + rl;
        const bf16_t* xr = XB + (size_t)m * D + hi * 32;
        f32x16 acc = (f32x16){}; float ss = 0.f;
        bf16x8 xa[4], xb[4];
#pragma unroll
        for (int q = 0; q < 4; ++q) xa[q] = *(const bf16x8*)(xr + q * 8);
#pragma unroll 1
        for (int t = 0; t < 16; t += 2) {
#pragma unroll
            for (int q = 0; q < 4; ++q) xb[q] = *(const bf16x8*)(xr + (t + 1) * 64 + q * 8);
#pragma unroll
            for (int q = 0; q < 4; ++q) { const bf16x8 ah = *(const LAS bf16x8*)(wh + t * 128 + q * 16), al = *(const LAS bf16x8*)(wl_ + t * 128 + q * 16);
                acc = __builtin_amdgcn_mfma_f32_32x32x16_bf16(ah, xa[q], acc, 0, 0, 0); acc = __builtin_amdgcn_mfma_f32_32x32x16_bf16(al, xa[q], acc, 0, 0, 0);
#pragma unroll
                for (int j = 0; j < 4; ++j) { const unsigned w = ((const unsigned*)&xa[q])[j]; const float a = bf_lo(w), b = bf_hi(w); ss += a * a + b * b; } }
            if (t + 2 < 16) {
#pragma unroll
                for (int q = 0; q < 4; ++q) xa[q] = *(const bf16x8*)(xr + (t + 2) * 64 + q * 8); }
#pragma unroll
            for (int q = 0; q < 4; ++q) { const bf16x8 ah = *(const LAS bf16x8*)(wh + (t + 1) * 128 + q * 16), al = *(const LAS bf16x8*)(wl_ + (t + 1) * 128 + q * 16);
                acc = __builtin_amdgcn_mfma_f32_32x32x16_bf16(ah, xb[q], acc, 0, 0, 0); acc = __builtin_amdgcn_mfma_f32_32x32x16_bf16(al, xb[q], acc, 0, 0, 0);
#pragma unroll
                for (int j = 0; j < 4; ++j) { const unsigned w = ((const unsigned*)&xb[q])[j]; const float a = bf_lo(w), b = bf_hi(w); ss += a * a + b * b; } }
        }
        ss += __shfl_xor(ss, 32);
        const float rstd = 1.0f / sqrtf(ss * (1.0f / D) + NORM_EPS);
        float lg[4];
#pragma unroll
        for (int o = 0; o < 4; ++o) lg[o] = acc[o] * rstd + bgr[o];
        int gs = 0; float gm = lg[0];
#pragma unroll
        for (int o = 1; o < 4; ++o) if (lg[o] > gm) { gm = lg[o]; gs = o; }
        float den = 0.f;
#pragma unroll
        for (int o = 0; o < 4; ++o) den += __expf(lg[o] - gm);
        const float pg = 1.0f / den;
        if ((gs >> 1) == hi) {
            float el[4];
#pragma unroll
            for (int o = 0; o < 4; ++o) el[o] = ((gs & 1) ? acc[8 + o] : acc[4 + o]) * rstd + ber[gs * 4 + o];
            int i0 = 0; float v0 = el[0];
#pragma unroll
            for (int o = 1; o < 4; ++o) if (el[o] > v0) { v0 = el[o]; i0 = o; }
            int i1 = -1; float v1 = -INFINITY;
#pragma unroll
            for (int o = 0; o < 4; ++o) if (o != i0 && el[o] > v1) { v1 = el[o]; i1 = o; }
            const float ex = __expf(v1 - v0); const float w0 = 1.0f / (1.0f + ex), w1 = ex * w0;
            te[rl * 2] = gs * 4 + i0; te[rl * 2 + 1] = gs * 4 + i1; tc[rl * 2] = w0 * pg; tc[rl * 2 + 1] = w1 * pg; trs[rl] = rstd;
        }
        __syncthreads();
        if (tid < 16) { int c = 0; for (int q = 0; q < 512; ++q) if (te[q] == tid) { trank[q] = c; ++c; }
            ebase[tid] = c ? (int)__hip_atomic_fetch_add(cnt_cur + tid * 64, (unsigned)c, __ATOMIC_RELAXED, __HIP_MEMORY_SCOPE_AGENT) : 0; }
        __syncthreads();
        { const int q = tid, e = te[q], pos = ebase[e] + trank[q], tok = blk * 256 + (q >> 1);
          rowtok[(size_t)e * ECAP + pos] = (unsigned)tok; cwraw[(size_t)e * ECAP + pos] = tc[q]; rsraw[(size_t)e * ECAP + pos] = trs[q >> 1]; tokinfo[(size_t)tok * 2 + (q & 1)] = ((unsigned)e << 16) | (unsigned)pos; }
        __syncthreads();
    }
    __syncthreads();
}

__device__ __forceinline__ void phase_conv(const Params& p, int gw, int NGW, int lane) {
    const bf16_t* BG = (const bf16_t*)(p.ws + WS_BG); const bf16_t* Z = (const bf16_t*)(p.ws + WS_Z); bf16_t* A2 = (bf16_t*)(p.ws + WS_CAT);
    const float* cw = p.in[16];
    float w0[16], w1[16], w2[16];
#pragma unroll
    for (int h = 0; h < 2; ++h)
#pragma unroll
        for (int j = 0; j < 8; ++j) { const int c = h * 512 + lane * 8 + j; w0[h * 8 + j] = cw[c]; w1[h * 8 + j] = cw[D + c]; w2[h * 8 + j] = cw[2 * D + c]; }
    for (int run = gw; run < T / 32; run += NGW) {
        const int t0 = run * 32;
        float zm1[16], zm2[16];
#pragma unroll
        for (int j = 0; j < 16; ++j) { zm1[j] = 0.f; zm2[j] = 0.f; }
        if ((t0 & (SEQ - 1)) != 0) {
#pragma unroll
            for (int h = 0; h < 2; ++h) { const u32x4 a = *(const u32x4*)(Z + (size_t)(t0 - 1) * D + h * 512 + lane * 8), b = *(const u32x4*)(Z + (size_t)(t0 - 2) * D + h * 512 + lane * 8);
#pragma unroll
                for (int q = 0; q < 4; ++q) { zm1[h * 8 + 2 * q] = bf_lo(a[q]); zm1[h * 8 + 2 * q + 1] = bf_hi(a[q]); zm2[h * 8 + 2 * q] = bf_lo(b[q]); zm2[h * 8 + 2 * q + 1] = bf_hi(b[q]); } }
        }
#pragma unroll 4
        for (int i = 0; i < 32; ++i) {
            const size_t rb = (size_t)(t0 + i) * D;
#pragma unroll
            for (int h = 0; h < 2; ++h) { const u32x4 zz = *(const u32x4*)(Z + rb + h * 512 + lane * 8), bb = *(const u32x4*)(BG + rb + h * 512 + lane * 8);
                float o[8];
#pragma unroll
                for (int q = 0; q < 4; ++q) {
#pragma unroll
                    for (int s = 0; s < 2; ++s) { const int j = h * 8 + 2 * q + s; const float zc = s ? bf_hi(zz[q]) : bf_lo(zz[q]), bg = s ? bf_hi(bb[q]) : bf_lo(bb[q]);
                        o[2 * q + s] = bg * (w0[j] * zm2[j] + w1[j] * zm1[j] + w2[j] * zc); zm2[j] = zm1[j]; zm1[j] = zc; } }
                u32x4 w; w.x = cvt_pk_bf16(o[0], o[1]); w.y = cvt_pk_bf16(o[2], o[3]); w.z = cvt_pk_bf16(o[4], o[5]); w.w = cvt_pk_bf16(o[6], o[7]);
                *(u32x4*)(A2 + rb + h * 512 + lane * 8) = w; }
        }
    }
}

__device__ __forceinline__ void phase_gate_scan(const Params& p, int gw, int NGW, int lane) {
    const float* gates = (const float*)(p.ws + WS_GATES);
    float* SA = (float*)(p.ws + WS_SA); float* SAM = (float*)(p.ws + WS_SAM); float* SBA = (float*)(p.ws + WS_SBA);
    for (int sq = gw; sq < NBATCH * 4; sq += NGW) {
        const int b = sq >> 2, hd = sq & 3; const float ib = p.in[7][hd], fb = p.in[8][hd];
        float lf[32], ig[32];
#pragma unroll
        for (int i = 0; i < 32; ++i) { const size_t t = (size_t)b * SEQ + lane * 32 + i; const float f = gates[t * 8 + 4 + hd] + fb; ig[i] = gates[t * 8 + hd] + ib;
            lf[i] = (f >= 0.f) ? -log1pf(expf(-f)) : (f - log1pf(expf(f))); }
        float run = 0.f;
#pragma unroll
        for (int i = 0; i < 32; ++i) { run += lf[i]; lf[i] = run; }
        float tot = run, pre = 0.f;
#pragma unroll
        for (int o = 1; o < 64; o <<= 1) { const float v = __shfl_up(tot, o); if (lane >= o) tot += v; }
        pre = tot - run;
        float amax = -INFINITY;
#pragma unroll
        for (int i = 0; i < 32; ++i) { lf[i] += pre; ig[i] = ig[i] - lf[i]; amax = fmaxf(amax, ig[i]); }
        float pm = amax;
#pragma unroll
        for (int o = 1; o < 64; o <<= 1) { const float v = __shfl_up(pm, o); if (lane >= o) pm = fmaxf(pm, v); }
        float prev = __shfl_up(pm, 1); if (lane == 0) prev = -INFINITY;
        float rm = prev;
#pragma unroll
        for (int i = 0; i < 32; ++i) { const size_t o = (size_t)sq * SEQ + lane * 32 + i; rm = fmaxf(rm, ig[i]); SA[o] = ig[i]; SAM[o] = rm; SBA[o] = lf[i] + rm; }
    }
}

struct TileRegs { u32x4 v[2]; };
__device__ __forceinline__ TileRegs tile_load(const bf16_t* src, int tid) { TileRegs r;
#pragma unroll
    for (int i = 0; i < 2; ++i) { const int n = tid + 512 * i, row = n >> 4, ch = n & 15; r.v[i] = *(const u32x4*)(src + (size_t)row * NP + ch * 8); } return r; }
__device__ __forceinline__ void tile_write(LAS unsigned char* dst, int tid, const TileRegs& r) {
#pragma unroll
    for (int i = 0; i < 2; ++i) { const int n = tid + 512 * i, row = n >> 4, ch = n & 15; *(LAS u32x4*)(dst + off_b(row, ch)) = r.v[i]; } }

__device__ __forceinline__ void glds16(const void* gsrc, unsigned lds_dst) { unsigned keep;
    asm volatile("s_mov_b32 %0, m0\n\ts_mov_b32 m0, %2\n\ts_nop 0\n\tglobal_load_lds_dwordx4 %1, off\n\ts_mov_b32 m0, %0" : "=&s"(keep) : "v"(gsrc), "s"(lds_dst) : "memory"); }
__device__ __forceinline__ void tile_dma(const bf16_t* src, LAS unsigned char* dst, int wave, int lane) {
#pragma unroll
    for (int i = 0; i < 2; ++i) { const int piece = 2 * wave + i, row = 4 * piece + (lane >> 4); const unsigned ch = (unsigned)(lane & 15) ^ ((((unsigned)lane >> 4) << 2) | ((unsigned)piece & 3u));
        glds16(src + (size_t)row * NP + ch * 8, (unsigned)__builtin_amdgcn_readfirstlane((int)(unsigned)(uintptr_t)(dst + piece * 1024))); }
}
#define WAIT_ALL_BAR() asm volatile("s_waitcnt vmcnt(0) lgkmcnt(0)\n\ts_barrier" ::: "memory")
__device__ __forceinline__ void attn_unit(const Params& p, LAS unsigned char* lds, int bh, int qblk, int tid_, int wave, int lane_) {
    int tid = tid_; asm volatile("" : "+v"(tid)); const int lane = tid & 63;
    const bf16_t* P = (const bf16_t*)(p.ws + WS_P); bf16_t* CAT = (bf16_t*)(p.ws + WS_CAT);
    const int b = bh >> 2, hd = bh & 3, map = wave >> 2, qs = wave & 3, r32 = lane & 31, hi = lane >> 5;
    const size_t rowbase = (size_t)b * SEQ;
    const int q0 = qblk * 128 + qs * 32, qrow = q0 + r32;
    LAS float* fs = (LAS float*)(lds + MISC_OFF) + MW_F;
    LAS float* tbl = fs;
    constexpr float LOG2E = 1.4426950408889634f;
    if (tid < 272) { const int n = tid - 64; int bk;
        if (n < 16) bk = n < 0 ? 0 : n; else { bk = 16; const int th[15] = {19, 21, 24, 27, 31, 35, 40, 46, 52, 59, 67, 77, 87, 99, 113};
#pragma unroll
            for (int j = 0; j < 15; ++j) bk += (n >= th[j]) ? 1 : 0; }
        tbl[tid] = n < 0 ? -INFINITY : p.in[1][bk * 4 + hd] * LOG2E; }
    bf16x8 qf[4];
    { const bf16_t* qp = P + (rowbase + qrow) * NP + P_DQ + hd * 128 + map * 64 + hi * 8;
#pragma unroll
      for (int ks = 0; ks < 4; ++ks) qf[ks] = *(const bf16x8*)(qp + ks * 16); }
    const bf16_t* Kg = P + rowbase * NP + P_DK + hd * 128; const bf16_t* Vg = P + rowbase * NP + P_DV + hd * 128;
    const int NS = qblk + 1;
    f32x16 o[4];
#pragma unroll
    for (int c = 0; c < 4; ++c) o[c] = (f32x16){};
    float mrun = -INFINITY, lrun = 0.f;
    const float bias_far = p.in[1][31 * 4 + hd] * LOG2E;
    const unsigned xr = ((unsigned)(r32 & 3) << 2) | ((unsigned)(r32 >> 2) & 3u);
    const unsigned q4 = (lane & 15) >> 2, pp = lane & 3, blk = (lane >> 4) & 1;
#ifndef ATT_DMA
#define ATT_DMA 5
#endif
#ifndef ATT_LATE_DMA
#define ATT_LATE_DMA 1
#endif
#if ATT_DMA == 2 || ATT_DMA == 4
#elif ATT_DMA
    WAIT_ALL_BAR();
    { tile_dma(Kg, lds, wave, lane); tile_dma(Vg, lds + 16384, wave, lane); tile_dma(Kg + (size_t)64 * NP, lds + 32768, wave, lane); tile_dma(Vg + (size_t)64 * NP, lds + 49152, wave, lane); }
#else
    { TileRegs a0 = tile_load(Kg, tid), a1 = tile_load(Vg, tid), a2 = tile_load(Kg + (size_t)64 * NP, tid), a3 = tile_load(Vg + (size_t)64 * NP, tid);
      tile_write(lds, tid, a0); tile_write(lds + 16384, tid, a1); tile_write(lds + 32768, tid, a2); tile_write(lds + 49152, tid, a3); }
#endif
#if ATT_DMA == 5
    WAIT_ALL_BAR();
#endif
    asm volatile("" :: "v"(qf[0]), "v"(qf[1]), "v"(qf[2]), "v"(qf[3]));
#pragma unroll 1
    for (int st = 0; st < NS; ++st) {
        WAIT_ALL_BAR();
#if ATT_DMA == 2
        { LAS unsigned char* nb = lds + (st & 1) * 65536; const size_t ro = (size_t)st * 128 * NP;
            tile_dma(Kg + ro, nb, wave, lane); tile_dma(Vg + ro, nb + 16384, wave, lane); tile_dma(Kg + ro + (size_t)64 * NP, nb + 32768, wave, lane); tile_dma(Vg + ro + (size_t)64 * NP, nb + 49152, wave, lane); }
        WAIT_ALL_BAR();
#elif ATT_DMA == 3
#elif ATT_DMA
#if ATT_DMA == 4
        if (st == 0) { tile_dma(Kg, lds, wave, lane); tile_dma(Vg, lds + 16384, wave, lane); tile_dma(Kg + (size_t)64 * NP, lds + 32768, wave, lane); tile_dma(Vg + (size_t)64 * NP, lds + 49152, wave, lane); WAIT_ALL_BAR(); }
#endif
        if (!ATT_LATE_DMA && st + 1 < NS) { LAS unsigned char* nb = lds + ((st + 1) & 1) * 65536; const size_t ro = (size_t)(st + 1) * 128 * NP;
            tile_dma(Kg + ro, nb, wave, lane); tile_dma(Vg + ro, nb + 16384, wave, lane); tile_dma(Kg + ro + (size_t)64 * NP, nb + 32768, wave, lane); tile_dma(Vg + ro + (size_t)64 * NP, nb + 49152, wave, lane); }
#else
        TileRegs a0, a1;
        if (st + 1 < NS) { const size_t ro = (size_t)(st + 1) * 128 * NP; a0 = tile_load(Kg + ro, tid); a1 = tile_load(Vg + ro, tid); }
#endif
#pragma unroll
        for (int half = 0; half < 2; ++half) {
            const int j = 2 * st + half;
            const LAS unsigned char* Kt = lds + (st & 1) * 65536 + half * 32768; const LAS unsigned char* Vt = Kt + 16384;
            if (64 * j <= q0 + 31) {
                const int nmin = q0 - (64 * j + 63);
                const bool first = (mrun == -INFINITY);
                const float cinit = first ? 0.f : (nmin >= 113 ? bias_far - mrun : -mrun);
                f32x16 p0, p1;
#pragma unroll
                for (int r = 0; r < 16; ++r) { p0[r] = cinit; p1[r] = cinit; }
#pragma unroll
                for (int ks = 0; ks < 4; ++ks) { const unsigned ch = (unsigned)(8 * map + 2 * ks + hi) ^ xr;
                    const bf16x8 k0 = *(const LAS bf16x8*)(Kt + 256u * r32 + 16u * ch), k1 = *(const LAS bf16x8*)(Kt + 256u * (32 + r32) + 16u * ch);
                    p0 = __builtin_amdgcn_mfma_f32_32x32x16_bf16(k0, qf[ks], p0, 0, 0, 0); p1 = __builtin_amdgcn_mfma_f32_32x32x16_bf16(k1, qf[ks], p1, 0, 0, 0); }
                __builtin_amdgcn_sched_barrier(0);
                float rm = -INFINITY;
                if (first) {
                    if (nmin >= 113) {
#pragma unroll
                        for (int r = 0; r < 16; ++r) { p0[r] = p0[r] + bias_far; p1[r] = p1[r] + bias_far; rm = fmaxf(rm, fmaxf(p0[r], p1[r])); }
                    } else {
                        const LAS float* tb = tbl + (qrow - 64 * j - 4 * hi + 5);
#pragma unroll
                        for (int r = 0; r < 16; ++r) { const int e = (r & 3) + 8 * (r >> 2);
                            p0[r] += tb[59 - e]; p1[r] += tb[27 - e];
                            rm = fmaxf(rm, fmaxf(p0[r], p1[r])); }
                    }
                    { auto rr = __builtin_amdgcn_permlane32_swap(__float_as_uint(rm), __float_as_uint(rm), false, false); rm = fmaxf(__uint_as_float(rr[0]), __uint_as_float(rr[1])); }
                    mrun = rm;
#pragma unroll
                    for (int r = 0; r < 16; ++r) { p0[r] -= mrun; p1[r] -= mrun; }
                } else {
                    if (nmin < 113) {
                        const LAS float* tb = tbl + (qrow - 64 * j - 4 * hi + 5);
                        float bv0[16], bv1[16];
#pragma unroll
                        for (int r = 0; r < 16; ++r) { const int e = (r & 3) + 8 * (r >> 2); bv0[r] = tb[59 - e]; bv1[r] = tb[27 - e]; }
#pragma unroll
                        for (int r = 0; r < 16; ++r) { p0[r] += bv0[r]; p1[r] += bv1[r]; }
                    }
                    { float m0 = fmaxf(p0[0], p1[0]), m1 = fmaxf(p0[1], p1[1]);
#pragma unroll
                      for (int r = 2; r < 16; r += 2) { m0 = __builtin_fmaxf(__builtin_fmaxf(m0, p0[r]), p1[r]); m1 = __builtin_fmaxf(__builtin_fmaxf(m1, p0[r + 1]), p1[r + 1]); }
                      rm = fmaxf(m0, m1); }
                    { auto rr = __builtin_amdgcn_permlane32_swap(__float_as_uint(rm), __float_as_uint(rm), false, false); rm = fmaxf(__uint_as_float(rr[0]), __uint_as_float(rr[1])); }
                    if (__any(rm > 8.0f)) {
                        const float dl = fmaxf(rm, 0.f); const float alpha = fast_exp2(-dl);
                        lrun *= alpha; mrun += dl;
#pragma unroll
                        for (int r = 0; r < 16; ++r) { p0[r] -= dl; p1[r] -= dl; }
#pragma unroll
                        for (int c = 0; c < 4; ++c)
#pragma unroll
                            for (int r = 0; r < 16; ++r) o[c][r] *= alpha;
                    }
                }
                float psa = 0.f, psb = 0.f;
                bf16x8 pf[4];
#define ATT_EXPK(ks_) do { u32x4 w_; _Pragma("unroll") for (int q = 0; q < 4; ++q) { const int r = 8 * ((ks_) & 1) + 2 * q; \
                        const float ea = fast_exp2((ks_) < 2 ? p0[r] : p1[r]), eb = fast_exp2((ks_) < 2 ? p0[r + 1] : p1[r + 1]); psa += ea; psb += eb; w_[q] = cvt_pk_bf16(ea, eb); } \
                    pf[ks_] = __builtin_bit_cast(bf16x8, w_); } while (0)
                bf16x8 vf[2][4];
#define ATT_LOADV(buf, ks_) do { _Pragma("unroll") for (int c = 0; c < 4; ++c) { const unsigned chv = (unsigned)(4 * c + 2 * blk + (pp >> 1)); const unsigned row0 = 16u * (ks_) + 4u * hi + q4; \
                        vf[buf][c] = cat8(vtr(Vt + off_b(row0, chv) + 8u * (pp & 1)), vtr(Vt + off_b(row0 + 8u, chv) + 8u * (pp & 1))); } } while (0)
                ATT_LOADV(0, 0);
                ATT_EXPK(0);
                if (ATT_LATE_DMA && half == 0 && st + 1 < NS) {
                    LAS unsigned char* nb = lds + ((st + 1) & 1) * 65536; const size_t ro = (size_t)(st + 1) * 128 * NP;
                    tile_dma(Kg + ro, nb, wave, lane); tile_dma(Vg + ro, nb + 16384, wave, lane); tile_dma(Kg + ro + (size_t)64 * NP, nb + 32768, wave, lane); tile_dma(Vg + ro + (size_t)64 * NP, nb + 49152, wave, lane); }
#pragma unroll
                for (int ks = 0; ks < 4; ++ks) {
                    if (ks < 3) ATT_LOADV((ks + 1) & 1, ks + 1);
                    __builtin_amdgcn_sched_barrier(0);
#pragma unroll
                    for (int c = 0; c < 4; ++c) o[c] = __builtin_amdgcn_mfma_f32_32x32x16_bf16(vf[ks & 1][c], pf[ks], o[c], 0, 0, 0);
                    if (ks < 3) { ATT_EXPK(ks + 1); asm volatile("" : "+v"(pf[(ks + 1) & 3]), "+v"(psa), "+v"(psb)); }
                    __builtin_amdgcn_sched_barrier(0);
                }
                lrun += psa + psb;
#undef ATT_EXPK
#undef ATT_LOADV
            }
#if ATT_DMA == 5
            if (half == 0) WAIT_ALL_BAR();
#endif
#if !ATT_DMA
            if (st + 1 < NS) { LAS unsigned char* nb = lds + ((st + 1) & 1) * 65536 + half * 32768; tile_write(nb, tid, a0); tile_write(nb + 16384, tid, a1);
                if (half == 0) { const size_t ro = (size_t)(st + 1) * 128 * NP + (size_t)64 * NP; a0 = tile_load(Kg + ro, tid); a1 = tile_load(Vg + ro, tid); } }
#endif
        }
#if ATT_DMA == 3
        WAIT_ALL_BAR();
        if (st + 1 < NS) { LAS unsigned char* nb = lds + ((st + 1) & 1) * 65536; const size_t ro = (size_t)(st + 1) * 128 * NP;
            tile_dma(Kg + ro, nb, wave, lane); tile_dma(Vg + ro, nb + 16384, wave, lane); tile_dma(Kg + ro + (size_t)64 * NP, nb + 32768, wave, lane); tile_dma(Vg + ro + (size_t)64 * NP, nb + 49152, wave, lane); }
#endif

    }
    WAIT_ALL_BAR();
    lrun += __shfl_xor(lrun, 32);
    const float inv = 1.0f / lrun;
    float lam;
    { float s1 = 0.f, s2 = 0.f; const float a1 = p.in[10][lane] * p.in[11][lane], a2 = p.in[12][lane] * p.in[13][lane]; s1 = wave_sum(a1); s2 = wave_sum(a2);
      const float lam_init = 0.8f - 0.6f * 1.0f;
      lam = expf(s1) - expf(s2) + lam_init; }
    LAS float* xch = (LAS float*)lds + qs * 4096;
    if (map == 1) {
#pragma unroll
        for (int c = 0; c < 4; ++c)
#pragma unroll
            for (int r = 0; r < 16; ++r) xch[(32 * c + crow(r, hi)) * 32 + r32] = o[c][r] * inv * lam;
    }
    __syncthreads();
    if (map == 0) {
        float ss = 0.f;
#pragma unroll
        for (int c = 0; c < 4; ++c)
#pragma unroll
            for (int r = 0; r < 16; ++r) { const float v = o[c][r] * inv - xch[(32 * c + crow(r, hi)) * 32 + r32]; o[c][r] = v; ss += v * v; }
        ss += __shfl_xor(ss, 32);
        const float rstd = 1.0f / sqrtf(ss * (1.0f / 128.0f) + NORM_EPS) * 0.8f;
        const float* sub = p.in[14];
        bf16_t* orow = CAT + (rowbase + qrow) * D + 512 + hd * 128;
#pragma unroll
        for (int c = 0; c < 4; ++c)
#pragma unroll
            for (int rq = 0; rq < 4; ++rq) { const int e0 = 32 * c + 8 * rq + 4 * hi; const f32x4 sv = *(const f32x4*)(sub + e0);
                u32x2 w; w.x = cvt_pk_bf16(o[c][4 * rq] * rstd * sv[0], o[c][4 * rq + 1] * rstd * sv[1]); w.y = cvt_pk_bf16(o[c][4 * rq + 2] * rstd * sv[2], o[c][4 * rq + 3] * rstd * sv[3]);
                *(u32x2*)(orow + e0) = w; }
    }
    __syncthreads();
}

__device__ __forceinline__ void mlstm_s1_unit(const Params& p, LAS unsigned char* lds, int bh, int c, int tid_, int wave, int lane_) {
    int tid = tid_; asm volatile("" : "+v"(tid)); const int lane = tid & 63;
    const bf16_t* P = (const bf16_t*)(p.ws + WS_P);
    const int b = bh >> 2, hd = bh & 3, r32 = lane & 31, hi = lane >> 5;
    const size_t t0 = (size_t)b * SEQ + (size_t)c * MCH;
    const float* SA = (const float*)(p.ws + WS_SA) + (size_t)bh * SEQ + c * MCH;
    LAS float* fs = (LAS float*)(lds + MISC_OFF) + MW_F;
    LAS float* wsm = fs;
    LAS float* red = fs + 256;
    float av = (tid < 256) ? SA[tid] : -INFINITY;
    float mx = av;
#pragma unroll
    for (int o = 1; o < 64; o <<= 1) mx = fmaxf(mx, __shfl_xor(mx, o));
    if (lane == 0) red[wave] = mx;
    __syncthreads();
    float R = red[0];
#pragma unroll
    for (int w = 1; w < 4; ++w) R = fmaxf(R, red[w]);
    if (tid < 256) wsm[tid] = __expf(av - R) * 0.08838834764831845f;
    __syncthreads();
    LAS unsigned char* Kl = lds; LAS unsigned char* Vl = lds + 65536;
    const bf16_t* Kg = P + t0 * NP + P_MK + hd * 128; const bf16_t* Vg = P + t0 * NP + P_MV + hd * 128;
#pragma unroll
    for (int i = 0; i < 8; ++i) { const int n = tid + 512 * i, row = n >> 4, ch = n & 15;
        const u32x4 kv = *(const u32x4*)(Kg + (size_t)row * NP + ch * 8); const u32x4 vv = *(const u32x4*)(Vg + (size_t)row * NP + ch * 8);
        const float w = wsm[row]; u32x4 ks;
#pragma unroll
        for (int q = 0; q < 4; ++q) ks[q] = cvt_pk_bf16(bf_lo(kv[q]) * w, bf_hi(kv[q]) * w);
        *(LAS u32x4*)(Kl + off_b(row, ch)) = ks; *(LAS u32x4*)(Vl + off_b(row, ch)) = vv; }
    __syncthreads();
    const int eb = wave >> 1, dh = wave & 1;
    const unsigned q4 = (lane & 15) >> 2, pp = lane & 3, blk = (lane >> 4) & 1;
    f32x16 acc[2]; acc[0] = (f32x16){}; acc[1] = (f32x16){};
    for (int ks = 0; ks < 16; ++ks) {
        const unsigned row0 = 16u * ks + 8u * hi + q4, row1 = row0 + 4u;
        const unsigned cha = (unsigned)(4 * eb + 2 * blk + (pp >> 1));
        const bf16x8 af = cat8(vtr(Vl + off_b(row0, cha) + 8u * (pp & 1)), vtr(Vl + off_b(row1, cha) + 8u * (pp & 1)));
#pragma unroll
        for (int db = 0; db < 2; ++db) { const unsigned chb = (unsigned)(4 * (2 * dh + db) + 2 * blk + (pp >> 1));
            const bf16x8 bfr = cat8(vtr(Kl + off_b(row0, chb) + 8u * (pp & 1)), vtr(Kl + off_b(row1, chb) + 8u * (pp & 1)));
            acc[db] = __builtin_amdgcn_mfma_f32_32x32x16_bf16(af, bfr, acc[db], 0, 0, 0); }
    }
    const int unit = bh * NCH + c;
    float* UT = (float*)(p.ws + WS_UT) + (size_t)unit * 16384;
#pragma unroll
    for (int db = 0; db < 2; ++db)
#pragma unroll
        for (int r = 0; r < 16; ++r) UT[(32 * eb + crow(r, hi)) * 128 + 64 * dh + 32 * db + r32] = acc[db][r];
    if (tid < 128) { float s = 0.f; const int d = tid;
        for (int srow = 0; srow < 256; ++srow) { const unsigned short hv = *(const LAS unsigned short*)(Kl + off_b(srow, d >> 3) + (d & 7) * 2); s += __uint_as_float((unsigned)hv << 16); }
        ((float*)(p.ws + WS_UN))[(size_t)unit * 128 + d] = s; }
    if (tid == 0) ((float*)(p.ws + WS_UR))[unit] = R;
    __syncthreads();
}

__device__ __forceinline__ void mlstm_s3_unit(const Params& p, LAS unsigned char* lds, int bh, int c, int tid_, int wave, int lane_) {
    int tid = tid_; asm volatile("" : "+v"(tid)); const int lane = tid & 63;
    const bf16_t* P = (const bf16_t*)(p.ws + WS_P); bf16_t* CAT = (bf16_t*)(p.ws + WS_CAT);
    const int b = bh >> 2, hd = bh & 3, r32 = lane & 31, hi = lane >> 5;
    const size_t t0 = (size_t)b * SEQ + (size_t)c * MCH;
    const size_t so = (size_t)bh * SEQ + c * MCH;
    const float* SA = (const float*)(p.ws + WS_SA) + so; const float* SAM = (const float*)(p.ws + WS_SAM) + so; const float* SBA = (const float*)(p.ws + WS_SBA) + so;
    LAS float* fs = (LAS float*)(lds + MISC_OFF) + MW_F;
    LAS float* as = fs;
    LAS float* nC = fs + 256;
    LAS unsigned char* Ct = lds + 65536;
    const int qloc = 32 * wave + r32;
    const float Aq = SAM[qloc], BAq = SBA[qloc];
    if (tid < 256) as[tid] = SA[tid];
    bf16x8 qf[8];
    { const bf16_t* qp = P + (t0 + qloc) * NP + P_MQ + hd * 128 + hi * 8;
#pragma unroll
      for (int ks = 0; ks < 8; ++ks) qf[ks] = *(const bf16x8*)(qp + ks * 16); }
    const bf16_t* Kg = P + t0 * NP + P_MK + hd * 128; const bf16_t* Vg = P + t0 * NP + P_MV + hd * 128;
#if defined(S3_REGSTAGE)
    { TileRegs k0 = tile_load(Kg, tid), v0 = tile_load(Vg, tid); tile_write(lds, tid, k0); tile_write(lds + 16384, tid, v0); }
#elif !defined(S3_SERIAL)
    tile_dma(Kg, lds, wave, lane); tile_dma(Vg, lds + 16384, wave, lane);
#endif
    f32x16 o[4];
#pragma unroll
    for (int cb = 0; cb < 4; ++cb) o[cb] = (f32x16){};
    float den = 0.f, fst = 0.f;
    const unsigned xr = ((unsigned)(r32 & 3) << 2) | ((unsigned)(r32 >> 2) & 3u);
    if (c > 0) {
        const float* UR = (const float*)(p.ws + WS_UR) + bh * NCH; const float* UT = (const float*)(p.ws + WS_UT) + (size_t)bh * NCH * 16384; const float* UN = (const float*)(p.ws + WS_UN) + (size_t)bh * NCH * 128;
        float Pref = -INFINITY, ur[7];
#pragma unroll
        for (int j = 0; j < 7; ++j) { ur[j] = UR[j]; if (j < c) Pref = fmaxf(Pref, ur[j]); }
        float cf[7];
#pragma unroll
        for (int j = 0; j < 7; ++j) cf[j] = (j < c) ? __expf(ur[j] - Pref) : 0.f;
#pragma unroll 1
        for (int i = 0; i < 4; ++i) { const int n = tid + 512 * i, e = n >> 4, ch = n & 15; f32x4 u0[7], u1[7];
#pragma unroll
            for (int j = 0; j < 7; ++j) { const f32x4* up = (const f32x4*)(UT + (size_t)j * 16384 + e * 128 + ch * 8); u0[j] = up[0]; u1[j] = up[1]; }
            f32x4 s0 = (f32x4){0.f, 0.f, 0.f, 0.f}, s1 = s0;
#pragma unroll
            for (int j = 0; j < 7; ++j) { s0 += u0[j] * cf[j]; s1 += u1[j] * cf[j]; }
            u32x4 w; w.x = cvt_pk_bf16(s0[0], s0[1]); w.y = cvt_pk_bf16(s0[2], s0[3]); w.z = cvt_pk_bf16(s1[0], s1[1]); w.w = cvt_pk_bf16(s1[2], s1[3]);
            *(LAS u32x4*)(Ct + off_b(e, ch)) = w; }
        if (tid < 128) { float sN = 0.f;
#pragma unroll
            for (int j = 0; j < 7; ++j) sN += cf[j] * UN[j * 128 + tid];
            nC[tid] = sN; }
        fst = __expf(Pref - Aq);
    }
    asm volatile("" :: "v"(qf[0]), "v"(qf[1]), "v"(qf[2]), "v"(qf[3]), "v"(qf[4]), "v"(qf[5]), "v"(qf[6]), "v"(qf[7]), "v"(Aq), "v"(BAq));
    WAIT_ALL_BAR();
    if (c > 0) {
#pragma unroll
        for (int cb = 0; cb < 4; ++cb) {
#pragma unroll
            for (int ks = 0; ks < 8; ++ks) { const unsigned ch = (unsigned)(2 * ks + hi) ^ xr;
                const bf16x8 cfr = *(const LAS bf16x8*)(Ct + 256u * (32 * cb + r32) + 16u * ch);
                o[cb] = __builtin_amdgcn_mfma_f32_32x32x16_bf16(cfr, qf[ks], o[cb], 0, 0, 0); }
            __builtin_amdgcn_sched_barrier(0); }
#pragma unroll
        for (int cb = 0; cb < 4; ++cb)
#pragma unroll
            for (int r = 0; r < 16; ++r) o[cb][r] *= fst;
        float dq = 0.f;
#pragma unroll
        for (int ks = 0; ks < 8; ++ks)
#pragma unroll
            for (int q = 0; q < 4; ++q) { const unsigned w = ((const unsigned*)&qf[ks])[q]; const int d = 16 * ks + 8 * hi + 2 * q; dq += bf_lo(w) * nC[d] + bf_hi(w) * nC[d + 1]; }
        den = fst * dq;
    }
    const unsigned q4 = (lane & 15) >> 2, pp = lane & 3, blk = (lane >> 4) & 1;
#pragma unroll 1
    for (int j = 0; j < 4; ++j) {
        WAIT_ALL_BAR();
        const LAS unsigned char* Kt = lds + (j & 1) * 32768; const LAS unsigned char* Vt = Kt + 16384;
#if defined(S3_REGSTAGE)
        TileRegs kr, vr; if (j + 1 < 4) { kr = tile_load(Kg + (size_t)(j + 1) * 64 * NP, tid); vr = tile_load(Vg + (size_t)(j + 1) * 64 * NP, tid); }
#elif defined(S3_SERIAL)
        { LAS unsigned char* nb = lds + (j & 1) * 32768; tile_dma(Kg + (size_t)j * 64 * NP, nb, wave, lane); tile_dma(Vg + (size_t)j * 64 * NP, nb + 16384, wave, lane); }
        WAIT_ALL_BAR();
#else
        if (j + 1 < 4) { LAS unsigned char* nb = lds + ((j + 1) & 1) * 32768; tile_dma(Kg + (size_t)(j + 1) * 64 * NP, nb, wave, lane); tile_dma(Vg + (size_t)(j + 1) * 64 * NP, nb + 16384, wave, lane); }
#endif
        const bool doit = (64 * j <= 32 * wave + 31);
        bf16x8 pf[4];
        if (doit) {
            f32x16 p0 = (f32x16){}, p1 = (f32x16){};
#pragma unroll
            for (int ks = 0; ks < 8; ++ks) { const unsigned ch = (unsigned)(2 * ks + hi) ^ xr;
                const bf16x8 k0 = *(const LAS bf16x8*)(Kt + 256u * r32 + 16u * ch), k1 = *(const LAS bf16x8*)(Kt + 256u * (32 + r32) + 16u * ch);
                p0 = __builtin_amdgcn_mfma_f32_32x32x16_bf16(k0, qf[ks], p0, 0, 0, 0); p1 = __builtin_amdgcn_mfma_f32_32x32x16_bf16(k1, qf[ks], p1, 0, 0, 0); if ((ks & 3) == 3) __builtin_amdgcn_sched_barrier(0); }
            float ps = 0.f;
#pragma unroll
            for (int r = 0; r < 16; ++r) { const int kv = 64 * j + crow(r, hi);
                const float w0 = (kv <= qloc) ? __expf(as[kv] - Aq) * 0.08838834764831845f : 0.f, w1 = (kv + 32 <= qloc) ? __expf(as[kv + 32] - Aq) * 0.08838834764831845f : 0.f;
                p0[r] *= w0; p1[r] *= w1; ps += p0[r] + p1[r]; }
            den += ps;
#pragma unroll
            for (int ks = 0; ks < 4; ++ks) { u32x4 w;
#pragma unroll
                for (int q = 0; q < 4; ++q) { const int r = 8 * (ks & 1) + 2 * q; w[q] = (ks < 2) ? cvt_pk_bf16(p0[r], p0[r + 1]) : cvt_pk_bf16(p1[r], p1[r + 1]); }
                pf[ks] = __builtin_bit_cast(bf16x8, w); }
        }
        WAIT_ALL_BAR();
        if (doit) {
            bf16x8 vf[2][4];
#define S3_LOADV(buf, ks_) do { _Pragma("unroll") for (int cb = 0; cb < 4; ++cb) { const unsigned chv = (unsigned)(4 * cb + 2 * blk + (pp >> 1)); const unsigned row0 = 16u * (ks_) + 4u * hi + q4; \
                vf[buf][cb] = cat8(vtr(Vt + off_b(row0, chv) + 8u * (pp & 1)), vtr(Vt + off_b(row0 + 8u, chv) + 8u * (pp & 1))); } } while (0)
            S3_LOADV(0, 0);
#pragma unroll
            for (int ks = 0; ks < 4; ++ks) {
                if (ks < 3) S3_LOADV((ks + 1) & 1, ks + 1);
                __builtin_amdgcn_sched_barrier(0);
#pragma unroll
                for (int cb = 0; cb < 4; ++cb) o[cb] = __builtin_amdgcn_mfma_f32_32x32x16_bf16(vf[ks & 1][cb], pf[ks], o[cb], 0, 0, 0);
                __builtin_amdgcn_sched_barrier(0);
            }
#undef S3_LOADV
        }
#if defined(S3_REGSTAGE)
        if (j + 1 < 4) { LAS unsigned char* nb = lds + ((j + 1) & 1) * 32768; tile_write(nb, tid, kr); tile_write(nb + 16384, tid, vr); }
#endif
    }
    den += __shfl_xor(den, 32);
    const float dinv = 1.0f / fmaxf(fabsf(den), __expf(-BAq));
    float sm = 0.f;
#pragma unroll
    for (int cb = 0; cb < 4; ++cb)
#pragma unroll
        for (int r = 0; r < 16; ++r) { o[cb][r] *= dinv; sm += o[cb][r]; }
    sm += __shfl_xor(sm, 32);
    const float mu = sm * (1.0f / 128.0f);
    float vs = 0.f;
#pragma unroll
    for (int cb = 0; cb < 4; ++cb)
#pragma unroll
        for (int r = 0; r < 16; ++r) { o[cb][r] -= mu; vs += o[cb][r] * o[cb][r]; }
    vs += __shfl_xor(vs, 32);
    const float rstd = 1.0f / sqrtf(vs * (1.0f / 128.0f) + NORM_EPS);
    const float* hn = p.in[9] + hd * 128;
    const bf16_t* mo = P + (t0 + qloc) * NP + P_MO + hd * 128;
    bf16_t* orow = CAT + (t0 + qloc) * D + hd * 128;
    u32x2 mw[4][4];
#pragma unroll
    for (int cb = 0; cb < 4; ++cb)
#pragma unroll
        for (int rq = 0; rq < 4; ++rq) mw[cb][rq] = *(const u32x2*)(mo + 32 * cb + 8 * rq + 4 * hi);
#pragma unroll
    for (int cb = 0; cb < 4; ++cb)
#pragma unroll
        for (int rq = 0; rq < 4; ++rq) { const int e0 = 32 * cb + 8 * rq + 4 * hi; const f32x4 hv = *(const f32x4*)(hn + e0); const u32x2 m2 = mw[cb][rq];
            const float g0 = fast_rcp(1.0f + __expf(-bf_lo(m2.x))), g1 = fast_rcp(1.0f + __expf(-bf_hi(m2.x))), g2 = fast_rcp(1.0f + __expf(-bf_lo(m2.y))), g3 = fast_rcp(1.0f + __expf(-bf_hi(m2.y)));
            u32x2 w; w.x = cvt_pk_bf16(o[cb][4 * rq] * rstd * hv[0] * g0, o[cb][4 * rq + 1] * rstd * hv[1] * g1); w.y = cvt_pk_bf16(o[cb][4 * rq + 2] * rstd * hv[2] * g2, o[cb][4 * rq + 3] * rstd * hv[3] * g3);
            *(u32x2*)(orow + e0) = w; }
    WAIT_ALL_BAR();
}

__device__ __forceinline__ void mlstm_seq_unit(const Params& p, LAS unsigned char* lds, int bh, int tid_, int wave, int lane_) {
    int tid = tid_; asm volatile("" : "+v"(tid)); const int lane = tid & 63;
    const bf16_t* P = (const bf16_t*)(p.ws + WS_P); bf16_t* CAT = (bf16_t*)(p.ws + WS_CAT);
    const int b = bh >> 2, hd = bh & 3, r32 = lane & 31, hi = lane >> 5;
    LAS float* fs = (LAS float*)(lds + MISC_OFF) + MW_F;
    LAS float* as = fs;
    LAS float* nC = fs + 256;
    LAS float* wsc = fs + 384;
    LAS unsigned char* Ct = lds + 65536;
    const unsigned xr = ((unsigned)(r32 & 3) << 2) | ((unsigned)(r32 >> 2) & 3u);
    const unsigned q4 = (lane & 15) >> 2, pp = lane & 3, blk = (lane >> 4) & 1;
    const int eb = wave >> 1, dh = wave & 1;
    f32x16 cacc[2]; cacc[0] = (f32x16){}; cacc[1] = (f32x16){};
    float nrun = 0.f;
    float Prun = -INFINITY;
    LAS float* hnl = fs + 896;
    if (tid < 128) hnl[tid] = p.in[9][hd * 128 + tid];
#pragma unroll 1
    for (int c = 0; c < NCH; ++c) {
        const size_t t0 = (size_t)b * SEQ + (size_t)c * MCH;
        const size_t so = (size_t)bh * SEQ + c * MCH;
        const float* SA = (const float*)(p.ws + WS_SA) + so; const float* SAM = (const float*)(p.ws + WS_SAM) + so; const float* SBA = (const float*)(p.ws + WS_SBA) + so;
        const int qloc = 32 * wave + r32;
        const float Aq2 = SAM[qloc] * 1.4426950408889634f;
        if (tid < 256) as[tid] = SA[tid] * 1.4426950408889634f;
        bf16x8 qf[2];
        LAS bf16x8* qpark = (LAS bf16x8*)(lds + 98304 + tid * 64);
        LAS bf16x8* qpark2 = (LAS bf16x8*)(lds + 147456 + tid * 32);
        { const bf16_t* qp = P + (t0 + qloc) * NP + P_MQ + hd * 128 + hi * 8;
#pragma unroll
          for (int ks = 0; ks < 2; ++ks) qf[ks] = *(const bf16x8*)(qp + ks * 16);
#pragma unroll
          for (int ks = 2; ks < 6; ++ks) qpark[ks - 2] = *(const bf16x8*)(qp + ks * 16);
#pragma unroll
          for (int ks = 6; ks < 8; ++ks) qpark2[ks - 6] = *(const bf16x8*)(qp + ks * 16); }
#define QFRAG(ks) ((ks) < 2 ? qf[(ks) & 1] : ((ks) < 6 ? qpark[((ks) - 2) & 3] : qpark2[((ks) - 6) & 1]))
        const bf16_t* Kg = P + t0 * NP + P_MK + hd * 128; const bf16_t* Vg = P + t0 * NP + P_MV + hd * 128;
        tile_dma(Kg, lds, wave, lane); tile_dma(Vg, lds + 16384, wave, lane);
        asm volatile("" :: "v"(qf[0]), "v"(qf[1]), "v"(Aq2));
        WAIT_ALL_BAR();
        float R = fmaxf(fmaxf(as[lane], as[lane + 64]), fmaxf(as[lane + 128], as[lane + 192]));
#pragma unroll
        for (int o = 1; o < 64; o <<= 1) R = fmaxf(R, __shfl_xor(R, o));
        R *= (1.0f / 1.4426950408889634f);
        const float Pnew = fmaxf(Prun, R);
        const float scC = (c > 0) ? __expf(Prun - Pnew) : 0.f;
        if (tid < 256) wsc[tid] = fast_exp2(as[tid] - Pnew * 1.4426950408889634f) * 0.08838834764831845f;
        f32x16 o[4];
#pragma unroll
        for (int cb = 0; cb < 4; ++cb) o[cb] = (f32x16){};
        float den = 0.f;
        if (c > 0) {
#pragma unroll
            for (int cb = 0; cb < 4; ++cb) {
#pragma unroll
                for (int ks = 0; ks < 8; ++ks) { const unsigned ch = (unsigned)(2 * ks + hi) ^ xr;
                    const bf16x8 cfr = *(const LAS bf16x8*)(Ct + 256u * (32 * cb + r32) + 16u * ch);
                    const bf16x8 qv = QFRAG(ks);
                    o[cb] = __builtin_amdgcn_mfma_f32_32x32x16_bf16(cfr, qv, o[cb], 0, 0, 0); }
                __builtin_amdgcn_sched_barrier(0); }
            const float fst = fast_exp2(Prun * 1.4426950408889634f - Aq2);
#pragma unroll
            for (int cb = 0; cb < 4; ++cb)
#pragma unroll
                for (int r = 0; r < 16; ++r) o[cb][r] *= fst;
            float dq = 0.f;
#pragma unroll
            for (int ks = 0; ks < 8; ++ks) { const bf16x8 qv = QFRAG(ks);
#pragma unroll
                for (int q = 0; q < 4; ++q) { const unsigned w = ((const unsigned*)&qv)[q]; const int d = 16 * ks + 8 * hi + 2 * q; dq += bf_lo(w) * nC[d] + bf_hi(w) * nC[d + 1]; } }
            den = fst * dq;
#pragma unroll
            for (int r = 0; r < 16; ++r) { cacc[0][r] *= scC; cacc[1][r] *= scC; }
        }
        nrun *= scC;
#pragma unroll 1
        for (int j = 0; j < 4; ++j) {
            WAIT_ALL_BAR();
            const LAS unsigned char* Kt = lds + (j & 1) * 32768; const LAS unsigned char* Vt = Kt + 16384;
            if (j + 1 < 4) { LAS unsigned char* nb = lds + ((j + 1) & 1) * 32768; tile_dma(Kg + (size_t)(j + 1) * 64 * NP, nb, wave, lane); tile_dma(Vg + (size_t)(j + 1) * 64 * NP, nb + 16384, wave, lane); }
            const bool doit = (64 * j <= 32 * wave + 31);
            if (doit) {
                float ps = 0.f;
#pragma unroll
                for (int hf = 0; hf < 2; ++hf) {
                    f32x16 pp0 = (f32x16){};
#pragma unroll
                    for (int ks = 0; ks < 8; ++ks) { const unsigned ch = (unsigned)(2 * ks + hi) ^ xr;
                        const bf16x8 k0 = *(const LAS bf16x8*)(Kt + 256u * (32 * hf + r32) + 16u * ch);
                        const bf16x8 qv = QFRAG(ks);
                        pp0 = __builtin_amdgcn_mfma_f32_32x32x16_bf16(k0, qv, pp0, 0, 0, 0); }
#pragma unroll
                    for (int r = 0; r < 16; ++r) { const int kv = 64 * j + 32 * hf + crow(r, hi);
                        const float w0 = (kv <= qloc) ? fast_exp2(as[kv] - Aq2) * 0.08838834764831845f : 0.f;
                        pp0[r] *= w0; ps += pp0[r]; }
                    bf16x8 pfh[2];
#pragma unroll
                    for (int k2 = 0; k2 < 2; ++k2) { u32x4 w;
#pragma unroll
                        for (int q = 0; q < 4; ++q) { const int r = 8 * k2 + 2 * q; w[q] = cvt_pk_bf16(pp0[r], pp0[r + 1]); }
                        pfh[k2] = __builtin_bit_cast(bf16x8, w); }
                    __builtin_amdgcn_sched_barrier(0);
#pragma unroll
                    for (int k2 = 0; k2 < 2; ++k2)
#pragma unroll
                        for (int c2 = 0; c2 < 2; ++c2) {
                            bf16x8 vf[2];
#pragma unroll
                            for (int u = 0; u < 2; ++u) { const int cb = 2 * c2 + u; const unsigned chv = (unsigned)(4 * cb + 2 * blk + (pp >> 1)); const unsigned row0 = 16u * (2 * hf + k2) + 4u * hi + q4;
                                vf[u] = cat8(vtr(Vt + off_b(row0, chv) + 8u * (pp & 1)), vtr(Vt + off_b(row0 + 8u, chv) + 8u * (pp & 1))); }
                            o[2 * c2] = __builtin_amdgcn_mfma_f32_32x32x16_bf16(vf[0], pfh[k2], o[2 * c2], 0, 0, 0); o[2 * c2 + 1] = __builtin_amdgcn_mfma_f32_32x32x16_bf16(vf[1], pfh[k2], o[2 * c2 + 1], 0, 0, 0);
                            __builtin_amdgcn_sched_barrier(0);
                        }
                }
                den += ps;
            }
#pragma unroll
            for (int ks = 0; ks < 4; ++ks) {
                const unsigned row0 = 16u * ks + 8u * hi + q4, row1 = row0 + 4u;
                const unsigned cha = (unsigned)(4 * eb + 2 * blk + (pp >> 1));
                const bf16x8 af = cat8(vtr(Vt + off_b(row0, cha) + 8u * (pp & 1)), vtr(Vt + off_b(row1, cha) + 8u * (pp & 1)));
                const f32x4 wa = *(const LAS f32x4*)(wsc + 64 * j + 16 * ks + 8 * hi), wb = *(const LAS f32x4*)(wsc + 64 * j + 16 * ks + 8 * hi + 4);
#pragma unroll
                for (int db = 0; db < 2; ++db) { const unsigned chb = (unsigned)(4 * (2 * dh + db) + 2 * blk + (pp >> 1));
                    const s16x4 k0 = vtr(Kt + off_b(row0, chb) + 8u * (pp & 1)), k1 = vtr(Kt + off_b(row1, chb) + 8u * (pp & 1));
                    const u32x2 u0 = __builtin_bit_cast(u32x2, k0), u1 = __builtin_bit_cast(u32x2, k1);
                    u32x4 kw; kw.x = cvt_pk_bf16(bf_lo(u0.x) * wa[0], bf_hi(u0.x) * wa[1]); kw.y = cvt_pk_bf16(bf_lo(u0.y) * wa[2], bf_hi(u0.y) * wa[3]);
                    kw.z = cvt_pk_bf16(bf_lo(u1.x) * wb[0], bf_hi(u1.x) * wb[1]); kw.w = cvt_pk_bf16(bf_lo(u1.y) * wb[2], bf_hi(u1.y) * wb[3]);
                    cacc[db] = __builtin_amdgcn_mfma_f32_32x32x16_bf16(af, __builtin_bit_cast(bf16x8, kw), cacc[db], 0, 0, 0); }
                __builtin_amdgcn_sched_barrier(0);
            }
            { const int d = tid & 127, sq = tid >> 7; float sN = 0.f;
#pragma unroll 4
                for (int s2 = 0; s2 < 16; ++s2) { const int srow = 16 * sq + s2; const unsigned short hv = *(const LAS unsigned short*)(Kt + off_b(srow, d >> 3) + (d & 7) * 2); sN += __uint_as_float((unsigned)hv << 16) * wsc[64 * j + srow]; }
                nrun += sN; }
            WAIT_ALL_BAR();
        }
        int tid2 = tid_; asm volatile("" : "+v"(tid2));
        const int qloc2 = 32 * wave + (tid2 & 31), hi2 = (tid2 >> 5) & 1;
        const float BAq = SBA[qloc2];
        den += __shfl_xor(den, 32);
        const float dinv = 1.0f / fmaxf(fabsf(den), __expf(-BAq));
        float sm = 0.f;
#pragma unroll
        for (int cb = 0; cb < 4; ++cb)
#pragma unroll
            for (int r = 0; r < 16; ++r) { o[cb][r] *= dinv; sm += o[cb][r]; }
        sm += __shfl_xor(sm, 32);
        const float mu = sm * (1.0f / 128.0f);
        float vs = 0.f;
#pragma unroll
        for (int cb = 0; cb < 4; ++cb)
#pragma unroll
            for (int r = 0; r < 16; ++r) { o[cb][r] -= mu; vs += o[cb][r] * o[cb][r]; }
        vs += __shfl_xor(vs, 32);
        const float rstd = 1.0f / sqrtf(vs * (1.0f / 128.0f) + NORM_EPS);
        const bf16_t* mo = P + (t0 + qloc2) * NP + P_MO + hd * 128 + 4 * hi2;
        bf16_t* orow = CAT + (t0 + qloc2) * D + hd * 128 + 4 * hi2;
#pragma unroll
        for (int c2 = 0; c2 < 2; ++c2) {
            u32x2 mw[8];
#pragma unroll
            for (int u = 0; u < 8; ++u) mw[u] = *(const u32x2*)(mo + 32 * (2 * c2 + (u >> 2)) + 8 * (u & 3));
#pragma unroll
            for (int u = 0; u < 8; ++u) { const int cb = 2 * c2 + (u >> 2), rq = u & 3; const int e0 = 32 * cb + 8 * rq; const u32x2 m2 = mw[u]; const f32x4 hv = *(const LAS f32x4*)(hnl + e0 + 4 * hi2);
                const float g0 = fast_rcp(1.0f + fast_exp2(-1.4426950408889634f * bf_lo(m2.x))), g1 = fast_rcp(1.0f + fast_exp2(-1.4426950408889634f * bf_hi(m2.x))), g2 = fast_rcp(1.0f + fast_exp2(-1.4426950408889634f * bf_lo(m2.y))), g3 = fast_rcp(1.0f + fast_exp2(-1.4426950408889634f * bf_hi(m2.y)));
                u32x2 w; w.x = cvt_pk_bf16(o[cb][4 * rq] * rstd * hv[0] * g0, o[cb][4 * rq + 1] * rstd * hv[1] * g1); w.y = cvt_pk_bf16(o[cb][4 * rq + 2] * rstd * hv[2] * g2, o[cb][4 * rq + 3] * rstd * hv[3] * g3);
                *(u32x2*)(orow + e0) = w; }
            __builtin_amdgcn_sched_barrier(0); }
        if (c + 1 < NCH) {
#pragma unroll
            for (int db = 0; db < 2; ++db)
#pragma unroll
                for (int r = 0; r < 16; ++r) { const int e = 32 * eb + crow(r, hi), d = 64 * dh + 32 * db + r32;
                    *(LAS unsigned short*)(Ct + off_b(e, d >> 3) + (d & 7) * 2) = (unsigned short)(cvt_pk_bf16(cacc[db][r], 0.f) & 0xffffu); }
            wsc[tid] = nrun;
        }
        Prun = Pnew;
        WAIT_ALL_BAR();
        if (c + 1 < NCH) { if (tid < 128) nC[tid] = (wsc[tid] + wsc[tid + 128]) + (wsc[tid + 256] + wsc[tid + 384]); }
    }
#undef QFRAG
}

__device__ __forceinline__ int moe_table(LAS unsigned char* lds, unsigned* cnt, int tid) {
    LAS int* misc = (LAS int*)(lds + MISC_OFF);
    __syncthreads();
    if (tid == 0) { int acc = 0; for (int e = 0; e < 16; ++e) { const int c = (int)__hip_atomic_load(cnt + e * 64, __ATOMIC_RELAXED, __HIP_MEMORY_SCOPE_AGENT); misc[MW_CN + e] = c; misc[MW_TB + e] = acc; acc += (c + 255) >> 8; } misc[MW_TB + 16] = acc; }
    __syncthreads();
    return misc[MW_TB + 16];
}

#ifndef STAGGER_MASK
#define STAGGER_MASK 0u
#endif
#ifndef STAGGER_GROUPS
#define STAGGER_GROUPS 4
#endif
#ifndef STAGGER_TICKS
#define STAGGER_TICKS 700
#endif
__device__ __forceinline__ void stagger(int vcu, int phase_bit) {
    if (!((STAGGER_MASK >> phase_bit) & 1u)) return;
    const int g = vcu & (STAGGER_GROUPS - 1); if (g == 0) return;
    const unsigned long long t0 = __builtin_amdgcn_s_memrealtime(); const unsigned long long w = (unsigned long long)g * STAGGER_TICKS;
    while (__builtin_amdgcn_s_memrealtime() - t0 < w) __builtin_amdgcn_s_sleep(8);
}
constexpr int LATE_UNITS = 224, LATE_UNITS_A = 160, LATE_UNITS_B = 64, CW_LATEQ = CW_QUEUE + 64 * 8;
template <int QID>
__device__ __forceinline__ void late_convert(const Params& p, LAS unsigned char* lds, unsigned* ctl, int quota, int tid, int wave, int lane) {
    volatile LAS unsigned* misc = (volatile LAS unsigned*)(lds + MISC_OFF);
    for (int k = 0; k < quota; ++k) {
        __syncthreads();
        if (tid == 0) misc[MW_Q] = __hip_atomic_fetch_add(ctl + CW_LATEQ + 64 * QID, 1u, __ATOMIC_RELAXED, __HIP_MEMORY_SCOPE_AGENT);
        __syncthreads();
        const int q = (int)misc[MW_Q];
        if (q >= 4 * (QID == 0 ? LATE_UNITS_A : LATE_UNITS_B)) break;
        const int c = q >> 2, sub = q & 3;
        const int v = QID == 0 ? (c < 32 ? 8 + c : 232 + 12 * ((c - 32) >> 3) + ((c - 32) & 7)) : 232 + 12 * (c >> 2) + 8 + (c & 3);
        const int f = WT_I1 + 64 * v + 16 * sub + 2 * wave;
        phase_prologue_weights(p, lds, f, f + 2, 1, wave, lane);
    }
    __syncthreads();
}
template <int LAYER>
__device__ __forceinline__ void moe_block(const Params& p, LAS unsigned char* lds, const XcdBarrier& bar, unsigned* ctl, int tid, int wave, int lane, int vcu, int G) {
    unsigned char* ws = p.ws;
    const LAS int* tb = (const LAS int*)(lds + MISC_OFF) + MW_TB; const LAS int* cn = (const LAS int*)(lds + MISC_OFF) + MW_CN;
    unsigned* cnt = ctl + CW_CNT + LAYER * 16 * 64;
    if (PH(12)) phase_router(p, lds, tid, wave, G, p.in[3] + LAYER * D, p.in[18] + (size_t)LAYER * D * 4, p.in[19] + LAYER * 4, p.in[20] + (size_t)LAYER * D * 16, p.in[21] + LAYER * 16, cnt);
    xcd_barrier(bar);
    const int ntot = moe_table(lds, cnt, tid);
    stagger(vcu, 13);
    for (int rep_ = 0; rep_ < REPS(13); ++rep_) if (PH(13)) { pg8::MoeSched<true> S{(const char*)(ws + WS_XB8), (const char*)(ws + WS_WGU) + (size_t)LAYER * 16 * 1024 * 1024, 512, (size_t)1024 * 1024, tb, cn, (const unsigned*)(ws + WS_ROWTOK), ntot, vcu, G};
      pg8::EpiPair<1> E{nullptr, (bf16_t*)(ws + WS_HM), FF, (const float*)(ws + WS_RSRAW), (const unsigned*)(ws + WS_ROWTOK), tb, cn};
      pg8::gemm_phase<pg8::EpiPair<1>, pg8::MoeSched<true>, true, true>(lds, 512, S, E); }
    const int nun = ntot * 4, rounds_max = (nun + G - 1) / G, rounds_mine = nun > vcu ? (nun - vcu + G - 1) / G : 0;
    if (LATE_CV && LAYER == 0 && PH(0)) late_convert<0>(p, lds, ctl, 2 * (rounds_max - rounds_mine), tid, wave, lane);
    if (LATE_CV && LAYER == 1 && PH(0)) { late_convert<1>(p, lds, ctl, 2 * (rounds_max - rounds_mine), tid, wave, lane); late_convert<1>(p, lds, ctl, 1 << 20, tid, wave, lane); }
    xcd_barrier(bar);
    stagger(vcu, 14);
    for (int rep_ = 0; rep_ < REPS(14); ++rep_) if (PH(14)) { pg8::MoeSched<false> S{(const char*)(ws + WS_HM), (const char*)(ws + WS_WD) + (size_t)LAYER * 16 * 1024 * 512, 256, (size_t)1024 * 512, tb, cn, nullptr, ntot, vcu, G};
      pg8::EpiDown E{(unsigned char*)(ws + WS_YC), (const float*)(ws + WS_CWRAW), tb, cn};
      pg8::gemm_phase<pg8::EpiDown, pg8::MoeSched<false>, false, true>(lds, 256, S, E); }
    if (LATE_CV && LAYER == 0 && PH(0)) { late_convert<0>(p, lds, ctl, rounds_max - rounds_mine, tid, wave, lane); late_convert<0>(p, lds, ctl, 1 << 20, tid, wave, lane); }
    xcd_barrier(bar);
}

__global__ void __launch_bounds__(NTHR, 2) fwd_kernel(Params p) {
    extern __shared__ __attribute__((aligned(16))) unsigned char lds_raw[];
    LAS unsigned char* lds = (LAS unsigned char*)lds_raw;
    const int tid = threadIdx.x, lane = tid & 63, wave = __builtin_amdgcn_readfirstlane(tid >> 6);
    const int G = gridDim.x; const int bx = blockIdx.x;
    const int vcu = (G % 8 == 0) ? (bx % 8) * (G / 8) + bx / 8 : bx;
    const int gw = vcu * NWAVES + wave, NGW = G * NWAVES;
    volatile LAS unsigned* misc = (volatile LAS unsigned*)(lds + MISC_OFF);
    for (int u = tid; u < (LDS_BYTES - MISC_OFF) / 4; u += NTHR) misc[u] = 0u;
    __syncthreads();
    unsigned* ctl = (unsigned*)(p.ws + WS_CTL);
    XcdBarrier bar = xcd_barrier_post(ctl + CW_BAR, misc + MW_BAR);
    unsigned char* ws = p.ws;

    for (int rep_ = 0; rep_ < REPS(0); ++rep_) if (PH(0)) phase_prologue_weights(p, lds, gw, WT_I1, NGW, wave, lane);
    __syncthreads();
    for (int rep_ = 0; rep_ < REPS(1); ++rep_) if (PH(1)) phase_norm_gates(p, lds, tid, gw, NGW, lane);
    xcd_barrier(bar);

    if (PH(2)) phase_gate_scan(p, gw, NGW, lane);
    stagger(vcu, 3);
    for (int rep_ = 0; rep_ < REPS(3); ++rep_) if (PH(3)) { pg8::DenseSched S; S.init(ws + WS_H, ws + WS_WT1, T, NP, 1024, G, bx); pg8::EpiBf16 E{(bf16_t*)(ws + WS_P), NP};
      pg8::gemm_phase<pg8::EpiBf16, pg8::DenseSched, false>(lds, 1024, S, E); }
    xcd_barrier(bar);

    {
        constexpr int NSEQ = NBATCH * 4, NAT = NBATCH * 4 * 16, NMEM = LATE_CV ? WT_UNITS - LATE_UNITS : WT_UNITS;
        for (int u = bx; u < NSEQ; u += G) { for (int r2 = 0; r2 < REPS(16); ++r2) if (PH(4)) mlstm_seq_unit(p, lds, u, tid, wave, lane); }
        for (int rep_ = 0; rep_ < REPS(4); ++rep_) {
            bool a_done = false, m_done = false; int sa_cnt = 0, sm_cnt = 0; (void)sa_cnt; (void)sm_cnt;
            for (int it = 0; !(a_done && m_done); ++it) {
                const int r5 = it % 5; bool want_mem = (r5 == 1 || r5 == 3);
                if (want_mem && m_done) want_mem = false; else if (!want_mem && a_done) want_mem = true;
                __syncthreads();
#ifdef STATIC_Q
                if (tid == 0) { misc[MW_Q] = (unsigned)((want_mem ? sm_cnt : sa_cnt) * G + bx); }
                if (want_mem) ++sm_cnt; else ++sa_cnt;
#else
                if (tid == 0) misc[MW_Q] = __hip_atomic_fetch_add(ctl + CW_QUEUE + 64 * (2 * rep_ + (want_mem ? 1 : 0)), 1u, __ATOMIC_RELAXED, __HIP_MEMORY_SCOPE_AGENT);
#endif
                __syncthreads();
                const int u = (int)misc[MW_Q];
                if (want_mem) {
                    if (u >= NMEM) { m_done = true; continue; }
                    { const int v = LATE_CV ? (u < 8 ? u : u + 32) : u;        for (int r2 = 0; r2 < REPS(18); ++r2) if (PH(0)) { const int f = WT_I1 + 64 * v + 8 * wave; phase_prologue_weights(p, lds, f, f + 8, 1, wave, lane); } }
                } else {
                    if (u >= NAT) { a_done = true; continue; }
                    for (int r2 = 0; r2 < REPS(17); ++r2) if (PH(5)) attn_unit(p, lds, u & 127, 15 - (u >> 7), tid, wave, lane);
                }
            }
        }
    }
    xcd_barrier(bar);

    for (int rep_ = 0; rep_ < REPS(7); ++rep_) if (PH(7)) { pg8::DenseSched S; S.init(ws + WS_CAT, ws + WS_WT2, T, 1024, 1024, G, bx); pg8::EpiResid<true> E{p.in[0], (bf16_t*)(ws + WS_XB), ws + WS_XB8};
      pg8::gemm_phase<pg8::EpiResid<true>, pg8::DenseSched, false>(lds, 1024, S, E); }
    xcd_barrier(bar);

    moe_block<0>(p, lds, bar, ctl, tid, wave, lane, vcu, G);
    if (PH(8)) phase_rows<0, true>(p, lds, tid, wave, lane, G, p.in[2] + D, nullptr, nullptr, nullptr, nullptr, ctl + CW_CNT, nullptr);
    xcd_barrier(bar);
    stagger(vcu, 9);
    for (int rep_ = 0; rep_ < REPS(9); ++rep_) if (PH(9)) { pg8::DenseSched S; S.init(G3_F8 ? ws + WS_XB8 : ws + WS_XB, ws + WS_WT3, T, 3072, G3_F8 ? 512 : 1024, G, bx); pg8::EpiPair<0> E{(bf16_t*)(ws + WS_BG), (bf16_t*)(ws + WS_Z), D, (const float*)(ws + WS_RSTD), nullptr, nullptr, nullptr};
      pg8::gemm_phase<pg8::EpiPair<0>, pg8::DenseSched, false, G3_F8 != 0>(lds, G3_F8 ? 512 : 1024, S, E); }
    xcd_barrier(bar);
    for (int rep_ = 0; rep_ < REPS(10); ++rep_) if (PH(10)) phase_conv(p, gw, NGW, lane);
    xcd_barrier(bar);
    if (PH(11)) { pg8::DenseSched S; S.init(ws + WS_CAT, ws + WS_WT4, T, 1024, 1024, G, bx); pg8::EpiResid<false> E{nullptr, (bf16_t*)(ws + WS_XB), ws + WS_XB8};
      pg8::gemm_phase<pg8::EpiResid<false>, pg8::DenseSched, false>(lds, 1024, S, E); }
    xcd_barrier(bar);
    moe_block<1>(p, lds, bar, ctl, tid, wave, lane, vcu, G);
    if (PH(15)) phase_rows<2, true>(p, lds, tid, wave, lane, G, p.in[4], nullptr, nullptr, nullptr, nullptr, ctl + CW_CNT + 16 * 64, nullptr);
}

extern "C" void kernel_launch(void* const* d_in, const int* in_sizes, int n_in, void* d_out, int out_size, void* d_ws, size_t ws_size, hipStream_t stream) {
    static int grid = 0;
    if (grid == 0) {
        if (n_in != 25 || in_sizes[0] != T * D || out_size != T * D || ws_size < WS_END) { fprintf(stderr, "kernel_launch: unexpected shapes (n_in %d, in0 %d, out %d, ws %zu)\n", n_in, n_in > 0 ? in_sizes[0] : -1, out_size, ws_size); grid = -1; return; }
        int dev = 0, cus = 0, per_cu = 0;
        if (hipGetDevice(&dev) != hipSuccess || hipDeviceGetAttribute(&cus, hipDeviceAttributeMultiprocessorCount, dev) != hipSuccess) { grid = -1; return; }
        if (hipFuncSetAttribute((const void*)fwd_kernel, hipFuncAttributeMaxDynamicSharedMemorySize, LDS_BYTES) != hipSuccess) { fprintf(stderr, "kernel_launch: hipFuncSetAttribute failed\n"); grid = -1; return; }
        if (hipOccupancyMaxActiveBlocksPerMultiprocessor(&per_cu, (const void*)fwd_kernel, NTHR, LDS_BYTES) != hipSuccess || per_cu < 1) fprintf(stderr, "kernel_launch: occupancy query reports %d\n", per_cu);
        (void)hipGetLastError();
        grid = cus;
    }
    if (grid < 0) return;
    hipMemsetAsync((char*)d_ws + WS_CTL, 0, CTL_ZERO_BYTES, stream);
    Params p{};
    for (int i = 0; i < 25; ++i) p.in[i] = (const float*)d_in[i];
    p.out = (float*)d_out; p.ws = (unsigned char*)d_ws;
    hipLaunchKernelGGL(fwd_kernel, dim3(grid), dim3(NTHR), LDS_BYTES, stream, p);
}
```

```cpp
#include <hip/hip_runtime.h>
#include <cstdio>
#include <cstdint>
#ifndef PHASE_MASK
#define PHASE_MASK 0xffffffffu
#endif
#define PH(k) (((PHASE_MASK) >> (k)) & 1u)
#ifndef PHASE_TWICE
#define PHASE_TWICE 0u
#endif
#define REPS(k) (1 + (int)(((PHASE_TWICE) >> (k)) & 1u))

#define LAS __attribute__((address_space(3)))
#define GAS __attribute__((address_space(1)))
typedef unsigned short bf16_t;
typedef short bf16x8 __attribute__((ext_vector_type(8)));
typedef short s16x4 __attribute__((ext_vector_type(4)));
typedef float f32x4 __attribute__((ext_vector_type(4)));
typedef float f32x2 __attribute__((ext_vector_type(2)));
typedef float f32x16 __attribute__((ext_vector_type(16)));
typedef unsigned u32x4 __attribute__((ext_vector_type(4)));
typedef unsigned u32x2 __attribute__((ext_vector_type(2)));
typedef GAS unsigned gu32;
typedef int i32x8 __attribute__((ext_vector_type(8)));
typedef int i32x4 __attribute__((ext_vector_type(4)));

constexpr int D = 1024, NBATCH = 32, SEQ = 2048, T = NBATCH * SEQ;
constexpr int EVEN_IN = 3592, NP = 3584;
constexpr int P_MQ = 0, P_MK = 512, P_MV = 1024, P_MO = 1536, P_DQ = 2048, P_DK = 2560, P_DV = 3072;
constexpr int NE = 16, FF = 512;
constexpr int ECAP = 65536;
constexpr float NORM_EPS = 1e-6f;
constexpr int NWAVES = 8, NTHR = 512;
constexpr int MCH = 256, NCH = SEQ / MCH;
constexpr int WT_I1 = 16 * 112, WT_ITEMS = 28928, WT_UNITS = (WT_ITEMS - WT_I1) / 64;

constexpr size_t MiB = 1u << 20;
constexpr size_t WS_CTL = 0, CTL_ZERO_BYTES = 1 * MiB;
constexpr size_t WS_WT1 = 1 * MiB, WS_WT2 = 8 * MiB, WS_WT3 = 10 * MiB, WS_WT4 = 16 * MiB, WS_WGU = 18 * MiB, WS_WD = 82 * MiB;
constexpr size_t WS_GATES = 114 * MiB, WS_SA = 116 * MiB, WS_SAM = 117 * MiB, WS_SBA = 118 * MiB, WS_UN = 119 * MiB, WS_UR = 119 * MiB + 768 * 1024;
constexpr size_t WS_UT = 120 * MiB;
constexpr size_t WS_ROWTOK = 184 * MiB, WS_CWRAW = 188 * MiB, WS_TOKINFO = 192 * MiB, WS_RSTD = 193 * MiB;
constexpr size_t WS_H = 194 * MiB, WS_CAT = 322 * MiB, WS_P = 450 * MiB;
constexpr size_t WS_RSRAW = 120 * MiB;
constexpr size_t WS_XB8 = 720 * MiB;
constexpr size_t WS_XB = WS_H;
constexpr size_t WS_BG = WS_P, WS_Z = WS_P + 128 * MiB, WS_HM = WS_P, WS_YC = WS_P + 136 * MiB;
constexpr size_t WS_END = 898 * MiB;
constexpr int CW_BAR = 4096;
constexpr int CW_CNT = 16384;
constexpr int CW_QUEUE = 32768;

__device__ __forceinline__ unsigned cvt_pk_bf16(float lo, float hi) { unsigned r; asm volatile("v_cvt_pk_bf16_f32 %0, %1, %2" : "=v"(r) : "v"(lo), "v"(hi)); return r; }
__device__ __forceinline__ unsigned cvt_pk4_fp8(float a, float b, float c, float d) { unsigned w = 0; w = (unsigned)__builtin_amdgcn_cvt_pk_fp8_f32(a, b, (int)w, false); w = (unsigned)__builtin_amdgcn_cvt_pk_fp8_f32(c, d, (int)w, true); return w; }
#ifndef LATE_CV
#define LATE_CV 1
#endif
#ifndef G3_F8
#define G3_F8 1
#endif
constexpr float F8_WSCALE = 64.0f, F8_HSCALE = 16.0f, F8_YSCALE = 64.0f;
__device__ __forceinline__ float bf_lo(unsigned w) { return __uint_as_float(w << 16); }
__device__ __forceinline__ float bf_hi(unsigned w) { return __uint_as_float(w & 0xffff0000u); }
__device__ __forceinline__ float wave_sum(float v) {
#pragma unroll
    for (int o = 1; o < 64; o <<= 1) v += __shfl_xor(v, o);
    return v;
}
__device__ __forceinline__ float fast_exp2(float x) { return __builtin_amdgcn_exp2f(x); }
__device__ __forceinline__ float fast_rcp(float x) { return __builtin_amdgcn_rcpf(x); }
__device__ __forceinline__ int crow(int r, int hi) { return (r & 3) + 8 * (r >> 2) + 4 * hi; }
__device__ __forceinline__ unsigned off_b(unsigned row, unsigned ch) { return 256u * row + 16u * (ch ^ (((row & 3u) << 2) | ((row >> 2) & 3u))); }
__device__ __forceinline__ s16x4 vtr(const LAS unsigned char* p) { return __builtin_bit_cast(s16x4, __builtin_amdgcn_ds_read_tr16_b64_v4i16((LAS s16x4*)p)); }
__device__ __forceinline__ bf16x8 cat8(s16x4 a, s16x4 b) { return (bf16x8){a[0], a[1], a[2], a[3], b[0], b[1], b[2], b[3]}; }

#define XB_TMO      128
#define XB_XCNT(j)  (256  + 64 * (j))
#define XB_XSUB(j)  (1280 + 64 * (j))
#define XB_XGEN(j)  (2304 + 64 * (j))
#define XB_TOP      3328
#define XB_TOPGEN   3392
#define XCD_BAR_WORDS 3456
#define XB_SPIN_CAP (1u << 18)
__device__ __forceinline__ unsigned xb_ld(unsigned* p)              { return __hip_atomic_load(p, __ATOMIC_RELAXED, __HIP_MEMORY_SCOPE_AGENT); }
__device__ __forceinline__ unsigned xb_add(unsigned* p, unsigned v) { return __hip_atomic_fetch_add(p, v, __ATOMIC_RELAXED, __HIP_MEMORY_SCOPE_AGENT); }
__device__ __forceinline__ unsigned xb_xcc_id() { return (unsigned)__builtin_amdgcn_s_getreg((3 << 11) | 20) & 0xFu; }
#define XB_SPIN(cond, bar) do { unsigned _sp = 0; while (cond) { __builtin_amdgcn_s_sleep(1); \
    if ((++_sp & 255u) == 0u) { if (xb_ld(&(bar)[XB_TMO])) break; if (_sp > XB_SPIN_CAP) { atomicAdd(&(bar)[XB_TMO], 1u); break; } } } } while (0)
struct XcdBarrier { unsigned* bar; unsigned x; volatile LAS unsigned* st; };
__device__ __forceinline__ XcdBarrier xcd_barrier_post(unsigned* bar, volatile LAS unsigned* st) {
    XcdBarrier b; b.bar = bar; b.x = xb_xcc_id(); b.st = st;
    if (threadIdx.x == 0) (void)xb_add(&bar[XB_XCNT(b.x)], 1u);
    return b;
}
__device__ __forceinline__ void xcd_barrier_complete(unsigned* bar, unsigned x, unsigned& nloc, unsigned& nx) {
    const unsigned G = gridDim.x * gridDim.y * gridDim.z;
    unsigned sum, cnt, mine, sp = 0u;
    for (;;) {
        sum = 0u; cnt = 0u; mine = 0u;
#pragma unroll
        for (unsigned j = 0; j < 16; ++j) { const unsigned c = xb_ld(&bar[XB_XCNT(j)]); sum += c; cnt += (c > 0u) ? 1u : 0u; mine = (j == x) ? c : mine; }
        if (sum == G) break;
        __builtin_amdgcn_s_sleep(1);
        if ((++sp & 255u) == 0u) { if (xb_ld(&bar[XB_TMO])) break; if (sp > XB_SPIN_CAP) { atomicAdd(&bar[XB_TMO], 1u); break; } }
    }
    nloc = mine > 0u ? mine : 1u; nx = cnt > 0u ? cnt : 1u;
}
__device__ __forceinline__ void xcd_barrier(const XcdBarrier& b) {
    asm volatile("s_waitcnt vmcnt(0)" ::: "memory");
    __syncthreads();
    if (threadIdx.x == 0) {
        unsigned* bar = b.bar;
        __builtin_amdgcn_s_waitcnt(0);
        unsigned nloc = b.st[0], nx = b.st[1];
        if (nloc == 0u) { xcd_barrier_complete(bar, b.x, nloc, nx); b.st[0] = nloc; b.st[1] = nx; }
        const unsigned old = xb_add(&bar[XB_XSUB(b.x)], 1u);
        const unsigned gen = old / nloc;
        if (old + 1u == (gen + 1u) * nloc) {
            __builtin_amdgcn_fence(__ATOMIC_RELEASE, "agent");
            asm volatile("s_waitcnt vmcnt(0)" ::: "memory");
            const unsigned og = xb_add(&bar[XB_TOP], 1u);
            const unsigned tg = og / nx;
            if (og + 1u == (tg + 1u) * nx) xb_add(&bar[XB_TOPGEN], 1u);
            else XB_SPIN(xb_ld(&bar[XB_TOPGEN]) == tg, bar);
            __builtin_amdgcn_fence(__ATOMIC_ACQUIRE, "agent");
            xb_add(&bar[XB_XGEN(b.x)], 1u);
            asm volatile("s_waitcnt vmcnt(0)" ::: "memory");
        } else {
            XB_SPIN(xb_ld(&bar[XB_XGEN(b.x)]) == gen, bar);
            __builtin_amdgcn_fence(__ATOMIC_ACQUIRE, "agent");
            asm volatile("s_waitcnt vmcnt(0)" ::: "memory");
        }
    }
    __syncthreads();
}

namespace pg8 {
constexpr int BM = 256, BK = 64, HALF = 128, HTB = HALF * BK * 2, STAGE_BYTES = 8 * HTB, NXCD = 8, WGM = 8;
__device__ __forceinline__ int lds_byte(int r, int c) { const int st = (r >> 4) * 2 + (c >> 5), rr = r & 15, cc = c & 31, ob = rr * 64 + cc * 2; return st * 1024 + (ob ^ (((ob >> 9) & 1) << 5)); }
__device__ __forceinline__ void stage_rc(int b, int& R, int& C) { const int st = b / 1024, sb = b % 1024, swz = sb ^ (((sb >> 9) & 1) << 5); R = (st >> 1) * 16 + swz / 64; C = (st & 1) * 32 + (swz % 64) / 2; }
__device__ __forceinline__ int perm32(int rho) { const int n = rho >> 4, i = rho & 15; return 8 * (i >> 2) + 4 * n + (i & 3); }
struct Unit { int pm, pn; };

template <class Epi, class Sched, bool GATHER, bool F8 = false>
__device__ __forceinline__ void gemm_phase(LAS unsigned char* lds, const int K, const Sched& S, const Epi& E) {
    int tid = threadIdx.x; asm volatile("" : "+v"(tid));
    const int wid = __builtin_amdgcn_readfirstlane(tid >> 6), lane = tid & 63, wr = wid >> 2, wc = wid & 3, fr = lane & 15, fq = lane >> 4;
    const int nt = K / BK;
    int Rr[2], Cc[2]; unsigned voffB[2];
#pragma unroll
    for (int i = 0; i < 2; ++i) { stage_rc(tid * 16 + i * 8192, Rr[i], Cc[i]); const int Rb = Epi::PERM ? ((Rr[i] & ~31) + perm32(Rr[i] & 31)) : Rr[i];
        voffB[i] = (unsigned)(Rb * K + Cc[i]) * 2u; }
    const size_t kstep = (size_t)(BK * 2);
    const size_t hstep = (size_t)HALF * K * 2;
    const unsigned ldsw = (unsigned)wid * 1024u;
    const int aoff = lds_byte(wr * 64 + fr, fq * 8), boff = lds_byte(wc * 32 + fr, fq * 8);
#define PG8_SA(b, h) (((b) * 2 + (h)) * HTB)
#define PG8_SB(b, h) ((4 + (b) * 2 + (h)) * HTB)
#define PG8_STAGE(bufoff, gbase, voff) do { _Pragma("unroll") for (int _i = 0; _i < 2; ++_i) \
        __builtin_amdgcn_global_load_lds((const unsigned*)((const char*)(gbase) + (voff)[_i]), (LAS unsigned*)(lds + (bufoff) + ldsw + _i * 8192), 16, 0, 0); } while (0)
#define PG8_LD8(p) __builtin_shufflevector(*(const LAS i32x4*)(p), *(const LAS i32x4*)((p) + 1024), 0, 1, 2, 3, 4, 5, 6, 7)
#define PG8_LDA(dst, b, h) do { if constexpr (F8) { _Pragma("unroll") for (int m = 0; m < 4; ++m) dst##8[m] = PG8_LD8(lds + PG8_SA(b, h) + aoff + m * 2048); } \
        else { _Pragma("unroll") for (int m = 0; m < 4; ++m) _Pragma("unroll") for (int k = 0; k < 2; ++k) dst[m][k] = *(const LAS bf16x8*)(lds + PG8_SA(b, h) + aoff + m * 2048 + k * 1024); } } while (0)
#define PG8_LDB(dst, b, h) do { if constexpr (F8) { _Pragma("unroll") for (int n = 0; n < 2; ++n) dst##8[n] = PG8_LD8(lds + PG8_SB(b, h) + boff + n * 2048); } \
        else { _Pragma("unroll") for (int n = 0; n < 2; ++n) _Pragma("unroll") for (int k = 0; k < 2; ++k) dst[n][k] = *(const LAS bf16x8*)(lds + PG8_SB(b, h) + boff + n * 2048 + k * 1024); } } while (0)
#define PG8_CAT8(x0, x1) __builtin_shufflevector(__builtin_bit_cast(i32x4, x0), __builtin_bit_cast(i32x4, x1), 0, 1, 2, 3, 4, 5, 6, 7)
#define PG8_MMA(ai, bj, At, Bt) do { __builtin_amdgcn_s_setprio(1); _Pragma("unroll") for (int m = 0; m < 4; ++m) _Pragma("unroll") for (int n = 0; n < 2; ++n) { \
        if constexpr (F8) asm volatile("v_mfma_scale_f32_16x16x128_f8f6f4 %0, %1, %2, %0, %3, %3 op_sel_hi:[0,0,0]" : "+v"(acc[ai][bj][m][n]) : "v"(Bt##8[n]), "v"(At##8[m]), "v"(f8one)); \
        else { _Pragma("unroll") for (int k = 0; k < 2; ++k) acc[ai][bj][m][n] = __builtin_amdgcn_mfma_f32_16x16x32_bf16(Bt[n][k], At[m][k], acc[ai][bj][m][n], 0, 0, 0); } } __builtin_amdgcn_s_setprio(0); } while (0)
#define PG8_WAIT_V(n) asm volatile("s_waitcnt vmcnt(" #n ")" ::: "memory")
#define PG8_WAIT_L(n) asm volatile("s_waitcnt lgkmcnt(" #n ")" ::: "memory")
#define PG8_BAR __builtin_amdgcn_s_barrier()
#define PG8_SCHED __builtin_amdgcn_sched_barrier(0)
#define PG8_VOFF(dst, u) do { _Pragma("unroll") for (int _h = 0; _h < 2; ++_h) _Pragma("unroll") for (int _i = 0; _i < 2; ++_i) { \
        if constexpr (GATHER) dst[_h][_i] = S.arow(u, _h * HALF + Rr[_i]) * (unsigned)(K * 2) + (unsigned)(Cc[_i] * 2); \
        else dst[_h][_i] = (unsigned)((_h * HALF + Rr[_i]) * K + Cc[_i]) * 2u; } } while (0)
    Unit cur, nxt; int ui = 0;
    if (!S.next(0, cur)) return;
    f32x4 acc[2][2][4][2];
    if constexpr (Epi::PRELOAD) E.preload(acc, cur, wr, wc, fr, fq);
    else {
#pragma unroll
    for (int a = 0; a < 2; ++a)
#pragma unroll
        for (int b = 0; b < 2; ++b)
#pragma unroll
            for (int m = 0; m < 4; ++m)
#pragma unroll
                for (int n = 0; n < 2; ++n) acc[a][b][m][n] = (f32x4){0.f, 0.f, 0.f, 0.f};
    }
    float epf[2][4] = {{0.f, 0.f, 0.f, 0.f}, {0.f, 0.f, 0.f, 0.f}};
    bf16x8 At[4][2], B0[2][2], B1[2][2];
    i32x8 At8[4], B08[2], B18[2]; const unsigned f8one = 0x7f7f7f7fu;
    unsigned vA[2][2], vN[2][2];
    PG8_VOFF(vA, cur);
    if constexpr (Epi::PREFETCH) E.prefetch(epf, cur, wr, fr);
    const char* cA = S.abase(cur); const char* cB = S.bbase(cur);
    PG8_STAGE(PG8_SB(0, 0), cB, voffB); PG8_STAGE(PG8_SB(0, 1), cB + hstep, voffB); PG8_STAGE(PG8_SA(0, 0), cA, vA[0]); PG8_STAGE(PG8_SA(0, 1), cA, vA[1]);
    if (wr == 1) PG8_BAR;
    PG8_WAIT_V(2); PG8_BAR;
    PG8_STAGE(PG8_SB(1, 0), cB + kstep, voffB); PG8_STAGE(PG8_SA(1, 0), cA + kstep, vA[0]); PG8_STAGE(PG8_SB(1, 1), cB + hstep + kstep, voffB);
    PG8_WAIT_V(6); PG8_BAR;
    for (;;) {
        const bool has_next = S.next(ui + 1, nxt);
        const char* nA = has_next ? S.abase(nxt) : cA; const char* nB = has_next ? S.bbase(nxt) : cB;
        if constexpr (GATHER) { if (has_next) { PG8_VOFF(vN, nxt); } else {
#pragma unroll
            for (int h = 0; h < 2; ++h)
#pragma unroll
                for (int i = 0; i < 2; ++i) vN[h][i] = vA[h][i]; } }
#pragma unroll 1
        for (int t = 0; t < nt; t += 2) {
            const bool last = (t == nt - 2);
            const char* a1 = cA + (size_t)(t + 1) * kstep;
            const char* a2 = last ? nA : cA + (size_t)(t + 2) * kstep; const char* b2 = last ? nB : cB + (size_t)(t + 2) * kstep;
            const char* a3 = a2 + kstep; const char* b3 = b2 + kstep;
            unsigned v2[2][2]; const unsigned lmask = last ? 0xffffffffu : 0u;
#pragma unroll
            for (int h = 0; h < 2; ++h)
#pragma unroll
                for (int i = 0; i < 2; ++i) { if constexpr (GATHER) v2[h][i] = (vN[h][i] & lmask) | (vA[h][i] & ~lmask); else v2[h][i] = vA[h][i]; }
            PG8_LDB(B0, 0, 0); PG8_LDB(B1, 0, 1); PG8_SCHED; PG8_LDA(At, 0, 0); PG8_STAGE(PG8_SA(1, 1), a1, vA[1]);
            PG8_WAIT_V(8); PG8_WAIT_L(0); PG8_BAR; PG8_MMA(0, 0, At, B0); PG8_MMA(0, 1, At, B1); PG8_BAR; PG8_SCHED;
            PG8_LDA(At, 0, 1); PG8_STAGE(PG8_SB(0, 0), b2, voffB); PG8_STAGE(PG8_SB(0, 1), b2 + hstep, voffB); PG8_STAGE(PG8_SA(0, 0), a2, v2[0]);
            PG8_WAIT_V(8); PG8_WAIT_L(0); PG8_BAR; PG8_MMA(1, 0, At, B0); PG8_MMA(1, 1, At, B1); PG8_BAR; PG8_SCHED;
            PG8_LDB(B0, 1, 0); PG8_LDB(B1, 1, 1); PG8_SCHED; PG8_LDA(At, 1, 0); PG8_STAGE(PG8_SA(0, 1), a2, v2[1]);
            PG8_WAIT_V(8); PG8_WAIT_L(0); PG8_BAR; PG8_MMA(0, 0, At, B0); PG8_MMA(0, 1, At, B1); PG8_BAR; PG8_SCHED;
            PG8_LDA(At, 1, 1); PG8_STAGE(PG8_SB(1, 0), b3, voffB); PG8_STAGE(PG8_SB(1, 1), b3 + hstep, voffB); PG8_STAGE(PG8_SA(1, 0), a3, v2[0]);
            PG8_WAIT_V(8); PG8_WAIT_L(0); PG8_BAR; PG8_MMA(1, 0, At, B0); PG8_MMA(1, 1, At, B1); PG8_BAR; PG8_SCHED;
        }
        if (wr == 0) PG8_BAR;
        if constexpr (F8) asm volatile("s_nop 15\n\ts_nop 15" ::: "memory");
        if constexpr (Epi::PREFETCH) E(acc, cur, wr, wc, fr, fq, epf); else E(acc, cur, wr, wc, fr, fq);
        if (!has_next) break;
        if constexpr (Epi::PREFETCH) E.prefetch(epf, nxt, wr, fr);
        if constexpr (Epi::PRELOAD) E.preload(acc, nxt, wr, wc, fr, fq);
        else {
#pragma unroll
        for (int a = 0; a < 2; ++a)
#pragma unroll
            for (int b = 0; b < 2; ++b)
#pragma unroll
                for (int m = 0; m < 4; ++m)
#pragma unroll
                    for (int n = 0; n < 2; ++n) acc[a][b][m][n] = (f32x4){0.f, 0.f, 0.f, 0.f};
        }
        cur = nxt; cA = nA; cB = nB; ++ui;
        if constexpr (GATHER) {
#pragma unroll
        for (int h = 0; h < 2; ++h)
#pragma unroll
            for (int i = 0; i < 2; ++i) vA[h][i] = vN[h][i]; }
        if (wr == 1) PG8_BAR;
    }
    PG8_WAIT_V(0);
    PG8_BAR;
#undef PG8_SA
#undef PG8_SB
#undef PG8_STAGE
#undef PG8_LDA
#undef PG8_LD8
#undef PG8_LDB
#undef PG8_MMA
#undef PG8_CAT8
#undef PG8_WAIT_V
#undef PG8_WAIT_L
#undef PG8_BAR
#undef PG8_SCHED
#undef PG8_VOFF
}

struct DenseSched {
    const char* A; const char* Bt; int K; int nM, nN, nwg, G, c;
    __device__ __forceinline__ void init(const void* A_, const void* Bt_, int M, int N, int K_, int G_, int c_) { A = (const char*)A_; Bt = (const char*)Bt_; K = K_; nM = M / BM; nN = N / BM; nwg = nM * nN; G = G_; c = c_; }
    __device__ __forceinline__ bool next(int i, Unit& u) const {
        const long L = (long)i * G + c; if (L >= nwg) return false;
        int wgid = (int)L; { const int q = nwg / NXCD, r = nwg % NXCD, xcd = wgid % NXCD, off = wgid / NXCD; wgid = (xcd < r ? xcd * (q + 1) : r * (q + 1) + (xcd - r) * q) + off; }
        const int nig = WGM * nN, gid = wgid / nig, fm = gid * WGM, gsz = (nM - fm) < WGM ? (nM - fm) : WGM;
        u.pm = fm + ((wgid % nig) % gsz); u.pn = (wgid % nig) / gsz; return true;
    }
    __device__ __forceinline__ const char* abase(const Unit& u) const { return A + (size_t)u.pm * BM * K * 2; }
    __device__ __forceinline__ const char* bbase(const Unit& u) const { return Bt + (size_t)u.pn * BM * K * 2; }
    __device__ __forceinline__ unsigned arow(const Unit&, int) const { return 0u; }
};
template <bool GATHER_A>
struct MoeSched {
    const char* A; const char* W; int K; size_t wstride; const LAS int* tb; const LAS int* cn; const unsigned* rowtok; int ntot, vcu, G;
    __device__ __forceinline__ bool next(int i, Unit& u) const { const int L = i * G + vcu; if (L >= ntot * 4) return false; u.pm = L >> 2; u.pn = L & 3; return true; }
    __device__ __forceinline__ int expert(int pm) const { int e = 0;
#pragma unroll
        for (int j = 1; j < 16; ++j) e += (pm >= tb[j]) ? 1 : 0; return e; }
    __device__ __forceinline__ const char* abase(const Unit& u) const { return GATHER_A ? A : A + (size_t)u.pm * BM * K * 2; }
    __device__ __forceinline__ const char* bbase(const Unit& u) const { return W + (size_t)expert(u.pm) * wstride + (size_t)u.pn * BM * K * 2; }
    __device__ __forceinline__ unsigned arow(const Unit& u, int r) const { const int e = expert(u.pm); const int idx = (u.pm - tb[e]) * BM + r; return idx < cn[e] ? rowtok[(size_t)e * ECAP + idx] : 0u; }
};

struct EpiBf16 {
    static constexpr bool PERM = true, PRELOAD = false, PREFETCH = false;
    bf16_t* O; int ldc;
    __device__ __forceinline__ void operator()(const f32x4 (&acc)[2][2][4][2], const Unit& u, int wr, int wc, int fr, int fq) const {
        const int row0 = u.pm * BM + wr * 64 + fr, col0 = u.pn * BM + wc * 32 + 8 * fq;
#pragma unroll
        for (int ai = 0; ai < 2; ++ai)
#pragma unroll
            for (int m = 0; m < 4; ++m) { bf16_t* rowp = O + (size_t)(row0 + ai * HALF + m * 16) * ldc + col0;
#pragma unroll
                for (int bj = 0; bj < 2; ++bj) { const f32x4 v0 = acc[ai][bj][m][0], v1 = acc[ai][bj][m][1];
                    u32x4 w; w.x = cvt_pk_bf16(v0[0], v0[1]); w.y = cvt_pk_bf16(v0[2], v0[3]); w.z = cvt_pk_bf16(v1[0], v1[1]); w.w = cvt_pk_bf16(v1[2], v1[3]);
#ifdef EPI_NT
                    __builtin_nontemporal_store(w, (u32x4*)(rowp + bj * HALF));
#else
                    *(u32x4*)(rowp + bj * HALF) = w;
#endif
                } }
    }
};
template <bool XF32>
struct EpiResid {
    static constexpr bool PERM = true, PRELOAD = true, PREFETCH = false;
    const float* xin; bf16_t* XB; unsigned char* XB8;
    __device__ __forceinline__ void preload(f32x4 (&acc)[2][2][4][2], const Unit& u, int wr, int wc, int fr, int fq) const {
        const int row0 = u.pm * BM + wr * 64 + fr, col0 = u.pn * BM + wc * 32 + 8 * fq;
#pragma unroll
        for (int ai = 0; ai < 2; ++ai)
#pragma unroll
            for (int m = 0; m < 4; ++m) { const size_t off = (size_t)(row0 + ai * HALF + m * 16) * D + col0;
#pragma unroll
                for (int bj = 0; bj < 2; ++bj) {
                    if (XF32) { acc[ai][bj][m][0] = *(const f32x4*)(xin + off + bj * HALF); acc[ai][bj][m][1] = *(const f32x4*)(xin + off + bj * HALF + 4); }
                    else { const u32x4 w = *(const u32x4*)(XB + off + bj * HALF); acc[ai][bj][m][0] = (f32x4){bf_lo(w.x), bf_hi(w.x), bf_lo(w.y), bf_hi(w.y)}; acc[ai][bj][m][1] = (f32x4){bf_lo(w.z), bf_hi(w.z), bf_lo(w.w), bf_hi(w.w)}; } } }
    }
    __device__ __forceinline__ void operator()(const f32x4 (&acc)[2][2][4][2], const Unit& u, int wr, int wc, int fr, int fq) const {
        const int row0 = u.pm * BM + wr * 64 + fr, col0 = u.pn * BM + wc * 32 + 8 * fq;
#pragma unroll
        for (int ai = 0; ai < 2; ++ai)
#pragma unroll
            for (int m = 0; m < 4; ++m) { bf16_t* rowp = XB + (size_t)(row0 + ai * HALF + m * 16) * D + col0;
#pragma unroll
                for (int bj = 0; bj < 2; ++bj) { const f32x4 v0 = acc[ai][bj][m][0], v1 = acc[ai][bj][m][1];
                    u32x4 w; w.x = cvt_pk_bf16(v0[0], v0[1]); w.y = cvt_pk_bf16(v0[2], v0[3]); w.z = cvt_pk_bf16(v1[0], v1[1]); w.w = cvt_pk_bf16(v1[2], v1[3]);
                    *(u32x4*)(rowp + bj * HALF) = w;
                    u32x2 w8; w8.x = cvt_pk4_fp8(bf_lo(w.x), bf_hi(w.x), bf_lo(w.y), bf_hi(w.y)); w8.y = cvt_pk4_fp8(bf_lo(w.z), bf_hi(w.z), bf_lo(w.w), bf_hi(w.w));
                    *(u32x2*)(XB8 + (size_t)(row0 + ai * HALF + m * 16) * D + col0 + bj * HALF) = w8; } }
    }
};
template <int MODE  >
struct EpiPair {
    static constexpr bool PERM = true, PRELOAD = false, PREFETCH = true;
    bf16_t* O0; bf16_t* O1; int ld1;
    const float* rstd; const unsigned* rowtok; const LAS int* tb; const LAS int* cn;
    __device__ __forceinline__ void prefetch(float (&rs)[2][4], const Unit& u, int wr, int fr) const {
        const int row0 = u.pm * BM + wr * 64 + fr;
        if (MODE == 0) {
#pragma unroll
            for (int ai = 0; ai < 2; ++ai)
#pragma unroll
                for (int m = 0; m < 4; ++m) rs[ai][m] = rstd[row0 + ai * HALF + m * 16] * (G3_F8 ? 1.0f / F8_WSCALE : 1.0f);
        } else {
            int e = 0;
#pragma unroll
            for (int j = 1; j < 16; ++j) e += (u.pm >= tb[j]) ? 1 : 0;
            const int idx0 = (u.pm - tb[e]) * BM + wr * 64 + fr, cne = cn[e];
#pragma unroll
            for (int ai = 0; ai < 2; ++ai)
#pragma unroll
                for (int m = 0; m < 4; ++m) { const int idx = idx0 + ai * HALF + m * 16; rs[ai][m] = idx < cne ? rstd[(size_t)e * ECAP + idx] * (1.0f / F8_WSCALE) : 0.f; }
        }
    }
    __device__ __forceinline__ void operator()(const f32x4 (&acc)[2][2][4][2], const Unit& u, int wr, int wc, int fr, int fq, const float (&rs)[2][4]) const {
        const int row0 = u.pm * BM + wr * 64 + fr;
        if (MODE == 0 && u.pn < 4) {
            const int col0 = u.pn * BM + wc * 32 + 8 * fq;
#pragma unroll
            for (int ai = 0; ai < 2; ++ai)
#pragma unroll
                for (int m = 0; m < 4; ++m) { bf16_t* rowp = O0 + (size_t)(row0 + ai * HALF + m * 16) * D + col0;
#pragma unroll
                    for (int bj = 0; bj < 2; ++bj) { const f32x4 v0 = acc[ai][bj][m][0] * rs[ai][m], v1 = acc[ai][bj][m][1] * rs[ai][m];
                        u32x4 w; w.x = cvt_pk_bf16(v0[0], v0[1]); w.y = cvt_pk_bf16(v0[2], v0[3]); w.z = cvt_pk_bf16(v1[0], v1[1]); w.w = cvt_pk_bf16(v1[2], v1[3]);
                        *(u32x4*)(rowp + bj * HALF) = w; } }
        } else {
            const int pt = (MODE == 0) ? (u.pn - 4) : u.pn;
            const int col0 = pt * HALF + wc * 32 + 8 * fq;
#pragma unroll
            for (int ai = 0; ai < 2; ++ai)
#pragma unroll
                for (int m = 0; m < 4; ++m) { bf16_t* rowp = O1 + (size_t)(row0 + ai * HALF + m * 16) * ld1 + col0;
                    f32x4 r[2];
#pragma unroll
                    for (int n = 0; n < 2; ++n) { const f32x4 g = acc[ai][0][m][n] * rs[ai][m], up = acc[ai][1][m][n] * rs[ai][m];
                        if (MODE == 0) r[n] = g * up;
                        else {
#pragma unroll
                            for (int j = 0; j < 4; ++j) r[n][j] = __builtin_amdgcn_fmed3f(g[j] * fast_rcp(1.0f + fast_exp2(-1.4426950408889634f * g[j])) * up[j] * F8_HSCALE, -448.0f, 448.0f); } }
                    if (MODE == 1) { u32x2 w; w.x = cvt_pk4_fp8(r[0][0], r[0][1], r[0][2], r[0][3]); w.y = cvt_pk4_fp8(r[1][0], r[1][1], r[1][2], r[1][3]);
                        *(u32x2*)((unsigned char*)O1 + (size_t)(row0 + ai * HALF + m * 16) * ld1 + col0) = w; }
                    else { u32x4 w; w.x = cvt_pk_bf16(r[0][0], r[0][1]); w.y = cvt_pk_bf16(r[0][2], r[0][3]); w.z = cvt_pk_bf16(r[1][0], r[1][1]); w.w = cvt_pk_bf16(r[1][2], r[1][3]);
                        *(u32x4*)rowp = w; } }
        }
    }
};
struct EpiDown {
    static constexpr bool PERM = true, PRELOAD = false, PREFETCH = true;
    unsigned char* O; const float* cwraw; const LAS int* tb; const LAS int* cn;
    __device__ __forceinline__ void prefetch(float (&cws)[2][4], const Unit& u, int wr, int fr) const {
        int e = 0;
#pragma unroll
        for (int j = 1; j < 16; ++j) e += (u.pm >= tb[j]) ? 1 : 0;
        const int idx0 = (u.pm - tb[e]) * BM + wr * 64 + fr, cne = cn[e];
#pragma unroll
        for (int ai = 0; ai < 2; ++ai)
#pragma unroll
            for (int m = 0; m < 4; ++m) { const int idx = idx0 + ai * HALF + m * 16; cws[ai][m] = idx < cne ? cwraw[(size_t)e * ECAP + idx] * (F8_YSCALE / (F8_WSCALE * F8_HSCALE)) : 0.f; }
    }
    __device__ __forceinline__ void operator()(const f32x4 (&acc)[2][2][4][2], const Unit& u, int wr, int wc, int fr, int fq, const float (&cws)[2][4]) const {
        const int row0 = u.pm * BM + wr * 64 + fr, col0 = u.pn * BM + wc * 32 + 8 * fq;
#pragma unroll
        for (int ai = 0; ai < 2; ++ai)
#pragma unroll
            for (int m = 0; m < 4; ++m) { const float cw = cws[ai][m];
                unsigned char* rowp = O + (size_t)(row0 + ai * HALF + m * 16) * D + col0;
#pragma unroll
                for (int bj = 0; bj < 2; ++bj) { f32x4 v0 = acc[ai][bj][m][0] * cw, v1 = acc[ai][bj][m][1] * cw;
#pragma unroll
                    for (int j = 0; j < 4; ++j) { v0[j] = __builtin_amdgcn_fmed3f(v0[j], -448.0f, 448.0f); v1[j] = __builtin_amdgcn_fmed3f(v1[j], -448.0f, 448.0f); }
                    u32x2 w; w.x = cvt_pk4_fp8(v0[0], v0[1], v0[2], v0[3]); w.y = cvt_pk4_fp8(v1[0], v1[1], v1[2], v1[3]);
                    *(u32x2*)(rowp + bj * HALF) = w; } }
    }
};
}

constexpr int RING_BYTES = 131072;
constexpr int MISC_OFF = RING_BYTES;
constexpr int LDS_BYTES = 163840;
constexpr int MW_BAR = 0;
constexpr int MW_TB = 16;
constexpr int MW_CN = 40;
constexpr int MW_Q = 60;
constexpr int MW_F = 64;

struct Params {
    const float* in[25]; float* out; unsigned char* ws;
};

constexpr float ATT_QSCALE = 0.125f * 1.4426950408889634f;
__device__ __forceinline__ void transpose_item(const float* W, int ld, int K, int k0, int srccol, bf16_t* WT, int dstrow, LAS float* scr, int lane, const float* gk = nullptr, float wsc = 1.0f) {
    float tv[32];
#pragma unroll
    for (int i = 0; i < 32; ++i) { const int kk = 2 * i + (lane >> 5); tv[i] = W[(size_t)(k0 + kk) * ld + srccol + (lane & 31)]; }
#pragma unroll
    for (int i = 0; i < 32; ++i) { const int kk = 2 * i + (lane >> 5); scr[kk * 33 + (lane & 31)] = (gk ? tv[i] * gk[k0 + kk] : tv[i]) * wsc; }
    asm volatile("s_waitcnt lgkmcnt(0)" ::: "memory");
    const int c = lane & 7;
#pragma unroll
    for (int j = 0; j < 4; ++j) { const int n = (lane >> 3) + 8 * j; const LAS float* s = scr + (8 * c) * 33 + n;
        u32x4 o; o.x = cvt_pk_bf16(s[0 * 33], s[1 * 33]); o.y = cvt_pk_bf16(s[2 * 33], s[3 * 33]); o.z = cvt_pk_bf16(s[4 * 33], s[5 * 33]); o.w = cvt_pk_bf16(s[6 * 33], s[7 * 33]);
        *(u32x4*)(WT + (size_t)(dstrow + n) * K + k0 + 8 * c) = o; }
    asm volatile("s_waitcnt lgkmcnt(0)" ::: "memory");
}
__device__ __forceinline__ void transpose_item_f8(const float* W, int ld, int K, int k0, int srccol, unsigned char* WT8, int dstrow, LAS float* scr, int lane, const float* gk, float scale) {
    float tv[32];
#pragma unroll
    for (int i = 0; i < 32; ++i) { const int kk = 2 * i + (lane >> 5); tv[i] = W[(size_t)(k0 + kk) * ld + srccol + (lane & 31)]; }
#pragma unroll
    for (int i = 0; i < 32; ++i) { const int kk = 2 * i + (lane >> 5); scr[kk * 33 + (lane & 31)] = (gk ? tv[i] * gk[k0 + kk] : tv[i]) * scale; }
    asm volatile("s_waitcnt lgkmcnt(0)" ::: "memory");
    const int c = lane & 3;
#pragma unroll
    for (int j = 0; j < 2; ++j) { const int n = (lane >> 2) + 16 * j; const LAS float* q = scr + (16 * c) * 33 + n;
        u32x4 o; o.x = cvt_pk4_fp8(q[0 * 33], q[1 * 33], q[2 * 33], q[3 * 33]); o.y = cvt_pk4_fp8(q[4 * 33], q[5 * 33], q[6 * 33], q[7 * 33]);
        o.z = cvt_pk4_fp8(q[8 * 33], q[9 * 33], q[10 * 33], q[11 * 33]); o.w = cvt_pk4_fp8(q[12 * 33], q[13 * 33], q[14 * 33], q[15 * 33]);
        *(u32x4*)(WT8 + (size_t)(dstrow + n) * K + k0 + 16 * c) = o; }
    asm volatile("s_waitcnt lgkmcnt(0)" ::: "memory");
}
__device__ __forceinline__ int pair_row(int ch, int up) { return (ch >> 7) * 256 + up * 128 + (ch & 127); }

__device__ __forceinline__ void phase_prologue_weights(const Params& p, LAS unsigned char* lds, int first, int last, int step, int wave, int lane_) {
    int lane = lane_; asm volatile("" : "+v"(lane));
    LAS float* scr = (LAS float*)(lds + wave * 16384);
    unsigned char* ws = p.ws;
    constexpr int I1 = 16 * 112, I2 = 16 * 32, I3 = 16 * 96, I4 = 16 * 32, IE = 768;
    constexpr int NITEMS = I1 + I2 + I3 + I4 + 32 * IE;
    static_assert(NITEMS == 28928, "item count");
    for (int it = first; it < last; it += step) {
        int r = it;
        if (r < I1) { const int kb = r / 112, nb = r % 112; const int sc = nb < 64 ? 32 * nb : 2056 + 32 * (nb - 64), dr = nb < 64 ? 32 * nb : 2048 + 32 * (nb - 64);
            transpose_item(p.in[5], EVEN_IN, 1024, 64 * kb, sc, (bf16_t*)(ws + WS_WT1), dr, scr, lane, nullptr, (dr >= P_DQ && dr < P_DK) ? ATT_QSCALE : 1.0f); continue; } r -= I1;
        if (r < I2) { const int kb = r / 32, nb = r % 32; transpose_item(p.in[6], 1024, 1024, 64 * kb, 32 * nb, (bf16_t*)(ws + WS_WT2), 32 * nb, scr, lane); continue; } r -= I2;
        if (r < I3) { const int kb = r / 96, nb = r % 96; int dr;
            if (nb < 32) dr = 32 * nb; else if (nb < 64) dr = 1024 + pair_row(32 * (nb - 32), 0); else dr = 1024 + pair_row(32 * (nb - 64), 1);
            if (G3_F8) transpose_item_f8(p.in[15], 3072, 1024, 64 * kb, 32 * nb, ws + WS_WT3, dr, scr, lane, p.in[2] + D, F8_WSCALE);
            else transpose_item(p.in[15], 3072, 1024, 64 * kb, 32 * nb, (bf16_t*)(ws + WS_WT3), dr, scr, lane, p.in[2] + D);
            continue; } r -= I3;
        if (r < I4) { const int kb = r / 32, nb = r % 32; transpose_item(p.in[17], 1024, 1024, 64 * kb, 32 * nb, (bf16_t*)(ws + WS_WT4), 32 * nb, scr, lane); continue; } r -= I4;
        const int le = r / IE; r %= IE;
        unsigned char* wgu = ws + WS_WGU + (size_t)le * 1024 * 1024; unsigned char* wd = ws + WS_WD + (size_t)le * 1024 * 512;
        if (r < 256) { const int kb = r / 16, nb = r % 16; transpose_item_f8(p.in[22] + (size_t)le * 1024 * 512, 512, 1024, 64 * kb, 32 * nb, wgu, pair_row(32 * nb, 0), scr, lane, p.in[3] + (le >> 4) * D, F8_WSCALE); continue; } r -= 256;
        if (r < 256) { const int kb = r / 16, nb = r % 16; transpose_item_f8(p.in[23] + (size_t)le * 1024 * 512, 512, 1024, 64 * kb, 32 * nb, wgu, pair_row(32 * nb, 1), scr, lane, p.in[3] + (le >> 4) * D, F8_WSCALE); continue; } r -= 256;
        { const int kb = r / 32, nb = r % 32; transpose_item_f8(p.in[24] + (size_t)le * 512 * 1024, 1024, 512, 64 * kb, 32 * nb, wd, 32 * nb, scr, lane, nullptr, F8_WSCALE); }
    }
}

struct RowV { f32x4 v[4]; };
__device__ __forceinline__ RowV row_load(const float* xr, int lane) { RowV r; const f32x4* p = (const f32x4*)xr + lane;
#pragma unroll
    for (int j = 0; j < 4; ++j) r.v[j] = p[64 * j]; return r; }
__device__ __forceinline__ void row_store(float* xr, int lane, const RowV& r) { f32x4* p = (f32x4*)xr + lane;
#pragma unroll
    for (int j = 0; j < 4; ++j) p[64 * j] = r.v[j]; }
__device__ __forceinline__ RowV row_load_bf16(const bf16_t* yr, int lane) { RowV r; const u32x2* p = (const u32x2*)yr + lane;
#pragma unroll
    for (int j = 0; j < 4; ++j) { const u32x2 w = p[64 * j]; r.v[j] = (f32x4){bf_lo(w.x), bf_hi(w.x), bf_lo(w.y), bf_hi(w.y)}; } return r; }
__device__ __forceinline__ RowV row_load_fp8(const unsigned char* yr, int lane, float sc) { RowV r; const unsigned* p = (const unsigned*)yr + lane;
#pragma unroll
    for (int j = 0; j < 4; ++j) { const unsigned w = p[64 * j]; const f32x2 lo = __builtin_amdgcn_cvt_pk_f32_fp8((int)w, false), hi = __builtin_amdgcn_cvt_pk_f32_fp8((int)w, true); r.v[j] = (f32x4){lo.x * sc, lo.y * sc, hi.x * sc, hi.y * sc}; } return r; }
__device__ __forceinline__ float row_rstd(const RowV& r) { float s = 0.f;
#pragma unroll
    for (int j = 0; j < 4; ++j) s += (r.v[j][0] * r.v[j][0] + r.v[j][1] * r.v[j][1]) + (r.v[j][2] * r.v[j][2] + r.v[j][3] * r.v[j][3]);
    return 1.0f / sqrtf(wave_sum(s) * (1.0f / D) + NORM_EPS); }
__device__ __forceinline__ void row_store_bf16(bf16_t* hr, int lane, const RowV& r) { u32x2* p = (u32x2*)hr + lane;
#pragma unroll
    for (int j = 0; j < 4; ++j) { u32x2 w; w.x = cvt_pk_bf16(r.v[j][0], r.v[j][1]); w.y = cvt_pk_bf16(r.v[j][2], r.v[j][3]); p[64 * j] = w; } }

__device__ __forceinline__ void phase_norm_gates(const Params& p, LAS unsigned char* lds, int tid, int gw, int NGW, int lane) {
    const float* x = p.in[0]; const float* g = p.in[2]; const float* win = p.in[5];
    bf16_t* H = (bf16_t*)(p.ws + WS_H); float* gates = (float*)(p.ws + WS_GATES);
    LAS float* wt = (LAS float*)lds;
    for (int i = tid; i < 8 * 1024; i += NTHR) { const int k = i >> 3, o = i & 7; wt[o * 1024 + k] = win[(size_t)k * EVEN_IN + 2048 + o] * g[k]; }
    __syncthreads();
    RowV gv = row_load(g, lane);
    for (int m0 = gw; m0 < T; m0 += 2 * NGW) {
      RowV rr[2];
#pragma unroll
      for (int u = 0; u < 2; ++u) { const int mm = m0 + u * NGW; rr[u] = row_load(x + (size_t)(mm < T ? mm : m0) * D, lane); }
#pragma unroll
      for (int u = 0; u < 2; ++u) {
        const int m = m0 + u * NGW; if (m >= T) break; RowV r = rr[u];
        const float rstd = row_rstd(r);
        float dots[8];
#pragma unroll
        for (int o = 0; o < 8; ++o) { float s = 0.f;
#pragma unroll
            for (int j = 0; j < 4; ++j) { const f32x4 w = *(const LAS f32x4*)(wt + o * 1024 + 4 * lane + 256 * j); s += (r.v[j][0] * w[0] + r.v[j][1] * w[1]) + (r.v[j][2] * w[2] + r.v[j][3] * w[3]); }
            dots[o] = s; }
        float gsum;
        { const bool b5 = (lane & 32) != 0, b4 = (lane & 16) != 0, b3 = (lane & 8) != 0;
          float k4[4];
#pragma unroll
          for (int i = 0; i < 4; ++i) { const float keep = b5 ? dots[4 + i] : dots[i], send = b5 ? dots[i] : dots[4 + i]; k4[i] = keep + __shfl_xor(send, 32); }
          float k2[2];
#pragma unroll
          for (int i = 0; i < 2; ++i) { const float keep = b4 ? k4[2 + i] : k4[i], send = b4 ? k4[i] : k4[2 + i]; k2[i] = keep + __shfl_xor(send, 16); }
          { const float keep = b3 ? k2[1] : k2[0], send = b3 ? k2[0] : k2[1]; gsum = keep + __shfl_xor(send, 8); }
          gsum += __shfl_xor(gsum, 4); gsum += __shfl_xor(gsum, 2); gsum += __shfl_xor(gsum, 1); }
#pragma unroll
        for (int j = 0; j < 4; ++j) r.v[j] = r.v[j] * rstd * gv.v[j];
        row_store_bf16(H + (size_t)m * D, lane, r);
        if ((lane & 7) == 0) gates[(size_t)m * 8 + ((lane >> 3) & 7)] = gsum * rstd;
      }
    }
    __syncthreads();
}

template <int MODE, bool COMBINE>
__device__ __forceinline__ void phase_rows(const Params& p, LAS unsigned char* lds, int tid_, int wave, int lane_, int G,
                                           const float* gvec, const float* wgr, const float* bgr, const float* wer, const float* ber, unsigned* cnt_prev, unsigned* cnt_cur) {
    int tid = tid_; asm volatile("" : "+v"(tid)); const int lane = tid & 63;
    float* OUT = p.out; bf16_t* XB = (bf16_t*)(p.ws + WS_XB); float* RSTD = (float*)(p.ws + WS_RSTD);
    const unsigned char* YC = (const unsigned char*)(p.ws + WS_YC); float* rsraw = (float*)(p.ws + WS_RSRAW);
    unsigned* tokinfo = (unsigned*)(p.ws + WS_TOKINFO);
    unsigned* rowtok = (unsigned*)(p.ws + WS_ROWTOK); float* cwraw = (float*)(p.ws + WS_CWRAW);
    LAS float* wt = (LAS float*)lds;
    LAS int* misc = (LAS int*)(lds + MISC_OFF);
    LAS int* tbp = misc + MW_TB;
    LAS int* te = misc + 1024;
    LAS float* tc = (LAS float*)(misc + 1536);
    LAS int* trank = misc + 2048;
    LAS int* ebase = misc + 2560;
    LAS float* trs = (LAS float*)(misc + 2600);
    if (COMBINE) { if (tid == 0) { int acc = 0; for (int e = 0; e < 16; ++e) { tbp[e] = acc; acc += ((int)__hip_atomic_load(cnt_prev + e * 64, __ATOMIC_RELAXED, __HIP_MEMORY_SCOPE_AGENT) + 255) >> 8; } tbp[16] = acc; } }
    if (MODE == 1) { for (int i = tid; i < 20 * 1024; i += NTHR) { const int o = i >> 10, k = i & 1023; wt[i] = (o < 4 ? wgr[(size_t)k * 4 + o] : wer[(size_t)k * 16 + (o - 4)]) * gvec[k]; } }
    __syncthreads();
    RowV gv; if (MODE == 2) gv = row_load(gvec, lane);
    for (int blk = blockIdx.x; blk < T / 256; blk += G) {
        for (int i2 = 0; i2 < 32; i2 += 2) {
          RowV rr[2];
#pragma unroll
          for (int u = 0; u < 2; ++u) {
            const int m = blk * 256 + wave * 32 + i2 + u;
            rr[u] = row_load_bf16(XB + (size_t)m * D, lane);
            if (COMBINE) {
                const unsigned i0 = tokinfo[(size_t)m * 2], i1 = tokinfo[(size_t)m * 2 + 1];
                const size_t s0 = (size_t)tbp[i0 >> 16] * 256 + (i0 & 0xffffu), s1 = (size_t)tbp[i1 >> 16] * 256 + (i1 & 0xffffu);
                const RowV y0 = row_load_fp8(YC + s0 * D, lane, 1.0f / F8_YSCALE), y1 = row_load_fp8(YC + s1 * D, lane, 1.0f / F8_YSCALE);
#pragma unroll
                for (int j = 0; j < 4; ++j) rr[u].v[j] = rr[u].v[j] + y0.v[j] + y1.v[j];
            }
          }
#pragma unroll
          for (int u = 0; u < 2; ++u) {
            const int i = i2 + u;
            const int rl = wave * 32 + i, m = blk * 256 + rl;
            RowV r = rr[u];
            if (MODE == 0) {
                u32x2* xp = (u32x2*)(XB + (size_t)m * D) + lane;
#pragma unroll
                for (int j = 0; j < 4; ++j) { u32x2 w; w.x = cvt_pk_bf16(r.v[j][0], r.v[j][1]); w.y = cvt_pk_bf16(r.v[j][2], r.v[j][3]); xp[64 * j] = w;
                    r.v[j] = (f32x4){bf_lo(w.x), bf_hi(w.x), bf_lo(w.y), bf_hi(w.y)}; }
            }
            const float rstd = row_rstd(r);
            if (MODE != 2) { if (lane == 0) RSTD[m] = rstd; }
            if (MODE == 1 || (MODE == 0 && G3_F8)) { unsigned* x8 = (unsigned*)(p.ws + WS_XB8 + (size_t)m * D) + lane;
#pragma unroll
                for (int j = 0; j < 4; ++j) x8[64 * j] = cvt_pk4_fp8(r.v[j][0], r.v[j][1], r.v[j][2], r.v[j][3]); }
            if (MODE == 1) {
                float lg[20];
#pragma unroll
                for (int o = 0; o < 20; ++o) { float s = 0.f;
#pragma unroll
                    for (int j = 0; j < 4; ++j) { const f32x4 w = *(const LAS f32x4*)(wt + o * 1024 + 4 * lane + 256 * j); s += (r.v[j][0] * w[0] + r.v[j][1] * w[1]) + (r.v[j][2] * w[2] + r.v[j][3] * w[3]); }
                    lg[o] = wave_sum(s) * rstd + (o < 4 ? bgr[o] : ber[o - 4]); }
                int gs = 0; float gm = lg[0];
#pragma unroll
                for (int o = 1; o < 4; ++o) if (lg[o] > gm) { gm = lg[o]; gs = o; }
                float den = 0.f;
#pragma unroll
                for (int o = 0; o < 4; ++o) den += __expf(lg[o] - gm);
                const float pg = 1.0f / den;
                float el[4];
#pragma unroll
                for (int o = 0; o < 4; ++o) { float v = lg[4 + o];
#pragma unroll
                    for (int g2 = 1; g2 < 4; ++g2) v = (gs == g2) ? lg[4 + 4 * g2 + o] : v;
                    el[o] = v; }
                int i0 = 0; float v0 = el[0];
#pragma unroll
                for (int o = 1; o < 4; ++o) if (el[o] > v0) { v0 = el[o]; i0 = o; }
                int i1 = -1; float v1 = -INFINITY;
#pragma unroll
                for (int o = 0; o < 4; ++o) if (o != i0 && el[o] > v1) { v1 = el[o]; i1 = o; }
                const float ex = __expf(v1 - v0); const float w0 = 1.0f / (1.0f + ex), w1 = ex * w0;
                if (lane == 0) { te[rl * 2] = gs * 4 + i0; te[rl * 2 + 1] = gs * 4 + i1; tc[rl * 2] = w0 * pg; tc[rl * 2 + 1] = w1 * pg; trs[rl] = rstd; }
            }
            if (MODE == 2) {
#pragma unroll
                for (int j = 0; j < 4; ++j) r.v[j] = r.v[j] * rstd * gv.v[j];
                row_store(OUT + (size_t)m * D, lane, r);
            }
          }
        }
        if (MODE == 1) {
            __syncthreads();
            if (tid < 16) { int c = 0; for (int q = 0; q < 512; ++q) if (te[q] == tid) { trank[q] = c; ++c; }
                ebase[tid] = c ? (int)__hip_atomic_fetch_add(cnt_cur + tid * 64, (unsigned)c, __ATOMIC_RELAXED, __HIP_MEMORY_SCOPE_AGENT) : 0; }
            __syncthreads();
            { const int q = tid, e = te[q], pos = ebase[e] + trank[q], tok = blk * 256 + (q >> 1);
              rowtok[(size_t)e * ECAP + pos] = (unsigned)tok; cwraw[(size_t)e * ECAP + pos] = tc[q]; rsraw[(size_t)e * ECAP + pos] = trs[q >> 1]; tokinfo[(size_t)tok * 2 + (q & 1)] = ((unsigned)e << 16) | (unsigned)pos; }
            __syncthreads();
        }
    }
    __syncthreads();
}

__device__ __forceinline__ void phase_router(const Params& p, LAS unsigned char* lds, int tid_, int wave, int G,
                                             const float* gvec, const float* wgr, const float* bgr, const float* wer, const float* ber, unsigned* cnt_cur) {
    int tid = tid_; asm volatile("" : "+v"(tid)); const int lane = tid & 63, r32 = lane & 31, hi = lane >> 5;
    const bf16_t* XB = (const bf16_t*)(p.ws + WS_XB); float* rsraw = (float*)(p.ws + WS_RSRAW);
    unsigned* tokinfo = (unsigned*)(p.ws + WS_TOKINFO);
    unsigned* rowtok = (unsigned*)(p.ws + WS_ROWTOK); float* cwraw = (float*)(p.ws + WS_CWRAW);
    constexpr int WROW = 2048 + 16;
    LAS unsigned char* Whi = lds; LAS unsigned char* Wlo = lds + 24 * WROW;
    LAS int* misc = (LAS int*)(lds + MISC_OFF);
    LAS int* te = misc + 1024; LAS float* tc = (LAS float*)(misc + 1536); LAS int* trank = misc + 2048; LAS int* ebase = misc + 2560; LAS float* trs = (LAS float*)(misc + 2600);
    for (int i = tid; i < 24 * 1024; i += NTHR) { const int sl = i >> 10, k = i & 1023; float w;
        if (sl < 8) w = wgr[(size_t)k * 4 + (sl & 3)]; else { const int q = sl - 8, e = (q & 3) + 8 * ((q >> 2) & 1) + 4 * (q >> 3); w = wer[(size_t)k * 16 + e]; }
        w *= gvec[k];
        const unsigned hb = cvt_pk_bf16(w, 0.f) & 0xffffu; const float wl = w - __uint_as_float(hb << 16); const unsigned lb = cvt_pk_bf16(wl, 0.f) & 0xffffu;
        *(LAS unsigned short*)(Whi + sl * WROW + k * 2) = (unsigned short)hb; *(LAS unsigned short*)(Wlo + sl * WROW + k * 2) = (unsigned short)lb; }
    __syncthreads();
    const int slot_row = r32 < 24 ? r32 : r32 - 8;
    const LAS unsigned char* wh = Whi + slot_row * WROW + hi * 64; const LAS unsigned char* wl_ = Wlo + slot_row * WROW + hi * 64;
    for (int blk = blockIdx.x; blk < T / 256; blk += G) {
        const int rl = wave * 32 + r32, m = blk * 256 + rl;
        const bf16_t* xr = XB + (size_t)m * D + hi * 32;
        f32x16 acc = (f32x16){}; float ss = 0.f;
        bf16x8 xa[4], xb[4];
#pragma unroll
        for (int q = 0; q < 4; ++q) xa[q] = *(const bf16x8*)(xr + q * 8);
#pragma unroll 1
        for (int t = 0; t < 16; t += 2) {
#pragma unroll
            for (int q = 0; q < 4; ++q) xb[q] = *(const bf16x8*)(xr + (t + 1) * 64 + q * 8);
#pragma unroll
            for (int q = 0; q < 4; ++q) { const bf16x8 ah = *(const LAS bf16x8*)(wh + t * 128 + q * 16), al = *(const LAS bf16x8*)(wl_ + t * 128 + q * 16);
                acc = __builtin_amdgcn_mfma_f32_32x32x16_bf16(ah, xa[q], acc, 0, 0, 0); acc = __builtin_amdgcn_mfma_f32_32x32x16_bf16(al, xa[q], acc, 0, 0, 0);
#pragma unroll
                for (int j = 0; j < 4; ++j) { const unsigned w = ((const unsigned*)&xa[q])[j]; const float a = bf_lo(w), b = bf_hi(w); ss += a * a + b * b; } }
            if (t + 2 < 16) {
#pragma unroll
                for (int q = 0; q < 4; ++q) xa[q] = *(const bf16x8*)(xr + (t + 2) * 64 + q * 8); }
#pragma unroll
            for (int q = 0; q < 4; ++q) { const bf16x8 ah = *(const LAS bf16x8*)(wh + (t + 1) * 128 + q * 16), al = *(const LAS bf16x8*)(wl_ + (t + 1) * 128 + q * 16);
                acc = __builtin_amdgcn_mfma_f32_32x32x16_bf16(ah, xb[q], acc, 0, 0, 0); acc = __builtin_amdgcn_mfma_f32_32x32x16_bf16(al, xb[q], acc, 0, 0, 0);
#pragma unroll
                for (int j = 0; j < 4; ++j) { const unsigned w = ((const unsigned*)&xb[q])[j]; const float a = bf_lo(w), b = bf_hi(w); ss += a * a + b * b; } }
        }
        ss += __shfl_xor(ss, 32);
        const float rstd = 1.0f / sqrtf(ss * (1.0f / D) + NORM_EPS);
        float lg[4];
#pragma unroll
        for (int o = 0; o < 4; ++o) lg[o] = acc[o] * rstd + bgr[o];
        int gs = 0; float gm = lg[0];
#pragma unroll
        for (int o = 1; o < 4; ++o) if (lg[o] > gm) { gm = lg[o]; gs = o; }
        float den = 0.f;
#pragma unroll
        for (int o = 0; o < 4; ++o) den += __expf(lg[o] - gm);
        const float pg = 1.0f / den;
        if ((gs >> 1) == hi) {
            float el[4];
#pragma unroll
            for (int o = 0; o < 4; ++o) el[o] = ((gs & 1) ? acc[8 + o] : acc[4 + o]) * rstd + ber[gs * 4 + o];
            int i0 = 0; float v0 = el[0];
#pragma unroll
            for (int o = 1; o < 4; ++o) if (el[o] > v0) { v0 = el[o]; i0 = o; }
            int i1 = -1; float v1 = -INFINITY;
#pragma unroll
            for (int o = 0; o < 4; ++o) if (o != i0 && el[o] > v1) { v1 = el[o]; i1 = o; }
            const float ex = __expf(v1 - v0); const float w0 = 1.0f / (1.0f + ex), w1 = ex * w0;
            te[rl * 2] = gs * 4 + i0; te[rl * 2 + 1] = gs * 4 + i1; tc[rl * 2] = w0 * pg; tc[rl * 2 + 1] = w1 * pg; trs[rl] = rstd;
        }
        __syncthreads();
        if (tid < 16) { int c = 0; for (int q = 0; q < 512; ++q) if (te[q] == tid) { trank[q] = c; ++c; }
            ebase[tid] = c ? (int)__hip_atomic_fetch_add(cnt_cur + tid * 64, (unsigned)c, __ATOMIC_RELAXED, __HIP_MEMORY_SCOPE_AGENT) : 0; }
        __syncthreads();
        { const int q = tid, e = te[q], pos = ebase[e] + trank[q], tok = blk * 256 + (q >> 1);
          rowtok[(size_t)e * ECAP + pos] = (unsigned)tok; cwraw[(size_t)e * ECAP + pos] = tc[q]; rsraw[(size_t)e * ECAP + pos] = trs[q >> 1]; tokinfo[(size_t)tok * 2 + (q & 1)] = ((unsigned)e << 16) | (unsigned)pos; }
        __syncthreads();
    }
    __syncthreads();
}

__device__ __forceinline__ void phase_conv(const Params& p, int gw, int NGW, int lane) {
    const bf16_t* BG = (const bf16_t*)(p.ws + WS_BG); const bf16_t* Z = (const bf16_t*)(p.ws + WS_Z); bf16_t* A2 = (bf16_t*)(p.ws + WS_CAT);
    const float* cw = p.in[16];
    float w0[16], w1[16], w2[16];
#pragma unroll
    for (int h = 0; h < 2; ++h)
#pragma unroll
        for (int j = 0; j < 8; ++j) { const int c = h * 512 + lane * 8 + j; w0[h * 8 + j] = cw[c]; w1[h * 8 + j] = cw[D + c]; w2[h * 8 + j] = cw[2 * D + c]; }
    for (int run = gw; run < T / 32; run += NGW) {
        const int t0 = run * 32;
        float zm1[16], zm2[16];
#pragma unroll
        for (int j = 0; j < 16; ++j) { zm1[j] = 0.f; zm2[j] = 0.f; }
        if ((t0 & (SEQ - 1)) != 0) {
#pragma unroll
            for (int h = 0; h < 2; ++h) { const u32x4 a = *(const u32x4*)(Z + (size_t)(t0 - 1) * D + h * 512 + lane * 8), b = *(const u32x4*)(Z + (size_t)(t0 - 2) * D + h * 512 + lane * 8);
#pragma unroll
                for (int q = 0; q < 4; ++q) { zm1[h * 8 + 2 * q] = bf_lo(a[q]); zm1[h * 8 + 2 * q + 1] = bf_hi(a[q]); zm2[h * 8 + 2 * q] = bf_lo(b[q]); zm2[h * 8 + 2 * q + 1] = bf_hi(b[q]); } }
        }
#pragma unroll 4
        for (int i = 0; i < 32; ++i) {
            const size_t rb = (size_t)(t0 + i) * D;
#pragma unroll
            for (int h = 0; h < 2; ++h) { const u32x4 zz = *(const u32x4*)(Z + rb + h * 512 + lane * 8), bb = *(const u32x4*)(BG + rb + h * 512 + lane * 8);
                float o[8];
#pragma unroll
                for (int q = 0; q < 4; ++q) {
#pragma unroll
                    for (int s = 0; s < 2; ++s) { const int j = h * 8 + 2 * q + s; const float zc = s ? bf_hi(zz[q]) : bf_lo(zz[q]), bg = s ? bf_hi(bb[q]) : bf_lo(bb[q]);
                        o[2 * q + s] = bg * (w0[j] * zm2[j] + w1[j] * zm1[j] + w2[j] * zc); zm2[j] = zm1[j]; zm1[j] = zc; } }
                u32x4 w; w.x = cvt_pk_bf16(o[0], o[1]); w.y = cvt_pk_bf16(o[2], o[3]); w.z = cvt_pk_bf16(o[4], o[5]); w.w = cvt_pk_bf16(o[6], o[7]);
                *(u32x4*)(A2 + rb + h * 512 + lane * 8) = w; }
        }
    }
}

__device__ __forceinline__ void phase_gate_scan(const Params& p, int gw, int NGW, int lane) {
    const float* gates = (const float*)(p.ws + WS_GATES);
    float* SA = (float*)(p.ws + WS_SA); float* SAM = (float*)(p.ws + WS_SAM); float* SBA = (float*)(p.ws + WS_SBA);
    for (int sq = gw; sq < NBATCH * 4; sq += NGW) {
        const int b = sq >> 2, hd = sq & 3; const float ib = p.in[7][hd], fb = p.in[8][hd];
        float lf[32], ig[32];
#pragma unroll
        for (int i = 0; i < 32; ++i) { const size_t t = (size_t)b * SEQ + lane * 32 + i; const float f = gates[t * 8 + 4 + hd] + fb; ig[i] = gates[t * 8 + hd] + ib;
            lf[i] = (f >= 0.f) ? -log1pf(expf(-f)) : (f - log1pf(expf(f))); }
        float run = 0.f;
#pragma unroll
        for (int i = 0; i < 32; ++i) { run += lf[i]; lf[i] = run; }
        float tot = run, pre = 0.f;
#pragma unroll
        for (int o = 1; o < 64; o <<= 1) { const float v = __shfl_up(tot, o); if (lane >= o) tot += v; }
        pre = tot - run;
        float amax = -INFINITY;
#pragma unroll
        for (int i = 0; i < 32; ++i) { lf[i] += pre; ig[i] = ig[i] - lf[i]; amax = fmaxf(amax, ig[i]); }
        float pm = amax;
#pragma unroll
        for (int o = 1; o < 64; o <<= 1) { const float v = __shfl_up(pm, o); if (lane >= o) pm = fmaxf(pm, v); }
        float prev = __shfl_up(pm, 1); if (lane == 0) prev = -INFINITY;
        float rm = prev;
#pragma unroll
        for (int i = 0; i < 32; ++i) { const size_t o = (size_t)sq * SEQ + lane * 32 + i; rm = fmaxf(rm, ig[i]); SA[o] = ig[i]; SAM[o] = rm; SBA[o] = lf[i] + rm; }
    }
}

struct TileRegs { u32x4 v[2]; };
__device__ __forceinline__ TileRegs tile_load(const bf16_t* src, int tid) { TileRegs r;
#pragma unroll
    for (int i = 0; i < 2; ++i) { const int n = tid + 512 * i, row = n >> 4, ch = n & 15; r.v[i] = *(const u32x4*)(src + (size_t)row * NP + ch * 8); } return r; }
__device__ __forceinline__ void tile_write(LAS unsigned char* dst, int tid, const TileRegs& r) {
#pragma unroll
    for (int i = 0; i < 2; ++i) { const int n = tid + 512 * i, row = n >> 4, ch = n & 15; *(LAS u32x4*)(dst + off_b(row, ch)) = r.v[i]; } }

__device__ __forceinline__ void glds16(const void* gsrc, unsigned lds_dst) { unsigned keep;
    asm volatile("s_mov_b32 %0, m0\n\ts_mov_b32 m0, %2\n\ts_nop 0\n\tglobal_load_lds_dwordx4 %1, off\n\ts_mov_b32 m0, %0" : "=&s"(keep) : "v"(gsrc), "s"(lds_dst) : "memory"); }
__device__ __forceinline__ void tile_dma(const bf16_t* src, LAS unsigned char* dst, int wave, int lane) {
#pragma unroll
    for (int i = 0; i < 2; ++i) { const int piece = 2 * wave + i, row = 4 * piece + (lane >> 4); const unsigned ch = (unsigned)(lane & 15) ^ ((((unsigned)lane >> 4) << 2) | ((unsigned)piece & 3u));
        glds16(src + (size_t)row * NP + ch * 8, (unsigned)__builtin_amdgcn_readfirstlane((int)(unsigned)(uintptr_t)(dst + piece * 1024))); }
}
#define WAIT_ALL_BAR() asm volatile("s_waitcnt vmcnt(0) lgkmcnt(0)\n\ts_barrier" ::: "memory")
__device__ __forceinline__ void attn_unit(const Params& p, LAS unsigned char* lds, int bh, int qblk, int tid_, int wave, int lane_) {
    int tid = tid_; asm volatile("" : "+v"(tid)); const int lane = tid & 63;
    const bf16_t* P = (const bf16_t*)(p.ws + WS_P); bf16_t* CAT = (bf16_t*)(p.ws + WS_CAT);
    const int b = bh >> 2, hd = bh & 3, map = wave >> 2, qs = wave & 3, r32 = lane & 31, hi = lane >> 5;
    const size_t rowbase = (size_t)b * SEQ;
    const int q0 = qblk * 128 + qs * 32, qrow = q0 + r32;
    LAS float* fs = (LAS float*)(lds + MISC_OFF) + MW_F;
    LAS float* tbl = fs;
    constexpr float LOG2E = 1.4426950408889634f;
    if (tid < 272) { const int n = tid - 64; int bk;
        if (n < 16) bk = n < 0 ? 0 : n; else { bk = 16; const int th[15] = {19, 21, 24, 27, 31, 35, 40, 46, 52, 59, 67, 77, 87, 99, 113};
#pragma unroll
            for (int j = 0; j < 15; ++j) bk += (n >= th[j]) ? 1 : 0; }
        tbl[tid] = n < 0 ? -INFINITY : p.in[1][bk * 4 + hd] * LOG2E; }
    bf16x8 qf[4];
    { const bf16_t* qp = P + (rowbase + qrow) * NP + P_DQ + hd * 128 + map * 64 + hi * 8;
#pragma unroll
      for (int ks = 0; ks < 4; ++ks) qf[ks] = *(const bf16x8*)(qp + ks * 16); }
    const bf16_t* Kg = P + rowbase * NP + P_DK + hd * 128; const bf16_t* Vg = P + rowbase * NP + P_DV + hd * 128;
    const int NS = qblk + 1;
    f32x16 o[4];
#pragma unroll
    for (int c = 0; c < 4; ++c) o[c] = (f32x16){};
    float mrun = -INFINITY, lrun = 0.f;
    const float bias_far = p.in[1][31 * 4 + hd] * LOG2E;
    const unsigned xr = ((unsigned)(r32 & 3) << 2) | ((unsigned)(r32 >> 2) & 3u);
    const unsigned q4 = (lane & 15) >> 2, pp = lane & 3, blk = (lane >> 4) & 1;
    const int NT = 2 * (qblk + 1);
#define ATT_TILE_DMA(t_) do { LAS unsigned char* nb_ = lds + ((t_) & 3) * 32768; const size_t ro_ = (size_t)(t_) * 64 * NP; tile_dma(Kg + ro_, nb_, wave, lane); tile_dma(Vg + ro_, nb_ + 16384, wave, lane); } while (0)
#define WAIT_BAR_N(n) asm volatile("s_waitcnt vmcnt(" #n ") lgkmcnt(0)\n\ts_barrier" ::: "memory")
    WAIT_ALL_BAR();
    asm volatile("" :: "v"(qf[0]), "v"(qf[1]), "v"(qf[2]), "v"(qf[3]), "v"(bias_far));
    ATT_TILE_DMA(0); ATT_TILE_DMA(1); if (NT > 2) ATT_TILE_DMA(2);
    if (NT > 2) WAIT_BAR_N(8); else WAIT_BAR_N(4);
#pragma unroll 1
    for (int t = 0; t < NT; ++t) {
        if (t + 3 <= NT) WAIT_BAR_N(4); else WAIT_ALL_BAR();
        {
            const int j = t;
            const LAS unsigned char* Kt = lds + (t & 3) * 32768; const LAS unsigned char* Vt = Kt + 16384;
            if (64 * j <= q0 + 31) {
                const int nmin = q0 - (64 * j + 63);
                const bool first = (mrun == -INFINITY);
                const float cinit = first ? 0.f : (nmin >= 113 ? bias_far - mrun : -mrun);
                f32x16 p0, p1;
#pragma unroll
                for (int r = 0; r < 16; ++r) { p0[r] = cinit; p1[r] = cinit; }
#pragma unroll
                for (int ks = 0; ks < 4; ++ks) { const unsigned ch = (unsigned)(8 * map + 2 * ks + hi) ^ xr;
                    const bf16x8 k0 = *(const LAS bf16x8*)(Kt + 256u * r32 + 16u * ch), k1 = *(const LAS bf16x8*)(Kt + 256u * (32 + r32) + 16u * ch);
                    p0 = __builtin_amdgcn_mfma_f32_32x32x16_bf16(k0, qf[ks], p0, 0, 0, 0); p1 = __builtin_amdgcn_mfma_f32_32x32x16_bf16(k1, qf[ks], p1, 0, 0, 0); }
                __builtin_amdgcn_sched_barrier(0);
                float rm = -INFINITY;
                if (first) {
                    if (nmin >= 113) {
#pragma unroll
                        for (int r = 0; r < 16; ++r) { p0[r] = p0[r] + bias_far; p1[r] = p1[r] + bias_far; rm = fmaxf(rm, fmaxf(p0[r], p1[r])); }
                    } else {
                        const LAS float* tb = tbl + (qrow - 64 * j - 4 * hi + 5);
#pragma unroll
                        for (int r = 0; r < 16; ++r) { const int e = (r & 3) + 8 * (r >> 2);
                            p0[r] += tb[59 - e]; p1[r] += tb[27 - e];
                            rm = fmaxf(rm, fmaxf(p0[r], p1[r])); }
                    }
                    { auto rr = __builtin_amdgcn_permlane32_swap(__float_as_uint(rm), __float_as_uint(rm), false, false); rm = fmaxf(__uint_as_float(rr[0]), __uint_as_float(rr[1])); }
                    mrun = rm;
#pragma unroll
                    for (int r = 0; r < 16; ++r) { p0[r] -= mrun; p1[r] -= mrun; }
                } else {
                    if (nmin < 113) {
                        const LAS float* tb = tbl + (qrow - 64 * j - 4 * hi + 5);
                        float bv0[16], bv1[16];
#pragma unroll
                        for (int r = 0; r < 16; ++r) { const int e = (r & 3) + 8 * (r >> 2); bv0[r] = tb[59 - e]; bv1[r] = tb[27 - e]; }
#pragma unroll
                        for (int r = 0; r < 16; ++r) { p0[r] += bv0[r]; p1[r] += bv1[r]; }
                    }
                    { float m0 = fmaxf(p0[0], p1[0]), m1 = fmaxf(p0[1], p1[1]);
#pragma unroll
                      for (int r = 2; r < 16; r += 2) { m0 = __builtin_fmaxf(__builtin_fmaxf(m0, p0[r]), p1[r]); m1 = __builtin_fmaxf(__builtin_fmaxf(m1, p0[r + 1]), p1[r + 1]); }
                      rm = fmaxf(m0, m1); }
                    { auto rr = __builtin_amdgcn_permlane32_swap(__float_as_uint(rm), __float_as_uint(rm), false, false); rm = fmaxf(__uint_as_float(rr[0]), __uint_as_float(rr[1])); }
                    if (__any(rm > 8.0f)) {
                        const float dl = fmaxf(rm, 0.f); const float alpha = fast_exp2(-dl);
                        lrun *= alpha; mrun += dl;
#pragma unroll
                        for (int r = 0; r < 16; ++r) { p0[r] -= dl; p1[r] -= dl; }
#pragma unroll
                        for (int c = 0; c < 4; ++c)
#pragma unroll
                            for (int r = 0; r < 16; ++r) o[c][r] *= alpha;
                    }
                }
                float psa = 0.f, psb = 0.f;
                bf16x8 pf[4];
#define ATT_EXPK(ks_) do { u32x4 w_; _Pragma("unroll") for (int q = 0; q < 4; ++q) { const int r = 8 * ((ks_) & 1) + 2 * q; \
                        const float ea = fast_exp2((ks_) < 2 ? p0[r] : p1[r]), eb = fast_exp2((ks_) < 2 ? p0[r + 1] : p1[r + 1]); psa += ea; psb += eb; w_[q] = cvt_pk_bf16(ea, eb); } \
                    pf[ks_] = __builtin_bit_cast(bf16x8, w_); } while (0)
                bf16x8 vf[2][4];
#define ATT_LOADV(buf, ks_) do { _Pragma("unroll") for (int c = 0; c < 4; ++c) { const unsigned chv = (unsigned)(4 * c + 2 * blk + (pp >> 1)); const unsigned row0 = 16u * (ks_) + 4u * hi + q4; \
                        vf[buf][c] = cat8(vtr(Vt + off_b(row0, chv) + 8u * (pp & 1)), vtr(Vt + off_b(row0 + 8u, chv) + 8u * (pp & 1))); } } while (0)
                ATT_LOADV(0, 0);
                ATT_EXPK(0);
                if (t + 3 < NT) ATT_TILE_DMA(t + 3);
#pragma unroll
                for (int ks = 0; ks < 4; ++ks) {
                    if (ks < 3) ATT_LOADV((ks + 1) & 1, ks + 1);
                    __builtin_amdgcn_sched_barrier(0);
#pragma unroll
                    for (int c = 0; c < 4; ++c) o[c] = __builtin_amdgcn_mfma_f32_32x32x16_bf16(vf[ks & 1][c], pf[ks], o[c], 0, 0, 0);
                    if (ks < 3) { ATT_EXPK(ks + 1); asm volatile("" : "+v"(pf[(ks + 1) & 3]), "+v"(psa), "+v"(psb)); }
                    __builtin_amdgcn_sched_barrier(0);
                }
                lrun += psa + psb;
#undef ATT_EXPK
#undef ATT_LOADV
            }
        }
    }
#undef ATT_TILE_DMA
#undef WAIT_BAR_N
    WAIT_ALL_BAR();
    lrun += __shfl_xor(lrun, 32);
    const float inv = 1.0f / lrun;
    float lam;
    { float s1 = 0.f, s2 = 0.f; const float a1 = p.in[10][lane] * p.in[11][lane], a2 = p.in[12][lane] * p.in[13][lane]; s1 = wave_sum(a1); s2 = wave_sum(a2);
      const float lam_init = 0.8f - 0.6f * 1.0f;
      lam = expf(s1) - expf(s2) + lam_init; }
    LAS float* xch = (LAS float*)lds + qs * 4096;
    if (map == 1) {
#pragma unroll
        for (int c = 0; c < 4; ++c)
#pragma unroll
            for (int r = 0; r < 16; ++r) xch[(32 * c + crow(r, hi)) * 32 + r32] = o[c][r] * inv * lam;
    }
    __syncthreads();
    if (map == 0) {
        float ss = 0.f;
#pragma unroll
        for (int c = 0; c < 4; ++c)
#pragma unroll
            for (int r = 0; r < 16; ++r) { const float v = o[c][r] * inv - xch[(32 * c + crow(r, hi)) * 32 + r32]; o[c][r] = v; ss += v * v; }
        ss += __shfl_xor(ss, 32);
        const float rstd = 1.0f / sqrtf(ss * (1.0f / 128.0f) + NORM_EPS) * 0.8f;
        const float* sub = p.in[14];
        bf16_t* orow = CAT + (rowbase + qrow) * D + 512 + hd * 128;
#pragma unroll
        for (int c = 0; c < 4; ++c)
#pragma unroll
            for (int rq = 0; rq < 4; ++rq) { const int e0 = 32 * c + 8 * rq + 4 * hi; const f32x4 sv = *(const f32x4*)(sub + e0);
                u32x2 w; w.x = cvt_pk_bf16(o[c][4 * rq] * rstd * sv[0], o[c][4 * rq + 1] * rstd * sv[1]); w.y = cvt_pk_bf16(o[c][4 * rq + 2] * rstd * sv[2], o[c][4 * rq + 3] * rstd * sv[3]);
                *(u32x2*)(orow + e0) = w; }
    }
    __syncthreads();
}

__device__ __forceinline__ void mlstm_s1_unit(const Params& p, LAS unsigned char* lds, int bh, int c, int tid_, int wave, int lane_) {
    int tid = tid_; asm volatile("" : "+v"(tid)); const int lane = tid & 63;
    const bf16_t* P = (const bf16_t*)(p.ws + WS_P);
    const int b = bh >> 2, hd = bh & 3, r32 = lane & 31, hi = lane >> 5;
    const size_t t0 = (size_t)b * SEQ + (size_t)c * MCH;
    const float* SA = (const float*)(p.ws + WS_SA) + (size_t)bh * SEQ + c * MCH;
    LAS float* fs = (LAS float*)(lds + MISC_OFF) + MW_F;
    LAS float* wsm = fs;
    LAS float* red = fs + 256;
    float av = (tid < 256) ? SA[tid] : -INFINITY;
    float mx = av;
#pragma unroll
    for (int o = 1; o < 64; o <<= 1) mx = fmaxf(mx, __shfl_xor(mx, o));
    if (lane == 0) red[wave] = mx;
    __syncthreads();
    float R = red[0];
#pragma unroll
    for (int w = 1; w < 4; ++w) R = fmaxf(R, red[w]);
    if (tid < 256) wsm[tid] = __expf(av - R) * 0.08838834764831845f;
    __syncthreads();
    LAS unsigned char* Kl = lds; LAS unsigned char* Vl = lds + 65536;
    const bf16_t* Kg = P + t0 * NP + P_MK + hd * 128; const bf16_t* Vg = P + t0 * NP + P_MV + hd * 128;
#pragma unroll
    for (int i = 0; i < 8; ++i) { const int n = tid + 512 * i, row = n >> 4, ch = n & 15;
        const u32x4 kv = *(const u32x4*)(Kg + (size_t)row * NP + ch * 8); const u32x4 vv = *(const u32x4*)(Vg + (size_t)row * NP + ch * 8);
        const float w = wsm[row]; u32x4 ks;
#pragma unroll
        for (int q = 0; q < 4; ++q) ks[q] = cvt_pk_bf16(bf_lo(kv[q]) * w, bf_hi(kv[q]) * w);
        *(LAS u32x4*)(Kl + off_b(row, ch)) = ks; *(LAS u32x4*)(Vl + off_b(row, ch)) = vv; }
    __syncthreads();
    const int eb = wave >> 1, dh = wave & 1;
    const unsigned q4 = (lane & 15) >> 2, pp = lane & 3, blk = (lane >> 4) & 1;
    f32x16 acc[2]; acc[0] = (f32x16){}; acc[1] = (f32x16){};
    for (int ks = 0; ks < 16; ++ks) {
        const unsigned row0 = 16u * ks + 8u * hi + q4, row1 = row0 + 4u;
        const unsigned cha = (unsigned)(4 * eb + 2 * blk + (pp >> 1));
        const bf16x8 af = cat8(vtr(Vl + off_b(row0, cha) + 8u * (pp & 1)), vtr(Vl + off_b(row1, cha) + 8u * (pp & 1)));
#pragma unroll
        for (int db = 0; db < 2; ++db) { const unsigned chb = (unsigned)(4 * (2 * dh + db) + 2 * blk + (pp >> 1));
            const bf16x8 bfr = cat8(vtr(Kl + off_b(row0, chb) + 8u * (pp & 1)), vtr(Kl + off_b(row1, chb) + 8u * (pp & 1)));
            acc[db] = __builtin_amdgcn_mfma_f32_32x32x16_bf16(af, bfr, acc[db], 0, 0, 0); }
    }
    const int unit = bh * NCH + c;
    float* UT = (float*)(p.ws + WS_UT) + (size_t)unit * 16384;
#pragma unroll
    for (int db = 0; db < 2; ++db)
#pragma unroll
        for (int r = 0; r < 16; ++r) UT[(32 * eb + crow(r, hi)) * 128 + 64 * dh + 32 * db + r32] = acc[db][r];
    if (tid < 128) { float s = 0.f; const int d = tid;
        for (int srow = 0; srow < 256; ++srow) { const unsigned short hv = *(const LAS unsigned short*)(Kl + off_b(srow, d >> 3) + (d & 7) * 2); s += __uint_as_float((unsigned)hv << 16); }
        ((float*)(p.ws + WS_UN))[(size_t)unit * 128 + d] = s; }
    if (tid == 0) ((float*)(p.ws + WS_UR))[unit] = R;
    __syncthreads();
}

__device__ __forceinline__ void mlstm_s3_unit(const Params& p, LAS unsigned char* lds, int bh, int c, int tid_, int wave, int lane_) {
    int tid = tid_; asm volatile("" : "+v"(tid)); const int lane = tid & 63;
    const bf16_t* P = (const bf16_t*)(p.ws + WS_P); bf16_t* CAT = (bf16_t*)(p.ws + WS_CAT);
    const int b = bh >> 2, hd = bh & 3, r32 = lane & 31, hi = lane >> 5;
    const size_t t0 = (size_t)b * SEQ + (size_t)c * MCH;
    const size_t so = (size_t)bh * SEQ + c * MCH;
    const float* SA = (const float*)(p.ws + WS_SA) + so; const float* SAM = (const float*)(p.ws + WS_SAM) + so; const float* SBA = (const float*)(p.ws + WS_SBA) + so;
    LAS float* fs = (LAS float*)(lds + MISC_OFF) + MW_F;
    LAS float* as = fs;
    LAS float* nC = fs + 256;
    LAS unsigned char* Ct = lds + 65536;
    const int qloc = 32 * wave + r32;
    const float Aq = SAM[qloc], BAq = SBA[qloc];
    if (tid < 256) as[tid] = SA[tid];
    bf16x8 qf[8];
    { const bf16_t* qp = P + (t0 + qloc) * NP + P_MQ + hd * 128 + hi * 8;
#pragma unroll
      for (int ks = 0; ks < 8; ++ks) qf[ks] = *(const bf16x8*)(qp + ks * 16); }
    const bf16_t* Kg = P + t0 * NP + P_MK + hd * 128; const bf16_t* Vg = P + t0 * NP + P_MV + hd * 128;
#if defined(S3_REGSTAGE)
    { TileRegs k0 = tile_load(Kg, tid), v0 = tile_load(Vg, tid); tile_write(lds, tid, k0); tile_write(lds + 16384, tid, v0); }
#elif !defined(S3_SERIAL)
    tile_dma(Kg, lds, wave, lane); tile_dma(Vg, lds + 16384, wave, lane);
#endif
    f32x16 o[4];
#pragma unroll
    for (int cb = 0; cb < 4; ++cb) o[cb] = (f32x16){};
    float den = 0.f, fst = 0.f;
    const unsigned xr = ((unsigned)(r32 & 3) << 2) | ((unsigned)(r32 >> 2) & 3u);
    if (c > 0) {
        const float* UR = (const float*)(p.ws + WS_UR) + bh * NCH; const float* UT = (const float*)(p.ws + WS_UT) + (size_t)bh * NCH * 16384; const float* UN = (const float*)(p.ws + WS_UN) + (size_t)bh * NCH * 128;
        float Pref = -INFINITY, ur[7];
#pragma unroll
        for (int j = 0; j < 7; ++j) { ur[j] = UR[j]; if (j < c) Pref = fmaxf(Pref, ur[j]); }
        float cf[7];
#pragma unroll
        for (int j = 0; j < 7; ++j) cf[j] = (j < c) ? __expf(ur[j] - Pref) : 0.f;
#pragma unroll 1
        for (int i = 0; i < 4; ++i) { const int n = tid + 512 * i, e = n >> 4, ch = n & 15; f32x4 u0[7], u1[7];
#pragma unroll
            for (int j = 0; j < 7; ++j) { const f32x4* up = (const f32x4*)(UT + (size_t)j * 16384 + e * 128 + ch * 8); u0[j] = up[0]; u1[j] = up[1]; }
            f32x4 s0 = (f32x4){0.f, 0.f, 0.f, 0.f}, s1 = s0;
#pragma unroll
            for (int j = 0; j < 7; ++j) { s0 += u0[j] * cf[j]; s1 += u1[j] * cf[j]; }
            u32x4 w; w.x = cvt_pk_bf16(s0[0], s0[1]); w.y = cvt_pk_bf16(s0[2], s0[3]); w.z = cvt_pk_bf16(s1[0], s1[1]); w.w = cvt_pk_bf16(s1[2], s1[3]);
            *(LAS u32x4*)(Ct + off_b(e, ch)) = w; }
        if (tid < 128) { float sN = 0.f;
#pragma unroll
            for (int j = 0; j < 7; ++j) sN += cf[j] * UN[j * 128 + tid];
            nC[tid] = sN; }
        fst = __expf(Pref - Aq);
    }
    asm volatile("" :: "v"(qf[0]), "v"(qf[1]), "v"(qf[2]), "v"(qf[3]), "v"(qf[4]), "v"(qf[5]), "v"(qf[6]), "v"(qf[7]), "v"(Aq), "v"(BAq));
    WAIT_ALL_BAR();
    if (c > 0) {
#pragma unroll
        for (int cb = 0; cb < 4; ++cb) {
#pragma unroll
            for (int ks = 0; ks < 8; ++ks) { const unsigned ch = (unsigned)(2 * ks + hi) ^ xr;
                const bf16x8 cfr = *(const LAS bf16x8*)(Ct + 256u * (32 * cb + r32) + 16u * ch);
                o[cb] = __builtin_amdgcn_mfma_f32_32x32x16_bf16(cfr, qf[ks], o[cb], 0, 0, 0); }
            __builtin_amdgcn_sched_barrier(0); }
#pragma unroll
        for (int cb = 0; cb < 4; ++cb)
#pragma unroll
            for (int r = 0; r < 16; ++r) o[cb][r] *= fst;
        float dq = 0.f;
#pragma unroll
        for (int ks = 0; ks < 8; ++ks)
#pragma unroll
            for (int q = 0; q < 4; ++q) { const unsigned w = ((const unsigned*)&qf[ks])[q]; const int d = 16 * ks + 8 * hi + 2 * q; dq += bf_lo(w) * nC[d] + bf_hi(w) * nC[d + 1]; }
        den = fst * dq;
    }
    const unsigned q4 = (lane & 15) >> 2, pp = lane & 3, blk = (lane >> 4) & 1;
#pragma unroll 1
    for (int j = 0; j < 4; ++j) {
        WAIT_ALL_BAR();
        const LAS unsigned char* Kt = lds + (j & 1) * 32768; const LAS unsigned char* Vt = Kt + 16384;
#if defined(S3_REGSTAGE)
        TileRegs kr, vr; if (j + 1 < 4) { kr = tile_load(Kg + (size_t)(j + 1) * 64 * NP, tid); vr = tile_load(Vg + (size_t)(j + 1) * 64 * NP, tid); }
#elif defined(S3_SERIAL)
        { LAS unsigned char* nb = lds + (j & 1) * 32768; tile_dma(Kg + (size_t)j * 64 * NP, nb, wave, lane); tile_dma(Vg + (size_t)j * 64 * NP, nb + 16384, wave, lane); }
        WAIT_ALL_BAR();
#else
        if (j + 1 < 4) { LAS unsigned char* nb = lds + ((j + 1) & 1) * 32768; tile_dma(Kg + (size_t)(j + 1) * 64 * NP, nb, wave, lane); tile_dma(Vg + (size_t)(j + 1) * 64 * NP, nb + 16384, wave, lane); }
#endif
        const bool doit = (64 * j <= 32 * wave + 31);
        bf16x8 pf[4];
        if (doit) {
            f32x16 p0 = (f32x16){}, p1 = (f32x16){};
#pragma unroll
            for (int ks = 0; ks < 8; ++ks) { const unsigned ch = (unsigned)(2 * ks + hi) ^ xr;
                const bf16x8 k0 = *(const LAS bf16x8*)(Kt + 256u * r32 + 16u * ch), k1 = *(const LAS bf16x8*)(Kt + 256u * (32 + r32) + 16u * ch);
                p0 = __builtin_amdgcn_mfma_f32_32x32x16_bf16(k0, qf[ks], p0, 0, 0, 0); p1 = __builtin_amdgcn_mfma_f32_32x32x16_bf16(k1, qf[ks], p1, 0, 0, 0); if ((ks & 3) == 3) __builtin_amdgcn_sched_barrier(0); }
            float ps = 0.f;
#pragma unroll
            for (int r = 0; r < 16; ++r) { const int kv = 64 * j + crow(r, hi);
                const float w0 = (kv <= qloc) ? __expf(as[kv] - Aq) * 0.08838834764831845f : 0.f, w1 = (kv + 32 <= qloc) ? __expf(as[kv + 32] - Aq) * 0.08838834764831845f : 0.f;
                p0[r] *= w0; p1[r] *= w1; ps += p0[r] + p1[r]; }
            den += ps;
#pragma unroll
            for (int ks = 0; ks < 4; ++ks) { u32x4 w;
#pragma unroll
                for (int q = 0; q < 4; ++q) { const int r = 8 * (ks & 1) + 2 * q; w[q] = (ks < 2) ? cvt_pk_bf16(p0[r], p0[r + 1]) : cvt_pk_bf16(p1[r], p1[r + 1]); }
                pf[ks] = __builtin_bit_cast(bf16x8, w); }
        }
        WAIT_ALL_BAR();
        if (doit) {
            bf16x8 vf[2][4];
#define S3_LOADV(buf, ks_) do { _Pragma("unroll") for (int cb = 0; cb < 4; ++cb) { const unsigned chv = (unsigned)(4 * cb + 2 * blk + (pp >> 1)); const unsigned row0 = 16u * (ks_) + 4u * hi + q4; \
                vf[buf][cb] = cat8(vtr(Vt + off_b(row0, chv) + 8u * (pp & 1)), vtr(Vt + off_b(row0 + 8u, chv) + 8u * (pp & 1))); } } while (0)
            S3_LOADV(0, 0);
#pragma unroll
            for (int ks = 0; ks < 4; ++ks) {
                if (ks < 3) S3_LOADV((ks + 1) & 1, ks + 1);
                __builtin_amdgcn_sched_barrier(0);
#pragma unroll
                for (int cb = 0; cb < 4; ++cb) o[cb] = __builtin_amdgcn_mfma_f32_32x32x16_bf16(vf[ks & 1][cb], pf[ks], o[cb], 0, 0, 0);
                __builtin_amdgcn_sched_barrier(0);
            }
#undef S3_LOADV
        }
#if defined(S3_REGSTAGE)
        if (j + 1 < 4) { LAS unsigned char* nb = lds + ((j + 1) & 1) * 32768; tile_write(nb, tid, kr); tile_write(nb + 16384, tid, vr); }
#endif
    }
    den += __shfl_xor(den, 32);
    const float dinv = 1.0f / fmaxf(fabsf(den), __expf(-BAq));
    float sm = 0.f;
#pragma unroll
    for (int cb = 0; cb < 4; ++cb)
#pragma unroll
        for (int r = 0; r < 16; ++r) { o[cb][r] *= dinv; sm += o[cb][r]; }
    sm += __shfl_xor(sm, 32);
    const float mu = sm * (1.0f / 128.0f);
    float vs = 0.f;
#pragma unroll
    for (int cb = 0; cb < 4; ++cb)
#pragma unroll
        for (int r = 0; r < 16; ++r) { o[cb][r] -= mu; vs += o[cb][r] * o[cb][r]; }
    vs += __shfl_xor(vs, 32);
    const float rstd = 1.0f / sqrtf(vs * (1.0f / 128.0f) + NORM_EPS);
    const float* hn = p.in[9] + hd * 128;
    const bf16_t* mo = P + (t0 + qloc) * NP + P_MO + hd * 128;
    bf16_t* orow = CAT + (t0 + qloc) * D + hd * 128;
    u32x2 mw[4][4];
#pragma unroll
    for (int cb = 0; cb < 4; ++cb)
#pragma unroll
        for (int rq = 0; rq < 4; ++rq) mw[cb][rq] = *(const u32x2*)(mo + 32 * cb + 8 * rq + 4 * hi);
#pragma unroll
    for (int cb = 0; cb < 4; ++cb)
#pragma unroll
        for (int rq = 0; rq < 4; ++rq) { const int e0 = 32 * cb + 8 * rq + 4 * hi; const f32x4 hv = *(const f32x4*)(hn + e0); const u32x2 m2 = mw[cb][rq];
            const float g0 = fast_rcp(1.0f + __expf(-bf_lo(m2.x))), g1 = fast_rcp(1.0f + __expf(-bf_hi(m2.x))), g2 = fast_rcp(1.0f + __expf(-bf_lo(m2.y))), g3 = fast_rcp(1.0f + __expf(-bf_hi(m2.y)));
            u32x2 w; w.x = cvt_pk_bf16(o[cb][4 * rq] * rstd * hv[0] * g0, o[cb][4 * rq + 1] * rstd * hv[1] * g1); w.y = cvt_pk_bf16(o[cb][4 * rq + 2] * rstd * hv[2] * g2, o[cb][4 * rq + 3] * rstd * hv[3] * g3);
            *(u32x2*)(orow + e0) = w; }
    WAIT_ALL_BAR();
}

__device__ __forceinline__ void mlstm_seq_unit(const Params& p, LAS unsigned char* lds, int bh, int tid_, int wave, int lane_) {
    int tid = tid_; asm volatile("" : "+v"(tid)); const int lane = tid & 63;
    const bf16_t* P = (const bf16_t*)(p.ws + WS_P); bf16_t* CAT = (bf16_t*)(p.ws + WS_CAT);
    const int b = bh >> 2, hd = bh & 3, r32 = lane & 31, hi = lane >> 5;
    LAS float* fs = (LAS float*)(lds + MISC_OFF) + MW_F;
    LAS float* as = fs;
    LAS float* nC = fs + 256;
    LAS float* wsc = fs + 384;
    LAS unsigned char* Ct = lds + 65536;
    const unsigned xr = ((unsigned)(r32 & 3) << 2) | ((unsigned)(r32 >> 2) & 3u);
    const unsigned q4 = (lane & 15) >> 2, pp = lane & 3, blk = (lane >> 4) & 1;
    const int eb = wave >> 1, dh = wave & 1;
    f32x16 cacc[2]; cacc[0] = (f32x16){}; cacc[1] = (f32x16){};
    float nrun = 0.f;
    float Prun = -INFINITY;
    LAS float* hnl = fs + 896;
    if (tid < 128) hnl[tid] = p.in[9][hd * 128 + tid];
#pragma unroll 1
    for (int c = 0; c < NCH; ++c) {
        const size_t t0 = (size_t)b * SEQ + (size_t)c * MCH;
        const size_t so = (size_t)bh * SEQ + c * MCH;
        const float* SA = (const float*)(p.ws + WS_SA) + so; const float* SAM = (const float*)(p.ws + WS_SAM) + so; const float* SBA = (const float*)(p.ws + WS_SBA) + so;
        const int qloc = 32 * wave + r32;
        const float Aq2 = SAM[qloc] * 1.4426950408889634f;
        if (tid < 256) as[tid] = SA[tid] * 1.4426950408889634f;
        bf16x8 qf[2];
        LAS bf16x8* qpark = (LAS bf16x8*)(lds + 98304 + tid * 64);
        LAS bf16x8* qpark2 = (LAS bf16x8*)(lds + 147456 + tid * 32);
        { const bf16_t* qp = P + (t0 + qloc) * NP + P_MQ + hd * 128 + hi * 8;
#pragma unroll
          for (int ks = 0; ks < 2; ++ks) qf[ks] = *(const bf16x8*)(qp + ks * 16);
#pragma unroll
          for (int ks = 2; ks < 6; ++ks) qpark[ks - 2] = *(const bf16x8*)(qp + ks * 16);
#pragma unroll
          for (int ks = 6; ks < 8; ++ks) qpark2[ks - 6] = *(const bf16x8*)(qp + ks * 16); }
#define QFRAG(ks) ((ks) < 2 ? qf[(ks) & 1] : ((ks) < 6 ? qpark[((ks) - 2) & 3] : qpark2[((ks) - 6) & 1]))
        const bf16_t* Kg = P + t0 * NP + P_MK + hd * 128; const bf16_t* Vg = P + t0 * NP + P_MV + hd * 128;
        tile_dma(Kg, lds, wave, lane); tile_dma(Vg, lds + 16384, wave, lane);
        asm volatile("" :: "v"(qf[0]), "v"(qf[1]), "v"(Aq2));
        WAIT_ALL_BAR();
        float R = fmaxf(fmaxf(as[lane], as[lane + 64]), fmaxf(as[lane + 128], as[lane + 192]));
#pragma unroll
        for (int o = 1; o < 64; o <<= 1) R = fmaxf(R, __shfl_xor(R, o));
        R *= (1.0f / 1.4426950408889634f);
        const float Pnew = fmaxf(Prun, R);
        const float scC = (c > 0) ? __expf(Prun - Pnew) : 0.f;
        if (tid < 256) wsc[tid] = fast_exp2(as[tid] - Pnew * 1.4426950408889634f) * 0.08838834764831845f;
        f32x16 o[4];
#pragma unroll
        for (int cb = 0; cb < 4; ++cb) o[cb] = (f32x16){};
        float den = 0.f;
        if (c > 0) {
#pragma unroll
            for (int cb = 0; cb < 4; ++cb) {
#pragma unroll
                for (int ks = 0; ks < 8; ++ks) { const unsigned ch = (unsigned)(2 * ks + hi) ^ xr;
                    const bf16x8 cfr = *(const LAS bf16x8*)(Ct + 256u * (32 * cb + r32) + 16u * ch);
                    const bf16x8 qv = QFRAG(ks);
                    o[cb] = __builtin_amdgcn_mfma_f32_32x32x16_bf16(cfr, qv, o[cb], 0, 0, 0); }
                __builtin_amdgcn_sched_barrier(0); }
            const float fst = fast_exp2(Prun * 1.4426950408889634f - Aq2);
#pragma unroll
            for (int cb = 0; cb < 4; ++cb)
#pragma unroll
                for (int r = 0; r < 16; ++r) o[cb][r] *= fst;
            float dq = 0.f;
#pragma unroll
            for (int ks = 0; ks < 8; ++ks) { const bf16x8 qv = QFRAG(ks);
#pragma unroll
                for (int q = 0; q < 4; ++q) { const unsigned w = ((const unsigned*)&qv)[q]; const int d = 16 * ks + 8 * hi + 2 * q; dq += bf_lo(w) * nC[d] + bf_hi(w) * nC[d + 1]; } }
            den = fst * dq;
#pragma unroll
            for (int r = 0; r < 16; ++r) { cacc[0][r] *= scC; cacc[1][r] *= scC; }
        }
        nrun *= scC;
#pragma unroll 1
        for (int j = 0; j < 4; ++j) {
            WAIT_ALL_BAR();
            const LAS unsigned char* Kt = lds + (j & 1) * 32768; const LAS unsigned char* Vt = Kt + 16384;
            if (j + 1 < 4) { LAS unsigned char* nb = lds + ((j + 1) & 1) * 32768; tile_dma(Kg + (size_t)(j + 1) * 64 * NP, nb, wave, lane); tile_dma(Vg + (size_t)(j + 1) * 64 * NP, nb + 16384, wave, lane); }
            const bool doit = (64 * j <= 32 * wave + 31);
            if (doit) {
                float ps = 0.f;
#pragma unroll
                for (int hf = 0; hf < 2; ++hf) {
                    f32x16 pp0 = (f32x16){};
#pragma unroll
                    for (int ks = 0; ks < 8; ++ks) { const unsigned ch = (unsigned)(2 * ks + hi) ^ xr;
                        const bf16x8 k0 = *(const LAS bf16x8*)(Kt + 256u * (32 * hf + r32) + 16u * ch);
                        const bf16x8 qv = QFRAG(ks);
                        pp0 = __builtin_amdgcn_mfma_f32_32x32x16_bf16(k0, qv, pp0, 0, 0, 0); }
#pragma unroll
                    for (int r = 0; r < 16; ++r) { const int kv = 64 * j + 32 * hf + crow(r, hi);
                        const float w0 = (kv <= qloc) ? fast_exp2(as[kv] - Aq2) * 0.08838834764831845f : 0.f;
                        pp0[r] *= w0; ps += pp0[r]; }
                    bf16x8 pfh[2];
#pragma unroll
                    for (int k2 = 0; k2 < 2; ++k2) { u32x4 w;
#pragma unroll
                        for (int q = 0; q < 4; ++q) { const int r = 8 * k2 + 2 * q; w[q] = cvt_pk_bf16(pp0[r], pp0[r + 1]); }
                        pfh[k2] = __builtin_bit_cast(bf16x8, w); }
                    __builtin_amdgcn_sched_barrier(0);
#pragma unroll
                    for (int k2 = 0; k2 < 2; ++k2)
#pragma unroll
                        for (int c2 = 0; c2 < 2; ++c2) {
                            bf16x8 vf[2];
#pragma unroll
                            for (int u = 0; u < 2; ++u) { const int cb = 2 * c2 + u; const unsigned chv = (unsigned)(4 * cb + 2 * blk + (pp >> 1)); const unsigned row0 = 16u * (2 * hf + k2) + 4u * hi + q4;
                                vf[u] = cat8(vtr(Vt + off_b(row0, chv) + 8u * (pp & 1)), vtr(Vt + off_b(row0 + 8u, chv) + 8u * (pp & 1))); }
                            o[2 * c2] = __builtin_amdgcn_mfma_f32_32x32x16_bf16(vf[0], pfh[k2], o[2 * c2], 0, 0, 0); o[2 * c2 + 1] = __builtin_amdgcn_mfma_f32_32x32x16_bf16(vf[1], pfh[k2], o[2 * c2 + 1], 0, 0, 0);
                            __builtin_amdgcn_sched_barrier(0);
                        }
                }
                den += ps;
            }
#pragma unroll
            for (int ks = 0; ks < 4; ++ks) {
                const unsigned row0 = 16u * ks + 8u * hi + q4, row1 = row0 + 4u;
                const unsigned cha = (unsigned)(4 * eb + 2 * blk + (pp >> 1));
                const bf16x8 af = cat8(vtr(Vt + off_b(row0, cha) + 8u * (pp & 1)), vtr(Vt + off_b(row1, cha) + 8u * (pp & 1)));
                const f32x4 wa = *(const LAS f32x4*)(wsc + 64 * j + 16 * ks + 8 * hi), wb = *(const LAS f32x4*)(wsc + 64 * j + 16 * ks + 8 * hi + 4);
#pragma unroll
                for (int db = 0; db < 2; ++db) { const unsigned chb = (unsigned)(4 * (2 * dh + db) + 2 * blk + (pp >> 1));
                    const s16x4 k0 = vtr(Kt + off_b(row0, chb) + 8u * (pp & 1)), k1 = vtr(Kt + off_b(row1, chb) + 8u * (pp & 1));
                    const u32x2 u0 = __builtin_bit_cast(u32x2, k0), u1 = __builtin_bit_cast(u32x2, k1);
                    u32x4 kw; kw.x = cvt_pk_bf16(bf_lo(u0.x) * wa[0], bf_hi(u0.x) * wa[1]); kw.y = cvt_pk_bf16(bf_lo(u0.y) * wa[2], bf_hi(u0.y) * wa[3]);
                    kw.z = cvt_pk_bf16(bf_lo(u1.x) * wb[0], bf_hi(u1.x) * wb[1]); kw.w = cvt_pk_bf16(bf_lo(u1.y) * wb[2], bf_hi(u1.y) * wb[3]);
                    cacc[db] = __builtin_amdgcn_mfma_f32_32x32x16_bf16(af, __builtin_bit_cast(bf16x8, kw), cacc[db], 0, 0, 0); }
                __builtin_amdgcn_sched_barrier(0);
            }
            { const int d = tid & 127, sq = tid >> 7; float sN = 0.f;
#pragma unroll 4
                for (int s2 = 0; s2 < 16; ++s2) { const int srow = 16 * sq + s2; const unsigned short hv = *(const LAS unsigned short*)(Kt + off_b(srow, d >> 3) + (d & 7) * 2); sN += __uint_as_float((unsigned)hv << 16) * wsc[64 * j + srow]; }
                nrun += sN; }
            WAIT_ALL_BAR();
        }
        int tid2 = tid_; asm volatile("" : "+v"(tid2));
        const int qloc2 = 32 * wave + (tid2 & 31), hi2 = (tid2 >> 5) & 1;
        const float BAq = SBA[qloc2];
        den += __shfl_xor(den, 32);
        const float dinv = 1.0f / fmaxf(fabsf(den), __expf(-BAq));
        float sm = 0.f;
#pragma unroll
        for (int cb = 0; cb < 4; ++cb)
#pragma unroll
            for (int r = 0; r < 16; ++r) { o[cb][r] *= dinv; sm += o[cb][r]; }
        sm += __shfl_xor(sm, 32);
        const float mu = sm * (1.0f / 128.0f);
        float vs = 0.f;
#pragma unroll
        for (int cb = 0; cb < 4; ++cb)
#pragma unroll
            for (int r = 0; r < 16; ++r) { o[cb][r] -= mu; vs += o[cb][r] * o[cb][r]; }
        vs += __shfl_xor(vs, 32);
        const float rstd = 1.0f / sqrtf(vs * (1.0f / 128.0f) + NORM_EPS);
        const bf16_t* mo = P + (t0 + qloc2) * NP + P_MO + hd * 128 + 4 * hi2;
        bf16_t* orow = CAT + (t0 + qloc2) * D + hd * 128 + 4 * hi2;
#pragma unroll
        for (int c2 = 0; c2 < 2; ++c2) {
            u32x2 mw[8];
#pragma unroll
            for (int u = 0; u < 8; ++u) mw[u] = *(const u32x2*)(mo + 32 * (2 * c2 + (u >> 2)) + 8 * (u & 3));
#pragma unroll
            for (int u = 0; u < 8; ++u) { const int cb = 2 * c2 + (u >> 2), rq = u & 3; const int e0 = 32 * cb + 8 * rq; const u32x2 m2 = mw[u]; const f32x4 hv = *(const LAS f32x4*)(hnl + e0 + 4 * hi2);
                const float g0 = fast_rcp(1.0f + fast_exp2(-1.4426950408889634f * bf_lo(m2.x))), g1 = fast_rcp(1.0f + fast_exp2(-1.4426950408889634f * bf_hi(m2.x))), g2 = fast_rcp(1.0f + fast_exp2(-1.4426950408889634f * bf_lo(m2.y))), g3 = fast_rcp(1.0f + fast_exp2(-1.4426950408889634f * bf_hi(m2.y)));
                u32x2 w; w.x = cvt_pk_bf16(o[cb][4 * rq] * rstd * hv[0] * g0, o[cb][4 * rq + 1] * rstd * hv[1] * g1); w.y = cvt_pk_bf16(o[cb][4 * rq + 2] * rstd * hv[2] * g2, o[cb][4 * rq + 3] * rstd * hv[3] * g3);
                *(u32x2*)(orow + e0) = w; }
            __builtin_amdgcn_sched_barrier(0); }
        if (c + 1 < NCH) {
#pragma unroll
            for (int db = 0; db < 2; ++db)
#pragma unroll
                for (int r = 0; r < 16; ++r) { const int e = 32 * eb + crow(r, hi), d = 64 * dh + 32 * db + r32;
                    *(LAS unsigned short*)(Ct + off_b(e, d >> 3) + (d & 7) * 2) = (unsigned short)(cvt_pk_bf16(cacc[db][r], 0.f) & 0xffffu); }
            wsc[tid] = nrun;
        }
        Prun = Pnew;
        WAIT_ALL_BAR();
        if (c + 1 < NCH) { if (tid < 128) nC[tid] = (wsc[tid] + wsc[tid + 128]) + (wsc[tid + 256] + wsc[tid + 384]); }
    }
#undef QFRAG
}

__device__ __forceinline__ int moe_table(LAS unsigned char* lds, unsigned* cnt, int tid) {
    LAS int* misc = (LAS int*)(lds + MISC_OFF);
    __syncthreads();
    if (tid == 0) { int acc = 0; for (int e = 0; e < 16; ++e) { const int c = (int)__hip_atomic_load(cnt + e * 64, __ATOMIC_RELAXED, __HIP_MEMORY_SCOPE_AGENT); misc[MW_CN + e] = c; misc[MW_TB + e] = acc; acc += (c + 255) >> 8; } misc[MW_TB + 16] = acc; }
    __syncthreads();
    return misc[MW_TB + 16];
}

#ifndef STAGGER_MASK
#define STAGGER_MASK 0u
#endif
#ifndef STAGGER_GROUPS
#define STAGGER_GROUPS 4
#endif
#ifndef STAGGER_TICKS
#define STAGGER_TICKS 700
#endif
__device__ __forceinline__ void stagger(int vcu, int phase_bit) {
    if (!((STAGGER_MASK >> phase_bit) & 1u)) return;
    const int g = vcu & (STAGGER_GROUPS - 1); if (g == 0) return;
    const unsigned long long t0 = __builtin_amdgcn_s_memrealtime(); const unsigned long long w = (unsigned long long)g * STAGGER_TICKS;
    while (__builtin_amdgcn_s_memrealtime() - t0 < w) __builtin_amdgcn_s_sleep(8);
}
constexpr int LATE_UNITS = 224, LATE_UNITS_A = 160, LATE_UNITS_B = 64, CW_LATEQ = CW_QUEUE + 64 * 8;
template <int QID>
__device__ __forceinline__ void late_convert(const Params& p, LAS unsigned char* lds, unsigned* ctl, int quota, int tid, int wave, int lane) {
    volatile LAS unsigned* misc = (volatile LAS unsigned*)(lds + MISC_OFF);
    for (int k = 0; k < quota; ++k) {
        __syncthreads();
        if (tid == 0) misc[MW_Q] = __hip_atomic_fetch_add(ctl + CW_LATEQ + 64 * QID, 1u, __ATOMIC_RELAXED, __HIP_MEMORY_SCOPE_AGENT);
        __syncthreads();
        const int q = (int)misc[MW_Q];
        if (q >= 4 * (QID == 0 ? LATE_UNITS_A : LATE_UNITS_B)) break;
        const int c = q >> 2, sub = q & 3;
        const int v = QID == 0 ? (c < 32 ? 8 + c : 232 + 12 * ((c - 32) >> 3) + ((c - 32) & 7)) : 232 + 12 * (c >> 2) + 8 + (c & 3);
        const int f = WT_I1 + 64 * v + 16 * sub + 2 * wave;
        phase_prologue_weights(p, lds, f, f + 2, 1, wave, lane);
    }
    __syncthreads();
}
template <int LAYER>
__device__ __forceinline__ void moe_block(const Params& p, LAS unsigned char* lds, const XcdBarrier& bar, unsigned* ctl, int tid, int wave, int lane, int vcu, int G) {
    unsigned char* ws = p.ws;
    const LAS int* tb = (const LAS int*)(lds + MISC_OFF) + MW_TB; const LAS int* cn = (const LAS int*)(lds + MISC_OFF) + MW_CN;
    unsigned* cnt = ctl + CW_CNT + LAYER * 16 * 64;
    if (PH(12)) phase_router(p, lds, tid, wave, G, p.in[3] + LAYER * D, p.in[18] + (size_t)LAYER * D * 4, p.in[19] + LAYER * 4, p.in[20] + (size_t)LAYER * D * 16, p.in[21] + LAYER * 16, cnt);
    xcd_barrier(bar);
    const int ntot = moe_table(lds, cnt, tid);
    stagger(vcu, 13);
    for (int rep_ = 0; rep_ < REPS(13); ++rep_) if (PH(13)) { pg8::MoeSched<true> S{(const char*)(ws + WS_XB8), (const char*)(ws + WS_WGU) + (size_t)LAYER * 16 * 1024 * 1024, 512, (size_t)1024 * 1024, tb, cn, (const unsigned*)(ws + WS_ROWTOK), ntot, vcu, G};
      pg8::EpiPair<1> E{nullptr, (bf16_t*)(ws + WS_HM), FF, (const float*)(ws + WS_RSRAW), (const unsigned*)(ws + WS_ROWTOK), tb, cn};
      pg8::gemm_phase<pg8::EpiPair<1>, pg8::MoeSched<true>, true, true>(lds, 512, S, E); }
    const int nun = ntot * 4, rounds_max = (nun + G - 1) / G, rounds_mine = nun > vcu ? (nun - vcu + G - 1) / G : 0;
    if (LATE_CV && LAYER == 0 && PH(0)) late_convert<0>(p, lds, ctl, 2 * (rounds_max - rounds_mine), tid, wave, lane);
    if (LATE_CV && LAYER == 1 && PH(0)) { late_convert<1>(p, lds, ctl, 2 * (rounds_max - rounds_mine), tid, wave, lane); late_convert<1>(p, lds, ctl, 1 << 20, tid, wave, lane); }
    xcd_barrier(bar);
    stagger(vcu, 14);
    for (int rep_ = 0; rep_ < REPS(14); ++rep_) if (PH(14)) { pg8::MoeSched<false> S{(const char*)(ws + WS_HM), (const char*)(ws + WS_WD) + (size_t)LAYER * 16 * 1024 * 512, 256, (size_t)1024 * 512, tb, cn, nullptr, ntot, vcu, G};
      pg8::EpiDown E{(unsigned char*)(ws + WS_YC), (const float*)(ws + WS_CWRAW), tb, cn};
      pg8::gemm_phase<pg8::EpiDown, pg8::MoeSched<false>, false, true>(lds, 256, S, E); }
    if (LATE_CV && LAYER == 0 && PH(0)) { late_convert<0>(p, lds, ctl, rounds_max - rounds_mine, tid, wave, lane); late_convert<0>(p, lds, ctl, 1 << 20, tid, wave, lane); }
    xcd_barrier(bar);
}

__global__ void __launch_bounds__(NTHR, 2) fwd_kernel(Params p) {
    extern __shared__ __attribute__((aligned(16))) unsigned char lds_raw[];
    LAS unsigned char* lds = (LAS unsigned char*)lds_raw;
    const int tid = threadIdx.x, lane = tid & 63, wave = __builtin_amdgcn_readfirstlane(tid >> 6);
    const int G = gridDim.x; const int bx = blockIdx.x;
    const int vcu = (G % 8 == 0) ? (bx % 8) * (G / 8) + bx / 8 : bx;
    const int gw = vcu * NWAVES + wave, NGW = G * NWAVES;
    volatile LAS unsigned* misc = (volatile LAS unsigned*)(lds + MISC_OFF);
    for (int u = tid; u < (LDS_BYTES - MISC_OFF) / 4; u += NTHR) misc[u] = 0u;
    __syncthreads();
    unsigned* ctl = (unsigned*)(p.ws + WS_CTL);
    XcdBarrier bar = xcd_barrier_post(ctl + CW_BAR, misc + MW_BAR);
    unsigned char* ws = p.ws;

    for (int rep_ = 0; rep_ < REPS(0); ++rep_) if (PH(0)) phase_prologue_weights(p, lds, gw, WT_I1, NGW, wave, lane);
    __syncthreads();
    for (int rep_ = 0; rep_ < REPS(1); ++rep_) if (PH(1)) phase_norm_gates(p, lds, tid, gw, NGW, lane);
    xcd_barrier(bar);

    if (PH(2)) phase_gate_scan(p, gw, NGW, lane);
    stagger(vcu, 3);
    for (int rep_ = 0; rep_ < REPS(3); ++rep_) if (PH(3)) { pg8::DenseSched S; S.init(ws + WS_H, ws + WS_WT1, T, NP, 1024, G, bx); pg8::EpiBf16 E{(bf16_t*)(ws + WS_P), NP};
      pg8::gemm_phase<pg8::EpiBf16, pg8::DenseSched, false>(lds, 1024, S, E); }
    xcd_barrier(bar);

    {
        constexpr int NSEQ = NBATCH * 4, NAT = NBATCH * 4 * 16, NMEM = LATE_CV ? WT_UNITS - LATE_UNITS : WT_UNITS;
        for (int u = bx; u < NSEQ; u += G) { for (int r2 = 0; r2 < REPS(16); ++r2) if (PH(4)) mlstm_seq_unit(p, lds, u, tid, wave, lane); }
        for (int rep_ = 0; rep_ < REPS(4); ++rep_) {
            bool a_done = false, m_done = false; int sa_cnt = 0, sm_cnt = 0; (void)sa_cnt; (void)sm_cnt;
            for (int it = 0; !(a_done && m_done); ++it) {
                const int r5 = it % 5; bool want_mem = (r5 == 1 || r5 == 3);
                if (want_mem && m_done) want_mem = false; else if (!want_mem && a_done) want_mem = true;
                __syncthreads();
#ifdef STATIC_Q
                if (tid == 0) { misc[MW_Q] = (unsigned)((want_mem ? sm_cnt : sa_cnt) * G + bx); }
                if (want_mem) ++sm_cnt; else ++sa_cnt;
#else
                if (tid == 0) misc[MW_Q] = __hip_atomic_fetch_add(ctl + CW_QUEUE + 64 * (2 * rep_ + (want_mem ? 1 : 0)), 1u, __ATOMIC_RELAXED, __HIP_MEMORY_SCOPE_AGENT);
#endif
                __syncthreads();
                const int u = (int)misc[MW_Q];
                if (want_mem) {
                    if (u >= NMEM) { m_done = true; continue; }
                    { const int v = LATE_CV ? (u < 8 ? u : u + 32) : u;        for (int r2 = 0; r2 < REPS(18); ++r2) if (PH(0)) { const int f = WT_I1 + 64 * v + 8 * wave; phase_prologue_weights(p, lds, f, f + 8, 1, wave, lane); } }
                } else {
                    if (u >= NAT) { a_done = true; continue; }
                    for (int r2 = 0; r2 < REPS(17); ++r2) if (PH(5)) attn_unit(p, lds, u & 127, 15 - (u >> 7), tid, wave, lane);
                }
            }
        }
    }
    xcd_barrier(bar);

    for (int rep_ = 0; rep_ < REPS(7); ++rep_) if (PH(7)) { pg8::DenseSched S; S.init(ws + WS_CAT, ws + WS_WT2, T, 1024, 1024, G, bx); pg8::EpiResid<true> E{p.in[0], (bf16_t*)(ws + WS_XB), ws + WS_XB8};
      pg8::gemm_phase<pg8::EpiResid<true>, pg8::DenseSched, false>(lds, 1024, S, E); }
    xcd_barrier(bar);

    moe_block<0>(p, lds, bar, ctl, tid, wave, lane, vcu, G);
    if (PH(8)) phase_rows<0, true>(p, lds, tid, wave, lane, G, p.in[2] + D, nullptr, nullptr, nullptr, nullptr, ctl + CW_CNT, nullptr);
    xcd_barrier(bar);
    stagger(vcu, 9);
    for (int rep_ = 0; rep_ < REPS(9); ++rep_) if (PH(9)) { pg8::DenseSched S; S.init(G3_F8 ? ws + WS_XB8 : ws + WS_XB, ws + WS_WT3, T, 3072, G3_F8 ? 512 : 1024, G, bx); pg8::EpiPair<0> E{(bf16_t*)(ws + WS_BG), (bf16_t*)(ws + WS_Z), D, (const float*)(ws + WS_RSTD), nullptr, nullptr, nullptr};
      pg8::gemm_phase<pg8::EpiPair<0>, pg8::DenseSched, false, G3_F8 != 0>(lds, G3_F8 ? 512 : 1024, S, E); }
    xcd_barrier(bar);
    for (int rep_ = 0; rep_ < REPS(10); ++rep_) if (PH(10)) phase_conv(p, gw, NGW, lane);
    xcd_barrier(bar);
    if (PH(11)) { pg8::DenseSched S; S.init(ws + WS_CAT, ws + WS_WT4, T, 1024, 1024, G, bx); pg8::EpiResid<false> E{nullptr, (bf16_t*)(ws + WS_XB), ws + WS_XB8};
      pg8::gemm_phase<pg8::EpiResid<false>, pg8::DenseSched, false>(lds, 1024, S, E); }
    xcd_barrier(bar);
    moe_block<1>(p, lds, bar, ctl, tid, wave, lane, vcu, G);
    if (PH(15)) phase_rows<2, true>(p, lds, tid, wave, lane, G, p.in[4], nullptr, nullptr, nullptr, nullptr, ctl + CW_CNT + 16 * 64, nullptr);
}

extern "C" void kernel_launch(void* const* d_in, const int* in_sizes, int n_in, void* d_out, int out_size, void* d_ws, size_t ws_size, hipStream_t stream) {
    static int grid = 0;
    if (grid == 0) {
        if (n_in != 25 || in_sizes[0] != T * D || out_size != T * D || ws_size < WS_END) { fprintf(stderr, "kernel_launch: unexpected shapes (n_in %d, in0 %d, out %d, ws %zu)\n", n_in, n_in > 0 ? in_sizes[0] : -1, out_size, ws_size); grid = -1; return; }
        int dev = 0, cus = 0, per_cu = 0;
        if (hipGetDevice(&dev) != hipSuccess || hipDeviceGetAttribute(&cus, hipDeviceAttributeMultiprocessorCount, dev) != hipSuccess) { grid = -1; return; }
        if (hipFuncSetAttribute((const void*)fwd_kernel, hipFuncAttributeMaxDynamicSharedMemorySize, LDS_BYTES) != hipSuccess) { fprintf(stderr, "kernel_launch: hipFuncSetAttribute failed\n"); grid = -1; return; }
        if (hipOccupancyMaxActiveBlocksPerMultiprocessor(&per_cu, (const void*)fwd_kernel, NTHR, LDS_BYTES) != hipSuccess || per_cu < 1) fprintf(stderr, "kernel_launch: occupancy query reports %d\n", per_cu);
        (void)hipGetLastError();
        grid = cus;
    }
    if (grid < 0) return;
    hipMemsetAsync((char*)d_ws + WS_CTL, 0, CTL_ZERO_BYTES, stream);
    Params p{};
    for (int i = 0; i < 25; ++i) p.in[i] = (const float*)d_in[i];
    p.out = (float*)d_out; p.ws = (unsigned char*)d_ws;
    hipLaunchKernelGGL(fwd_kernel, dim3(grid), dim3(NTHR), LDS_BYTES, stream, p);
}
```

```cpp
#include <hip/hip_runtime.h>
#include <cstdio>
#include <cstdint>
#ifndef PHASE_MASK
#define PHASE_MASK 0xffffffffu
#endif
#define PH(k) (((PHASE_MASK) >> (k)) & 1u)
#ifndef PHASE_TWICE
#define PHASE_TWICE 0u
#endif
#define REPS(k) (1 + (int)(((PHASE_TWICE) >> (k)) & 1u))

#define LAS __attribute__((address_space(3)))
#define GAS __attribute__((address_space(1)))
typedef unsigned short bf16_t;
typedef short bf16x8 __attribute__((ext_vector_type(8)));
typedef short s16x4 __attribute__((ext_vector_type(4)));
typedef float f32x4 __attribute__((ext_vector_type(4)));
typedef float f32x2 __attribute__((ext_vector_type(2)));
typedef float f32x16 __attribute__((ext_vector_type(16)));
typedef unsigned u32x4 __attribute__((ext_vector_type(4)));
typedef unsigned u32x2 __attribute__((ext_vector_type(2)));
typedef GAS unsigned gu32;
typedef int i32x8 __attribute__((ext_vector_type(8)));
typedef int i32x4 __attribute__((ext_vector_type(4)));

constexpr int D = 1024, NBATCH = 32, SEQ = 2048, T = NBATCH * SEQ;
constexpr int EVEN_IN = 3592, NP = 3584;
constexpr int P_MQ = 0, P_MK = 512, P_MV = 1024, P_MO = 1536, P_DQ = 2048, P_DK = 2560, P_DV = 3072;
constexpr int NE = 16, FF = 512;
constexpr int ECAP = 65536;
constexpr float NORM_EPS = 1e-6f;
constexpr int NWAVES = 8, NTHR = 512;
constexpr int MCH = 256, NCH = SEQ / MCH;
constexpr int WT_I1 = 16 * 112, WT_ITEMS = 28928, WT_UNITS = (WT_ITEMS - WT_I1) / 64;

constexpr size_t MiB = 1u << 20;
constexpr size_t WS_CTL = 0, CTL_ZERO_BYTES = 1 * MiB;
constexpr size_t WS_WT1 = 1 * MiB, WS_WT2 = 8 * MiB, WS_WT3 = 10 * MiB, WS_WT4 = 16 * MiB, WS_WGU = 18 * MiB, WS_WD = 82 * MiB;
constexpr size_t WS_GATES = 114 * MiB, WS_SA = 116 * MiB, WS_SAM = 117 * MiB, WS_SBA = 118 * MiB, WS_UN = 119 * MiB, WS_UR = 119 * MiB + 768 * 1024;
constexpr size_t WS_UT = 120 * MiB;
constexpr size_t WS_ROWTOK = 184 * MiB, WS_CWRAW = 188 * MiB, WS_TOKINFO = 192 * MiB, WS_RSTD = 193 * MiB;
constexpr size_t WS_H = 194 * MiB, WS_CAT = 322 * MiB, WS_P = 450 * MiB;
constexpr size_t WS_RSRAW = 120 * MiB;
constexpr size_t WS_XB8 = 720 * MiB;
constexpr size_t WS_XB = WS_H;
constexpr size_t WS_BG = WS_P, WS_Z = WS_P + 128 * MiB, WS_HM = WS_P, WS_YC = WS_P + 136 * MiB;
constexpr size_t WS_END = 898 * MiB;
constexpr int CW_BAR = 4096;
constexpr int CW_CNT = 16384;
constexpr int CW_QUEUE = 32768;

__device__ __forceinline__ unsigned cvt_pk_bf16(float lo, float hi) { unsigned r; asm volatile("v_cvt_pk_bf16_f32 %0, %1, %2" : "=v"(r) : "v"(lo), "v"(hi)); return r; }
__device__ __forceinline__ unsigned cvt_pk4_fp8(float a, float b, float c, float d) { unsigned w = 0; w = (unsigned)__builtin_amdgcn_cvt_pk_fp8_f32(a, b, (int)w, false); w = (unsigned)__builtin_amdgcn_cvt_pk_fp8_f32(c, d, (int)w, true); return w; }
#ifndef LATE_CV
#define LATE_CV 1
#endif
#ifndef G3_F8
#define G3_F8 1
#endif
constexpr float F8_WSCALE = 64.0f, F8_HSCALE = 16.0f, F8_YSCALE = 64.0f;
__device__ __forceinline__ float bf_lo(unsigned w) { return __uint_as_float(w << 16); }
__device__ __forceinline__ float bf_hi(unsigned w) { return __uint_as_float(w & 0xffff0000u); }
__device__ __forceinline__ float wave_sum(float v) {
#pragma unroll
    for (int o = 1; o < 64; o <<= 1) v += __shfl_xor(v, o);
    return v;
}
__device__ __forceinline__ float fast_exp2(float x) { return __builtin_amdgcn_exp2f(x); }
__device__ __forceinline__ float fast_rcp(float x) { return __builtin_amdgcn_rcpf(x); }
__device__ __forceinline__ int crow(int r, int hi) { return (r & 3) + 8 * (r >> 2) + 4 * hi; }
__device__ __forceinline__ unsigned off_b(unsigned row, unsigned ch) { return 256u * row + 16u * (ch ^ (((row & 3u) << 2) | ((row >> 2) & 3u))); }
__device__ __forceinline__ s16x4 vtr(const LAS unsigned char* p) { return __builtin_bit_cast(s16x4, __builtin_amdgcn_ds_read_tr16_b64_v4i16((LAS s16x4*)p)); }
__device__ __forceinline__ bf16x8 cat8(s16x4 a, s16x4 b) { return (bf16x8){a[0], a[1], a[2], a[3], b[0], b[1], b[2], b[3]}; }

#define XB_TMO      128
#define XB_XCNT(j)  (256  + 64 * (j))
#define XB_XSUB(j)  (1280 + 64 * (j))
#define XB_XGEN(j)  (2304 + 64 * (j))
#define XB_TOP      3328
#define XB_TOPGEN   3392
#define XCD_BAR_WORDS 3456
#define XB_SPIN_CAP (1u << 18)
__device__ __forceinline__ unsigned xb_ld(unsigned* p)              { return __hip_atomic_load(p, __ATOMIC_RELAXED, __HIP_MEMORY_SCOPE_AGENT); }
__device__ __forceinline__ unsigned xb_add(unsigned* p, unsigned v) { return __hip_atomic_fetch_add(p, v, __ATOMIC_RELAXED, __HIP_MEMORY_SCOPE_AGENT); }
__device__ __forceinline__ unsigned xb_xcc_id() { return (unsigned)__builtin_amdgcn_s_getreg((3 << 11) | 20) & 0xFu; }
#define XB_SPIN(cond, bar) do { unsigned _sp = 0; while (cond) { __builtin_amdgcn_s_sleep(1); \
    if ((++_sp & 255u) == 0u) { if (xb_ld(&(bar)[XB_TMO])) break; if (_sp > XB_SPIN_CAP) { atomicAdd(&(bar)[XB_TMO], 1u); break; } } } } while (0)
struct XcdBarrier { unsigned* bar; unsigned x; volatile LAS unsigned* st; };
__device__ __forceinline__ XcdBarrier xcd_barrier_post(unsigned* bar, volatile LAS unsigned* st) {
    XcdBarrier b; b.bar = bar; b.x = xb_xcc_id(); b.st = st;
    if (threadIdx.x == 0) (void)xb_add(&bar[XB_XCNT(b.x)], 1u);
    return b;
}
__device__ __forceinline__ void xcd_barrier_complete(unsigned* bar, unsigned x, unsigned& nloc, unsigned& nx) {
    const unsigned G = gridDim.x * gridDim.y * gridDim.z;
    unsigned sum, cnt, mine, sp = 0u;
    for (;;) {
        sum = 0u; cnt = 0u; mine = 0u;
#pragma unroll
        for (unsigned j = 0; j < 16; ++j) { const unsigned c = xb_ld(&bar[XB_XCNT(j)]); sum += c; cnt += (c > 0u) ? 1u : 0u; mine = (j == x) ? c : mine; }
        if (sum == G) break;
        __builtin_amdgcn_s_sleep(1);
        if ((++sp & 255u) == 0u) { if (xb_ld(&bar[XB_TMO])) break; if (sp > XB_SPIN_CAP) { atomicAdd(&bar[XB_TMO], 1u); break; } }
    }
    nloc = mine > 0u ? mine : 1u; nx = cnt > 0u ? cnt : 1u;
}
__device__ __forceinline__ void xcd_barrier(const XcdBarrier& b) {
    asm volatile("s_waitcnt vmcnt(0)" ::: "memory");
    __syncthreads();
    if (threadIdx.x == 0) {
        unsigned* bar = b.bar;
        __builtin_amdgcn_s_waitcnt(0);
        unsigned nloc = b.st[0], nx = b.st[1];
        if (nloc == 0u) { xcd_barrier_complete(bar, b.x, nloc, nx); b.st[0] = nloc; b.st[1] = nx; }
        const unsigned old = xb_add(&bar[XB_XSUB(b.x)], 1u);
        const unsigned gen = old / nloc;
        if (old + 1u == (gen + 1u) * nloc) {
            __builtin_amdgcn_fence(__ATOMIC_RELEASE, "agent");
            asm volatile("s_waitcnt vmcnt(0)" ::: "memory");
            const unsigned og = xb_add(&bar[XB_TOP], 1u);
            const unsigned tg = og / nx;
            if (og + 1u == (tg + 1u) * nx) xb_add(&bar[XB_TOPGEN], 1u);
            else XB_SPIN(xb_ld(&bar[XB_TOPGEN]) == tg, bar);
            __builtin_amdgcn_fence(__ATOMIC_ACQUIRE, "agent");
            xb_add(&bar[XB_XGEN(b.x)], 1u);
            asm volatile("s_waitcnt vmcnt(0)" ::: "memory");
        } else {
            XB_SPIN(xb_ld(&bar[XB_XGEN(b.x)]) == gen, bar);
            __builtin_amdgcn_fence(__ATOMIC_ACQUIRE, "agent");
            asm volatile("s_waitcnt vmcnt(0)" ::: "memory");
        }
    }
    __syncthreads();
}

namespace pg8 {
constexpr int BM = 256, BK = 64, HALF = 128, HTB = HALF * BK * 2, STAGE_BYTES = 8 * HTB, NXCD = 8, WGM = 8;
__device__ __forceinline__ int lds_byte(int r, int c) { const int st = (r >> 4) * 2 + (c >> 5), rr = r & 15, cc = c & 31, ob = rr * 64 + cc * 2; return st * 1024 + (ob ^ (((ob >> 9) & 1) << 5)); }
__device__ __forceinline__ void stage_rc(int b, int& R, int& C) { const int st = b / 1024, sb = b % 1024, swz = sb ^ (((sb >> 9) & 1) << 5); R = (st >> 1) * 16 + swz / 64; C = (st & 1) * 32 + (swz % 64) / 2; }
__device__ __forceinline__ int perm32(int rho) { const int n = rho >> 4, i = rho & 15; return 8 * (i >> 2) + 4 * n + (i & 3); }
struct Unit { int pm, pn; };

template <class Epi, class Sched, bool GATHER, bool F8 = false>
__device__ __forceinline__ void gemm_phase(LAS unsigned char* lds, const int K, const Sched& S, const Epi& E) {
    int tid = threadIdx.x; asm volatile("" : "+v"(tid));
    const int wid = __builtin_amdgcn_readfirstlane(tid >> 6), lane = tid & 63, wr = wid >> 2, wc = wid & 3, fr = lane & 15, fq = lane >> 4;
    const int nt = K / BK;
    int Rr[2], Cc[2]; unsigned voffB[2];
#pragma unroll
    for (int i = 0; i < 2; ++i) { stage_rc(tid * 16 + i * 8192, Rr[i], Cc[i]); const int Rb = Epi::PERM ? ((Rr[i] & ~31) + perm32(Rr[i] & 31)) : Rr[i];
        voffB[i] = (unsigned)(Rb * K + Cc[i]) * 2u; }
    const size_t kstep = (size_t)(BK * 2);
    const size_t hstep = (size_t)HALF * K * 2;
    const unsigned ldsw = (unsigned)wid * 1024u;
    const int aoff = lds_byte(wr * 64 + fr, fq * 8), boff = lds_byte(wc * 32 + fr, fq * 8);
#define PG8_SA(b, h) (((b) * 2 + (h)) * HTB)
#define PG8_SB(b, h) ((4 + (b) * 2 + (h)) * HTB)
#define PG8_STAGE(bufoff, gbase, voff) do { _Pragma("unroll") for (int _i = 0; _i < 2; ++_i) \
        __builtin_amdgcn_global_load_lds((const unsigned*)((const char*)(gbase) + (voff)[_i]), (LAS unsigned*)(lds + (bufoff) + ldsw + _i * 8192), 16, 0, 0); } while (0)
#define PG8_LD8(p) __builtin_shufflevector(*(const LAS i32x4*)(p), *(const LAS i32x4*)((p) + 1024), 0, 1, 2, 3, 4, 5, 6, 7)
#define PG8_LDA(dst, b, h) do { if constexpr (F8) { _Pragma("unroll") for (int m = 0; m < 4; ++m) dst##8[m] = PG8_LD8(lds + PG8_SA(b, h) + aoff + m * 2048); } \
        else { _Pragma("unroll") for (int m = 0; m < 4; ++m) _Pragma("unroll") for (int k = 0; k < 2; ++k) dst[m][k] = *(const LAS bf16x8*)(lds + PG8_SA(b, h) + aoff + m * 2048 + k * 1024); } } while (0)
#define PG8_LDB(dst, b, h) do { if constexpr (F8) { _Pragma("unroll") for (int n = 0; n < 2; ++n) dst##8[n] = PG8_LD8(lds + PG8_SB(b, h) + boff + n * 2048); } \
        else { _Pragma("unroll") for (int n = 0; n < 2; ++n) _Pragma("unroll") for (int k = 0; k < 2; ++k) dst[n][k] = *(const LAS bf16x8*)(lds + PG8_SB(b, h) + boff + n * 2048 + k * 1024); } } while (0)
#define PG8_CAT8(x0, x1) __builtin_shufflevector(__builtin_bit_cast(i32x4, x0), __builtin_bit_cast(i32x4, x1), 0, 1, 2, 3, 4, 5, 6, 7)
#define PG8_MMA(ai, bj, At, Bt) do { __builtin_amdgcn_s_setprio(1); _Pragma("unroll") for (int m = 0; m < 4; ++m) _Pragma("unroll") for (int n = 0; n < 2; ++n) { \
        if constexpr (F8) asm volatile("v_mfma_scale_f32_16x16x128_f8f6f4 %0, %1, %2, %0, %3, %3 op_sel_hi:[0,0,0]" : "+v"(acc[ai][bj][m][n]) : "v"(Bt##8[n]), "v"(At##8[m]), "v"(f8one)); \
        else { _Pragma("unroll") for (int k = 0; k < 2; ++k) acc[ai][bj][m][n] = __builtin_amdgcn_mfma_f32_16x16x32_bf16(Bt[n][k], At[m][k], acc[ai][bj][m][n], 0, 0, 0); } } __builtin_amdgcn_s_setprio(0); } while (0)
#define PG8_WAIT_V(n) asm volatile("s_waitcnt vmcnt(" #n ")" ::: "memory")
#define PG8_WAIT_L(n) asm volatile("s_waitcnt lgkmcnt(" #n ")" ::: "memory")
#define PG8_BAR __builtin_amdgcn_s_barrier()
#define PG8_SCHED __builtin_amdgcn_sched_barrier(0)
#define PG8_VOFF(dst, u) do { _Pragma("unroll") for (int _h = 0; _h < 2; ++_h) _Pragma("unroll") for (int _i = 0; _i < 2; ++_i) { \
        if constexpr (GATHER) dst[_h][_i] = S.arow(u, _h * HALF + Rr[_i]) * (unsigned)(K * 2) + (unsigned)(Cc[_i] * 2); \
        else dst[_h][_i] = (unsigned)((_h * HALF + Rr[_i]) * K + Cc[_i]) * 2u; } } while (0)
    Unit cur, nxt; int ui = 0;
    if (!S.next(0, cur)) return;
    f32x4 acc[2][2][4][2];
    if constexpr (Epi::PRELOAD) E.preload(acc, cur, wr, wc, fr, fq);
    else {
#pragma unroll
    for (int a = 0; a < 2; ++a)
#pragma unroll
        for (int b = 0; b < 2; ++b)
#pragma unroll
            for (int m = 0; m < 4; ++m)
#pragma unroll
                for (int n = 0; n < 2; ++n) acc[a][b][m][n] = (f32x4){0.f, 0.f, 0.f, 0.f};
    }
    float epf[2][4] = {{0.f, 0.f, 0.f, 0.f}, {0.f, 0.f, 0.f, 0.f}};
    bf16x8 At[4][2], B0[2][2], B1[2][2];
    i32x8 At8[4], B08[2], B18[2]; const unsigned f8one = 0x7f7f7f7fu;
    unsigned vA[2][2], vN[2][2];
    PG8_VOFF(vA, cur);
    if constexpr (Epi::PREFETCH) E.prefetch(epf, cur, wr, fr);
    const char* cA = S.abase(cur); const char* cB = S.bbase(cur);
    PG8_STAGE(PG8_SB(0, 0), cB, voffB); PG8_STAGE(PG8_SB(0, 1), cB + hstep, voffB); PG8_STAGE(PG8_SA(0, 0), cA, vA[0]); PG8_STAGE(PG8_SA(0, 1), cA, vA[1]);
    if (wr == 1) PG8_BAR;
    PG8_WAIT_V(2); PG8_BAR;
    PG8_STAGE(PG8_SB(1, 0), cB + kstep, voffB); PG8_STAGE(PG8_SA(1, 0), cA + kstep, vA[0]); PG8_STAGE(PG8_SB(1, 1), cB + hstep + kstep, voffB);
    PG8_WAIT_V(6); PG8_BAR;
    for (;;) {
        const bool has_next = S.next(ui + 1, nxt);
        const char* nA = has_next ? S.abase(nxt) : cA; const char* nB = has_next ? S.bbase(nxt) : cB;
        if constexpr (GATHER) { if (has_next) { PG8_VOFF(vN, nxt); } else {
#pragma unroll
            for (int h = 0; h < 2; ++h)
#pragma unroll
                for (int i = 0; i < 2; ++i) vN[h][i] = vA[h][i]; } }
#pragma unroll 1
        for (int t = 0; t < nt; t += 2) {
            const bool last = (t == nt - 2);
            const char* a1 = cA + (size_t)(t + 1) * kstep;
            const char* a2 = last ? nA : cA + (size_t)(t + 2) * kstep; const char* b2 = last ? nB : cB + (size_t)(t + 2) * kstep;
            const char* a3 = a2 + kstep; const char* b3 = b2 + kstep;
            unsigned v2[2][2]; const unsigned lmask = last ? 0xffffffffu : 0u;
#pragma unroll
            for (int h = 0; h < 2; ++h)
#pragma unroll
                for (int i = 0; i < 2; ++i) { if constexpr (GATHER) v2[h][i] = (vN[h][i] & lmask) | (vA[h][i] & ~lmask); else v2[h][i] = vA[h][i]; }
            PG8_LDB(B0, 0, 0); PG8_LDB(B1, 0, 1); PG8_SCHED; PG8_LDA(At, 0, 0); PG8_STAGE(PG8_SA(1, 1), a1, vA[1]);
            PG8_WAIT_V(8); PG8_WAIT_L(0); PG8_BAR; PG8_MMA(0, 0, At, B0); PG8_MMA(0, 1, At, B1); PG8_BAR; PG8_SCHED;
            PG8_LDA(At, 0, 1); PG8_STAGE(PG8_SB(0, 0), b2, voffB); PG8_STAGE(PG8_SB(0, 1), b2 + hstep, voffB); PG8_STAGE(PG8_SA(0, 0), a2, v2[0]);
            PG8_WAIT_V(8); PG8_WAIT_L(0); PG8_BAR; PG8_MMA(1, 0, At, B0); PG8_MMA(1, 1, At, B1); PG8_BAR; PG8_SCHED;
            PG8_LDB(B0, 1, 0); PG8_LDB(B1, 1, 1); PG8_SCHED; PG8_LDA(At, 1, 0); PG8_STAGE(PG8_SA(0, 1), a2, v2[1]);
            PG8_WAIT_V(8); PG8_WAIT_L(0); PG8_BAR; PG8_MMA(0, 0, At, B0); PG8_MMA(0, 1, At, B1); PG8_BAR; PG8_SCHED;
            PG8_LDA(At, 1, 1); PG8_STAGE(PG8_SB(1, 0), b3, voffB); PG8_STAGE(PG8_SB(1, 1), b3 + hstep, voffB); PG8_STAGE(PG8_SA(1, 0), a3, v2[0]);
            PG8_WAIT_V(8); PG8_WAIT_L(0); PG8_BAR; PG8_MMA(1, 0, At, B0); PG8_MMA(1, 1, At, B1); PG8_BAR; PG8_SCHED;
        }
        if (wr == 0) PG8_BAR;
        if constexpr (F8) asm volatile("s_nop 15\n\ts_nop 15" ::: "memory");
        if constexpr (Epi::PREFETCH) E(acc, cur, wr, wc, fr, fq, epf); else E(acc, cur, wr, wc, fr, fq);
        if (!has_next) break;
        if constexpr (Epi::PREFETCH) E.prefetch(epf, nxt, wr, fr);
        if constexpr (Epi::PRELOAD) E.preload(acc, nxt, wr, wc, fr, fq);
        else {
#pragma unroll
        for (int a = 0; a < 2; ++a)
#pragma unroll
            for (int b = 0; b < 2; ++b)
#pragma unroll
                for (int m = 0; m < 4; ++m)
#pragma unroll
                    for (int n = 0; n < 2; ++n) acc[a][b][m][n] = (f32x4){0.f, 0.f, 0.f, 0.f};
        }
        cur = nxt; cA = nA; cB = nB; ++ui;
        if constexpr (GATHER) {
#pragma unroll
        for (int h = 0; h < 2; ++h)
#pragma unroll
            for (int i = 0; i < 2; ++i) vA[h][i] = vN[h][i]; }
        if (wr == 1) PG8_BAR;
    }
    PG8_WAIT_V(0);
    PG8_BAR;
#undef PG8_SA
#undef PG8_SB
#undef PG8_STAGE
#undef PG8_LDA
#undef PG8_LD8
#undef PG8_LDB
#undef PG8_MMA
#undef PG8_CAT8
#undef PG8_WAIT_V
#undef PG8_WAIT_L
#undef PG8_BAR
#undef PG8_SCHED
#undef PG8_VOFF
}

struct DenseSched {
    const char* A; const char* Bt; int K; int nM, nN, nwg, G, c;
    __device__ __forceinline__ void init(const void* A_, const void* Bt_, int M, int N, int K_, int G_, int c_) { A = (const char*)A_; Bt = (const char*)Bt_; K = K_; nM = M / BM; nN = N / BM; nwg = nM * nN; G = G_; c = c_; }
    __device__ __forceinline__ bool next(int i, Unit& u) const {
        const long L = (long)i * G + c; if (L >= nwg) return false;
        int wgid = (int)L; { const int q = nwg / NXCD, r = nwg % NXCD, xcd = wgid % NXCD, off = wgid / NXCD; wgid = (xcd < r ? xcd * (q + 1) : r * (q + 1) + (xcd - r) * q) + off; }
        const int nig = WGM * nN, gid = wgid / nig, fm = gid * WGM, gsz = (nM - fm) < WGM ? (nM - fm) : WGM;
        u.pm = fm + ((wgid % nig) % gsz); u.pn = (wgid % nig) / gsz; return true;
    }
    __device__ __forceinline__ const char* abase(const Unit& u) const { return A + (size_t)u.pm * BM * K * 2; }
    __device__ __forceinline__ const char* bbase(const Unit& u) const { return Bt + (size_t)u.pn * BM * K * 2; }
    __device__ __forceinline__ unsigned arow(const Unit&, int) const { return 0u; }
};
template <bool GATHER_A>
struct MoeSched {
    const char* A; const char* W; int K; size_t wstride; const LAS int* tb; const LAS int* cn; const unsigned* rowtok; int ntot, vcu, G;
    __device__ __forceinline__ bool next(int i, Unit& u) const { const int L = i * G + vcu; if (L >= ntot * 4) return false; u.pm = L >> 2; u.pn = L & 3; return true; }
    __device__ __forceinline__ int expert(int pm) const { int e = 0;
#pragma unroll
        for (int j = 1; j < 16; ++j) e += (pm >= tb[j]) ? 1 : 0; return e; }
    __device__ __forceinline__ const char* abase(const Unit& u) const { return GATHER_A ? A : A + (size_t)u.pm * BM * K * 2; }
    __device__ __forceinline__ const char* bbase(const Unit& u) const { return W + (size_t)expert(u.pm) * wstride + (size_t)u.pn * BM * K * 2; }
    __device__ __forceinline__ unsigned arow(const Unit& u, int r) const { const int e = expert(u.pm); const int idx = (u.pm - tb[e]) * BM + r; return idx < cn[e] ? rowtok[(size_t)e * ECAP + idx] : 0u; }
};

__device__ __forceinline__ u32x4 widen16(u32x2 a, u32x2 b) {
    const auto rx = __builtin_amdgcn_permlane16_swap(a.x, b.x, false, false); const auto ry = __builtin_amdgcn_permlane16_swap(a.y, b.y, false, false);
    u32x4 o; o.x = rx[0]; o.y = ry[0]; o.z = rx[1]; o.w = ry[1]; return o; }
struct EpiBf16 {
    static constexpr bool PERM = true, PRELOAD = false, PREFETCH = false;
    bf16_t* O; int ldc;
    __device__ __forceinline__ void operator()(const f32x4 (&acc)[2][2][4][2], const Unit& u, int wr, int wc, int fr, int fq) const {
        const int row0 = u.pm * BM + wr * 64 + fr, col0 = u.pn * BM + wc * 32 + 8 * fq;
#pragma unroll
        for (int ai = 0; ai < 2; ++ai)
#pragma unroll
            for (int m = 0; m < 4; ++m) { bf16_t* rowp = O + (size_t)(row0 + ai * HALF + m * 16) * ldc + col0;
#pragma unroll
                for (int bj = 0; bj < 2; ++bj) { const f32x4 v0 = acc[ai][bj][m][0], v1 = acc[ai][bj][m][1];
                    u32x4 w; w.x = cvt_pk_bf16(v0[0], v0[1]); w.y = cvt_pk_bf16(v0[2], v0[3]); w.z = cvt_pk_bf16(v1[0], v1[1]); w.w = cvt_pk_bf16(v1[2], v1[3]);
#ifdef EPI_NT
                    __builtin_nontemporal_store(w, (u32x4*)(rowp + bj * HALF));
#else
                    *(u32x4*)(rowp + bj * HALF) = w;
#endif
                } }
    }
};
template <bool XF32>
struct EpiResid {
    static constexpr bool PERM = true, PRELOAD = true, PREFETCH = false;
    const float* xin; bf16_t* XB; unsigned char* XB8;
    __device__ __forceinline__ void preload(f32x4 (&acc)[2][2][4][2], const Unit& u, int wr, int wc, int fr, int fq) const {
        const int row0 = u.pm * BM + wr * 64 + fr, col0 = u.pn * BM + wc * 32 + 8 * fq;
#pragma unroll
        for (int ai = 0; ai < 2; ++ai)
#pragma unroll
            for (int m = 0; m < 4; ++m) { const size_t off = (size_t)(row0 + ai * HALF + m * 16) * D + col0;
#pragma unroll
                for (int bj = 0; bj < 2; ++bj) {
                    if (XF32) { acc[ai][bj][m][0] = *(const f32x4*)(xin + off + bj * HALF); acc[ai][bj][m][1] = *(const f32x4*)(xin + off + bj * HALF + 4); }
                    else { const u32x4 w = *(const u32x4*)(XB + off + bj * HALF); acc[ai][bj][m][0] = (f32x4){bf_lo(w.x), bf_hi(w.x), bf_lo(w.y), bf_hi(w.y)}; acc[ai][bj][m][1] = (f32x4){bf_lo(w.z), bf_hi(w.z), bf_lo(w.w), bf_hi(w.w)}; } } }
    }
    __device__ __forceinline__ void operator()(const f32x4 (&acc)[2][2][4][2], const Unit& u, int wr, int wc, int fr, int fq) const {
        const int row0 = u.pm * BM + wr * 64 + fr, col0 = u.pn * BM + wc * 32 + 8 * fq;
        const int colw = u.pn * BM + wc * 32 + 8 * (fq & ~1);
#pragma unroll
        for (int ai = 0; ai < 2; ++ai)
#pragma unroll
            for (int mp = 0; mp < 4; mp += 2)
#pragma unroll
                for (int bj = 0; bj < 2; ++bj) { u32x2 w8[2];
#pragma unroll
                    for (int h = 0; h < 2; ++h) { const int m = mp + h; bf16_t* rowp = XB + (size_t)(row0 + ai * HALF + m * 16) * D + col0;
                        const f32x4 v0 = acc[ai][bj][m][0], v1 = acc[ai][bj][m][1];
                        u32x4 w; w.x = cvt_pk_bf16(v0[0], v0[1]); w.y = cvt_pk_bf16(v0[2], v0[3]); w.z = cvt_pk_bf16(v1[0], v1[1]); w.w = cvt_pk_bf16(v1[2], v1[3]);
                        *(u32x4*)(rowp + bj * HALF) = w;
                        w8[h].x = cvt_pk4_fp8(bf_lo(w.x), bf_hi(w.x), bf_lo(w.y), bf_hi(w.y)); w8[h].y = cvt_pk4_fp8(bf_lo(w.z), bf_hi(w.z), bf_lo(w.w), bf_hi(w.w)); }
                    *(u32x4*)(XB8 + (size_t)(row0 + ai * HALF + (mp + (fq & 1)) * 16) * D + colw + bj * HALF) = widen16(w8[0], w8[1]); }
    }
};
template <int MODE  >
struct EpiPair {
    static constexpr bool PERM = true, PRELOAD = false, PREFETCH = true;
    bf16_t* O0; bf16_t* O1; int ld1;
    const float* rstd; const unsigned* rowtok; const LAS int* tb; const LAS int* cn;
    __device__ __forceinline__ void prefetch(float (&rs)[2][4], const Unit& u, int wr, int fr) const {
        const int row0 = u.pm * BM + wr * 64 + fr;
        if (MODE == 0) {
#pragma unroll
            for (int ai = 0; ai < 2; ++ai)
#pragma unroll
                for (int m = 0; m < 4; ++m) rs[ai][m] = rstd[row0 + ai * HALF + m * 16] * (G3_F8 ? 1.0f / F8_WSCALE : 1.0f);
        } else {
            int e = 0;
#pragma unroll
            for (int j = 1; j < 16; ++j) e += (u.pm >= tb[j]) ? 1 : 0;
            const int idx0 = (u.pm - tb[e]) * BM + wr * 64 + fr, cne = cn[e];
#pragma unroll
            for (int ai = 0; ai < 2; ++ai)
#pragma unroll
                for (int m = 0; m < 4; ++m) { const int idx = idx0 + ai * HALF + m * 16; rs[ai][m] = idx < cne ? rstd[(size_t)e * ECAP + idx] * (1.0f / F8_WSCALE) : 0.f; }
        }
    }
    __device__ __forceinline__ void operator()(const f32x4 (&acc)[2][2][4][2], const Unit& u, int wr, int wc, int fr, int fq, const float (&rs)[2][4]) const {
        const int row0 = u.pm * BM + wr * 64 + fr;
        if (MODE == 0 && u.pn < 4) {
            const int col0 = u.pn * BM + wc * 32 + 8 * fq;
#pragma unroll
            for (int ai = 0; ai < 2; ++ai)
#pragma unroll
                for (int m = 0; m < 4; ++m) { bf16_t* rowp = O0 + (size_t)(row0 + ai * HALF + m * 16) * D + col0;
#pragma unroll
                    for (int bj = 0; bj < 2; ++bj) { const f32x4 v0 = acc[ai][bj][m][0] * rs[ai][m], v1 = acc[ai][bj][m][1] * rs[ai][m];
                        u32x4 w; w.x = cvt_pk_bf16(v0[0], v0[1]); w.y = cvt_pk_bf16(v0[2], v0[3]); w.z = cvt_pk_bf16(v1[0], v1[1]); w.w = cvt_pk_bf16(v1[2], v1[3]);
                        *(u32x4*)(rowp + bj * HALF) = w; } }
        } else {
            const int pt = (MODE == 0) ? (u.pn - 4) : u.pn;
            const int col0 = pt * HALF + wc * 32 + 8 * fq;
#pragma unroll
            for (int ai = 0; ai < 2; ++ai) { u32x2 wkeep = {0u, 0u};
#pragma unroll
                for (int m = 0; m < 4; ++m) { bf16_t* rowp = O1 + (size_t)(row0 + ai * HALF + m * 16) * ld1 + col0;
                    f32x4 r[2];
#pragma unroll
                    for (int n = 0; n < 2; ++n) { const f32x4 g = acc[ai][0][m][n] * rs[ai][m], up = acc[ai][1][m][n] * rs[ai][m];
                        if (MODE == 0) r[n] = g * up;
                        else {
#pragma unroll
                            for (int j = 0; j < 4; ++j) r[n][j] = __builtin_amdgcn_fmed3f(g[j] * fast_rcp(1.0f + fast_exp2(-1.4426950408889634f * g[j])) * up[j] * F8_HSCALE, -448.0f, 448.0f); } }
                    if (MODE == 1) { u32x2 w; w.x = cvt_pk4_fp8(r[0][0], r[0][1], r[0][2], r[0][3]); w.y = cvt_pk4_fp8(r[1][0], r[1][1], r[1][2], r[1][3]);
                        if ((m & 1) == 0) wkeep = w;
                        else *(u32x4*)((unsigned char*)O1 + (size_t)(row0 + ai * HALF + (m - 1 + (fq & 1)) * 16) * ld1 + (pt * HALF + wc * 32 + 8 * (fq & ~1))) = widen16(wkeep, w); }
                    else { u32x4 w; w.x = cvt_pk_bf16(r[0][0], r[0][1]); w.y = cvt_pk_bf16(r[0][2], r[0][3]); w.z = cvt_pk_bf16(r[1][0], r[1][1]); w.w = cvt_pk_bf16(r[1][2], r[1][3]);
                        *(u32x4*)rowp = w; } } }
        }
    }
};
struct EpiDown {
    static constexpr bool PERM = true, PRELOAD = false, PREFETCH = true;
    unsigned char* O; const float* cwraw; const LAS int* tb; const LAS int* cn;
    __device__ __forceinline__ void prefetch(float (&cws)[2][4], const Unit& u, int wr, int fr) const {
        int e = 0;
#pragma unroll
        for (int j = 1; j < 16; ++j) e += (u.pm >= tb[j]) ? 1 : 0;
        const int idx0 = (u.pm - tb[e]) * BM + wr * 64 + fr, cne = cn[e];
#pragma unroll
        for (int ai = 0; ai < 2; ++ai)
#pragma unroll
            for (int m = 0; m < 4; ++m) { const int idx = idx0 + ai * HALF + m * 16; cws[ai][m] = idx < cne ? cwraw[(size_t)e * ECAP + idx] * (F8_YSCALE / (F8_WSCALE * F8_HSCALE)) : 0.f; }
    }
    __device__ __forceinline__ void operator()(const f32x4 (&acc)[2][2][4][2], const Unit& u, int wr, int wc, int fr, int fq, const float (&cws)[2][4]) const {
        const int row0 = u.pm * BM + wr * 64 + fr, col0 = u.pn * BM + wc * 32 + 8 * fq;
        const int colw = u.pn * BM + wc * 32 + 8 * (fq & ~1);
#pragma unroll
        for (int ai = 0; ai < 2; ++ai)
#pragma unroll
            for (int mp = 0; mp < 4; mp += 2) {
                unsigned char* rowp = O + (size_t)(row0 + ai * HALF + (mp + (fq & 1)) * 16) * D + colw;
#pragma unroll
                for (int bj = 0; bj < 2; ++bj) { u32x2 w[2];
#pragma unroll
                    for (int h = 0; h < 2; ++h) { const float cw = cws[ai][mp + h]; f32x4 v0 = acc[ai][bj][mp + h][0] * cw, v1 = acc[ai][bj][mp + h][1] * cw;
#pragma unroll
                        for (int j = 0; j < 4; ++j) { v0[j] = __builtin_amdgcn_fmed3f(v0[j], -448.0f, 448.0f); v1[j] = __builtin_amdgcn_fmed3f(v1[j], -448.0f, 448.0f); }
                        w[h].x = cvt_pk4_fp8(v0[0], v0[1], v0[2], v0[3]); w[h].y = cvt_pk4_fp8(v1[0], v1[1], v1[2], v1[3]); }
                    *(u32x4*)(rowp + bj * HALF) = widen16(w[0], w[1]); } }
    }
};
}

constexpr int RING_BYTES = 131072;
constexpr int MISC_OFF = RING_BYTES;
constexpr int LDS_BYTES = 163840;
constexpr int MW_BAR = 0;
constexpr int MW_TB = 16;
constexpr int MW_CN = 40;
constexpr int MW_Q = 60;
constexpr int MW_F = 64;

struct Params {
    const float* in[25]; float* out; unsigned char* ws;
};

constexpr float ATT_QSCALE = 0.125f * 1.4426950408889634f;
__device__ __forceinline__ void transpose_item(const float* W, int ld, int K, int k0, int srccol, bf16_t* WT, int dstrow, LAS float* scr, int lane, const float* gk = nullptr, float wsc = 1.0f) {
    float tv[32];
#pragma unroll
    for (int i = 0; i < 32; ++i) { const int kk = 2 * i + (lane >> 5); tv[i] = W[(size_t)(k0 + kk) * ld + srccol + (lane & 31)]; }
#pragma unroll
    for (int i = 0; i < 32; ++i) { const int kk = 2 * i + (lane >> 5); scr[kk * 33 + (lane & 31)] = (gk ? tv[i] * gk[k0 + kk] : tv[i]) * wsc; }
    asm volatile("s_waitcnt lgkmcnt(0)" ::: "memory");
    const int c = lane & 7;
#pragma unroll
    for (int j = 0; j < 4; ++j) { const int n = (lane >> 3) + 8 * j; const LAS float* s = scr + (8 * c) * 33 + n;
        u32x4 o; o.x = cvt_pk_bf16(s[0 * 33], s[1 * 33]); o.y = cvt_pk_bf16(s[2 * 33], s[3 * 33]); o.z = cvt_pk_bf16(s[4 * 33], s[5 * 33]); o.w = cvt_pk_bf16(s[6 * 33], s[7 * 33]);
        *(u32x4*)(WT + (size_t)(dstrow + n) * K + k0 + 8 * c) = o; }
    asm volatile("s_waitcnt lgkmcnt(0)" ::: "memory");
}
__device__ __forceinline__ void transpose_item_f8(const float* W, int ld, int K, int k0, int srccol, unsigned char* WT8, int dstrow, LAS float* scr, int lane, const float* gk, float scale) {
    float tv[32];
#pragma unroll
    for (int i = 0; i < 32; ++i) { const int kk = 2 * i + (lane >> 5); tv[i] = W[(size_t)(k0 + kk) * ld + srccol + (lane & 31)]; }
#pragma unroll
    for (int i = 0; i < 32; ++i) { const int kk = 2 * i + (lane >> 5); scr[kk * 33 + (lane & 31)] = (gk ? tv[i] * gk[k0 + kk] : tv[i]) * scale; }
    asm volatile("s_waitcnt lgkmcnt(0)" ::: "memory");
    const int c = lane & 3;
#pragma unroll
    for (int j = 0; j < 2; ++j) { const int n = (lane >> 2) + 16 * j; const LAS float* q = scr + (16 * c) * 33 + n;
        u32x4 o; o.x = cvt_pk4_fp8(q[0 * 33], q[1 * 33], q[2 * 33], q[3 * 33]); o.y = cvt_pk4_fp8(q[4 * 33], q[5 * 33], q[6 * 33], q[7 * 33]);
        o.z = cvt_pk4_fp8(q[8 * 33], q[9 * 33], q[10 * 33], q[11 * 33]); o.w = cvt_pk4_fp8(q[12 * 33], q[13 * 33], q[14 * 33], q[15 * 33]);
        *(u32x4*)(WT8 + (size_t)(dstrow + n) * K + k0 + 16 * c) = o; }
    asm volatile("s_waitcnt lgkmcnt(0)" ::: "memory");
}
__device__ __forceinline__ int pair_row(int ch, int up) { return (ch >> 7) * 256 + up * 128 + (ch & 127); }

__device__ __forceinline__ void phase_prologue_weights(const Params& p, LAS unsigned char* lds, int first, int last, int step, int wave, int lane_) {
    int lane = lane_; asm volatile("" : "+v"(lane));
    LAS float* scr = (LAS float*)(lds + wave * 16384);
    unsigned char* ws = p.ws;
    constexpr int I1 = 16 * 112, I2 = 16 * 32, I3 = 16 * 96, I4 = 16 * 32, IE = 768;
    constexpr int NITEMS = I1 + I2 + I3 + I4 + 32 * IE;
    static_assert(NITEMS == 28928, "item count");
    for (int it = first; it < last; it += step) {
        int r = it;
        if (r < I1) { const int kb = r / 112, nb = r % 112; const int sc = nb < 64 ? 32 * nb : 2056 + 32 * (nb - 64), dr = nb < 64 ? 32 * nb : 2048 + 32 * (nb - 64);
            transpose_item(p.in[5], EVEN_IN, 1024, 64 * kb, sc, (bf16_t*)(ws + WS_WT1), dr, scr, lane, nullptr, (dr >= P_DQ && dr < P_DK) ? ATT_QSCALE : 1.0f); continue; } r -= I1;
        if (r < I2) { const int kb = r / 32, nb = r % 32; transpose_item(p.in[6], 1024, 1024, 64 * kb, 32 * nb, (bf16_t*)(ws + WS_WT2), 32 * nb, scr, lane); continue; } r -= I2;
        if (r < I3) { const int kb = r / 96, nb = r % 96; int dr;
            if (nb < 32) dr = 32 * nb; else if (nb < 64) dr = 1024 + pair_row(32 * (nb - 32), 0); else dr = 1024 + pair_row(32 * (nb - 64), 1);
            if (G3_F8) transpose_item_f8(p.in[15], 3072, 1024, 64 * kb, 32 * nb, ws + WS_WT3, dr, scr, lane, p.in[2] + D, F8_WSCALE);
            else transpose_item(p.in[15], 3072, 1024, 64 * kb, 32 * nb, (bf16_t*)(ws + WS_WT3), dr, scr, lane, p.in[2] + D);
            continue; } r -= I3;
        if (r < I4) { const int kb = r / 32, nb = r % 32; transpose_item(p.in[17], 1024, 1024, 64 * kb, 32 * nb, (bf16_t*)(ws + WS_WT4), 32 * nb, scr, lane); continue; } r -= I4;
        const int le = r / IE; r %= IE;
        unsigned char* wgu = ws + WS_WGU + (size_t)le * 1024 * 1024; unsigned char* wd = ws + WS_WD + (size_t)le * 1024 * 512;
        if (r < 256) { const int kb = r / 16, nb = r % 16; transpose_item_f8(p.in[22] + (size_t)le * 1024 * 512, 512, 1024, 64 * kb, 32 * nb, wgu, pair_row(32 * nb, 0), scr, lane, p.in[3] + (le >> 4) * D, F8_WSCALE); continue; } r -= 256;
        if (r < 256) { const int kb = r / 16, nb = r % 16; transpose_item_f8(p.in[23] + (size_t)le * 1024 * 512, 512, 1024, 64 * kb, 32 * nb, wgu, pair_row(32 * nb, 1), scr, lane, p.in[3] + (le >> 4) * D, F8_WSCALE); continue; } r -= 256;
        { const int kb = r / 32, nb = r % 32; transpose_item_f8(p.in[24] + (size_t)le * 512 * 1024, 1024, 512, 64 * kb, 32 * nb, wd, 32 * nb, scr, lane, nullptr, F8_WSCALE); }
    }
}

struct RowV { f32x4 v[4]; };
__device__ __forceinline__ RowV row_load(const float* xr, int lane) { RowV r; const f32x4* p = (const f32x4*)xr + lane;
#pragma unroll
    for (int j = 0; j < 4; ++j) r.v[j] = p[64 * j]; return r; }
__device__ __forceinline__ void row_store(float* xr, int lane, const RowV& r) { f32x4* p = (f32x4*)xr + lane;
#pragma unroll
    for (int j = 0; j < 4; ++j) p[64 * j] = r.v[j]; }
__device__ __forceinline__ RowV row_load_bf16(const bf16_t* yr, int lane) { RowV r; const u32x2* p = (const u32x2*)yr + lane;
#pragma unroll
    for (int j = 0; j < 4; ++j) { const u32x2 w = p[64 * j]; r.v[j] = (f32x4){bf_lo(w.x), bf_hi(w.x), bf_lo(w.y), bf_hi(w.y)}; } return r; }
__device__ __forceinline__ RowV row_load_fp8(const unsigned char* yr, int lane, float sc) { RowV r; const unsigned* p = (const unsigned*)yr + lane;
#pragma unroll
    for (int j = 0; j < 4; ++j) { const unsigned w = p[64 * j]; const f32x2 lo = __builtin_amdgcn_cvt_pk_f32_fp8((int)w, false), hi = __builtin_amdgcn_cvt_pk_f32_fp8((int)w, true); r.v[j] = (f32x4){lo.x * sc, lo.y * sc, hi.x * sc, hi.y * sc}; } return r; }
__device__ __forceinline__ float row_rstd(const RowV& r) { float s = 0.f;
#pragma unroll
    for (int j = 0; j < 4; ++j) s += (r.v[j][0] * r.v[j][0] + r.v[j][1] * r.v[j][1]) + (r.v[j][2] * r.v[j][2] + r.v[j][3] * r.v[j][3]);
    return 1.0f / sqrtf(wave_sum(s) * (1.0f / D) + NORM_EPS); }
__device__ __forceinline__ void row_store_bf16(bf16_t* hr, int lane, const RowV& r) { u32x2* p = (u32x2*)hr + lane;
#pragma unroll
    for (int j = 0; j < 4; ++j) { u32x2 w; w.x = cvt_pk_bf16(r.v[j][0], r.v[j][1]); w.y = cvt_pk_bf16(r.v[j][2], r.v[j][3]); p[64 * j] = w; } }

__device__ __forceinline__ void phase_norm_gates(const Params& p, LAS unsigned char* lds, int tid, int gw, int NGW, int lane) {
    const float* x = p.in[0]; const float* g = p.in[2]; const float* win = p.in[5];
    bf16_t* H = (bf16_t*)(p.ws + WS_H); float* gates = (float*)(p.ws + WS_GATES);
    LAS float* wt = (LAS float*)lds;
    for (int i = tid; i < 8 * 1024; i += NTHR) { const int k = i >> 3, o = i & 7; wt[o * 1024 + k] = win[(size_t)k * EVEN_IN + 2048 + o] * g[k]; }
    __syncthreads();
    RowV gv = row_load(g, lane);
    for (int m0 = gw; m0 < T; m0 += 2 * NGW) {
      RowV rr[2];
#pragma unroll
      for (int u = 0; u < 2; ++u) { const int mm = m0 + u * NGW; rr[u] = row_load(x + (size_t)(mm < T ? mm : m0) * D, lane); }
#pragma unroll
      for (int u = 0; u < 2; ++u) {
        const int m = m0 + u * NGW; if (m >= T) break; RowV r = rr[u];
        const float rstd = row_rstd(r);
        float dots[8];
#pragma unroll
        for (int o = 0; o < 8; ++o) { float s = 0.f;
#pragma unroll
            for (int j = 0; j < 4; ++j) { const f32x4 w = *(const LAS f32x4*)(wt + o * 1024 + 4 * lane + 256 * j); s += (r.v[j][0] * w[0] + r.v[j][1] * w[1]) + (r.v[j][2] * w[2] + r.v[j][3] * w[3]); }
            dots[o] = s; }
        float gsum;
        { const bool b5 = (lane & 32) != 0, b4 = (lane & 16) != 0, b3 = (lane & 8) != 0;
          float k4[4];
#pragma unroll
          for (int i = 0; i < 4; ++i) { const float keep = b5 ? dots[4 + i] : dots[i], send = b5 ? dots[i] : dots[4 + i]; k4[i] = keep + __shfl_xor(send, 32); }
          float k2[2];
#pragma unroll
          for (int i = 0; i < 2; ++i) { const float keep = b4 ? k4[2 + i] : k4[i], send = b4 ? k4[i] : k4[2 + i]; k2[i] = keep + __shfl_xor(send, 16); }
          { const float keep = b3 ? k2[1] : k2[0], send = b3 ? k2[0] : k2[1]; gsum = keep + __shfl_xor(send, 8); }
          gsum += __shfl_xor(gsum, 4); gsum += __shfl_xor(gsum, 2); gsum += __shfl_xor(gsum, 1); }
#pragma unroll
        for (int j = 0; j < 4; ++j) r.v[j] = r.v[j] * rstd * gv.v[j];
        row_store_bf16(H + (size_t)m * D, lane, r);
        if ((lane & 7) == 0) gates[(size_t)m * 8 + ((lane >> 3) & 7)] = gsum * rstd;
      }
    }
    __syncthreads();
}

template <int MODE, bool COMBINE>
__device__ __forceinline__ void phase_rows(const Params& p, LAS unsigned char* lds, int tid_, int wave, int lane_, int G,
                                           const float* gvec, const float* wgr, const float* bgr, const float* wer, const float* ber, unsigned* cnt_prev, unsigned* cnt_cur) {
    int tid = tid_; asm volatile("" : "+v"(tid)); const int lane = tid & 63;
    float* OUT = p.out; bf16_t* XB = (bf16_t*)(p.ws + WS_XB); float* RSTD = (float*)(p.ws + WS_RSTD);
    const unsigned char* YC = (const unsigned char*)(p.ws + WS_YC); float* rsraw = (float*)(p.ws + WS_RSRAW);
    unsigned* tokinfo = (unsigned*)(p.ws + WS_TOKINFO);
    unsigned* rowtok = (unsigned*)(p.ws + WS_ROWTOK); float* cwraw = (float*)(p.ws + WS_CWRAW);
    LAS float* wt = (LAS float*)lds;
    LAS int* misc = (LAS int*)(lds + MISC_OFF);
    LAS int* tbp = misc + MW_TB;
    LAS int* te = misc + 1024;
    LAS float* tc = (LAS float*)(misc + 1536);
    LAS int* trank = misc + 2048;
    LAS int* ebase = misc + 2560;
    LAS float* trs = (LAS float*)(misc + 2600);
    if (COMBINE) { if (tid == 0) { int acc = 0; for (int e = 0; e < 16; ++e) { tbp[e] = acc; acc += ((int)__hip_atomic_load(cnt_prev + e * 64, __ATOMIC_RELAXED, __HIP_MEMORY_SCOPE_AGENT) + 255) >> 8; } tbp[16] = acc; } }
    if (MODE == 1) { for (int i = tid; i < 20 * 1024; i += NTHR) { const int o = i >> 10, k = i & 1023; wt[i] = (o < 4 ? wgr[(size_t)k * 4 + o] : wer[(size_t)k * 16 + (o - 4)]) * gvec[k]; } }
    __syncthreads();
    RowV gv; if (MODE == 2) gv = row_load(gvec, lane);
    for (int blk = blockIdx.x; blk < T / 256; blk += G) {
        for (int i2 = 0; i2 < 32; i2 += 2) {
          RowV rr[2];
#pragma unroll
          for (int u = 0; u < 2; ++u) {
            const int m = blk * 256 + wave * 32 + i2 + u;
            rr[u] = row_load_bf16(XB + (size_t)m * D, lane);
            if (COMBINE) {
                const unsigned i0 = tokinfo[(size_t)m * 2], i1 = tokinfo[(size_t)m * 2 + 1];
                const size_t s0 = (size_t)tbp[i0 >> 16] * 256 + (i0 & 0xffffu), s1 = (size_t)tbp[i1 >> 16] * 256 + (i1 & 0xffffu);
                const RowV y0 = row_load_fp8(YC + s0 * D, lane, 1.0f / F8_YSCALE), y1 = row_load_fp8(YC + s1 * D, lane, 1.0f / F8_YSCALE);
#pragma unroll
                for (int j = 0; j < 4; ++j) rr[u].v[j] = rr[u].v[j] + y0.v[j] + y1.v[j];
            }
          }
#pragma unroll
          for (int u = 0; u < 2; ++u) {
            const int i = i2 + u;
            const int rl = wave * 32 + i, m = blk * 256 + rl;
            RowV r = rr[u];
            if (MODE == 0) {
                u32x2* xp = (u32x2*)(XB + (size_t)m * D) + lane;
#pragma unroll
                for (int j = 0; j < 4; ++j) { u32x2 w; w.x = cvt_pk_bf16(r.v[j][0], r.v[j][1]); w.y = cvt_pk_bf16(r.v[j][2], r.v[j][3]); xp[64 * j] = w;
                    r.v[j] = (f32x4){bf_lo(w.x), bf_hi(w.x), bf_lo(w.y), bf_hi(w.y)}; }
            }
            const float rstd = row_rstd(r);
            if (MODE != 2) { if (lane == 0) RSTD[m] = rstd; }
            if (MODE == 1 || (MODE == 0 && G3_F8)) { unsigned* x8 = (unsigned*)(p.ws + WS_XB8 + (size_t)m * D) + lane;
#pragma unroll
                for (int j = 0; j < 4; ++j) x8[64 * j] = cvt_pk4_fp8(r.v[j][0], r.v[j][1], r.v[j][2], r.v[j][3]); }
            if (MODE == 1) {
                float lg[20];
#pragma unroll
                for (int o = 0; o < 20; ++o) { float s = 0.f;
#pragma unroll
                    for (int j = 0; j < 4; ++j) { const f32x4 w = *(const LAS f32x4*)(wt + o * 1024 + 4 * lane + 256 * j); s += (r.v[j][0] * w[0] + r.v[j][1] * w[1]) + (r.v[j][2] * w[2] + r.v[j][3] * w[3]); }
                    lg[o] = wave_sum(s) * rstd + (o < 4 ? bgr[o] : ber[o - 4]); }
                int gs = 0; float gm = lg[0];
#pragma unroll
                for (int o = 1; o < 4; ++o) if (lg[o] > gm) { gm = lg[o]; gs = o; }
                float den = 0.f;
#pragma unroll
                for (int o = 0; o < 4; ++o) den += __expf(lg[o] - gm);
                const float pg = 1.0f / den;
                float el[4];
#pragma unroll
                for (int o = 0; o < 4; ++o) { float v = lg[4 + o];
#pragma unroll
                    for (int g2 = 1; g2 < 4; ++g2) v = (gs == g2) ? lg[4 + 4 * g2 + o] : v;
                    el[o] = v; }
                int i0 = 0; float v0 = el[0];
#pragma unroll
                for (int o = 1; o < 4; ++o) if (el[o] > v0) { v0 = el[o]; i0 = o; }
                int i1 = -1; float v1 = -INFINITY;
#pragma unroll
                for (int o = 0; o < 4; ++o) if (o != i0 && el[o] > v1) { v1 = el[o]; i1 = o; }
                const float ex = __expf(v1 - v0); const float w0 = 1.0f / (1.0f + ex), w1 = ex * w0;
                if (lane == 0) { te[rl * 2] = gs * 4 + i0; te[rl * 2 + 1] = gs * 4 + i1; tc[rl * 2] = w0 * pg; tc[rl * 2 + 1] = w1 * pg; trs[rl] = rstd; }
            }
            if (MODE == 2) {
#pragma unroll
                for (int j = 0; j < 4; ++j) r.v[j] = r.v[j] * rstd * gv.v[j];
                row_store(OUT + (size_t)m * D, lane, r);
            }
          }
        }
        if (MODE == 1) {
            __syncthreads();
            if (tid < 16) { int c = 0; for (int q = 0; q < 512; ++q) if (te[q] == tid) { trank[q] = c; ++c; }
                ebase[tid] = c ? (int)__hip_atomic_fetch_add(cnt_cur + tid * 64, (unsigned)c, __ATOMIC_RELAXED, __HIP_MEMORY_SCOPE_AGENT) : 0; }
            __syncthreads();
            { const int q = tid, e = te[q], pos = ebase[e] + trank[q], tok = blk * 256 + (q >> 1);
              rowtok[(size_t)e * ECAP + pos] = (unsigned)tok; cwraw[(size_t)e * ECAP + pos] = tc[q]; rsraw[(size_t)e * ECAP + pos] = trs[q >> 1]; tokinfo[(size_t)tok * 2 + (q & 1)] = ((unsigned)e << 16) | (unsigned)pos; }
            __syncthreads();
        }
    }
    __syncthreads();
}

__device__ __forceinline__ void phase_router(const Params& p, LAS unsigned char* lds, int tid_, int wave, int G,
                                             const float* gvec, const float* wgr, const float* bgr, const float* wer, const float* ber, unsigned* cnt_cur) {
    int tid = tid_; asm volatile("" : "+v"(tid)); const int lane = tid & 63, r32 = lane & 31, hi = lane >> 5;
    const bf16_t* XB = (const bf16_t*)(p.ws + WS_XB); float* rsraw = (float*)(p.ws + WS_RSRAW);
    unsigned* tokinfo = (unsigned*)(p.ws + WS_TOKINFO);
    unsigned* rowtok = (unsigned*)(p.ws + WS_ROWTOK); float* cwraw = (float*)(p.ws + WS_CWRAW);
    constexpr int WROW = 2048 + 16;
    LAS unsigned char* Whi = lds; LAS unsigned char* Wlo = lds + 24 * WROW;
    LAS int* misc = (LAS int*)(lds + MISC_OFF);
    LAS int* te = misc + 1024; LAS float* tc = (LAS float*)(misc + 1536); LAS int* trank = misc + 2048; LAS int* ebase = misc + 2560; LAS float* trs = (LAS float*)(misc + 2600);
    for (int i = tid; i < 24 * 1024; i += NTHR) { const int sl = i >> 10, k = i & 1023; float w;
        if (sl < 8) w = wgr[(size_t)k * 4 + (sl & 3)]; else { const int q = sl - 8, e = (q & 3) + 8 * ((q >> 2) & 1) + 4 * (q >> 3); w = wer[(size_t)k * 16 + e]; }
        w *= gvec[k];
        const unsigned hb = cvt_pk_bf16(w, 0.f) & 0xffffu; const float wl = w - __uint_as_float(hb << 16); const unsigned lb = cvt_pk_bf16(wl, 0.f) & 0xffffu;
        *(LAS unsigned short*)(Whi + sl * WROW + k * 2) = (unsigned short)hb; *(LAS unsigned short*)(Wlo + sl * WROW + k * 2) = (unsigned short)lb; }
    __syncthreads();
    const int slot_row = r32 < 24 ? r32 : r32 - 8;
    const LAS unsigned char* wh = Whi + slot_row * WROW + hi * 64; const LAS unsigned char* wl_ = Wlo + slot_row * WROW + hi * 64;
    for (int blk = blockIdx.x; blk < T / 256; blk += G) {
        const int rl = wave * 32 + r32, m = blk * 256 + rl;
        const bf16_t* xr = XB + (size_t)m * D + hi * 32;
        f32x16 acc = (f32x16){}; float ss = 0.f;
        bf16x8 xa[4], xb[4];
#pragma unroll
        for (int q = 0; q < 4; ++q) xa[q] = *(const bf16x8*)(xr + q * 8);
#pragma unroll 1
        for (int t = 0; t < 16; t += 2) {
#pragma unroll
            for (int q = 0; q < 4; ++q) xb[q] = *(const bf16x8*)(xr + (t + 1) * 64 + q * 8);
#pragma unroll
            for (int q = 0; q < 4; ++q) { const bf16x8 ah = *(const LAS bf16x8*)(wh + t * 128 + q * 16), al = *(const LAS bf16x8*)(wl_ + t * 128 + q * 16);
                acc = __builtin_amdgcn_mfma_f32_32x32x16_bf16(ah, xa[q], acc, 0, 0, 0); acc = __builtin_amdgcn_mfma_f32_32x32x16_bf16(al, xa[q], acc, 0, 0, 0);
#pragma unroll
                for (int j = 0; j < 4; ++j) { const unsigned w = ((const unsigned*)&xa[q])[j]; const float a = bf_lo(w), b = bf_hi(w); ss += a * a + b * b; } }
            if (t + 2 < 16) {
#pragma unroll
                for (int q = 0; q < 4; ++q) xa[q] = *(const bf16x8*)(xr + (t + 2) * 64 + q * 8); }
#pragma unroll
            for (int q = 0; q < 4; ++q) { const bf16x8 ah = *(const LAS bf16x8*)(wh + (t + 1) * 128 + q * 16), al = *(const LAS bf16x8*)(wl_ + (t + 1) * 128 + q * 16);
                acc = __builtin_amdgcn_mfma_f32_32x32x16_bf16(ah, xb[q], acc, 0, 0, 0); acc = __builtin_amdgcn_mfma_f32_32x32x16_bf16(al, xb[q], acc, 0, 0, 0);
#pragma unroll
                for (int j = 0; j < 4; ++j) { const unsigned w = ((const unsigned*)&xb[q])[j]; const float a = bf_lo(w), b = bf_hi(w); ss += a * a + b * b; } }
        }
        ss += __shfl_xor(ss, 32);
        const float rstd = 1.0f / sqrtf(ss * (1.0f / D) + NORM_EPS);
        float lg[4];
#pragma unroll
        for (int o = 0; o < 4; ++o) lg[o] = acc[o] * rstd + bgr[o];
        int gs = 0; float gm = lg[0];
#pragma unroll
        for (int o = 1; o < 4; ++o) if (lg[o] > gm) { gm = lg[o]; gs = o; }
        float den = 0.f;
#pragma unroll
        for (int o = 0; o < 4; ++o) den += __expf(lg[o] - gm);
        const float pg = 1.0f / den;
        if ((gs >> 1) == hi) {
            float el[4];
#pragma unroll
            for (int o = 0; o < 4; ++o) el[o] = ((gs & 1) ? acc[8 + o] : acc[4 + o]) * rstd + ber[gs * 4 + o];
            int i0 = 0; float v0 = el[0];
#pragma unroll
            for (int o = 1; o < 4; ++o) if (el[o] > v0) { v0 = el[o]; i0 = o; }
            int i1 = -1; float v1 = -INFINITY;
#pragma unroll
            for (int o = 0; o < 4; ++o) if (o != i0 && el[o] > v1) { v1 = el[o]; i1 = o; }
            const float ex = __expf(v1 - v0); const float w0 = 1.0f / (1.0f + ex), w1 = ex * w0;
            te[rl * 2] = gs * 4 + i0; te[rl * 2 + 1] = gs * 4 + i1; tc[rl * 2] = w0 * pg; tc[rl * 2 + 1] = w1 * pg; trs[rl] = rstd;
        }
        __syncthreads();
        if (tid < 16) { int c = 0; for (int q = 0; q < 512; ++q) if (te[q] == tid) { trank[q] = c; ++c; }
            ebase[tid] = c ? (int)__hip_atomic_fetch_add(cnt_cur + tid * 64, (unsigned)c, __ATOMIC_RELAXED, __HIP_MEMORY_SCOPE_AGENT) : 0; }
        __syncthreads();
        { const int q = tid, e = te[q], pos = ebase[e] + trank[q], tok = blk * 256 + (q >> 1);
          rowtok[(size_t)e * ECAP + pos] = (unsigned)tok; cwraw[(size_t)e * ECAP + pos] = tc[q]; rsraw[(size_t)e * ECAP + pos] = trs[q >> 1]; tokinfo[(size_t)tok * 2 + (q & 1)] = ((unsigned)e << 16) | (unsigned)pos; }
        __syncthreads();
    }
    __syncthreads();
}

__device__ __forceinline__ void phase_conv(const Params& p, int gw, int NGW, int lane) {
    const bf16_t* BG = (const bf16_t*)(p.ws + WS_BG); const bf16_t* Z = (const bf16_t*)(p.ws + WS_Z); bf16_t* A2 = (bf16_t*)(p.ws + WS_CAT);
    const float* cw = p.in[16];
    float w0[16], w1[16], w2[16];
#pragma unroll
    for (int h = 0; h < 2; ++h)
#pragma unroll
        for (int j = 0; j < 8; ++j) { const int c = h * 512 + lane * 8 + j; w0[h * 8 + j] = cw[c]; w1[h * 8 + j] = cw[D + c]; w2[h * 8 + j] = cw[2 * D + c]; }
    for (int run = gw; run < T / 32; run += NGW) {
        const int t0 = run * 32;
        float zm1[16], zm2[16];
#pragma unroll
        for (int j = 0; j < 16; ++j) { zm1[j] = 0.f; zm2[j] = 0.f; }
        if ((t0 & (SEQ - 1)) != 0) {
#pragma unroll
            for (int h = 0; h < 2; ++h) { const u32x4 a = *(const u32x4*)(Z + (size_t)(t0 - 1) * D + h * 512 + lane * 8), b = *(const u32x4*)(Z + (size_t)(t0 - 2) * D + h * 512 + lane * 8);
#pragma unroll
                for (int q = 0; q < 4; ++q) { zm1[h * 8 + 2 * q] = bf_lo(a[q]); zm1[h * 8 + 2 * q + 1] = bf_hi(a[q]); zm2[h * 8 + 2 * q] = bf_lo(b[q]); zm2[h * 8 + 2 * q + 1] = bf_hi(b[q]); } }
        }
#pragma unroll 4
        for (int i = 0; i < 32; ++i) {
            const size_t rb = (size_t)(t0 + i) * D;
#pragma unroll
            for (int h = 0; h < 2; ++h) { const u32x4 zz = *(const u32x4*)(Z + rb + h * 512 + lane * 8), bb = *(const u32x4*)(BG + rb + h * 512 + lane * 8);
                float o[8];
#pragma unroll
                for (int q = 0; q < 4; ++q) {
#pragma unroll
                    for (int s = 0; s < 2; ++s) { const int j = h * 8 + 2 * q + s; const float zc = s ? bf_hi(zz[q]) : bf_lo(zz[q]), bg = s ? bf_hi(bb[q]) : bf_lo(bb[q]);
                        o[2 * q + s] = bg * (w0[j] * zm2[j] + w1[j] * zm1[j] + w2[j] * zc); zm2[j] = zm1[j]; zm1[j] = zc; } }
                u32x4 w; w.x = cvt_pk_bf16(o[0], o[1]); w.y = cvt_pk_bf16(o[2], o[3]); w.z = cvt_pk_bf16(o[4], o[5]); w.w = cvt_pk_bf16(o[6], o[7]);
                *(u32x4*)(A2 + rb + h * 512 + lane * 8) = w; }
        }
    }
}

__device__ __forceinline__ void phase_gate_scan(const Params& p, int gw, int NGW, int lane) {
    const float* gates = (const float*)(p.ws + WS_GATES);
    float* SA = (float*)(p.ws + WS_SA); float* SAM = (float*)(p.ws + WS_SAM); float* SBA = (float*)(p.ws + WS_SBA);
    for (int sq = gw; sq < NBATCH * 4; sq += NGW) {
        const int b = sq >> 2, hd = sq & 3; const float ib = p.in[7][hd], fb = p.in[8][hd];
        float lf[32], ig[32];
#pragma unroll
        for (int i = 0; i < 32; ++i) { const size_t t = (size_t)b * SEQ + lane * 32 + i; const float f = gates[t * 8 + 4 + hd] + fb; ig[i] = gates[t * 8 + hd] + ib;
            lf[i] = (f >= 0.f) ? -log1pf(expf(-f)) : (f - log1pf(expf(f))); }
        float run = 0.f;
#pragma unroll
        for (int i = 0; i < 32; ++i) { run += lf[i]; lf[i] = run; }
        float tot = run, pre = 0.f;
#pragma unroll
        for (int o = 1; o < 64; o <<= 1) { const float v = __shfl_up(tot, o); if (lane >= o) tot += v; }
        pre = tot - run;
        float amax = -INFINITY;
#pragma unroll
        for (int i = 0; i < 32; ++i) { lf[i] += pre; ig[i] = ig[i] - lf[i]; amax = fmaxf(amax, ig[i]); }
        float pm = amax;
#pragma unroll
        for (int o = 1; o < 64; o <<= 1) { const float v = __shfl_up(pm, o); if (lane >= o) pm = fmaxf(pm, v); }
        float prev = __shfl_up(pm, 1); if (lane == 0) prev = -INFINITY;
        float rm = prev;
#pragma unroll
        for (int i = 0; i < 32; ++i) { const size_t o = (size_t)sq * SEQ + lane * 32 + i; rm = fmaxf(rm, ig[i]); SA[o] = ig[i]; SAM[o] = rm; SBA[o] = lf[i] + rm; }
    }
}

struct TileRegs { u32x4 v[2]; };
__device__ __forceinline__ TileRegs tile_load(const bf16_t* src, int tid) { TileRegs r;
#pragma unroll
    for (int i = 0; i < 2; ++i) { const int n = tid + 512 * i, row = n >> 4, ch = n & 15; r.v[i] = *(const u32x4*)(src + (size_t)row * NP + ch * 8); } return r; }
__device__ __forceinline__ void tile_write(LAS unsigned char* dst, int tid, const TileRegs& r) {
#pragma unroll
    for (int i = 0; i < 2; ++i) { const int n = tid + 512 * i, row = n >> 4, ch = n & 15; *(LAS u32x4*)(dst + off_b(row, ch)) = r.v[i]; } }

__device__ __forceinline__ void glds16(const void* gsrc, unsigned lds_dst) { unsigned keep;
    asm volatile("s_mov_b32 %0, m0\n\ts_mov_b32 m0, %2\n\ts_nop 0\n\tglobal_load_lds_dwordx4 %1, off\n\ts_mov_b32 m0, %0" : "=&s"(keep) : "v"(gsrc), "s"(lds_dst) : "memory"); }
__device__ __forceinline__ void tile_dma(const bf16_t* src, LAS unsigned char* dst, int wave, int lane) {
#pragma unroll
    for (int i = 0; i < 2; ++i) { const int piece = 2 * wave + i, row = 4 * piece + (lane >> 4); const unsigned ch = (unsigned)(lane & 15) ^ ((((unsigned)lane >> 4) << 2) | ((unsigned)piece & 3u));
        glds16(src + (size_t)row * NP + ch * 8, (unsigned)__builtin_amdgcn_readfirstlane((int)(unsigned)(uintptr_t)(dst + piece * 1024))); }
}
#define WAIT_ALL_BAR() asm volatile("s_waitcnt vmcnt(0) lgkmcnt(0)\n\ts_barrier" ::: "memory")
__device__ __forceinline__ void attn_unit(const Params& p, LAS unsigned char* lds, int bh, int qblk, int tid_, int wave, int lane_) {
    int tid = tid_; asm volatile("" : "+v"(tid)); const int lane = tid & 63;
    const bf16_t* P = (const bf16_t*)(p.ws + WS_P); bf16_t* CAT = (bf16_t*)(p.ws + WS_CAT);
    const int b = bh >> 2, hd = bh & 3, map = wave >> 2, qs = wave & 3, r32 = lane & 31, hi = lane >> 5;
    const size_t rowbase = (size_t)b * SEQ;
    const int q0 = qblk * 128 + qs * 32, qrow = q0 + r32;
    LAS float* fs = (LAS float*)(lds + MISC_OFF) + MW_F;
    LAS float* tbl = fs;
    constexpr float LOG2E = 1.4426950408889634f;
    if (tid < 272) { const int n = tid - 64; int bk;
        if (n < 16) bk = n < 0 ? 0 : n; else { bk = 16; const int th[15] = {19, 21, 24, 27, 31, 35, 40, 46, 52, 59, 67, 77, 87, 99, 113};
#pragma unroll
            for (int j = 0; j < 15; ++j) bk += (n >= th[j]) ? 1 : 0; }
        tbl[tid] = n < 0 ? -INFINITY : p.in[1][bk * 4 + hd] * LOG2E; }
    bf16x8 qf[4];
    { const bf16_t* qp = P + (rowbase + qrow) * NP + P_DQ + hd * 128 + map * 64 + hi * 8;
#pragma unroll
      for (int ks = 0; ks < 4; ++ks) qf[ks] = *(const bf16x8*)(qp + ks * 16); }
    const bf16_t* Kg = P + rowbase * NP + P_DK + hd * 128; const bf16_t* Vg = P + rowbase * NP + P_DV + hd * 128;
    const int NS = qblk + 1;
    f32x16 o[4];
#pragma unroll
    for (int c = 0; c < 4; ++c) o[c] = (f32x16){};
    float mrun = -INFINITY, lrun = 0.f;
    const float bias_far = p.in[1][31 * 4 + hd] * LOG2E;
    const unsigned xr = ((unsigned)(r32 & 3) << 2) | ((unsigned)(r32 >> 2) & 3u);
    const unsigned q4 = (lane & 15) >> 2, pp = lane & 3, blk = (lane >> 4) & 1;
#ifndef ATT_DMA
#define ATT_DMA 5
#endif
#ifndef ATT_LATE_DMA
#define ATT_LATE_DMA 1
#endif
#if ATT_DMA == 2 || ATT_DMA == 4
#elif ATT_DMA
    WAIT_ALL_BAR();
    { tile_dma(Kg, lds, wave, lane); tile_dma(Vg, lds + 16384, wave, lane); tile_dma(Kg + (size_t)64 * NP, lds + 32768, wave, lane); tile_dma(Vg + (size_t)64 * NP, lds + 49152, wave, lane); }
#else
    { TileRegs a0 = tile_load(Kg, tid), a1 = tile_load(Vg, tid), a2 = tile_load(Kg + (size_t)64 * NP, tid), a3 = tile_load(Vg + (size_t)64 * NP, tid);
      tile_write(lds, tid, a0); tile_write(lds + 16384, tid, a1); tile_write(lds + 32768, tid, a2); tile_write(lds + 49152, tid, a3); }
#endif
#if ATT_DMA == 5
    WAIT_ALL_BAR();
#endif
    asm volatile("" :: "v"(qf[0]), "v"(qf[1]), "v"(qf[2]), "v"(qf[3]));
#pragma unroll 1
    for (int st = 0; st < NS; ++st) {
        WAIT_ALL_BAR();
#if ATT_DMA == 2
        { LAS unsigned char* nb = lds + (st & 1) * 65536; const size_t ro = (size_t)st * 128 * NP;
            tile_dma(Kg + ro, nb, wave, lane); tile_dma(Vg + ro, nb + 16384, wave, lane); tile_dma(Kg + ro + (size_t)64 * NP, nb + 32768, wave, lane); tile_dma(Vg + ro + (size_t)64 * NP, nb + 49152, wave, lane); }
        WAIT_ALL_BAR();
#elif ATT_DMA == 3
#elif ATT_DMA
#if ATT_DMA == 4
        if (st == 0) { tile_dma(Kg, lds, wave, lane); tile_dma(Vg, lds + 16384, wave, lane); tile_dma(Kg + (size_t)64 * NP, lds + 32768, wave, lane); tile_dma(Vg + (size_t)64 * NP, lds + 49152, wave, lane); WAIT_ALL_BAR(); }
#endif
        if (!ATT_LATE_DMA && st + 1 < NS) { LAS unsigned char* nb = lds + ((st + 1) & 1) * 65536; const size_t ro = (size_t)(st + 1) * 128 * NP;
            tile_dma(Kg + ro, nb, wave, lane); tile_dma(Vg + ro, nb + 16384, wave, lane); tile_dma(Kg + ro + (size_t)64 * NP, nb + 32768, wave, lane); tile_dma(Vg + ro + (size_t)64 * NP, nb + 49152, wave, lane); }
#else
        TileRegs a0, a1;
        if (st + 1 < NS) { const size_t ro = (size_t)(st + 1) * 128 * NP; a0 = tile_load(Kg + ro, tid); a1 = tile_load(Vg + ro, tid); }
#endif
#pragma unroll
        for (int half = 0; half < 2; ++half) {
            const int j = 2 * st + half;
            const LAS unsigned char* Kt = lds + (st & 1) * 65536 + half * 32768; const LAS unsigned char* Vt = Kt + 16384;
            if (64 * j <= q0 + 31) {
                const int nmin = q0 - (64 * j + 63);
                const bool first = (mrun == -INFINITY);
                const float cinit = first ? 0.f : (nmin >= 113 ? bias_far - mrun : -mrun);
                f32x16 p0, p1;
#pragma unroll
                for (int r = 0; r < 16; ++r) { p0[r] = cinit; p1[r] = cinit; }
#pragma unroll
                for (int ks = 0; ks < 4; ++ks) { const unsigned ch = (unsigned)(8 * map + 2 * ks + hi) ^ xr;
                    const bf16x8 k0 = *(const LAS bf16x8*)(Kt + 256u * r32 + 16u * ch), k1 = *(const LAS bf16x8*)(Kt + 256u * (32 + r32) + 16u * ch);
                    p0 = __builtin_amdgcn_mfma_f32_32x32x16_bf16(k0, qf[ks], p0, 0, 0, 0); p1 = __builtin_amdgcn_mfma_f32_32x32x16_bf16(k1, qf[ks], p1, 0, 0, 0); }
                __builtin_amdgcn_sched_barrier(0);
                float rm = -INFINITY;
                if (first) {
                    if (nmin >= 113) {
#pragma unroll
                        for (int r = 0; r < 16; ++r) { p0[r] = p0[r] + bias_far; p1[r] = p1[r] + bias_far; rm = fmaxf(rm, fmaxf(p0[r], p1[r])); }
                    } else {
                        const LAS float* tb = tbl + (qrow - 64 * j - 4 * hi + 5);
#pragma unroll
                        for (int r = 0; r < 16; ++r) { const int e = (r & 3) + 8 * (r >> 2);
                            p0[r] += tb[59 - e]; p1[r] += tb[27 - e];
                            rm = fmaxf(rm, fmaxf(p0[r], p1[r])); }
                    }
                    { auto rr = __builtin_amdgcn_permlane32_swap(__float_as_uint(rm), __float_as_uint(rm), false, false); rm = fmaxf(__uint_as_float(rr[0]), __uint_as_float(rr[1])); }
                    mrun = rm;
#pragma unroll
                    for (int r = 0; r < 16; ++r) { p0[r] -= mrun; p1[r] -= mrun; }
                } else {
                    if (nmin < 113) {
                        const LAS float* tb = tbl + (qrow - 64 * j - 4 * hi + 5);
                        float bv0[16], bv1[16];
#pragma unroll
                        for (int r = 0; r < 16; ++r) { const int e = (r & 3) + 8 * (r >> 2); bv0[r] = tb[59 - e]; bv1[r] = tb[27 - e]; }
#pragma unroll
                        for (int r = 0; r < 16; ++r) { p0[r] += bv0[r]; p1[r] += bv1[r]; }
                    }
                    { float m0 = fmaxf(p0[0], p1[0]), m1 = fmaxf(p0[1], p1[1]);
#pragma unroll
                      for (int r = 2; r < 16; r += 2) { m0 = __builtin_fmaxf(__builtin_fmaxf(m0, p0[r]), p1[r]); m1 = __builtin_fmaxf(__builtin_fmaxf(m1, p0[r + 1]), p1[r + 1]); }
                      rm = fmaxf(m0, m1); }
                    { auto rr = __builtin_amdgcn_permlane32_swap(__float_as_uint(rm), __float_as_uint(rm), false, false); rm = fmaxf(__uint_as_float(rr[0]), __uint_as_float(rr[1])); }
                    if (__any(rm > 8.0f)) {
                        const float dl = fmaxf(rm, 0.f); const float alpha = fast_exp2(-dl);
                        lrun *= alpha; mrun += dl;
#pragma unroll
                        for (int r = 0; r < 16; ++r) { p0[r] -= dl; p1[r] -= dl; }
#pragma unroll
                        for (int c = 0; c < 4; ++c)
#pragma unroll
                            for (int r = 0; r < 16; ++r) o[c][r] *= alpha;
                    }
                }
                float psa = 0.f, psb = 0.f;
                bf16x8 pf[4];
#define ATT_EXPK(ks_) do { u32x4 w_; _Pragma("unroll") for (int q = 0; q < 4; ++q) { const int r = 8 * ((ks_) & 1) + 2 * q; \
                        const float ea = fast_exp2((ks_) < 2 ? p0[r] : p1[r]), eb = fast_exp2((ks_) < 2 ? p0[r + 1] : p1[r + 1]); psa += ea; psb += eb; w_[q] = cvt_pk_bf16(ea, eb); } \
                    pf[ks_] = __builtin_bit_cast(bf16x8, w_); } while (0)
                bf16x8 vf[2][4];
#define ATT_LOADV(buf, ks_) do { _Pragma("unroll") for (int c = 0; c < 4; ++c) { const unsigned chv = (unsigned)(4 * c + 2 * blk + (pp >> 1)); const unsigned row0 = 16u * (ks_) + 4u * hi + q4; \
                        vf[buf][c] = cat8(vtr(Vt + off_b(row0, chv) + 8u * (pp & 1)), vtr(Vt + off_b(row0 + 8u, chv) + 8u * (pp & 1))); } } while (0)
                ATT_LOADV(0, 0);
                ATT_EXPK(0);
                if (ATT_LATE_DMA && half == 0 && st + 1 < NS) {
                    LAS unsigned char* nb = lds + ((st + 1) & 1) * 65536; const size_t ro = (size_t)(st + 1) * 128 * NP;
                    tile_dma(Kg + ro, nb, wave, lane); tile_dma(Vg + ro, nb + 16384, wave, lane); tile_dma(Kg + ro + (size_t)64 * NP, nb + 32768, wave, lane); tile_dma(Vg + ro + (size_t)64 * NP, nb + 49152, wave, lane); }
#pragma unroll
                for (int ks = 0; ks < 4; ++ks) {
                    if (ks < 3) ATT_LOADV((ks + 1) & 1, ks + 1);
                    __builtin_amdgcn_sched_barrier(0);
#pragma unroll
                    for (int c = 0; c < 4; ++c) o[c] = __builtin_amdgcn_mfma_f32_32x32x16_bf16(vf[ks & 1][c], pf[ks], o[c], 0, 0, 0);
                    if (ks < 3) { ATT_EXPK(ks + 1); asm volatile("" : "+v"(pf[(ks + 1) & 3]), "+v"(psa), "+v"(psb)); }
                    __builtin_amdgcn_sched_barrier(0);
                }
                lrun += psa + psb;
#undef ATT_EXPK
#undef ATT_LOADV
            }
#if ATT_DMA == 5
            if (half == 0) WAIT_ALL_BAR();
#endif
#if !ATT_DMA
            if (st + 1 < NS) { LAS unsigned char* nb = lds + ((st + 1) & 1) * 65536 + half * 32768; tile_write(nb, tid, a0); tile_write(nb + 16384, tid, a1);
                if (half == 0) { const size_t ro = (size_t)(st + 1) * 128 * NP + (size_t)64 * NP; a0 = tile_load(Kg + ro, tid); a1 = tile_load(Vg + ro, tid); } }
#endif
        }
#if ATT_DMA == 3
        WAIT_ALL_BAR();
        if (st + 1 < NS) { LAS unsigned char* nb = lds + ((st + 1) & 1) * 65536; const size_t ro = (size_t)(st + 1) * 128 * NP;
            tile_dma(Kg + ro, nb, wave, lane); tile_dma(Vg + ro, nb + 16384, wave, lane); tile_dma(Kg + ro + (size_t)64 * NP, nb + 32768, wave, lane); tile_dma(Vg + ro + (size_t)64 * NP, nb + 49152, wave, lane); }
#endif

    }
    WAIT_ALL_BAR();
    lrun += __shfl_xor(lrun, 32);
    const float inv = 1.0f / lrun;
    float lam;
    { float s1 = 0.f, s2 = 0.f; const float a1 = p.in[10][lane] * p.in[11][lane], a2 = p.in[12][lane] * p.in[13][lane]; s1 = wave_sum(a1); s2 = wave_sum(a2);
      const float lam_init = 0.8f - 0.6f * 1.0f;
      lam = expf(s1) - expf(s2) + lam_init; }
    LAS float* xch = (LAS float*)lds + qs * 4096;
    if (map == 1) {
#pragma unroll
        for (int c = 0; c < 4; ++c)
#pragma unroll
            for (int r = 0; r < 16; ++r) xch[(32 * c + crow(r, hi)) * 32 + r32] = o[c][r] * inv * lam;
    }
    __syncthreads();
    if (map == 0) {
        float ss = 0.f;
#pragma unroll
        for (int c = 0; c < 4; ++c)
#pragma unroll
            for (int r = 0; r < 16; ++r) { const float v = o[c][r] * inv - xch[(32 * c + crow(r, hi)) * 32 + r32]; o[c][r] = v; ss += v * v; }
        ss += __shfl_xor(ss, 32);
        const float rstd = 1.0f / sqrtf(ss * (1.0f / 128.0f) + NORM_EPS) * 0.8f;
        const float* sub = p.in[14];
        bf16_t* orow = CAT + (rowbase + qrow) * D + 512 + hd * 128;
#pragma unroll
        for (int c = 0; c < 4; ++c)
#pragma unroll
            for (int rq = 0; rq < 4; ++rq) { const int e0 = 32 * c + 8 * rq + 4 * hi; const f32x4 sv = *(const f32x4*)(sub + e0);
                u32x2 w; w.x = cvt_pk_bf16(o[c][4 * rq] * rstd * sv[0], o[c][4 * rq + 1] * rstd * sv[1]); w.y = cvt_pk_bf16(o[c][4 * rq + 2] * rstd * sv[2], o[c][4 * rq + 3] * rstd * sv[3]);
                *(u32x2*)(orow + e0) = w; }
    }
    __syncthreads();
}

__device__ __forceinline__ void mlstm_s1_unit(const Params& p, LAS unsigned char* lds, int bh, int c, int tid_, int wave, int lane_) {
    int tid = tid_; asm volatile("" : "+v"(tid)); const int lane = tid & 63;
    const bf16_t* P = (const bf16_t*)(p.ws + WS_P);
    const int b = bh >> 2, hd = bh & 3, r32 = lane & 31, hi = lane >> 5;
    const size_t t0 = (size_t)b * SEQ + (size_t)c * MCH;
    const float* SA = (const float*)(p.ws + WS_SA) + (size_t)bh * SEQ + c * MCH;
    LAS float* fs = (LAS float*)(lds + MISC_OFF) + MW_F;
    LAS float* wsm = fs;
    LAS float* red = fs + 256;
    float av = (tid < 256) ? SA[tid] : -INFINITY;
    float mx = av;
#pragma unroll
    for (int o = 1; o < 64; o <<= 1) mx = fmaxf(mx, __shfl_xor(mx, o));
    if (lane == 0) red[wave] = mx;
    __syncthreads();
    float R = red[0];
#pragma unroll
    for (int w = 1; w < 4; ++w) R = fmaxf(R, red[w]);
    if (tid < 256) wsm[tid] = __expf(av - R) * 0.08838834764831845f;
    __syncthreads();
    LAS unsigned char* Kl = lds; LAS unsigned char* Vl = lds + 65536;
    const bf16_t* Kg = P + t0 * NP + P_MK + hd * 128; const bf16_t* Vg = P + t0 * NP + P_MV + hd * 128;
#pragma unroll
    for (int i = 0; i < 8; ++i) { const int n = tid + 512 * i, row = n >> 4, ch = n & 15;
        const u32x4 kv = *(const u32x4*)(Kg + (size_t)row * NP + ch * 8); const u32x4 vv = *(const u32x4*)(Vg + (size_t)row * NP + ch * 8);
        const float w = wsm[row]; u32x4 ks;
#pragma unroll
        for (int q = 0; q < 4; ++q) ks[q] = cvt_pk_bf16(bf_lo(kv[q]) * w, bf_hi(kv[q]) * w);
        *(LAS u32x4*)(Kl + off_b(row, ch)) = ks; *(LAS u32x4*)(Vl + off_b(row, ch)) = vv; }
    __syncthreads();
    const int eb = wave >> 1, dh = wave & 1;
    const unsigned q4 = (lane & 15) >> 2, pp = lane & 3, blk = (lane >> 4) & 1;
    f32x16 acc[2]; acc[0] = (f32x16){}; acc[1] = (f32x16){};
    for (int ks = 0; ks < 16; ++ks) {
        const unsigned row0 = 16u * ks + 8u * hi + q4, row1 = row0 + 4u;
        const unsigned cha = (unsigned)(4 * eb + 2 * blk + (pp >> 1));
        const bf16x8 af = cat8(vtr(Vl + off_b(row0, cha) + 8u * (pp & 1)), vtr(Vl + off_b(row1, cha) + 8u * (pp & 1)));
#pragma unroll
        for (int db = 0; db < 2; ++db) { const unsigned chb = (unsigned)(4 * (2 * dh + db) + 2 * blk + (pp >> 1));
            const bf16x8 bfr = cat8(vtr(Kl + off_b(row0, chb) + 8u * (pp & 1)), vtr(Kl + off_b(row1, chb) + 8u * (pp & 1)));
            acc[db] = __builtin_amdgcn_mfma_f32_32x32x16_bf16(af, bfr, acc[db], 0, 0, 0); }
    }
    const int unit = bh * NCH + c;
    float* UT = (float*)(p.ws + WS_UT) + (size_t)unit * 16384;
#pragma unroll
    for (int db = 0; db < 2; ++db)
#pragma unroll
        for (int r = 0; r < 16; ++r) UT[(32 * eb + crow(r, hi)) * 128 + 64 * dh + 32 * db + r32] = acc[db][r];
    if (tid < 128) { float s = 0.f; const int d = tid;
        for (int srow = 0; srow < 256; ++srow) { const unsigned short hv = *(const LAS unsigned short*)(Kl + off_b(srow, d >> 3) + (d & 7) * 2); s += __uint_as_float((unsigned)hv << 16); }
        ((float*)(p.ws + WS_UN))[(size_t)unit * 128 + d] = s; }
    if (tid == 0) ((float*)(p.ws + WS_UR))[unit] = R;
    __syncthreads();
}

__device__ __forceinline__ void mlstm_s3_unit(const Params& p, LAS unsigned char* lds, int bh, int c, int tid_, int wave, int lane_) {
    int tid = tid_; asm volatile("" : "+v"(tid)); const int lane = tid & 63;
    const bf16_t* P = (const bf16_t*)(p.ws + WS_P); bf16_t* CAT = (bf16_t*)(p.ws + WS_CAT);
    const int b = bh >> 2, hd = bh & 3, r32 = lane & 31, hi = lane >> 5;
    const size_t t0 = (size_t)b * SEQ + (size_t)c * MCH;
    const size_t so = (size_t)bh * SEQ + c * MCH;
    const float* SA = (const float*)(p.ws + WS_SA) + so; const float* SAM = (const float*)(p.ws + WS_SAM) + so; const float* SBA = (const float*)(p.ws + WS_SBA) + so;
    LAS float* fs = (LAS float*)(lds + MISC_OFF) + MW_F;
    LAS float* as = fs;
    LAS float* nC = fs + 256;
    LAS unsigned char* Ct = lds + 65536;
    const int qloc = 32 * wave + r32;
    const float Aq = SAM[qloc], BAq = SBA[qloc];
    if (tid < 256) as[tid] = SA[tid];
    bf16x8 qf[8];
    { const bf16_t* qp = P + (t0 + qloc) * NP + P_MQ + hd * 128 + hi * 8;
#pragma unroll
      for (int ks = 0; ks < 8; ++ks) qf[ks] = *(const bf16x8*)(qp + ks * 16); }
    const bf16_t* Kg = P + t0 * NP + P_MK + hd * 128; const bf16_t* Vg = P + t0 * NP + P_MV + hd * 128;
#if defined(S3_REGSTAGE)
    { TileRegs k0 = tile_load(Kg, tid), v0 = tile_load(Vg, tid); tile_write(lds, tid, k0); tile_write(lds + 16384, tid, v0); }
#elif !defined(S3_SERIAL)
    tile_dma(Kg, lds, wave, lane); tile_dma(Vg, lds + 16384, wave, lane);
#endif
    f32x16 o[4];
#pragma unroll
    for (int cb = 0; cb < 4; ++cb) o[cb] = (f32x16){};
    float den = 0.f, fst = 0.f;
    const unsigned xr = ((unsigned)(r32 & 3) << 2) | ((unsigned)(r32 >> 2) & 3u);
    if (c > 0) {
        const float* UR = (const float*)(p.ws + WS_UR) + bh * NCH; const float* UT = (const float*)(p.ws + WS_UT) + (size_t)bh * NCH * 16384; const float* UN = (const float*)(p.ws + WS_UN) + (size_t)bh * NCH * 128;
        float Pref = -INFINITY, ur[7];
#pragma unroll
        for (int j = 0; j < 7; ++j) { ur[j] = UR[j]; if (j < c) Pref = fmaxf(Pref, ur[j]); }
        float cf[7];
#pragma unroll
        for (int j = 0; j < 7; ++j) cf[j] = (j < c) ? __expf(ur[j] - Pref) : 0.f;
#pragma unroll 1
        for (int i = 0; i < 4; ++i) { const int n = tid + 512 * i, e = n >> 4, ch = n & 15; f32x4 u0[7], u1[7];
#pragma unroll
            for (int j = 0; j < 7; ++j) { const f32x4* up = (const f32x4*)(UT + (size_t)j * 16384 + e * 128 + ch * 8); u0[j] = up[0]; u1[j] = up[1]; }
            f32x4 s0 = (f32x4){0.f, 0.f, 0.f, 0.f}, s1 = s0;
#pragma unroll
            for (int j = 0; j < 7; ++j) { s0 += u0[j] * cf[j]; s1 += u1[j] * cf[j]; }
            u32x4 w; w.x = cvt_pk_bf16(s0[0], s0[1]); w.y = cvt_pk_bf16(s0[2], s0[3]); w.z = cvt_pk_bf16(s1[0], s1[1]); w.w = cvt_pk_bf16(s1[2], s1[3]);
            *(LAS u32x4*)(Ct + off_b(e, ch)) = w; }
        if (tid < 128) { float sN = 0.f;
#pragma unroll
            for (int j = 0; j < 7; ++j) sN += cf[j] * UN[j * 128 + tid];
            nC[tid] = sN; }
        fst = __expf(Pref - Aq);
    }
    asm volatile("" :: "v"(qf[0]), "v"(qf[1]), "v"(qf[2]), "v"(qf[3]), "v"(qf[4]), "v"(qf[5]), "v"(qf[6]), "v"(qf[7]), "v"(Aq), "v"(BAq));
    WAIT_ALL_BAR();
    if (c > 0) {
#pragma unroll
        for (int cb = 0; cb < 4; ++cb) {
#pragma unroll
            for (int ks = 0; ks < 8; ++ks) { const unsigned ch = (unsigned)(2 * ks + hi) ^ xr;
                const bf16x8 cfr = *(const LAS bf16x8*)(Ct + 256u * (32 * cb + r32) + 16u * ch);
                o[cb] = __builtin_amdgcn_mfma_f32_32x32x16_bf16(cfr, qf[ks], o[cb], 0, 0, 0); }
            __builtin_amdgcn_sched_barrier(0); }
#pragma unroll
        for (int cb = 0; cb < 4; ++cb)
#pragma unroll
            for (int r = 0; r < 16; ++r) o[cb][r] *= fst;
        float dq = 0.f;
#pragma unroll
        for (int ks = 0; ks < 8; ++ks)
#pragma unroll
            for (int q = 0; q < 4; ++q) { const unsigned w = ((const unsigned*)&qf[ks])[q]; const int d = 16 * ks + 8 * hi + 2 * q; dq += bf_lo(w) * nC[d] + bf_hi(w) * nC[d + 1]; }
        den = fst * dq;
    }
    const unsigned q4 = (lane & 15) >> 2, pp = lane & 3, blk = (lane >> 4) & 1;
#pragma unroll 1
    for (int j = 0; j < 4; ++j) {
        WAIT_ALL_BAR();
        const LAS unsigned char* Kt = lds + (j & 1) * 32768; const LAS unsigned char* Vt = Kt + 16384;
#if defined(S3_REGSTAGE)
        TileRegs kr, vr; if (j + 1 < 4) { kr = tile_load(Kg + (size_t)(j + 1) * 64 * NP, tid); vr = tile_load(Vg + (size_t)(j + 1) * 64 * NP, tid); }
#elif defined(S3_SERIAL)
        { LAS unsigned char* nb = lds + (j & 1) * 32768; tile_dma(Kg + (size_t)j * 64 * NP, nb, wave, lane); tile_dma(Vg + (size_t)j * 64 * NP, nb + 16384, wave, lane); }
        WAIT_ALL_BAR();
#else
        if (j + 1 < 4) { LAS unsigned char* nb = lds + ((j + 1) & 1) * 32768; tile_dma(Kg + (size_t)(j + 1) * 64 * NP, nb, wave, lane); tile_dma(Vg + (size_t)(j + 1) * 64 * NP, nb + 16384, wave, lane); }
#endif
        const bool doit = (64 * j <= 32 * wave + 31);
        bf16x8 pf[4];
        if (doit) {
            f32x16 p0 = (f32x16){}, p1 = (f32x16){};
#pragma unroll
            for (int ks = 0; ks < 8; ++ks) { const unsigned ch = (unsigned)(2 * ks + hi) ^ xr;
                const bf16x8 k0 = *(const LAS bf16x8*)(Kt + 256u * r32 + 16u * ch), k1 = *(const LAS bf16x8*)(Kt + 256u * (32 + r32) + 16u * ch);
                p0 = __builtin_amdgcn_mfma_f32_32x32x16_bf16(k0, qf[ks], p0, 0, 0, 0); p1 = __builtin_amdgcn_mfma_f32_32x32x16_bf16(k1, qf[ks], p1, 0, 0, 0); if ((ks & 3) == 3) __builtin_amdgcn_sched_barrier(0); }
            float ps = 0.f;
#pragma unroll
            for (int r = 0; r < 16; ++r) { const int kv = 64 * j + crow(r, hi);
                const float w0 = (kv <= qloc) ? __expf(as[kv] - Aq) * 0.08838834764831845f : 0.f, w1 = (kv + 32 <= qloc) ? __expf(as[kv + 32] - Aq) * 0.08838834764831845f : 0.f;
                p0[r] *= w0; p1[r] *= w1; ps += p0[r] + p1[r]; }
            den += ps;
#pragma unroll
            for (int ks = 0; ks < 4; ++ks) { u32x4 w;
#pragma unroll
                for (int q = 0; q < 4; ++q) { const int r = 8 * (ks & 1) + 2 * q; w[q] = (ks < 2) ? cvt_pk_bf16(p0[r], p0[r + 1]) : cvt_pk_bf16(p1[r], p1[r + 1]); }
                pf[ks] = __builtin_bit_cast(bf16x8, w); }
        }
        WAIT_ALL_BAR();
        if (doit) {
            bf16x8 vf[2][4];
#define S3_LOADV(buf, ks_) do { _Pragma("unroll") for (int cb = 0; cb < 4; ++cb) { const unsigned chv = (unsigned)(4 * cb + 2 * blk + (pp >> 1)); const unsigned row0 = 16u * (ks_) + 4u * hi + q4; \
                vf[buf][cb] = cat8(vtr(Vt + off_b(row0, chv) + 8u * (pp & 1)), vtr(Vt + off_b(row0 + 8u, chv) + 8u * (pp & 1))); } } while (0)
            S3_LOADV(0, 0);
#pragma unroll
            for (int ks = 0; ks < 4; ++ks) {
                if (ks < 3) S3_LOADV((ks + 1) & 1, ks + 1);
                __builtin_amdgcn_sched_barrier(0);
#pragma unroll
                for (int cb = 0; cb < 4; ++cb) o[cb] = __builtin_amdgcn_mfma_f32_32x32x16_bf16(vf[ks & 1][cb], pf[ks], o[cb], 0, 0, 0);
                __builtin_amdgcn_sched_barrier(0);
            }
#undef S3_LOADV
        }
#if defined(S3_REGSTAGE)
        if (j + 1 < 4) { LAS unsigned char* nb = lds + ((j + 1) & 1) * 32768; tile_write(nb, tid, kr); tile_write(nb + 16384, tid, vr); }
#endif
    }
    den += __shfl_xor(den, 32);
    const float dinv = 1.0f / fmaxf(fabsf(den), __expf(-BAq));
    float sm = 0.f;
#pragma unroll
    for (int cb = 0; cb < 4; ++cb)
#pragma unroll
        for (int r = 0; r < 16; ++r) { o[cb][r] *= dinv; sm += o[cb][r]; }
    sm += __shfl_xor(sm, 32);
    const float mu = sm * (1.0f / 128.0f);
    float vs = 0.f;
#pragma unroll
    for (int cb = 0; cb < 4; ++cb)
#pragma unroll
        for (int r = 0; r < 16; ++r) { o[cb][r] -= mu; vs += o[cb][r] * o[cb][r]; }
    vs += __shfl_xor(vs, 32);
    const float rstd = 1.0f / sqrtf(vs * (1.0f / 128.0f) + NORM_EPS);
    const float* hn = p.in[9] + hd * 128;
    const bf16_t* mo = P + (t0 + qloc) * NP + P_MO + hd * 128;
    bf16_t* orow = CAT + (t0 + qloc) * D + hd * 128;
    u32x2 mw[4][4];
#pragma unroll
    for (int cb = 0; cb < 4; ++cb)
#pragma unroll
        for (int rq = 0; rq < 4; ++rq) mw[cb][rq] = *(const u32x2*)(mo + 32 * cb + 8 * rq + 4 * hi);
#pragma unroll
    for (int cb = 0; cb < 4; ++cb)
#pragma unroll
        for (int rq = 0; rq < 4; ++rq) { const int e0 = 32 * cb + 8 * rq + 4 * hi; const f32x4 hv = *(const f32x4*)(hn + e0); const u32x2 m2 = mw[cb][rq];
            const float g0 = fast_rcp(1.0f + __expf(-bf_lo(m2.x))), g1 = fast_rcp(1.0f + __expf(-bf_hi(m2.x))), g2 = fast_rcp(1.0f + __expf(-bf_lo(m2.y))), g3 = fast_rcp(1.0f + __expf(-bf_hi(m2.y)));
            u32x2 w; w.x = cvt_pk_bf16(o[cb][4 * rq] * rstd * hv[0] * g0, o[cb][4 * rq + 1] * rstd * hv[1] * g1); w.y = cvt_pk_bf16(o[cb][4 * rq + 2] * rstd * hv[2] * g2, o[cb][4 * rq + 3] * rstd * hv[3] * g3);
            *(u32x2*)(orow + e0) = w; }
    WAIT_ALL_BAR();
}

__device__ __forceinline__ void mlstm_seq_unit(const Params& p, LAS unsigned char* lds, int bh, int tid_, int wave, int lane_) {
    int tid = tid_; asm volatile("" : "+v"(tid)); const int lane = tid & 63;
    const bf16_t* P = (const bf16_t*)(p.ws + WS_P); bf16_t* CAT = (bf16_t*)(p.ws + WS_CAT);
    const int b = bh >> 2, hd = bh & 3, r32 = lane & 31, hi = lane >> 5;
    LAS float* fs = (LAS float*)(lds + MISC_OFF) + MW_F;
    LAS float* as = fs;
    LAS float* nC = fs + 256;
    LAS float* wsc = fs + 384;
    LAS unsigned char* Ct = lds + 65536;
    const unsigned xr = ((unsigned)(r32 & 3) << 2) | ((unsigned)(r32 >> 2) & 3u);
    const unsigned q4 = (lane & 15) >> 2, pp = lane & 3, blk = (lane >> 4) & 1;
    const int eb = wave >> 1, dh = wave & 1;
    f32x16 cacc[2]; cacc[0] = (f32x16){}; cacc[1] = (f32x16){};
    float nrun = 0.f;
    float Prun = -INFINITY;
    LAS float* hnl = fs + 896;
    if (tid < 128) hnl[tid] = p.in[9][hd * 128 + tid];
#pragma unroll 1
    for (int c = 0; c < NCH; ++c) {
        const size_t t0 = (size_t)b * SEQ + (size_t)c * MCH;
        const size_t so = (size_t)bh * SEQ + c * MCH;
        const float* SA = (const float*)(p.ws + WS_SA) + so; const float* SAM = (const float*)(p.ws + WS_SAM) + so; const float* SBA = (const float*)(p.ws + WS_SBA) + so;
        const int qloc = 32 * wave + r32;
        const float Aq2 = SAM[qloc] * 1.4426950408889634f;
        if (tid < 256) as[tid] = SA[tid] * 1.4426950408889634f;
        bf16x8 qf[2];
        LAS bf16x8* qpark = (LAS bf16x8*)(lds + 98304 + tid * 64);
        LAS bf16x8* qpark2 = (LAS bf16x8*)(lds + 147456 + tid * 32);
        { const bf16_t* qp = P + (t0 + qloc) * NP + P_MQ + hd * 128 + hi * 8;
#pragma unroll
          for (int ks = 0; ks < 2; ++ks) qf[ks] = *(const bf16x8*)(qp + ks * 16);
#pragma unroll
          for (int ks = 2; ks < 6; ++ks) qpark[ks - 2] = *(const bf16x8*)(qp + ks * 16);
#pragma unroll
          for (int ks = 6; ks < 8; ++ks) qpark2[ks - 6] = *(const bf16x8*)(qp + ks * 16); }
#define QFRAG(ks) ((ks) < 2 ? qf[(ks) & 1] : ((ks) < 6 ? qpark[((ks) - 2) & 3] : qpark2[((ks) - 6) & 1]))
        const bf16_t* Kg = P + t0 * NP + P_MK + hd * 128; const bf16_t* Vg = P + t0 * NP + P_MV + hd * 128;
        tile_dma(Kg, lds, wave, lane); tile_dma(Vg, lds + 16384, wave, lane);
        asm volatile("" :: "v"(qf[0]), "v"(qf[1]), "v"(Aq2));
        WAIT_ALL_BAR();
        float R = fmaxf(fmaxf(as[lane], as[lane + 64]), fmaxf(as[lane + 128], as[lane + 192]));
#pragma unroll
        for (int o = 1; o < 64; o <<= 1) R = fmaxf(R, __shfl_xor(R, o));
        R *= (1.0f / 1.4426950408889634f);
        const float Pnew = fmaxf(Prun, R);
        const float scC = (c > 0) ? __expf(Prun - Pnew) : 0.f;
        if (tid < 256) wsc[tid] = fast_exp2(as[tid] - Pnew * 1.4426950408889634f) * 0.08838834764831845f;
        f32x16 o[4];
#pragma unroll
        for (int cb = 0; cb < 4; ++cb) o[cb] = (f32x16){};
        float den = 0.f;
        if (c > 0) {
#pragma unroll
            for (int cb = 0; cb < 4; ++cb) {
#pragma unroll
                for (int ks = 0; ks < 8; ++ks) { const unsigned ch = (unsigned)(2 * ks + hi) ^ xr;
                    const bf16x8 cfr = *(const LAS bf16x8*)(Ct + 256u * (32 * cb + r32) + 16u * ch);
                    const bf16x8 qv = QFRAG(ks);
                    o[cb] = __builtin_amdgcn_mfma_f32_32x32x16_bf16(cfr, qv, o[cb], 0, 0, 0); }
                __builtin_amdgcn_sched_barrier(0); }
            const float fst = fast_exp2(Prun * 1.4426950408889634f - Aq2);
#pragma unroll
            for (int cb = 0; cb < 4; ++cb)
#pragma unroll
                for (int r = 0; r < 16; ++r) o[cb][r] *= fst;
            float dq = 0.f;
#pragma unroll
            for (int ks = 0; ks < 8; ++ks) { const bf16x8 qv = QFRAG(ks);
#pragma unroll
                for (int q = 0; q < 4; ++q) { const unsigned w = ((const unsigned*)&qv)[q]; const int d = 16 * ks + 8 * hi + 2 * q; dq += bf_lo(w) * nC[d] + bf_hi(w) * nC[d + 1]; } }
            den = fst * dq;
#pragma unroll
            for (int r = 0; r < 16; ++r) { cacc[0][r] *= scC; cacc[1][r] *= scC; }
        }
        nrun *= scC;
#pragma unroll 1
        for (int j = 0; j < 4; ++j) {
            WAIT_ALL_BAR();
            const LAS unsigned char* Kt = lds + (j & 1) * 32768; const LAS unsigned char* Vt = Kt + 16384;
            if (j + 1 < 4) { LAS unsigned char* nb = lds + ((j + 1) & 1) * 32768; tile_dma(Kg + (size_t)(j + 1) * 64 * NP, nb, wave, lane); tile_dma(Vg + (size_t)(j + 1) * 64 * NP, nb + 16384, wave, lane); }
            const bool doit = (64 * j <= 32 * wave + 31);
            if (doit) {
                float ps = 0.f;
#pragma unroll
                for (int hf = 0; hf < 2; ++hf) {
                    f32x16 pp0 = (f32x16){};
#pragma unroll
                    for (int ks = 0; ks < 8; ++ks) { const unsigned ch = (unsigned)(2 * ks + hi) ^ xr;
                        const bf16x8 k0 = *(const LAS bf16x8*)(Kt + 256u * (32 * hf + r32) + 16u * ch);
                        const bf16x8 qv = QFRAG(ks);
                        pp0 = __builtin_amdgcn_mfma_f32_32x32x16_bf16(k0, qv, pp0, 0, 0, 0); }
#pragma unroll
                    for (int r = 0; r < 16; ++r) { const int kv = 64 * j + 32 * hf + crow(r, hi);
                        const float w0 = (kv <= qloc) ? fast_exp2(as[kv] - Aq2) * 0.08838834764831845f : 0.f;
                        pp0[r] *= w0; ps += pp0[r]; }
                    bf16x8 pfh[2];
#pragma unroll
                    for (int k2 = 0; k2 < 2; ++k2) { u32x4 w;
#pragma unroll
                        for (int q = 0; q < 4; ++q) { const int r = 8 * k2 + 2 * q; w[q] = cvt_pk_bf16(pp0[r], pp0[r + 1]); }
                        pfh[k2] = __builtin_bit_cast(bf16x8, w); }
                    __builtin_amdgcn_sched_barrier(0);
#pragma unroll
                    for (int k2 = 0; k2 < 2; ++k2)
#pragma unroll
                        for (int c2 = 0; c2 < 2; ++c2) {
                            bf16x8 vf[2];
#pragma unroll
                            for (int u = 0; u < 2; ++u) { const int cb = 2 * c2 + u; const unsigned chv = (unsigned)(4 * cb + 2 * blk + (pp >> 1)); const unsigned row0 = 16u * (2 * hf + k2) + 4u * hi + q4;
                                vf[u] = cat8(vtr(Vt + off_b(row0, chv) + 8u * (pp & 1)), vtr(Vt + off_b(row0 + 8u, chv) + 8u * (pp & 1))); }
                            o[2 * c2] = __builtin_amdgcn_mfma_f32_32x32x16_bf16(vf[0], pfh[k2], o[2 * c2], 0, 0, 0); o[2 * c2 + 1] = __builtin_amdgcn_mfma_f32_32x32x16_bf16(vf[1], pfh[k2], o[2 * c2 + 1], 0, 0, 0);
                            __builtin_amdgcn_sched_barrier(0);
                        }
                }
                den += ps;
            }
#pragma unroll
            for (int ks = 0; ks < 4; ++ks) {
                const unsigned row0 = 16u * ks + 8u * hi + q4, row1 = row0 + 4u;
                const unsigned cha = (unsigned)(4 * eb + 2 * blk + (pp >> 1));
                const bf16x8 af = cat8(vtr(Vt + off_b(row0, cha) + 8u * (pp & 1)), vtr(Vt + off_b(row1, cha) + 8u * (pp & 1)));
                const f32x4 wa = *(const LAS f32x4*)(wsc + 64 * j + 16 * ks + 8 * hi), wb = *(const LAS f32x4*)(wsc + 64 * j + 16 * ks + 8 * hi + 4);
#pragma unroll
                for (int db = 0; db < 2; ++db) { const unsigned chb = (unsigned)(4 * (2 * dh + db) + 2 * blk + (pp >> 1));
                    const s16x4 k0 = vtr(Kt + off_b(row0, chb) + 8u * (pp & 1)), k1 = vtr(Kt + off_b(row1, chb) + 8u * (pp & 1));
                    const u32x2 u0 = __builtin_bit_cast(u32x2, k0), u1 = __builtin_bit_cast(u32x2, k1);
                    u32x4 kw; kw.x = cvt_pk_bf16(bf_lo(u0.x) * wa[0], bf_hi(u0.x) * wa[1]); kw.y = cvt_pk_bf16(bf_lo(u0.y) * wa[2], bf_hi(u0.y) * wa[3]);
                    kw.z = cvt_pk_bf16(bf_lo(u1.x) * wb[0], bf_hi(u1.x) * wb[1]); kw.w = cvt_pk_bf16(bf_lo(u1.y) * wb[2], bf_hi(u1.y) * wb[3]);
                    cacc[db] = __builtin_amdgcn_mfma_f32_32x32x16_bf16(af, __builtin_bit_cast(bf16x8, kw), cacc[db], 0, 0, 0); }
                __builtin_amdgcn_sched_barrier(0);
            }
            { const int d = tid & 127, sq = tid >> 7; float sN = 0.f;
#pragma unroll 4
                for (int s2 = 0; s2 < 16; ++s2) { const int srow = 16 * sq + s2; const unsigned short hv = *(const LAS unsigned short*)(Kt + off_b(srow, d >> 3) + (d & 7) * 2); sN += __uint_as_float((unsigned)hv << 16) * wsc[64 * j + srow]; }
                nrun += sN; }
            WAIT_ALL_BAR();
        }
        int tid2 = tid_; asm volatile("" : "+v"(tid2));
        const int qloc2 = 32 * wave + (tid2 & 31), hi2 = (tid2 >> 5) & 1;
        const float BAq = SBA[qloc2];
        den += __shfl_xor(den, 32);
        const float dinv = 1.0f / fmaxf(fabsf(den), __expf(-BAq));
        float sm = 0.f;
#pragma unroll
        for (int cb = 0; cb < 4; ++cb)
#pragma unroll
            for (int r = 0; r < 16; ++r) { o[cb][r] *= dinv; sm += o[cb][r]; }
        sm += __shfl_xor(sm, 32);
        const float mu = sm * (1.0f / 128.0f);
        float vs = 0.f;
#pragma unroll
        for (int cb = 0; cb < 4; ++cb)
#pragma unroll
            for (int r = 0; r < 16; ++r) { o[cb][r] -= mu; vs += o[cb][r] * o[cb][r]; }
        vs += __shfl_xor(vs, 32);
        const float rstd = 1.0f / sqrtf(vs * (1.0f / 128.0f) + NORM_EPS);
        const bf16_t* mo = P + (t0 + qloc2) * NP + P_MO + hd * 128 + 4 * hi2;
        bf16_t* orow = CAT + (t0 + qloc2) * D + hd * 128 + 4 * hi2;
#pragma unroll
        for (int c2 = 0; c2 < 2; ++c2) {
            u32x2 mw[8];
#pragma unroll
            for (int u = 0; u < 8; ++u) mw[u] = *(const u32x2*)(mo + 32 * (2 * c2 + (u >> 2)) + 8 * (u & 3));
#pragma unroll
            for (int u = 0; u < 8; ++u) { const int cb = 2 * c2 + (u >> 2), rq = u & 3; const int e0 = 32 * cb + 8 * rq; const u32x2 m2 = mw[u]; const f32x4 hv = *(const LAS f32x4*)(hnl + e0 + 4 * hi2);
                const float g0 = fast_rcp(1.0f + fast_exp2(-1.4426950408889634f * bf_lo(m2.x))), g1 = fast_rcp(1.0f + fast_exp2(-1.4426950408889634f * bf_hi(m2.x))), g2 = fast_rcp(1.0f + fast_exp2(-1.4426950408889634f * bf_lo(m2.y))), g3 = fast_rcp(1.0f + fast_exp2(-1.4426950408889634f * bf_hi(m2.y)));
                u32x2 w; w.x = cvt_pk_bf16(o[cb][4 * rq] * rstd * hv[0] * g0, o[cb][4 * rq + 1] * rstd * hv[1] * g1); w.y = cvt_pk_bf16(o[cb][4 * rq + 2] * rstd * hv[2] * g2, o[cb][4 * rq + 3] * rstd * hv[3] * g3);
                *(u32x2*)(orow + e0) = w; }
            __builtin_amdgcn_sched_barrier(0); }
        if (c + 1 < NCH) {
#pragma unroll
            for (int db = 0; db < 2; ++db)
#pragma unroll
                for (int r = 0; r < 16; ++r) { const int e = 32 * eb + crow(r, hi), d = 64 * dh + 32 * db + r32;
                    *(LAS unsigned short*)(Ct + off_b(e, d >> 3) + (d & 7) * 2) = (unsigned short)(cvt_pk_bf16(cacc[db][r], 0.f) & 0xffffu); }
            wsc[tid] = nrun;
        }
        Prun = Pnew;
        WAIT_ALL_BAR();
        if (c + 1 < NCH) { if (tid < 128) nC[tid] = (wsc[tid] + wsc[tid + 128]) + (wsc[tid + 256] + wsc[tid + 384]); }
    }
#undef QFRAG
}

__device__ __forceinline__ int moe_table(LAS unsigned char* lds, unsigned* cnt, int tid) {
    LAS int* misc = (LAS int*)(lds + MISC_OFF);
    __syncthreads();
    if (tid == 0) { int acc = 0; for (int e = 0; e < 16; ++e) { const int c = (int)__hip_atomic_load(cnt + e * 64, __ATOMIC_RELAXED, __HIP_MEMORY_SCOPE_AGENT); misc[MW_CN + e] = c; misc[MW_TB + e] = acc; acc += (c + 255) >> 8; } misc[MW_TB + 16] = acc; }
    __syncthreads();
    return misc[MW_TB + 16];
}

#ifndef STAGGER_MASK
#define STAGGER_MASK 0u
#endif
#ifndef STAGGER_GROUPS
#define STAGGER_GROUPS 4
#endif
#ifndef STAGGER_TICKS
#define STAGGER_TICKS 700
#endif
__device__ __forceinline__ void stagger(int vcu, int phase_bit) {
    if (!((STAGGER_MASK >> phase_bit) & 1u)) return;
    const int g = vcu & (STAGGER_GROUPS - 1); if (g == 0) return;
    const unsigned long long t0 = __builtin_amdgcn_s_memrealtime(); const unsigned long long w = (unsigned long long)g * STAGGER_TICKS;
    while (__builtin_amdgcn_s_memrealtime() - t0 < w) __builtin_amdgcn_s_sleep(8);
}
constexpr int LATE_UNITS = 224, LATE_UNITS_A = 160, LATE_UNITS_B = 64, CW_LATEQ = CW_QUEUE + 64 * 8;
template <int QID>
__device__ __forceinline__ void late_convert(const Params& p, LAS unsigned char* lds, unsigned* ctl, int quota, int tid, int wave, int lane) {
    volatile LAS unsigned* misc = (volatile LAS unsigned*)(lds + MISC_OFF);
    for (int k = 0; k < quota; ++k) {
        __syncthreads();
        if (tid == 0) misc[MW_Q] = __hip_atomic_fetch_add(ctl + CW_LATEQ + 64 * QID, 1u, __ATOMIC_RELAXED, __HIP_MEMORY_SCOPE_AGENT);
        __syncthreads();
        const int q = (int)misc[MW_Q];
        if (q >= 4 * (QID == 0 ? LATE_UNITS_A : LATE_UNITS_B)) break;
        const int c = q >> 2, sub = q & 3;
        const int v = QID == 0 ? (c < 32 ? 8 + c : 232 + 12 * ((c - 32) >> 3) + ((c - 32) & 7)) : 232 + 12 * (c >> 2) + 8 + (c & 3);
        const int f = WT_I1 + 64 * v + 16 * sub + 2 * wave;
        phase_prologue_weights(p, lds, f, f + 2, 1, wave, lane);
    }
    __syncthreads();
}
template <int LAYER>
__device__ __forceinline__ void moe_block(const Params& p, LAS unsigned char* lds, const XcdBarrier& bar, unsigned* ctl, int tid, int wave, int lane, int vcu, int G) {
    unsigned char* ws = p.ws;
    const LAS int* tb = (const LAS int*)(lds + MISC_OFF) + MW_TB; const LAS int* cn = (const LAS int*)(lds + MISC_OFF) + MW_CN;
    unsigned* cnt = ctl + CW_CNT + LAYER * 16 * 64;
    if (PH(12)) phase_router(p, lds, tid, wave, G, p.in[3] + LAYER * D, p.in[18] + (size_t)LAYER * D * 4, p.in[19] + LAYER * 4, p.in[20] + (size_t)LAYER * D * 16, p.in[21] + LAYER * 16, cnt);
    xcd_barrier(bar);
    const int ntot = moe_table(lds, cnt, tid);
    stagger(vcu, 13);
    for (int rep_ = 0; rep_ < REPS(13); ++rep_) if (PH(13)) { pg8::MoeSched<true> S{(const char*)(ws + WS_XB8), (const char*)(ws + WS_WGU) + (size_t)LAYER * 16 * 1024 * 1024, 512, (size_t)1024 * 1024, tb, cn, (const unsigned*)(ws + WS_ROWTOK), ntot, vcu, G};
      pg8::EpiPair<1> E{nullptr, (bf16_t*)(ws + WS_HM), FF, (const float*)(ws + WS_RSRAW), (const unsigned*)(ws + WS_ROWTOK), tb, cn};
      pg8::gemm_phase<pg8::EpiPair<1>, pg8::MoeSched<true>, true, true>(lds, 512, S, E); }
    const int nun = ntot * 4, rounds_max = (nun + G - 1) / G, rounds_mine = nun > vcu ? (nun - vcu + G - 1) / G : 0;
    if (LATE_CV && LAYER == 0 && PH(0)) late_convert<0>(p, lds, ctl, 2 * (rounds_max - rounds_mine), tid, wave, lane);
    if (LATE_CV && LAYER == 1 && PH(0)) { late_convert<1>(p, lds, ctl, 2 * (rounds_max - rounds_mine), tid, wave, lane); late_convert<1>(p, lds, ctl, 1 << 20, tid, wave, lane); }
    xcd_barrier(bar);
    stagger(vcu, 14);
    for (int rep_ = 0; rep_ < REPS(14); ++rep_) if (PH(14)) { pg8::MoeSched<false> S{(const char*)(ws + WS_HM), (const char*)(ws + WS_WD) + (size_t)LAYER * 16 * 1024 * 512, 256, (size_t)1024 * 512, tb, cn, nullptr, ntot, vcu, G};
      pg8::EpiDown E{(unsigned char*)(ws + WS_YC), (const float*)(ws + WS_CWRAW), tb, cn};
      pg8::gemm_phase<pg8::EpiDown, pg8::MoeSched<false>, false, true>(lds, 256, S, E); }
    if (LATE_CV && LAYER == 0 && PH(0)) { late_convert<0>(p, lds, ctl, rounds_max - rounds_mine, tid, wave, lane); late_convert<0>(p, lds, ctl, 1 << 20, tid, wave, lane); }
    xcd_barrier(bar);
}

__global__ void __launch_bounds__(NTHR, 2) fwd_kernel(Params p) {
    extern __shared__ __attribute__((aligned(16))) unsigned char lds_raw[];
    LAS unsigned char* lds = (LAS unsigned char*)lds_raw;
    const int tid = threadIdx.x, lane = tid & 63, wave = __builtin_amdgcn_readfirstlane(tid >> 6);
    const int G = gridDim.x; const int bx = blockIdx.x;
    const int vcu = (G % 8 == 0) ? (bx % 8) * (G / 8) + bx / 8 : bx;
    const int gw = vcu * NWAVES + wave, NGW = G * NWAVES;
    volatile LAS unsigned* misc = (volatile LAS unsigned*)(lds + MISC_OFF);
    for (int u = tid; u < (LDS_BYTES - MISC_OFF) / 4; u += NTHR) misc[u] = 0u;
    __syncthreads();
    unsigned* ctl = (unsigned*)(p.ws + WS_CTL);
    XcdBarrier bar = xcd_barrier_post(ctl + CW_BAR, misc + MW_BAR);
    unsigned char* ws = p.ws;

    for (int rep_ = 0; rep_ < REPS(0); ++rep_) if (PH(0)) phase_prologue_weights(p, lds, gw, WT_I1, NGW, wave, lane);
    __syncthreads();
    for (int rep_ = 0; rep_ < REPS(1); ++rep_) if (PH(1)) phase_norm_gates(p, lds, tid, gw, NGW, lane);
    xcd_barrier(bar);

    if (PH(2)) phase_gate_scan(p, gw, NGW, lane);
    stagger(vcu, 3);
    for (int rep_ = 0; rep_ < REPS(3); ++rep_) if (PH(3)) { pg8::DenseSched S; S.init(ws + WS_H, ws + WS_WT1, T, NP, 1024, G, bx); pg8::EpiBf16 E{(bf16_t*)(ws + WS_P), NP};
      pg8::gemm_phase<pg8::EpiBf16, pg8::DenseSched, false>(lds, 1024, S, E); }
    xcd_barrier(bar);

    {
        constexpr int NSEQ = NBATCH * 4, NAT = NBATCH * 4 * 16, NMEM = LATE_CV ? WT_UNITS - LATE_UNITS : WT_UNITS;
        for (int u = bx; u < NSEQ; u += G) { for (int r2 = 0; r2 < REPS(16); ++r2) if (PH(4)) mlstm_seq_unit(p, lds, u, tid, wave, lane); }
        for (int rep_ = 0; rep_ < REPS(4); ++rep_) {
            bool a_done = false, m_done = false; int sa_cnt = 0, sm_cnt = 0; (void)sa_cnt; (void)sm_cnt;
            for (int it = 0; !(a_done && m_done); ++it) {
                const int r5 = it % 5; bool want_mem = (r5 == 1 || r5 == 3);
                if (want_mem && m_done) want_mem = false; else if (!want_mem && a_done) want_mem = true;
                __syncthreads();
#ifdef STATIC_Q
                if (tid == 0) { misc[MW_Q] = (unsigned)((want_mem ? sm_cnt : sa_cnt) * G + bx); }
                if (want_mem) ++sm_cnt; else ++sa_cnt;
#else
                if (tid == 0) misc[MW_Q] = __hip_atomic_fetch_add(ctl + CW_QUEUE + 64 * (2 * rep_ + (want_mem ? 1 : 0)), 1u, __ATOMIC_RELAXED, __HIP_MEMORY_SCOPE_AGENT);
#endif
                __syncthreads();
                const int u = (int)misc[MW_Q];
                if (want_mem) {
                    if (u >= NMEM) { m_done = true; continue; }
                    { const int v = LATE_CV ? (u < 8 ? u : u + 32) : u;        for (int r2 = 0; r2 < REPS(18); ++r2) if (PH(0)) { const int f = WT_I1 + 64 * v + 8 * wave; phase_prologue_weights(p, lds, f, f + 8, 1, wave, lane); } }
                } else {
                    if (u >= NAT) { a_done = true; continue; }
                    for (int r2 = 0; r2 < REPS(17); ++r2) if (PH(5)) attn_unit(p, lds, u & 127, 15 - (u >> 7), tid, wave, lane);
                }
            }
        }
    }
    xcd_barrier(bar);

    for (int rep_ = 0; rep_ < REPS(7); ++rep_) if (PH(7)) { pg8::DenseSched S; S.init(ws + WS_CAT, ws + WS_WT2, T, 1024, 1024, G, bx); pg8::EpiResid<true> E{p.in[0], (bf16_t*)(ws + WS_XB), ws + WS_XB8};
      pg8::gemm_phase<pg8::EpiResid<true>, pg8::DenseSched, false>(lds, 1024, S, E); }
    xcd_barrier(bar);

    moe_block<0>(p, lds, bar, ctl, tid, wave, lane, vcu, G);
    if (PH(8)) phase_rows<0, true>(p, lds, tid, wave, lane, G, p.in[2] + D, nullptr, nullptr, nullptr, nullptr, ctl + CW_CNT, nullptr);
    xcd_barrier(bar);
    stagger(vcu, 9);
    for (int rep_ = 0; rep_ < REPS(9); ++rep_) if (PH(9)) { pg8::DenseSched S; S.init(G3_F8 ? ws + WS_XB8 : ws + WS_XB, ws + WS_WT3, T, 3072, G3_F8 ? 512 : 1024, G, bx); pg8::EpiPair<0> E{(bf16_t*)(ws + WS_BG), (bf16_t*)(ws + WS_Z), D, (const float*)(ws + WS_RSTD), nullptr, nullptr, nullptr};
      pg8::gemm_phase<pg8::EpiPair<0>, pg8::DenseSched, false, G3_F8 != 0>(lds, G3_F8 ? 512 : 1024, S, E); }
    xcd_barrier(bar);
    for (int rep_ = 0; rep_ < REPS(10); ++rep_) if (PH(10)) phase_conv(p, gw, NGW, lane);
    xcd_barrier(bar);
    if (PH(11)) { pg8::DenseSched S; S.init(ws + WS_CAT, ws + WS_WT4, T, 1024, 1024, G, bx); pg8::EpiResid<false> E{nullptr, (bf16_t*)(ws + WS_XB), ws + WS_XB8};
      pg8::gemm_phase<pg8::EpiResid<false>, pg8::DenseSched, false>(lds, 1024, S, E); }
    xcd_barrier(bar);
    moe_block<1>(p, lds, bar, ctl, tid, wave, lane, vcu, G);
    if (PH(15)) phase_rows<2, true>(p, lds, tid, wave, lane, G, p.in[4], nullptr, nullptr, nullptr, nullptr, ctl + CW_CNT + 16 * 64, nullptr);
}

extern "C" void kernel_launch(void* const* d_in, const int* in_sizes, int n_in, void* d_out, int out_size, void* d_ws, size_t ws_size, hipStream_t stream) {
    static int grid = 0;
    if (grid == 0) {
        if (n_in != 25 || in_sizes[0] != T * D || out_size != T * D || ws_size < WS_END) { fprintf(stderr, "kernel_launch: unexpected shapes (n_in %d, in0 %d, out %d, ws %zu)\n", n_in, n_in > 0 ? in_sizes[0] : -1, out_size, ws_size); grid = -1; return; }
        int dev = 0, cus = 0, per_cu = 0;
        if (hipGetDevice(&dev) != hipSuccess || hipDeviceGetAttribute(&cus, hipDeviceAttributeMultiprocessorCount, dev) != hipSuccess) { grid = -1; return; }
        if (hipFuncSetAttribute((const void*)fwd_kernel, hipFuncAttributeMaxDynamicSharedMemorySize, LDS_BYTES) != hipSuccess) { fprintf(stderr, "kernel_launch: hipFuncSetAttribute failed\n"); grid = -1; return; }
        if (hipOccupancyMaxActiveBlocksPerMultiprocessor(&per_cu, (const void*)fwd_kernel, NTHR, LDS_BYTES) != hipSuccess || per_cu < 1) fprintf(stderr, "kernel_launch: occupancy query reports %d\n", per_cu);
        (void)hipGetLastError();
        grid = cus;
    }
    if (grid < 0) return;
    hipMemsetAsync((char*)d_ws + WS_CTL, 0, CTL_ZERO_BYTES, stream);
    Params p{};
    for (int i = 0; i < 25; ++i) p.in[i] = (const float*)d_in[i];
    p.out = (float*)d_out; p.ws = (unsigned char*)d_ws;
    hipLaunchKernelGGL(fwd_kernel, dim3(grid), dim3(NTHR), LDS_BYTES, stream, p);
}
```

```cpp
#include <hip/hip_runtime.h>
#include <cstdio>
#include <cstdint>
#ifndef PHASE_MASK
#define PHASE_MASK 0xffffffffu
#endif
#define PH(k) (((PHASE_MASK) >> (k)) & 1u)
#ifndef PHASE_TWICE
#define PHASE_TWICE 0u
#endif
#define REPS(k) (1 + (int)(((PHASE_TWICE) >> (k)) & 1u))

#define LAS __attribute__((address_space(3)))
#define GAS __attribute__((address_space(1)))
typedef unsigned short bf16_t;
typedef short bf16x8 __attribute__((ext_vector_type(8)));
typedef short s16x4 __attribute__((ext_vector_type(4)));
typedef float f32x4 __attribute__((ext_vector_type(4)));
typedef float f32x2 __attribute__((ext_vector_type(2)));
typedef float f32x16 __attribute__((ext_vector_type(16)));
typedef unsigned u32x4 __attribute__((ext_vector_type(4)));
typedef unsigned u32x2 __attribute__((ext_vector_type(2)));
typedef GAS unsigned gu32;
typedef int i32x8 __attribute__((ext_vector_type(8)));
typedef int i32x4 __attribute__((ext_vector_type(4)));

constexpr int D = 1024, NBATCH = 32, SEQ = 2048, T = NBATCH * SEQ;
constexpr int EVEN_IN = 3592, NP = 3584;
constexpr int P_MQ = 0, P_MK = 512, P_MV = 1024, P_MO = 1536, P_DQ = 2048, P_DK = 2560, P_DV = 3072;
constexpr int NE = 16, FF = 512;
constexpr int ECAP = 65536;
constexpr float NORM_EPS = 1e-6f;
constexpr int NWAVES = 8, NTHR = 512;
constexpr int MCH = 256, NCH = SEQ / MCH;
constexpr int WT_I1 = 16 * 112, WT_ITEMS = 28928, WT_UNITS = (WT_ITEMS - WT_I1) / 64;

constexpr size_t MiB = 1u << 20;
constexpr size_t WS_CTL = 0, CTL_ZERO_BYTES = 1 * MiB;
constexpr size_t WS_WT1 = 1 * MiB, WS_WT2 = 8 * MiB, WS_WT3 = 10 * MiB, WS_WT4 = 16 * MiB, WS_WGU = 18 * MiB, WS_WD = 82 * MiB;
constexpr size_t WS_GATES = 114 * MiB, WS_SA = 116 * MiB, WS_SAM = 117 * MiB, WS_SBA = 118 * MiB, WS_UN = 119 * MiB, WS_UR = 119 * MiB + 768 * 1024;
constexpr size_t WS_UT = 120 * MiB;
constexpr size_t WS_ROWTOK = 184 * MiB, WS_CWRAW = 188 * MiB, WS_TOKINFO = 192 * MiB, WS_RSTD = 193 * MiB;
constexpr size_t WS_H = 194 * MiB, WS_CAT = 322 * MiB, WS_P = 450 * MiB;
constexpr size_t WS_RSRAW = 120 * MiB;
constexpr size_t WS_XB8 = 720 * MiB;
constexpr size_t WS_XB = WS_H;
constexpr size_t WS_BG = WS_P, WS_Z = WS_P + 128 * MiB, WS_HM = WS_P, WS_YC = WS_P + 136 * MiB;
constexpr size_t WS_END = 898 * MiB;
constexpr int CW_BAR = 4096;
constexpr int CW_CNT = 16384;
constexpr int CW_QUEUE = 32768;

__device__ __forceinline__ unsigned cvt_pk_bf16(float lo, float hi) { unsigned r; asm volatile("v_cvt_pk_bf16_f32 %0, %1, %2" : "=v"(r) : "v"(lo), "v"(hi)); return r; }
__device__ __forceinline__ unsigned cvt_pk4_fp8(float a, float b, float c, float d) { unsigned w = 0; w = (unsigned)__builtin_amdgcn_cvt_pk_fp8_f32(a, b, (int)w, false); w = (unsigned)__builtin_amdgcn_cvt_pk_fp8_f32(c, d, (int)w, true); return w; }
#ifndef LATE_CV
#define LATE_CV 1
#endif
#ifndef G3_F8
#define G3_F8 1
#endif
constexpr float F8_WSCALE = 64.0f, F8_HSCALE = 16.0f, F8_YSCALE = 64.0f;
__device__ __forceinline__ float bf_lo(unsigned w) { return __uint_as_float(w << 16); }
__device__ __forceinline__ float bf_hi(unsigned w) { return __uint_as_float(w & 0xffff0000u); }
__device__ __forceinline__ float wave_sum(float v) {
#pragma unroll
    for (int o = 1; o < 64; o <<= 1) v += __shfl_xor(v, o);
    return v;
}
__device__ __forceinline__ float fast_exp2(float x) { return __builtin_amdgcn_exp2f(x); }
__device__ __forceinline__ float fast_rcp(float x) { return __builtin_amdgcn_rcpf(x); }
__device__ __forceinline__ int crow(int r, int hi) { return (r & 3) + 8 * (r >> 2) + 4 * hi; }
__device__ __forceinline__ unsigned off_b(unsigned row, unsigned ch) { return 256u * row + 16u * (ch ^ (((row & 3u) << 2) | ((row >> 2) & 3u))); }
__device__ __forceinline__ s16x4 vtr(const LAS unsigned char* p) { return __builtin_bit_cast(s16x4, __builtin_amdgcn_ds_read_tr16_b64_v4i16((LAS s16x4*)p)); }
__device__ __forceinline__ bf16x8 cat8(s16x4 a, s16x4 b) { return (bf16x8){a[0], a[1], a[2], a[3], b[0], b[1], b[2], b[3]}; }

#define XB_TMO      128
#define XB_XCNT(j)  (256  + 64 * (j))
#define XB_XSUB(j)  (1280 + 64 * (j))
#define XB_XGEN(j)  (2304 + 64 * (j))
#define XB_TOP      3328
#define XB_TOPGEN   3392
#define XCD_BAR_WORDS 3456
#define XB_SPIN_CAP (1u << 18)
__device__ __forceinline__ unsigned xb_ld(unsigned* p)              { return __hip_atomic_load(p, __ATOMIC_RELAXED, __HIP_MEMORY_SCOPE_AGENT); }
__device__ __forceinline__ unsigned xb_add(unsigned* p, unsigned v) { return __hip_atomic_fetch_add(p, v, __ATOMIC_RELAXED, __HIP_MEMORY_SCOPE_AGENT); }
__device__ __forceinline__ unsigned xb_xcc_id() { return (unsigned)__builtin_amdgcn_s_getreg((3 << 11) | 20) & 0xFu; }
#define XB_SPIN(cond, bar) do { unsigned _sp = 0; while (cond) { __builtin_amdgcn_s_sleep(1); \
    if ((++_sp & 255u) == 0u) { if (xb_ld(&(bar)[XB_TMO])) break; if (_sp > XB_SPIN_CAP) { atomicAdd(&(bar)[XB_TMO], 1u); break; } } } } while (0)
struct XcdBarrier { unsigned* bar; unsigned x; volatile LAS unsigned* st; };
__device__ __forceinline__ XcdBarrier xcd_barrier_post(unsigned* bar, volatile LAS unsigned* st) {
    XcdBarrier b; b.bar = bar; b.x = xb_xcc_id(); b.st = st;
    if (threadIdx.x == 0) (void)xb_add(&bar[XB_XCNT(b.x)], 1u);
    return b;
}
__device__ __forceinline__ void xcd_barrier_complete(unsigned* bar, unsigned x, unsigned& nloc, unsigned& nx) {
    const unsigned G = gridDim.x * gridDim.y * gridDim.z;
    unsigned sum, cnt, mine, sp = 0u;
    for (;;) {
        sum = 0u; cnt = 0u; mine = 0u;
#pragma unroll
        for (unsigned j = 0; j < 16; ++j) { const unsigned c = xb_ld(&bar[XB_XCNT(j)]); sum += c; cnt += (c > 0u) ? 1u : 0u; mine = (j == x) ? c : mine; }
        if (sum == G) break;
        __builtin_amdgcn_s_sleep(1);
        if ((++sp & 255u) == 0u) { if (xb_ld(&bar[XB_TMO])) break; if (sp > XB_SPIN_CAP) { atomicAdd(&bar[XB_TMO], 1u); break; } }
    }
    nloc = mine > 0u ? mine : 1u; nx = cnt > 0u ? cnt : 1u;
}
__device__ __forceinline__ void xcd_barrier(const XcdBarrier& b) {
    asm volatile("s_waitcnt vmcnt(0)" ::: "memory");
    __syncthreads();
    if (threadIdx.x == 0) {
        unsigned* bar = b.bar;
        __builtin_amdgcn_s_waitcnt(0);
        unsigned nloc = b.st[0], nx = b.st[1];
        if (nloc == 0u) { xcd_barrier_complete(bar, b.x, nloc, nx); b.st[0] = nloc; b.st[1] = nx; }
        const unsigned old = xb_add(&bar[XB_XSUB(b.x)], 1u);
        const unsigned gen = old / nloc;
        if (old + 1u == (gen + 1u) * nloc) {
            __builtin_amdgcn_fence(__ATOMIC_RELEASE, "agent");
            asm volatile("s_waitcnt vmcnt(0)" ::: "memory");
            const unsigned og = xb_add(&bar[XB_TOP], 1u);
            const unsigned tg = og / nx;
            if (og + 1u == (tg + 1u) * nx) xb_add(&bar[XB_TOPGEN], 1u);
            else XB_SPIN(xb_ld(&bar[XB_TOPGEN]) == tg, bar);
            __builtin_amdgcn_fence(__ATOMIC_ACQUIRE, "agent");
            xb_add(&bar[XB_XGEN(b.x)], 1u);
            asm volatile("s_waitcnt vmcnt(0)" ::: "memory");
        } else {
            XB_SPIN(xb_ld(&bar[XB_XGEN(b.x)]) == gen, bar);
            __builtin_amdgcn_fence(__ATOMIC_ACQUIRE, "agent");
            asm volatile("s_waitcnt vmcnt(0)" ::: "memory");
        }
    }
    __syncthreads();
}

namespace pg8 {
constexpr int BM = 256, BK = 64, HALF = 128, HTB = HALF * BK * 2, STAGE_BYTES = 8 * HTB, NXCD = 8, WGM = 8;
__device__ __forceinline__ int lds_byte(int r, int c) { const int st = (r >> 4) * 2 + (c >> 5), rr = r & 15, cc = c & 31, ob = rr * 64 + cc * 2; return st * 1024 + (ob ^ (((ob >> 9) & 1) << 5)); }
__device__ __forceinline__ void stage_rc(int b, int& R, int& C) { const int st = b / 1024, sb = b % 1024, swz = sb ^ (((sb >> 9) & 1) << 5); R = (st >> 1) * 16 + swz / 64; C = (st & 1) * 32 + (swz % 64) / 2; }
__device__ __forceinline__ int perm32(int rho) { const int n = rho >> 4, i = rho & 15; return 8 * (i >> 2) + 4 * n + (i & 3); }
struct Unit { int pm, pn; };

template <class Epi, class Sched, bool GATHER, bool F8 = false>
__device__ __forceinline__ void gemm_phase(LAS unsigned char* lds, const int K, const Sched& S, const Epi& E) {
    int tid = threadIdx.x; asm volatile("" : "+v"(tid));
    const int wid = __builtin_amdgcn_readfirstlane(tid >> 6), lane = tid & 63, wr = wid >> 2, wc = wid & 3, fr = lane & 15, fq = lane >> 4;
    const int nt = K / BK;
    int Rr[2], Cc[2]; unsigned voffB[2];
#pragma unroll
    for (int i = 0; i < 2; ++i) { stage_rc(tid * 16 + i * 8192, Rr[i], Cc[i]); const int Rb = Epi::PERM ? ((Rr[i] & ~31) + perm32(Rr[i] & 31)) : Rr[i];
        voffB[i] = (unsigned)(Rb * K + Cc[i]) * 2u; }
    const size_t kstep = (size_t)(BK * 2);
    const size_t hstep = (size_t)HALF * K * 2;
    const unsigned ldsw = (unsigned)wid * 1024u;
    const int aoff = lds_byte(wr * 64 + fr, fq * 8), boff = lds_byte(wc * 32 + fr, fq * 8);
#define PG8_SA(b, h) (((b) * 2 + (h)) * HTB)
#define PG8_SB(b, h) ((4 + (b) * 2 + (h)) * HTB)
#define PG8_STAGE(bufoff, gbase, voff) do { _Pragma("unroll") for (int _i = 0; _i < 2; ++_i) \
        __builtin_amdgcn_global_load_lds((const unsigned*)((const char*)(gbase) + (voff)[_i]), (LAS unsigned*)(lds + (bufoff) + ldsw + _i * 8192), 16, 0, 0); } while (0)
#define PG8_LD8(p) __builtin_shufflevector(*(const LAS i32x4*)(p), *(const LAS i32x4*)((p) + 1024), 0, 1, 2, 3, 4, 5, 6, 7)
#define PG8_LDA(dst, b, h) do { if constexpr (F8) { _Pragma("unroll") for (int m = 0; m < 4; ++m) dst##8[m] = PG8_LD8(lds + PG8_SA(b, h) + aoff + m * 2048); } \
        else { _Pragma("unroll") for (int m = 0; m < 4; ++m) _Pragma("unroll") for (int k = 0; k < 2; ++k) dst[m][k] = *(const LAS bf16x8*)(lds + PG8_SA(b, h) + aoff + m * 2048 + k * 1024); } } while (0)
#define PG8_LDB(dst, b, h) do { if constexpr (F8) { _Pragma("unroll") for (int n = 0; n < 2; ++n) dst##8[n] = PG8_LD8(lds + PG8_SB(b, h) + boff + n * 2048); } \
        else { _Pragma("unroll") for (int n = 0; n < 2; ++n) _Pragma("unroll") for (int k = 0; k < 2; ++k) dst[n][k] = *(const LAS bf16x8*)(lds + PG8_SB(b, h) + boff + n * 2048 + k * 1024); } } while (0)
#define PG8_CAT8(x0, x1) __builtin_shufflevector(__builtin_bit_cast(i32x4, x0), __builtin_bit_cast(i32x4, x1), 0, 1, 2, 3, 4, 5, 6, 7)
#define PG8_MMA(ai, bj, At, Bt) do { __builtin_amdgcn_s_setprio(1); _Pragma("unroll") for (int m = 0; m < 4; ++m) _Pragma("unroll") for (int n = 0; n < 2; ++n) { \
        if constexpr (F8) asm volatile("v_mfma_scale_f32_16x16x128_f8f6f4 %0, %1, %2, %0, %3, %3 op_sel_hi:[0,0,0]" : "+v"(acc[ai][bj][m][n]) : "v"(Bt##8[n]), "v"(At##8[m]), "v"(f8one)); \
        else { _Pragma("unroll") for (int k = 0; k < 2; ++k) acc[ai][bj][m][n] = __builtin_amdgcn_mfma_f32_16x16x32_bf16(Bt[n][k], At[m][k], acc[ai][bj][m][n], 0, 0, 0); } } __builtin_amdgcn_s_setprio(0); } while (0)
#define PG8_WAIT_V(n) asm volatile("s_waitcnt vmcnt(" #n ")" ::: "memory")
#define PG8_WAIT_L(n) asm volatile("s_waitcnt lgkmcnt(" #n ")" ::: "memory")
#define PG8_BAR __builtin_amdgcn_s_barrier()
#define PG8_SCHED __builtin_amdgcn_sched_barrier(0)
#define PG8_VOFF(dst, u) do { _Pragma("unroll") for (int _h = 0; _h < 2; ++_h) _Pragma("unroll") for (int _i = 0; _i < 2; ++_i) { \
        if constexpr (GATHER) dst[_h][_i] = S.arow(u, _h * HALF + Rr[_i]) * (unsigned)(K * 2) + (unsigned)(Cc[_i] * 2); \
        else dst[_h][_i] = (unsigned)((_h * HALF + Rr[_i]) * K + Cc[_i]) * 2u; } } while (0)
    Unit cur, nxt; int ui = 0;
    if (!S.next(0, cur)) return;
    f32x4 acc[2][2][4][2];
    if constexpr (Epi::PRELOAD) E.preload(acc, cur, wr, wc, fr, fq);
    else {
#pragma unroll
    for (int a = 0; a < 2; ++a)
#pragma unroll
        for (int b = 0; b < 2; ++b)
#pragma unroll
            for (int m = 0; m < 4; ++m)
#pragma unroll
                for (int n = 0; n < 2; ++n) acc[a][b][m][n] = (f32x4){0.f, 0.f, 0.f, 0.f};
    }
    float epf[2][4] = {{0.f, 0.f, 0.f, 0.f}, {0.f, 0.f, 0.f, 0.f}};
    bf16x8 At[4][2], B0[2][2], B1[2][2];
    i32x8 At8[4], B08[2], B18[2]; const unsigned f8one = 0x7f7f7f7fu;
    unsigned vA[2][2], vN[2][2];
    PG8_VOFF(vA, cur);
    if constexpr (Epi::PREFETCH) E.prefetch(epf, cur, wr, fr);
    const char* cA = S.abase(cur); const char* cB = S.bbase(cur);
    PG8_STAGE(PG8_SB(0, 0), cB, voffB); PG8_STAGE(PG8_SB(0, 1), cB + hstep, voffB); PG8_STAGE(PG8_SA(0, 0), cA, vA[0]); PG8_STAGE(PG8_SA(0, 1), cA, vA[1]);
    if (wr == 1) PG8_BAR;
    PG8_WAIT_V(2); PG8_BAR;
    PG8_STAGE(PG8_SB(1, 0), cB + kstep, voffB); PG8_STAGE(PG8_SA(1, 0), cA + kstep, vA[0]); PG8_STAGE(PG8_SB(1, 1), cB + hstep + kstep, voffB);
    PG8_WAIT_V(6); PG8_BAR;
    for (;;) {
        const bool has_next = S.next(ui + 1, nxt);
        const char* nA = has_next ? S.abase(nxt) : cA; const char* nB = has_next ? S.bbase(nxt) : cB;
        if constexpr (GATHER) { if (has_next) { PG8_VOFF(vN, nxt); } else {
#pragma unroll
            for (int h = 0; h < 2; ++h)
#pragma unroll
                for (int i = 0; i < 2; ++i) vN[h][i] = vA[h][i]; } }
#pragma unroll 1
        for (int t = 0; t < nt; t += 2) {
            const bool last = (t == nt - 2);
            const char* a1 = cA + (size_t)(t + 1) * kstep;
            const char* a2 = last ? nA : cA + (size_t)(t + 2) * kstep; const char* b2 = last ? nB : cB + (size_t)(t + 2) * kstep;
            const char* a3 = a2 + kstep; const char* b3 = b2 + kstep;
            unsigned v2[2][2]; const unsigned lmask = last ? 0xffffffffu : 0u;
#pragma unroll
            for (int h = 0; h < 2; ++h)
#pragma unroll
                for (int i = 0; i < 2; ++i) { if constexpr (GATHER) v2[h][i] = (vN[h][i] & lmask) | (vA[h][i] & ~lmask); else v2[h][i] = vA[h][i]; }
            PG8_LDB(B0, 0, 0); PG8_LDB(B1, 0, 1); PG8_SCHED; PG8_LDA(At, 0, 0); PG8_STAGE(PG8_SA(1, 1), a1, vA[1]);
            PG8_WAIT_V(8); PG8_WAIT_L(0); PG8_BAR; PG8_MMA(0, 0, At, B0); PG8_MMA(0, 1, At, B1); PG8_BAR; PG8_SCHED;
            PG8_LDA(At, 0, 1); PG8_STAGE(PG8_SB(0, 0), b2, voffB); PG8_STAGE(PG8_SB(0, 1), b2 + hstep, voffB); PG8_STAGE(PG8_SA(0, 0), a2, v2[0]);
            PG8_WAIT_V(8); PG8_WAIT_L(0); PG8_BAR; PG8_MMA(1, 0, At, B0); PG8_MMA(1, 1, At, B1); PG8_BAR; PG8_SCHED;
            PG8_LDB(B0, 1, 0); PG8_LDB(B1, 1, 1); PG8_SCHED; PG8_LDA(At, 1, 0); PG8_STAGE(PG8_SA(0, 1), a2, v2[1]);
            PG8_WAIT_V(8); PG8_WAIT_L(0); PG8_BAR; PG8_MMA(0, 0, At, B0); PG8_MMA(0, 1, At, B1); PG8_BAR; PG8_SCHED;
            PG8_LDA(At, 1, 1); PG8_STAGE(PG8_SB(1, 0), b3, voffB); PG8_STAGE(PG8_SB(1, 1), b3 + hstep, voffB); PG8_STAGE(PG8_SA(1, 0), a3, v2[0]);
            PG8_WAIT_V(8); PG8_WAIT_L(0); PG8_BAR; PG8_MMA(1, 0, At, B0); PG8_MMA(1, 1, At, B1); PG8_BAR; PG8_SCHED;
        }
        if (wr == 0) PG8_BAR;
        if constexpr (F8) asm volatile("s_nop 15\n\ts_nop 15" ::: "memory");
        if constexpr (Epi::PREFETCH) E(acc, cur, wr, wc, fr, fq, epf); else E(acc, cur, wr, wc, fr, fq);
        if (!has_next) break;
        if constexpr (Epi::PREFETCH) E.prefetch(epf, nxt, wr, fr);
        if constexpr (Epi::PRELOAD) E.preload(acc, nxt, wr, wc, fr, fq);
        else {
#pragma unroll
        for (int a = 0; a < 2; ++a)
#pragma unroll
            for (int b = 0; b < 2; ++b)
#pragma unroll
                for (int m = 0; m < 4; ++m)
#pragma unroll
                    for (int n = 0; n < 2; ++n) acc[a][b][m][n] = (f32x4){0.f, 0.f, 0.f, 0.f};
        }
        cur = nxt; cA = nA; cB = nB; ++ui;
        if constexpr (GATHER) {
#pragma unroll
        for (int h = 0; h < 2; ++h)
#pragma unroll
            for (int i = 0; i < 2; ++i) vA[h][i] = vN[h][i]; }
        if (wr == 1) PG8_BAR;
    }
    PG8_WAIT_V(0);
    PG8_BAR;
#undef PG8_SA
#undef PG8_SB
#undef PG8_STAGE
#undef PG8_LDA
#undef PG8_LD8
#undef PG8_LDB
#undef PG8_MMA
#undef PG8_CAT8
#undef PG8_WAIT_V
#undef PG8_WAIT_L
#undef PG8_BAR
#undef PG8_SCHED
#undef PG8_VOFF
}

struct DenseSched {
    const char* A; const char* Bt; int K; int nM, nN, nwg, G, c;
    __device__ __forceinline__ void init(const void* A_, const void* Bt_, int M, int N, int K_, int G_, int c_) { A = (const char*)A_; Bt = (const char*)Bt_; K = K_; nM = M / BM; nN = N / BM; nwg = nM * nN; G = G_; c = c_; }
    __device__ __forceinline__ bool next(int i, Unit& u) const {
        const long L = (long)i * G + c; if (L >= nwg) return false;
        int wgid = (int)L; { const int q = nwg / NXCD, r = nwg % NXCD, xcd = wgid % NXCD, off = wgid / NXCD; wgid = (xcd < r ? xcd * (q + 1) : r * (q + 1) + (xcd - r) * q) + off; }
        const int nig = WGM * nN, gid = wgid / nig, fm = gid * WGM, gsz = (nM - fm) < WGM ? (nM - fm) : WGM;
        u.pm = fm + ((wgid % nig) % gsz); u.pn = (wgid % nig) / gsz; return true;
    }
    __device__ __forceinline__ const char* abase(const Unit& u) const { return A + (size_t)u.pm * BM * K * 2; }
    __device__ __forceinline__ const char* bbase(const Unit& u) const { return Bt + (size_t)u.pn * BM * K * 2; }
    __device__ __forceinline__ unsigned arow(const Unit&, int) const { return 0u; }
};
template <bool GATHER_A>
struct MoeSched {
    const char* A; const char* W; int K; size_t wstride; const LAS int* tb; const LAS int* cn; const unsigned* rowtok; int ntot, vcu, G;
    __device__ __forceinline__ bool next(int i, Unit& u) const { const int L = i * G + vcu; if (L >= ntot * 4) return false; u.pm = L >> 2; u.pn = L & 3; return true; }
    __device__ __forceinline__ int expert(int pm) const { int e = 0;
#pragma unroll
        for (int j = 1; j < 16; ++j) e += (pm >= tb[j]) ? 1 : 0; return e; }
    __device__ __forceinline__ const char* abase(const Unit& u) const { return GATHER_A ? A : A + (size_t)u.pm * BM * K * 2; }
    __device__ __forceinline__ const char* bbase(const Unit& u) const { return W + (size_t)expert(u.pm) * wstride + (size_t)u.pn * BM * K * 2; }
    __device__ __forceinline__ unsigned arow(const Unit& u, int r) const { const int e = expert(u.pm); const int idx = (u.pm - tb[e]) * BM + r; return idx < cn[e] ? rowtok[(size_t)e * ECAP + idx] : 0u; }
};

__device__ __forceinline__ u32x4 widen16(u32x2 a, u32x2 b) {
    const auto rx = __builtin_amdgcn_permlane16_swap(a.x, b.x, false, false); const auto ry = __builtin_amdgcn_permlane16_swap(a.y, b.y, false, false);
    u32x4 o; o.x = rx[0]; o.y = ry[0]; o.z = rx[1]; o.w = ry[1]; return o; }
struct EpiBf16 {
    static constexpr bool PERM = true, PRELOAD = false, PREFETCH = false;
    bf16_t* O; int ldc;
    __device__ __forceinline__ void operator()(const f32x4 (&acc)[2][2][4][2], const Unit& u, int wr, int wc, int fr, int fq) const {
        const int row0 = u.pm * BM + wr * 64 + fr, col0 = u.pn * BM + wc * 32 + 8 * fq;
#pragma unroll
        for (int ai = 0; ai < 2; ++ai)
#pragma unroll
            for (int m = 0; m < 4; ++m) { bf16_t* rowp = O + (size_t)(row0 + ai * HALF + m * 16) * ldc + col0;
#pragma unroll
                for (int bj = 0; bj < 2; ++bj) { const f32x4 v0 = acc[ai][bj][m][0], v1 = acc[ai][bj][m][1];
                    u32x4 w; w.x = cvt_pk_bf16(v0[0], v0[1]); w.y = cvt_pk_bf16(v0[2], v0[3]); w.z = cvt_pk_bf16(v1[0], v1[1]); w.w = cvt_pk_bf16(v1[2], v1[3]);
#ifdef EPI_NT
                    __builtin_nontemporal_store(w, (u32x4*)(rowp + bj * HALF));
#else
                    *(u32x4*)(rowp + bj * HALF) = w;
#endif
                } }
    }
};
template <bool XF32>
struct EpiResid {
    static constexpr bool PERM = true, PRELOAD = true, PREFETCH = false;
    const float* xin; bf16_t* XB; unsigned char* XB8;
    __device__ __forceinline__ void preload(f32x4 (&acc)[2][2][4][2], const Unit& u, int wr, int wc, int fr, int fq) const {
        const int row0 = u.pm * BM + wr * 64 + fr, col0 = u.pn * BM + wc * 32 + 8 * fq;
#pragma unroll
        for (int ai = 0; ai < 2; ++ai)
#pragma unroll
            for (int m = 0; m < 4; ++m) { const size_t off = (size_t)(row0 + ai * HALF + m * 16) * D + col0;
#pragma unroll
                for (int bj = 0; bj < 2; ++bj) {
                    if (XF32) { acc[ai][bj][m][0] = *(const f32x4*)(xin + off + bj * HALF); acc[ai][bj][m][1] = *(const f32x4*)(xin + off + bj * HALF + 4); }
                    else { const u32x4 w = *(const u32x4*)(XB + off + bj * HALF); acc[ai][bj][m][0] = (f32x4){bf_lo(w.x), bf_hi(w.x), bf_lo(w.y), bf_hi(w.y)}; acc[ai][bj][m][1] = (f32x4){bf_lo(w.z), bf_hi(w.z), bf_lo(w.w), bf_hi(w.w)}; } } }
    }
    __device__ __forceinline__ void operator()(const f32x4 (&acc)[2][2][4][2], const Unit& u, int wr, int wc, int fr, int fq) const {
        const int row0 = u.pm * BM + wr * 64 + fr, col0 = u.pn * BM + wc * 32 + 8 * fq;
        const int colw = u.pn * BM + wc * 32 + 8 * (fq & ~1);
#pragma unroll
        for (int ai = 0; ai < 2; ++ai)
#pragma unroll
            for (int mp = 0; mp < 4; mp += 2)
#pragma unroll
                for (int bj = 0; bj < 2; ++bj) { u32x2 w8[2];
#pragma unroll
                    for (int h = 0; h < 2; ++h) { const int m = mp + h; bf16_t* rowp = XB + (size_t)(row0 + ai * HALF + m * 16) * D + col0;
                        const f32x4 v0 = acc[ai][bj][m][0], v1 = acc[ai][bj][m][1];
                        u32x4 w; w.x = cvt_pk_bf16(v0[0], v0[1]); w.y = cvt_pk_bf16(v0[2], v0[3]); w.z = cvt_pk_bf16(v1[0], v1[1]); w.w = cvt_pk_bf16(v1[2], v1[3]);
                        *(u32x4*)(rowp + bj * HALF) = w;
                        w8[h].x = cvt_pk4_fp8(bf_lo(w.x), bf_hi(w.x), bf_lo(w.y), bf_hi(w.y)); w8[h].y = cvt_pk4_fp8(bf_lo(w.z), bf_hi(w.z), bf_lo(w.w), bf_hi(w.w)); }
                    *(u32x4*)(XB8 + (size_t)(row0 + ai * HALF + (mp + (fq & 1)) * 16) * D + colw + bj * HALF) = widen16(w8[0], w8[1]); }
    }
};
template <int MODE  >
struct EpiPair {
    static constexpr bool PERM = true, PRELOAD = false, PREFETCH = true;
    bf16_t* O0; bf16_t* O1; int ld1;
    const float* rstd; const unsigned* rowtok; const LAS int* tb; const LAS int* cn;
    __device__ __forceinline__ void prefetch(float (&rs)[2][4], const Unit& u, int wr, int fr) const {
        const int row0 = u.pm * BM + wr * 64 + fr;
        if (MODE == 0) {
#pragma unroll
            for (int ai = 0; ai < 2; ++ai)
#pragma unroll
                for (int m = 0; m < 4; ++m) rs[ai][m] = rstd[row0 + ai * HALF + m * 16] * (G3_F8 ? 1.0f / F8_WSCALE : 1.0f);
        } else {
            int e = 0;
#pragma unroll
            for (int j = 1; j < 16; ++j) e += (u.pm >= tb[j]) ? 1 : 0;
            const int idx0 = (u.pm - tb[e]) * BM + wr * 64 + fr, cne = cn[e];
#pragma unroll
            for (int ai = 0; ai < 2; ++ai)
#pragma unroll
                for (int m = 0; m < 4; ++m) { const int idx = idx0 + ai * HALF + m * 16; rs[ai][m] = idx < cne ? rstd[(size_t)e * ECAP + idx] * (1.0f / F8_WSCALE) : 0.f; }
        }
    }
    __device__ __forceinline__ void operator()(const f32x4 (&acc)[2][2][4][2], const Unit& u, int wr, int wc, int fr, int fq, const float (&rs)[2][4]) const {
        const int row0 = u.pm * BM + wr * 64 + fr;
        if (MODE == 0 && u.pn < 4) {
            const int col0 = u.pn * BM + wc * 32 + 8 * fq;
#pragma unroll
            for (int ai = 0; ai < 2; ++ai)
#pragma unroll
                for (int m = 0; m < 4; ++m) { bf16_t* rowp = O0 + (size_t)(row0 + ai * HALF + m * 16) * D + col0;
#pragma unroll
                    for (int bj = 0; bj < 2; ++bj) { const f32x4 v0 = acc[ai][bj][m][0] * rs[ai][m], v1 = acc[ai][bj][m][1] * rs[ai][m];
                        u32x4 w; w.x = cvt_pk_bf16(v0[0], v0[1]); w.y = cvt_pk_bf16(v0[2], v0[3]); w.z = cvt_pk_bf16(v1[0], v1[1]); w.w = cvt_pk_bf16(v1[2], v1[3]);
                        *(u32x4*)(rowp + bj * HALF) = w; } }
        } else {
            const int pt = (MODE == 0) ? (u.pn - 4) : u.pn;
            const int col0 = pt * HALF + wc * 32 + 8 * fq;
#pragma unroll
            for (int ai = 0; ai < 2; ++ai) { u32x2 wkeep = {0u, 0u};
#pragma unroll
                for (int m = 0; m < 4; ++m) { bf16_t* rowp = O1 + (size_t)(row0 + ai * HALF + m * 16) * ld1 + col0;
                    f32x4 r[2];
#pragma unroll
                    for (int n = 0; n < 2; ++n) { const f32x4 g = acc[ai][0][m][n] * rs[ai][m], up = acc[ai][1][m][n] * rs[ai][m];
                        if (MODE == 0) r[n] = g * up;
                        else {
#pragma unroll
                            for (int j = 0; j < 4; ++j) r[n][j] = __builtin_amdgcn_fmed3f(g[j] * fast_rcp(1.0f + fast_exp2(-1.4426950408889634f * g[j])) * up[j] * F8_HSCALE, -448.0f, 448.0f); } }
                    if (MODE == 1) { u32x2 w; w.x = cvt_pk4_fp8(r[0][0], r[0][1], r[0][2], r[0][3]); w.y = cvt_pk4_fp8(r[1][0], r[1][1], r[1][2], r[1][3]);
                        if ((m & 1) == 0) wkeep = w;
                        else *(u32x4*)((unsigned char*)O1 + (size_t)(row0 + ai * HALF + (m - 1 + (fq & 1)) * 16) * ld1 + (pt * HALF + wc * 32 + 8 * (fq & ~1))) = widen16(wkeep, w); }
                    else { u32x4 w; w.x = cvt_pk_bf16(r[0][0], r[0][1]); w.y = cvt_pk_bf16(r[0][2], r[0][3]); w.z = cvt_pk_bf16(r[1][0], r[1][1]); w.w = cvt_pk_bf16(r[1][2], r[1][3]);
                        *(u32x4*)rowp = w; } } }
        }
    }
};
struct EpiDown {
    static constexpr bool PERM = true, PRELOAD = false, PREFETCH = true;
    unsigned char* O; const float* cwraw; const LAS int* tb; const LAS int* cn;
    __device__ __forceinline__ void prefetch(float (&cws)[2][4], const Unit& u, int wr, int fr) const {
        int e = 0;
#pragma unroll
        for (int j = 1; j < 16; ++j) e += (u.pm >= tb[j]) ? 1 : 0;
        const int idx0 = (u.pm - tb[e]) * BM + wr * 64 + fr, cne = cn[e];
#pragma unroll
        for (int ai = 0; ai < 2; ++ai)
#pragma unroll
            for (int m = 0; m < 4; ++m) { const int idx = idx0 + ai * HALF + m * 16; cws[ai][m] = idx < cne ? cwraw[(size_t)e * ECAP + idx] * (F8_YSCALE / (F8_WSCALE * F8_HSCALE)) : 0.f; }
    }
    __device__ __forceinline__ void operator()(const f32x4 (&acc)[2][2][4][2], const Unit& u, int wr, int wc, int fr, int fq, const float (&cws)[2][4]) const {
        const int row0 = u.pm * BM + wr * 64 + fr, col0 = u.pn * BM + wc * 32 + 8 * fq;
        const int colw = u.pn * BM + wc * 32 + 8 * (fq & ~1);
#pragma unroll
        for (int ai = 0; ai < 2; ++ai)
#pragma unroll
            for (int mp = 0; mp < 4; mp += 2) {
                unsigned char* rowp = O + (size_t)(row0 + ai * HALF + (mp + (fq & 1)) * 16) * D + colw;
#pragma unroll
                for (int bj = 0; bj < 2; ++bj) { u32x2 w[2];
#pragma unroll
                    for (int h = 0; h < 2; ++h) { const float cw = cws[ai][mp + h]; f32x4 v0 = acc[ai][bj][mp + h][0] * cw, v1 = acc[ai][bj][mp + h][1] * cw;
#pragma unroll
                        for (int j = 0; j < 4; ++j) { v0[j] = __builtin_amdgcn_fmed3f(v0[j], -448.0f, 448.0f); v1[j] = __builtin_amdgcn_fmed3f(v1[j], -448.0f, 448.0f); }
                        w[h].x = cvt_pk4_fp8(v0[0], v0[1], v0[2], v0[3]); w[h].y = cvt_pk4_fp8(v1[0], v1[1], v1[2], v1[3]); }
                    *(u32x4*)(rowp + bj * HALF) = widen16(w[0], w[1]); } }
    }
};
}

constexpr int RING_BYTES = 131072;
constexpr int MISC_OFF = RING_BYTES;
constexpr int LDS_BYTES = 163840;
constexpr int MW_BAR = 0;
constexpr int MW_TB = 16;
constexpr int MW_CN = 40;
constexpr int MW_Q = 60;
constexpr int MW_F = 64;

struct Params {
    const float* in[25]; float* out; unsigned char* ws;
};

constexpr float ATT_QSCALE = 0.125f * 1.4426950408889634f;
__device__ __forceinline__ void transpose_item(const float* W, int ld, int K, int k0, int srccol, bf16_t* WT, int dstrow, LAS float* scr, int lane, const float* gk = nullptr, float wsc = 1.0f) {
    float tv[32];
#pragma unroll
    for (int i = 0; i < 32; ++i) { const int kk = 2 * i + (lane >> 5); tv[i] = W[(size_t)(k0 + kk) * ld + srccol + (lane & 31)]; }
#pragma unroll
    for (int i = 0; i < 32; ++i) { const int kk = 2 * i + (lane >> 5); scr[kk * 33 + (lane & 31)] = (gk ? tv[i] * gk[k0 + kk] : tv[i]) * wsc; }
    asm volatile("s_waitcnt lgkmcnt(0)" ::: "memory");
    const int c = lane & 7;
#pragma unroll
    for (int j = 0; j < 4; ++j) { const int n = (lane >> 3) + 8 * j; const LAS float* s = scr + (8 * c) * 33 + n;
        u32x4 o; o.x = cvt_pk_bf16(s[0 * 33], s[1 * 33]); o.y = cvt_pk_bf16(s[2 * 33], s[3 * 33]); o.z = cvt_pk_bf16(s[4 * 33], s[5 * 33]); o.w = cvt_pk_bf16(s[6 * 33], s[7 * 33]);
        *(u32x4*)(WT + (size_t)(dstrow + n) * K + k0 + 8 * c) = o; }
    asm volatile("s_waitcnt lgkmcnt(0)" ::: "memory");
}
__device__ __forceinline__ void transpose_item_f8(const float* W, int ld, int K, int k0, int srccol, unsigned char* WT8, int dstrow, LAS float* scr, int lane, const float* gk, float scale) {
    float tv[32];
#pragma unroll
    for (int i = 0; i < 32; ++i) { const int kk = 2 * i + (lane >> 5); tv[i] = W[(size_t)(k0 + kk) * ld + srccol + (lane & 31)]; }
#pragma unroll
    for (int i = 0; i < 32; ++i) { const int kk = 2 * i + (lane >> 5); scr[kk * 33 + (lane & 31)] = (gk ? tv[i] * gk[k0 + kk] : tv[i]) * scale; }
    asm volatile("s_waitcnt lgkmcnt(0)" ::: "memory");
    const int c = lane & 3;
#pragma unroll
    for (int j = 0; j < 2; ++j) { const int n = (lane >> 2) + 16 * j; const LAS float* q = scr + (16 * c) * 33 + n;
        u32x4 o; o.x = cvt_pk4_fp8(q[0 * 33], q[1 * 33], q[2 * 33], q[3 * 33]); o.y = cvt_pk4_fp8(q[4 * 33], q[5 * 33], q[6 * 33], q[7 * 33]);
        o.z = cvt_pk4_fp8(q[8 * 33], q[9 * 33], q[10 * 33], q[11 * 33]); o.w = cvt_pk4_fp8(q[12 * 33], q[13 * 33], q[14 * 33], q[15 * 33]);
        *(u32x4*)(WT8 + (size_t)(dstrow + n) * K + k0 + 16 * c) = o; }
    asm volatile("s_waitcnt lgkmcnt(0)" ::: "memory");
}
__device__ __forceinline__ int pair_row(int ch, int up) { return (ch >> 7) * 256 + up * 128 + (ch & 127); }

__device__ __forceinline__ void phase_prologue_weights(const Params& p, LAS unsigned char* lds, int first, int last, int step, int wave, int lane_) {
    int lane = lane_; asm volatile("" : "+v"(lane));
    LAS float* scr = (LAS float*)(lds + wave * 16384);
    unsigned char* ws = p.ws;
    constexpr int I1 = 16 * 112, I2 = 16 * 32, I3 = 16 * 96, I4 = 16 * 32, IE = 768;
    constexpr int NITEMS = I1 + I2 + I3 + I4 + 32 * IE;
    static_assert(NITEMS == 28928, "item count");
    for (int it = first; it < last; it += step) {
        int r = it;
        if (r < I1) { const int kb = r / 112, nb = r % 112; const int sc = nb < 64 ? 32 * nb : 2056 + 32 * (nb - 64), dr = nb < 64 ? 32 * nb : 2048 + 32 * (nb - 64);
            transpose_item(p.in[5], EVEN_IN, 1024, 64 * kb, sc, (bf16_t*)(ws + WS_WT1), dr, scr, lane, nullptr, (dr >= P_DQ && dr < P_DK) ? ATT_QSCALE : 1.0f); continue; } r -= I1;
        if (r < I2) { const int kb = r / 32, nb = r % 32; transpose_item(p.in[6], 1024, 1024, 64 * kb, 32 * nb, (bf16_t*)(ws + WS_WT2), 32 * nb, scr, lane); continue; } r -= I2;
        if (r < I3) { const int kb = r / 96, nb = r % 96; int dr;
            if (nb < 32) dr = 32 * nb; else if (nb < 64) dr = 1024 + pair_row(32 * (nb - 32), 0); else dr = 1024 + pair_row(32 * (nb - 64), 1);
            if (G3_F8) transpose_item_f8(p.in[15], 3072, 1024, 64 * kb, 32 * nb, ws + WS_WT3, dr, scr, lane, p.in[2] + D, F8_WSCALE);
            else transpose_item(p.in[15], 3072, 1024, 64 * kb, 32 * nb, (bf16_t*)(ws + WS_WT3), dr, scr, lane, p.in[2] + D);
            continue; } r -= I3;
        if (r < I4) { const int kb = r / 32, nb = r % 32; transpose_item(p.in[17], 1024, 1024, 64 * kb, 32 * nb, (bf16_t*)(ws + WS_WT4), 32 * nb, scr, lane); continue; } r -= I4;
        const int le = r / IE; r %= IE;
        unsigned char* wgu = ws + WS_WGU + (size_t)le * 1024 * 1024; unsigned char* wd = ws + WS_WD + (size_t)le * 1024 * 512;
        if (r < 256) { const int kb = r / 16, nb = r % 16; transpose_item_f8(p.in[22] + (size_t)le * 1024 * 512, 512, 1024, 64 * kb, 32 * nb, wgu, pair_row(32 * nb, 0), scr, lane, p.in[3] + (le >> 4) * D, F8_WSCALE); continue; } r -= 256;
        if (r < 256) { const int kb = r / 16, nb = r % 16; transpose_item_f8(p.in[23] + (size_t)le * 1024 * 512, 512, 1024, 64 * kb, 32 * nb, wgu, pair_row(32 * nb, 1), scr, lane, p.in[3] + (le >> 4) * D, F8_WSCALE); continue; } r -= 256;
        { const int kb = r / 32, nb = r % 32; transpose_item_f8(p.in[24] + (size_t)le * 512 * 1024, 1024, 512, 64 * kb, 32 * nb, wd, 32 * nb, scr, lane, nullptr, F8_WSCALE); }
    }
}

struct RowV { f32x4 v[4]; };
__device__ __forceinline__ RowV row_load(const float* xr, int lane) { RowV r; const f32x4* p = (const f32x4*)xr + lane;
#pragma unroll
    for (int j = 0; j < 4; ++j) r.v[j] = p[64 * j]; return r; }
__device__ __forceinline__ void row_store(float* xr, int lane, const RowV& r) { f32x4* p = (f32x4*)xr + lane;
#pragma unroll
    for (int j = 0; j < 4; ++j) p[64 * j] = r.v[j]; }
__device__ __forceinline__ RowV row_load_bf16(const bf16_t* yr, int lane) { RowV r; const u32x2* p = (const u32x2*)yr + lane;
#pragma unroll
    for (int j = 0; j < 4; ++j) { const u32x2 w = p[64 * j]; r.v[j] = (f32x4){bf_lo(w.x), bf_hi(w.x), bf_lo(w.y), bf_hi(w.y)}; } return r; }
__device__ __forceinline__ RowV row_load_fp8(const unsigned char* yr, int lane, float sc) { RowV r; const unsigned* p = (const unsigned*)yr + lane;
#pragma unroll
    for (int j = 0; j < 4; ++j) { const unsigned w = p[64 * j]; const f32x2 lo = __builtin_amdgcn_cvt_pk_f32_fp8((int)w, false), hi = __builtin_amdgcn_cvt_pk_f32_fp8((int)w, true); r.v[j] = (f32x4){lo.x * sc, lo.y * sc, hi.x * sc, hi.y * sc}; } return r; }
__device__ __forceinline__ float row_rstd(const RowV& r) { float s = 0.f;
#pragma unroll
    for (int j = 0; j < 4; ++j) s += (r.v[j][0] * r.v[j][0] + r.v[j][1] * r.v[j][1]) + (r.v[j][2] * r.v[j][2] + r.v[j][3] * r.v[j][3]);
    return 1.0f / sqrtf(wave_sum(s) * (1.0f / D) + NORM_EPS); }
__device__ __forceinline__ void row_store_bf16(bf16_t* hr, int lane, const RowV& r) { u32x2* p = (u32x2*)hr + lane;
#pragma unroll
    for (int j = 0; j < 4; ++j) { u32x2 w; w.x = cvt_pk_bf16(r.v[j][0], r.v[j][1]); w.y = cvt_pk_bf16(r.v[j][2], r.v[j][3]); p[64 * j] = w; } }

__device__ __forceinline__ void phase_norm_gates(const Params& p, LAS unsigned char* lds, int tid, int gw, int NGW, int lane) {
    const float* x = p.in[0]; const float* g = p.in[2]; const float* win = p.in[5];
    bf16_t* H = (bf16_t*)(p.ws + WS_H); float* gates = (float*)(p.ws + WS_GATES);
    LAS float* wt = (LAS float*)lds;
    for (int i = tid; i < 8 * 1024; i += NTHR) { const int k = i >> 3, o = i & 7; wt[o * 1024 + k] = win[(size_t)k * EVEN_IN + 2048 + o] * g[k]; }
    __syncthreads();
    RowV gv = row_load(g, lane);
    for (int m0 = gw; m0 < T; m0 += 2 * NGW) {
      RowV rr[2];
#pragma unroll
      for (int u = 0; u < 2; ++u) { const int mm = m0 + u * NGW; rr[u] = row_load(x + (size_t)(mm < T ? mm : m0) * D, lane); }
#pragma unroll
      for (int u = 0; u < 2; ++u) {
        const int m = m0 + u * NGW; if (m >= T) break; RowV r = rr[u];
        const float rstd = row_rstd(r);
        float dots[8];
#pragma unroll
        for (int o = 0; o < 8; ++o) { float s = 0.f;
#pragma unroll
            for (int j = 0; j < 4; ++j) { const f32x4 w = *(const LAS f32x4*)(wt + o * 1024 + 4 * lane + 256 * j); s += (r.v[j][0] * w[0] + r.v[j][1] * w[1]) + (r.v[j][2] * w[2] + r.v[j][3] * w[3]); }
            dots[o] = s; }
        float gsum;
        { const bool b5 = (lane & 32) != 0, b4 = (lane & 16) != 0, b3 = (lane & 8) != 0;
          float k4[4];
#pragma unroll
          for (int i = 0; i < 4; ++i) { const float keep = b5 ? dots[4 + i] : dots[i], send = b5 ? dots[i] : dots[4 + i]; k4[i] = keep + __shfl_xor(send, 32); }
          float k2[2];
#pragma unroll
          for (int i = 0; i < 2; ++i) { const float keep = b4 ? k4[2 + i] : k4[i], send = b4 ? k4[i] : k4[2 + i]; k2[i] = keep + __shfl_xor(send, 16); }
          { const float keep = b3 ? k2[1] : k2[0], send = b3 ? k2[0] : k2[1]; gsum = keep + __shfl_xor(send, 8); }
          gsum += __shfl_xor(gsum, 4); gsum += __shfl_xor(gsum, 2); gsum += __shfl_xor(gsum, 1); }
#pragma unroll
        for (int j = 0; j < 4; ++j) r.v[j] = r.v[j] * rstd * gv.v[j];
        row_store_bf16(H + (size_t)m * D, lane, r);
        if ((lane & 7) == 0) gates[(size_t)m * 8 + ((lane >> 3) & 7)] = gsum * rstd;
      }
    }
    __syncthreads();
}

template <int MODE, bool COMBINE>
__device__ __forceinline__ void phase_rows(const Params& p, LAS unsigned char* lds, int tid_, int wave, int lane_, int G,
                                           const float* gvec, const float* wgr, const float* bgr, const float* wer, const float* ber, unsigned* cnt_prev, unsigned* cnt_cur) {
    int tid = tid_; asm volatile("" : "+v"(tid)); const int lane = tid & 63;
    float* OUT = p.out; bf16_t* XB = (bf16_t*)(p.ws + WS_XB); float* RSTD = (float*)(p.ws + WS_RSTD);
    const unsigned char* YC = (const unsigned char*)(p.ws + WS_YC); float* rsraw = (float*)(p.ws + WS_RSRAW);
    unsigned* tokinfo = (unsigned*)(p.ws + WS_TOKINFO);
    unsigned* rowtok = (unsigned*)(p.ws + WS_ROWTOK); float* cwraw = (float*)(p.ws + WS_CWRAW);
    LAS float* wt = (LAS float*)lds;
    LAS int* misc = (LAS int*)(lds + MISC_OFF);
    LAS int* tbp = misc + MW_TB;
    LAS int* te = misc + 1024;
    LAS float* tc = (LAS float*)(misc + 1536);
    LAS int* trank = misc + 2048;
    LAS int* ebase = misc + 2560;
    LAS float* trs = (LAS float*)(misc + 2600);
    if (COMBINE) { if (tid == 0) { int acc = 0; for (int e = 0; e < 16; ++e) { tbp[e] = acc; acc += ((int)__hip_atomic_load(cnt_prev + e * 64, __ATOMIC_RELAXED, __HIP_MEMORY_SCOPE_AGENT) + 255) >> 8; } tbp[16] = acc; } }
    if (MODE == 1) { for (int i = tid; i < 20 * 1024; i += NTHR) { const int o = i >> 10, k = i & 1023; wt[i] = (o < 4 ? wgr[(size_t)k * 4 + o] : wer[(size_t)k * 16 + (o - 4)]) * gvec[k]; } }
    __syncthreads();
    RowV gv; if (MODE == 2) gv = row_load(gvec, lane);
    for (int blk = blockIdx.x; blk < T / 256; blk += G) {
        for (int i2 = 0; i2 < 32; i2 += 2) {
          RowV rr[2];
#pragma unroll
          for (int u = 0; u < 2; ++u) {
            const int m = blk * 256 + wave * 32 + i2 + u;
            rr[u] = row_load_bf16(XB + (size_t)m * D, lane);
            if (COMBINE) {
                const unsigned i0 = tokinfo[(size_t)m * 2], i1 = tokinfo[(size_t)m * 2 + 1];
                const size_t s0 = (size_t)tbp[i0 >> 16] * 256 + (i0 & 0xffffu), s1 = (size_t)tbp[i1 >> 16] * 256 + (i1 & 0xffffu);
                const RowV y0 = row_load_fp8(YC + s0 * D, lane, 1.0f / F8_YSCALE), y1 = row_load_fp8(YC + s1 * D, lane, 1.0f / F8_YSCALE);
#pragma unroll
                for (int j = 0; j < 4; ++j) rr[u].v[j] = rr[u].v[j] + y0.v[j] + y1.v[j];
            }
          }
#pragma unroll
          for (int u = 0; u < 2; ++u) {
            const int i = i2 + u;
            const int rl = wave * 32 + i, m = blk * 256 + rl;
            RowV r = rr[u];
            if (MODE == 0) {
                u32x2* xp = (u32x2*)(XB + (size_t)m * D) + lane;
#pragma unroll
                for (int j = 0; j < 4; ++j) { u32x2 w; w.x = cvt_pk_bf16(r.v[j][0], r.v[j][1]); w.y = cvt_pk_bf16(r.v[j][2], r.v[j][3]); xp[64 * j] = w;
                    r.v[j] = (f32x4){bf_lo(w.x), bf_hi(w.x), bf_lo(w.y), bf_hi(w.y)}; }
            }
            const float rstd = row_rstd(r);
            if (MODE != 2) { if (lane == 0) RSTD[m] = rstd; }
            if (MODE == 1 || (MODE == 0 && G3_F8)) { unsigned* x8 = (unsigned*)(p.ws + WS_XB8 + (size_t)m * D) + lane;
#pragma unroll
                for (int j = 0; j < 4; ++j) x8[64 * j] = cvt_pk4_fp8(r.v[j][0], r.v[j][1], r.v[j][2], r.v[j][3]); }
            if (MODE == 1) {
                float lg[20];
#pragma unroll
                for (int o = 0; o < 20; ++o) { float s = 0.f;
#pragma unroll
                    for (int j = 0; j < 4; ++j) { const f32x4 w = *(const LAS f32x4*)(wt + o * 1024 + 4 * lane + 256 * j); s += (r.v[j][0] * w[0] + r.v[j][1] * w[1]) + (r.v[j][2] * w[2] + r.v[j][3] * w[3]); }
                    lg[o] = wave_sum(s) * rstd + (o < 4 ? bgr[o] : ber[o - 4]); }
                int gs = 0; float gm = lg[0];
#pragma unroll
                for (int o = 1; o < 4; ++o) if (lg[o] > gm) { gm = lg[o]; gs = o; }
                float den = 0.f;
#pragma unroll
                for (int o = 0; o < 4; ++o) den += __expf(lg[o] - gm);
                const float pg = 1.0f / den;
                float el[4];
#pragma unroll
                for (int o = 0; o < 4; ++o) { float v = lg[4 + o];
#pragma unroll
                    for (int g2 = 1; g2 < 4; ++g2) v = (gs == g2) ? lg[4 + 4 * g2 + o] : v;
                    el[o] = v; }
                int i0 = 0; float v0 = el[0];
#pragma unroll
                for (int o = 1; o < 4; ++o) if (el[o] > v0) { v0 = el[o]; i0 = o; }
                int i1 = -1; float v1 = -INFINITY;
#pragma unroll
                for (int o = 0; o < 4; ++o) if (o != i0 && el[o] > v1) { v1 = el[o]; i1 = o; }
                const float ex = __expf(v1 - v0); const float w0 = 1.0f / (1.0f + ex), w1 = ex * w0;
                if (lane == 0) { te[rl * 2] = gs * 4 + i0; te[rl * 2 + 1] = gs * 4 + i1; tc[rl * 2] = w0 * pg; tc[rl * 2 + 1] = w1 * pg; trs[rl] = rstd; }
            }
            if (MODE == 2) {
#pragma unroll
                for (int j = 0; j < 4; ++j) r.v[j] = r.v[j] * rstd * gv.v[j];
                row_store(OUT + (size_t)m * D, lane, r);
            }
          }
        }
        if (MODE == 1) {
            __syncthreads();
            if (tid < 16) { int c = 0; for (int q = 0; q < 512; ++q) if (te[q] == tid) { trank[q] = c; ++c; }
                ebase[tid] = c ? (int)__hip_atomic_fetch_add(cnt_cur + tid * 64, (unsigned)c, __ATOMIC_RELAXED, __HIP_MEMORY_SCOPE_AGENT) : 0; }
            __syncthreads();
            { const int q = tid, e = te[q], pos = ebase[e] + trank[q], tok = blk * 256 + (q >> 1);
              rowtok[(size_t)e * ECAP + pos] = (unsigned)tok; cwraw[(size_t)e * ECAP + pos] = tc[q]; rsraw[(size_t)e * ECAP + pos] = trs[q >> 1]; tokinfo[(size_t)tok * 2 + (q & 1)] = ((unsigned)e << 16) | (unsigned)pos; }
            __syncthreads();
        }
    }
    __syncthreads();
}

__device__ __forceinline__ void phase_router(const Params& p, LAS unsigned char* lds, int tid_, int wave, int G,
                                             const float* gvec, const float* wgr, const float* bgr, const float* wer, const float* ber, unsigned* cnt_cur) {
    int tid = tid_; asm volatile("" : "+v"(tid)); const int lane = tid & 63, r32 = lane & 31, hi = lane >> 5;
    const bf16_t* XB = (const bf16_t*)(p.ws + WS_XB); float* rsraw = (float*)(p.ws + WS_RSRAW);
    unsigned* tokinfo = (unsigned*)(p.ws + WS_TOKINFO);
    unsigned* rowtok = (unsigned*)(p.ws + WS_ROWTOK); float* cwraw = (float*)(p.ws + WS_CWRAW);
    constexpr int WROW = 2048 + 16;
    LAS unsigned char* Whi = lds; LAS unsigned char* Wlo = lds + 24 * WROW;
    LAS int* misc = (LAS int*)(lds + MISC_OFF);
    LAS int* te = misc + 1024; LAS float* tc = (LAS float*)(misc + 1536); LAS int* trank = misc + 2048; LAS int* ebase = misc + 2560; LAS float* trs = (LAS float*)(misc + 2600);
    for (int i = tid; i < 24 * 1024; i += NTHR) { const int sl = i >> 10, k = i & 1023; float w;
        if (sl < 8) w = wgr[(size_t)k * 4 + (sl & 3)]; else { const int q = sl - 8, e = (q & 3) + 8 * ((q >> 2) & 1) + 4 * (q >> 3); w = wer[(size_t)k * 16 + e]; }
        w *= gvec[k];
        const unsigned hb = cvt_pk_bf16(w, 0.f) & 0xffffu; const float wl = w - __uint_as_float(hb << 16); const unsigned lb = cvt_pk_bf16(wl, 0.f) & 0xffffu;
        *(LAS unsigned short*)(Whi + sl * WROW + k * 2) = (unsigned short)hb; *(LAS unsigned short*)(Wlo + sl * WROW + k * 2) = (unsigned short)lb; }
    __syncthreads();
    const int slot_row = r32 < 24 ? r32 : r32 - 8;
    const LAS unsigned char* wh = Whi + slot_row * WROW + hi * 64; const LAS unsigned char* wl_ = Wlo + slot_row * WROW + hi * 64;
    for (int blk = blockIdx.x; blk < T / 256; blk += G) {
        const int rl = wave * 32 + r32, m = blk * 256 + rl;
        const bf16_t* xr = XB + (size_t)m * D + hi * 32;
        f32x16 acc = (f32x16){}; float ss = 0.f;
        bf16x8 xa[4], xb[4];
#pragma unroll
        for (int q = 0; q < 4; ++q) xa[q] = *(const bf16x8*)(xr + q * 8);
#pragma unroll 1
        for (int t = 0; t < 16; t += 2) {
#pragma unroll
            for (int q = 0; q < 4; ++q) xb[q] = *(const bf16x8*)(xr + (t + 1) * 64 + q * 8);
#pragma unroll
            for (int q = 0; q < 4; ++q) { const bf16x8 ah = *(const LAS bf16x8*)(wh + t * 128 + q * 16), al = *(const LAS bf16x8*)(wl_ + t * 128 + q * 16);
                acc = __builtin_amdgcn_mfma_f32_32x32x16_bf16(ah, xa[q], acc, 0, 0, 0); acc = __builtin_amdgcn_mfma_f32_32x32x16_bf16(al, xa[q], acc, 0, 0, 0);
#pragma unroll
                for (int j = 0; j < 4; ++j) { const unsigned w = ((const unsigned*)&xa[q])[j]; const float a = bf_lo(w), b = bf_hi(w); ss += a * a + b * b; } }
            if (t + 2 < 16) {
#pragma unroll
                for (int q = 0; q < 4; ++q) xa[q] = *(const bf16x8*)(xr + (t + 2) * 64 + q * 8); }
#pragma unroll
            for (int q = 0; q < 4; ++q) { const bf16x8 ah = *(const LAS bf16x8*)(wh + (t + 1) * 128 + q * 16), al = *(const LAS bf16x8*)(wl_ + (t + 1) * 128 + q * 16);
                acc = __builtin_amdgcn_mfma_f32_32x32x16_bf16(ah, xb[q], acc, 0, 0, 0); acc = __builtin_amdgcn_mfma_f32_32x32x16_bf16(al, xb[q], acc, 0, 0, 0);
#pragma unroll
                for (int j = 0; j < 4; ++j) { const unsigned w = ((const unsigned*)&xb[q])[j]; const float a = bf_lo(w), b = bf_hi(w); ss += a * a + b * b; } }
        }
        ss += __shfl_xor(ss, 32);
        const float rstd = 1.0f / sqrtf(ss * (1.0f / D) + NORM_EPS);
        float lg[4];
#pragma unroll
        for (int o = 0; o < 4; ++o) lg[o] = acc[o] * rstd + bgr[o];
        int gs = 0; float gm = lg[0];
#pragma unroll
        for (int o = 1; o < 4; ++o) if (lg[o] > gm) { gm = lg[o]; gs = o; }
        float den = 0.f;
#pragma unroll
        for (int o = 0; o < 4; ++o) den += __expf(lg[o] - gm);
        const float pg = 1.0f / den;
        if ((gs >> 1) == hi) {
            float el[4];
#pragma unroll
            for (int o = 0; o < 4; ++o) el[o] = ((gs & 1) ? acc[8 + o] : acc[4 + o]) * rstd + ber[gs * 4 + o];
            int i0 = 0; float v0 = el[0];
#pragma unroll
            for (int o = 1; o < 4; ++o) if (el[o] > v0) { v0 = el[o]; i0 = o; }
            int i1 = -1; float v1 = -INFINITY;
#pragma unroll
            for (int o = 0; o < 4; ++o) if (o != i0 && el[o] > v1) { v1 = el[o]; i1 = o; }
            const float ex = __expf(v1 - v0); const float w0 = 1.0f / (1.0f + ex), w1 = ex * w0;
            te[rl * 2] = gs * 4 + i0; te[rl * 2 + 1] = gs * 4 + i1; tc[rl * 2] = w0 * pg; tc[rl * 2 + 1] = w1 * pg; trs[rl] = rstd;
        }
        __syncthreads();
        if (tid < 16) { int c = 0; for (int q = 0; q < 512; ++q) if (te[q] == tid) { trank[q] = c; ++c; }
            ebase[tid] = c ? (int)__hip_atomic_fetch_add(cnt_cur + tid * 64, (unsigned)c, __ATOMIC_RELAXED, __HIP_MEMORY_SCOPE_AGENT) : 0; }
        __syncthreads();
        { const int q = tid, e = te[q], pos = ebase[e] + trank[q], tok = blk * 256 + (q >> 1);
          rowtok[(size_t)e * ECAP + pos] = (unsigned)tok; cwraw[(size_t)e * ECAP + pos] = tc[q]; rsraw[(size_t)e * ECAP + pos] = trs[q >> 1]; tokinfo[(size_t)tok * 2 + (q & 1)] = ((unsigned)e << 16) | (unsigned)pos; }
        __syncthreads();
    }
    __syncthreads();
}

__device__ __forceinline__ void phase_conv(const Params& p, int gw, int NGW, int lane) {
    const bf16_t* BG = (const bf16_t*)(p.ws + WS_BG); const bf16_t* Z = (const bf16_t*)(p.ws + WS_Z); bf16_t* A2 = (bf16_t*)(p.ws + WS_CAT);
    const float* cw = p.in[16];
    float w0[16], w1[16], w2[16];
#pragma unroll
    for (int h = 0; h < 2; ++h)
#pragma unroll
        for (int j = 0; j < 8; ++j) { const int c = h * 512 + lane * 8 + j; w0[h * 8 + j] = cw[c]; w1[h * 8 + j] = cw[D + c]; w2[h * 8 + j] = cw[2 * D + c]; }
    for (int run = gw; run < T / 32; run += NGW) {
        const int t0 = run * 32;
        float zm1[16], zm2[16];
#pragma unroll
        for (int j = 0; j < 16; ++j) { zm1[j] = 0.f; zm2[j] = 0.f; }
        if ((t0 & (SEQ - 1)) != 0) {
#pragma unroll
            for (int h = 0; h < 2; ++h) { const u32x4 a = *(const u32x4*)(Z + (size_t)(t0 - 1) * D + h * 512 + lane * 8), b = *(const u32x4*)(Z + (size_t)(t0 - 2) * D + h * 512 + lane * 8);
#pragma unroll
                for (int q = 0; q < 4; ++q) { zm1[h * 8 + 2 * q] = bf_lo(a[q]); zm1[h * 8 + 2 * q + 1] = bf_hi(a[q]); zm2[h * 8 + 2 * q] = bf_lo(b[q]); zm2[h * 8 + 2 * q + 1] = bf_hi(b[q]); } }
        }
#pragma unroll 4
        for (int i = 0; i < 32; ++i) {
            const size_t rb = (size_t)(t0 + i) * D;
#pragma unroll
            for (int h = 0; h < 2; ++h) { const u32x4 zz = *(const u32x4*)(Z + rb + h * 512 + lane * 8), bb = *(const u32x4*)(BG + rb + h * 512 + lane * 8);
                float o[8];
#pragma unroll
                for (int q = 0; q < 4; ++q) {
#pragma unroll
                    for (int s = 0; s < 2; ++s) { const int j = h * 8 + 2 * q + s; const float zc = s ? bf_hi(zz[q]) : bf_lo(zz[q]), bg = s ? bf_hi(bb[q]) : bf_lo(bb[q]);
                        o[2 * q + s] = bg * (w0[j] * zm2[j] + w1[j] * zm1[j] + w2[j] * zc); zm2[j] = zm1[j]; zm1[j] = zc; } }
                u32x4 w; w.x = cvt_pk_bf16(o[0], o[1]); w.y = cvt_pk_bf16(o[2], o[3]); w.z = cvt_pk_bf16(o[4], o[5]); w.w = cvt_pk_bf16(o[6], o[7]);
                *(u32x4*)(A2 + rb + h * 512 + lane * 8) = w; }
        }
    }
}

__device__ __forceinline__ void phase_gate_scan(const Params& p, int gw, int NGW, int lane) {
    const float* gates = (const float*)(p.ws + WS_GATES);
    float* SA = (float*)(p.ws + WS_SA); float* SAM = (float*)(p.ws + WS_SAM); float* SBA = (float*)(p.ws + WS_SBA);
    for (int sq = gw; sq < NBATCH * 4; sq += NGW) {
        const int b = sq >> 2, hd = sq & 3; const float ib = p.in[7][hd], fb = p.in[8][hd];
        float carryB = 0.f, carryM = -INFINITY;
#pragma unroll 1
        for (int i0 = 0; i0 < 32; i0 += 8) {
            float lf[8], ig[8];
#pragma unroll
            for (int i = 0; i < 8; ++i) { const size_t t = (size_t)b * SEQ + 64 * (i0 + i) + lane; const float f = gates[t * 8 + 4 + hd] + fb; ig[i] = gates[t * 8 + hd] + ib;
                lf[i] = (f >= 0.f) ? -log1pf(expf(-f)) : (f - log1pf(expf(f))); }
#pragma unroll
            for (int i = 0; i < 8; ++i) {
                float sB = lf[i];
#pragma unroll
                for (int o = 1; o < 64; o <<= 1) { const float v = __shfl_up(sB, o); if (lane >= o) sB += v; }
                sB += carryB; carryB = __shfl(sB, 63);
                const float a = ig[i] - sB;
                float m = a;
#pragma unroll
                for (int o = 1; o < 64; o <<= 1) { const float v = __shfl_up(m, o); if (lane >= o) m = fmaxf(m, v); }
                m = fmaxf(m, carryM); carryM = __shfl(m, 63);
                const size_t o2 = (size_t)sq * SEQ + 64 * (i0 + i) + lane; SA[o2] = a; SAM[o2] = m; SBA[o2] = sB + m;
            }
        }
    }
}

struct TileRegs { u32x4 v[2]; };
__device__ __forceinline__ TileRegs tile_load(const bf16_t* src, int tid) { TileRegs r;
#pragma unroll
    for (int i = 0; i < 2; ++i) { const int n = tid + 512 * i, row = n >> 4, ch = n & 15; r.v[i] = *(const u32x4*)(src + (size_t)row * NP + ch * 8); } return r; }
__device__ __forceinline__ void tile_write(LAS unsigned char* dst, int tid, const TileRegs& r) {
#pragma unroll
    for (int i = 0; i < 2; ++i) { const int n = tid + 512 * i, row = n >> 4, ch = n & 15; *(LAS u32x4*)(dst + off_b(row, ch)) = r.v[i]; } }

__device__ __forceinline__ void glds16(const void* gsrc, unsigned lds_dst) { unsigned keep;
    asm volatile("s_mov_b32 %0, m0\n\ts_mov_b32 m0, %2\n\ts_nop 0\n\tglobal_load_lds_dwordx4 %1, off\n\ts_mov_b32 m0, %0" : "=&s"(keep) : "v"(gsrc), "s"(lds_dst) : "memory"); }
__device__ __forceinline__ void tile_dma(const bf16_t* src, LAS unsigned char* dst, int wave, int lane) {
#pragma unroll
    for (int i = 0; i < 2; ++i) { const int piece = 2 * wave + i, row = 4 * piece + (lane >> 4); const unsigned ch = (unsigned)(lane & 15) ^ ((((unsigned)lane >> 4) << 2) | ((unsigned)piece & 3u));
        glds16(src + (size_t)row * NP + ch * 8, (unsigned)__builtin_amdgcn_readfirstlane((int)(unsigned)(uintptr_t)(dst + piece * 1024))); }
}
#define WAIT_ALL_BAR() asm volatile("s_waitcnt vmcnt(0) lgkmcnt(0)\n\ts_barrier" ::: "memory")
__device__ __forceinline__ void attn_unit(const Params& p, LAS unsigned char* lds, int bh, int qblk, int tid_, int wave, int lane_) {
    int tid = tid_; asm volatile("" : "+v"(tid)); const int lane = tid & 63;
    const bf16_t* P = (const bf16_t*)(p.ws + WS_P); bf16_t* CAT = (bf16_t*)(p.ws + WS_CAT);
    const int b = bh >> 2, hd = bh & 3, map = wave >> 2, qs = wave & 3, r32 = lane & 31, hi = lane >> 5;
    const size_t rowbase = (size_t)b * SEQ;
    const int q0 = qblk * 128 + qs * 32, qrow = q0 + r32;
    LAS float* fs = (LAS float*)(lds + MISC_OFF) + MW_F;
    LAS float* tbl = fs;
    constexpr float LOG2E = 1.4426950408889634f;
    if (tid < 272) { const int n = tid - 64; int bk;
        if (n < 16) bk = n < 0 ? 0 : n; else { bk = 16; const int th[15] = {19, 21, 24, 27, 31, 35, 40, 46, 52, 59, 67, 77, 87, 99, 113};
#pragma unroll
            for (int j = 0; j < 15; ++j) bk += (n >= th[j]) ? 1 : 0; }
        tbl[tid] = n < 0 ? -INFINITY : p.in[1][bk * 4 + hd] * LOG2E; }
    bf16x8 qf[4];
    { const bf16_t* qp = P + (rowbase + qrow) * NP + P_DQ + hd * 128 + map * 64 + hi * 8;
#pragma unroll
      for (int ks = 0; ks < 4; ++ks) qf[ks] = *(const bf16x8*)(qp + ks * 16); }
    const bf16_t* Kg = P + rowbase * NP + P_DK + hd * 128; const bf16_t* Vg = P + rowbase * NP + P_DV + hd * 128;
    const int NS = qblk + 1;
    f32x16 o[4];
#pragma unroll
    for (int c = 0; c < 4; ++c) o[c] = (f32x16){};
    float mrun = -INFINITY, lrun = 0.f;
    const float bias_far = p.in[1][31 * 4 + hd] * LOG2E;
    const unsigned xr = ((unsigned)(r32 & 3) << 2) | ((unsigned)(r32 >> 2) & 3u);
    const unsigned q4 = (lane & 15) >> 2, pp = lane & 3, blk = (lane >> 4) & 1;
#ifndef ATT_DMA
#define ATT_DMA 5
#endif
#ifndef ATT_LATE_DMA
#define ATT_LATE_DMA 1
#endif
#if ATT_DMA == 2 || ATT_DMA == 4
#elif ATT_DMA
    WAIT_ALL_BAR();
    { tile_dma(Kg, lds, wave, lane); tile_dma(Vg, lds + 16384, wave, lane); tile_dma(Kg + (size_t)64 * NP, lds + 32768, wave, lane); tile_dma(Vg + (size_t)64 * NP, lds + 49152, wave, lane); }
#else
    { TileRegs a0 = tile_load(Kg, tid), a1 = tile_load(Vg, tid), a2 = tile_load(Kg + (size_t)64 * NP, tid), a3 = tile_load(Vg + (size_t)64 * NP, tid);
      tile_write(lds, tid, a0); tile_write(lds + 16384, tid, a1); tile_write(lds + 32768, tid, a2); tile_write(lds + 49152, tid, a3); }
#endif
#if ATT_DMA == 5
    WAIT_ALL_BAR();
#endif
    asm volatile("" :: "v"(qf[0]), "v"(qf[1]), "v"(qf[2]), "v"(qf[3]));
#pragma unroll 1
    for (int st = 0; st < NS; ++st) {
        WAIT_ALL_BAR();
#if ATT_DMA == 2
        { LAS unsigned char* nb = lds + (st & 1) * 65536; const size_t ro = (size_t)st * 128 * NP;
            tile_dma(Kg + ro, nb, wave, lane); tile_dma(Vg + ro, nb + 16384, wave, lane); tile_dma(Kg + ro + (size_t)64 * NP, nb + 32768, wave, lane); tile_dma(Vg + ro + (size_t)64 * NP, nb + 49152, wave, lane); }
        WAIT_ALL_BAR();
#elif ATT_DMA == 3
#elif ATT_DMA
#if ATT_DMA == 4
        if (st == 0) { tile_dma(Kg, lds, wave, lane); tile_dma(Vg, lds + 16384, wave, lane); tile_dma(Kg + (size_t)64 * NP, lds + 32768, wave, lane); tile_dma(Vg + (size_t)64 * NP, lds + 49152, wave, lane); WAIT_ALL_BAR(); }
#endif
        if (!ATT_LATE_DMA && st + 1 < NS) { LAS unsigned char* nb = lds + ((st + 1) & 1) * 65536; const size_t ro = (size_t)(st + 1) * 128 * NP;
            tile_dma(Kg + ro, nb, wave, lane); tile_dma(Vg + ro, nb + 16384, wave, lane); tile_dma(Kg + ro + (size_t)64 * NP, nb + 32768, wave, lane); tile_dma(Vg + ro + (size_t)64 * NP, nb + 49152, wave, lane); }
#else
        TileRegs a0, a1;
        if (st + 1 < NS) { const size_t ro = (size_t)(st + 1) * 128 * NP; a0 = tile_load(Kg + ro, tid); a1 = tile_load(Vg + ro, tid); }
#endif
#pragma unroll
        for (int half = 0; half < 2; ++half) {
            const int j = 2 * st + half;
            const LAS unsigned char* Kt = lds + (st & 1) * 65536 + half * 32768; const LAS unsigned char* Vt = Kt + 16384;
            if (64 * j <= q0 + 31) {
                const int nmin = q0 - (64 * j + 63);
                const bool first = (mrun == -INFINITY);
                const float cinit = first ? 0.f : (nmin >= 113 ? bias_far - mrun : -mrun);
                f32x16 p0, p1;
#pragma unroll
                for (int r = 0; r < 16; ++r) { p0[r] = cinit; p1[r] = cinit; }
#pragma unroll
                for (int ks = 0; ks < 4; ++ks) { const unsigned ch = (unsigned)(8 * map + 2 * ks + hi) ^ xr;
                    const bf16x8 k0 = *(const LAS bf16x8*)(Kt + 256u * r32 + 16u * ch), k1 = *(const LAS bf16x8*)(Kt + 256u * (32 + r32) + 16u * ch);
                    p0 = __builtin_amdgcn_mfma_f32_32x32x16_bf16(k0, qf[ks], p0, 0, 0, 0); p1 = __builtin_amdgcn_mfma_f32_32x32x16_bf16(k1, qf[ks], p1, 0, 0, 0); }
                __builtin_amdgcn_sched_barrier(0);
                float rm = -INFINITY;
                if (first) {
                    if (nmin >= 113) {
#pragma unroll
                        for (int r = 0; r < 16; ++r) { p0[r] = p0[r] + bias_far; p1[r] = p1[r] + bias_far; rm = fmaxf(rm, fmaxf(p0[r], p1[r])); }
                    } else {
                        const LAS float* tb = tbl + (qrow - 64 * j - 4 * hi + 5);
#pragma unroll
                        for (int r = 0; r < 16; ++r) { const int e = (r & 3) + 8 * (r >> 2);
                            p0[r] += tb[59 - e]; p1[r] += tb[27 - e];
                            rm = fmaxf(rm, fmaxf(p0[r], p1[r])); }
                    }
                    { auto rr = __builtin_amdgcn_permlane32_swap(__float_as_uint(rm), __float_as_uint(rm), false, false); rm = fmaxf(__uint_as_float(rr[0]), __uint_as_float(rr[1])); }
                    mrun = rm;
#pragma unroll
                    for (int r = 0; r < 16; ++r) { p0[r] -= mrun; p1[r] -= mrun; }
                } else {
                    if (nmin < 113) {
                        const LAS float* tb = tbl + (qrow - 64 * j - 4 * hi + 5);
                        float bv0[16], bv1[16];
#pragma unroll
                        for (int r = 0; r < 16; ++r) { const int e = (r & 3) + 8 * (r >> 2); bv0[r] = tb[59 - e]; bv1[r] = tb[27 - e]; }
#pragma unroll
                        for (int r = 0; r < 16; ++r) { p0[r] += bv0[r]; p1[r] += bv1[r]; }
                    }
                    { float m0 = fmaxf(p0[0], p1[0]), m1 = fmaxf(p0[1], p1[1]);
#pragma unroll
                      for (int r = 2; r < 16; r += 2) { m0 = __builtin_fmaxf(__builtin_fmaxf(m0, p0[r]), p1[r]); m1 = __builtin_fmaxf(__builtin_fmaxf(m1, p0[r + 1]), p1[r + 1]); }
                      rm = fmaxf(m0, m1); }
                    { auto rr = __builtin_amdgcn_permlane32_swap(__float_as_uint(rm), __float_as_uint(rm), false, false); rm = fmaxf(__uint_as_float(rr[0]), __uint_as_float(rr[1])); }
                    if (__any(rm > 8.0f)) {
                        const float dl = fmaxf(rm, 0.f); const float alpha = fast_exp2(-dl);
                        lrun *= alpha; mrun += dl;
#pragma unroll
                        for (int r = 0; r < 16; ++r) { p0[r] -= dl; p1[r] -= dl; }
#pragma unroll
                        for (int c = 0; c < 4; ++c)
#pragma unroll
                            for (int r = 0; r < 16; ++r) o[c][r] *= alpha;
                    }
                }
                float psa = 0.f, psb = 0.f;
                bf16x8 pf[4];
#define ATT_EXPK(ks_) do { u32x4 w_; _Pragma("unroll") for (int q = 0; q < 4; ++q) { const int r = 8 * ((ks_) & 1) + 2 * q; \
                        const float ea = fast_exp2((ks_) < 2 ? p0[r] : p1[r]), eb = fast_exp2((ks_) < 2 ? p0[r + 1] : p1[r + 1]); psa += ea; psb += eb; w_[q] = cvt_pk_bf16(ea, eb); } \
                    pf[ks_] = __builtin_bit_cast(bf16x8, w_); } while (0)
                bf16x8 vf[2][4];
#define ATT_LOADV(buf, ks_) do { _Pragma("unroll") for (int c = 0; c < 4; ++c) { const unsigned chv = (unsigned)(4 * c + 2 * blk + (pp >> 1)); const unsigned row0 = 16u * (ks_) + 4u * hi + q4; \
                        vf[buf][c] = cat8(vtr(Vt + off_b(row0, chv) + 8u * (pp & 1)), vtr(Vt + off_b(row0 + 8u, chv) + 8u * (pp & 1))); } } while (0)
                ATT_LOADV(0, 0);
                ATT_EXPK(0);
                if (ATT_LATE_DMA && half == 0 && st + 1 < NS) {
                    LAS unsigned char* nb = lds + ((st + 1) & 1) * 65536; const size_t ro = (size_t)(st + 1) * 128 * NP;
                    tile_dma(Kg + ro, nb, wave, lane); tile_dma(Vg + ro, nb + 16384, wave, lane); tile_dma(Kg + ro + (size_t)64 * NP, nb + 32768, wave, lane); tile_dma(Vg + ro + (size_t)64 * NP, nb + 49152, wave, lane); }
#pragma unroll
                for (int ks = 0; ks < 4; ++ks) {
                    if (ks < 3) ATT_LOADV((ks + 1) & 1, ks + 1);
                    __builtin_amdgcn_sched_barrier(0);
#pragma unroll
                    for (int c = 0; c < 4; ++c) o[c] = __builtin_amdgcn_mfma_f32_32x32x16_bf16(vf[ks & 1][c], pf[ks], o[c], 0, 0, 0);
                    if (ks < 3) { ATT_EXPK(ks + 1); asm volatile("" : "+v"(pf[(ks + 1) & 3]), "+v"(psa), "+v"(psb)); }
                    __builtin_amdgcn_sched_barrier(0);
                }
                lrun += psa + psb;
#undef ATT_EXPK
#undef ATT_LOADV
            }
#if ATT_DMA == 5
            if (half == 0) WAIT_ALL_BAR();
#endif
#if !ATT_DMA
            if (st + 1 < NS) { LAS unsigned char* nb = lds + ((st + 1) & 1) * 65536 + half * 32768; tile_write(nb, tid, a0); tile_write(nb + 16384, tid, a1);
                if (half == 0) { const size_t ro = (size_t)(st + 1) * 128 * NP + (size_t)64 * NP; a0 = tile_load(Kg + ro, tid); a1 = tile_load(Vg + ro, tid); } }
#endif
        }
#if ATT_DMA == 3
        WAIT_ALL_BAR();
        if (st + 1 < NS) { LAS unsigned char* nb = lds + ((st + 1) & 1) * 65536; const size_t ro = (size_t)(st + 1) * 128 * NP;
            tile_dma(Kg + ro, nb, wave, lane); tile_dma(Vg + ro, nb + 16384, wave, lane); tile_dma(Kg + ro + (size_t)64 * NP, nb + 32768, wave, lane); tile_dma(Vg + ro + (size_t)64 * NP, nb + 49152, wave, lane); }
#endif

    }
    WAIT_ALL_BAR();
    lrun += __shfl_xor(lrun, 32);
    const float inv = 1.0f / lrun;
    float lam;
    { float s1 = 0.f, s2 = 0.f; const float a1 = p.in[10][lane] * p.in[11][lane], a2 = p.in[12][lane] * p.in[13][lane]; s1 = wave_sum(a1); s2 = wave_sum(a2);
      const float lam_init = 0.8f - 0.6f * 1.0f;
      lam = expf(s1) - expf(s2) + lam_init; }
    LAS float* xch = (LAS float*)lds + qs * 4096;
    if (map == 1) {
#pragma unroll
        for (int c = 0; c < 4; ++c)
#pragma unroll
            for (int r = 0; r < 16; ++r) xch[(32 * c + crow(r, hi)) * 32 + r32] = o[c][r] * inv * lam;
    }
    __syncthreads();
    if (map == 0) {
        float ss = 0.f;
#pragma unroll
        for (int c = 0; c < 4; ++c)
#pragma unroll
            for (int r = 0; r < 16; ++r) { const float v = o[c][r] * inv - xch[(32 * c + crow(r, hi)) * 32 + r32]; o[c][r] = v; ss += v * v; }
        ss += __shfl_xor(ss, 32);
        const float rstd = 1.0f / sqrtf(ss * (1.0f / 128.0f) + NORM_EPS) * 0.8f;
        const float* sub = p.in[14];
        bf16_t* orow = CAT + (rowbase + qrow) * D + 512 + hd * 128;
#pragma unroll
        for (int c = 0; c < 4; ++c)
#pragma unroll
            for (int rq = 0; rq < 4; ++rq) { const int e0 = 32 * c + 8 * rq + 4 * hi; const f32x4 sv = *(const f32x4*)(sub + e0);
                u32x2 w; w.x = cvt_pk_bf16(o[c][4 * rq] * rstd * sv[0], o[c][4 * rq + 1] * rstd * sv[1]); w.y = cvt_pk_bf16(o[c][4 * rq + 2] * rstd * sv[2], o[c][4 * rq + 3] * rstd * sv[3]);
                *(u32x2*)(orow + e0) = w; }
    }
    __syncthreads();
}

__device__ __forceinline__ void mlstm_s1_unit(const Params& p, LAS unsigned char* lds, int bh, int c, int tid_, int wave, int lane_) {
    int tid = tid_; asm volatile("" : "+v"(tid)); const int lane = tid & 63;
    const bf16_t* P = (const bf16_t*)(p.ws + WS_P);
    const int b = bh >> 2, hd = bh & 3, r32 = lane & 31, hi = lane >> 5;
    const size_t t0 = (size_t)b * SEQ + (size_t)c * MCH;
    const float* SA = (const float*)(p.ws + WS_SA) + (size_t)bh * SEQ + c * MCH;
    LAS float* fs = (LAS float*)(lds + MISC_OFF) + MW_F;
    LAS float* wsm = fs;
    LAS float* red = fs + 256;
    float av = (tid < 256) ? SA[tid] : -INFINITY;
    float mx = av;
#pragma unroll
    for (int o = 1; o < 64; o <<= 1) mx = fmaxf(mx, __shfl_xor(mx, o));
    if (lane == 0) red[wave] = mx;
    __syncthreads();
    float R = red[0];
#pragma unroll
    for (int w = 1; w < 4; ++w) R = fmaxf(R, red[w]);
    if (tid < 256) wsm[tid] = __expf(av - R) * 0.08838834764831845f;
    __syncthreads();
    LAS unsigned char* Kl = lds; LAS unsigned char* Vl = lds + 65536;
    const bf16_t* Kg = P + t0 * NP + P_MK + hd * 128; const bf16_t* Vg = P + t0 * NP + P_MV + hd * 128;
#pragma unroll
    for (int i = 0; i < 8; ++i) { const int n = tid + 512 * i, row = n >> 4, ch = n & 15;
        const u32x4 kv = *(const u32x4*)(Kg + (size_t)row * NP + ch * 8); const u32x4 vv = *(const u32x4*)(Vg + (size_t)row * NP + ch * 8);
        const float w = wsm[row]; u32x4 ks;
#pragma unroll
        for (int q = 0; q < 4; ++q) ks[q] = cvt_pk_bf16(bf_lo(kv[q]) * w, bf_hi(kv[q]) * w);
        *(LAS u32x4*)(Kl + off_b(row, ch)) = ks; *(LAS u32x4*)(Vl + off_b(row, ch)) = vv; }
    __syncthreads();
    const int eb = wave >> 1, dh = wave & 1;
    const unsigned q4 = (lane & 15) >> 2, pp = lane & 3, blk = (lane >> 4) & 1;
    f32x16 acc[2]; acc[0] = (f32x16){}; acc[1] = (f32x16){};
    for (int ks = 0; ks < 16; ++ks) {
        const unsigned row0 = 16u * ks + 8u * hi + q4, row1 = row0 + 4u;
        const unsigned cha = (unsigned)(4 * eb + 2 * blk + (pp >> 1));
        const bf16x8 af = cat8(vtr(Vl + off_b(row0, cha) + 8u * (pp & 1)), vtr(Vl + off_b(row1, cha) + 8u * (pp & 1)));
#pragma unroll
        for (int db = 0; db < 2; ++db) { const unsigned chb = (unsigned)(4 * (2 * dh + db) + 2 * blk + (pp >> 1));
            const bf16x8 bfr = cat8(vtr(Kl + off_b(row0, chb) + 8u * (pp & 1)), vtr(Kl + off_b(row1, chb) + 8u * (pp & 1)));
            acc[db] = __builtin_amdgcn_mfma_f32_32x32x16_bf16(af, bfr, acc[db], 0, 0, 0); }
    }
    const int unit = bh * NCH + c;
    float* UT = (float*)(p.ws + WS_UT) + (size_t)unit * 16384;
#pragma unroll
    for (int db = 0; db < 2; ++db)
#pragma unroll
        for (int r = 0; r < 16; ++r) UT[(32 * eb + crow(r, hi)) * 128 + 64 * dh + 32 * db + r32] = acc[db][r];
    if (tid < 128) { float s = 0.f; const int d = tid;
        for (int srow = 0; srow < 256; ++srow) { const unsigned short hv = *(const LAS unsigned short*)(Kl + off_b(srow, d >> 3) + (d & 7) * 2); s += __uint_as_float((unsigned)hv << 16); }
        ((float*)(p.ws + WS_UN))[(size_t)unit * 128 + d] = s; }
    if (tid == 0) ((float*)(p.ws + WS_UR))[unit] = R;
    __syncthreads();
}

__device__ __forceinline__ void mlstm_s3_unit(const Params& p, LAS unsigned char* lds, int bh, int c, int tid_, int wave, int lane_) {
    int tid = tid_; asm volatile("" : "+v"(tid)); const int lane = tid & 63;
    const bf16_t* P = (const bf16_t*)(p.ws + WS_P); bf16_t* CAT = (bf16_t*)(p.ws + WS_CAT);
    const int b = bh >> 2, hd = bh & 3, r32 = lane & 31, hi = lane >> 5;
    const size_t t0 = (size_t)b * SEQ + (size_t)c * MCH;
    const size_t so = (size_t)bh * SEQ + c * MCH;
    const float* SA = (const float*)(p.ws + WS_SA) + so; const float* SAM = (const float*)(p.ws + WS_SAM) + so; const float* SBA = (const float*)(p.ws + WS_SBA) + so;
    LAS float* fs = (LAS float*)(lds + MISC_OFF) + MW_F;
    LAS float* as = fs;
    LAS float* nC = fs + 256;
    LAS unsigned char* Ct = lds + 65536;
    const int qloc = 32 * wave + r32;
    const float Aq = SAM[qloc], BAq = SBA[qloc];
    if (tid < 256) as[tid] = SA[tid];
    bf16x8 qf[8];
    { const bf16_t* qp = P + (t0 + qloc) * NP + P_MQ + hd * 128 + hi * 8;
#pragma unroll
      for (int ks = 0; ks < 8; ++ks) qf[ks] = *(const bf16x8*)(qp + ks * 16); }
    const bf16_t* Kg = P + t0 * NP + P_MK + hd * 128; const bf16_t* Vg = P + t0 * NP + P_MV + hd * 128;
#if defined(S3_REGSTAGE)
    { TileRegs k0 = tile_load(Kg, tid), v0 = tile_load(Vg, tid); tile_write(lds, tid, k0); tile_write(lds + 16384, tid, v0); }
#elif !defined(S3_SERIAL)
    tile_dma(Kg, lds, wave, lane); tile_dma(Vg, lds + 16384, wave, lane);
#endif
    f32x16 o[4];
#pragma unroll
    for (int cb = 0; cb < 4; ++cb) o[cb] = (f32x16){};
    float den = 0.f, fst = 0.f;
    const unsigned xr = ((unsigned)(r32 & 3) << 2) | ((unsigned)(r32 >> 2) & 3u);
    if (c > 0) {
        const float* UR = (const float*)(p.ws + WS_UR) + bh * NCH; const float* UT = (const float*)(p.ws + WS_UT) + (size_t)bh * NCH * 16384; const float* UN = (const float*)(p.ws + WS_UN) + (size_t)bh * NCH * 128;
        float Pref = -INFINITY, ur[7];
#pragma unroll
        for (int j = 0; j < 7; ++j) { ur[j] = UR[j]; if (j < c) Pref = fmaxf(Pref, ur[j]); }
        float cf[7];
#pragma unroll
        for (int j = 0; j < 7; ++j) cf[j] = (j < c) ? __expf(ur[j] - Pref) : 0.f;
#pragma unroll 1
        for (int i = 0; i < 4; ++i) { const int n = tid + 512 * i, e = n >> 4, ch = n & 15; f32x4 u0[7], u1[7];
#pragma unroll
            for (int j = 0; j < 7; ++j) { const f32x4* up = (const f32x4*)(UT + (size_t)j * 16384 + e * 128 + ch * 8); u0[j] = up[0]; u1[j] = up[1]; }
            f32x4 s0 = (f32x4){0.f, 0.f, 0.f, 0.f}, s1 = s0;
#pragma unroll
            for (int j = 0; j < 7; ++j) { s0 += u0[j] * cf[j]; s1 += u1[j] * cf[j]; }
            u32x4 w; w.x = cvt_pk_bf16(s0[0], s0[1]); w.y = cvt_pk_bf16(s0[2], s0[3]); w.z = cvt_pk_bf16(s1[0], s1[1]); w.w = cvt_pk_bf16(s1[2], s1[3]);
            *(LAS u32x4*)(Ct + off_b(e, ch)) = w; }
        if (tid < 128) { float sN = 0.f;
#pragma unroll
            for (int j = 0; j < 7; ++j) sN += cf[j] * UN[j * 128 + tid];
            nC[tid] = sN; }
        fst = __expf(Pref - Aq);
    }
    asm volatile("" :: "v"(qf[0]), "v"(qf[1]), "v"(qf[2]), "v"(qf[3]), "v"(qf[4]), "v"(qf[5]), "v"(qf[6]), "v"(qf[7]), "v"(Aq), "v"(BAq));
    WAIT_ALL_BAR();
    if (c > 0) {
#pragma unroll
        for (int cb = 0; cb < 4; ++cb) {
#pragma unroll
            for (int ks = 0; ks < 8; ++ks) { const unsigned ch = (unsigned)(2 * ks + hi) ^ xr;
                const bf16x8 cfr = *(const LAS bf16x8*)(Ct + 256u * (32 * cb + r32) + 16u * ch);
                o[cb] = __builtin_amdgcn_mfma_f32_32x32x16_bf16(cfr, qf[ks], o[cb], 0, 0, 0); }
            __builtin_amdgcn_sched_barrier(0); }
#pragma unroll
        for (int cb = 0; cb < 4; ++cb)
#pragma unroll
            for (int r = 0; r < 16; ++r) o[cb][r] *= fst;
        float dq = 0.f;
#pragma unroll
        for (int ks = 0; ks < 8; ++ks)
#pragma unroll
            for (int q = 0; q < 4; ++q) { const unsigned w = ((const unsigned*)&qf[ks])[q]; const int d = 16 * ks + 8 * hi + 2 * q; dq += bf_lo(w) * nC[d] + bf_hi(w) * nC[d + 1]; }
        den = fst * dq;
    }
    const unsigned q4 = (lane & 15) >> 2, pp = lane & 3, blk = (lane >> 4) & 1;
#pragma unroll 1
    for (int j = 0; j < 4; ++j) {
        WAIT_ALL_BAR();
        const LAS unsigned char* Kt = lds + (j & 1) * 32768; const LAS unsigned char* Vt = Kt + 16384;
#if defined(S3_REGSTAGE)
        TileRegs kr, vr; if (j + 1 < 4) { kr = tile_load(Kg + (size_t)(j + 1) * 64 * NP, tid); vr = tile_load(Vg + (size_t)(j + 1) * 64 * NP, tid); }
#elif defined(S3_SERIAL)
        { LAS unsigned char* nb = lds + (j & 1) * 32768; tile_dma(Kg + (size_t)j * 64 * NP, nb, wave, lane); tile_dma(Vg + (size_t)j * 64 * NP, nb + 16384, wave, lane); }
        WAIT_ALL_BAR();
#else
        if (j + 1 < 4) { LAS unsigned char* nb = lds + ((j + 1) & 1) * 32768; tile_dma(Kg + (size_t)(j + 1) * 64 * NP, nb, wave, lane); tile_dma(Vg + (size_t)(j + 1) * 64 * NP, nb + 16384, wave, lane); }
#endif
        const bool doit = (64 * j <= 32 * wave + 31);
        bf16x8 pf[4];
        if (doit) {
            f32x16 p0 = (f32x16){}, p1 = (f32x16){};
#pragma unroll
            for (int ks = 0; ks < 8; ++ks) { const unsigned ch = (unsigned)(2 * ks + hi) ^ xr;
                const bf16x8 k0 = *(const LAS bf16x8*)(Kt + 256u * r32 + 16u * ch), k1 = *(const LAS bf16x8*)(Kt + 256u * (32 + r32) + 16u * ch);
                p0 = __builtin_amdgcn_mfma_f32_32x32x16_bf16(k0, qf[ks], p0, 0, 0, 0); p1 = __builtin_amdgcn_mfma_f32_32x32x16_bf16(k1, qf[ks], p1, 0, 0, 0); if ((ks & 3) == 3) __builtin_amdgcn_sched_barrier(0); }
            float ps = 0.f;
#pragma unroll
            for (int r = 0; r < 16; ++r) { const int kv = 64 * j + crow(r, hi);
                const float w0 = (kv <= qloc) ? __expf(as[kv] - Aq) * 0.08838834764831845f : 0.f, w1 = (kv + 32 <= qloc) ? __expf(as[kv + 32] - Aq) * 0.08838834764831845f : 0.f;
                p0[r] *= w0; p1[r] *= w1; ps += p0[r] + p1[r]; }
            den += ps;
#pragma unroll
            for (int ks = 0; ks < 4; ++ks) { u32x4 w;
#pragma unroll
                for (int q = 0; q < 4; ++q) { const int r = 8 * (ks & 1) + 2 * q; w[q] = (ks < 2) ? cvt_pk_bf16(p0[r], p0[r + 1]) : cvt_pk_bf16(p1[r], p1[r + 1]); }
                pf[ks] = __builtin_bit_cast(bf16x8, w); }
        }
        WAIT_ALL_BAR();
        if (doit) {
            bf16x8 vf[2][4];
#define S3_LOADV(buf, ks_) do { _Pragma("unroll") for (int cb = 0; cb < 4; ++cb) { const unsigned chv = (unsigned)(4 * cb + 2 * blk + (pp >> 1)); const unsigned row0 = 16u * (ks_) + 4u * hi + q4; \
                vf[buf][cb] = cat8(vtr(Vt + off_b(row0, chv) + 8u * (pp & 1)), vtr(Vt + off_b(row0 + 8u, chv) + 8u * (pp & 1))); } } while (0)
            S3_LOADV(0, 0);
#pragma unroll
            for (int ks = 0; ks < 4; ++ks) {
                if (ks < 3) S3_LOADV((ks + 1) & 1, ks + 1);
                __builtin_amdgcn_sched_barrier(0);
#pragma unroll
                for (int cb = 0; cb < 4; ++cb) o[cb] = __builtin_amdgcn_mfma_f32_32x32x16_bf16(vf[ks & 1][cb], pf[ks], o[cb], 0, 0, 0);
                __builtin_amdgcn_sched_barrier(0);
            }
#undef S3_LOADV
        }
#if defined(S3_REGSTAGE)
        if (j + 1 < 4) { LAS unsigned char* nb = lds + ((j + 1) & 1) * 32768; tile_write(nb, tid, kr); tile_write(nb + 16384, tid, vr); }
#endif
    }
    den += __shfl_xor(den, 32);
    const float dinv = 1.0f / fmaxf(fabsf(den), __expf(-BAq));
    float sm = 0.f;
#pragma unroll
    for (int cb = 0; cb < 4; ++cb)
#pragma unroll
        for (int r = 0; r < 16; ++r) { o[cb][r] *= dinv; sm += o[cb][r]; }
    sm += __shfl_xor(sm, 32);
    const float mu = sm * (1.0f / 128.0f);
    float vs = 0.f;
#pragma unroll
    for (int cb = 0; cb < 4; ++cb)
#pragma unroll
        for (int r = 0; r < 16; ++r) { o[cb][r] -= mu; vs += o[cb][r] * o[cb][r]; }
    vs += __shfl_xor(vs, 32);
    const float rstd = 1.0f / sqrtf(vs * (1.0f / 128.0f) + NORM_EPS);
    const float* hn = p.in[9] + hd * 128;
    const bf16_t* mo = P + (t0 + qloc) * NP + P_MO + hd * 128;
    bf16_t* orow = CAT + (t0 + qloc) * D + hd * 128;
    u32x2 mw[4][4];
#pragma unroll
    for (int cb = 0; cb < 4; ++cb)
#pragma unroll
        for (int rq = 0; rq < 4; ++rq) mw[cb][rq] = *(const u32x2*)(mo + 32 * cb + 8 * rq + 4 * hi);
#pragma unroll
    for (int cb = 0; cb < 4; ++cb)
#pragma unroll
        for (int rq = 0; rq < 4; ++rq) { const int e0 = 32 * cb + 8 * rq + 4 * hi; const f32x4 hv = *(const f32x4*)(hn + e0); const u32x2 m2 = mw[cb][rq];
            const float g0 = fast_rcp(1.0f + __expf(-bf_lo(m2.x))), g1 = fast_rcp(1.0f + __expf(-bf_hi(m2.x))), g2 = fast_rcp(1.0f + __expf(-bf_lo(m2.y))), g3 = fast_rcp(1.0f + __expf(-bf_hi(m2.y)));
            u32x2 w; w.x = cvt_pk_bf16(o[cb][4 * rq] * rstd * hv[0] * g0, o[cb][4 * rq + 1] * rstd * hv[1] * g1); w.y = cvt_pk_bf16(o[cb][4 * rq + 2] * rstd * hv[2] * g2, o[cb][4 * rq + 3] * rstd * hv[3] * g3);
            *(u32x2*)(orow + e0) = w; }
    WAIT_ALL_BAR();
}

__device__ __forceinline__ void mlstm_seq_unit(const Params& p, LAS unsigned char* lds, int bh, int tid_, int wave, int lane_) {
    int tid = tid_; asm volatile("" : "+v"(tid)); const int lane = tid & 63;
    const bf16_t* P = (const bf16_t*)(p.ws + WS_P); bf16_t* CAT = (bf16_t*)(p.ws + WS_CAT);
    const int b = bh >> 2, hd = bh & 3, r32 = lane & 31, hi = lane >> 5;
    LAS float* fs = (LAS float*)(lds + MISC_OFF) + MW_F;
    LAS float* as = fs;
    LAS float* nC = fs + 256;
    LAS float* wsc = fs + 384;
    LAS unsigned char* Ct = lds + 65536;
    const unsigned xr = ((unsigned)(r32 & 3) << 2) | ((unsigned)(r32 >> 2) & 3u);
    const unsigned q4 = (lane & 15) >> 2, pp = lane & 3, blk = (lane >> 4) & 1;
    const int eb = wave >> 1, dh = wave & 1;
    f32x16 cacc[2]; cacc[0] = (f32x16){}; cacc[1] = (f32x16){};
    float nrun = 0.f;
    float Prun = -INFINITY;
    LAS float* hnl = fs + 896;
    if (tid < 128) hnl[tid] = p.in[9][hd * 128 + tid];
#pragma unroll 1
    for (int c = 0; c < NCH; ++c) {
        const size_t t0 = (size_t)b * SEQ + (size_t)c * MCH;
        const size_t so = (size_t)bh * SEQ + c * MCH;
        const float* SA = (const float*)(p.ws + WS_SA) + so; const float* SAM = (const float*)(p.ws + WS_SAM) + so; const float* SBA = (const float*)(p.ws + WS_SBA) + so;
        const int qloc = 32 * wave + r32;
        const float Aq2 = SAM[qloc] * 1.4426950408889634f;
        if (tid < 256) as[tid] = SA[tid] * 1.4426950408889634f;
        bf16x8 qf[2];
        LAS bf16x8* qpark = (LAS bf16x8*)(lds + 98304 + tid * 64);
        LAS bf16x8* qpark2 = (LAS bf16x8*)(lds + 147456 + tid * 32);
        { const bf16_t* qp = P + (t0 + qloc) * NP + P_MQ + hd * 128 + hi * 8;
#pragma unroll
          for (int ks = 0; ks < 2; ++ks) qf[ks] = *(const bf16x8*)(qp + ks * 16);
#pragma unroll
          for (int ks = 2; ks < 6; ++ks) qpark[ks - 2] = *(const bf16x8*)(qp + ks * 16);
#pragma unroll
          for (int ks = 6; ks < 8; ++ks) qpark2[ks - 6] = *(const bf16x8*)(qp + ks * 16); }
#define QFRAG(ks) ((ks) < 2 ? qf[(ks) & 1] : ((ks) < 6 ? qpark[((ks) - 2) & 3] : qpark2[((ks) - 6) & 1]))
        const bf16_t* Kg = P + t0 * NP + P_MK + hd * 128; const bf16_t* Vg = P + t0 * NP + P_MV + hd * 128;
        tile_dma(Kg, lds, wave, lane); tile_dma(Vg, lds + 16384, wave, lane);
        asm volatile("" :: "v"(qf[0]), "v"(qf[1]), "v"(Aq2));
        WAIT_ALL_BAR();
        float R = fmaxf(fmaxf(as[lane], as[lane + 64]), fmaxf(as[lane + 128], as[lane + 192]));
#pragma unroll
        for (int o = 1; o < 64; o <<= 1) R = fmaxf(R, __shfl_xor(R, o));
        R *= (1.0f / 1.4426950408889634f);
        const float Pnew = fmaxf(Prun, R);
        const float scC = (c > 0) ? __expf(Prun - Pnew) : 0.f;
        if (tid < 256) wsc[tid] = fast_exp2(as[tid] - Pnew * 1.4426950408889634f) * 0.08838834764831845f;
        f32x16 o[4];
#pragma unroll
        for (int cb = 0; cb < 4; ++cb) o[cb] = (f32x16){};
        float den = 0.f;
        if (c > 0) {
#pragma unroll
            for (int cb = 0; cb < 4; ++cb) {
#pragma unroll
                for (int ks = 0; ks < 8; ++ks) { const unsigned ch = (unsigned)(2 * ks + hi) ^ xr;
                    const bf16x8 cfr = *(const LAS bf16x8*)(Ct + 256u * (32 * cb + r32) + 16u * ch);
                    const bf16x8 qv = QFRAG(ks);
                    o[cb] = __builtin_amdgcn_mfma_f32_32x32x16_bf16(cfr, qv, o[cb], 0, 0, 0); }
                __builtin_amdgcn_sched_barrier(0); }
            const float fst = fast_exp2(Prun * 1.4426950408889634f - Aq2);
#pragma unroll
            for (int cb = 0; cb < 4; ++cb)
#pragma unroll
                for (int r = 0; r < 16; ++r) o[cb][r] *= fst;
            float dq = 0.f;
#pragma unroll
            for (int ks = 0; ks < 8; ++ks) { const bf16x8 qv = QFRAG(ks);
#pragma unroll
                for (int q = 0; q < 4; ++q) { const unsigned w = ((const unsigned*)&qv)[q]; const int d = 16 * ks + 8 * hi + 2 * q; dq += bf_lo(w) * nC[d] + bf_hi(w) * nC[d + 1]; } }
            den = fst * dq;
#pragma unroll
            for (int r = 0; r < 16; ++r) { cacc[0][r] *= scC; cacc[1][r] *= scC; }
        }
        nrun *= scC;
#pragma unroll 1
        for (int j = 0; j < 4; ++j) {
            WAIT_ALL_BAR();
            const LAS unsigned char* Kt = lds + (j & 1) * 32768; const LAS unsigned char* Vt = Kt + 16384;
            if (j + 1 < 4) { LAS unsigned char* nb = lds + ((j + 1) & 1) * 32768; tile_dma(Kg + (size_t)(j + 1) * 64 * NP, nb, wave, lane); tile_dma(Vg + (size_t)(j + 1) * 64 * NP, nb + 16384, wave, lane); }
            const bool doit = (64 * j <= 32 * wave + 31);
            if (doit) {
                float ps = 0.f;
#pragma unroll
                for (int hf = 0; hf < 2; ++hf) {
                    f32x16 pp0 = (f32x16){};
#pragma unroll
                    for (int ks = 0; ks < 8; ++ks) { const unsigned ch = (unsigned)(2 * ks + hi) ^ xr;
                        const bf16x8 k0 = *(const LAS bf16x8*)(Kt + 256u * (32 * hf + r32) + 16u * ch);
                        const bf16x8 qv = QFRAG(ks);
                        pp0 = __builtin_amdgcn_mfma_f32_32x32x16_bf16(k0, qv, pp0, 0, 0, 0); }
#pragma unroll
                    for (int r = 0; r < 16; ++r) { const int kv = 64 * j + 32 * hf + crow(r, hi);
                        const float w0 = (kv <= qloc) ? fast_exp2(as[kv] - Aq2) * 0.08838834764831845f : 0.f;
                        pp0[r] *= w0; ps += pp0[r]; }
                    bf16x8 pfh[2];
#pragma unroll
                    for (int k2 = 0; k2 < 2; ++k2) { u32x4 w;
#pragma unroll
                        for (int q = 0; q < 4; ++q) { const int r = 8 * k2 + 2 * q; w[q] = cvt_pk_bf16(pp0[r], pp0[r + 1]); }
                        pfh[k2] = __builtin_bit_cast(bf16x8, w); }
                    __builtin_amdgcn_sched_barrier(0);
#pragma unroll
                    for (int k2 = 0; k2 < 2; ++k2)
#pragma unroll
                        for (int c2 = 0; c2 < 2; ++c2) {
                            bf16x8 vf[2];
#pragma unroll
                            for (int u = 0; u < 2; ++u) { const int cb = 2 * c2 + u; const unsigned chv = (unsigned)(4 * cb + 2 * blk + (pp >> 1)); const unsigned row0 = 16u * (2 * hf + k2) + 4u * hi + q4;
                                vf[u] = cat8(vtr(Vt + off_b(row0, chv) + 8u * (pp & 1)), vtr(Vt + off_b(row0 + 8u, chv) + 8u * (pp & 1))); }
                            o[2 * c2] = __builtin_amdgcn_mfma_f32_32x32x16_bf16(vf[0], pfh[k2], o[2 * c2], 0, 0, 0); o[2 * c2 + 1] = __builtin_amdgcn_mfma_f32_32x32x16_bf16(vf[1], pfh[k2], o[2 * c2 + 1], 0, 0, 0);
                            __builtin_amdgcn_sched_barrier(0);
                        }
                }
                den += ps;
            }
#pragma unroll
            for (int ks = 0; ks < 4; ++ks) {
                const unsigned row0 = 16u * ks + 8u * hi + q4, row1 = row0 + 4u;
                const unsigned cha = (unsigned)(4 * eb + 2 * blk + (pp >> 1));
                const bf16x8 af = cat8(vtr(Vt + off_b(row0, cha) + 8u * (pp & 1)), vtr(Vt + off_b(row1, cha) + 8u * (pp & 1)));
                const f32x4 wa = *(const LAS f32x4*)(wsc + 64 * j + 16 * ks + 8 * hi), wb = *(const LAS f32x4*)(wsc + 64 * j + 16 * ks + 8 * hi + 4);
#pragma unroll
                for (int db = 0; db < 2; ++db) { const unsigned chb = (unsigned)(4 * (2 * dh + db) + 2 * blk + (pp >> 1));
                    const s16x4 k0 = vtr(Kt + off_b(row0, chb) + 8u * (pp & 1)), k1 = vtr(Kt + off_b(row1, chb) + 8u * (pp & 1));
                    const u32x2 u0 = __builtin_bit_cast(u32x2, k0), u1 = __builtin_bit_cast(u32x2, k1);
                    u32x4 kw; kw.x = cvt_pk_bf16(bf_lo(u0.x) * wa[0], bf_hi(u0.x) * wa[1]); kw.y = cvt_pk_bf16(bf_lo(u0.y) * wa[2], bf_hi(u0.y) * wa[3]);
                    kw.z = cvt_pk_bf16(bf_lo(u1.x) * wb[0], bf_hi(u1.x) * wb[1]); kw.w = cvt_pk_bf16(bf_lo(u1.y) * wb[2], bf_hi(u1.y) * wb[3]);
                    cacc[db] = __builtin_amdgcn_mfma_f32_32x32x16_bf16(af, __builtin_bit_cast(bf16x8, kw), cacc[db], 0, 0, 0); }
                __builtin_amdgcn_sched_barrier(0);
            }
            { const int d = tid & 127, sq = tid >> 7; float sN = 0.f;
#pragma unroll 4
                for (int s2 = 0; s2 < 16; ++s2) { const int srow = 16 * sq + s2; const unsigned short hv = *(const LAS unsigned short*)(Kt + off_b(srow, d >> 3) + (d & 7) * 2); sN += __uint_as_float((unsigned)hv << 16) * wsc[64 * j + srow]; }
                nrun += sN; }
            WAIT_ALL_BAR();
        }
        int tid2 = tid_; asm volatile("" : "+v"(tid2));
        const int qloc2 = 32 * wave + (tid2 & 31), hi2 = (tid2 >> 5) & 1;
        const float BAq = SBA[qloc2];
        den += __shfl_xor(den, 32);
        const float dinv = 1.0f / fmaxf(fabsf(den), __expf(-BAq));
        float sm = 0.f;
#pragma unroll
        for (int cb = 0; cb < 4; ++cb)
#pragma unroll
            for (int r = 0; r < 16; ++r) { o[cb][r] *= dinv; sm += o[cb][r]; }
        sm += __shfl_xor(sm, 32);
        const float mu = sm * (1.0f / 128.0f);
        float vs = 0.f;
#pragma unroll
        for (int cb = 0; cb < 4; ++cb)
#pragma unroll
            for (int r = 0; r < 16; ++r) { o[cb][r] -= mu; vs += o[cb][r] * o[cb][r]; }
        vs += __shfl_xor(vs, 32);
        const float rstd = 1.0f / sqrtf(vs * (1.0f / 128.0f) + NORM_EPS);
        const bf16_t* mo = P + (t0 + qloc2) * NP + P_MO + hd * 128 + 4 * hi2;
        bf16_t* orow = CAT + (t0 + qloc2) * D + hd * 128 + 4 * hi2;
#pragma unroll
        for (int c2 = 0; c2 < 2; ++c2) {
            u32x2 mw[8];
#pragma unroll
            for (int u = 0; u < 8; ++u) mw[u] = *(const u32x2*)(mo + 32 * (2 * c2 + (u >> 2)) + 8 * (u & 3));
#pragma unroll
            for (int u = 0; u < 8; ++u) { const int cb = 2 * c2 + (u >> 2), rq = u & 3; const int e0 = 32 * cb + 8 * rq; const u32x2 m2 = mw[u]; const f32x4 hv = *(const LAS f32x4*)(hnl + e0 + 4 * hi2);
                const float g0 = fast_rcp(1.0f + fast_exp2(-1.4426950408889634f * bf_lo(m2.x))), g1 = fast_rcp(1.0f + fast_exp2(-1.4426950408889634f * bf_hi(m2.x))), g2 = fast_rcp(1.0f + fast_exp2(-1.4426950408889634f * bf_lo(m2.y))), g3 = fast_rcp(1.0f + fast_exp2(-1.4426950408889634f * bf_hi(m2.y)));
                u32x2 w; w.x = cvt_pk_bf16(o[cb][4 * rq] * rstd * hv[0] * g0, o[cb][4 * rq + 1] * rstd * hv[1] * g1); w.y = cvt_pk_bf16(o[cb][4 * rq + 2] * rstd * hv[2] * g2, o[cb][4 * rq + 3] * rstd * hv[3] * g3);
                *(u32x2*)(orow + e0) = w; }
            __builtin_amdgcn_sched_barrier(0); }
        if (c + 1 < NCH) {
#pragma unroll
            for (int db = 0; db < 2; ++db)
#pragma unroll
                for (int r = 0; r < 16; ++r) { const int e = 32 * eb + crow(r, hi), d = 64 * dh + 32 * db + r32;
                    *(LAS unsigned short*)(Ct + off_b(e, d >> 3) + (d & 7) * 2) = (unsigned short)(cvt_pk_bf16(cacc[db][r], 0.f) & 0xffffu); }
            wsc[tid] = nrun;
        }
        Prun = Pnew;
        WAIT_ALL_BAR();
        if (c + 1 < NCH) { if (tid < 128) nC[tid] = (wsc[tid] + wsc[tid + 128]) + (wsc[tid + 256] + wsc[tid + 384]); }
    }
#undef QFRAG
}

__device__ __forceinline__ int moe_table(LAS unsigned char* lds, unsigned* cnt, int tid) {
    LAS int* misc = (LAS int*)(lds + MISC_OFF);
    __syncthreads();
    if (tid == 0) { int acc = 0; for (int e = 0; e < 16; ++e) { const int c = (int)__hip_atomic_load(cnt + e * 64, __ATOMIC_RELAXED, __HIP_MEMORY_SCOPE_AGENT); misc[MW_CN + e] = c; misc[MW_TB + e] = acc; acc += (c + 255) >> 8; } misc[MW_TB + 16] = acc; }
    __syncthreads();
    return misc[MW_TB + 16];
}

#ifndef STAGGER_MASK
#define STAGGER_MASK 0u
#endif
#ifndef STAGGER_GROUPS
#define STAGGER_GROUPS 4
#endif
#ifndef STAGGER_TICKS
#define STAGGER_TICKS 700
#endif
__device__ __forceinline__ void stagger(int vcu, int phase_bit) {
    if (!((STAGGER_MASK >> phase_bit) & 1u)) return;
    const int g = vcu & (STAGGER_GROUPS - 1); if (g == 0) return;
    const unsigned long long t0 = __builtin_amdgcn_s_memrealtime(); const unsigned long long w = (unsigned long long)g * STAGGER_TICKS;
    while (__builtin_amdgcn_s_memrealtime() - t0 < w) __builtin_amdgcn_s_sleep(8);
}
constexpr int LATE_UNITS = 224, LATE_UNITS_A = 160, LATE_UNITS_B = 64, CW_LATEQ = CW_QUEUE + 64 * 8;
template <int QID>
__device__ __forceinline__ void late_convert(const Params& p, LAS unsigned char* lds, unsigned* ctl, int quota, int tid, int wave, int lane) {
    volatile LAS unsigned* misc = (volatile LAS unsigned*)(lds + MISC_OFF);
    for (int k = 0; k < quota; ++k) {
        __syncthreads();
        if (tid == 0) misc[MW_Q] = __hip_atomic_fetch_add(ctl + CW_LATEQ + 64 * QID, 1u, __ATOMIC_RELAXED, __HIP_MEMORY_SCOPE_AGENT);
        __syncthreads();
        const int q = (int)misc[MW_Q];
        if (q >= 4 * (QID == 0 ? LATE_UNITS_A : LATE_UNITS_B)) break;
        const int c = q >> 2, sub = q & 3;
        const int v = QID == 0 ? (c < 32 ? 8 + c : 232 + 12 * ((c - 32) >> 3) + ((c - 32) & 7)) : 232 + 12 * (c >> 2) + 8 + (c & 3);
        const int f = WT_I1 + 64 * v + 16 * sub + 2 * wave;
        phase_prologue_weights(p, lds, f, f + 2, 1, wave, lane);
    }
    __syncthreads();
}
template <int LAYER>
__device__ __forceinline__ void moe_block(const Params& p, LAS unsigned char* lds, const XcdBarrier& bar, unsigned* ctl, int tid, int wave, int lane, int vcu, int G) {
    unsigned char* ws = p.ws;
    const LAS int* tb = (const LAS int*)(lds + MISC_OFF) + MW_TB; const LAS int* cn = (const LAS int*)(lds + MISC_OFF) + MW_CN;
    unsigned* cnt = ctl + CW_CNT + LAYER * 16 * 64;
    if (PH(12)) phase_router(p, lds, tid, wave, G, p.in[3] + LAYER * D, p.in[18] + (size_t)LAYER * D * 4, p.in[19] + LAYER * 4, p.in[20] + (size_t)LAYER * D * 16, p.in[21] + LAYER * 16, cnt);
    xcd_barrier(bar);
    const int ntot = moe_table(lds, cnt, tid);
    stagger(vcu, 13);
    for (int rep_ = 0; rep_ < REPS(13); ++rep_) if (PH(13)) { pg8::MoeSched<true> S{(const char*)(ws + WS_XB8), (const char*)(ws + WS_WGU) + (size_t)LAYER * 16 * 1024 * 1024, 512, (size_t)1024 * 1024, tb, cn, (const unsigned*)(ws + WS_ROWTOK), ntot, vcu, G};
      pg8::EpiPair<1> E{nullptr, (bf16_t*)(ws + WS_HM), FF, (const float*)(ws + WS_RSRAW), (const unsigned*)(ws + WS_ROWTOK), tb, cn};
      pg8::gemm_phase<pg8::EpiPair<1>, pg8::MoeSched<true>, true, true>(lds, 512, S, E); }
    const int nun = ntot * 4, rounds_max = (nun + G - 1) / G, rounds_mine = nun > vcu ? (nun - vcu + G - 1) / G : 0;
    if (LATE_CV && LAYER == 0 && PH(0)) late_convert<0>(p, lds, ctl, 2 * (rounds_max - rounds_mine), tid, wave, lane);
    if (LATE_CV && LAYER == 1 && PH(0)) { late_convert<1>(p, lds, ctl, 2 * (rounds_max - rounds_mine), tid, wave, lane); late_convert<1>(p, lds, ctl, 1 << 20, tid, wave, lane); }
    xcd_barrier(bar);
    stagger(vcu, 14);
    for (int rep_ = 0; rep_ < REPS(14); ++rep_) if (PH(14)) { pg8::MoeSched<false> S{(const char*)(ws + WS_HM), (const char*)(ws + WS_WD) + (size_t)LAYER * 16 * 1024 * 512, 256, (size_t)1024 * 512, tb, cn, nullptr, ntot, vcu, G};
      pg8::EpiDown E{(unsigned char*)(ws + WS_YC), (const float*)(ws + WS_CWRAW), tb, cn};
      pg8::gemm_phase<pg8::EpiDown, pg8::MoeSched<false>, false, true>(lds, 256, S, E); }
    if (LATE_CV && LAYER == 0 && PH(0)) { late_convert<0>(p, lds, ctl, rounds_max - rounds_mine, tid, wave, lane); late_convert<0>(p, lds, ctl, 1 << 20, tid, wave, lane); }
    xcd_barrier(bar);
}

__global__ void __launch_bounds__(NTHR, 2) fwd_kernel(Params p) {
    extern __shared__ __attribute__((aligned(16))) unsigned char lds_raw[];
    LAS unsigned char* lds = (LAS unsigned char*)lds_raw;
    const int tid = threadIdx.x, lane = tid & 63, wave = __builtin_amdgcn_readfirstlane(tid >> 6);
    const int G = gridDim.x; const int bx = blockIdx.x;
    const int vcu = (G % 8 == 0) ? (bx % 8) * (G / 8) + bx / 8 : bx;
    const int gw = vcu * NWAVES + wave, NGW = G * NWAVES;
    volatile LAS unsigned* misc = (volatile LAS unsigned*)(lds + MISC_OFF);
    for (int u = tid; u < (LDS_BYTES - MISC_OFF) / 4; u += NTHR) misc[u] = 0u;
    __syncthreads();
    unsigned* ctl = (unsigned*)(p.ws + WS_CTL);
    XcdBarrier bar = xcd_barrier_post(ctl + CW_BAR, misc + MW_BAR);
    unsigned char* ws = p.ws;

    for (int rep_ = 0; rep_ < REPS(0); ++rep_) if (PH(0)) phase_prologue_weights(p, lds, gw, WT_I1, NGW, wave, lane);
    __syncthreads();
    for (int rep_ = 0; rep_ < REPS(1); ++rep_) if (PH(1)) phase_norm_gates(p, lds, tid, gw, NGW, lane);
    xcd_barrier(bar);

    if (PH(2)) phase_gate_scan(p, gw, NGW, lane);
    stagger(vcu, 3);
    for (int rep_ = 0; rep_ < REPS(3); ++rep_) if (PH(3)) { pg8::DenseSched S; S.init(ws + WS_H, ws + WS_WT1, T, NP, 1024, G, bx); pg8::EpiBf16 E{(bf16_t*)(ws + WS_P), NP};
      pg8::gemm_phase<pg8::EpiBf16, pg8::DenseSched, false>(lds, 1024, S, E); }
    xcd_barrier(bar);

    {
        constexpr int NSEQ = NBATCH * 4, NAT = NBATCH * 4 * 16, NMEM = LATE_CV ? WT_UNITS - LATE_UNITS : WT_UNITS;
        for (int u = bx; u < NSEQ; u += G) { for (int r2 = 0; r2 < REPS(16); ++r2) if (PH(4)) mlstm_seq_unit(p, lds, u, tid, wave, lane); }
        for (int rep_ = 0; rep_ < REPS(4); ++rep_) {
            bool a_done = false, m_done = false; int sa_cnt = 0, sm_cnt = 0; (void)sa_cnt; (void)sm_cnt;
            for (int it = 0; !(a_done && m_done); ++it) {
                const int r5 = it % 5; bool want_mem = (r5 == 1 || r5 == 3);
                if (want_mem && m_done) want_mem = false; else if (!want_mem && a_done) want_mem = true;
                __syncthreads();
#ifdef STATIC_Q
                if (tid == 0) { misc[MW_Q] = (unsigned)((want_mem ? sm_cnt : sa_cnt) * G + bx); }
                if (want_mem) ++sm_cnt; else ++sa_cnt;
#else
                if (tid == 0) misc[MW_Q] = __hip_atomic_fetch_add(ctl + CW_QUEUE + 64 * (2 * rep_ + (want_mem ? 1 : 0)), 1u, __ATOMIC_RELAXED, __HIP_MEMORY_SCOPE_AGENT);
#endif
                __syncthreads();
                const int u = (int)misc[MW_Q];
                if (want_mem) {
                    if (u >= NMEM) { m_done = true; continue; }
                    { const int v = LATE_CV ? (u < 8 ? u : u + 32) : u;        for (int r2 = 0; r2 < REPS(18); ++r2) if (PH(0)) { const int f = WT_I1 + 64 * v + 8 * wave; phase_prologue_weights(p, lds, f, f + 8, 1, wave, lane); } }
                } else {
                    if (u >= NAT) { a_done = true; continue; }
                    for (int r2 = 0; r2 < REPS(17); ++r2) if (PH(5)) attn_unit(p, lds, u & 127, 15 - (u >> 7), tid, wave, lane);
                }
            }
        }
    }
    xcd_barrier(bar);

    for (int rep_ = 0; rep_ < REPS(7); ++rep_) if (PH(7)) { pg8::DenseSched S; S.init(ws + WS_CAT, ws + WS_WT2, T, 1024, 1024, G, bx); pg8::EpiResid<true> E{p.in[0], (bf16_t*)(ws + WS_XB), ws + WS_XB8};
      pg8::gemm_phase<pg8::EpiResid<true>, pg8::DenseSched, false>(lds, 1024, S, E); }
    xcd_barrier(bar);

    moe_block<0>(p, lds, bar, ctl, tid, wave, lane, vcu, G);
    if (PH(8)) phase_rows<0, true>(p, lds, tid, wave, lane, G, p.in[2] + D, nullptr, nullptr, nullptr, nullptr, ctl + CW_CNT, nullptr);
    xcd_barrier(bar);
    stagger(vcu, 9);
    for (int rep_ = 0; rep_ < REPS(9); ++rep_) if (PH(9)) { pg8::DenseSched S; S.init(G3_F8 ? ws + WS_XB8 : ws + WS_XB, ws + WS_WT3, T, 3072, G3_F8 ? 512 : 1024, G, bx); pg8::EpiPair<0> E{(bf16_t*)(ws + WS_BG), (bf16_t*)(ws + WS_Z), D, (const float*)(ws + WS_RSTD), nullptr, nullptr, nullptr};
      pg8::gemm_phase<pg8::EpiPair<0>, pg8::DenseSched, false, G3_F8 != 0>(lds, G3_F8 ? 512 : 1024, S, E); }
    xcd_barrier(bar);
    for (int rep_ = 0; rep_ < REPS(10); ++rep_) if (PH(10)) phase_conv(p, gw, NGW, lane);
    xcd_barrier(bar);
    if (PH(11)) { pg8::DenseSched S; S.init(ws + WS_CAT, ws + WS_WT4, T, 1024, 1024, G, bx); pg8::EpiResid<false> E{nullptr, (bf16_t*)(ws + WS_XB), ws + WS_XB8};
      pg8::gemm_phase<pg8::EpiResid<false>, pg8::DenseSched, false>(lds, 1024, S, E); }
    xcd_barrier(bar);
    moe_block<1>(p, lds, bar, ctl, tid, wave, lane, vcu, G);
    if (PH(15)) phase_rows<2, true>(p, lds, tid, wave, lane, G, p.in[4], nullptr, nullptr, nullptr, nullptr, ctl + CW_CNT + 16 * 64, nullptr);
}

extern "C" void kernel_launch(void* const* d_in, const int* in_sizes, int n_in, void* d_out, int out_size, void* d_ws, size_t ws_size, hipStream_t stream) {
    static int grid = 0;
    if (grid == 0) {
        if (n_in != 25 || in_sizes[0] != T * D || out_size != T * D || ws_size < WS_END) { fprintf(stderr, "kernel_launch: unexpected shapes (n_in %d, in0 %d, out %d, ws %zu)\n", n_in, n_in > 0 ? in_sizes[0] : -1, out_size, ws_size); grid = -1; return; }
        int dev = 0, cus = 0, per_cu = 0;
        if (hipGetDevice(&dev) != hipSuccess || hipDeviceGetAttribute(&cus, hipDeviceAttributeMultiprocessorCount, dev) != hipSuccess) { grid = -1; return; }
        if (hipFuncSetAttribute((const void*)fwd_kernel, hipFuncAttributeMaxDynamicSharedMemorySize, LDS_BYTES) != hipSuccess) { fprintf(stderr, "kernel_launch: hipFuncSetAttribute failed\n"); grid = -1; return; }
        if (hipOccupancyMaxActiveBlocksPerMultiprocessor(&per_cu, (const void*)fwd_kernel, NTHR, LDS_BYTES) != hipSuccess || per_cu < 1) fprintf(stderr, "kernel_launch: occupancy query reports %d\n", per_cu);
        (void)hipGetLastError();
        grid = cus;
    }
    if (grid < 0) return;
    hipMemsetAsync((char*)d_ws + WS_CTL, 0, CTL_ZERO_BYTES, stream);
    Params p{};
    for (int i = 0; i < 25; ++i) p.in[i] = (const float*)d_in[i];
    p.out = (float*)d_out; p.ws = (unsigned char*)d_ws;
    hipLaunchKernelGGL(fwd_kernel, dim3(grid), dim3(NTHR), LDS_BYTES, stream, p);
}
```

```cpp
#include <hip/hip_runtime.h>
#include <cstdio>
#include <cstdint>
#ifndef PHASE_MASK
#define PHASE_MASK 0xffffffffu
#endif
#define PH(k) (((PHASE_MASK) >> (k)) & 1u)
#ifndef PHASE_TWICE
#define PHASE_TWICE 0u
#endif
#define REPS(k) (1 + (int)(((PHASE_TWICE) >> (k)) & 1u))

#define LAS __attribute__((address_space(3)))
#define GAS __attribute__((address_space(1)))
typedef unsigned short bf16_t;
typedef short bf16x8 __attribute__((ext_vector_type(8)));
typedef short s16x4 __attribute__((ext_vector_type(4)));
typedef float f32x4 __attribute__((ext_vector_type(4)));
typedef float f32x2 __attribute__((ext_vector_type(2)));
typedef float f32x16 __attribute__((ext_vector_type(16)));
typedef unsigned u32x4 __attribute__((ext_vector_type(4)));
typedef unsigned u32x2 __attribute__((ext_vector_type(2)));
typedef GAS unsigned gu32;
typedef int i32x8 __attribute__((ext_vector_type(8)));
typedef int i32x4 __attribute__((ext_vector_type(4)));

constexpr int D = 1024, NBATCH = 32, SEQ = 2048, T = NBATCH * SEQ;
constexpr int EVEN_IN = 3592, NP = 3584;
constexpr int P_MQ = 0, P_MK = 512, P_MV = 1024, P_MO = 1536, P_DQ = 2048, P_DK = 2560, P_DV = 3072;
constexpr int NE = 16, FF = 512;
constexpr int ECAP = 65536;
constexpr float NORM_EPS = 1e-6f;
constexpr int NWAVES = 8, NTHR = 512;
constexpr int MCH = 256, NCH = SEQ / MCH;
constexpr int WT_I1 = 16 * 112, WT_ITEMS = 28928, WT_UNITS = (WT_ITEMS - WT_I1) / 64;

constexpr size_t MiB = 1u << 20;
constexpr size_t WS_CTL = 0, CTL_ZERO_BYTES = 1 * MiB;
constexpr size_t WS_WT1 = 1 * MiB, WS_WT2 = 8 * MiB, WS_WT3 = 10 * MiB, WS_WT4 = 16 * MiB, WS_WGU = 18 * MiB, WS_WD = 82 * MiB;
constexpr size_t WS_GATES = 114 * MiB, WS_SA = 116 * MiB, WS_SAM = 117 * MiB, WS_SBA = 118 * MiB, WS_UN = 119 * MiB, WS_UR = 119 * MiB + 768 * 1024;
constexpr size_t WS_UT = 120 * MiB;
constexpr size_t WS_ROWTOK = 184 * MiB, WS_CWRAW = 188 * MiB, WS_TOKINFO = 192 * MiB, WS_RSTD = 193 * MiB;
constexpr size_t WS_H = 194 * MiB, WS_CAT = 322 * MiB, WS_P = 450 * MiB;
constexpr size_t WS_RSRAW = 120 * MiB;
constexpr size_t WS_XB8 = 720 * MiB;
constexpr size_t WS_XB = WS_H;
constexpr size_t WS_BG = WS_P, WS_Z = WS_P + 128 * MiB, WS_HM = WS_P, WS_YC = WS_P + 136 * MiB;
constexpr size_t WS_END = 898 * MiB;
constexpr int CW_BAR = 4096;
constexpr int CW_CNT = 16384;
constexpr int CW_QUEUE = 32768;

__device__ __forceinline__ unsigned cvt_pk_bf16(float lo, float hi) { unsigned r; asm volatile("v_cvt_pk_bf16_f32 %0, %1, %2" : "=v"(r) : "v"(lo), "v"(hi)); return r; }
__device__ __forceinline__ unsigned cvt_pk4_fp8(float a, float b, float c, float d) { unsigned w = 0; w = (unsigned)__builtin_amdgcn_cvt_pk_fp8_f32(a, b, (int)w, false); w = (unsigned)__builtin_amdgcn_cvt_pk_fp8_f32(c, d, (int)w, true); return w; }
#ifndef LATE_CV
#define LATE_CV 1
#endif
#ifndef G3_F8
#define G3_F8 1
#endif
constexpr float F8_WSCALE = 64.0f, F8_HSCALE = 16.0f, F8_YSCALE = 64.0f;
__device__ __forceinline__ float bf_lo(unsigned w) { return __uint_as_float(w << 16); }
__device__ __forceinline__ float bf_hi(unsigned w) { return __uint_as_float(w & 0xffff0000u); }
__device__ __forceinline__ float wave_sum(float v) {
#pragma unroll
    for (int o = 1; o < 64; o <<= 1) v += __shfl_xor(v, o);
    return v;
}
__device__ __forceinline__ float fast_exp2(float x) { return __builtin_amdgcn_exp2f(x); }
__device__ __forceinline__ float fast_rcp(float x) { return __builtin_amdgcn_rcpf(x); }
__device__ __forceinline__ int crow(int r, int hi) { return (r & 3) + 8 * (r >> 2) + 4 * hi; }
__device__ __forceinline__ unsigned off_b(unsigned row, unsigned ch) { return 256u * row + 16u * (ch ^ (((row & 3u) << 2) | ((row >> 2) & 3u))); }
__device__ __forceinline__ s16x4 vtr(const LAS unsigned char* p) { return __builtin_bit_cast(s16x4, __builtin_amdgcn_ds_read_tr16_b64_v4i16((LAS s16x4*)p)); }
__device__ __forceinline__ bf16x8 cat8(s16x4 a, s16x4 b) { return (bf16x8){a[0], a[1], a[2], a[3], b[0], b[1], b[2], b[3]}; }

#define XB_TMO      128
#define XB_XCNT(j)  (256  + 64 * (j))
#define XB_XSUB(j)  (1280 + 64 * (j))
#define XB_XGEN(j)  (2304 + 64 * (j))
#define XB_TOP      3328
#define XB_TOPGEN   3392
#define XCD_BAR_WORDS 3456
#define XB_SPIN_CAP (1u << 18)
__device__ __forceinline__ unsigned xb_ld(unsigned* p)              { return __hip_atomic_load(p, __ATOMIC_RELAXED, __HIP_MEMORY_SCOPE_AGENT); }
__device__ __forceinline__ unsigned xb_add(unsigned* p, unsigned v) { return __hip_atomic_fetch_add(p, v, __ATOMIC_RELAXED, __HIP_MEMORY_SCOPE_AGENT); }
__device__ __forceinline__ unsigned xb_xcc_id() { return (unsigned)__builtin_amdgcn_s_getreg((3 << 11) | 20) & 0xFu; }
#define XB_SPIN(cond, bar) do { unsigned _sp = 0; while (cond) { __builtin_amdgcn_s_sleep(1); \
    if ((++_sp & 255u) == 0u) { if (xb_ld(&(bar)[XB_TMO])) break; if (_sp > XB_SPIN_CAP) { atomicAdd(&(bar)[XB_TMO], 1u); break; } } } } while (0)
struct XcdBarrier { unsigned* bar; unsigned x; volatile LAS unsigned* st; };
__device__ __forceinline__ XcdBarrier xcd_barrier_post(unsigned* bar, volatile LAS unsigned* st) {
    XcdBarrier b; b.bar = bar; b.x = xb_xcc_id(); b.st = st;
    if (threadIdx.x == 0) (void)xb_add(&bar[XB_XCNT(b.x)], 1u);
    return b;
}
__device__ __forceinline__ void xcd_barrier_complete(unsigned* bar, unsigned x, unsigned& nloc, unsigned& nx) {
    const unsigned G = gridDim.x * gridDim.y * gridDim.z;
    unsigned sum, cnt, mine, sp = 0u;
    for (;;) {
        sum = 0u; cnt = 0u; mine = 0u;
#pragma unroll
        for (unsigned j = 0; j < 16; ++j) { const unsigned c = xb_ld(&bar[XB_XCNT(j)]); sum += c; cnt += (c > 0u) ? 1u : 0u; mine = (j == x) ? c : mine; }
        if (sum == G) break;
        __builtin_amdgcn_s_sleep(1);
        if ((++sp & 255u) == 0u) { if (xb_ld(&bar[XB_TMO])) break; if (sp > XB_SPIN_CAP) { atomicAdd(&bar[XB_TMO], 1u); break; } }
    }
    nloc = mine > 0u ? mine : 1u; nx = cnt > 0u ? cnt : 1u;
}
__device__ __forceinline__ void xcd_barrier(const XcdBarrier& b) {
    asm volatile("s_waitcnt vmcnt(0)" ::: "memory");
    __syncthreads();
    if (threadIdx.x == 0) {
        unsigned* bar = b.bar;
        __builtin_amdgcn_s_waitcnt(0);
        unsigned nloc = b.st[0], nx = b.st[1];
        if (nloc == 0u) { xcd_barrier_complete(bar, b.x, nloc, nx); b.st[0] = nloc; b.st[1] = nx; }
        const unsigned old = xb_add(&bar[XB_XSUB(b.x)], 1u);
        const unsigned gen = old / nloc;
        if (old + 1u == (gen + 1u) * nloc) {
            __builtin_amdgcn_fence(__ATOMIC_RELEASE, "agent");
            asm volatile("s_waitcnt vmcnt(0)" ::: "memory");
            const unsigned og = xb_add(&bar[XB_TOP], 1u);
            const unsigned tg = og / nx;
            if (og + 1u == (tg + 1u) * nx) xb_add(&bar[XB_TOPGEN], 1u);
            else XB_SPIN(xb_ld(&bar[XB_TOPGEN]) == tg, bar);
            __builtin_amdgcn_fence(__ATOMIC_ACQUIRE, "agent");
            xb_add(&bar[XB_XGEN(b.x)], 1u);
            asm volatile("s_waitcnt vmcnt(0)" ::: "memory");
        } else {
            XB_SPIN(xb_ld(&bar[XB_XGEN(b.x)]) == gen, bar);
            __builtin_amdgcn_fence(__ATOMIC_ACQUIRE, "agent");
            asm volatile("s_waitcnt vmcnt(0)" ::: "memory");
        }
    }
    __syncthreads();
}

namespace pg8 {
constexpr int BM = 256, BK = 64, HALF = 128, HTB = HALF * BK * 2, STAGE_BYTES = 8 * HTB, NXCD = 8, WGM = 8;
__device__ __forceinline__ int lds_byte(int r, int c) { const int st = (r >> 4) * 2 + (c >> 5), rr = r & 15, cc = c & 31, ob = rr * 64 + cc * 2; return st * 1024 + (ob ^ (((ob >> 9) & 1) << 5)); }
__device__ __forceinline__ void stage_rc(int b, int& R, int& C) { const int st = b / 1024, sb = b % 1024, swz = sb ^ (((sb >> 9) & 1) << 5); R = (st >> 1) * 16 + swz / 64; C = (st & 1) * 32 + (swz % 64) / 2; }
__device__ __forceinline__ int perm32(int rho) { const int n = rho >> 4, i = rho & 15; return 8 * (i >> 2) + 4 * n + (i & 3); }
struct Unit { int pm, pn; };

template <class Epi, class Sched, bool GATHER, bool F8 = false>
__device__ __forceinline__ void gemm_phase(LAS unsigned char* lds, const int K, const Sched& S, const Epi& E) {
    int tid = threadIdx.x; asm volatile("" : "+v"(tid));
    const int wid = __builtin_amdgcn_readfirstlane(tid >> 6), lane = tid & 63, wr = wid >> 2, wc = wid & 3, fr = lane & 15, fq = lane >> 4;
    const int nt = K / BK;
    int Rr[2], Cc[2]; unsigned voffB[2];
#pragma unroll
    for (int i = 0; i < 2; ++i) { stage_rc(tid * 16 + i * 8192, Rr[i], Cc[i]); const int Rb = Epi::PERM ? ((Rr[i] & ~31) + perm32(Rr[i] & 31)) : Rr[i];
        voffB[i] = (unsigned)(Rb * K + Cc[i]) * 2u; }
    const size_t kstep = (size_t)(BK * 2);
    const size_t hstep = (size_t)HALF * K * 2;
    const unsigned ldsw = (unsigned)wid * 1024u;
    const int aoff = lds_byte(wr * 64 + fr, fq * 8), boff = lds_byte(wc * 32 + fr, fq * 8);
#define PG8_SA(b, h) (((b) * 2 + (h)) * HTB)
#define PG8_SB(b, h) ((4 + (b) * 2 + (h)) * HTB)
#define PG8_STAGE(bufoff, gbase, voff) do { _Pragma("unroll") for (int _i = 0; _i < 2; ++_i) \
        __builtin_amdgcn_global_load_lds((const unsigned*)((const char*)(gbase) + (voff)[_i]), (LAS unsigned*)(lds + (bufoff) + ldsw + _i * 8192), 16, 0, 0); } while (0)
#define PG8_LD8(p) __builtin_shufflevector(*(const LAS i32x4*)(p), *(const LAS i32x4*)((p) + 1024), 0, 1, 2, 3, 4, 5, 6, 7)
#define PG8_LDA(dst, b, h) do { if constexpr (F8) { _Pragma("unroll") for (int m = 0; m < 4; ++m) dst##8[m] = PG8_LD8(lds + PG8_SA(b, h) + aoff + m * 2048); } \
        else { _Pragma("unroll") for (int m = 0; m < 4; ++m) _Pragma("unroll") for (int k = 0; k < 2; ++k) dst[m][k] = *(const LAS bf16x8*)(lds + PG8_SA(b, h) + aoff + m * 2048 + k * 1024); } } while (0)
#define PG8_LDB(dst, b, h) do { if constexpr (F8) { _Pragma("unroll") for (int n = 0; n < 2; ++n) dst##8[n] = PG8_LD8(lds + PG8_SB(b, h) + boff + n * 2048); } \
        else { _Pragma("unroll") for (int n = 0; n < 2; ++n) _Pragma("unroll") for (int k = 0; k < 2; ++k) dst[n][k] = *(const LAS bf16x8*)(lds + PG8_SB(b, h) + boff + n * 2048 + k * 1024); } } while (0)
#define PG8_CAT8(x0, x1) __builtin_shufflevector(__builtin_bit_cast(i32x4, x0), __builtin_bit_cast(i32x4, x1), 0, 1, 2, 3, 4, 5, 6, 7)
#define PG8_MMA(ai, bj, At, Bt) do { __builtin_amdgcn_s_setprio(1); _Pragma("unroll") for (int m = 0; m < 4; ++m) _Pragma("unroll") for (int n = 0; n < 2; ++n) { \
        if constexpr (F8) asm volatile("v_mfma_scale_f32_16x16x128_f8f6f4 %0, %1, %2, %0, %3, %3 op_sel_hi:[0,0,0]" : "+v"(acc[ai][bj][m][n]) : "v"(Bt##8[n]), "v"(At##8[m]), "v"(f8one)); \
        else { _Pragma("unroll") for (int k = 0; k < 2; ++k) acc[ai][bj][m][n] = __builtin_amdgcn_mfma_f32_16x16x32_bf16(Bt[n][k], At[m][k], acc[ai][bj][m][n], 0, 0, 0); } } __builtin_amdgcn_s_setprio(0); } while (0)
#define PG8_WAIT_V(n) asm volatile("s_waitcnt vmcnt(" #n ")" ::: "memory")
#define PG8_WAIT_L(n) asm volatile("s_waitcnt lgkmcnt(" #n ")" ::: "memory")
#define PG8_BAR __builtin_amdgcn_s_barrier()
#define PG8_SCHED __builtin_amdgcn_sched_barrier(0)
#define PG8_VOFF(dst, u) do { _Pragma("unroll") for (int _h = 0; _h < 2; ++_h) _Pragma("unroll") for (int _i = 0; _i < 2; ++_i) { \
        if constexpr (GATHER) dst[_h][_i] = S.arow(u, _h * HALF + Rr[_i]) * (unsigned)(K * 2) + (unsigned)(Cc[_i] * 2); \
        else dst[_h][_i] = (unsigned)((_h * HALF + Rr[_i]) * K + Cc[_i]) * 2u; } } while (0)
    Unit cur, nxt; int ui = 0;
    if (!S.next(0, cur)) return;
    f32x4 acc[2][2][4][2];
    if constexpr (Epi::PRELOAD) E.preload(acc, cur, wr, wc, fr, fq);
    else {
#pragma unroll
    for (int a = 0; a < 2; ++a)
#pragma unroll
        for (int b = 0; b < 2; ++b)
#pragma unroll
            for (int m = 0; m < 4; ++m)
#pragma unroll
                for (int n = 0; n < 2; ++n) acc[a][b][m][n] = (f32x4){0.f, 0.f, 0.f, 0.f};
    }
    float epf[2][4] = {{0.f, 0.f, 0.f, 0.f}, {0.f, 0.f, 0.f, 0.f}};
    bf16x8 At[4][2], B0[2][2], B1[2][2];
    i32x8 At8[4], B08[2], B18[2]; const unsigned f8one = 0x7f7f7f7fu;
    unsigned vA[2][2], vN[2][2];
    PG8_VOFF(vA, cur);
    if constexpr (Epi::PREFETCH) E.prefetch(epf, cur, wr, fr);
    const char* cA = S.abase(cur); const char* cB = S.bbase(cur);
    PG8_STAGE(PG8_SB(0, 0), cB, voffB); PG8_STAGE(PG8_SB(0, 1), cB + hstep, voffB); PG8_STAGE(PG8_SA(0, 0), cA, vA[0]); PG8_STAGE(PG8_SA(0, 1), cA, vA[1]);
    if (wr == 1) PG8_BAR;
    PG8_WAIT_V(2); PG8_BAR;
    PG8_STAGE(PG8_SB(1, 0), cB + kstep, voffB); PG8_STAGE(PG8_SA(1, 0), cA + kstep, vA[0]); PG8_STAGE(PG8_SB(1, 1), cB + hstep + kstep, voffB);
    PG8_WAIT_V(6); PG8_BAR;
    for (;;) {
        const bool has_next = S.next(ui + 1, nxt);
        const char* nA = has_next ? S.abase(nxt) : cA; const char* nB = has_next ? S.bbase(nxt) : cB;
        if constexpr (GATHER) { if (has_next) { PG8_VOFF(vN, nxt); } else {
#pragma unroll
            for (int h = 0; h < 2; ++h)
#pragma unroll
                for (int i = 0; i < 2; ++i) vN[h][i] = vA[h][i]; } }
#pragma unroll 1
        for (int t = 0; t < nt; t += 2) {
            const bool last = (t == nt - 2);
            const char* a1 = cA + (size_t)(t + 1) * kstep;
            const char* a2 = last ? nA : cA + (size_t)(t + 2) * kstep; const char* b2 = last ? nB : cB + (size_t)(t + 2) * kstep;
            const char* a3 = a2 + kstep; const char* b3 = b2 + kstep;
            unsigned v2[2][2]; const unsigned lmask = last ? 0xffffffffu : 0u;
#pragma unroll
            for (int h = 0; h < 2; ++h)
#pragma unroll
                for (int i = 0; i < 2; ++i) { if constexpr (GATHER) v2[h][i] = (vN[h][i] & lmask) | (vA[h][i] & ~lmask); else v2[h][i] = vA[h][i]; }
            PG8_LDB(B0, 0, 0); PG8_LDB(B1, 0, 1); PG8_SCHED; PG8_LDA(At, 0, 0); PG8_STAGE(PG8_SA(1, 1), a1, vA[1]);
            PG8_WAIT_V(8); PG8_WAIT_L(0); PG8_BAR; PG8_MMA(0, 0, At, B0); PG8_MMA(0, 1, At, B1); PG8_BAR; PG8_SCHED;
            PG8_LDA(At, 0, 1); PG8_STAGE(PG8_SB(0, 0), b2, voffB); PG8_STAGE(PG8_SB(0, 1), b2 + hstep, voffB); PG8_STAGE(PG8_SA(0, 0), a2, v2[0]);
            PG8_WAIT_V(8); PG8_WAIT_L(0); PG8_BAR; PG8_MMA(1, 0, At, B0); PG8_MMA(1, 1, At, B1); PG8_BAR; PG8_SCHED;
            PG8_LDB(B0, 1, 0); PG8_LDB(B1, 1, 1); PG8_SCHED; PG8_LDA(At, 1, 0); PG8_STAGE(PG8_SA(0, 1), a2, v2[1]);
            PG8_WAIT_V(8); PG8_WAIT_L(0); PG8_BAR; PG8_MMA(0, 0, At, B0); PG8_MMA(0, 1, At, B1); PG8_BAR; PG8_SCHED;
            PG8_LDA(At, 1, 1); PG8_STAGE(PG8_SB(1, 0), b3, voffB); PG8_STAGE(PG8_SB(1, 1), b3 + hstep, voffB); PG8_STAGE(PG8_SA(1, 0), a3, v2[0]);
            PG8_WAIT_V(8); PG8_WAIT_L(0); PG8_BAR; PG8_MMA(1, 0, At, B0); PG8_MMA(1, 1, At, B1); PG8_BAR; PG8_SCHED;
        }
        if (wr == 0) PG8_BAR;
        if constexpr (F8) asm volatile("s_nop 15\n\ts_nop 15" ::: "memory");
        if constexpr (Epi::PREFETCH) E(acc, cur, wr, wc, fr, fq, epf); else E(acc, cur, wr, wc, fr, fq);
        if (!has_next) break;
        if constexpr (Epi::PREFETCH) E.prefetch(epf, nxt, wr, fr);
        if constexpr (Epi::PRELOAD) E.preload(acc, nxt, wr, wc, fr, fq);
        else {
#pragma unroll
        for (int a = 0; a < 2; ++a)
#pragma unroll
            for (int b = 0; b < 2; ++b)
#pragma unroll
                for (int m = 0; m < 4; ++m)
#pragma unroll
                    for (int n = 0; n < 2; ++n) acc[a][b][m][n] = (f32x4){0.f, 0.f, 0.f, 0.f};
        }
        cur = nxt; cA = nA; cB = nB; ++ui;
        if constexpr (GATHER) {
#pragma unroll
        for (int h = 0; h < 2; ++h)
#pragma unroll
            for (int i = 0; i < 2; ++i) vA[h][i] = vN[h][i]; }
        if (wr == 1) PG8_BAR;
    }
    PG8_WAIT_V(0);
    PG8_BAR;
#undef PG8_SA
#undef PG8_SB
#undef PG8_STAGE
#undef PG8_LDA
#undef PG8_LD8
#undef PG8_LDB
#undef PG8_MMA
#undef PG8_CAT8
#undef PG8_WAIT_V
#undef PG8_WAIT_L
#undef PG8_BAR
#undef PG8_SCHED
#undef PG8_VOFF
}

struct DenseSched {
    const char* A; const char* Bt; int K; int nM, nN, nwg, G, c;
    __device__ __forceinline__ void init(const void* A_, const void* Bt_, int M, int N, int K_, int G_, int c_) { A = (const char*)A_; Bt = (const char*)Bt_; K = K_; nM = M / BM; nN = N / BM; nwg = nM * nN; G = G_; c = c_; }
    __device__ __forceinline__ bool next(int i, Unit& u) const {
        const long L = (long)i * G + c; if (L >= nwg) return false;
        int wgid = (int)L; { const int q = nwg / NXCD, r = nwg % NXCD, xcd = wgid % NXCD, off = wgid / NXCD; wgid = (xcd < r ? xcd * (q + 1) : r * (q + 1) + (xcd - r) * q) + off; }
        const int nig = WGM * nN, gid = wgid / nig, fm = gid * WGM, gsz = (nM - fm) < WGM ? (nM - fm) : WGM;
        u.pm = fm + ((wgid % nig) % gsz); u.pn = (wgid % nig) / gsz; return true;
    }
    __device__ __forceinline__ const char* abase(const Unit& u) const { return A + (size_t)u.pm * BM * K * 2; }
    __device__ __forceinline__ const char* bbase(const Unit& u) const { return Bt + (size_t)u.pn * BM * K * 2; }
    __device__ __forceinline__ unsigned arow(const Unit&, int) const { return 0u; }
};
template <bool GATHER_A>
struct MoeSched {
    const char* A; const char* W; int K; size_t wstride; const LAS int* tb; const LAS int* cn; const unsigned* rowtok; int ntot, vcu, G;
    __device__ __forceinline__ bool next(int i, Unit& u) const { const int L = i * G + vcu; if (L >= ntot * 4) return false; u.pm = L >> 2; u.pn = L & 3; return true; }
    __device__ __forceinline__ int expert(int pm) const { int e = 0;
#pragma unroll
        for (int j = 1; j < 16; ++j) e += (pm >= tb[j]) ? 1 : 0; return e; }
    __device__ __forceinline__ const char* abase(const Unit& u) const { return GATHER_A ? A : A + (size_t)u.pm * BM * K * 2; }
    __device__ __forceinline__ const char* bbase(const Unit& u) const { return W + (size_t)expert(u.pm) * wstride + (size_t)u.pn * BM * K * 2; }
    __device__ __forceinline__ unsigned arow(const Unit& u, int r) const { const int e = expert(u.pm); const int idx = (u.pm - tb[e]) * BM + r; return idx < cn[e] ? rowtok[(size_t)e * ECAP + idx] : 0u; }
};

__device__ __forceinline__ u32x4 widen16(u32x2 a, u32x2 b) {
    const auto rx = __builtin_amdgcn_permlane16_swap(a.x, b.x, false, false); const auto ry = __builtin_amdgcn_permlane16_swap(a.y, b.y, false, false);
    u32x4 o; o.x = rx[0]; o.y = ry[0]; o.z = rx[1]; o.w = ry[1]; return o; }
struct EpiBf16 {
    static constexpr bool PERM = true, PRELOAD = false, PREFETCH = false;
    bf16_t* O; int ldc;
    __device__ __forceinline__ void operator()(const f32x4 (&acc)[2][2][4][2], const Unit& u, int wr, int wc, int fr, int fq) const {
        const int row0 = u.pm * BM + wr * 64 + fr, col0 = u.pn * BM + wc * 32 + 8 * fq;
#pragma unroll
        for (int ai = 0; ai < 2; ++ai)
#pragma unroll
            for (int m = 0; m < 4; ++m) { bf16_t* rowp = O + (size_t)(row0 + ai * HALF + m * 16) * ldc + col0;
#pragma unroll
                for (int bj = 0; bj < 2; ++bj) { const f32x4 v0 = acc[ai][bj][m][0], v1 = acc[ai][bj][m][1];
                    u32x4 w; w.x = cvt_pk_bf16(v0[0], v0[1]); w.y = cvt_pk_bf16(v0[2], v0[3]); w.z = cvt_pk_bf16(v1[0], v1[1]); w.w = cvt_pk_bf16(v1[2], v1[3]);
#ifdef EPI_NT
                    __builtin_nontemporal_store(w, (u32x4*)(rowp + bj * HALF));
#else
                    *(u32x4*)(rowp + bj * HALF) = w;
#endif
                } }
    }
};
template <bool XF32>
struct EpiResid {
    static constexpr bool PERM = true, PRELOAD = true, PREFETCH = false;
    const float* xin; bf16_t* XB; unsigned char* XB8;
    __device__ __forceinline__ void preload(f32x4 (&acc)[2][2][4][2], const Unit& u, int wr, int wc, int fr, int fq) const {
        const int row0 = u.pm * BM + wr * 64 + fr, col0 = u.pn * BM + wc * 32 + 8 * fq;
#pragma unroll
        for (int ai = 0; ai < 2; ++ai)
#pragma unroll
            for (int m = 0; m < 4; ++m) { const size_t off = (size_t)(row0 + ai * HALF + m * 16) * D + col0;
#pragma unroll
                for (int bj = 0; bj < 2; ++bj) {
                    if (XF32) { acc[ai][bj][m][0] = *(const f32x4*)(xin + off + bj * HALF); acc[ai][bj][m][1] = *(const f32x4*)(xin + off + bj * HALF + 4); }
                    else { const u32x4 w = *(const u32x4*)(XB + off + bj * HALF); acc[ai][bj][m][0] = (f32x4){bf_lo(w.x), bf_hi(w.x), bf_lo(w.y), bf_hi(w.y)}; acc[ai][bj][m][1] = (f32x4){bf_lo(w.z), bf_hi(w.z), bf_lo(w.w), bf_hi(w.w)}; } } }
    }
    __device__ __forceinline__ void operator()(const f32x4 (&acc)[2][2][4][2], const Unit& u, int wr, int wc, int fr, int fq) const {
        const int row0 = u.pm * BM + wr * 64 + fr, col0 = u.pn * BM + wc * 32 + 8 * fq;
        const int colw = u.pn * BM + wc * 32 + 8 * (fq & ~1);
#pragma unroll
        for (int ai = 0; ai < 2; ++ai)
#pragma unroll
            for (int mp = 0; mp < 4; mp += 2)
#pragma unroll
                for (int bj = 0; bj < 2; ++bj) { u32x2 w8[2];
#pragma unroll
                    for (int h = 0; h < 2; ++h) { const int m = mp + h; bf16_t* rowp = XB + (size_t)(row0 + ai * HALF + m * 16) * D + col0;
                        const f32x4 v0 = acc[ai][bj][m][0], v1 = acc[ai][bj][m][1];
                        u32x4 w; w.x = cvt_pk_bf16(v0[0], v0[1]); w.y = cvt_pk_bf16(v0[2], v0[3]); w.z = cvt_pk_bf16(v1[0], v1[1]); w.w = cvt_pk_bf16(v1[2], v1[3]);
                        *(u32x4*)(rowp + bj * HALF) = w;
                        w8[h].x = cvt_pk4_fp8(bf_lo(w.x), bf_hi(w.x), bf_lo(w.y), bf_hi(w.y)); w8[h].y = cvt_pk4_fp8(bf_lo(w.z), bf_hi(w.z), bf_lo(w.w), bf_hi(w.w)); }
                    *(u32x4*)(XB8 + (size_t)(row0 + ai * HALF + (mp + (fq & 1)) * 16) * D + colw + bj * HALF) = widen16(w8[0], w8[1]); }
    }
};
template <int MODE  >
struct EpiPair {
    static constexpr bool PERM = true, PRELOAD = false, PREFETCH = true;
    bf16_t* O0; bf16_t* O1; int ld1;
    const float* rstd; const unsigned* rowtok; const LAS int* tb; const LAS int* cn;
    __device__ __forceinline__ void prefetch(float (&rs)[2][4], const Unit& u, int wr, int fr) const {
        const int row0 = u.pm * BM + wr * 64 + fr;
        if (MODE == 0) {
#pragma unroll
            for (int ai = 0; ai < 2; ++ai)
#pragma unroll
                for (int m = 0; m < 4; ++m) rs[ai][m] = rstd[row0 + ai * HALF + m * 16] * (G3_F8 ? 1.0f / F8_WSCALE : 1.0f);
        } else {
            int e = 0;
#pragma unroll
            for (int j = 1; j < 16; ++j) e += (u.pm >= tb[j]) ? 1 : 0;
            const int idx0 = (u.pm - tb[e]) * BM + wr * 64 + fr, cne = cn[e];
#pragma unroll
            for (int ai = 0; ai < 2; ++ai)
#pragma unroll
                for (int m = 0; m < 4; ++m) { const int idx = idx0 + ai * HALF + m * 16; rs[ai][m] = idx < cne ? rstd[(size_t)e * ECAP + idx] * (1.0f / F8_WSCALE) : 0.f; }
        }
    }
    __device__ __forceinline__ void operator()(const f32x4 (&acc)[2][2][4][2], const Unit& u, int wr, int wc, int fr, int fq, const float (&rs)[2][4]) const {
        const int row0 = u.pm * BM + wr * 64 + fr;
        if (MODE == 0 && u.pn < 4) {
            const int col0 = u.pn * BM + wc * 32 + 8 * fq;
#pragma unroll
            for (int ai = 0; ai < 2; ++ai)
#pragma unroll
                for (int m = 0; m < 4; ++m) { bf16_t* rowp = O0 + (size_t)(row0 + ai * HALF + m * 16) * D + col0;
#pragma unroll
                    for (int bj = 0; bj < 2; ++bj) { const f32x4 v0 = acc[ai][bj][m][0] * rs[ai][m], v1 = acc[ai][bj][m][1] * rs[ai][m];
                        u32x4 w; w.x = cvt_pk_bf16(v0[0], v0[1]); w.y = cvt_pk_bf16(v0[2], v0[3]); w.z = cvt_pk_bf16(v1[0], v1[1]); w.w = cvt_pk_bf16(v1[2], v1[3]);
                        *(u32x4*)(rowp + bj * HALF) = w; } }
        } else {
            const int pt = (MODE == 0) ? (u.pn - 4) : u.pn;
            const int col0 = pt * HALF + wc * 32 + 8 * fq;
#pragma unroll
            for (int ai = 0; ai < 2; ++ai) { u32x2 wkeep = {0u, 0u};
#pragma unroll
                for (int m = 0; m < 4; ++m) { bf16_t* rowp = O1 + (size_t)(row0 + ai * HALF + m * 16) * ld1 + col0;
                    f32x4 r[2];
#pragma unroll
                    for (int n = 0; n < 2; ++n) { const f32x4 g = acc[ai][0][m][n] * rs[ai][m], up = acc[ai][1][m][n] * rs[ai][m];
                        if (MODE == 0) r[n] = g * up;
                        else {
#pragma unroll
                            for (int j = 0; j < 4; ++j) r[n][j] = __builtin_amdgcn_fmed3f(g[j] * fast_rcp(1.0f + fast_exp2(-1.4426950408889634f * g[j])) * up[j] * F8_HSCALE, -448.0f, 448.0f); } }
                    if (MODE == 1) { u32x2 w; w.x = cvt_pk4_fp8(r[0][0], r[0][1], r[0][2], r[0][3]); w.y = cvt_pk4_fp8(r[1][0], r[1][1], r[1][2], r[1][3]);
                        if ((m & 1) == 0) wkeep = w;
                        else *(u32x4*)((unsigned char*)O1 + (size_t)(row0 + ai * HALF + (m - 1 + (fq & 1)) * 16) * ld1 + (pt * HALF + wc * 32 + 8 * (fq & ~1))) = widen16(wkeep, w); }
                    else { u32x4 w; w.x = cvt_pk_bf16(r[0][0], r[0][1]); w.y = cvt_pk_bf16(r[0][2], r[0][3]); w.z = cvt_pk_bf16(r[1][0], r[1][1]); w.w = cvt_pk_bf16(r[1][2], r[1][3]);
                        *(u32x4*)rowp = w; } } }
        }
    }
};
struct EpiDown {
    static constexpr bool PERM = true, PRELOAD = false, PREFETCH = true;
    unsigned char* O; const float* cwraw; const LAS int* tb; const LAS int* cn;
    __device__ __forceinline__ void prefetch(float (&cws)[2][4], const Unit& u, int wr, int fr) const {
        int e = 0;
#pragma unroll
        for (int j = 1; j < 16; ++j) e += (u.pm >= tb[j]) ? 1 : 0;
        const int idx0 = (u.pm - tb[e]) * BM + wr * 64 + fr, cne = cn[e];
#pragma unroll
        for (int ai = 0; ai < 2; ++ai)
#pragma unroll
            for (int m = 0; m < 4; ++m) { const int idx = idx0 + ai * HALF + m * 16; cws[ai][m] = idx < cne ? cwraw[(size_t)e * ECAP + idx] * (F8_YSCALE / (F8_WSCALE * F8_HSCALE)) : 0.f; }
    }
    __device__ __forceinline__ void operator()(const f32x4 (&acc)[2][2][4][2], const Unit& u, int wr, int wc, int fr, int fq, const float (&cws)[2][4]) const {
        const int row0 = u.pm * BM + wr * 64 + fr, col0 = u.pn * BM + wc * 32 + 8 * fq;
        const int colw = u.pn * BM + wc * 32 + 8 * (fq & ~1);
#pragma unroll
        for (int ai = 0; ai < 2; ++ai)
#pragma unroll
            for (int mp = 0; mp < 4; mp += 2) {
                unsigned char* rowp = O + (size_t)(row0 + ai * HALF + (mp + (fq & 1)) * 16) * D + colw;
#pragma unroll
                for (int bj = 0; bj < 2; ++bj) { u32x2 w[2];
#pragma unroll
                    for (int h = 0; h < 2; ++h) { const float cw = cws[ai][mp + h]; f32x4 v0 = acc[ai][bj][mp + h][0] * cw, v1 = acc[ai][bj][mp + h][1] * cw;
#pragma unroll
                        for (int j = 0; j < 4; ++j) { v0[j] = __builtin_amdgcn_fmed3f(v0[j], -448.0f, 448.0f); v1[j] = __builtin_amdgcn_fmed3f(v1[j], -448.0f, 448.0f); }
                        w[h].x = cvt_pk4_fp8(v0[0], v0[1], v0[2], v0[3]); w[h].y = cvt_pk4_fp8(v1[0], v1[1], v1[2], v1[3]); }
                    *(u32x4*)(rowp + bj * HALF) = widen16(w[0], w[1]); } }
    }
};
}

constexpr int RING_BYTES = 131072;
constexpr int MISC_OFF = RING_BYTES;
constexpr int LDS_BYTES = 163840;
constexpr int MW_BAR = 0;
constexpr int MW_TB = 16;
constexpr int MW_CN = 40;
constexpr int MW_Q = 60;
constexpr int MW_F = 64;

struct Params {
    const float* in[25]; float* out; unsigned char* ws;
};

constexpr float ATT_QSCALE = 0.125f * 1.4426950408889634f;
__device__ __forceinline__ void transpose_item(const float* W, int ld, int K, int k0, int srccol, bf16_t* WT, int dstrow, LAS float* scr, int lane, const float* gk = nullptr, float wsc = 1.0f) {
    float tv[32];
#pragma unroll
    for (int i = 0; i < 32; ++i) { const int kk = 2 * i + (lane >> 5); tv[i] = W[(size_t)(k0 + kk) * ld + srccol + (lane & 31)]; }
#pragma unroll
    for (int i = 0; i < 32; ++i) { const int kk = 2 * i + (lane >> 5); scr[kk * 33 + (lane & 31)] = (gk ? tv[i] * gk[k0 + kk] : tv[i]) * wsc; }
    asm volatile("s_waitcnt lgkmcnt(0)" ::: "memory");
    const int c = lane & 7;
#pragma unroll
    for (int j = 0; j < 4; ++j) { const int n = (lane >> 3) + 8 * j; const LAS float* s = scr + (8 * c) * 33 + n;
        u32x4 o; o.x = cvt_pk_bf16(s[0 * 33], s[1 * 33]); o.y = cvt_pk_bf16(s[2 * 33], s[3 * 33]); o.z = cvt_pk_bf16(s[4 * 33], s[5 * 33]); o.w = cvt_pk_bf16(s[6 * 33], s[7 * 33]);
        *(u32x4*)(WT + (size_t)(dstrow + n) * K + k0 + 8 * c) = o; }
    asm volatile("s_waitcnt lgkmcnt(0)" ::: "memory");
}
__device__ __forceinline__ void transpose_item_f8(const float* W, int ld, int K, int k0, int srccol, unsigned char* WT8, int dstrow, LAS float* scr, int lane, const float* gk, float scale) {
    float tv[32];
#pragma unroll
    for (int i = 0; i < 32; ++i) { const int kk = 2 * i + (lane >> 5); tv[i] = W[(size_t)(k0 + kk) * ld + srccol + (lane & 31)]; }
#pragma unroll
    for (int i = 0; i < 32; ++i) { const int kk = 2 * i + (lane >> 5); scr[kk * 33 + (lane & 31)] = (gk ? tv[i] * gk[k0 + kk] : tv[i]) * scale; }
    asm volatile("s_waitcnt lgkmcnt(0)" ::: "memory");
    const int c = lane & 3;
#pragma unroll
    for (int j = 0; j < 2; ++j) { const int n = (lane >> 2) + 16 * j; const LAS float* q = scr + (16 * c) * 33 + n;
        u32x4 o; o.x = cvt_pk4_fp8(q[0 * 33], q[1 * 33], q[2 * 33], q[3 * 33]); o.y = cvt_pk4_fp8(q[4 * 33], q[5 * 33], q[6 * 33], q[7 * 33]);
        o.z = cvt_pk4_fp8(q[8 * 33], q[9 * 33], q[10 * 33], q[11 * 33]); o.w = cvt_pk4_fp8(q[12 * 33], q[13 * 33], q[14 * 33], q[15 * 33]);
        *(u32x4*)(WT8 + (size_t)(dstrow + n) * K + k0 + 16 * c) = o; }
    asm volatile("s_waitcnt lgkmcnt(0)" ::: "memory");
}
__device__ __forceinline__ int pair_row(int ch, int up) { return (ch >> 7) * 256 + up * 128 + (ch & 127); }

__device__ __forceinline__ void phase_prologue_weights(const Params& p, LAS unsigned char* lds, int first, int last, int step, int wave, int lane_) {
    int lane = lane_; asm volatile("" : "+v"(lane));
    LAS float* scr = (LAS float*)(lds + wave * 16384);
    unsigned char* ws = p.ws;
    constexpr int I1 = 16 * 112, I2 = 16 * 32, I3 = 16 * 96, I4 = 16 * 32, IE = 768;
    constexpr int NITEMS = I1 + I2 + I3 + I4 + 32 * IE;
    static_assert(NITEMS == 28928, "item count");
    for (int it = first; it < last; it += step) {
        int r = it;
        if (r < I1) { const int kb = r / 112, nb = r % 112; const int sc = nb < 64 ? 32 * nb : 2056 + 32 * (nb - 64), dr = nb < 64 ? 32 * nb : 2048 + 32 * (nb - 64);
            transpose_item(p.in[5], EVEN_IN, 1024, 64 * kb, sc, (bf16_t*)(ws + WS_WT1), dr, scr, lane, nullptr, (dr >= P_DQ && dr < P_DK) ? ATT_QSCALE : 1.0f); continue; } r -= I1;
        if (r < I2) { const int kb = r / 32, nb = r % 32; transpose_item(p.in[6], 1024, 1024, 64 * kb, 32 * nb, (bf16_t*)(ws + WS_WT2), 32 * nb, scr, lane); continue; } r -= I2;
        if (r < I3) { const int kb = r / 96, nb = r % 96; int dr;
            if (nb < 32) dr = 32 * nb; else if (nb < 64) dr = 1024 + pair_row(32 * (nb - 32), 0); else dr = 1024 + pair_row(32 * (nb - 64), 1);
            if (G3_F8) transpose_item_f8(p.in[15], 3072, 1024, 64 * kb, 32 * nb, ws + WS_WT3, dr, scr, lane, p.in[2] + D, F8_WSCALE);
            else transpose_item(p.in[15], 3072, 1024, 64 * kb, 32 * nb, (bf16_t*)(ws + WS_WT3), dr, scr, lane, p.in[2] + D);
            continue; } r -= I3;
        if (r < I4) { const int kb = r / 32, nb = r % 32; transpose_item(p.in[17], 1024, 1024, 64 * kb, 32 * nb, (bf16_t*)(ws + WS_WT4), 32 * nb, scr, lane); continue; } r -= I4;
        const int le = r / IE; r %= IE;
        unsigned char* wgu = ws + WS_WGU + (size_t)le * 1024 * 1024; unsigned char* wd = ws + WS_WD + (size_t)le * 1024 * 512;
        if (r < 256) { const int kb = r / 16, nb = r % 16; transpose_item_f8(p.in[22] + (size_t)le * 1024 * 512, 512, 1024, 64 * kb, 32 * nb, wgu, pair_row(32 * nb, 0), scr, lane, p.in[3] + (le >> 4) * D, F8_WSCALE); continue; } r -= 256;
        if (r < 256) { const int kb = r / 16, nb = r % 16; transpose_item_f8(p.in[23] + (size_t)le * 1024 * 512, 512, 1024, 64 * kb, 32 * nb, wgu, pair_row(32 * nb, 1), scr, lane, p.in[3] + (le >> 4) * D, F8_WSCALE); continue; } r -= 256;
        { const int kb = r / 32, nb = r % 32; transpose_item_f8(p.in[24] + (size_t)le * 512 * 1024, 1024, 512, 64 * kb, 32 * nb, wd, 32 * nb, scr, lane, nullptr, F8_WSCALE); }
    }
}

struct RowV { f32x4 v[4]; };
__device__ __forceinline__ RowV row_load(const float* xr, int lane) { RowV r; const f32x4* p = (const f32x4*)xr + lane;
#pragma unroll
    for (int j = 0; j < 4; ++j) r.v[j] = p[64 * j]; return r; }
__device__ __forceinline__ void row_store(float* xr, int lane, const RowV& r) { f32x4* p = (f32x4*)xr + lane;
#pragma unroll
    for (int j = 0; j < 4; ++j) p[64 * j] = r.v[j]; }
__device__ __forceinline__ RowV row_load_bf16(const bf16_t* yr, int lane) { RowV r; const u32x2* p = (const u32x2*)yr + lane;
#pragma unroll
    for (int j = 0; j < 4; ++j) { const u32x2 w = p[64 * j]; r.v[j] = (f32x4){bf_lo(w.x), bf_hi(w.x), bf_lo(w.y), bf_hi(w.y)}; } return r; }
__device__ __forceinline__ RowV row_load_fp8(const unsigned char* yr, int lane, float sc) { RowV r; const unsigned* p = (const unsigned*)yr + lane;
#pragma unroll
    for (int j = 0; j < 4; ++j) { const unsigned w = p[64 * j]; const f32x2 lo = __builtin_amdgcn_cvt_pk_f32_fp8((int)w, false), hi = __builtin_amdgcn_cvt_pk_f32_fp8((int)w, true); r.v[j] = (f32x4){lo.x * sc, lo.y * sc, hi.x * sc, hi.y * sc}; } return r; }
__device__ __forceinline__ float row_rstd(const RowV& r) { float s = 0.f;
#pragma unroll
    for (int j = 0; j < 4; ++j) s += (r.v[j][0] * r.v[j][0] + r.v[j][1] * r.v[j][1]) + (r.v[j][2] * r.v[j][2] + r.v[j][3] * r.v[j][3]);
    return 1.0f / sqrtf(wave_sum(s) * (1.0f / D) + NORM_EPS); }
__device__ __forceinline__ void row_store_bf16(bf16_t* hr, int lane, const RowV& r) { u32x2* p = (u32x2*)hr + lane;
#pragma unroll
    for (int j = 0; j < 4; ++j) { u32x2 w; w.x = cvt_pk_bf16(r.v[j][0], r.v[j][1]); w.y = cvt_pk_bf16(r.v[j][2], r.v[j][3]); p[64 * j] = w; } }

__device__ __forceinline__ void phase_norm_gates(const Params& p, LAS unsigned char* lds, int tid, int gw, int NGW, int lane) {
    const float* x = p.in[0]; const float* g = p.in[2]; const float* win = p.in[5];
    bf16_t* H = (bf16_t*)(p.ws + WS_H); float* gates = (float*)(p.ws + WS_GATES);
    LAS float* wt = (LAS float*)lds;
    for (int i = tid; i < 8 * 1024; i += NTHR) { const int k = i >> 3, o = i & 7; wt[o * 1024 + k] = win[(size_t)k * EVEN_IN + 2048 + o] * g[k]; }
    __syncthreads();
    RowV gv = row_load(g, lane);
    for (int m0 = gw; m0 < T; m0 += 2 * NGW) {
      RowV rr[2];
#pragma unroll
      for (int u = 0; u < 2; ++u) { const int mm = m0 + u * NGW; rr[u] = row_load(x + (size_t)(mm < T ? mm : m0) * D, lane); }
#pragma unroll
      for (int u = 0; u < 2; ++u) {
        const int m = m0 + u * NGW; if (m >= T) break; RowV r = rr[u];
        const float rstd = row_rstd(r);
        float dots[8];
#pragma unroll
        for (int o = 0; o < 8; ++o) { float s = 0.f;
#pragma unroll
            for (int j = 0; j < 4; ++j) { const f32x4 w = *(const LAS f32x4*)(wt + o * 1024 + 4 * lane + 256 * j); s += (r.v[j][0] * w[0] + r.v[j][1] * w[1]) + (r.v[j][2] * w[2] + r.v[j][3] * w[3]); }
            dots[o] = s; }
        float gsum;
        { const bool b5 = (lane & 32) != 0, b4 = (lane & 16) != 0, b3 = (lane & 8) != 0;
          float k4[4];
#pragma unroll
          for (int i = 0; i < 4; ++i) { const float keep = b5 ? dots[4 + i] : dots[i], send = b5 ? dots[i] : dots[4 + i]; k4[i] = keep + __shfl_xor(send, 32); }
          float k2[2];
#pragma unroll
          for (int i = 0; i < 2; ++i) { const float keep = b4 ? k4[2 + i] : k4[i], send = b4 ? k4[i] : k4[2 + i]; k2[i] = keep + __shfl_xor(send, 16); }
          { const float keep = b3 ? k2[1] : k2[0], send = b3 ? k2[0] : k2[1]; gsum = keep + __shfl_xor(send, 8); }
          gsum += __shfl_xor(gsum, 4); gsum += __shfl_xor(gsum, 2); gsum += __shfl_xor(gsum, 1); }
#pragma unroll
        for (int j = 0; j < 4; ++j) r.v[j] = r.v[j] * rstd * gv.v[j];
        row_store_bf16(H + (size_t)m * D, lane, r);
        if ((lane & 7) == 0) gates[(size_t)m * 8 + ((lane >> 3) & 7)] = gsum * rstd;
      }
    }
    __syncthreads();
}

template <int MODE, bool COMBINE>
__device__ __forceinline__ void phase_rows(const Params& p, LAS unsigned char* lds, int tid_, int wave, int lane_, int G,
                                           const float* gvec, const float* wgr, const float* bgr, const float* wer, const float* ber, unsigned* cnt_prev, unsigned* cnt_cur) {
    int tid = tid_; asm volatile("" : "+v"(tid)); const int lane = tid & 63;
    float* OUT = p.out; bf16_t* XB = (bf16_t*)(p.ws + WS_XB); float* RSTD = (float*)(p.ws + WS_RSTD);
    const unsigned char* YC = (const unsigned char*)(p.ws + WS_YC); float* rsraw = (float*)(p.ws + WS_RSRAW);
    unsigned* tokinfo = (unsigned*)(p.ws + WS_TOKINFO);
    unsigned* rowtok = (unsigned*)(p.ws + WS_ROWTOK); float* cwraw = (float*)(p.ws + WS_CWRAW);
    LAS float* wt = (LAS float*)lds;
    LAS int* misc = (LAS int*)(lds + MISC_OFF);
    LAS int* tbp = misc + MW_TB;
    LAS int* te = misc + 1024;
    LAS float* tc = (LAS float*)(misc + 1536);
    LAS int* trank = misc + 2048;
    LAS int* ebase = misc + 2560;
    LAS float* trs = (LAS float*)(misc + 2600);
    if (COMBINE) { if (tid == 0) { int acc = 0; for (int e = 0; e < 16; ++e) { tbp[e] = acc; acc += ((int)__hip_atomic_load(cnt_prev + e * 64, __ATOMIC_RELAXED, __HIP_MEMORY_SCOPE_AGENT) + 255) >> 8; } tbp[16] = acc; } }
    if (MODE == 1) { for (int i = tid; i < 20 * 1024; i += NTHR) { const int o = i >> 10, k = i & 1023; wt[i] = (o < 4 ? wgr[(size_t)k * 4 + o] : wer[(size_t)k * 16 + (o - 4)]) * gvec[k]; } }
    __syncthreads();
    RowV gv; if (MODE == 2) gv = row_load(gvec, lane);
    for (int blk = blockIdx.x; blk < T / 256; blk += G) {
        for (int i2 = 0; i2 < 32; i2 += 2) {
          RowV rr[2];
#pragma unroll
          for (int u = 0; u < 2; ++u) {
            const int m = blk * 256 + wave * 32 + i2 + u;
            rr[u] = row_load_bf16(XB + (size_t)m * D, lane);
            if (COMBINE) {
                const unsigned i0 = tokinfo[(size_t)m * 2], i1 = tokinfo[(size_t)m * 2 + 1];
                const size_t s0 = (size_t)tbp[i0 >> 16] * 256 + (i0 & 0xffffu), s1 = (size_t)tbp[i1 >> 16] * 256 + (i1 & 0xffffu);
                const RowV y0 = row_load_fp8(YC + s0 * D, lane, 1.0f / F8_YSCALE), y1 = row_load_fp8(YC + s1 * D, lane, 1.0f / F8_YSCALE);
#pragma unroll
                for (int j = 0; j < 4; ++j) rr[u].v[j] = rr[u].v[j] + y0.v[j] + y1.v[j];
            }
          }
#pragma unroll
          for (int u = 0; u < 2; ++u) {
            const int i = i2 + u;
            const int rl = wave * 32 + i, m = blk * 256 + rl;
            RowV r = rr[u];
            if (MODE == 0) {
                u32x2* xp = (u32x2*)(XB + (size_t)m * D) + lane;
#pragma unroll
                for (int j = 0; j < 4; ++j) { u32x2 w; w.x = cvt_pk_bf16(r.v[j][0], r.v[j][1]); w.y = cvt_pk_bf16(r.v[j][2], r.v[j][3]); xp[64 * j] = w;
                    r.v[j] = (f32x4){bf_lo(w.x), bf_hi(w.x), bf_lo(w.y), bf_hi(w.y)}; }
            }
            const float rstd = row_rstd(r);
            if (MODE != 2) { if (lane == 0) RSTD[m] = rstd; }
            if (MODE == 1 || (MODE == 0 && G3_F8)) { unsigned* x8 = (unsigned*)(p.ws + WS_XB8 + (size_t)m * D) + lane;
#pragma unroll
                for (int j = 0; j < 4; ++j) x8[64 * j] = cvt_pk4_fp8(r.v[j][0], r.v[j][1], r.v[j][2], r.v[j][3]); }
            if (MODE == 1) {
                float lg[20];
#pragma unroll
                for (int o = 0; o < 20; ++o) { float s = 0.f;
#pragma unroll
                    for (int j = 0; j < 4; ++j) { const f32x4 w = *(const LAS f32x4*)(wt + o * 1024 + 4 * lane + 256 * j); s += (r.v[j][0] * w[0] + r.v[j][1] * w[1]) + (r.v[j][2] * w[2] + r.v[j][3] * w[3]); }
                    lg[o] = wave_sum(s) * rstd + (o < 4 ? bgr[o] : ber[o - 4]); }
                int gs = 0; float gm = lg[0];
#pragma unroll
                for (int o = 1; o < 4; ++o) if (lg[o] > gm) { gm = lg[o]; gs = o; }
                float den = 0.f;
#pragma unroll
                for (int o = 0; o < 4; ++o) den += __expf(lg[o] - gm);
                const float pg = 1.0f / den;
                float el[4];
#pragma unroll
                for (int o = 0; o < 4; ++o) { float v = lg[4 + o];
#pragma unroll
                    for (int g2 = 1; g2 < 4; ++g2) v = (gs == g2) ? lg[4 + 4 * g2 + o] : v;
                    el[o] = v; }
                int i0 = 0; float v0 = el[0];
#pragma unroll
                for (int o = 1; o < 4; ++o) if (el[o] > v0) { v0 = el[o]; i0 = o; }
                int i1 = -1; float v1 = -INFINITY;
#pragma unroll
                for (int o = 0; o < 4; ++o) if (o != i0 && el[o] > v1) { v1 = el[o]; i1 = o; }
                const float ex = __expf(v1 - v0); const float w0 = 1.0f / (1.0f + ex), w1 = ex * w0;
                if (lane == 0) { te[rl * 2] = gs * 4 + i0; te[rl * 2 + 1] = gs * 4 + i1; tc[rl * 2] = w0 * pg; tc[rl * 2 + 1] = w1 * pg; trs[rl] = rstd; }
            }
            if (MODE == 2) {
#pragma unroll
                for (int j = 0; j < 4; ++j) r.v[j] = r.v[j] * rstd * gv.v[j];
                row_store(OUT + (size_t)m * D, lane, r);
            }
          }
        }
        if (MODE == 1) {
            __syncthreads();
            if (tid < 16) { int c = 0; for (int q = 0; q < 512; ++q) if (te[q] == tid) { trank[q] = c; ++c; }
                ebase[tid] = c ? (int)__hip_atomic_fetch_add(cnt_cur + tid * 64, (unsigned)c, __ATOMIC_RELAXED, __HIP_MEMORY_SCOPE_AGENT) : 0; }
            __syncthreads();
            { const int q = tid, e = te[q], pos = ebase[e] + trank[q], tok = blk * 256 + (q >> 1);
              rowtok[(size_t)e * ECAP + pos] = (unsigned)tok; cwraw[(size_t)e * ECAP + pos] = tc[q]; rsraw[(size_t)e * ECAP + pos] = trs[q >> 1]; tokinfo[(size_t)tok * 2 + (q & 1)] = ((unsigned)e << 16) | (unsigned)pos; }
            __syncthreads();
        }
    }
    __syncthreads();
}

__device__ __forceinline__ void phase_router(const Params& p, LAS unsigned char* lds, int tid_, int wave, int G,
                                             const float* gvec, const float* wgr, const float* bgr, const float* wer, const float* ber, unsigned* cnt_cur) {
    int tid = tid_; asm volatile("" : "+v"(tid)); const int lane = tid & 63, r32 = lane & 31, hi = lane >> 5;
    const bf16_t* XB = (const bf16_t*)(p.ws + WS_XB); float* rsraw = (float*)(p.ws + WS_RSRAW);
    unsigned* tokinfo = (unsigned*)(p.ws + WS_TOKINFO);
    unsigned* rowtok = (unsigned*)(p.ws + WS_ROWTOK); float* cwraw = (float*)(p.ws + WS_CWRAW);
    constexpr int WROW = 2048 + 16;
    LAS unsigned char* Whi = lds; LAS unsigned char* Wlo = lds + 24 * WROW;
    LAS int* misc = (LAS int*)(lds + MISC_OFF);
    LAS int* te = misc + 1024; LAS float* tc = (LAS float*)(misc + 1536); LAS int* trank = misc + 2048; LAS int* ebase = misc + 2560; LAS float* trs = (LAS float*)(misc + 2600);
    for (int i = tid; i < 24 * 1024; i += NTHR) { const int sl = i >> 10, k = i & 1023; float w;
        if (sl < 8) w = wgr[(size_t)k * 4 + (sl & 3)]; else { const int q = sl - 8, e = (q & 3) + 8 * ((q >> 2) & 1) + 4 * (q >> 3); w = wer[(size_t)k * 16 + e]; }
        w *= gvec[k];
        const unsigned hb = cvt_pk_bf16(w, 0.f) & 0xffffu; const float wl = w - __uint_as_float(hb << 16); const unsigned lb = cvt_pk_bf16(wl, 0.f) & 0xffffu;
        *(LAS unsigned short*)(Whi + sl * WROW + k * 2) = (unsigned short)hb; *(LAS unsigned short*)(Wlo + sl * WROW + k * 2) = (unsigned short)lb; }
    __syncthreads();
    const int slot_row = r32 < 24 ? r32 : r32 - 8;
    const LAS unsigned char* wh = Whi + slot_row * WROW + hi * 64; const LAS unsigned char* wl_ = Wlo + slot_row * WROW + hi * 64;
    for (int blk = blockIdx.x; blk < T / 256; blk += G) {
        const int rl = wave * 32 + r32, m = blk * 256 + rl;
        const bf16_t* xr = XB + (size_t)m * D + hi * 32;
        f32x16 acc = (f32x16){}; float ss = 0.f;
        bf16x8 xa[4], xb[4];
#pragma unroll
        for (int q = 0; q < 4; ++q) xa[q] = *(const bf16x8*)(xr + q * 8);
#pragma unroll 1
        for (int t = 0; t < 16; t += 2) {
#pragma unroll
            for (int q = 0; q < 4; ++q) xb[q] = *(const bf16x8*)(xr + (t + 1) * 64 + q * 8);
#pragma unroll
            for (int q = 0; q < 4; ++q) { const bf16x8 ah = *(const LAS bf16x8*)(wh + t * 128 + q * 16), al = *(const LAS bf16x8*)(wl_ + t * 128 + q * 16);
                acc = __builtin_amdgcn_mfma_f32_32x32x16_bf16(ah, xa[q], acc, 0, 0, 0); acc = __builtin_amdgcn_mfma_f32_32x32x16_bf16(al, xa[q], acc, 0, 0, 0);
#pragma unroll
                for (int j = 0; j < 4; ++j) { const unsigned w = ((const unsigned*)&xa[q])[j]; const float a = bf_lo(w), b = bf_hi(w); ss += a * a + b * b; } }
            if (t + 2 < 16) {
#pragma unroll
                for (int q = 0; q < 4; ++q) xa[q] = *(const bf16x8*)(xr + (t + 2) * 64 + q * 8); }
#pragma unroll
            for (int q = 0; q < 4; ++q) { const bf16x8 ah = *(const LAS bf16x8*)(wh + (t + 1) * 128 + q * 16), al = *(const LAS bf16x8*)(wl_ + (t + 1) * 128 + q * 16);
                acc = __builtin_amdgcn_mfma_f32_32x32x16_bf16(ah, xb[q], acc, 0, 0, 0); acc = __builtin_amdgcn_mfma_f32_32x32x16_bf16(al, xb[q], acc, 0, 0, 0);
#pragma unroll
                for (int j = 0; j < 4; ++j) { const unsigned w = ((const unsigned*)&xb[q])[j]; const float a = bf_lo(w), b = bf_hi(w); ss += a * a + b * b; } }
        }
        ss += __shfl_xor(ss, 32);
        const float rstd = 1.0f / sqrtf(ss * (1.0f / D) + NORM_EPS);
        float lg[4];
#pragma unroll
        for (int o = 0; o < 4; ++o) lg[o] = acc[o] * rstd + bgr[o];
        int gs = 0; float gm = lg[0];
#pragma unroll
        for (int o = 1; o < 4; ++o) if (lg[o] > gm) { gm = lg[o]; gs = o; }
        float den = 0.f;
#pragma unroll
        for (int o = 0; o < 4; ++o) den += __expf(lg[o] - gm);
        const float pg = 1.0f / den;
        if ((gs >> 1) == hi) {
            float el[4];
#pragma unroll
            for (int o = 0; o < 4; ++o) el[o] = ((gs & 1) ? acc[8 + o] : acc[4 + o]) * rstd + ber[gs * 4 + o];
            int i0 = 0; float v0 = el[0];
#pragma unroll
            for (int o = 1; o < 4; ++o) if (el[o] > v0) { v0 = el[o]; i0 = o; }
            int i1 = -1; float v1 = -INFINITY;
#pragma unroll
            for (int o = 0; o < 4; ++o) if (o != i0 && el[o] > v1) { v1 = el[o]; i1 = o; }
            const float ex = __expf(v1 - v0); const float w0 = 1.0f / (1.0f + ex), w1 = ex * w0;
            te[rl * 2] = gs * 4 + i0; te[rl * 2 + 1] = gs * 4 + i1; tc[rl * 2] = w0 * pg; tc[rl * 2 + 1] = w1 * pg; trs[rl] = rstd;
        }
        __syncthreads();
        if (tid < 16) { int c = 0; for (int q = 0; q < 512; ++q) if (te[q] == tid) { trank[q] = c; ++c; }
            ebase[tid] = c ? (int)__hip_atomic_fetch_add(cnt_cur + tid * 64, (unsigned)c, __ATOMIC_RELAXED, __HIP_MEMORY_SCOPE_AGENT) : 0; }
        __syncthreads();
        { const int q = tid, e = te[q], pos = ebase[e] + trank[q], tok = blk * 256 + (q >> 1);
          rowtok[(size_t)e * ECAP + pos] = (unsigned)tok; cwraw[(size_t)e * ECAP + pos] = tc[q]; rsraw[(size_t)e * ECAP + pos] = trs[q >> 1]; tokinfo[(size_t)tok * 2 + (q & 1)] = ((unsigned)e << 16) | (unsigned)pos; }
        __syncthreads();
    }
    __syncthreads();
}

__device__ __forceinline__ void phase_conv(const Params& p, int gw, int NGW, int lane) {
    const bf16_t* BG = (const bf16_t*)(p.ws + WS_BG); const bf16_t* Z = (const bf16_t*)(p.ws + WS_Z); bf16_t* A2 = (bf16_t*)(p.ws + WS_CAT);
    const float* cw = p.in[16];
    float w0[16], w1[16], w2[16];
#pragma unroll
    for (int h = 0; h < 2; ++h)
#pragma unroll
        for (int j = 0; j < 8; ++j) { const int c = h * 512 + lane * 8 + j; w0[h * 8 + j] = cw[c]; w1[h * 8 + j] = cw[D + c]; w2[h * 8 + j] = cw[2 * D + c]; }
    for (int run = gw; run < T / 32; run += NGW) {
        const int t0 = run * 32;
        float zm1[16], zm2[16];
#pragma unroll
        for (int j = 0; j < 16; ++j) { zm1[j] = 0.f; zm2[j] = 0.f; }
        if ((t0 & (SEQ - 1)) != 0) {
#pragma unroll
            for (int h = 0; h < 2; ++h) { const u32x4 a = *(const u32x4*)(Z + (size_t)(t0 - 1) * D + h * 512 + lane * 8), b = *(const u32x4*)(Z + (size_t)(t0 - 2) * D + h * 512 + lane * 8);
#pragma unroll
                for (int q = 0; q < 4; ++q) { zm1[h * 8 + 2 * q] = bf_lo(a[q]); zm1[h * 8 + 2 * q + 1] = bf_hi(a[q]); zm2[h * 8 + 2 * q] = bf_lo(b[q]); zm2[h * 8 + 2 * q + 1] = bf_hi(b[q]); } }
        }
#pragma unroll 4
        for (int i = 0; i < 32; ++i) {
            const size_t rb = (size_t)(t0 + i) * D;
#pragma unroll
            for (int h = 0; h < 2; ++h) { const u32x4 zz = *(const u32x4*)(Z + rb + h * 512 + lane * 8), bb = *(const u32x4*)(BG + rb + h * 512 + lane * 8);
                float o[8];
#pragma unroll
                for (int q = 0; q < 4; ++q) {
#pragma unroll
                    for (int s = 0; s < 2; ++s) { const int j = h * 8 + 2 * q + s; const float zc = s ? bf_hi(zz[q]) : bf_lo(zz[q]), bg = s ? bf_hi(bb[q]) : bf_lo(bb[q]);
                        o[2 * q + s] = bg * (w0[j] * zm2[j] + w1[j] * zm1[j] + w2[j] * zc); zm2[j] = zm1[j]; zm1[j] = zc; } }
                u32x4 w; w.x = cvt_pk_bf16(o[0], o[1]); w.y = cvt_pk_bf16(o[2], o[3]); w.z = cvt_pk_bf16(o[4], o[5]); w.w = cvt_pk_bf16(o[6], o[7]);
                *(u32x4*)(A2 + rb + h * 512 + lane * 8) = w; }
        }
    }
}

__device__ __forceinline__ void phase_gate_scan(const Params& p, int gw, int NGW, int lane) {
    const float* gates = (const float*)(p.ws + WS_GATES);
    float* SA = (float*)(p.ws + WS_SA); float* SAM = (float*)(p.ws + WS_SAM); float* SBA = (float*)(p.ws + WS_SBA);
    for (int sq = gw; sq < NBATCH * 4; sq += NGW) {
        const int b = sq >> 2, hd = sq & 3; const float ib = p.in[7][hd], fb = p.in[8][hd];
        float carryB = 0.f, carryM = -INFINITY;
#pragma unroll 1
        for (int i0 = 0; i0 < 32; i0 += 8) {
            float lf[8], ig[8];
#pragma unroll
            for (int i = 0; i < 8; ++i) { const size_t t = (size_t)b * SEQ + 64 * (i0 + i) + lane; const float f = gates[t * 8 + 4 + hd] + fb; ig[i] = gates[t * 8 + hd] + ib;
                lf[i] = (f >= 0.f) ? -log1pf(expf(-f)) : (f - log1pf(expf(f))); }
#pragma unroll
            for (int i = 0; i < 8; ++i) {
                float sB = lf[i];
#pragma unroll
                for (int o = 1; o < 64; o <<= 1) { const float v = __shfl_up(sB, o); if (lane >= o) sB += v; }
                sB += carryB; carryB = __shfl(sB, 63);
                const float a = ig[i] - sB;
                float m = a;
#pragma unroll
                for (int o = 1; o < 64; o <<= 1) { const float v = __shfl_up(m, o); if (lane >= o) m = fmaxf(m, v); }
                m = fmaxf(m, carryM); carryM = __shfl(m, 63);
                const size_t o2 = (size_t)sq * SEQ + 64 * (i0 + i) + lane; SA[o2] = a; SAM[o2] = m; SBA[o2] = sB + m;
            }
        }
    }
}

struct TileRegs { u32x4 v[2]; };
__device__ __forceinline__ TileRegs tile_load(const bf16_t* src, int tid) { TileRegs r;
#pragma unroll
    for (int i = 0; i < 2; ++i) { const int n = tid + 512 * i, row = n >> 4, ch = n & 15; r.v[i] = *(const u32x4*)(src + (size_t)row * NP + ch * 8); } return r; }
__device__ __forceinline__ void tile_write(LAS unsigned char* dst, int tid, const TileRegs& r) {
#pragma unroll
    for (int i = 0; i < 2; ++i) { const int n = tid + 512 * i, row = n >> 4, ch = n & 15; *(LAS u32x4*)(dst + off_b(row, ch)) = r.v[i]; } }

__device__ __forceinline__ void glds16(const void* gsrc, unsigned lds_dst) { unsigned keep;
    asm volatile("s_mov_b32 %0, m0\n\ts_mov_b32 m0, %2\n\ts_nop 0\n\tglobal_load_lds_dwordx4 %1, off\n\ts_mov_b32 m0, %0" : "=&s"(keep) : "v"(gsrc), "s"(lds_dst) : "memory"); }
__device__ __forceinline__ void tile_dma(const bf16_t* src, LAS unsigned char* dst, int wave, int lane) {
#pragma unroll
    for (int i = 0; i < 2; ++i) { const int piece = 2 * wave + i, row = 4 * piece + (lane >> 4); const unsigned ch = (unsigned)(lane & 15) ^ ((((unsigned)lane >> 4) << 2) | ((unsigned)piece & 3u));
        glds16(src + (size_t)row * NP + ch * 8, (unsigned)__builtin_amdgcn_readfirstlane((int)(unsigned)(uintptr_t)(dst + piece * 1024))); }
}
#define WAIT_ALL_BAR() asm volatile("s_waitcnt vmcnt(0) lgkmcnt(0)\n\ts_barrier" ::: "memory")
__device__ __forceinline__ void attn_unit(const Params& p, LAS unsigned char* lds, int bh, int qblk, int tid_, int wave, int lane_) {
    int tid = tid_; asm volatile("" : "+v"(tid)); const int lane = tid & 63;
    const bf16_t* P = (const bf16_t*)(p.ws + WS_P); bf16_t* CAT = (bf16_t*)(p.ws + WS_CAT);
    const int b = bh >> 2, hd = bh & 3, map = wave >> 2, qs = wave & 3, r32 = lane & 31, hi = lane >> 5;
    const size_t rowbase = (size_t)b * SEQ;
    const int q0 = qblk * 128 + qs * 32, qrow = q0 + r32;
    LAS float* fs = (LAS float*)(lds + MISC_OFF) + MW_F;
    LAS float* tbl = fs;
    constexpr float LOG2E = 1.4426950408889634f;
    if (tid < 272) { const int n = tid - 64; int bk;
        if (n < 16) bk = n < 0 ? 0 : n; else { bk = 16; const int th[15] = {19, 21, 24, 27, 31, 35, 40, 46, 52, 59, 67, 77, 87, 99, 113};
#pragma unroll
            for (int j = 0; j < 15; ++j) bk += (n >= th[j]) ? 1 : 0; }
        tbl[tid] = n < 0 ? -INFINITY : p.in[1][bk * 4 + hd] * LOG2E; }
    bf16x8 qf[4];
    { const bf16_t* qp = P + (rowbase + qrow) * NP + P_DQ + hd * 128 + map * 64 + hi * 8;
#pragma unroll
      for (int ks = 0; ks < 4; ++ks) qf[ks] = *(const bf16x8*)(qp + ks * 16); }
    const bf16_t* Kg = P + rowbase * NP + P_DK + hd * 128; const bf16_t* Vg = P + rowbase * NP + P_DV + hd * 128;
    const int NS = qblk + 1;
    f32x16 o[4];
#pragma unroll
    for (int c = 0; c < 4; ++c) o[c] = (f32x16){};
    float mrun = -INFINITY, lrun = 0.f;
    const float bias_far = p.in[1][31 * 4 + hd] * LOG2E;
    const unsigned xr = ((unsigned)(r32 & 3) << 2) | ((unsigned)(r32 >> 2) & 3u);
    const unsigned q4 = (lane & 15) >> 2, pp = lane & 3, blk = (lane >> 4) & 1;
#ifndef ATT_DMA
#define ATT_DMA 5
#endif
#ifndef ATT_LATE_DMA
#define ATT_LATE_DMA 1
#endif
#if ATT_DMA == 2 || ATT_DMA == 4
#elif ATT_DMA
    WAIT_ALL_BAR();
    { tile_dma(Kg, lds, wave, lane); tile_dma(Vg, lds + 16384, wave, lane); tile_dma(Kg + (size_t)64 * NP, lds + 32768, wave, lane); tile_dma(Vg + (size_t)64 * NP, lds + 49152, wave, lane); }
#else
    { TileRegs a0 = tile_load(Kg, tid), a1 = tile_load(Vg, tid), a2 = tile_load(Kg + (size_t)64 * NP, tid), a3 = tile_load(Vg + (size_t)64 * NP, tid);
      tile_write(lds, tid, a0); tile_write(lds + 16384, tid, a1); tile_write(lds + 32768, tid, a2); tile_write(lds + 49152, tid, a3); }
#endif
#if ATT_DMA == 5
    WAIT_ALL_BAR();
#endif
    asm volatile("" :: "v"(qf[0]), "v"(qf[1]), "v"(qf[2]), "v"(qf[3]));
#pragma unroll 1
    for (int st = 0; st < NS; ++st) {
        WAIT_ALL_BAR();
#if ATT_DMA == 2
        { LAS unsigned char* nb = lds + (st & 1) * 65536; const size_t ro = (size_t)st * 128 * NP;
            tile_dma(Kg + ro, nb, wave, lane); tile_dma(Vg + ro, nb + 16384, wave, lane); tile_dma(Kg + ro + (size_t)64 * NP, nb + 32768, wave, lane); tile_dma(Vg + ro + (size_t)64 * NP, nb + 49152, wave, lane); }
        WAIT_ALL_BAR();
#elif ATT_DMA == 3
#elif ATT_DMA
#if ATT_DMA == 4
        if (st == 0) { tile_dma(Kg, lds, wave, lane); tile_dma(Vg, lds + 16384, wave, lane); tile_dma(Kg + (size_t)64 * NP, lds + 32768, wave, lane); tile_dma(Vg + (size_t)64 * NP, lds + 49152, wave, lane); WAIT_ALL_BAR(); }
#endif
        if (!ATT_LATE_DMA && st + 1 < NS) { LAS unsigned char* nb = lds + ((st + 1) & 1) * 65536; const size_t ro = (size_t)(st + 1) * 128 * NP;
            tile_dma(Kg + ro, nb, wave, lane); tile_dma(Vg + ro, nb + 16384, wave, lane); tile_dma(Kg + ro + (size_t)64 * NP, nb + 32768, wave, lane); tile_dma(Vg + ro + (size_t)64 * NP, nb + 49152, wave, lane); }
#else
        TileRegs a0, a1;
        if (st + 1 < NS) { const size_t ro = (size_t)(st + 1) * 128 * NP; a0 = tile_load(Kg + ro, tid); a1 = tile_load(Vg + ro, tid); }
#endif
#pragma unroll
        for (int half = 0; half < 2; ++half) {
            const int j = 2 * st + half;
            const LAS unsigned char* Kt = lds + (st & 1) * 65536 + half * 32768; const LAS unsigned char* Vt = Kt + 16384;
            if (64 * j <= q0 + 31) {
                const int nmin = q0 - (64 * j + 63);
                const bool first = (mrun == -INFINITY);
                const float cinit = first ? 0.f : (nmin >= 113 ? bias_far - mrun : -mrun);
                f32x16 p0, p1;
#pragma unroll
                for (int r = 0; r < 16; ++r) { p0[r] = cinit; p1[r] = cinit; }
#pragma unroll
                for (int ks = 0; ks < 4; ++ks) { const unsigned ch = (unsigned)(8 * map + 2 * ks + hi) ^ xr;
                    const bf16x8 k0 = *(const LAS bf16x8*)(Kt + 256u * r32 + 16u * ch), k1 = *(const LAS bf16x8*)(Kt + 256u * (32 + r32) + 16u * ch);
                    p0 = __builtin_amdgcn_mfma_f32_32x32x16_bf16(k0, qf[ks], p0, 0, 0, 0); p1 = __builtin_amdgcn_mfma_f32_32x32x16_bf16(k1, qf[ks], p1, 0, 0, 0); }
                __builtin_amdgcn_sched_barrier(0);
                float rm = -INFINITY;
                if (first) {
                    if (nmin >= 113) {
#pragma unroll
                        for (int r = 0; r < 16; ++r) { p0[r] = p0[r] + bias_far; p1[r] = p1[r] + bias_far; rm = fmaxf(rm, fmaxf(p0[r], p1[r])); }
                    } else {
                        const LAS float* tb = tbl + (qrow - 64 * j - 4 * hi + 5);
#pragma unroll
                        for (int r = 0; r < 16; ++r) { const int e = (r & 3) + 8 * (r >> 2);
                            p0[r] += tb[59 - e]; p1[r] += tb[27 - e];
                            rm = fmaxf(rm, fmaxf(p0[r], p1[r])); }
                    }
                    { auto rr = __builtin_amdgcn_permlane32_swap(__float_as_uint(rm), __float_as_uint(rm), false, false); rm = fmaxf(__uint_as_float(rr[0]), __uint_as_float(rr[1])); }
                    mrun = rm;
#pragma unroll
                    for (int r = 0; r < 16; ++r) { p0[r] -= mrun; p1[r] -= mrun; }
                } else {
                    if (nmin < 113) {
                        const LAS float* tb = tbl + (qrow - 64 * j - 4 * hi + 5);
                        float bv0[16], bv1[16];
#pragma unroll
                        for (int r = 0; r < 16; ++r) { const int e = (r & 3) + 8 * (r >> 2); bv0[r] = tb[59 - e]; bv1[r] = tb[27 - e]; }
#pragma unroll
                        for (int r = 0; r < 16; ++r) { p0[r] += bv0[r]; p1[r] += bv1[r]; }
                    }
                    { float m0 = fmaxf(p0[0], p1[0]), m1 = fmaxf(p0[1], p1[1]);
#pragma unroll
                      for (int r = 2; r < 16; r += 2) { m0 = __builtin_fmaxf(__builtin_fmaxf(m0, p0[r]), p1[r]); m1 = __builtin_fmaxf(__builtin_fmaxf(m1, p0[r + 1]), p1[r + 1]); }
                      rm = fmaxf(m0, m1); }
                    { auto rr = __builtin_amdgcn_permlane32_swap(__float_as_uint(rm), __float_as_uint(rm), false, false); rm = fmaxf(__uint_as_float(rr[0]), __uint_as_float(rr[1])); }
                    if (__any(rm > 8.0f)) {
                        const float dl = fmaxf(rm, 0.f); const float alpha = fast_exp2(-dl);
                        lrun *= alpha; mrun += dl;
#pragma unroll
                        for (int r = 0; r < 16; ++r) { p0[r] -= dl; p1[r] -= dl; }
#pragma unroll
                        for (int c = 0; c < 4; ++c)
#pragma unroll
                            for (int r = 0; r < 16; ++r) o[c][r] *= alpha;
                    }
                }
                float psa = 0.f, psb = 0.f;
                bf16x8 pf[4];
#define ATT_EXPK(ks_) do { u32x4 w_; _Pragma("unroll") for (int q = 0; q < 4; ++q) { const int r = 8 * ((ks_) & 1) + 2 * q; \
                        const float ea = fast_exp2((ks_) < 2 ? p0[r] : p1[r]), eb = fast_exp2((ks_) < 2 ? p0[r + 1] : p1[r + 1]); psa += ea; psb += eb; w_[q] = cvt_pk_bf16(ea, eb); } \
                    pf[ks_] = __builtin_bit_cast(bf16x8, w_); } while (0)
                bf16x8 vf[2][4];
#define ATT_LOADV(buf, ks_) do { _Pragma("unroll") for (int c = 0; c < 4; ++c) { const unsigned chv = (unsigned)(4 * c + 2 * blk + (pp >> 1)); const unsigned row0 = 16u * (ks_) + 4u * hi + q4; \
                        vf[buf][c] = cat8(vtr(Vt + off_b(row0, chv) + 8u * (pp & 1)), vtr(Vt + off_b(row0 + 8u, chv) + 8u * (pp & 1))); } } while (0)
                ATT_LOADV(0, 0);
                ATT_EXPK(0);
                if (ATT_LATE_DMA && half == 0 && st + 1 < NS) {
                    LAS unsigned char* nb = lds + ((st + 1) & 1) * 65536; const size_t ro = (size_t)(st + 1) * 128 * NP;
                    tile_dma(Kg + ro, nb, wave, lane); tile_dma(Vg + ro, nb + 16384, wave, lane); tile_dma(Kg + ro + (size_t)64 * NP, nb + 32768, wave, lane); tile_dma(Vg + ro + (size_t)64 * NP, nb + 49152, wave, lane); }
#pragma unroll
                for (int ks = 0; ks < 4; ++ks) {
                    if (ks < 3) ATT_LOADV((ks + 1) & 1, ks + 1);
                    __builtin_amdgcn_sched_barrier(0);
#pragma unroll
                    for (int c = 0; c < 4; ++c) o[c] = __builtin_amdgcn_mfma_f32_32x32x16_bf16(vf[ks & 1][c], pf[ks], o[c], 0, 0, 0);
                    if (ks < 3) { ATT_EXPK(ks + 1); asm volatile("" : "+v"(pf[(ks + 1) & 3]), "+v"(psa), "+v"(psb)); }
                    __builtin_amdgcn_sched_barrier(0);
                }
                lrun += psa + psb;
#undef ATT_EXPK
#undef ATT_LOADV
            }
#if ATT_DMA == 5
            if (half == 0) WAIT_ALL_BAR();
#endif
#if !ATT_DMA
            if (st + 1 < NS) { LAS unsigned char* nb = lds + ((st + 1) & 1) * 65536 + half * 32768; tile_write(nb, tid, a0); tile_write(nb + 16384, tid, a1);
                if (half == 0) { const size_t ro = (size_t)(st + 1) * 128 * NP + (size_t)64 * NP; a0 = tile_load(Kg + ro, tid); a1 = tile_load(Vg + ro, tid); } }
#endif
        }
#if ATT_DMA == 3
        WAIT_ALL_BAR();
        if (st + 1 < NS) { LAS unsigned char* nb = lds + ((st + 1) & 1) * 65536; const size_t ro = (size_t)(st + 1) * 128 * NP;
            tile_dma(Kg + ro, nb, wave, lane); tile_dma(Vg + ro, nb + 16384, wave, lane); tile_dma(Kg + ro + (size_t)64 * NP, nb + 32768, wave, lane); tile_dma(Vg + ro + (size_t)64 * NP, nb + 49152, wave, lane); }
#endif

    }
    WAIT_ALL_BAR();
    lrun += __shfl_xor(lrun, 32);
    const float inv = 1.0f / lrun;
    float lam;
    { float s1 = 0.f, s2 = 0.f; const float a1 = p.in[10][lane] * p.in[11][lane], a2 = p.in[12][lane] * p.in[13][lane]; s1 = wave_sum(a1); s2 = wave_sum(a2);
      const float lam_init = 0.8f - 0.6f * 1.0f;
      lam = expf(s1) - expf(s2) + lam_init; }
    LAS float* xch = (LAS float*)lds + qs * 4096;
    if (map == 1) {
#pragma unroll
        for (int c = 0; c < 4; ++c)
#pragma unroll
            for (int r = 0; r < 16; ++r) xch[(32 * c + crow(r, hi)) * 32 + r32] = o[c][r] * inv * lam;
    }
    __syncthreads();
    if (map == 0) {
        float ss = 0.f;
#pragma unroll
        for (int c = 0; c < 4; ++c)
#pragma unroll
            for (int r = 0; r < 16; ++r) { const float v = o[c][r] * inv - xch[(32 * c + crow(r, hi)) * 32 + r32]; o[c][r] = v; ss += v * v; }
        ss += __shfl_xor(ss, 32);
        const float rstd = 1.0f / sqrtf(ss * (1.0f / 128.0f) + NORM_EPS) * 0.8f;
        const float* sub = p.in[14];
        bf16_t* orow = CAT + (rowbase + qrow) * D + 512 + hd * 128;
#pragma unroll
        for (int c = 0; c < 4; ++c)
#pragma unroll
            for (int rqp = 0; rqp < 4; rqp += 2) { u32x2 w[2];
#pragma unroll
                for (int h = 0; h < 2; ++h) { const int rq = rqp + h; const int e0 = 32 * c + 8 * rq + 4 * hi; const f32x4 sv = *(const f32x4*)(sub + e0);
                    w[h].x = cvt_pk_bf16(o[c][4 * rq] * rstd * sv[0], o[c][4 * rq + 1] * rstd * sv[1]); w[h].y = cvt_pk_bf16(o[c][4 * rq + 2] * rstd * sv[2], o[c][4 * rq + 3] * rstd * sv[3]); }
                const auto rx = __builtin_amdgcn_permlane32_swap(w[0].x, w[1].x, false, false); const auto ry = __builtin_amdgcn_permlane32_swap(w[0].y, w[1].y, false, false);
                u32x4 ww; ww.x = rx[0]; ww.y = ry[0]; ww.z = rx[1]; ww.w = ry[1];
                *(u32x4*)(orow + 32 * c + 8 * (rqp + hi)) = ww; }
    }
    __syncthreads();
}

__device__ __forceinline__ void mlstm_s1_unit(const Params& p, LAS unsigned char* lds, int bh, int c, int tid_, int wave, int lane_) {
    int tid = tid_; asm volatile("" : "+v"(tid)); const int lane = tid & 63;
    const bf16_t* P = (const bf16_t*)(p.ws + WS_P);
    const int b = bh >> 2, hd = bh & 3, r32 = lane & 31, hi = lane >> 5;
    const size_t t0 = (size_t)b * SEQ + (size_t)c * MCH;
    const float* SA = (const float*)(p.ws + WS_SA) + (size_t)bh * SEQ + c * MCH;
    LAS float* fs = (LAS float*)(lds + MISC_OFF) + MW_F;
    LAS float* wsm = fs;
    LAS float* red = fs + 256;
    float av = (tid < 256) ? SA[tid] : -INFINITY;
    float mx = av;
#pragma unroll
    for (int o = 1; o < 64; o <<= 1) mx = fmaxf(mx, __shfl_xor(mx, o));
    if (lane == 0) red[wave] = mx;
    __syncthreads();
    float R = red[0];
#pragma unroll
    for (int w = 1; w < 4; ++w) R = fmaxf(R, red[w]);
    if (tid < 256) wsm[tid] = __expf(av - R) * 0.08838834764831845f;
    __syncthreads();
    LAS unsigned char* Kl = lds; LAS unsigned char* Vl = lds + 65536;
    const bf16_t* Kg = P + t0 * NP + P_MK + hd * 128; const bf16_t* Vg = P + t0 * NP + P_MV + hd * 128;
#pragma unroll
    for (int i = 0; i < 8; ++i) { const int n = tid + 512 * i, row = n >> 4, ch = n & 15;
        const u32x4 kv = *(const u32x4*)(Kg + (size_t)row * NP + ch * 8); const u32x4 vv = *(const u32x4*)(Vg + (size_t)row * NP + ch * 8);
        const float w = wsm[row]; u32x4 ks;
#pragma unroll
        for (int q = 0; q < 4; ++q) ks[q] = cvt_pk_bf16(bf_lo(kv[q]) * w, bf_hi(kv[q]) * w);
        *(LAS u32x4*)(Kl + off_b(row, ch)) = ks; *(LAS u32x4*)(Vl + off_b(row, ch)) = vv; }
    __syncthreads();
    const int eb = wave >> 1, dh = wave & 1;
    const unsigned q4 = (lane & 15) >> 2, pp = lane & 3, blk = (lane >> 4) & 1;
    f32x16 acc[2]; acc[0] = (f32x16){}; acc[1] = (f32x16){};
    for (int ks = 0; ks < 16; ++ks) {
        const unsigned row0 = 16u * ks + 8u * hi + q4, row1 = row0 + 4u;
        const unsigned cha = (unsigned)(4 * eb + 2 * blk + (pp >> 1));
        const bf16x8 af = cat8(vtr(Vl + off_b(row0, cha) + 8u * (pp & 1)), vtr(Vl + off_b(row1, cha) + 8u * (pp & 1)));
#pragma unroll
        for (int db = 0; db < 2; ++db) { const unsigned chb = (unsigned)(4 * (2 * dh + db) + 2 * blk + (pp >> 1));
            const bf16x8 bfr = cat8(vtr(Kl + off_b(row0, chb) + 8u * (pp & 1)), vtr(Kl + off_b(row1, chb) + 8u * (pp & 1)));
            acc[db] = __builtin_amdgcn_mfma_f32_32x32x16_bf16(af, bfr, acc[db], 0, 0, 0); }
    }
    const int unit = bh * NCH + c;
    float* UT = (float*)(p.ws + WS_UT) + (size_t)unit * 16384;
#pragma unroll
    for (int db = 0; db < 2; ++db)
#pragma unroll
        for (int r = 0; r < 16; ++r) UT[(32 * eb + crow(r, hi)) * 128 + 64 * dh + 32 * db + r32] = acc[db][r];
    if (tid < 128) { float s = 0.f; const int d = tid;
        for (int srow = 0; srow < 256; ++srow) { const unsigned short hv = *(const LAS unsigned short*)(Kl + off_b(srow, d >> 3) + (d & 7) * 2); s += __uint_as_float((unsigned)hv << 16); }
        ((float*)(p.ws + WS_UN))[(size_t)unit * 128 + d] = s; }
    if (tid == 0) ((float*)(p.ws + WS_UR))[unit] = R;
    __syncthreads();
}

__device__ __forceinline__ void mlstm_s3_unit(const Params& p, LAS unsigned char* lds, int bh, int c, int tid_, int wave, int lane_) {
    int tid = tid_; asm volatile("" : "+v"(tid)); const int lane = tid & 63;
    const bf16_t* P = (const bf16_t*)(p.ws + WS_P); bf16_t* CAT = (bf16_t*)(p.ws + WS_CAT);
    const int b = bh >> 2, hd = bh & 3, r32 = lane & 31, hi = lane >> 5;
    const size_t t0 = (size_t)b * SEQ + (size_t)c * MCH;
    const size_t so = (size_t)bh * SEQ + c * MCH;
    const float* SA = (const float*)(p.ws + WS_SA) + so; const float* SAM = (const float*)(p.ws + WS_SAM) + so; const float* SBA = (const float*)(p.ws + WS_SBA) + so;
    LAS float* fs = (LAS float*)(lds + MISC_OFF) + MW_F;
    LAS float* as = fs;
    LAS float* nC = fs + 256;
    LAS unsigned char* Ct = lds + 65536;
    const int qloc = 32 * wave + r32;
    const float Aq = SAM[qloc], BAq = SBA[qloc];
    if (tid < 256) as[tid] = SA[tid];
    bf16x8 qf[8];
    { const bf16_t* qp = P + (t0 + qloc) * NP + P_MQ + hd * 128 + hi * 8;
#pragma unroll
      for (int ks = 0; ks < 8; ++ks) qf[ks] = *(const bf16x8*)(qp + ks * 16); }
    const bf16_t* Kg = P + t0 * NP + P_MK + hd * 128; const bf16_t* Vg = P + t0 * NP + P_MV + hd * 128;
#if defined(S3_REGSTAGE)
    { TileRegs k0 = tile_load(Kg, tid), v0 = tile_load(Vg, tid); tile_write(lds, tid, k0); tile_write(lds + 16384, tid, v0); }
#elif !defined(S3_SERIAL)
    tile_dma(Kg, lds, wave, lane); tile_dma(Vg, lds + 16384, wave, lane);
#endif
    f32x16 o[4];
#pragma unroll
    for (int cb = 0; cb < 4; ++cb) o[cb] = (f32x16){};
    float den = 0.f, fst = 0.f;
    const unsigned xr = ((unsigned)(r32 & 3) << 2) | ((unsigned)(r32 >> 2) & 3u);
    if (c > 0) {
        const float* UR = (const float*)(p.ws + WS_UR) + bh * NCH; const float* UT = (const float*)(p.ws + WS_UT) + (size_t)bh * NCH * 16384; const float* UN = (const float*)(p.ws + WS_UN) + (size_t)bh * NCH * 128;
        float Pref = -INFINITY, ur[7];
#pragma unroll
        for (int j = 0; j < 7; ++j) { ur[j] = UR[j]; if (j < c) Pref = fmaxf(Pref, ur[j]); }
        float cf[7];
#pragma unroll
        for (int j = 0; j < 7; ++j) cf[j] = (j < c) ? __expf(ur[j] - Pref) : 0.f;
#pragma unroll 1
        for (int i = 0; i < 4; ++i) { const int n = tid + 512 * i, e = n >> 4, ch = n & 15; f32x4 u0[7], u1[7];
#pragma unroll
            for (int j = 0; j < 7; ++j) { const f32x4* up = (const f32x4*)(UT + (size_t)j * 16384 + e * 128 + ch * 8); u0[j] = up[0]; u1[j] = up[1]; }
            f32x4 s0 = (f32x4){0.f, 0.f, 0.f, 0.f}, s1 = s0;
#pragma unroll
            for (int j = 0; j < 7; ++j) { s0 += u0[j] * cf[j]; s1 += u1[j] * cf[j]; }
            u32x4 w; w.x = cvt_pk_bf16(s0[0], s0[1]); w.y = cvt_pk_bf16(s0[2], s0[3]); w.z = cvt_pk_bf16(s1[0], s1[1]); w.w = cvt_pk_bf16(s1[2], s1[3]);
            *(LAS u32x4*)(Ct + off_b(e, ch)) = w; }
        if (tid < 128) { float sN = 0.f;
#pragma unroll
            for (int j = 0; j < 7; ++j) sN += cf[j] * UN[j * 128 + tid];
            nC[tid] = sN; }
        fst = __expf(Pref - Aq);
    }
    asm volatile("" :: "v"(qf[0]), "v"(qf[1]), "v"(qf[2]), "v"(qf[3]), "v"(qf[4]), "v"(qf[5]), "v"(qf[6]), "v"(qf[7]), "v"(Aq), "v"(BAq));
    WAIT_ALL_BAR();
    if (c > 0) {
#pragma unroll
        for (int cb = 0; cb < 4; ++cb) {
#pragma unroll
            for (int ks = 0; ks < 8; ++ks) { const unsigned ch = (unsigned)(2 * ks + hi) ^ xr;
                const bf16x8 cfr = *(const LAS bf16x8*)(Ct + 256u * (32 * cb + r32) + 16u * ch);
                o[cb] = __builtin_amdgcn_mfma_f32_32x32x16_bf16(cfr, qf[ks], o[cb], 0, 0, 0); }
            __builtin_amdgcn_sched_barrier(0); }
#pragma unroll
        for (int cb = 0; cb < 4; ++cb)
#pragma unroll
            for (int r = 0; r < 16; ++r) o[cb][r] *= fst;
        float dq = 0.f;
#pragma unroll
        for (int ks = 0; ks < 8; ++ks)
#pragma unroll
            for (int q = 0; q < 4; ++q) { const unsigned w = ((const unsigned*)&qf[ks])[q]; const int d = 16 * ks + 8 * hi + 2 * q; dq += bf_lo(w) * nC[d] + bf_hi(w) * nC[d + 1]; }
        den = fst * dq;
    }
    const unsigned q4 = (lane & 15) >> 2, pp = lane & 3, blk = (lane >> 4) & 1;
#pragma unroll 1
    for (int j = 0; j < 4; ++j) {
        WAIT_ALL_BAR();
        const LAS unsigned char* Kt = lds + (j & 1) * 32768; const LAS unsigned char* Vt = Kt + 16384;
#if defined(S3_REGSTAGE)
        TileRegs kr, vr; if (j + 1 < 4) { kr = tile_load(Kg + (size_t)(j + 1) * 64 * NP, tid); vr = tile_load(Vg + (size_t)(j + 1) * 64 * NP, tid); }
#elif defined(S3_SERIAL)
        { LAS unsigned char* nb = lds + (j & 1) * 32768; tile_dma(Kg + (size_t)j * 64 * NP, nb, wave, lane); tile_dma(Vg + (size_t)j * 64 * NP, nb + 16384, wave, lane); }
        WAIT_ALL_BAR();
#else
        if (j + 1 < 4) { LAS unsigned char* nb = lds + ((j + 1) & 1) * 32768; tile_dma(Kg + (size_t)(j + 1) * 64 * NP, nb, wave, lane); tile_dma(Vg + (size_t)(j + 1) * 64 * NP, nb + 16384, wave, lane); }
#endif
        const bool doit = (64 * j <= 32 * wave + 31);
        bf16x8 pf[4];
        if (doit) {
            f32x16 p0 = (f32x16){}, p1 = (f32x16){};
#pragma unroll
            for (int ks = 0; ks < 8; ++ks) { const unsigned ch = (unsigned)(2 * ks + hi) ^ xr;
                const bf16x8 k0 = *(const LAS bf16x8*)(Kt + 256u * r32 + 16u * ch), k1 = *(const LAS bf16x8*)(Kt + 256u * (32 + r32) + 16u * ch);
                p0 = __builtin_amdgcn_mfma_f32_32x32x16_bf16(k0, qf[ks], p0, 0, 0, 0); p1 = __builtin_amdgcn_mfma_f32_32x32x16_bf16(k1, qf[ks], p1, 0, 0, 0); if ((ks & 3) == 3) __builtin_amdgcn_sched_barrier(0); }
            float ps = 0.f;
#pragma unroll
            for (int r = 0; r < 16; ++r) { const int kv = 64 * j + crow(r, hi);
                const float w0 = (kv <= qloc) ? __expf(as[kv] - Aq) * 0.08838834764831845f : 0.f, w1 = (kv + 32 <= qloc) ? __expf(as[kv + 32] - Aq) * 0.08838834764831845f : 0.f;
                p0[r] *= w0; p1[r] *= w1; ps += p0[r] + p1[r]; }
            den += ps;
#pragma unroll
            for (int ks = 0; ks < 4; ++ks) { u32x4 w;
#pragma unroll
                for (int q = 0; q < 4; ++q) { const int r = 8 * (ks & 1) + 2 * q; w[q] = (ks < 2) ? cvt_pk_bf16(p0[r], p0[r + 1]) : cvt_pk_bf16(p1[r], p1[r + 1]); }
                pf[ks] = __builtin_bit_cast(bf16x8, w); }
        }
        WAIT_ALL_BAR();
        if (doit) {
            bf16x8 vf[2][4];
#define S3_LOADV(buf, ks_) do { _Pragma("unroll") for (int cb = 0; cb < 4; ++cb) { const unsigned chv = (unsigned)(4 * cb + 2 * blk + (pp >> 1)); const unsigned row0 = 16u * (ks_) + 4u * hi + q4; \
                vf[buf][cb] = cat8(vtr(Vt + off_b(row0, chv) + 8u * (pp & 1)), vtr(Vt + off_b(row0 + 8u, chv) + 8u * (pp & 1))); } } while (0)
            S3_LOADV(0, 0);
#pragma unroll
            for (int ks = 0; ks < 4; ++ks) {
                if (ks < 3) S3_LOADV((ks + 1) & 1, ks + 1);
                __builtin_amdgcn_sched_barrier(0);
#pragma unroll
                for (int cb = 0; cb < 4; ++cb) o[cb] = __builtin_amdgcn_mfma_f32_32x32x16_bf16(vf[ks & 1][cb], pf[ks], o[cb], 0, 0, 0);
                __builtin_amdgcn_sched_barrier(0);
            }
#undef S3_LOADV
        }
#if defined(S3_REGSTAGE)
        if (j + 1 < 4) { LAS unsigned char* nb = lds + ((j + 1) & 1) * 32768; tile_write(nb, tid, kr); tile_write(nb + 16384, tid, vr); }
#endif
    }
    den += __shfl_xor(den, 32);
    const float dinv = 1.0f / fmaxf(fabsf(den), __expf(-BAq));
    float sm = 0.f;
#pragma unroll
    for (int cb = 0; cb < 4; ++cb)
#pragma unroll
        for (int r = 0; r < 16; ++r) { o[cb][r] *= dinv; sm += o[cb][r]; }
    sm += __shfl_xor(sm, 32);
    const float mu = sm * (1.0f / 128.0f);
    float vs = 0.f;
#pragma unroll
    for (int cb = 0; cb < 4; ++cb)
#pragma unroll
        for (int r = 0; r < 16; ++r) { o[cb][r] -= mu; vs += o[cb][r] * o[cb][r]; }
    vs += __shfl_xor(vs, 32);
    const float rstd = 1.0f / sqrtf(vs * (1.0f / 128.0f) + NORM_EPS);
    const float* hn = p.in[9] + hd * 128;
    const bf16_t* mo = P + (t0 + qloc) * NP + P_MO + hd * 128;
    bf16_t* orow = CAT + (t0 + qloc) * D + hd * 128;
    u32x2 mw[4][4];
#pragma unroll
    for (int cb = 0; cb < 4; ++cb)
#pragma unroll
        for (int rq = 0; rq < 4; ++rq) mw[cb][rq] = *(const u32x2*)(mo + 32 * cb + 8 * rq + 4 * hi);
#pragma unroll
    for (int cb = 0; cb < 4; ++cb)
#pragma unroll
        for (int rq = 0; rq < 4; ++rq) { const int e0 = 32 * cb + 8 * rq + 4 * hi; const f32x4 hv = *(const f32x4*)(hn + e0); const u32x2 m2 = mw[cb][rq];
            const float g0 = fast_rcp(1.0f + __expf(-bf_lo(m2.x))), g1 = fast_rcp(1.0f + __expf(-bf_hi(m2.x))), g2 = fast_rcp(1.0f + __expf(-bf_lo(m2.y))), g3 = fast_rcp(1.0f + __expf(-bf_hi(m2.y)));
            u32x2 w; w.x = cvt_pk_bf16(o[cb][4 * rq] * rstd * hv[0] * g0, o[cb][4 * rq + 1] * rstd * hv[1] * g1); w.y = cvt_pk_bf16(o[cb][4 * rq + 2] * rstd * hv[2] * g2, o[cb][4 * rq + 3] * rstd * hv[3] * g3);
            *(u32x2*)(orow + e0) = w; }
    WAIT_ALL_BAR();
}

__device__ __forceinline__ void mlstm_seq_unit(const Params& p, LAS unsigned char* lds, int bh, int tid_, int wave, int lane_) {
    int tid = tid_; asm volatile("" : "+v"(tid)); const int lane = tid & 63;
    const bf16_t* P = (const bf16_t*)(p.ws + WS_P); bf16_t* CAT = (bf16_t*)(p.ws + WS_CAT);
    const int b = bh >> 2, hd = bh & 3, r32 = lane & 31, hi = lane >> 5;
    LAS float* fs = (LAS float*)(lds + MISC_OFF) + MW_F;
    LAS float* as = fs;
    LAS float* nC = fs + 256;
    LAS float* wsc = fs + 384;
    LAS unsigned char* Ct = lds + 65536;
    const unsigned xr = ((unsigned)(r32 & 3) << 2) | ((unsigned)(r32 >> 2) & 3u);
    const unsigned q4 = (lane & 15) >> 2, pp = lane & 3, blk = (lane >> 4) & 1;
    const int eb = wave >> 1, dh = wave & 1;
    f32x16 cacc[2]; cacc[0] = (f32x16){}; cacc[1] = (f32x16){};
    float nrun = 0.f;
    float Prun = -INFINITY;
    LAS float* hnl = fs + 896;
    if (tid < 128) hnl[tid] = p.in[9][hd * 128 + tid];
#pragma unroll 1
    for (int c = 0; c < NCH; ++c) {
        const size_t t0 = (size_t)b * SEQ + (size_t)c * MCH;
        const size_t so = (size_t)bh * SEQ + c * MCH;
        const float* SA = (const float*)(p.ws + WS_SA) + so; const float* SAM = (const float*)(p.ws + WS_SAM) + so; const float* SBA = (const float*)(p.ws + WS_SBA) + so;
        const int qloc = 32 * wave + r32;
        const float Aq2 = SAM[qloc] * 1.4426950408889634f;
        if (tid < 256) as[tid] = SA[tid] * 1.4426950408889634f;
        bf16x8 qf[2];
        LAS bf16x8* qpark = (LAS bf16x8*)(lds + 98304 + tid * 64);
        LAS bf16x8* qpark2 = (LAS bf16x8*)(lds + 147456 + tid * 32);
        { const bf16_t* qp = P + (t0 + qloc) * NP + P_MQ + hd * 128 + hi * 8;
#pragma unroll
          for (int ks = 0; ks < 2; ++ks) qf[ks] = *(const bf16x8*)(qp + ks * 16);
#pragma unroll
          for (int ks = 2; ks < 6; ++ks) qpark[ks - 2] = *(const bf16x8*)(qp + ks * 16);
#pragma unroll
          for (int ks = 6; ks < 8; ++ks) qpark2[ks - 6] = *(const bf16x8*)(qp + ks * 16); }
#define QFRAG(ks) ((ks) < 2 ? qf[(ks) & 1] : ((ks) < 6 ? qpark[((ks) - 2) & 3] : qpark2[((ks) - 6) & 1]))
        const bf16_t* Kg = P + t0 * NP + P_MK + hd * 128; const bf16_t* Vg = P + t0 * NP + P_MV + hd * 128;
        tile_dma(Kg, lds, wave, lane); tile_dma(Vg, lds + 16384, wave, lane);
        asm volatile("" :: "v"(qf[0]), "v"(qf[1]), "v"(Aq2));
        WAIT_ALL_BAR();
        float R = fmaxf(fmaxf(as[lane], as[lane + 64]), fmaxf(as[lane + 128], as[lane + 192]));
#pragma unroll
        for (int o = 1; o < 64; o <<= 1) R = fmaxf(R, __shfl_xor(R, o));
        R *= (1.0f / 1.4426950408889634f);
        const float Pnew = fmaxf(Prun, R);
        const float scC = (c > 0) ? __expf(Prun - Pnew) : 0.f;
        if (tid < 256) wsc[tid] = fast_exp2(as[tid] - Pnew * 1.4426950408889634f) * 0.08838834764831845f;
        f32x16 o[4];
#pragma unroll
        for (int cb = 0; cb < 4; ++cb) o[cb] = (f32x16){};
        float den = 0.f;
        if (c > 0) {
#pragma unroll
            for (int cb = 0; cb < 4; ++cb) {
#pragma unroll
                for (int ks = 0; ks < 8; ++ks) { const unsigned ch = (unsigned)(2 * ks + hi) ^ xr;
                    const bf16x8 cfr = *(const LAS bf16x8*)(Ct + 256u * (32 * cb + r32) + 16u * ch);
                    const bf16x8 qv = QFRAG(ks);
                    o[cb] = __builtin_amdgcn_mfma_f32_32x32x16_bf16(cfr, qv, o[cb], 0, 0, 0); }
                __builtin_amdgcn_sched_barrier(0); }
            const float fst = fast_exp2(Prun * 1.4426950408889634f - Aq2);
#pragma unroll
            for (int cb = 0; cb < 4; ++cb)
#pragma unroll
                for (int r = 0; r < 16; ++r) o[cb][r] *= fst;
            float dq = 0.f;
#pragma unroll
            for (int ks = 0; ks < 8; ++ks) { const bf16x8 qv = QFRAG(ks);
#pragma unroll
                for (int q = 0; q < 4; ++q) { const unsigned w = ((const unsigned*)&qv)[q]; const int d = 16 * ks + 8 * hi + 2 * q; dq += bf_lo(w) * nC[d] + bf_hi(w) * nC[d + 1]; } }
            den = fst * dq;
#pragma unroll
            for (int r = 0; r < 16; ++r) { cacc[0][r] *= scC; cacc[1][r] *= scC; }
        }
        nrun *= scC;
#pragma unroll 1
        for (int j = 0; j < 4; ++j) {
            WAIT_ALL_BAR();
            const LAS unsigned char* Kt = lds + (j & 1) * 32768; const LAS unsigned char* Vt = Kt + 16384;
            if (j + 1 < 4) { LAS unsigned char* nb = lds + ((j + 1) & 1) * 32768; tile_dma(Kg + (size_t)(j + 1) * 64 * NP, nb, wave, lane); tile_dma(Vg + (size_t)(j + 1) * 64 * NP, nb + 16384, wave, lane); }
            const bool doit = (64 * j <= 32 * wave + 31);
            if (doit) {
                float ps = 0.f;
#pragma unroll
                for (int hf = 0; hf < 2; ++hf) {
                    f32x16 pp0 = (f32x16){};
#pragma unroll
                    for (int ks = 0; ks < 8; ++ks) { const unsigned ch = (unsigned)(2 * ks + hi) ^ xr;
                        const bf16x8 k0 = *(const LAS bf16x8*)(Kt + 256u * (32 * hf + r32) + 16u * ch);
                        const bf16x8 qv = QFRAG(ks);
                        pp0 = __builtin_amdgcn_mfma_f32_32x32x16_bf16(k0, qv, pp0, 0, 0, 0); }
#pragma unroll
                    for (int r = 0; r < 16; ++r) { const int kv = 64 * j + 32 * hf + crow(r, hi);
                        const float w0 = (kv <= qloc) ? fast_exp2(as[kv] - Aq2) * 0.08838834764831845f : 0.f;
                        pp0[r] *= w0; ps += pp0[r]; }
                    bf16x8 pfh[2];
#pragma unroll
                    for (int k2 = 0; k2 < 2; ++k2) { u32x4 w;
#pragma unroll
                        for (int q = 0; q < 4; ++q) { const int r = 8 * k2 + 2 * q; w[q] = cvt_pk_bf16(pp0[r], pp0[r + 1]); }
                        pfh[k2] = __builtin_bit_cast(bf16x8, w); }
                    __builtin_amdgcn_sched_barrier(0);
#pragma unroll
                    for (int k2 = 0; k2 < 2; ++k2)
#pragma unroll
                        for (int c2 = 0; c2 < 2; ++c2) {
                            bf16x8 vf[2];
#pragma unroll
                            for (int u = 0; u < 2; ++u) { const int cb = 2 * c2 + u; const unsigned chv = (unsigned)(4 * cb + 2 * blk + (pp >> 1)); const unsigned row0 = 16u * (2 * hf + k2) + 4u * hi + q4;
                                vf[u] = cat8(vtr(Vt + off_b(row0, chv) + 8u * (pp & 1)), vtr(Vt + off_b(row0 + 8u, chv) + 8u * (pp & 1))); }
                            o[2 * c2] = __builtin_amdgcn_mfma_f32_32x32x16_bf16(vf[0], pfh[k2], o[2 * c2], 0, 0, 0); o[2 * c2 + 1] = __builtin_amdgcn_mfma_f32_32x32x16_bf16(vf[1], pfh[k2], o[2 * c2 + 1], 0, 0, 0);
                            __builtin_amdgcn_sched_barrier(0);
                        }
                }
                den += ps;
            }
#pragma unroll
            for (int ks = 0; ks < 4; ++ks) {
                const unsigned row0 = 16u * ks + 8u * hi + q4, row1 = row0 + 4u;
                const unsigned cha = (unsigned)(4 * eb + 2 * blk + (pp >> 1));
                const bf16x8 af = cat8(vtr(Vt + off_b(row0, cha) + 8u * (pp & 1)), vtr(Vt + off_b(row1, cha) + 8u * (pp & 1)));
                const f32x4 wa = *(const LAS f32x4*)(wsc + 64 * j + 16 * ks + 8 * hi), wb = *(const LAS f32x4*)(wsc + 64 * j + 16 * ks + 8 * hi + 4);
#pragma unroll
                for (int db = 0; db < 2; ++db) { const unsigned chb = (unsigned)(4 * (2 * dh + db) + 2 * blk + (pp >> 1));
                    const s16x4 k0 = vtr(Kt + off_b(row0, chb) + 8u * (pp & 1)), k1 = vtr(Kt + off_b(row1, chb) + 8u * (pp & 1));
                    const u32x2 u0 = __builtin_bit_cast(u32x2, k0), u1 = __builtin_bit_cast(u32x2, k1);
                    u32x4 kw; kw.x = cvt_pk_bf16(bf_lo(u0.x) * wa[0], bf_hi(u0.x) * wa[1]); kw.y = cvt_pk_bf16(bf_lo(u0.y) * wa[2], bf_hi(u0.y) * wa[3]);
                    kw.z = cvt_pk_bf16(bf_lo(u1.x) * wb[0], bf_hi(u1.x) * wb[1]); kw.w = cvt_pk_bf16(bf_lo(u1.y) * wb[2], bf_hi(u1.y) * wb[3]);
                    cacc[db] = __builtin_amdgcn_mfma_f32_32x32x16_bf16(af, __builtin_bit_cast(bf16x8, kw), cacc[db], 0, 0, 0); }
                __builtin_amdgcn_sched_barrier(0);
            }
            { const int d = tid & 127, sq = tid >> 7; float sN = 0.f;
#pragma unroll 4
                for (int s2 = 0; s2 < 16; ++s2) { const int srow = 16 * sq + s2; const unsigned short hv = *(const LAS unsigned short*)(Kt + off_b(srow, d >> 3) + (d & 7) * 2); sN += __uint_as_float((unsigned)hv << 16) * wsc[64 * j + srow]; }
                nrun += sN; }
            WAIT_ALL_BAR();
        }
        int tid2 = tid_; asm volatile("" : "+v"(tid2));
        const int qloc2 = 32 * wave + (tid2 & 31), hi2 = (tid2 >> 5) & 1;
        const float BAq = SBA[qloc2];
        den += __shfl_xor(den, 32);
        const float dinv = 1.0f / fmaxf(fabsf(den), __expf(-BAq));
        float sm = 0.f;
#pragma unroll
        for (int cb = 0; cb < 4; ++cb)
#pragma unroll
            for (int r = 0; r < 16; ++r) { o[cb][r] *= dinv; sm += o[cb][r]; }
        sm += __shfl_xor(sm, 32);
        const float mu = sm * (1.0f / 128.0f);
        float vs = 0.f;
#pragma unroll
        for (int cb = 0; cb < 4; ++cb)
#pragma unroll
            for (int r = 0; r < 16; ++r) { o[cb][r] -= mu; vs += o[cb][r] * o[cb][r]; }
        vs += __shfl_xor(vs, 32);
        const float rstd = 1.0f / sqrtf(vs * (1.0f / 128.0f) + NORM_EPS);
        const bf16_t* mo = P + (t0 + qloc2) * NP + P_MO + hd * 128 + 4 * hi2;
        bf16_t* orow0 = CAT + (t0 + qloc2) * D + hd * 128;
#pragma unroll
        for (int c2 = 0; c2 < 2; ++c2) {
            u32x2 mw[8]; u32x2 wk = {0u, 0u};
#pragma unroll
            for (int u = 0; u < 8; u += 2) { const u32x4 g4 = *(const u32x4*)(mo - 4 * hi2 + 32 * (2 * c2 + (u >> 2)) + 8 * ((u & 3) + hi2));
                const auto rx = __builtin_amdgcn_permlane32_swap(g4.x, g4.z, false, false); const auto ry = __builtin_amdgcn_permlane32_swap(g4.y, g4.w, false, false);
                mw[u].x = rx[0]; mw[u].y = ry[0]; mw[u + 1].x = rx[1]; mw[u + 1].y = ry[1]; }
#pragma unroll
            for (int u = 0; u < 8; ++u) { const int cb = 2 * c2 + (u >> 2), rq = u & 3; const int e0 = 32 * cb + 8 * rq; const u32x2 m2 = mw[u]; const f32x4 hv = *(const LAS f32x4*)(hnl + e0 + 4 * hi2);
                const float g0 = fast_rcp(1.0f + fast_exp2(-1.4426950408889634f * bf_lo(m2.x))), g1 = fast_rcp(1.0f + fast_exp2(-1.4426950408889634f * bf_hi(m2.x))), g2 = fast_rcp(1.0f + fast_exp2(-1.4426950408889634f * bf_lo(m2.y))), g3 = fast_rcp(1.0f + fast_exp2(-1.4426950408889634f * bf_hi(m2.y)));
                u32x2 w; w.x = cvt_pk_bf16(o[cb][4 * rq] * rstd * hv[0] * g0, o[cb][4 * rq + 1] * rstd * hv[1] * g1); w.y = cvt_pk_bf16(o[cb][4 * rq + 2] * rstd * hv[2] * g2, o[cb][4 * rq + 3] * rstd * hv[3] * g3);
                if ((u & 1) == 0) wk = w;
                else { const auto sx = __builtin_amdgcn_permlane32_swap(wk.x, w.x, false, false); const auto sy = __builtin_amdgcn_permlane32_swap(wk.y, w.y, false, false);
                    u32x4 ww; ww.x = sx[0]; ww.y = sy[0]; ww.z = sx[1]; ww.w = sy[1];
                    *(u32x4*)(orow0 + 32 * cb + 8 * (rq - 1 + hi2)) = ww; } }
            __builtin_amdgcn_sched_barrier(0); }
        if (c + 1 < NCH) {
#pragma unroll
            for (int db = 0; db < 2; ++db)
#pragma unroll
                for (int r = 0; r < 16; ++r) { const int e = 32 * eb + crow(r, hi), d = 64 * dh + 32 * db + r32;
                    *(LAS unsigned short*)(Ct + off_b(e, d >> 3) + (d & 7) * 2) = (unsigned short)(cvt_pk_bf16(cacc[db][r], 0.f) & 0xffffu); }
            wsc[tid] = nrun;
        }
        Prun = Pnew;
        WAIT_ALL_BAR();
        if (c + 1 < NCH) { if (tid < 128) nC[tid] = (wsc[tid] + wsc[tid + 128]) + (wsc[tid + 256] + wsc[tid + 384]); }
    }
#undef QFRAG
}

__device__ __forceinline__ int moe_table(LAS unsigned char* lds, unsigned* cnt, int tid) {
    LAS int* misc = (LAS int*)(lds + MISC_OFF);
    __syncthreads();
    if (tid == 0) { int acc = 0; for (int e = 0; e < 16; ++e) { const int c = (int)__hip_atomic_load(cnt + e * 64, __ATOMIC_RELAXED, __HIP_MEMORY_SCOPE_AGENT); misc[MW_CN + e] = c; misc[MW_TB + e] = acc; acc += (c + 255) >> 8; } misc[MW_TB + 16] = acc; }
    __syncthreads();
    return misc[MW_TB + 16];
}

#ifndef STAGGER_MASK
#define STAGGER_MASK 0u
#endif
#ifndef STAGGER_GROUPS
#define STAGGER_GROUPS 4
#endif
#ifndef STAGGER_TICKS
#define STAGGER_TICKS 700
#endif
__device__ __forceinline__ void stagger(int vcu, int phase_bit) {
    if (!((STAGGER_MASK >> phase_bit) & 1u)) return;
    const int g = vcu & (STAGGER_GROUPS - 1); if (g == 0) return;
    const unsigned long long t0 = __builtin_amdgcn_s_memrealtime(); const unsigned long long w = (unsigned long long)g * STAGGER_TICKS;
    while (__builtin_amdgcn_s_memrealtime() - t0 < w) __builtin_amdgcn_s_sleep(8);
}
constexpr int LATE_UNITS = 224, LATE_UNITS_A = 160, LATE_UNITS_B = 64, CW_LATEQ = CW_QUEUE + 64 * 8;
template <int QID>
__device__ __forceinline__ void late_convert(const Params& p, LAS unsigned char* lds, unsigned* ctl, int quota, int tid, int wave, int lane) {
    volatile LAS unsigned* misc = (volatile LAS unsigned*)(lds + MISC_OFF);
    for (int k = 0; k < quota; ++k) {
        __syncthreads();
        if (tid == 0) misc[MW_Q] = __hip_atomic_fetch_add(ctl + CW_LATEQ + 64 * QID, 1u, __ATOMIC_RELAXED, __HIP_MEMORY_SCOPE_AGENT);
        __syncthreads();
        const int q = (int)misc[MW_Q];
        if (q >= 4 * (QID == 0 ? LATE_UNITS_A : LATE_UNITS_B)) break;
        const int c = q >> 2, sub = q & 3;
        const int v = QID == 0 ? (c < 32 ? 8 + c : 232 + 12 * ((c - 32) >> 3) + ((c - 32) & 7)) : 232 + 12 * (c >> 2) + 8 + (c & 3);
        const int f = WT_I1 + 64 * v + 16 * sub + 2 * wave;
        phase_prologue_weights(p, lds, f, f + 2, 1, wave, lane);
    }
    __syncthreads();
}
template <int LAYER>
__device__ __forceinline__ void moe_block(const Params& p, LAS unsigned char* lds, const XcdBarrier& bar, unsigned* ctl, int tid, int wave, int lane, int vcu, int G) {
    unsigned char* ws = p.ws;
    const LAS int* tb = (const LAS int*)(lds + MISC_OFF) + MW_TB; const LAS int* cn = (const LAS int*)(lds + MISC_OFF) + MW_CN;
    unsigned* cnt = ctl + CW_CNT + LAYER * 16 * 64;
    if (PH(12)) phase_router(p, lds, tid, wave, G, p.in[3] + LAYER * D, p.in[18] + (size_t)LAYER * D * 4, p.in[19] + LAYER * 4, p.in[20] + (size_t)LAYER * D * 16, p.in[21] + LAYER * 16, cnt);
    xcd_barrier(bar);
    const int ntot = moe_table(lds, cnt, tid);
    stagger(vcu, 13);
    for (int rep_ = 0; rep_ < REPS(13); ++rep_) if (PH(13)) { pg8::MoeSched<true> S{(const char*)(ws + WS_XB8), (const char*)(ws + WS_WGU) + (size_t)LAYER * 16 * 1024 * 1024, 512, (size_t)1024 * 1024, tb, cn, (const unsigned*)(ws + WS_ROWTOK), ntot, vcu, G};
      pg8::EpiPair<1> E{nullptr, (bf16_t*)(ws + WS_HM), FF, (const float*)(ws + WS_RSRAW), (const unsigned*)(ws + WS_ROWTOK), tb, cn};
      pg8::gemm_phase<pg8::EpiPair<1>, pg8::MoeSched<true>, true, true>(lds, 512, S, E); }
    const int nun = ntot * 4, rounds_max = (nun + G - 1) / G, rounds_mine = nun > vcu ? (nun - vcu + G - 1) / G : 0;
    if (LATE_CV && LAYER == 0 && PH(0)) late_convert<0>(p, lds, ctl, 2 * (rounds_max - rounds_mine), tid, wave, lane);
    if (LATE_CV && LAYER == 1 && PH(0)) { late_convert<1>(p, lds, ctl, 2 * (rounds_max - rounds_mine), tid, wave, lane); late_convert<1>(p, lds, ctl, 1 << 20, tid, wave, lane); }
    xcd_barrier(bar);
    stagger(vcu, 14);
    for (int rep_ = 0; rep_ < REPS(14); ++rep_) if (PH(14)) { pg8::MoeSched<false> S{(const char*)(ws + WS_HM), (const char*)(ws + WS_WD) + (size_t)LAYER * 16 * 1024 * 512, 256, (size_t)1024 * 512, tb, cn, nullptr, ntot, vcu, G};
      pg8::EpiDown E{(unsigned char*)(ws + WS_YC), (const float*)(ws + WS_CWRAW), tb, cn};
      pg8::gemm_phase<pg8::EpiDown, pg8::MoeSched<false>, false, true>(lds, 256, S, E); }
    if (LATE_CV && LAYER == 0 && PH(0)) { late_convert<0>(p, lds, ctl, rounds_max - rounds_mine, tid, wave, lane); late_convert<0>(p, lds, ctl, 1 << 20, tid, wave, lane); }
    xcd_barrier(bar);
}

__global__ void __launch_bounds__(NTHR, 2) fwd_kernel(Params p) {
    extern __shared__ __attribute__((aligned(16))) unsigned char lds_raw[];
    LAS unsigned char* lds = (LAS unsigned char*)lds_raw;
    const int tid = threadIdx.x, lane = tid & 63, wave = __builtin_amdgcn_readfirstlane(tid >> 6);
    const int G = gridDim.x; const int bx = blockIdx.x;
    const int vcu = (G % 8 == 0) ? (bx % 8) * (G / 8) + bx / 8 : bx;
    const int gw = vcu * NWAVES + wave, NGW = G * NWAVES;
    volatile LAS unsigned* misc = (volatile LAS unsigned*)(lds + MISC_OFF);
    for (int u = tid; u < (LDS_BYTES - MISC_OFF) / 4; u += NTHR) misc[u] = 0u;
    __syncthreads();
    unsigned* ctl = (unsigned*)(p.ws + WS_CTL);
    XcdBarrier bar = xcd_barrier_post(ctl + CW_BAR, misc + MW_BAR);
    unsigned char* ws = p.ws;

    for (int rep_ = 0; rep_ < REPS(0); ++rep_) if (PH(0)) phase_prologue_weights(p, lds, gw, WT_I1, NGW, wave, lane);
    __syncthreads();
    for (int rep_ = 0; rep_ < REPS(1); ++rep_) if (PH(1)) phase_norm_gates(p, lds, tid, gw, NGW, lane);
    xcd_barrier(bar);

    if (PH(2)) phase_gate_scan(p, gw, NGW, lane);
    stagger(vcu, 3);
    for (int rep_ = 0; rep_ < REPS(3); ++rep_) if (PH(3)) { pg8::DenseSched S; S.init(ws + WS_H, ws + WS_WT1, T, NP, 1024, G, bx); pg8::EpiBf16 E{(bf16_t*)(ws + WS_P), NP};
      pg8::gemm_phase<pg8::EpiBf16, pg8::DenseSched, false>(lds, 1024, S, E); }
    xcd_barrier(bar);

    {
        constexpr int NSEQ = NBATCH * 4, NAT = NBATCH * 4 * 16, NMEM = LATE_CV ? WT_UNITS - LATE_UNITS : WT_UNITS;
        for (int u = bx; u < NSEQ; u += G) { for (int r2 = 0; r2 < REPS(16); ++r2) if (PH(4)) mlstm_seq_unit(p, lds, u, tid, wave, lane); }
        for (int rep_ = 0; rep_ < REPS(4); ++rep_) {
            bool a_done = false, m_done = false; int sa_cnt = 0, sm_cnt = 0; (void)sa_cnt; (void)sm_cnt;
            for (int it = 0; !(a_done && m_done); ++it) {
                const int r5 = it % 5; bool want_mem = (r5 == 1 || r5 == 3);
                if (want_mem && m_done) want_mem = false; else if (!want_mem && a_done) want_mem = true;
                __syncthreads();
#ifdef STATIC_Q
                if (tid == 0) { misc[MW_Q] = (unsigned)((want_mem ? sm_cnt : sa_cnt) * G + bx); }
                if (want_mem) ++sm_cnt; else ++sa_cnt;
#else
                if (tid == 0) misc[MW_Q] = __hip_atomic_fetch_add(ctl + CW_QUEUE + 64 * (2 * rep_ + (want_mem ? 1 : 0)), 1u, __ATOMIC_RELAXED, __HIP_MEMORY_SCOPE_AGENT);
#endif
                __syncthreads();
                const int u = (int)misc[MW_Q];
                if (want_mem) {
                    if (u >= NMEM) { m_done = true; continue; }
                    { const int v = LATE_CV ? (u < 8 ? u : u + 32) : u;        for (int r2 = 0; r2 < REPS(18); ++r2) if (PH(0)) { const int f = WT_I1 + 64 * v + 8 * wave; phase_prologue_weights(p, lds, f, f + 8, 1, wave, lane); } }
                } else {
                    if (u >= NAT) { a_done = true; continue; }
                    for (int r2 = 0; r2 < REPS(17); ++r2) if (PH(5)) attn_unit(p, lds, u & 127, 15 - (u >> 7), tid, wave, lane);
                }
            }
        }
    }
    xcd_barrier(bar);

    for (int rep_ = 0; rep_ < REPS(7); ++rep_) if (PH(7)) { pg8::DenseSched S; S.init(ws + WS_CAT, ws + WS_WT2, T, 1024, 1024, G, bx); pg8::EpiResid<true> E{p.in[0], (bf16_t*)(ws + WS_XB), ws + WS_XB8};
      pg8::gemm_phase<pg8::EpiResid<true>, pg8::DenseSched, false>(lds, 1024, S, E); }
    xcd_barrier(bar);

    moe_block<0>(p, lds, bar, ctl, tid, wave, lane, vcu, G);
    if (PH(8)) phase_rows<0, true>(p, lds, tid, wave, lane, G, p.in[2] + D, nullptr, nullptr, nullptr, nullptr, ctl + CW_CNT, nullptr);
    xcd_barrier(bar);
    stagger(vcu, 9);
    for (int rep_ = 0; rep_ < REPS(9); ++rep_) if (PH(9)) { pg8::DenseSched S; S.init(G3_F8 ? ws + WS_XB8 : ws + WS_XB, ws + WS_WT3, T, 3072, G3_F8 ? 512 : 1024, G, bx); pg8::EpiPair<0> E{(bf16_t*)(ws + WS_BG), (bf16_t*)(ws + WS_Z), D, (const float*)(ws + WS_RSTD), nullptr, nullptr, nullptr};
      pg8::gemm_phase<pg8::EpiPair<0>, pg8::DenseSched, false, G3_F8 != 0>(lds, G3_F8 ? 512 : 1024, S, E); }
    xcd_barrier(bar);
    for (int rep_ = 0; rep_ < REPS(10); ++rep_) if (PH(10)) phase_conv(p, gw, NGW, lane);
    xcd_barrier(bar);
    if (PH(11)) { pg8::DenseSched S; S.init(ws + WS_CAT, ws + WS_WT4, T, 1024, 1024, G, bx); pg8::EpiResid<false> E{nullptr, (bf16_t*)(ws + WS_XB), ws + WS_XB8};
      pg8::gemm_phase<pg8::EpiResid<false>, pg8::DenseSched, false>(lds, 1024, S, E); }
    xcd_barrier(bar);
    moe_block<1>(p, lds, bar, ctl, tid, wave, lane, vcu, G);
    if (PH(15)) phase_rows<2, true>(p, lds, tid, wave, lane, G, p.in[4], nullptr, nullptr, nullptr, nullptr, ctl + CW_CNT + 16 * 64, nullptr);
}

extern "C" void kernel_launch(void* const* d_in, const int* in_sizes, int n_in, void* d_out, int out_size, void* d_ws, size_t ws_size, hipStream_t stream) {
    static int grid = 0;
    if (grid == 0) {
        if (n_in != 25 || in_sizes[0] != T * D || out_size != T * D || ws_size < WS_END) { fprintf(stderr, "kernel_launch: unexpected shapes (n_in %d, in0 %d, out %d, ws %zu)\n", n_in, n_in > 0 ? in_sizes[0] : -1, out_size, ws_size); grid = -1; return; }
        int dev = 0, cus = 0, per_cu = 0;
        if (hipGetDevice(&dev) != hipSuccess || hipDeviceGetAttribute(&cus, hipDeviceAttributeMultiprocessorCount, dev) != hipSuccess) { grid = -1; return; }
        if (hipFuncSetAttribute((const void*)fwd_kernel, hipFuncAttributeMaxDynamicSharedMemorySize, LDS_BYTES) != hipSuccess) { fprintf(stderr, "kernel_launch: hipFuncSetAttribute failed\n"); grid = -1; return; }
        if (hipOccupancyMaxActiveBlocksPerMultiprocessor(&per_cu, (const void*)fwd_kernel, NTHR, LDS_BYTES) != hipSuccess || per_cu < 1) fprintf(stderr, "kernel_launch: occupancy query reports %d\n", per_cu);
        (void)hipGetLastError();
        grid = cus;
    }
    if (grid < 0) return;
    hipMemsetAsync((char*)d_ws + WS_CTL, 0, CTL_ZERO_BYTES, stream);
    Params p{};
    for (int i = 0; i < 25; ++i) p.in[i] = (const float*)d_in[i];
    p.out = (float*)d_out; p.ws = (unsigned char*)d_ws;
    hipLaunchKernelGGL(fwd_kernel, dim3(grid), dim3(NTHR), LDS_BYTES, stream, p);
}
```

```cpp
#include <hip/hip_runtime.h>
#include <cstdio>
#include <cstdint>
#ifndef PHASE_MASK
#define PHASE_MASK 0xffffffffu
#endif
#define PH(k) (((PHASE_MASK) >> (k)) & 1u)
#ifndef PHASE_TWICE
#define PHASE_TWICE 0u
#endif
#define REPS(k) (1 + (int)(((PHASE_TWICE) >> (k)) & 1u))

#define LAS __attribute__((address_space(3)))
#define GAS __attribute__((address_space(1)))
typedef unsigned short bf16_t;
typedef short bf16x8 __attribute__((ext_vector_type(8)));
typedef short s16x4 __attribute__((ext_vector_type(4)));
typedef float f32x4 __attribute__((ext_vector_type(4)));
typedef float f32x2 __attribute__((ext_vector_type(2)));
typedef float f32x16 __attribute__((ext_vector_type(16)));
typedef unsigned u32x4 __attribute__((ext_vector_type(4)));
typedef unsigned u32x2 __attribute__((ext_vector_type(2)));
typedef GAS unsigned gu32;
typedef int i32x8 __attribute__((ext_vector_type(8)));
typedef int i32x4 __attribute__((ext_vector_type(4)));

constexpr int D = 1024, NBATCH = 32, SEQ = 2048, T = NBATCH * SEQ;
constexpr int EVEN_IN = 3592, NP = 3584;
constexpr int P_MQ = 0, P_MK = 512, P_MV = 1024, P_MO = 1536, P_DQ = 2048, P_DK = 2560, P_DV = 3072;
constexpr int NE = 16, FF = 512;
constexpr int ECAP = 65536;
constexpr float NORM_EPS = 1e-6f;
constexpr int NWAVES = 8, NTHR = 512;
constexpr int MCH = 256, NCH = SEQ / MCH;
constexpr int WT_I1 = 16 * 112, WT_ITEMS = 28928, WT_UNITS = (WT_ITEMS - WT_I1) / 64;

constexpr size_t MiB = 1u << 20;
constexpr size_t WS_CTL = 0, CTL_ZERO_BYTES = 1 * MiB;
constexpr size_t WS_WT1 = 1 * MiB, WS_WT2 = 8 * MiB, WS_WT3 = 10 * MiB, WS_WT4 = 16 * MiB, WS_WGU = 18 * MiB, WS_WD = 82 * MiB;
constexpr size_t WS_GATES = 114 * MiB, WS_SA = 116 * MiB, WS_SAM = 117 * MiB, WS_SBA = 118 * MiB, WS_UN = 119 * MiB, WS_UR = 119 * MiB + 768 * 1024;
constexpr size_t WS_UT = 120 * MiB;
constexpr size_t WS_ROWTOK = 184 * MiB, WS_CWRAW = 188 * MiB, WS_TOKINFO = 192 * MiB, WS_RSTD = 193 * MiB;
constexpr size_t WS_H = 194 * MiB, WS_CAT = 322 * MiB, WS_P = 450 * MiB;
constexpr size_t WS_RSRAW = 120 * MiB;
constexpr size_t WS_XB8 = 720 * MiB;
constexpr size_t WS_XB = WS_H;
constexpr size_t WS_BG = WS_P, WS_Z = WS_P + 128 * MiB, WS_HM = WS_P, WS_YC = WS_P + 136 * MiB;
constexpr size_t WS_END = 898 * MiB;
constexpr int CW_BAR = 4096;
constexpr int CW_CNT = 16384;
constexpr int CW_QUEUE = 32768;

__device__ __forceinline__ unsigned cvt_pk_bf16(float lo, float hi) { unsigned r; asm volatile("v_cvt_pk_bf16_f32 %0, %1, %2" : "=v"(r) : "v"(lo), "v"(hi)); return r; }
__device__ __forceinline__ unsigned cvt_pk4_fp8(float a, float b, float c, float d) { unsigned w = 0; w = (unsigned)__builtin_amdgcn_cvt_pk_fp8_f32(a, b, (int)w, false); w = (unsigned)__builtin_amdgcn_cvt_pk_fp8_f32(c, d, (int)w, true); return w; }
#ifndef LATE_CV
#define LATE_CV 1
#endif
#ifndef G3_F8
#define G3_F8 1
#endif
constexpr float F8_WSCALE = 64.0f, F8_HSCALE = 16.0f, F8_YSCALE = 64.0f;
__device__ __forceinline__ float bf_lo(unsigned w) { return __uint_as_float(w << 16); }
__device__ __forceinline__ float bf_hi(unsigned w) { return __uint_as_float(w & 0xffff0000u); }
__device__ __forceinline__ float wave_sum(float v) {
#pragma unroll
    for (int o = 1; o < 64; o <<= 1) v += __shfl_xor(v, o);
    return v;
}
__device__ __forceinline__ float fast_exp2(float x) { return __builtin_amdgcn_exp2f(x); }
__device__ __forceinline__ float fast_rcp(float x) { return __builtin_amdgcn_rcpf(x); }
__device__ __forceinline__ int crow(int r, int hi) { return (r & 3) + 8 * (r >> 2) + 4 * hi; }
__device__ __forceinline__ unsigned off_b(unsigned row, unsigned ch) { return 256u * row + 16u * (ch ^ (((row & 3u) << 2) | ((row >> 2) & 3u))); }
__device__ __forceinline__ s16x4 vtr(const LAS unsigned char* p) { return __builtin_bit_cast(s16x4, __builtin_amdgcn_ds_read_tr16_b64_v4i16((LAS s16x4*)p)); }
__device__ __forceinline__ bf16x8 cat8(s16x4 a, s16x4 b) { return (bf16x8){a[0], a[1], a[2], a[3], b[0], b[1], b[2], b[3]}; }

#define XB_TMO      128
#define XB_XCNT(j)  (256  + 64 * (j))
#define XB_XSUB(j)  (1280 + 64 * (j))
#define XB_XGEN(j)  (2304 + 64 * (j))
#define XB_TOP      3328
#define XB_TOPGEN   3392
#define XCD_BAR_WORDS 3456
#define XB_SPIN_CAP (1u << 18)
__device__ __forceinline__ unsigned xb_ld(unsigned* p)              { return __hip_atomic_load(p, __ATOMIC_RELAXED, __HIP_MEMORY_SCOPE_AGENT); }
__device__ __forceinline__ unsigned xb_add(unsigned* p, unsigned v) { return __hip_atomic_fetch_add(p, v, __ATOMIC_RELAXED, __HIP_MEMORY_SCOPE_AGENT); }
__device__ __forceinline__ unsigned xb_xcc_id() { return (unsigned)__builtin_amdgcn_s_getreg((3 << 11) | 20) & 0xFu; }
#define XB_SPIN(cond, bar) do { unsigned _sp = 0; while (cond) { __builtin_amdgcn_s_sleep(1); \
    if ((++_sp & 255u) == 0u) { if (xb_ld(&(bar)[XB_TMO])) break; if (_sp > XB_SPIN_CAP) { atomicAdd(&(bar)[XB_TMO], 1u); break; } } } } while (0)
struct XcdBarrier { unsigned* bar; unsigned x; volatile LAS unsigned* st; };
__device__ __forceinline__ XcdBarrier xcd_barrier_post(unsigned* bar, volatile LAS unsigned* st) {
    XcdBarrier b; b.bar = bar; b.x = xb_xcc_id(); b.st = st;
    if (threadIdx.x == 0) (void)xb_add(&bar[XB_XCNT(b.x)], 1u);
    return b;
}
__device__ __forceinline__ void xcd_barrier_complete(unsigned* bar, unsigned x, unsigned& nloc, unsigned& nx) {
    const unsigned G = gridDim.x * gridDim.y * gridDim.z;
    unsigned sum, cnt, mine, sp = 0u;
    for (;;) {
        sum = 0u; cnt = 0u; mine = 0u;
#pragma unroll
        for (unsigned j = 0; j < 16; ++j) { const unsigned c = xb_ld(&bar[XB_XCNT(j)]); sum += c; cnt += (c > 0u) ? 1u : 0u; mine = (j == x) ? c : mine; }
        if (sum == G) break;
        __builtin_amdgcn_s_sleep(1);
        if ((++sp & 255u) == 0u) { if (xb_ld(&bar[XB_TMO])) break; if (sp > XB_SPIN_CAP) { atomicAdd(&bar[XB_TMO], 1u); break; } }
    }
    nloc = mine > 0u ? mine : 1u; nx = cnt > 0u ? cnt : 1u;
}
__device__ __forceinline__ void xcd_barrier(const XcdBarrier& b) {
    asm volatile("s_waitcnt vmcnt(0)" ::: "memory");
    __syncthreads();
    if (threadIdx.x == 0) {
        unsigned* bar = b.bar;
        __builtin_amdgcn_s_waitcnt(0);
        unsigned nloc = b.st[0], nx = b.st[1];
        if (nloc == 0u) { xcd_barrier_complete(bar, b.x, nloc, nx); b.st[0] = nloc; b.st[1] = nx; }
        const unsigned old = xb_add(&bar[XB_XSUB(b.x)], 1u);
        const unsigned gen = old / nloc;
        if (old + 1u == (gen + 1u) * nloc) {
            __builtin_amdgcn_fence(__ATOMIC_RELEASE, "agent");
            asm volatile("s_waitcnt vmcnt(0)" ::: "memory");
            const unsigned og = xb_add(&bar[XB_TOP], 1u);
            const unsigned tg = og / nx;
            if (og + 1u == (tg + 1u) * nx) xb_add(&bar[XB_TOPGEN], 1u);
            else XB_SPIN(xb_ld(&bar[XB_TOPGEN]) == tg, bar);
            __builtin_amdgcn_fence(__ATOMIC_ACQUIRE, "agent");
            xb_add(&bar[XB_XGEN(b.x)], 1u);
            asm volatile("s_waitcnt vmcnt(0)" ::: "memory");
        } else {
            XB_SPIN(xb_ld(&bar[XB_XGEN(b.x)]) == gen, bar);
            __builtin_amdgcn_fence(__ATOMIC_ACQUIRE, "agent");
            asm volatile("s_waitcnt vmcnt(0)" ::: "memory");
        }
    }
    __syncthreads();
}

namespace pg8 {
constexpr int BM = 256, BK = 64, HALF = 128, HTB = HALF * BK * 2, STAGE_BYTES = 8 * HTB, NXCD = 8, WGM = 8;
__device__ __forceinline__ int lds_byte(int r, int c) { const int st = (r >> 4) * 2 + (c >> 5), rr = r & 15, cc = c & 31, ob = rr * 64 + cc * 2; return st * 1024 + (ob ^ (((ob >> 9) & 1) << 5)); }
__device__ __forceinline__ void stage_rc(int b, int& R, int& C) { const int st = b / 1024, sb = b % 1024, swz = sb ^ (((sb >> 9) & 1) << 5); R = (st >> 1) * 16 + swz / 64; C = (st & 1) * 32 + (swz % 64) / 2; }
__device__ __forceinline__ int perm32(int rho) { const int n = rho >> 4, i = rho & 15; return 8 * (i >> 2) + 4 * n + (i & 3); }
struct Unit { int pm, pn; };

template <class Epi, class Sched, bool GATHER, bool F8 = false>
__device__ __forceinline__ void gemm_phase(LAS unsigned char* lds, const int K, const Sched& S, const Epi& E) {
    int tid = threadIdx.x; asm volatile("" : "+v"(tid));
    const int wid = __builtin_amdgcn_readfirstlane(tid >> 6), lane = tid & 63, wr = wid >> 2, wc = wid & 3, fr = lane & 15, fq = lane >> 4;
    const int nt = K / BK;
    int Rr[2], Cc[2]; unsigned voffB[2];
#pragma unroll
    for (int i = 0; i < 2; ++i) { stage_rc(tid * 16 + i * 8192, Rr[i], Cc[i]); const int Rb = Epi::PERM ? ((Rr[i] & ~31) + perm32(Rr[i] & 31)) : Rr[i];
        voffB[i] = (unsigned)(Rb * K + Cc[i]) * 2u; }
    const size_t kstep = (size_t)(BK * 2);
    const size_t hstep = (size_t)HALF * K * 2;
    const unsigned ldsw = (unsigned)wid * 1024u;
    const int aoff = lds_byte(wr * 64 + fr, fq * 8), boff = lds_byte(wc * 32 + fr, fq * 8);
#define PG8_SA(b, h) (((b) * 2 + (h)) * HTB)
#define PG8_SB(b, h) ((4 + (b) * 2 + (h)) * HTB)
#define PG8_STAGE(bufoff, gbase, voff) do { _Pragma("unroll") for (int _i = 0; _i < 2; ++_i) \
        __builtin_amdgcn_global_load_lds((const unsigned*)((const char*)(gbase) + (voff)[_i]), (LAS unsigned*)(lds + (bufoff) + ldsw + _i * 8192), 16, 0, 0); } while (0)
#define PG8_LD8(p) __builtin_shufflevector(*(const LAS i32x4*)(p), *(const LAS i32x4*)((p) + 1024), 0, 1, 2, 3, 4, 5, 6, 7)
#define PG8_LDA(dst, b, h) do { if constexpr (F8) { _Pragma("unroll") for (int m = 0; m < 4; ++m) dst##8[m] = PG8_LD8(lds + PG8_SA(b, h) + aoff + m * 2048); } \
        else { _Pragma("unroll") for (int m = 0; m < 4; ++m) _Pragma("unroll") for (int k = 0; k < 2; ++k) dst[m][k] = *(const LAS bf16x8*)(lds + PG8_SA(b, h) + aoff + m * 2048 + k * 1024); } } while (0)
#define PG8_LDB(dst, b, h) do { if constexpr (F8) { _Pragma("unroll") for (int n = 0; n < 2; ++n) dst##8[n] = PG8_LD8(lds + PG8_SB(b, h) + boff + n * 2048); } \
        else { _Pragma("unroll") for (int n = 0; n < 2; ++n) _Pragma("unroll") for (int k = 0; k < 2; ++k) dst[n][k] = *(const LAS bf16x8*)(lds + PG8_SB(b, h) + boff + n * 2048 + k * 1024); } } while (0)
#define PG8_CAT8(x0, x1) __builtin_shufflevector(__builtin_bit_cast(i32x4, x0), __builtin_bit_cast(i32x4, x1), 0, 1, 2, 3, 4, 5, 6, 7)
#define PG8_MMA(ai, bj, At, Bt) do { __builtin_amdgcn_s_setprio(1); _Pragma("unroll") for (int m = 0; m < 4; ++m) _Pragma("unroll") for (int n = 0; n < 2; ++n) { \
        if constexpr (F8) asm volatile("v_mfma_scale_f32_16x16x128_f8f6f4 %0, %1, %2, %0, %3, %3 op_sel_hi:[0,0,0]" : "+v"(acc[ai][bj][m][n]) : "v"(Bt##8[n]), "v"(At##8[m]), "v"(f8one)); \
        else { _Pragma("unroll") for (int k = 0; k < 2; ++k) acc[ai][bj][m][n] = __builtin_amdgcn_mfma_f32_16x16x32_bf16(Bt[n][k], At[m][k], acc[ai][bj][m][n], 0, 0, 0); } } __builtin_amdgcn_s_setprio(0); } while (0)
#define PG8_WAIT_V(n) asm volatile("s_waitcnt vmcnt(" #n ")" ::: "memory")
#define PG8_WAIT_L(n) asm volatile("s_waitcnt lgkmcnt(" #n ")" ::: "memory")
#define PG8_BAR __builtin_amdgcn_s_barrier()
#define PG8_SCHED __builtin_amdgcn_sched_barrier(0)
#define PG8_VOFF(dst, u) do { _Pragma("unroll") for (int _h = 0; _h < 2; ++_h) _Pragma("unroll") for (int _i = 0; _i < 2; ++_i) { \
        if constexpr (GATHER) dst[_h][_i] = S.arow(u, _h * HALF + Rr[_i]) * (unsigned)(K * 2) + (unsigned)(Cc[_i] * 2); \
        else dst[_h][_i] = (unsigned)((_h * HALF + Rr[_i]) * K + Cc[_i]) * 2u; } } while (0)
    Unit cur, nxt; int ui = 0;
    if (!S.next(0, cur)) return;
    f32x4 acc[2][2][4][2];
    if constexpr (Epi::PRELOAD) E.preload(acc, cur, wr, wc, fr, fq);
    else {
#pragma unroll
    for (int a = 0; a < 2; ++a)
#pragma unroll
        for (int b = 0; b < 2; ++b)
#pragma unroll
            for (int m = 0; m < 4; ++m)
#pragma unroll
                for (int n = 0; n < 2; ++n) acc[a][b][m][n] = (f32x4){0.f, 0.f, 0.f, 0.f};
    }
    float epf[2][4] = {{0.f, 0.f, 0.f, 0.f}, {0.f, 0.f, 0.f, 0.f}};
    bf16x8 At[4][2], B0[2][2], B1[2][2];
    i32x8 At8[4], B08[2], B18[2]; const unsigned f8one = 0x7f7f7f7fu;
    unsigned vA[2][2], vN[2][2];
    PG8_VOFF(vA, cur);
    if constexpr (Epi::PREFETCH) E.prefetch(epf, cur, wr, fr);
    const char* cA = S.abase(cur); const char* cB = S.bbase(cur);
    PG8_STAGE(PG8_SB(0, 0), cB, voffB); PG8_STAGE(PG8_SB(0, 1), cB + hstep, voffB); PG8_STAGE(PG8_SA(0, 0), cA, vA[0]); PG8_STAGE(PG8_SA(0, 1), cA, vA[1]);
    if (wr == 1) PG8_BAR;
    PG8_WAIT_V(2); PG8_BAR;
    PG8_STAGE(PG8_SB(1, 0), cB + kstep, voffB); PG8_STAGE(PG8_SA(1, 0), cA + kstep, vA[0]); PG8_STAGE(PG8_SB(1, 1), cB + hstep + kstep, voffB);
    PG8_WAIT_V(6); PG8_BAR;
    for (;;) {
        const bool has_next = S.next(ui + 1, nxt);
        const char* nA = has_next ? S.abase(nxt) : cA; const char* nB = has_next ? S.bbase(nxt) : cB;
        if constexpr (GATHER) { if (has_next) { PG8_VOFF(vN, nxt); } else {
#pragma unroll
            for (int h = 0; h < 2; ++h)
#pragma unroll
                for (int i = 0; i < 2; ++i) vN[h][i] = vA[h][i]; } }
#pragma unroll 1
        for (int t = 0; t < nt; t += 2) {
            const bool last = (t == nt - 2);
            const char* a1 = cA + (size_t)(t + 1) * kstep;
            const char* a2 = last ? nA : cA + (size_t)(t + 2) * kstep; const char* b2 = last ? nB : cB + (size_t)(t + 2) * kstep;
            const char* a3 = a2 + kstep; const char* b3 = b2 + kstep;
            unsigned v2[2][2]; const unsigned lmask = last ? 0xffffffffu : 0u;
#pragma unroll
            for (int h = 0; h < 2; ++h)
#pragma unroll
                for (int i = 0; i < 2; ++i) { if constexpr (GATHER) v2[h][i] = (vN[h][i] & lmask) | (vA[h][i] & ~lmask); else v2[h][i] = vA[h][i]; }
            PG8_LDB(B0, 0, 0); PG8_LDB(B1, 0, 1); PG8_SCHED; PG8_LDA(At, 0, 0); PG8_STAGE(PG8_SA(1, 1), a1, vA[1]);
            PG8_WAIT_V(8); PG8_WAIT_L(0); PG8_BAR; PG8_MMA(0, 0, At, B0); PG8_MMA(0, 1, At, B1); PG8_BAR; PG8_SCHED;
            PG8_LDA(At, 0, 1); PG8_STAGE(PG8_SB(0, 0), b2, voffB); PG8_STAGE(PG8_SB(0, 1), b2 + hstep, voffB); PG8_STAGE(PG8_SA(0, 0), a2, v2[0]);
            PG8_WAIT_V(8); PG8_WAIT_L(0); PG8_BAR; PG8_MMA(1, 0, At, B0); PG8_MMA(1, 1, At, B1); PG8_BAR; PG8_SCHED;
            PG8_LDB(B0, 1, 0); PG8_LDB(B1, 1, 1); PG8_SCHED; PG8_LDA(At, 1, 0); PG8_STAGE(PG8_SA(0, 1), a2, v2[1]);
            PG8_WAIT_V(8); PG8_WAIT_L(0); PG8_BAR; PG8_MMA(0, 0, At, B0); PG8_MMA(0, 1, At, B1); PG8_BAR; PG8_SCHED;
            PG8_LDA(At, 1, 1); PG8_STAGE(PG8_SB(1, 0), b3, voffB); PG8_STAGE(PG8_SB(1, 1), b3 + hstep, voffB); PG8_STAGE(PG8_SA(1, 0), a3, v2[0]);
            PG8_WAIT_V(8); PG8_WAIT_L(0); PG8_BAR; PG8_MMA(1, 0, At, B0); PG8_MMA(1, 1, At, B1); PG8_BAR; PG8_SCHED;
        }
        if (wr == 0) PG8_BAR;
        if constexpr (F8) asm volatile("s_nop 15\n\ts_nop 15" ::: "memory");
        if constexpr (Epi::PREFETCH) E(acc, cur, wr, wc, fr, fq, epf); else E(acc, cur, wr, wc, fr, fq);
        if (!has_next) break;
        if constexpr (Epi::PREFETCH) E.prefetch(epf, nxt, wr, fr);
        if constexpr (Epi::PRELOAD) E.preload(acc, nxt, wr, wc, fr, fq);
        else {
#pragma unroll
        for (int a = 0; a < 2; ++a)
#pragma unroll
            for (int b = 0; b < 2; ++b)
#pragma unroll
                for (int m = 0; m < 4; ++m)
#pragma unroll
                    for (int n = 0; n < 2; ++n) acc[a][b][m][n] = (f32x4){0.f, 0.f, 0.f, 0.f};
        }
        cur = nxt; cA = nA; cB = nB; ++ui;
        if constexpr (GATHER) {
#pragma unroll
        for (int h = 0; h < 2; ++h)
#pragma unroll
            for (int i = 0; i < 2; ++i) vA[h][i] = vN[h][i]; }
        if (wr == 1) PG8_BAR;
    }
    PG8_WAIT_V(0);
    PG8_BAR;
#undef PG8_SA
#undef PG8_SB
#undef PG8_STAGE
#undef PG8_LDA
#undef PG8_LD8
#undef PG8_LDB
#undef PG8_MMA
#undef PG8_CAT8
#undef PG8_WAIT_V
#undef PG8_WAIT_L
#undef PG8_BAR
#undef PG8_SCHED
#undef PG8_VOFF
}

struct DenseSched {
    const char* A; const char* Bt; int K; int nM, nN, nwg, G, c;
    __device__ __forceinline__ void init(const void* A_, const void* Bt_, int M, int N, int K_, int G_, int c_) { A = (const char*)A_; Bt = (const char*)Bt_; K = K_; nM = M / BM; nN = N / BM; nwg = nM * nN; G = G_; c = c_; }
    __device__ __forceinline__ bool next(int i, Unit& u) const {
        const long L = (long)i * G + c; if (L >= nwg) return false;
        int wgid = (int)L; { const int q = nwg / NXCD, r = nwg % NXCD, xcd = wgid % NXCD, off = wgid / NXCD; wgid = (xcd < r ? xcd * (q + 1) : r * (q + 1) + (xcd - r) * q) + off; }
        const int nig = WGM * nN, gid = wgid / nig, fm = gid * WGM, gsz = (nM - fm) < WGM ? (nM - fm) : WGM;
        u.pm = fm + ((wgid % nig) % gsz); u.pn = (wgid % nig) / gsz; return true;
    }
    __device__ __forceinline__ const char* abase(const Unit& u) const { return A + (size_t)u.pm * BM * K * 2; }
    __device__ __forceinline__ const char* bbase(const Unit& u) const { return Bt + (size_t)u.pn * BM * K * 2; }
    __device__ __forceinline__ unsigned arow(const Unit&, int) const { return 0u; }
};
template <bool GATHER_A>
struct MoeSched {
    const char* A; const char* W; int K; size_t wstride; const LAS int* tb; const LAS int* cn; const unsigned* rowtok; int ntot, vcu, G;
    __device__ __forceinline__ bool next(int i, Unit& u) const { const int L = i * G + vcu; if (L >= ntot * 4) return false; u.pm = L >> 2; u.pn = L & 3; return true; }
    __device__ __forceinline__ int expert(int pm) const { int e = 0;
#pragma unroll
        for (int j = 1; j < 16; ++j) e += (pm >= tb[j]) ? 1 : 0; return e; }
    __device__ __forceinline__ const char* abase(const Unit& u) const { return GATHER_A ? A : A + (size_t)u.pm * BM * K * 2; }
    __device__ __forceinline__ const char* bbase(const Unit& u) const { return W + (size_t)expert(u.pm) * wstride + (size_t)u.pn * BM * K * 2; }
    __device__ __forceinline__ unsigned arow(const Unit& u, int r) const { const int e = expert(u.pm); const int idx = (u.pm - tb[e]) * BM + r; return idx < cn[e] ? rowtok[(size_t)e * ECAP + idx] : 0u; }
};

__device__ __forceinline__ u32x4 widen16(u32x2 a, u32x2 b) {
    const auto rx = __builtin_amdgcn_permlane16_swap(a.x, b.x, false, false); const auto ry = __builtin_amdgcn_permlane16_swap(a.y, b.y, false, false);
    u32x4 o; o.x = rx[0]; o.y = ry[0]; o.z = rx[1]; o.w = ry[1]; return o; }
struct EpiBf16 {
    static constexpr bool PERM = true, PRELOAD = false, PREFETCH = false;
    bf16_t* O; int ldc;
    __device__ __forceinline__ void operator()(const f32x4 (&acc)[2][2][4][2], const Unit& u, int wr, int wc, int fr, int fq) const {
        const int row0 = u.pm * BM + wr * 64 + fr, col0 = u.pn * BM + wc * 32 + 8 * fq;
#pragma unroll
        for (int ai = 0; ai < 2; ++ai)
#pragma unroll
            for (int m = 0; m < 4; ++m) { bf16_t* rowp = O + (size_t)(row0 + ai * HALF + m * 16) * ldc + col0;
#pragma unroll
                for (int bj = 0; bj < 2; ++bj) { const f32x4 v0 = acc[ai][bj][m][0], v1 = acc[ai][bj][m][1];
                    u32x4 w; w.x = cvt_pk_bf16(v0[0], v0[1]); w.y = cvt_pk_bf16(v0[2], v0[3]); w.z = cvt_pk_bf16(v1[0], v1[1]); w.w = cvt_pk_bf16(v1[2], v1[3]);
#ifdef EPI_NT
                    __builtin_nontemporal_store(w, (u32x4*)(rowp + bj * HALF));
#else
                    *(u32x4*)(rowp + bj * HALF) = w;
#endif
                } }
    }
};
template <bool XF32>
struct EpiResid {
    static constexpr bool PERM = true, PRELOAD = true, PREFETCH = false;
    const float* xin; bf16_t* XB; unsigned char* XB8;
    __device__ __forceinline__ void preload(f32x4 (&acc)[2][2][4][2], const Unit& u, int wr, int wc, int fr, int fq) const {
        const int row0 = u.pm * BM + wr * 64 + fr, col0 = u.pn * BM + wc * 32 + 8 * fq;
#pragma unroll
        for (int ai = 0; ai < 2; ++ai)
#pragma unroll
            for (int m = 0; m < 4; ++m) { const size_t off = (size_t)(row0 + ai * HALF + m * 16) * D + col0;
#pragma unroll
                for (int bj = 0; bj < 2; ++bj) {
                    if (XF32) { acc[ai][bj][m][0] = *(const f32x4*)(xin + off + bj * HALF); acc[ai][bj][m][1] = *(const f32x4*)(xin + off + bj * HALF + 4); }
                    else { const u32x4 w = *(const u32x4*)(XB + off + bj * HALF); acc[ai][bj][m][0] = (f32x4){bf_lo(w.x), bf_hi(w.x), bf_lo(w.y), bf_hi(w.y)}; acc[ai][bj][m][1] = (f32x4){bf_lo(w.z), bf_hi(w.z), bf_lo(w.w), bf_hi(w.w)}; } } }
    }
    __device__ __forceinline__ void operator()(const f32x4 (&acc)[2][2][4][2], const Unit& u, int wr, int wc, int fr, int fq) const {
        const int row0 = u.pm * BM + wr * 64 + fr, col0 = u.pn * BM + wc * 32 + 8 * fq;
        const int colw = u.pn * BM + wc * 32 + 8 * (fq & ~1);
#pragma unroll
        for (int ai = 0; ai < 2; ++ai)
#pragma unroll
            for (int mp = 0; mp < 4; mp += 2)
#pragma unroll
                for (int bj = 0; bj < 2; ++bj) { u32x2 w8[2];
#pragma unroll
                    for (int h = 0; h < 2; ++h) { const int m = mp + h; bf16_t* rowp = XB + (size_t)(row0 + ai * HALF + m * 16) * D + col0;
                        const f32x4 v0 = acc[ai][bj][m][0], v1 = acc[ai][bj][m][1];
                        u32x4 w; w.x = cvt_pk_bf16(v0[0], v0[1]); w.y = cvt_pk_bf16(v0[2], v0[3]); w.z = cvt_pk_bf16(v1[0], v1[1]); w.w = cvt_pk_bf16(v1[2], v1[3]);
                        *(u32x4*)(rowp + bj * HALF) = w;
                        w8[h].x = cvt_pk4_fp8(bf_lo(w.x), bf_hi(w.x), bf_lo(w.y), bf_hi(w.y)); w8[h].y = cvt_pk4_fp8(bf_lo(w.z), bf_hi(w.z), bf_lo(w.w), bf_hi(w.w)); }
                    *(u32x4*)(XB8 + (size_t)(row0 + ai * HALF + (mp + (fq & 1)) * 16) * D + colw + bj * HALF) = widen16(w8[0], w8[1]); }
    }
};
template <int MODE  >
struct EpiPair {
    static constexpr bool PERM = true, PRELOAD = false, PREFETCH = true;
    bf16_t* O0; bf16_t* O1; int ld1;
    const float* rstd; const unsigned* rowtok; const LAS int* tb; const LAS int* cn;
    __device__ __forceinline__ void prefetch(float (&rs)[2][4], const Unit& u, int wr, int fr) const {
        const int row0 = u.pm * BM + wr * 64 + fr;
        if (MODE == 0) {
#pragma unroll
            for (int ai = 0; ai < 2; ++ai)
#pragma unroll
                for (int m = 0; m < 4; ++m) rs[ai][m] = rstd[row0 + ai * HALF + m * 16] * (G3_F8 ? 1.0f / F8_WSCALE : 1.0f);
        } else {
            int e = 0;
#pragma unroll
            for (int j = 1; j < 16; ++j) e += (u.pm >= tb[j]) ? 1 : 0;
            const int idx0 = (u.pm - tb[e]) * BM + wr * 64 + fr, cne = cn[e];
#pragma unroll
            for (int ai = 0; ai < 2; ++ai)
#pragma unroll
                for (int m = 0; m < 4; ++m) { const int idx = idx0 + ai * HALF + m * 16; rs[ai][m] = idx < cne ? rstd[(size_t)e * ECAP + idx] * (1.0f / F8_WSCALE) : 0.f; }
        }
    }
    __device__ __forceinline__ void operator()(const f32x4 (&acc)[2][2][4][2], const Unit& u, int wr, int wc, int fr, int fq, const float (&rs)[2][4]) const {
        const int row0 = u.pm * BM + wr * 64 + fr;
        if (MODE == 0 && u.pn < 4) {
            const int col0 = u.pn * BM + wc * 32 + 8 * fq;
#pragma unroll
            for (int ai = 0; ai < 2; ++ai)
#pragma unroll
                for (int m = 0; m < 4; ++m) { bf16_t* rowp = O0 + (size_t)(row0 + ai * HALF + m * 16) * D + col0;
#pragma unroll
                    for (int bj = 0; bj < 2; ++bj) { const f32x4 v0 = acc[ai][bj][m][0] * rs[ai][m], v1 = acc[ai][bj][m][1] * rs[ai][m];
                        u32x4 w; w.x = cvt_pk_bf16(v0[0], v0[1]); w.y = cvt_pk_bf16(v0[2], v0[3]); w.z = cvt_pk_bf16(v1[0], v1[1]); w.w = cvt_pk_bf16(v1[2], v1[3]);
                        *(u32x4*)(rowp + bj * HALF) = w; } }
        } else {
            const int pt = (MODE == 0) ? (u.pn - 4) : u.pn;
            const int col0 = pt * HALF + wc * 32 + 8 * fq;
#pragma unroll
            for (int ai = 0; ai < 2; ++ai) { u32x2 wkeep = {0u, 0u};
#pragma unroll
                for (int m = 0; m < 4; ++m) { bf16_t* rowp = O1 + (size_t)(row0 + ai * HALF + m * 16) * ld1 + col0;
                    f32x4 r[2];
#pragma unroll
                    for (int n = 0; n < 2; ++n) { const f32x4 g = acc[ai][0][m][n] * rs[ai][m], up = acc[ai][1][m][n] * rs[ai][m];
                        if (MODE == 0) r[n] = g * up;
                        else {
#pragma unroll
                            for (int j = 0; j < 4; ++j) r[n][j] = __builtin_amdgcn_fmed3f(g[j] * fast_rcp(1.0f + fast_exp2(-1.4426950408889634f * g[j])) * up[j] * F8_HSCALE, -448.0f, 448.0f); } }
                    if (MODE == 1) { u32x2 w; w.x = cvt_pk4_fp8(r[0][0], r[0][1], r[0][2], r[0][3]); w.y = cvt_pk4_fp8(r[1][0], r[1][1], r[1][2], r[1][3]);
                        if ((m & 1) == 0) wkeep = w;
                        else *(u32x4*)((unsigned char*)O1 + (size_t)(row0 + ai * HALF + (m - 1 + (fq & 1)) * 16) * ld1 + (pt * HALF + wc * 32 + 8 * (fq & ~1))) = widen16(wkeep, w); }
                    else { u32x4 w; w.x = cvt_pk_bf16(r[0][0], r[0][1]); w.y = cvt_pk_bf16(r[0][2], r[0][3]); w.z = cvt_pk_bf16(r[1][0], r[1][1]); w.w = cvt_pk_bf16(r[1][2], r[1][3]);
                        *(u32x4*)rowp = w; } } }
        }
    }
};
struct EpiDown {
    static constexpr bool PERM = true, PRELOAD = false, PREFETCH = true;
    unsigned char* O; const float* cwraw; const LAS int* tb; const LAS int* cn;
    __device__ __forceinline__ void prefetch(float (&cws)[2][4], const Unit& u, int wr, int fr) const {
        int e = 0;
#pragma unroll
        for (int j = 1; j < 16; ++j) e += (u.pm >= tb[j]) ? 1 : 0;
        const int idx0 = (u.pm - tb[e]) * BM + wr * 64 + fr, cne = cn[e];
#pragma unroll
        for (int ai = 0; ai < 2; ++ai)
#pragma unroll
            for (int m = 0; m < 4; ++m) { const int idx = idx0 + ai * HALF + m * 16; cws[ai][m] = idx < cne ? cwraw[(size_t)e * ECAP + idx] * (F8_YSCALE / (F8_WSCALE * F8_HSCALE)) : 0.f; }
    }
    __device__ __forceinline__ void operator()(const f32x4 (&acc)[2][2][4][2], const Unit& u, int wr, int wc, int fr, int fq, const float (&cws)[2][4]) const {
        const int row0 = u.pm * BM + wr * 64 + fr, col0 = u.pn * BM + wc * 32 + 8 * fq;
        const int colw = u.pn * BM + wc * 32 + 8 * (fq & ~1);
#pragma unroll
        for (int ai = 0; ai < 2; ++ai)
#pragma unroll
            for (int mp = 0; mp < 4; mp += 2) {
                unsigned char* rowp = O + (size_t)(row0 + ai * HALF + (mp + (fq & 1)) * 16) * D + colw;
#pragma unroll
                for (int bj = 0; bj < 2; ++bj) { u32x2 w[2];
#pragma unroll
                    for (int h = 0; h < 2; ++h) { const float cw = cws[ai][mp + h]; f32x4 v0 = acc[ai][bj][mp + h][0] * cw, v1 = acc[ai][bj][mp + h][1] * cw;
#pragma unroll
                        for (int j = 0; j < 4; ++j) { v0[j] = __builtin_amdgcn_fmed3f(v0[j], -448.0f, 448.0f); v1[j] = __builtin_amdgcn_fmed3f(v1[j], -448.0f, 448.0f); }
                        w[h].x = cvt_pk4_fp8(v0[0], v0[1], v0[2], v0[3]); w[h].y = cvt_pk4_fp8(v1[0], v1[1], v1[2], v1[3]); }
                    *(u32x4*)(rowp + bj * HALF) = widen16(w[0], w[1]); } }
    }
};
}

constexpr int RING_BYTES = 131072;
constexpr int MISC_OFF = RING_BYTES;
constexpr int LDS_BYTES = 163840;
constexpr int MW_BAR = 0;
constexpr int MW_TB = 16;
constexpr int MW_CN = 40;
constexpr int MW_Q = 60;
constexpr int MW_F = 64;

struct Params {
    const float* in[25]; float* out; unsigned char* ws;
};

constexpr float ATT_QSCALE = 0.125f * 1.4426950408889634f;
__device__ __forceinline__ void transpose_item(const float* W, int ld, int K, int k0, int srccol, bf16_t* WT, int dstrow, LAS float* scr, int lane, const float* gk = nullptr, float wsc = 1.0f) {
    float tv[32];
#pragma unroll
    for (int i = 0; i < 32; ++i) { const int kk = 2 * i + (lane >> 5); tv[i] = W[(size_t)(k0 + kk) * ld + srccol + (lane & 31)]; }
#pragma unroll
    for (int i = 0; i < 32; ++i) { const int kk = 2 * i + (lane >> 5); scr[kk * 33 + (lane & 31)] = (gk ? tv[i] * gk[k0 + kk] : tv[i]) * wsc; }
    asm volatile("s_waitcnt lgkmcnt(0)" ::: "memory");
    const int c = lane & 7;
#pragma unroll
    for (int j = 0; j < 4; ++j) { const int n = (lane >> 3) + 8 * j; const LAS float* s = scr + (8 * c) * 33 + n;
        u32x4 o; o.x = cvt_pk_bf16(s[0 * 33], s[1 * 33]); o.y = cvt_pk_bf16(s[2 * 33], s[3 * 33]); o.z = cvt_pk_bf16(s[4 * 33], s[5 * 33]); o.w = cvt_pk_bf16(s[6 * 33], s[7 * 33]);
        *(u32x4*)(WT + (size_t)(dstrow + n) * K + k0 + 8 * c) = o; }
    asm volatile("s_waitcnt lgkmcnt(0)" ::: "memory");
}
__device__ __forceinline__ void transpose_item_f8(const float* W, int ld, int K, int k0, int srccol, unsigned char* WT8, int dstrow, LAS float* scr, int lane, const float* gk, float scale) {
    float tv[32];
#pragma unroll
    for (int i = 0; i < 32; ++i) { const int kk = 2 * i + (lane >> 5); tv[i] = W[(size_t)(k0 + kk) * ld + srccol + (lane & 31)]; }
#pragma unroll
    for (int i = 0; i < 32; ++i) { const int kk = 2 * i + (lane >> 5); scr[kk * 33 + (lane & 31)] = (gk ? tv[i] * gk[k0 + kk] : tv[i]) * scale; }
    asm volatile("s_waitcnt lgkmcnt(0)" ::: "memory");
    const int c = lane & 3;
#pragma unroll
    for (int j = 0; j < 2; ++j) { const int n = (lane >> 2) + 16 * j; const LAS float* q = scr + (16 * c) * 33 + n;
        u32x4 o; o.x = cvt_pk4_fp8(q[0 * 33], q[1 * 33], q[2 * 33], q[3 * 33]); o.y = cvt_pk4_fp8(q[4 * 33], q[5 * 33], q[6 * 33], q[7 * 33]);
        o.z = cvt_pk4_fp8(q[8 * 33], q[9 * 33], q[10 * 33], q[11 * 33]); o.w = cvt_pk4_fp8(q[12 * 33], q[13 * 33], q[14 * 33], q[15 * 33]);
        *(u32x4*)(WT8 + (size_t)(dstrow + n) * K + k0 + 16 * c) = o; }
    asm volatile("s_waitcnt lgkmcnt(0)" ::: "memory");
}
__device__ __forceinline__ int pair_row(int ch, int up) { return (ch >> 7) * 256 + up * 128 + (ch & 127); }

__device__ __forceinline__ void phase_prologue_weights(const Params& p, LAS unsigned char* lds, int first, int last, int step, int wave, int lane_) {
    int lane = lane_; asm volatile("" : "+v"(lane));
    LAS float* scr = (LAS float*)(lds + wave * 16384);
    unsigned char* ws = p.ws;
    constexpr int I1 = 16 * 112, I2 = 16 * 32, I3 = 16 * 96, I4 = 16 * 32, IE = 768;
    constexpr int NITEMS = I1 + I2 + I3 + I4 + 32 * IE;
    static_assert(NITEMS == 28928, "item count");
    for (int it = first; it < last; it += step) {
        int r = it;
        if (r < I1) { const int kb = r / 112, nb = r % 112; const int sc = nb < 64 ? 32 * nb : 2056 + 32 * (nb - 64), dr = nb < 64 ? 32 * nb : 2048 + 32 * (nb - 64);
            transpose_item(p.in[5], EVEN_IN, 1024, 64 * kb, sc, (bf16_t*)(ws + WS_WT1), dr, scr, lane, nullptr, (dr >= P_DQ && dr < P_DK) ? ATT_QSCALE : 1.0f); continue; } r -= I1;
        if (r < I2) { const int kb = r / 32, nb = r % 32; transpose_item(p.in[6], 1024, 1024, 64 * kb, 32 * nb, (bf16_t*)(ws + WS_WT2), 32 * nb, scr, lane); continue; } r -= I2;
        if (r < I3) { const int kb = r / 96, nb = r % 96; int dr;
            if (nb < 32) dr = 32 * nb; else if (nb < 64) dr = 1024 + pair_row(32 * (nb - 32), 0); else dr = 1024 + pair_row(32 * (nb - 64), 1);
            if (G3_F8) transpose_item_f8(p.in[15], 3072, 1024, 64 * kb, 32 * nb, ws + WS_WT3, dr, scr, lane, p.in[2] + D, F8_WSCALE);
            else transpose_item(p.in[15], 3072, 1024, 64 * kb, 32 * nb, (bf16_t*)(ws + WS_WT3), dr, scr, lane, p.in[2] + D);
            continue; } r -= I3;
        if (r < I4) { const int kb = r / 32, nb = r % 32; transpose_item(p.in[17], 1024, 1024, 64 * kb, 32 * nb, (bf16_t*)(ws + WS_WT4), 32 * nb, scr, lane); continue; } r -= I4;
        const int le = r / IE; r %= IE;
        unsigned char* wgu = ws + WS_WGU + (size_t)le * 1024 * 1024; unsigned char* wd = ws + WS_WD + (size_t)le * 1024 * 512;
        if (r < 256) { const int kb = r / 16, nb = r % 16; transpose_item_f8(p.in[22] + (size_t)le * 1024 * 512, 512, 1024, 64 * kb, 32 * nb, wgu, pair_row(32 * nb, 0), scr, lane, p.in[3] + (le >> 4) * D, F8_WSCALE); continue; } r -= 256;
        if (r < 256) { const int kb = r / 16, nb = r % 16; transpose_item_f8(p.in[23] + (size_t)le * 1024 * 512, 512, 1024, 64 * kb, 32 * nb, wgu, pair_row(32 * nb, 1), scr, lane, p.in[3] + (le >> 4) * D, F8_WSCALE); continue; } r -= 256;
        { const int kb = r / 32, nb = r % 32; transpose_item_f8(p.in[24] + (size_t)le * 512 * 1024, 1024, 512, 64 * kb, 32 * nb, wd, 32 * nb, scr, lane, nullptr, F8_WSCALE); }
    }
}

struct RowV { f32x4 v[4]; };
__device__ __forceinline__ RowV row_load(const float* xr, int lane) { RowV r; const f32x4* p = (const f32x4*)xr + lane;
#pragma unroll
    for (int j = 0; j < 4; ++j) r.v[j] = p[64 * j]; return r; }
__device__ __forceinline__ void row_store(float* xr, int lane, const RowV& r) { f32x4* p = (f32x4*)xr + lane;
#pragma unroll
    for (int j = 0; j < 4; ++j) p[64 * j] = r.v[j]; }
__device__ __forceinline__ RowV row_load_bf16(const bf16_t* yr, int lane) { RowV r; const u32x2* p = (const u32x2*)yr + lane;
#pragma unroll
    for (int j = 0; j < 4; ++j) { const u32x2 w = p[64 * j]; r.v[j] = (f32x4){bf_lo(w.x), bf_hi(w.x), bf_lo(w.y), bf_hi(w.y)}; } return r; }
__device__ __forceinline__ RowV row_load_fp8(const unsigned char* yr, int lane, float sc) { RowV r; const unsigned* p = (const unsigned*)yr + lane;
#pragma unroll
    for (int j = 0; j < 4; ++j) { const unsigned w = p[64 * j]; const f32x2 lo = __builtin_amdgcn_cvt_pk_f32_fp8((int)w, false), hi = __builtin_amdgcn_cvt_pk_f32_fp8((int)w, true); r.v[j] = (f32x4){lo.x * sc, lo.y * sc, hi.x * sc, hi.y * sc}; } return r; }
__device__ __forceinline__ float row_rstd(const RowV& r) { float s = 0.f;
#pragma unroll
    for (int j = 0; j < 4; ++j) s += (r.v[j][0] * r.v[j][0] + r.v[j][1] * r.v[j][1]) + (r.v[j][2] * r.v[j][2] + r.v[j][3] * r.v[j][3]);
    return 1.0f / sqrtf(wave_sum(s) * (1.0f / D) + NORM_EPS); }
__device__ __forceinline__ void row_store_bf16(bf16_t* hr, int lane, const RowV& r) { u32x2* p = (u32x2*)hr + lane;
#pragma unroll
    for (int j = 0; j < 4; ++j) { u32x2 w; w.x = cvt_pk_bf16(r.v[j][0], r.v[j][1]); w.y = cvt_pk_bf16(r.v[j][2], r.v[j][3]); p[64 * j] = w; } }

__device__ __forceinline__ void phase_norm_gates(const Params& p, LAS unsigned char* lds, int tid, int gw, int NGW, int lane) {
    const float* x = p.in[0]; const float* g = p.in[2]; const float* win = p.in[5];
    bf16_t* H = (bf16_t*)(p.ws + WS_H); float* gates = (float*)(p.ws + WS_GATES);
    LAS float* wt = (LAS float*)lds;
    for (int i = tid; i < 8 * 1024; i += NTHR) { const int k = i >> 3, o = i & 7; wt[o * 1024 + k] = win[(size_t)k * EVEN_IN + 2048 + o] * g[k]; }
    __syncthreads();
    RowV gv = row_load(g, lane);
    for (int m0 = gw; m0 < T; m0 += 2 * NGW) {
      RowV rr[2];
#pragma unroll
      for (int u = 0; u < 2; ++u) { const int mm = m0 + u * NGW; rr[u] = row_load(x + (size_t)(mm < T ? mm : m0) * D, lane); }
#pragma unroll
      for (int u = 0; u < 2; ++u) {
        const int m = m0 + u * NGW; if (m >= T) break; RowV r = rr[u];
        const float rstd = row_rstd(r);
        float dots[8];
#pragma unroll
        for (int o = 0; o < 8; ++o) { float s = 0.f;
#pragma unroll
            for (int j = 0; j < 4; ++j) { const f32x4 w = *(const LAS f32x4*)(wt + o * 1024 + 4 * lane + 256 * j); s += (r.v[j][0] * w[0] + r.v[j][1] * w[1]) + (r.v[j][2] * w[2] + r.v[j][3] * w[3]); }
            dots[o] = s; }
        float gsum;
        { const bool b5 = (lane & 32) != 0, b4 = (lane & 16) != 0, b3 = (lane & 8) != 0;
          float k4[4];
#pragma unroll
          for (int i = 0; i < 4; ++i) { const float keep = b5 ? dots[4 + i] : dots[i], send = b5 ? dots[i] : dots[4 + i]; k4[i] = keep + __shfl_xor(send, 32); }
          float k2[2];
#pragma unroll
          for (int i = 0; i < 2; ++i) { const float keep = b4 ? k4[2 + i] : k4[i], send = b4 ? k4[i] : k4[2 + i]; k2[i] = keep + __shfl_xor(send, 16); }
          { const float keep = b3 ? k2[1] : k2[0], send = b3 ? k2[0] : k2[1]; gsum = keep + __shfl_xor(send, 8); }
          gsum += __shfl_xor(gsum, 4); gsum += __shfl_xor(gsum, 2); gsum += __shfl_xor(gsum, 1); }
#pragma unroll
        for (int j = 0; j < 4; ++j) r.v[j] = r.v[j] * rstd * gv.v[j];
        row_store_bf16(H + (size_t)m * D, lane, r);
        if ((lane & 7) == 0) gates[(size_t)m * 8 + ((lane >> 3) & 7)] = gsum * rstd;
      }
    }
    __syncthreads();
}

template <int MODE, bool COMBINE>
__device__ __forceinline__ void phase_rows(const Params& p, LAS unsigned char* lds, int tid_, int wave, int lane_, int G,
                                           const float* gvec, const float* wgr, const float* bgr, const float* wer, const float* ber, unsigned* cnt_prev, unsigned* cnt_cur) {
    int tid = tid_; asm volatile("" : "+v"(tid)); const int lane = tid & 63;
    float* OUT = p.out; bf16_t* XB = (bf16_t*)(p.ws + WS_XB); float* RSTD = (float*)(p.ws + WS_RSTD);
    const unsigned char* YC = (const unsigned char*)(p.ws + WS_YC); float* rsraw = (float*)(p.ws + WS_RSRAW);
    unsigned* tokinfo = (unsigned*)(p.ws + WS_TOKINFO);
    unsigned* rowtok = (unsigned*)(p.ws + WS_ROWTOK); float* cwraw = (float*)(p.ws + WS_CWRAW);
    LAS float* wt = (LAS float*)lds;
    LAS int* misc = (LAS int*)(lds + MISC_OFF);
    LAS int* tbp = misc + MW_TB;
    LAS int* te = misc + 1024;
    LAS float* tc = (LAS float*)(misc + 1536);
    LAS int* trank = misc + 2048;
    LAS int* ebase = misc + 2560;
    LAS float* trs = (LAS float*)(misc + 2600);
    if (COMBINE) { if (tid == 0) { int acc = 0; for (int e = 0; e < 16; ++e) { tbp[e] = acc; acc += ((int)__hip_atomic_load(cnt_prev + e * 64, __ATOMIC_RELAXED, __HIP_MEMORY_SCOPE_AGENT) + 255) >> 8; } tbp[16] = acc; } }
    if (MODE == 1) { for (int i = tid; i < 20 * 1024; i += NTHR) { const int o = i >> 10, k = i & 1023; wt[i] = (o < 4 ? wgr[(size_t)k * 4 + o] : wer[(size_t)k * 16 + (o - 4)]) * gvec[k]; } }
    __syncthreads();
    RowV gv; if (MODE == 2) gv = row_load(gvec, lane);
    for (int blk = blockIdx.x; blk < T / 256; blk += G) {
        for (int i2 = 0; i2 < 32; i2 += 2) {
          RowV rr[2];
#pragma unroll
          for (int u = 0; u < 2; ++u) {
            const int m = blk * 256 + wave * 32 + i2 + u;
            rr[u] = row_load_bf16(XB + (size_t)m * D, lane);
            if (COMBINE) {
                const unsigned i0 = tokinfo[(size_t)m * 2], i1 = tokinfo[(size_t)m * 2 + 1];
                const size_t s0 = (size_t)tbp[i0 >> 16] * 256 + (i0 & 0xffffu), s1 = (size_t)tbp[i1 >> 16] * 256 + (i1 & 0xffffu);
                const RowV y0 = row_load_fp8(YC + s0 * D, lane, 1.0f / F8_YSCALE), y1 = row_load_fp8(YC + s1 * D, lane, 1.0f / F8_YSCALE);
#pragma unroll
                for (int j = 0; j < 4; ++j) rr[u].v[j] = rr[u].v[j] + y0.v[j] + y1.v[j];
            }
          }
#pragma unroll
          for (int u = 0; u < 2; ++u) {
            const int i = i2 + u;
            const int rl = wave * 32 + i, m = blk * 256 + rl;
            RowV r = rr[u];
            if (MODE == 0) {
                u32x2* xp = (u32x2*)(XB + (size_t)m * D) + lane;
#pragma unroll
                for (int j = 0; j < 4; ++j) { u32x2 w; w.x = cvt_pk_bf16(r.v[j][0], r.v[j][1]); w.y = cvt_pk_bf16(r.v[j][2], r.v[j][3]); xp[64 * j] = w;
                    r.v[j] = (f32x4){bf_lo(w.x), bf_hi(w.x), bf_lo(w.y), bf_hi(w.y)}; }
            }
            const float rstd = row_rstd(r);
            if (MODE != 2) { if (lane == 0) RSTD[m] = rstd; }
            if (MODE == 1 || (MODE == 0 && G3_F8)) { unsigned* x8 = (unsigned*)(p.ws + WS_XB8 + (size_t)m * D) + lane;
#pragma unroll
                for (int j = 0; j < 4; ++j) x8[64 * j] = cvt_pk4_fp8(r.v[j][0], r.v[j][1], r.v[j][2], r.v[j][3]); }
            if (MODE == 1) {
                float lg[20];
#pragma unroll
                for (int o = 0; o < 20; ++o) { float s = 0.f;
#pragma unroll
                    for (int j = 0; j < 4; ++j) { const f32x4 w = *(const LAS f32x4*)(wt + o * 1024 + 4 * lane + 256 * j); s += (r.v[j][0] * w[0] + r.v[j][1] * w[1]) + (r.v[j][2] * w[2] + r.v[j][3] * w[3]); }
                    lg[o] = wave_sum(s) * rstd + (o < 4 ? bgr[o] : ber[o - 4]); }
                int gs = 0; float gm = lg[0];
#pragma unroll
                for (int o = 1; o < 4; ++o) if (lg[o] > gm) { gm = lg[o]; gs = o; }
                float den = 0.f;
#pragma unroll
                for (int o = 0; o < 4; ++o) den += __expf(lg[o] - gm);
                const float pg = 1.0f / den;
                float el[4];
#pragma unroll
                for (int o = 0; o < 4; ++o) { float v = lg[4 + o];
#pragma unroll
                    for (int g2 = 1; g2 < 4; ++g2) v = (gs == g2) ? lg[4 + 4 * g2 + o] : v;
                    el[o] = v; }
                int i0 = 0; float v0 = el[0];
#pragma unroll
                for (int o = 1; o < 4; ++o) if (el[o] > v0) { v0 = el[o]; i0 = o; }
                int i1 = -1; float v1 = -INFINITY;
#pragma unroll
                for (int o = 0; o < 4; ++o) if (o != i0 && el[o] > v1) { v1 = el[o]; i1 = o; }
                const float ex = __expf(v1 - v0); const float w0 = 1.0f / (1.0f + ex), w1 = ex * w0;
                if (lane == 0) { te[rl * 2] = gs * 4 + i0; te[rl * 2 + 1] = gs * 4 + i1; tc[rl * 2] = w0 * pg; tc[rl * 2 + 1] = w1 * pg; trs[rl] = rstd; }
            }
            if (MODE == 2) {
#pragma unroll
                for (int j = 0; j < 4; ++j) r.v[j] = r.v[j] * rstd * gv.v[j];
                row_store(OUT + (size_t)m * D, lane, r);
            }
          }
        }
        if (MODE == 1) {
            __syncthreads();
            if (tid < 16) { int c = 0; for (int q = 0; q < 512; ++q) if (te[q] == tid) { trank[q] = c; ++c; }
                ebase[tid] = c ? (int)__hip_atomic_fetch_add(cnt_cur + tid * 64, (unsigned)c, __ATOMIC_RELAXED, __HIP_MEMORY_SCOPE_AGENT) : 0; }
            __syncthreads();
            { const int q = tid, e = te[q], pos = ebase[e] + trank[q], tok = blk * 256 + (q >> 1);
              rowtok[(size_t)e * ECAP + pos] = (unsigned)tok; cwraw[(size_t)e * ECAP + pos] = tc[q]; rsraw[(size_t)e * ECAP + pos] = trs[q >> 1]; tokinfo[(size_t)tok * 2 + (q & 1)] = ((unsigned)e << 16) | (unsigned)pos; }
            __syncthreads();
        }
    }
    __syncthreads();
}

__device__ __forceinline__ void phase_router(const Params& p, LAS unsigned char* lds, int tid_, int wave, int G,
                                             const float* gvec, const float* wgr, const float* bgr, const float* wer, const float* ber, unsigned* cnt_cur) {
    int tid = tid_; asm volatile("" : "+v"(tid)); const int lane = tid & 63, r32 = lane & 31, hi = lane >> 5;
    const bf16_t* XB = (const bf16_t*)(p.ws + WS_XB); float* rsraw = (float*)(p.ws + WS_RSRAW);
    unsigned* tokinfo = (unsigned*)(p.ws + WS_TOKINFO);
    unsigned* rowtok = (unsigned*)(p.ws + WS_ROWTOK); float* cwraw = (float*)(p.ws + WS_CWRAW);
    constexpr int WROW = 2048 + 16;
    LAS unsigned char* Whi = lds; LAS unsigned char* Wlo = lds + 24 * WROW;
    LAS int* misc = (LAS int*)(lds + MISC_OFF);
    LAS int* te = misc + 1024; LAS float* tc = (LAS float*)(misc + 1536); LAS int* trank = misc + 2048; LAS int* ebase = misc + 2560; LAS float* trs = (LAS float*)(misc + 2600);
    for (int i = tid; i < 24 * 1024; i += NTHR) { const int sl = i >> 10, k = i & 1023; float w;
        if (sl < 8) w = wgr[(size_t)k * 4 + (sl & 3)]; else { const int q = sl - 8, e = (q & 3) + 8 * ((q >> 2) & 1) + 4 * (q >> 3); w = wer[(size_t)k * 16 + e]; }
        w *= gvec[k];
        const unsigned hb = cvt_pk_bf16(w, 0.f) & 0xffffu; const float wl = w - __uint_as_float(hb << 16); const unsigned lb = cvt_pk_bf16(wl, 0.f) & 0xffffu;
        *(LAS unsigned short*)(Whi + sl * WROW + k * 2) = (unsigned short)hb; *(LAS unsigned short*)(Wlo + sl * WROW + k * 2) = (unsigned short)lb; }
    __syncthreads();
    const int slot_row = r32 < 24 ? r32 : r32 - 8;
    const LAS unsigned char* wh = Whi + slot_row * WROW + hi * 16; const LAS unsigned char* wl_ = Wlo + slot_row * WROW + hi * 16;
    for (int blk = blockIdx.x; blk < T / 256; blk += G) {
        const int rl = wave * 32 + r32, m = blk * 256 + rl;
        const bf16_t* xr = XB + (size_t)m * D + hi * 8;
        f32x16 acc = (f32x16){}; float ss = 0.f;
        bf16x8 xa[4], xb[4];
#pragma unroll
        for (int q = 0; q < 4; ++q) xa[q] = *(const bf16x8*)(xr + q * 16);
#pragma unroll 1
        for (int t = 0; t < 16; t += 2) {
#pragma unroll
            for (int q = 0; q < 4; ++q) xb[q] = *(const bf16x8*)(xr + (t + 1) * 64 + q * 16);
#pragma unroll
            for (int q = 0; q < 4; ++q) { const bf16x8 ah = *(const LAS bf16x8*)(wh + t * 128 + q * 32), al = *(const LAS bf16x8*)(wl_ + t * 128 + q * 32);
                acc = __builtin_amdgcn_mfma_f32_32x32x16_bf16(ah, xa[q], acc, 0, 0, 0); acc = __builtin_amdgcn_mfma_f32_32x32x16_bf16(al, xa[q], acc, 0, 0, 0);
#pragma unroll
                for (int j = 0; j < 4; ++j) { const unsigned w = ((const unsigned*)&xa[q])[j]; const float a = bf_lo(w), b = bf_hi(w); ss += a * a + b * b; } }
            if (t + 2 < 16) {
#pragma unroll
                for (int q = 0; q < 4; ++q) xa[q] = *(const bf16x8*)(xr + (t + 2) * 64 + q * 16); }
#pragma unroll
            for (int q = 0; q < 4; ++q) { const bf16x8 ah = *(const LAS bf16x8*)(wh + (t + 1) * 128 + q * 32), al = *(const LAS bf16x8*)(wl_ + (t + 1) * 128 + q * 32);
                acc = __builtin_amdgcn_mfma_f32_32x32x16_bf16(ah, xb[q], acc, 0, 0, 0); acc = __builtin_amdgcn_mfma_f32_32x32x16_bf16(al, xb[q], acc, 0, 0, 0);
#pragma unroll
                for (int j = 0; j < 4; ++j) { const unsigned w = ((const unsigned*)&xb[q])[j]; const float a = bf_lo(w), b = bf_hi(w); ss += a * a + b * b; } }
        }
        ss += __shfl_xor(ss, 32);
        const float rstd = 1.0f / sqrtf(ss * (1.0f / D) + NORM_EPS);
        float lg[4];
#pragma unroll
        for (int o = 0; o < 4; ++o) lg[o] = acc[o] * rstd + bgr[o];
        int gs = 0; float gm = lg[0];
#pragma unroll
        for (int o = 1; o < 4; ++o) if (lg[o] > gm) { gm = lg[o]; gs = o; }
        float den = 0.f;
#pragma unroll
        for (int o = 0; o < 4; ++o) den += __expf(lg[o] - gm);
        const float pg = 1.0f / den;
        if ((gs >> 1) == hi) {
            float el[4];
#pragma unroll
            for (int o = 0; o < 4; ++o) el[o] = ((gs & 1) ? acc[8 + o] : acc[4 + o]) * rstd + ber[gs * 4 + o];
            int i0 = 0; float v0 = el[0];
#pragma unroll
            for (int o = 1; o < 4; ++o) if (el[o] > v0) { v0 = el[o]; i0 = o; }
            int i1 = -1; float v1 = -INFINITY;
#pragma unroll
            for (int o = 0; o < 4; ++o) if (o != i0 && el[o] > v1) { v1 = el[o]; i1 = o; }
            const float ex = __expf(v1 - v0); const float w0 = 1.0f / (1.0f + ex), w1 = ex * w0;
            te[rl * 2] = gs * 4 + i0; te[rl * 2 + 1] = gs * 4 + i1; tc[rl * 2] = w0 * pg; tc[rl * 2 + 1] = w1 * pg; trs[rl] = rstd;
        }
        __syncthreads();
        int myrank = 0; const int eq = te[tid];
        { LAS int* wcnt = misc + 3000;
#pragma unroll
          for (int ee = 0; ee < 16; ++ee) { const unsigned long long mk = __ballot(eq == ee); if (eq == ee) myrank = __popcll(mk & ((1ull << lane) - 1ull)); if (lane == 0) wcnt[wave * 16 + ee] = __popcll(mk); }
          __syncthreads();
          for (int w2 = 0; w2 < wave; ++w2) myrank += wcnt[w2 * 16 + eq];
          if (tid < 16) { int c = 0;
#pragma unroll
              for (int w2 = 0; w2 < 8; ++w2) c += wcnt[w2 * 16 + tid];
              ebase[tid] = c ? (int)__hip_atomic_fetch_add(cnt_cur + tid * 64, (unsigned)c, __ATOMIC_RELAXED, __HIP_MEMORY_SCOPE_AGENT) : 0; } }
        __syncthreads();
        { const int q = tid, e = eq, pos = ebase[e] + myrank, tok = blk * 256 + (q >> 1);
          rowtok[(size_t)e * ECAP + pos] = (unsigned)tok; cwraw[(size_t)e * ECAP + pos] = tc[q]; rsraw[(size_t)e * ECAP + pos] = trs[q >> 1]; tokinfo[(size_t)tok * 2 + (q & 1)] = ((unsigned)e << 16) | (unsigned)pos; }
        __syncthreads();
    }
    __syncthreads();
}

__device__ __forceinline__ void phase_conv(const Params& p, int gw, int NGW, int lane) {
    const bf16_t* BG = (const bf16_t*)(p.ws + WS_BG); const bf16_t* Z = (const bf16_t*)(p.ws + WS_Z); bf16_t* A2 = (bf16_t*)(p.ws + WS_CAT);
    const float* cw = p.in[16];
    float w0[16], w1[16], w2[16];
#pragma unroll
    for (int h = 0; h < 2; ++h)
#pragma unroll
        for (int j = 0; j < 8; ++j) { const int c = h * 512 + lane * 8 + j; w0[h * 8 + j] = cw[c]; w1[h * 8 + j] = cw[D + c]; w2[h * 8 + j] = cw[2 * D + c]; }
    for (int run = gw; run < T / 32; run += NGW) {
        const int t0 = run * 32;
        float zm1[16], zm2[16];
#pragma unroll
        for (int j = 0; j < 16; ++j) { zm1[j] = 0.f; zm2[j] = 0.f; }
        if ((t0 & (SEQ - 1)) != 0) {
#pragma unroll
            for (int h = 0; h < 2; ++h) { const u32x4 a = *(const u32x4*)(Z + (size_t)(t0 - 1) * D + h * 512 + lane * 8), b = *(const u32x4*)(Z + (size_t)(t0 - 2) * D + h * 512 + lane * 8);
#pragma unroll
                for (int q = 0; q < 4; ++q) { zm1[h * 8 + 2 * q] = bf_lo(a[q]); zm1[h * 8 + 2 * q + 1] = bf_hi(a[q]); zm2[h * 8 + 2 * q] = bf_lo(b[q]); zm2[h * 8 + 2 * q + 1] = bf_hi(b[q]); } }
        }
#pragma unroll 4
        for (int i = 0; i < 32; ++i) {
            const size_t rb = (size_t)(t0 + i) * D;
#pragma unroll
            for (int h = 0; h < 2; ++h) { const u32x4 zz = *(const u32x4*)(Z + rb + h * 512 + lane * 8), bb = *(const u32x4*)(BG + rb + h * 512 + lane * 8);
                float o[8];
#pragma unroll
                for (int q = 0; q < 4; ++q) {
#pragma unroll
                    for (int s = 0; s < 2; ++s) { const int j = h * 8 + 2 * q + s; const float zc = s ? bf_hi(zz[q]) : bf_lo(zz[q]), bg = s ? bf_hi(bb[q]) : bf_lo(bb[q]);
                        o[2 * q + s] = bg * (w0[j] * zm2[j] + w1[j] * zm1[j] + w2[j] * zc); zm2[j] = zm1[j]; zm1[j] = zc; } }
                u32x4 w; w.x = cvt_pk_bf16(o[0], o[1]); w.y = cvt_pk_bf16(o[2], o[3]); w.z = cvt_pk_bf16(o[4], o[5]); w.w = cvt_pk_bf16(o[6], o[7]);
                *(u32x4*)(A2 + rb + h * 512 + lane * 8) = w; }
        }
    }
}

__device__ __forceinline__ void phase_gate_scan(const Params& p, int gw, int NGW, int lane) {
    const float* gates = (const float*)(p.ws + WS_GATES);
    float* SA = (float*)(p.ws + WS_SA); float* SAM = (float*)(p.ws + WS_SAM); float* SBA = (float*)(p.ws + WS_SBA);
    for (int sq = gw; sq < NBATCH * 4; sq += NGW) {
        const int b = sq >> 2, hd = sq & 3; const float ib = p.in[7][hd], fb = p.in[8][hd];
        float carryB = 0.f, carryM = -INFINITY;
#pragma unroll 1
        for (int i0 = 0; i0 < 32; i0 += 8) {
            float lf[8], ig[8];
#pragma unroll
            for (int i = 0; i < 8; ++i) { const size_t t = (size_t)b * SEQ + 64 * (i0 + i) + lane; const float f = gates[t * 8 + 4 + hd] + fb; ig[i] = gates[t * 8 + hd] + ib;
                lf[i] = (f >= 0.f) ? -log1pf(expf(-f)) : (f - log1pf(expf(f))); }
#pragma unroll
            for (int i = 0; i < 8; ++i) {
                float sB = lf[i];
#pragma unroll
                for (int o = 1; o < 64; o <<= 1) { const float v = __shfl_up(sB, o); if (lane >= o) sB += v; }
                sB += carryB; carryB = __shfl(sB, 63);
                const float a = ig[i] - sB;
                float m = a;
#pragma unroll
                for (int o = 1; o < 64; o <<= 1) { const float v = __shfl_up(m, o); if (lane >= o) m = fmaxf(m, v); }
                m = fmaxf(m, carryM); carryM = __shfl(m, 63);
                const size_t o2 = (size_t)sq * SEQ + 64 * (i0 + i) + lane; SA[o2] = a; SAM[o2] = m; SBA[o2] = sB + m;
            }
        }
    }
}

struct TileRegs { u32x4 v[2]; };
__device__ __forceinline__ TileRegs tile_load(const bf16_t* src, int tid) { TileRegs r;
#pragma unroll
    for (int i = 0; i < 2; ++i) { const int n = tid + 512 * i, row = n >> 4, ch = n & 15; r.v[i] = *(const u32x4*)(src + (size_t)row * NP + ch * 8); } return r; }
__device__ __forceinline__ void tile_write(LAS unsigned char* dst, int tid, const TileRegs& r) {
#pragma unroll
    for (int i = 0; i < 2; ++i) { const int n = tid + 512 * i, row = n >> 4, ch = n & 15; *(LAS u32x4*)(dst + off_b(row, ch)) = r.v[i]; } }

__device__ __forceinline__ void glds16(const void* gsrc, unsigned lds_dst) { unsigned keep;
    asm volatile("s_mov_b32 %0, m0\n\ts_mov_b32 m0, %2\n\ts_nop 0\n\tglobal_load_lds_dwordx4 %1, off\n\ts_mov_b32 m0, %0" : "=&s"(keep) : "v"(gsrc), "s"(lds_dst) : "memory"); }
__device__ __forceinline__ void tile_dma(const bf16_t* src, LAS unsigned char* dst, int wave, int lane) {
#pragma unroll
    for (int i = 0; i < 2; ++i) { const int piece = 2 * wave + i, row = 4 * piece + (lane >> 4); const unsigned ch = (unsigned)(lane & 15) ^ ((((unsigned)lane >> 4) << 2) | ((unsigned)piece & 3u));
        glds16(src + (size_t)row * NP + ch * 8, (unsigned)__builtin_amdgcn_readfirstlane((int)(unsigned)(uintptr_t)(dst + piece * 1024))); }
}
#define WAIT_ALL_BAR() asm volatile("s_waitcnt vmcnt(0) lgkmcnt(0)\n\ts_barrier" ::: "memory")
__device__ __forceinline__ void attn_unit(const Params& p, LAS unsigned char* lds, int bh, int qblk, int tid_, int wave, int lane_) {
    int tid = tid_; asm volatile("" : "+v"(tid)); const int lane = tid & 63;
    const bf16_t* P = (const bf16_t*)(p.ws + WS_P); bf16_t* CAT = (bf16_t*)(p.ws + WS_CAT);
    const int b = bh >> 2, hd = bh & 3, map = wave >> 2, qs = wave & 3, r32 = lane & 31, hi = lane >> 5;
    const size_t rowbase = (size_t)b * SEQ;
    const int q0 = qblk * 128 + qs * 32, qrow = q0 + r32;
    LAS float* fs = (LAS float*)(lds + MISC_OFF) + MW_F;
    LAS float* tbl = fs;
    constexpr float LOG2E = 1.4426950408889634f;
    if (tid < 272) { const int n = tid - 64; int bk;
        if (n < 16) bk = n < 0 ? 0 : n; else { bk = 16; const int th[15] = {19, 21, 24, 27, 31, 35, 40, 46, 52, 59, 67, 77, 87, 99, 113};
#pragma unroll
            for (int j = 0; j < 15; ++j) bk += (n >= th[j]) ? 1 : 0; }
        tbl[tid] = n < 0 ? -INFINITY : p.in[1][bk * 4 + hd] * LOG2E; }
    bf16x8 qf[4];
    { const bf16_t* qp = P + (rowbase + qrow) * NP + P_DQ + hd * 128 + map * 64 + hi * 8;
#pragma unroll
      for (int ks = 0; ks < 4; ++ks) qf[ks] = *(const bf16x8*)(qp + ks * 16); }
    const bf16_t* Kg = P + rowbase * NP + P_DK + hd * 128; const bf16_t* Vg = P + rowbase * NP + P_DV + hd * 128;
    const int NS = qblk + 1;
    f32x16 o[4];
#pragma unroll
    for (int c = 0; c < 4; ++c) o[c] = (f32x16){};
    float mrun = -INFINITY, lrun = 0.f;
    const float bias_far = p.in[1][31 * 4 + hd] * LOG2E;
    const unsigned xr = ((unsigned)(r32 & 3) << 2) | ((unsigned)(r32 >> 2) & 3u);
    const unsigned q4 = (lane & 15) >> 2, pp = lane & 3, blk = (lane >> 4) & 1;
#ifndef ATT_DMA
#define ATT_DMA 5
#endif
#ifndef ATT_LATE_DMA
#define ATT_LATE_DMA 1
#endif
#if ATT_DMA == 2 || ATT_DMA == 4
#elif ATT_DMA
    WAIT_ALL_BAR();
    { tile_dma(Kg, lds, wave, lane); tile_dma(Vg, lds + 16384, wave, lane); tile_dma(Kg + (size_t)64 * NP, lds + 32768, wave, lane); tile_dma(Vg + (size_t)64 * NP, lds + 49152, wave, lane); }
#else
    { TileRegs a0 = tile_load(Kg, tid), a1 = tile_load(Vg, tid), a2 = tile_load(Kg + (size_t)64 * NP, tid), a3 = tile_load(Vg + (size_t)64 * NP, tid);
      tile_write(lds, tid, a0); tile_write(lds + 16384, tid, a1); tile_write(lds + 32768, tid, a2); tile_write(lds + 49152, tid, a3); }
#endif
#if ATT_DMA == 5
    WAIT_ALL_BAR();
#endif
    asm volatile("" :: "v"(qf[0]), "v"(qf[1]), "v"(qf[2]), "v"(qf[3]));
#pragma unroll 1
    for (int st = 0; st < NS; ++st) {
        WAIT_ALL_BAR();
#if ATT_DMA == 2
        { LAS unsigned char* nb = lds + (st & 1) * 65536; const size_t ro = (size_t)st * 128 * NP;
            tile_dma(Kg + ro, nb, wave, lane); tile_dma(Vg + ro, nb + 16384, wave, lane); tile_dma(Kg + ro + (size_t)64 * NP, nb + 32768, wave, lane); tile_dma(Vg + ro + (size_t)64 * NP, nb + 49152, wave, lane); }
        WAIT_ALL_BAR();
#elif ATT_DMA == 3
#elif ATT_DMA
#if ATT_DMA == 4
        if (st == 0) { tile_dma(Kg, lds, wave, lane); tile_dma(Vg, lds + 16384, wave, lane); tile_dma(Kg + (size_t)64 * NP, lds + 32768, wave, lane); tile_dma(Vg + (size_t)64 * NP, lds + 49152, wave, lane); WAIT_ALL_BAR(); }
#endif
        if (!ATT_LATE_DMA && st + 1 < NS) { LAS unsigned char* nb = lds + ((st + 1) & 1) * 65536; const size_t ro = (size_t)(st + 1) * 128 * NP;
            tile_dma(Kg + ro, nb, wave, lane); tile_dma(Vg + ro, nb + 16384, wave, lane); tile_dma(Kg + ro + (size_t)64 * NP, nb + 32768, wave, lane); tile_dma(Vg + ro + (size_t)64 * NP, nb + 49152, wave, lane); }
#else
        TileRegs a0, a1;
        if (st + 1 < NS) { const size_t ro = (size_t)(st + 1) * 128 * NP; a0 = tile_load(Kg + ro, tid); a1 = tile_load(Vg + ro, tid); }
#endif
#pragma unroll
        for (int half = 0; half < 2; ++half) {
            const int j = 2 * st + half;
            const LAS unsigned char* Kt = lds + (st & 1) * 65536 + half * 32768; const LAS unsigned char* Vt = Kt + 16384;
            if (64 * j <= q0 + 31) {
                const int nmin = q0 - (64 * j + 63);
                const bool first = (mrun == -INFINITY);
                const float cinit = first ? 0.f : (nmin >= 113 ? bias_far - mrun : -mrun);
                f32x16 p0, p1;
#pragma unroll
                for (int r = 0; r < 16; ++r) { p0[r] = cinit; p1[r] = cinit; }
#pragma unroll
                for (int ks = 0; ks < 4; ++ks) { const unsigned ch = (unsigned)(8 * map + 2 * ks + hi) ^ xr;
                    const bf16x8 k0 = *(const LAS bf16x8*)(Kt + 256u * r32 + 16u * ch), k1 = *(const LAS bf16x8*)(Kt + 256u * (32 + r32) + 16u * ch);
                    p0 = __builtin_amdgcn_mfma_f32_32x32x16_bf16(k0, qf[ks], p0, 0, 0, 0); p1 = __builtin_amdgcn_mfma_f32_32x32x16_bf16(k1, qf[ks], p1, 0, 0, 0); }
                __builtin_amdgcn_sched_barrier(0);
                float rm = -INFINITY;
                if (first) {
                    if (nmin >= 113) {
#pragma unroll
                        for (int r = 0; r < 16; ++r) { p0[r] = p0[r] + bias_far; p1[r] = p1[r] + bias_far; rm = fmaxf(rm, fmaxf(p0[r], p1[r])); }
                    } else {
                        const LAS float* tb = tbl + (qrow - 64 * j - 4 * hi + 5);
#pragma unroll
                        for (int r = 0; r < 16; ++r) { const int e = (r & 3) + 8 * (r >> 2);
                            p0[r] += tb[59 - e]; p1[r] += tb[27 - e];
                            rm = fmaxf(rm, fmaxf(p0[r], p1[r])); }
                    }
                    { auto rr = __builtin_amdgcn_permlane32_swap(__float_as_uint(rm), __float_as_uint(rm), false, false); rm = fmaxf(__uint_as_float(rr[0]), __uint_as_float(rr[1])); }
                    mrun = rm;
#pragma unroll
                    for (int r = 0; r < 16; ++r) { p0[r] -= mrun; p1[r] -= mrun; }
                } else {
                    if (nmin < 113) {
                        const LAS float* tb = tbl + (qrow - 64 * j - 4 * hi + 5);
                        float bv0[16], bv1[16];
#pragma unroll
                        for (int r = 0; r < 16; ++r) { const int e = (r & 3) + 8 * (r >> 2); bv0[r] = tb[59 - e]; bv1[r] = tb[27 - e]; }
#pragma unroll
                        for (int r = 0; r < 16; ++r) { p0[r] += bv0[r]; p1[r] += bv1[r]; }
                    }
                    { float m0 = fmaxf(p0[0], p1[0]), m1 = fmaxf(p0[1], p1[1]);
#pragma unroll
                      for (int r = 2; r < 16; r += 2) { m0 = __builtin_fmaxf(__builtin_fmaxf(m0, p0[r]), p1[r]); m1 = __builtin_fmaxf(__builtin_fmaxf(m1, p0[r + 1]), p1[r + 1]); }
                      rm = fmaxf(m0, m1); }
                    { auto rr = __builtin_amdgcn_permlane32_swap(__float_as_uint(rm), __float_as_uint(rm), false, false); rm = fmaxf(__uint_as_float(rr[0]), __uint_as_float(rr[1])); }
                    if (__any(rm > 8.0f)) {
                        const float dl = fmaxf(rm, 0.f); const float alpha = fast_exp2(-dl);
                        lrun *= alpha; mrun += dl;
#pragma unroll
                        for (int r = 0; r < 16; ++r) { p0[r] -= dl; p1[r] -= dl; }
#pragma unroll
                        for (int c = 0; c < 4; ++c)
#pragma unroll
                            for (int r = 0; r < 16; ++r) o[c][r] *= alpha;
                    }
                }
                float psa = 0.f, psb = 0.f;
                bf16x8 pf[4];
#define ATT_EXPK(ks_) do { u32x4 w_; _Pragma("unroll") for (int q = 0; q < 4; ++q) { const int r = 8 * ((ks_) & 1) + 2 * q; \
                        const float ea = fast_exp2((ks_) < 2 ? p0[r] : p1[r]), eb = fast_exp2((ks_) < 2 ? p0[r + 1] : p1[r + 1]); psa += ea; psb += eb; w_[q] = cvt_pk_bf16(ea, eb); } \
                    pf[ks_] = __builtin_bit_cast(bf16x8, w_); } while (0)
                bf16x8 vf[2][4];
#define ATT_LOADV(buf, ks_) do { _Pragma("unroll") for (int c = 0; c < 4; ++c) { const unsigned chv = (unsigned)(4 * c + 2 * blk + (pp >> 1)); const unsigned row0 = 16u * (ks_) + 4u * hi + q4; \
                        vf[buf][c] = cat8(vtr(Vt + off_b(row0, chv) + 8u * (pp & 1)), vtr(Vt + off_b(row0 + 8u, chv) + 8u * (pp & 1))); } } while (0)
                ATT_LOADV(0, 0);
                ATT_EXPK(0);
                if (ATT_LATE_DMA && half == 0 && st + 1 < NS) {
                    LAS unsigned char* nb = lds + ((st + 1) & 1) * 65536; const size_t ro = (size_t)(st + 1) * 128 * NP;
                    tile_dma(Kg + ro, nb, wave, lane); tile_dma(Vg + ro, nb + 16384, wave, lane); tile_dma(Kg + ro + (size_t)64 * NP, nb + 32768, wave, lane); tile_dma(Vg + ro + (size_t)64 * NP, nb + 49152, wave, lane); }
#pragma unroll
                for (int ks = 0; ks < 4; ++ks) {
                    if (ks < 3) ATT_LOADV((ks + 1) & 1, ks + 1);
                    __builtin_amdgcn_sched_barrier(0);
#pragma unroll
                    for (int c = 0; c < 4; ++c) o[c] = __builtin_amdgcn_mfma_f32_32x32x16_bf16(vf[ks & 1][c], pf[ks], o[c], 0, 0, 0);
                    if (ks < 3) { ATT_EXPK(ks + 1); asm volatile("" : "+v"(pf[(ks + 1) & 3]), "+v"(psa), "+v"(psb)); }
                    __builtin_amdgcn_sched_barrier(0);
                }
                lrun += psa + psb;
#undef ATT_EXPK
#undef ATT_LOADV
            }
#if ATT_DMA == 5
            if (half == 0) WAIT_ALL_BAR();
#endif
#if !ATT_DMA
            if (st + 1 < NS) { LAS unsigned char* nb = lds + ((st + 1) & 1) * 65536 + half * 32768; tile_write(nb, tid, a0); tile_write(nb + 16384, tid, a1);
                if (half == 0) { const size_t ro = (size_t)(st + 1) * 128 * NP + (size_t)64 * NP; a0 = tile_load(Kg + ro, tid); a1 = tile_load(Vg + ro, tid); } }
#endif
        }
#if ATT_DMA == 3
        WAIT_ALL_BAR();
        if (st + 1 < NS) { LAS unsigned char* nb = lds + ((st + 1) & 1) * 65536; const size_t ro = (size_t)(st + 1) * 128 * NP;
            tile_dma(Kg + ro, nb, wave, lane); tile_dma(Vg + ro, nb + 16384, wave, lane); tile_dma(Kg + ro + (size_t)64 * NP, nb + 32768, wave, lane); tile_dma(Vg + ro + (size_t)64 * NP, nb + 49152, wave, lane); }
#endif

    }
    WAIT_ALL_BAR();
    lrun += __shfl_xor(lrun, 32);
    const float inv = 1.0f / lrun;
    float lam;
    { float s1 = 0.f, s2 = 0.f; const float a1 = p.in[10][lane] * p.in[11][lane], a2 = p.in[12][lane] * p.in[13][lane]; s1 = wave_sum(a1); s2 = wave_sum(a2);
      const float lam_init = 0.8f - 0.6f * 1.0f;
      lam = expf(s1) - expf(s2) + lam_init; }
    LAS float* xch = (LAS float*)lds + qs * 4096;
    if (map == 1) {
#pragma unroll
        for (int c = 0; c < 4; ++c)
#pragma unroll
            for (int r = 0; r < 16; ++r) xch[(32 * c + crow(r, hi)) * 32 + r32] = o[c][r] * inv * lam;
    }
    __syncthreads();
    if (map == 0) {
        float ss = 0.f;
#pragma unroll
        for (int c = 0; c < 4; ++c)
#pragma unroll
            for (int r = 0; r < 16; ++r) { const float v = o[c][r] * inv - xch[(32 * c + crow(r, hi)) * 32 + r32]; o[c][r] = v; ss += v * v; }
        ss += __shfl_xor(ss, 32);
        const float rstd = 1.0f / sqrtf(ss * (1.0f / 128.0f) + NORM_EPS) * 0.8f;
        const float* sub = p.in[14];
        bf16_t* orow = CAT + (rowbase + qrow) * D + 512 + hd * 128;
#pragma unroll
        for (int c = 0; c < 4; ++c)
#pragma unroll
            for (int rqp = 0; rqp < 4; rqp += 2) { u32x2 w[2];
#pragma unroll
                for (int h = 0; h < 2; ++h) { const int rq = rqp + h; const int e0 = 32 * c + 8 * rq + 4 * hi; const f32x4 sv = *(const f32x4*)(sub + e0);
                    w[h].x = cvt_pk_bf16(o[c][4 * rq] * rstd * sv[0], o[c][4 * rq + 1] * rstd * sv[1]); w[h].y = cvt_pk_bf16(o[c][4 * rq + 2] * rstd * sv[2], o[c][4 * rq + 3] * rstd * sv[3]); }
                const auto rx = __builtin_amdgcn_permlane32_swap(w[0].x, w[1].x, false, false); const auto ry = __builtin_amdgcn_permlane32_swap(w[0].y, w[1].y, false, false);
                u32x4 ww; ww.x = rx[0]; ww.y = ry[0]; ww.z = rx[1]; ww.w = ry[1];
                *(u32x4*)(orow + 32 * c + 8 * (rqp + hi)) = ww; }
    }
    __syncthreads();
}

__device__ __forceinline__ void mlstm_s1_unit(const Params& p, LAS unsigned char* lds, int bh, int c, int tid_, int wave, int lane_) {
    int tid = tid_; asm volatile("" : "+v"(tid)); const int lane = tid & 63;
    const bf16_t* P = (const bf16_t*)(p.ws + WS_P);
    const int b = bh >> 2, hd = bh & 3, r32 = lane & 31, hi = lane >> 5;
    const size_t t0 = (size_t)b * SEQ + (size_t)c * MCH;
    const float* SA = (const float*)(p.ws + WS_SA) + (size_t)bh * SEQ + c * MCH;
    LAS float* fs = (LAS float*)(lds + MISC_OFF) + MW_F;
    LAS float* wsm = fs;
    LAS float* red = fs + 256;
    float av = (tid < 256) ? SA[tid] : -INFINITY;
    float mx = av;
#pragma unroll
    for (int o = 1; o < 64; o <<= 1) mx = fmaxf(mx, __shfl_xor(mx, o));
    if (lane == 0) red[wave] = mx;
    __syncthreads();
    float R = red[0];
#pragma unroll
    for (int w = 1; w < 4; ++w) R = fmaxf(R, red[w]);
    if (tid < 256) wsm[tid] = __expf(av - R) * 0.08838834764831845f;
    __syncthreads();
    LAS unsigned char* Kl = lds; LAS unsigned char* Vl = lds + 65536;
    const bf16_t* Kg = P + t0 * NP + P_MK + hd * 128; const bf16_t* Vg = P + t0 * NP + P_MV + hd * 128;
#pragma unroll
    for (int i = 0; i < 8; ++i) { const int n = tid + 512 * i, row = n >> 4, ch = n & 15;
        const u32x4 kv = *(const u32x4*)(Kg + (size_t)row * NP + ch * 8); const u32x4 vv = *(const u32x4*)(Vg + (size_t)row * NP + ch * 8);
        const float w = wsm[row]; u32x4 ks;
#pragma unroll
        for (int q = 0; q < 4; ++q) ks[q] = cvt_pk_bf16(bf_lo(kv[q]) * w, bf_hi(kv[q]) * w);
        *(LAS u32x4*)(Kl + off_b(row, ch)) = ks; *(LAS u32x4*)(Vl + off_b(row, ch)) = vv; }
    __syncthreads();
    const int eb = wave >> 1, dh = wave & 1;
    const unsigned q4 = (lane & 15) >> 2, pp = lane & 3, blk = (lane >> 4) & 1;
    f32x16 acc[2]; acc[0] = (f32x16){}; acc[1] = (f32x16){};
    for (int ks = 0; ks < 16; ++ks) {
        const unsigned row0 = 16u * ks + 8u * hi + q4, row1 = row0 + 4u;
        const unsigned cha = (unsigned)(4 * eb + 2 * blk + (pp >> 1));
        const bf16x8 af = cat8(vtr(Vl + off_b(row0, cha) + 8u * (pp & 1)), vtr(Vl + off_b(row1, cha) + 8u * (pp & 1)));
#pragma unroll
        for (int db = 0; db < 2; ++db) { const unsigned chb = (unsigned)(4 * (2 * dh + db) + 2 * blk + (pp >> 1));
            const bf16x8 bfr = cat8(vtr(Kl + off_b(row0, chb) + 8u * (pp & 1)), vtr(Kl + off_b(row1, chb) + 8u * (pp & 1)));
            acc[db] = __builtin_amdgcn_mfma_f32_32x32x16_bf16(af, bfr, acc[db], 0, 0, 0); }
    }
    const int unit = bh * NCH + c;
    float* UT = (float*)(p.ws + WS_UT) + (size_t)unit * 16384;
#pragma unroll
    for (int db = 0; db < 2; ++db)
#pragma unroll
        for (int r = 0; r < 16; ++r) UT[(32 * eb + crow(r, hi)) * 128 + 64 * dh + 32 * db + r32] = acc[db][r];
    if (tid < 128) { float s = 0.f; const int d = tid;
        for (int srow = 0; srow < 256; ++srow) { const unsigned short hv = *(const LAS unsigned short*)(Kl + off_b(srow, d >> 3) + (d & 7) * 2); s += __uint_as_float((unsigned)hv << 16); }
        ((float*)(p.ws + WS_UN))[(size_t)unit * 128 + d] = s; }
    if (tid == 0) ((float*)(p.ws + WS_UR))[unit] = R;
    __syncthreads();
}

__device__ __forceinline__ void mlstm_s3_unit(const Params& p, LAS unsigned char* lds, int bh, int c, int tid_, int wave, int lane_) {
    int tid = tid_; asm volatile("" : "+v"(tid)); const int lane = tid & 63;
    const bf16_t* P = (const bf16_t*)(p.ws + WS_P); bf16_t* CAT = (bf16_t*)(p.ws + WS_CAT);
    const int b = bh >> 2, hd = bh & 3, r32 = lane & 31, hi = lane >> 5;
    const size_t t0 = (size_t)b * SEQ + (size_t)c * MCH;
    const size_t so = (size_t)bh * SEQ + c * MCH;
    const float* SA = (const float*)(p.ws + WS_SA) + so; const float* SAM = (const float*)(p.ws + WS_SAM) + so; const float* SBA = (const float*)(p.ws + WS_SBA) + so;
    LAS float* fs = (LAS float*)(lds + MISC_OFF) + MW_F;
    LAS float* as = fs;
    LAS float* nC = fs + 256;
    LAS unsigned char* Ct = lds + 65536;
    const int qloc = 32 * wave + r32;
    const float Aq = SAM[qloc], BAq = SBA[qloc];
    if (tid < 256) as[tid] = SA[tid];
    bf16x8 qf[8];
    { const bf16_t* qp = P + (t0 + qloc) * NP + P_MQ + hd * 128 + hi * 8;
#pragma unroll
      for (int ks = 0; ks < 8; ++ks) qf[ks] = *(const bf16x8*)(qp + ks * 16); }
    const bf16_t* Kg = P + t0 * NP + P_MK + hd * 128; const bf16_t* Vg = P + t0 * NP + P_MV + hd * 128;
#if defined(S3_REGSTAGE)
    { TileRegs k0 = tile_load(Kg, tid), v0 = tile_load(Vg, tid); tile_write(lds, tid, k0); tile_write(lds + 16384, tid, v0); }
#elif !defined(S3_SERIAL)
    tile_dma(Kg, lds, wave, lane); tile_dma(Vg, lds + 16384, wave, lane);
#endif
    f32x16 o[4];
#pragma unroll
    for (int cb = 0; cb < 4; ++cb) o[cb] = (f32x16){};
    float den = 0.f, fst = 0.f;
    const unsigned xr = ((unsigned)(r32 & 3) << 2) | ((unsigned)(r32 >> 2) & 3u);
    if (c > 0) {
        const float* UR = (const float*)(p.ws + WS_UR) + bh * NCH; const float* UT = (const float*)(p.ws + WS_UT) + (size_t)bh * NCH * 16384; const float* UN = (const float*)(p.ws + WS_UN) + (size_t)bh * NCH * 128;
        float Pref = -INFINITY, ur[7];
#pragma unroll
        for (int j = 0; j < 7; ++j) { ur[j] = UR[j]; if (j < c) Pref = fmaxf(Pref, ur[j]); }
        float cf[7];
#pragma unroll
        for (int j = 0; j < 7; ++j) cf[j] = (j < c) ? __expf(ur[j] - Pref) : 0.f;
#pragma unroll 1
        for (int i = 0; i < 4; ++i) { const int n = tid + 512 * i, e = n >> 4, ch = n & 15; f32x4 u0[7], u1[7];
#pragma unroll
            for (int j = 0; j < 7; ++j) { const f32x4* up = (const f32x4*)(UT + (size_t)j * 16384 + e * 128 + ch * 8); u0[j] = up[0]; u1[j] = up[1]; }
            f32x4 s0 = (f32x4){0.f, 0.f, 0.f, 0.f}, s1 = s0;
#pragma unroll
            for (int j = 0; j < 7; ++j) { s0 += u0[j] * cf[j]; s1 += u1[j] * cf[j]; }
            u32x4 w; w.x = cvt_pk_bf16(s0[0], s0[1]); w.y = cvt_pk_bf16(s0[2], s0[3]); w.z = cvt_pk_bf16(s1[0], s1[1]); w.w = cvt_pk_bf16(s1[2], s1[3]);
            *(LAS u32x4*)(Ct + off_b(e, ch)) = w; }
        if (tid < 128) { float sN = 0.f;
#pragma unroll
            for (int j = 0; j < 7; ++j) sN += cf[j] * UN[j * 128 + tid];
            nC[tid] = sN; }
        fst = __expf(Pref - Aq);
    }
    asm volatile("" :: "v"(qf[0]), "v"(qf[1]), "v"(qf[2]), "v"(qf[3]), "v"(qf[4]), "v"(qf[5]), "v"(qf[6]), "v"(qf[7]), "v"(Aq), "v"(BAq));
    WAIT_ALL_BAR();
    if (c > 0) {
#pragma unroll
        for (int cb = 0; cb < 4; ++cb) {
#pragma unroll
            for (int ks = 0; ks < 8; ++ks) { const unsigned ch = (unsigned)(2 * ks + hi) ^ xr;
                const bf16x8 cfr = *(const LAS bf16x8*)(Ct + 256u * (32 * cb + r32) + 16u * ch);
                o[cb] = __builtin_amdgcn_mfma_f32_32x32x16_bf16(cfr, qf[ks], o[cb], 0, 0, 0); }
            __builtin_amdgcn_sched_barrier(0); }
#pragma unroll
        for (int cb = 0; cb < 4; ++cb)
#pragma unroll
            for (int r = 0; r < 16; ++r) o[cb][r] *= fst;
        float dq = 0.f;
#pragma unroll
        for (int ks = 0; ks < 8; ++ks)
#pragma unroll
            for (int q = 0; q < 4; ++q) { const unsigned w = ((const unsigned*)&qf[ks])[q]; const int d = 16 * ks + 8 * hi + 2 * q; dq += bf_lo(w) * nC[d] + bf_hi(w) * nC[d + 1]; }
        den = fst * dq;
    }
    const unsigned q4 = (lane & 15) >> 2, pp = lane & 3, blk = (lane >> 4) & 1;
#pragma unroll 1
    for (int j = 0; j < 4; ++j) {
        WAIT_ALL_BAR();
        const LAS unsigned char* Kt = lds + (j & 1) * 32768; const LAS unsigned char* Vt = Kt + 16384;
#if defined(S3_REGSTAGE)
        TileRegs kr, vr; if (j + 1 < 4) { kr = tile_load(Kg + (size_t)(j + 1) * 64 * NP, tid); vr = tile_load(Vg + (size_t)(j + 1) * 64 * NP, tid); }
#elif defined(S3_SERIAL)
        { LAS unsigned char* nb = lds + (j & 1) * 32768; tile_dma(Kg + (size_t)j * 64 * NP, nb, wave, lane); tile_dma(Vg + (size_t)j * 64 * NP, nb + 16384, wave, lane); }
        WAIT_ALL_BAR();
#else
        if (j + 1 < 4) { LAS unsigned char* nb = lds + ((j + 1) & 1) * 32768; tile_dma(Kg + (size_t)(j + 1) * 64 * NP, nb, wave, lane); tile_dma(Vg + (size_t)(j + 1) * 64 * NP, nb + 16384, wave, lane); }
#endif
        const bool doit = (64 * j <= 32 * wave + 31);
        bf16x8 pf[4];
        if (doit) {
            f32x16 p0 = (f32x16){}, p1 = (f32x16){};
#pragma unroll
            for (int ks = 0; ks < 8; ++ks) { const unsigned ch = (unsigned)(2 * ks + hi) ^ xr;
                const bf16x8 k0 = *(const LAS bf16x8*)(Kt + 256u * r32 + 16u * ch), k1 = *(const LAS bf16x8*)(Kt + 256u * (32 + r32) + 16u * ch);
                p0 = __builtin_amdgcn_mfma_f32_32x32x16_bf16(k0, qf[ks], p0, 0, 0, 0); p1 = __builtin_amdgcn_mfma_f32_32x32x16_bf16(k1, qf[ks], p1, 0, 0, 0); if ((ks & 3) == 3) __builtin_amdgcn_sched_barrier(0); }
            float ps = 0.f;
#pragma unroll
            for (int r = 0; r < 16; ++r) { const int kv = 64 * j + crow(r, hi);
                const float w0 = (kv <= qloc) ? __expf(as[kv] - Aq) * 0.08838834764831845f : 0.f, w1 = (kv + 32 <= qloc) ? __expf(as[kv + 32] - Aq) * 0.08838834764831845f : 0.f;
                p0[r] *= w0; p1[r] *= w1; ps += p0[r] + p1[r]; }
            den += ps;
#pragma unroll
            for (int ks = 0; ks < 4; ++ks) { u32x4 w;
#pragma unroll
                for (int q = 0; q < 4; ++q) { const int r = 8 * (ks & 1) + 2 * q; w[q] = (ks < 2) ? cvt_pk_bf16(p0[r], p0[r + 1]) : cvt_pk_bf16(p1[r], p1[r + 1]); }
                pf[ks] = __builtin_bit_cast(bf16x8, w); }
        }
        WAIT_ALL_BAR();
        if (doit) {
            bf16x8 vf[2][4];
#define S3_LOADV(buf, ks_) do { _Pragma("unroll") for (int cb = 0; cb < 4; ++cb) { const unsigned chv = (unsigned)(4 * cb + 2 * blk + (pp >> 1)); const unsigned row0 = 16u * (ks_) + 4u * hi + q4; \
                vf[buf][cb] = cat8(vtr(Vt + off_b(row0, chv) + 8u * (pp & 1)), vtr(Vt + off_b(row0 + 8u, chv) + 8u * (pp & 1))); } } while (0)
            S3_LOADV(0, 0);
#pragma unroll
            for (int ks = 0; ks < 4; ++ks) {
                if (ks < 3) S3_LOADV((ks + 1) & 1, ks + 1);
                __builtin_amdgcn_sched_barrier(0);
#pragma unroll
                for (int cb = 0; cb < 4; ++cb) o[cb] = __builtin_amdgcn_mfma_f32_32x32x16_bf16(vf[ks & 1][cb], pf[ks], o[cb], 0, 0, 0);
                __builtin_amdgcn_sched_barrier(0);
            }
#undef S3_LOADV
        }
#if defined(S3_REGSTAGE)
        if (j + 1 < 4) { LAS unsigned char* nb = lds + ((j + 1) & 1) * 32768; tile_write(nb, tid, kr); tile_write(nb + 16384, tid, vr); }
#endif
    }
    den += __shfl_xor(den, 32);
    const float dinv = 1.0f / fmaxf(fabsf(den), __expf(-BAq));
    float sm = 0.f;
#pragma unroll
    for (int cb = 0; cb < 4; ++cb)
#pragma unroll
        for (int r = 0; r < 16; ++r) { o[cb][r] *= dinv; sm += o[cb][r]; }
    sm += __shfl_xor(sm, 32);
    const float mu = sm * (1.0f / 128.0f);
    float vs = 0.f;
#pragma unroll
    for (int cb = 0; cb < 4; ++cb)
#pragma unroll
        for (int r = 0; r < 16; ++r) { o[cb][r] -= mu; vs += o[cb][r] * o[cb][r]; }
    vs += __shfl_xor(vs, 32);
    const float rstd = 1.0f / sqrtf(vs * (1.0f / 128.0f) + NORM_EPS);
    const float* hn = p.in[9] + hd * 128;
    const bf16_t* mo = P + (t0 + qloc) * NP + P_MO + hd * 128;
    bf16_t* orow = CAT + (t0 + qloc) * D + hd * 128;
    u32x2 mw[4][4];
#pragma unroll
    for (int cb = 0; cb < 4; ++cb)
#pragma unroll
        for (int rq = 0; rq < 4; ++rq) mw[cb][rq] = *(const u32x2*)(mo + 32 * cb + 8 * rq + 4 * hi);
#pragma unroll
    for (int cb = 0; cb < 4; ++cb)
#pragma unroll
        for (int rq = 0; rq < 4; ++rq) { const int e0 = 32 * cb + 8 * rq + 4 * hi; const f32x4 hv = *(const f32x4*)(hn + e0); const u32x2 m2 = mw[cb][rq];
            const float g0 = fast_rcp(1.0f + __expf(-bf_lo(m2.x))), g1 = fast_rcp(1.0f + __expf(-bf_hi(m2.x))), g2 = fast_rcp(1.0f + __expf(-bf_lo(m2.y))), g3 = fast_rcp(1.0f + __expf(-bf_hi(m2.y)));
            u32x2 w; w.x = cvt_pk_bf16(o[cb][4 * rq] * rstd * hv[0] * g0, o[cb][4 * rq + 1] * rstd * hv[1] * g1); w.y = cvt_pk_bf16(o[cb][4 * rq + 2] * rstd * hv[2] * g2, o[cb][4 * rq + 3] * rstd * hv[3] * g3);
            *(u32x2*)(orow + e0) = w; }
    WAIT_ALL_BAR();
}

__device__ __forceinline__ void mlstm_seq_unit(const Params& p, LAS unsigned char* lds, int bh, int tid_, int wave, int lane_) {
    int tid = tid_; asm volatile("" : "+v"(tid)); const int lane = tid & 63;
    const bf16_t* P = (const bf16_t*)(p.ws + WS_P); bf16_t* CAT = (bf16_t*)(p.ws + WS_CAT);
    const int b = bh >> 2, hd = bh & 3, r32 = lane & 31, hi = lane >> 5;
    LAS float* fs = (LAS float*)(lds + MISC_OFF) + MW_F;
    LAS float* as = fs;
    LAS float* nC = fs + 256;
    LAS float* wsc = fs + 384;
    LAS unsigned char* Ct = lds + 65536;
    const unsigned xr = ((unsigned)(r32 & 3) << 2) | ((unsigned)(r32 >> 2) & 3u);
    const unsigned q4 = (lane & 15) >> 2, pp = lane & 3, blk = (lane >> 4) & 1;
    const int eb = wave >> 1, dh = wave & 1;
    f32x16 cacc[2]; cacc[0] = (f32x16){}; cacc[1] = (f32x16){};
    float nrun = 0.f;
    float Prun = -INFINITY;
    LAS float* hnl = fs + 896;
    if (tid < 128) hnl[tid] = p.in[9][hd * 128 + tid];
#pragma unroll 1
    for (int c = 0; c < NCH; ++c) {
        const size_t t0 = (size_t)b * SEQ + (size_t)c * MCH;
        const size_t so = (size_t)bh * SEQ + c * MCH;
        const float* SA = (const float*)(p.ws + WS_SA) + so; const float* SAM = (const float*)(p.ws + WS_SAM) + so; const float* SBA = (const float*)(p.ws + WS_SBA) + so;
        const int qloc = 32 * wave + r32;
        const float Aq2 = SAM[qloc] * 1.4426950408889634f;
        if (tid < 256) as[tid] = SA[tid] * 1.4426950408889634f;
        bf16x8 qf[2];
        LAS bf16x8* qpark = (LAS bf16x8*)(lds + 98304 + tid * 64);
        LAS bf16x8* qpark2 = (LAS bf16x8*)(lds + 147456 + tid * 32);
        { const bf16_t* qp = P + (t0 + qloc) * NP + P_MQ + hd * 128 + hi * 8;
#pragma unroll
          for (int ks = 0; ks < 2; ++ks) qf[ks] = *(const bf16x8*)(qp + ks * 16);
#pragma unroll
          for (int ks = 2; ks < 6; ++ks) qpark[ks - 2] = *(const bf16x8*)(qp + ks * 16);
#pragma unroll
          for (int ks = 6; ks < 8; ++ks) qpark2[ks - 6] = *(const bf16x8*)(qp + ks * 16); }
#define QFRAG(ks) ((ks) < 2 ? qf[(ks) & 1] : ((ks) < 6 ? qpark[((ks) - 2) & 3] : qpark2[((ks) - 6) & 1]))
        const bf16_t* Kg = P + t0 * NP + P_MK + hd * 128; const bf16_t* Vg = P + t0 * NP + P_MV + hd * 128;
        tile_dma(Kg, lds, wave, lane); tile_dma(Vg, lds + 16384, wave, lane);
        asm volatile("" :: "v"(qf[0]), "v"(qf[1]), "v"(Aq2));
        WAIT_ALL_BAR();
        float R = fmaxf(fmaxf(as[lane], as[lane + 64]), fmaxf(as[lane + 128], as[lane + 192]));
#pragma unroll
        for (int o = 1; o < 64; o <<= 1) R = fmaxf(R, __shfl_xor(R, o));
        R *= (1.0f / 1.4426950408889634f);
        const float Pnew = fmaxf(Prun, R);
        const float scC = (c > 0) ? __expf(Prun - Pnew) : 0.f;
        if (tid < 256) wsc[tid] = fast_exp2(as[tid] - Pnew * 1.4426950408889634f) * 0.08838834764831845f;
        f32x16 o[4];
#pragma unroll
        for (int cb = 0; cb < 4; ++cb) o[cb] = (f32x16){};
        float den = 0.f;
        if (c > 0) {
#pragma unroll
            for (int cb = 0; cb < 4; ++cb) {
#pragma unroll
                for (int ks = 0; ks < 8; ++ks) { const unsigned ch = (unsigned)(2 * ks + hi) ^ xr;
                    const bf16x8 cfr = *(const LAS bf16x8*)(Ct + 256u * (32 * cb + r32) + 16u * ch);
                    const bf16x8 qv = QFRAG(ks);
                    o[cb] = __builtin_amdgcn_mfma_f32_32x32x16_bf16(cfr, qv, o[cb], 0, 0, 0); }
                __builtin_amdgcn_sched_barrier(0); }
            const float fst = fast_exp2(Prun * 1.4426950408889634f - Aq2);
#pragma unroll
            for (int cb = 0; cb < 4; ++cb)
#pragma unroll
                for (int r = 0; r < 16; ++r) o[cb][r] *= fst;
            float dq = 0.f;
#pragma unroll
            for (int ks = 0; ks < 8; ++ks) { const bf16x8 qv = QFRAG(ks);
#pragma unroll
                for (int q = 0; q < 4; ++q) { const unsigned w = ((const unsigned*)&qv)[q]; const int d = 16 * ks + 8 * hi + 2 * q; dq += bf_lo(w) * nC[d] + bf_hi(w) * nC[d + 1]; } }
            den = fst * dq;
#pragma unroll
            for (int r = 0; r < 16; ++r) { cacc[0][r] *= scC; cacc[1][r] *= scC; }
        }
        nrun *= scC;
#pragma unroll 1
        for (int j = 0; j < 4; ++j) {
            WAIT_ALL_BAR();
            const LAS unsigned char* Kt = lds + (j & 1) * 32768; const LAS unsigned char* Vt = Kt + 16384;
            if (j + 1 < 4) { LAS unsigned char* nb = lds + ((j + 1) & 1) * 32768; tile_dma(Kg + (size_t)(j + 1) * 64 * NP, nb, wave, lane); tile_dma(Vg + (size_t)(j + 1) * 64 * NP, nb + 16384, wave, lane); }
            const bool doit = (64 * j <= 32 * wave + 31);
            if (doit) {
                float ps = 0.f;
#pragma unroll
                for (int hf = 0; hf < 2; ++hf) {
                    f32x16 pp0 = (f32x16){};
#pragma unroll
                    for (int ks = 0; ks < 8; ++ks) { const unsigned ch = (unsigned)(2 * ks + hi) ^ xr;
                        const bf16x8 k0 = *(const LAS bf16x8*)(Kt + 256u * (32 * hf + r32) + 16u * ch);
                        const bf16x8 qv = QFRAG(ks);
                        pp0 = __builtin_amdgcn_mfma_f32_32x32x16_bf16(k0, qv, pp0, 0, 0, 0); }
#pragma unroll
                    for (int r = 0; r < 16; ++r) { const int kv = 64 * j + 32 * hf + crow(r, hi);
                        const float w0 = (kv <= qloc) ? fast_exp2(as[kv] - Aq2) * 0.08838834764831845f : 0.f;
                        pp0[r] *= w0; ps += pp0[r]; }
                    bf16x8 pfh[2];
#pragma unroll
                    for (int k2 = 0; k2 < 2; ++k2) { u32x4 w;
#pragma unroll
                        for (int q = 0; q < 4; ++q) { const int r = 8 * k2 + 2 * q; w[q] = cvt_pk_bf16(pp0[r], pp0[r + 1]); }
                        pfh[k2] = __builtin_bit_cast(bf16x8, w); }
                    __builtin_amdgcn_sched_barrier(0);
#pragma unroll
                    for (int k2 = 0; k2 < 2; ++k2)
#pragma unroll
                        for (int c2 = 0; c2 < 2; ++c2) {
                            bf16x8 vf[2];
#pragma unroll
                            for (int u = 0; u < 2; ++u) { const int cb = 2 * c2 + u; const unsigned chv = (unsigned)(4 * cb + 2 * blk + (pp >> 1)); const unsigned row0 = 16u * (2 * hf + k2) + 4u * hi + q4;
                                vf[u] = cat8(vtr(Vt + off_b(row0, chv) + 8u * (pp & 1)), vtr(Vt + off_b(row0 + 8u, chv) + 8u * (pp & 1))); }
                            o[2 * c2] = __builtin_amdgcn_mfma_f32_32x32x16_bf16(vf[0], pfh[k2], o[2 * c2], 0, 0, 0); o[2 * c2 + 1] = __builtin_amdgcn_mfma_f32_32x32x16_bf16(vf[1], pfh[k2], o[2 * c2 + 1], 0, 0, 0);
                            __builtin_amdgcn_sched_barrier(0);
                        }
                }
                den += ps;
            }
#pragma unroll
            for (int ks = 0; ks < 4; ++ks) {
                const unsigned row0 = 16u * ks + 8u * hi + q4, row1 = row0 + 4u;
                const unsigned cha = (unsigned)(4 * eb + 2 * blk + (pp >> 1));
                const bf16x8 af = cat8(vtr(Vt + off_b(row0, cha) + 8u * (pp & 1)), vtr(Vt + off_b(row1, cha) + 8u * (pp & 1)));
                const f32x4 wa = *(const LAS f32x4*)(wsc + 64 * j + 16 * ks + 8 * hi), wb = *(const LAS f32x4*)(wsc + 64 * j + 16 * ks + 8 * hi + 4);
#pragma unroll
                for (int db = 0; db < 2; ++db) { const unsigned chb = (unsigned)(4 * (2 * dh + db) + 2 * blk + (pp >> 1));
                    const s16x4 k0 = vtr(Kt + off_b(row0, chb) + 8u * (pp & 1)), k1 = vtr(Kt + off_b(row1, chb) + 8u * (pp & 1));
                    const u32x2 u0 = __builtin_bit_cast(u32x2, k0), u1 = __builtin_bit_cast(u32x2, k1);
                    u32x4 kw; kw.x = cvt_pk_bf16(bf_lo(u0.x) * wa[0], bf_hi(u0.x) * wa[1]); kw.y = cvt_pk_bf16(bf_lo(u0.y) * wa[2], bf_hi(u0.y) * wa[3]);
                    kw.z = cvt_pk_bf16(bf_lo(u1.x) * wb[0], bf_hi(u1.x) * wb[1]); kw.w = cvt_pk_bf16(bf_lo(u1.y) * wb[2], bf_hi(u1.y) * wb[3]);
                    cacc[db] = __builtin_amdgcn_mfma_f32_32x32x16_bf16(af, __builtin_bit_cast(bf16x8, kw), cacc[db], 0, 0, 0); }
                __builtin_amdgcn_sched_barrier(0);
            }
            { const int d = tid & 127, sq = tid >> 7; float sN = 0.f;
#pragma unroll 4
                for (int s2 = 0; s2 < 16; ++s2) { const int srow = 16 * sq + s2; const unsigned short hv = *(const LAS unsigned short*)(Kt + off_b(srow, d >> 3) + (d & 7) * 2); sN += __uint_as_float((unsigned)hv << 16) * wsc[64 * j + srow]; }
                nrun += sN; }
            WAIT_ALL_BAR();
        }
        int tid2 = tid_; asm volatile("" : "+v"(tid2));
        const int qloc2 = 32 * wave + (tid2 & 31), hi2 = (tid2 >> 5) & 1;
        const float BAq = SBA[qloc2];
        den += __shfl_xor(den, 32);
        const float dinv = 1.0f / fmaxf(fabsf(den), __expf(-BAq));
        float sm = 0.f;
#pragma unroll
        for (int cb = 0; cb < 4; ++cb)
#pragma unroll
            for (int r = 0; r < 16; ++r) { o[cb][r] *= dinv; sm += o[cb][r]; }
        sm += __shfl_xor(sm, 32);
        const float mu = sm * (1.0f / 128.0f);
        float vs = 0.f;
#pragma unroll
        for (int cb = 0; cb < 4; ++cb)
#pragma unroll
            for (int r = 0; r < 16; ++r) { o[cb][r] -= mu; vs += o[cb][r] * o[cb][r]; }
        vs += __shfl_xor(vs, 32);
        const float rstd = 1.0f / sqrtf(vs * (1.0f / 128.0f) + NORM_EPS);
        const bf16_t* mo = P + (t0 + qloc2) * NP + P_MO + hd * 128 + 4 * hi2;
        bf16_t* orow0 = CAT + (t0 + qloc2) * D + hd * 128;
#pragma unroll
        for (int c2 = 0; c2 < 2; ++c2) {
            u32x2 mw[8]; u32x2 wk = {0u, 0u};
#pragma unroll
            for (int u = 0; u < 8; u += 2) { const u32x4 g4 = *(const u32x4*)(mo - 4 * hi2 + 32 * (2 * c2 + (u >> 2)) + 8 * ((u & 3) + hi2));
                const auto rx = __builtin_amdgcn_permlane32_swap(g4.x, g4.z, false, false); const auto ry = __builtin_amdgcn_permlane32_swap(g4.y, g4.w, false, false);
                mw[u].x = rx[0]; mw[u].y = ry[0]; mw[u + 1].x = rx[1]; mw[u + 1].y = ry[1]; }
#pragma unroll
            for (int u = 0; u < 8; ++u) { const int cb = 2 * c2 + (u >> 2), rq = u & 3; const int e0 = 32 * cb + 8 * rq; const u32x2 m2 = mw[u]; const f32x4 hv = *(const LAS f32x4*)(hnl + e0 + 4 * hi2);
                const float g0 = fast_rcp(1.0f + fast_exp2(-1.4426950408889634f * bf_lo(m2.x))), g1 = fast_rcp(1.0f + fast_exp2(-1.4426950408889634f * bf_hi(m2.x))), g2 = fast_rcp(1.0f + fast_exp2(-1.4426950408889634f * bf_lo(m2.y))), g3 = fast_rcp(1.0f + fast_exp2(-1.4426950408889634f * bf_hi(m2.y)));
                u32x2 w; w.x = cvt_pk_bf16(o[cb][4 * rq] * rstd * hv[0] * g0, o[cb][4 * rq + 1] * rstd * hv[1] * g1); w.y = cvt_pk_bf16(o[cb][4 * rq + 2] * rstd * hv[2] * g2, o[cb][4 * rq + 3] * rstd * hv[3] * g3);
                if ((u & 1) == 0) wk = w;
                else { const auto sx = __builtin_amdgcn_permlane32_swap(wk.x, w.x, false, false); const auto sy = __builtin_amdgcn_permlane32_swap(wk.y, w.y, false, false);
                    u32x4 ww; ww.x = sx[0]; ww.y = sy[0]; ww.z = sx[1]; ww.w = sy[1];
                    *(u32x4*)(orow0 + 32 * cb + 8 * (rq - 1 + hi2)) = ww; } }
            __builtin_amdgcn_sched_barrier(0); }
        if (c + 1 < NCH) {
#pragma unroll
            for (int db = 0; db < 2; ++db)
#pragma unroll
                for (int r = 0; r < 16; ++r) { const int e = 32 * eb + crow(r, hi), d = 64 * dh + 32 * db + r32;
                    *(LAS unsigned short*)(Ct + off_b(e, d >> 3) + (d & 7) * 2) = (unsigned short)(cvt_pk_bf16(cacc[db][r], 0.f) & 0xffffu); }
            wsc[tid] = nrun;
        }
        Prun = Pnew;
        WAIT_ALL_BAR();
        if (c + 1 < NCH) { if (tid < 128) nC[tid] = (wsc[tid] + wsc[tid + 128]) + (wsc[tid + 256] + wsc[tid + 384]); }
    }
#undef QFRAG
}

__device__ __forceinline__ int moe_table(LAS unsigned char* lds, unsigned* cnt, int tid) {
    LAS int* misc = (LAS int*)(lds + MISC_OFF);
    __syncthreads();
    if (tid == 0) { int acc = 0; for (int e = 0; e < 16; ++e) { const int c = (int)__hip_atomic_load(cnt + e * 64, __ATOMIC_RELAXED, __HIP_MEMORY_SCOPE_AGENT); misc[MW_CN + e] = c; misc[MW_TB + e] = acc; acc += (c + 255) >> 8; } misc[MW_TB + 16] = acc; }
    __syncthreads();
    return misc[MW_TB + 16];
}

#ifndef STAGGER_MASK
#define STAGGER_MASK 0u
#endif
#ifndef STAGGER_GROUPS
#define STAGGER_GROUPS 4
#endif
#ifndef STAGGER_TICKS
#define STAGGER_TICKS 700
#endif
__device__ __forceinline__ void stagger(int vcu, int phase_bit) {
    if (!((STAGGER_MASK >> phase_bit) & 1u)) return;
    const int g = vcu & (STAGGER_GROUPS - 1); if (g == 0) return;
    const unsigned long long t0 = __builtin_amdgcn_s_memrealtime(); const unsigned long long w = (unsigned long long)g * STAGGER_TICKS;
    while (__builtin_amdgcn_s_memrealtime() - t0 < w) __builtin_amdgcn_s_sleep(8);
}
constexpr int LATE_UNITS = 224, LATE_UNITS_A = 160, LATE_UNITS_B = 64, CW_LATEQ = CW_QUEUE + 64 * 8;
template <int QID>
__device__ __forceinline__ void late_convert(const Params& p, LAS unsigned char* lds, unsigned* ctl, int quota, int tid, int wave, int lane) {
    volatile LAS unsigned* misc = (volatile LAS unsigned*)(lds + MISC_OFF);
    for (int k = 0; k < quota; ++k) {
        __syncthreads();
        if (tid == 0) misc[MW_Q] = __hip_atomic_fetch_add(ctl + CW_LATEQ + 64 * QID, 1u, __ATOMIC_RELAXED, __HIP_MEMORY_SCOPE_AGENT);
        __syncthreads();
        const int q = (int)misc[MW_Q];
        if (q >= 4 * (QID == 0 ? LATE_UNITS_A : LATE_UNITS_B)) break;
        const int c = q >> 2, sub = q & 3;
        const int v = QID == 0 ? (c < 32 ? 8 + c : 232 + 12 * ((c - 32) >> 3) + ((c - 32) & 7)) : 232 + 12 * (c >> 2) + 8 + (c & 3);
        const int f = WT_I1 + 64 * v + 16 * sub + 2 * wave;
        phase_prologue_weights(p, lds, f, f + 2, 1, wave, lane);
    }
    __syncthreads();
}
template <int LAYER>
__device__ __forceinline__ void moe_block(const Params& p, LAS unsigned char* lds, const XcdBarrier& bar, unsigned* ctl, int tid, int wave, int lane, int vcu, int G) {
    unsigned char* ws = p.ws;
    const LAS int* tb = (const LAS int*)(lds + MISC_OFF) + MW_TB; const LAS int* cn = (const LAS int*)(lds + MISC_OFF) + MW_CN;
    unsigned* cnt = ctl + CW_CNT + LAYER * 16 * 64;
    if (PH(12)) phase_router(p, lds, tid, wave, G, p.in[3] + LAYER * D, p.in[18] + (size_t)LAYER * D * 4, p.in[19] + LAYER * 4, p.in[20] + (size_t)LAYER * D * 16, p.in[21] + LAYER * 16, cnt);
    xcd_barrier(bar);
    const int ntot = moe_table(lds, cnt, tid);
    stagger(vcu, 13);
    for (int rep_ = 0; rep_ < REPS(13); ++rep_) if (PH(13)) { pg8::MoeSched<true> S{(const char*)(ws + WS_XB8), (const char*)(ws + WS_WGU) + (size_t)LAYER * 16 * 1024 * 1024, 512, (size_t)1024 * 1024, tb, cn, (const unsigned*)(ws + WS_ROWTOK), ntot, vcu, G};
      pg8::EpiPair<1> E{nullptr, (bf16_t*)(ws + WS_HM), FF, (const float*)(ws + WS_RSRAW), (const unsigned*)(ws + WS_ROWTOK), tb, cn};
      pg8::gemm_phase<pg8::EpiPair<1>, pg8::MoeSched<true>, true, true>(lds, 512, S, E); }
    const int nun = ntot * 4, rounds_max = (nun + G - 1) / G, rounds_mine = nun > vcu ? (nun - vcu + G - 1) / G : 0;
    if (LATE_CV && LAYER == 0 && PH(0)) late_convert<0>(p, lds, ctl, 2 * (rounds_max - rounds_mine), tid, wave, lane);
    if (LATE_CV && LAYER == 1 && PH(0)) { late_convert<1>(p, lds, ctl, 2 * (rounds_max - rounds_mine), tid, wave, lane); late_convert<1>(p, lds, ctl, 1 << 20, tid, wave, lane); }
    xcd_barrier(bar);
    stagger(vcu, 14);
    for (int rep_ = 0; rep_ < REPS(14); ++rep_) if (PH(14)) { pg8::MoeSched<false> S{(const char*)(ws + WS_HM), (const char*)(ws + WS_WD) + (size_t)LAYER * 16 * 1024 * 512, 256, (size_t)1024 * 512, tb, cn, nullptr, ntot, vcu, G};
      pg8::EpiDown E{(unsigned char*)(ws + WS_YC), (const float*)(ws + WS_CWRAW), tb, cn};
      pg8::gemm_phase<pg8::EpiDown, pg8::MoeSched<false>, false, true>(lds, 256, S, E); }
    if (LATE_CV && LAYER == 0 && PH(0)) { late_convert<0>(p, lds, ctl, rounds_max - rounds_mine, tid, wave, lane); late_convert<0>(p, lds, ctl, 1 << 20, tid, wave, lane); }
    xcd_barrier(bar);
}

__global__ void __launch_bounds__(NTHR, 2) fwd_kernel(Params p) {
    extern __shared__ __attribute__((aligned(16))) unsigned char lds_raw[];
    LAS unsigned char* lds = (LAS unsigned char*)lds_raw;
    const int tid = threadIdx.x, lane = tid & 63, wave = __builtin_amdgcn_readfirstlane(tid >> 6);
    const int G = gridDim.x; const int bx = blockIdx.x;
    const int vcu = (G % 8 == 0) ? (bx % 8) * (G / 8) + bx / 8 : bx;
    const int gw = vcu * NWAVES + wave, NGW = G * NWAVES;
    volatile LAS unsigned* misc = (volatile LAS unsigned*)(lds + MISC_OFF);
    for (int u = tid; u < (LDS_BYTES - MISC_OFF) / 4; u += NTHR) misc[u] = 0u;
    __syncthreads();
    unsigned* ctl = (unsigned*)(p.ws + WS_CTL);
    XcdBarrier bar = xcd_barrier_post(ctl + CW_BAR, misc + MW_BAR);
    unsigned char* ws = p.ws;

    for (int rep_ = 0; rep_ < REPS(0); ++rep_) if (PH(0)) phase_prologue_weights(p, lds, gw, WT_I1, NGW, wave, lane);
    __syncthreads();
    for (int rep_ = 0; rep_ < REPS(1); ++rep_) if (PH(1)) phase_norm_gates(p, lds, tid, gw, NGW, lane);
    xcd_barrier(bar);

    if (PH(2)) phase_gate_scan(p, gw, NGW, lane);
    stagger(vcu, 3);
    for (int rep_ = 0; rep_ < REPS(3); ++rep_) if (PH(3)) { pg8::DenseSched S; S.init(ws + WS_H, ws + WS_WT1, T, NP, 1024, G, bx); pg8::EpiBf16 E{(bf16_t*)(ws + WS_P), NP};
      pg8::gemm_phase<pg8::EpiBf16, pg8::DenseSched, false>(lds, 1024, S, E); }
    xcd_barrier(bar);

    {
        constexpr int NSEQ = NBATCH * 4, NAT = NBATCH * 4 * 16, NMEM = LATE_CV ? WT_UNITS - LATE_UNITS : WT_UNITS;
        for (int u = bx; u < NSEQ; u += G) { for (int r2 = 0; r2 < REPS(16); ++r2) if (PH(4)) mlstm_seq_unit(p, lds, u, tid, wave, lane); }
        for (int rep_ = 0; rep_ < REPS(4); ++rep_) {
            bool a_done = false, m_done = false; int sa_cnt = 0, sm_cnt = 0; (void)sa_cnt; (void)sm_cnt;
            for (int it = 0; !(a_done && m_done); ++it) {
                const int r5 = it % 5; bool want_mem = (r5 == 1 || r5 == 3);
                if (want_mem && m_done) want_mem = false; else if (!want_mem && a_done) want_mem = true;
                __syncthreads();
#ifdef STATIC_Q
                if (tid == 0) { misc[MW_Q] = (unsigned)((want_mem ? sm_cnt : sa_cnt) * G + bx); }
                if (want_mem) ++sm_cnt; else ++sa_cnt;
#else
                if (tid == 0) misc[MW_Q] = __hip_atomic_fetch_add(ctl + CW_QUEUE + 64 * (2 * rep_ + (want_mem ? 1 : 0)), 1u, __ATOMIC_RELAXED, __HIP_MEMORY_SCOPE_AGENT);
#endif
                __syncthreads();
                const int u = (int)misc[MW_Q];
                if (want_mem) {
                    if (u >= NMEM) { m_done = true; continue; }
                    { const int v = LATE_CV ? (u < 8 ? u : u + 32) : u;        for (int r2 = 0; r2 < REPS(18); ++r2) if (PH(0)) { const int f = WT_I1 + 64 * v + 8 * wave; phase_prologue_weights(p, lds, f, f + 8, 1, wave, lane); } }
                } else {
                    if (u >= NAT) { a_done = true; continue; }
                    for (int r2 = 0; r2 < REPS(17); ++r2) if (PH(5)) attn_unit(p, lds, u & 127, 15 - (u >> 7), tid, wave, lane);
                }
            }
        }
    }
    xcd_barrier(bar);

    for (int rep_ = 0; rep_ < REPS(7); ++rep_) if (PH(7)) { pg8::DenseSched S; S.init(ws + WS_CAT, ws + WS_WT2, T, 1024, 1024, G, bx); pg8::EpiResid<true> E{p.in[0], (bf16_t*)(ws + WS_XB), ws + WS_XB8};
      pg8::gemm_phase<pg8::EpiResid<true>, pg8::DenseSched, false>(lds, 1024, S, E); }
    xcd_barrier(bar);

    moe_block<0>(p, lds, bar, ctl, tid, wave, lane, vcu, G);
    if (PH(8)) phase_rows<0, true>(p, lds, tid, wave, lane, G, p.in[2] + D, nullptr, nullptr, nullptr, nullptr, ctl + CW_CNT, nullptr);
    xcd_barrier(bar);
    stagger(vcu, 9);
    for (int rep_ = 0; rep_ < REPS(9); ++rep_) if (PH(9)) { pg8::DenseSched S; S.init(G3_F8 ? ws + WS_XB8 : ws + WS_XB, ws + WS_WT3, T, 3072, G3_F8 ? 512 : 1024, G, bx); pg8::EpiPair<0> E{(bf16_t*)(ws + WS_BG), (bf16_t*)(ws + WS_Z), D, (const float*)(ws + WS_RSTD), nullptr, nullptr, nullptr};
      pg8::gemm_phase<pg8::EpiPair<0>, pg8::DenseSched, false, G3_F8 != 0>(lds, G3_F8 ? 512 : 1024, S, E); }
    xcd_barrier(bar);
    for (int rep_ = 0; rep_ < REPS(10); ++rep_) if (PH(10)) phase_conv(p, gw, NGW, lane);
    xcd_barrier(bar);
    if (PH(11)) { pg8::DenseSched S; S.init(ws + WS_CAT, ws + WS_WT4, T, 1024, 1024, G, bx); pg8::EpiResid<false> E{nullptr, (bf16_t*)(ws + WS_XB), ws + WS_XB8};
      pg8::gemm_phase<pg8::EpiResid<false>, pg8::DenseSched, false>(lds, 1024, S, E); }
    xcd_barrier(bar);
    moe_block<1>(p, lds, bar, ctl, tid, wave, lane, vcu, G);
    if (PH(15)) phase_rows<2, true>(p, lds, tid, wave, lane, G, p.in[4], nullptr, nullptr, nullptr, nullptr, ctl + CW_CNT + 16 * 64, nullptr);
}

extern "C" void kernel_launch(void* const* d_in, const int* in_sizes, int n_in, void* d_out, int out_size, void* d_ws, size_t ws_size, hipStream_t stream) {
    static int grid = 0;
    if (grid == 0) {
        if (n_in != 25 || in_sizes[0] != T * D || out_size != T * D || ws_size < WS_END) { fprintf(stderr, "kernel_launch: unexpected shapes (n_in %d, in0 %d, out %d, ws %zu)\n", n_in, n_in > 0 ? in_sizes[0] : -1, out_size, ws_size); grid = -1; return; }
        int dev = 0, cus = 0, per_cu = 0;
        if (hipGetDevice(&dev) != hipSuccess || hipDeviceGetAttribute(&cus, hipDeviceAttributeMultiprocessorCount, dev) != hipSuccess) { grid = -1; return; }
        if (hipFuncSetAttribute((const void*)fwd_kernel, hipFuncAttributeMaxDynamicSharedMemorySize, LDS_BYTES) != hipSuccess) { fprintf(stderr, "kernel_launch: hipFuncSetAttribute failed\n"); grid = -1; return; }
        if (hipOccupancyMaxActiveBlocksPerMultiprocessor(&per_cu, (const void*)fwd_kernel, NTHR, LDS_BYTES) != hipSuccess || per_cu < 1) fprintf(stderr, "kernel_launch: occupancy query reports %d\n", per_cu);
        (void)hipGetLastError();
        grid = cus;
    }
    if (grid < 0) return;
    hipMemsetAsync((char*)d_ws + WS_CTL, 0, CTL_ZERO_BYTES, stream);
    Params p{};
    for (int i = 0; i < 25; ++i) p.in[i] = (const float*)d_in[i];
    p.out = (float*)d_out; p.ws = (unsigned char*)d_ws;
    hipLaunchKernelGGL(fwd_kernel, dim3(grid), dim3(NTHR), LDS_BYTES, stream, p);
}
```

```cpp
#include <hip/hip_runtime.h>
#include <cstdio>
#include <cstdint>
#ifndef PHASE_MASK
#define PHASE_MASK 0xffffffffu
#endif
#define PH(k) (((PHASE_MASK) >> (k)) & 1u)
#ifndef PHASE_TWICE
#define PHASE_TWICE 0u
#endif
#define REPS(k) (1 + (int)(((PHASE_TWICE) >> (k)) & 1u))

#define LAS __attribute__((address_space(3)))
#define GAS __attribute__((address_space(1)))
typedef unsigned short bf16_t;
typedef short bf16x8 __attribute__((ext_vector_type(8)));
typedef short s16x4 __attribute__((ext_vector_type(4)));
typedef float f32x4 __attribute__((ext_vector_type(4)));
typedef float f32x2 __attribute__((ext_vector_type(2)));
typedef float f32x16 __attribute__((ext_vector_type(16)));
typedef unsigned u32x4 __attribute__((ext_vector_type(4)));
typedef unsigned u32x2 __attribute__((ext_vector_type(2)));
typedef GAS unsigned gu32;
typedef int i32x8 __attribute__((ext_vector_type(8)));
typedef int i32x4 __attribute__((ext_vector_type(4)));

constexpr int D = 1024, NBATCH = 32, SEQ = 2048, T = NBATCH * SEQ;
constexpr int EVEN_IN = 3592, NP = 3584;
constexpr int P_MQ = 0, P_MK = 512, P_MV = 1024, P_MO = 1536, P_DQ = 2048, P_DK = 2560, P_DV = 3072;
constexpr int NE = 16, FF = 512;
constexpr int ECAP = 65536;
constexpr float NORM_EPS = 1e-6f;
constexpr int NWAVES = 8, NTHR = 512;
constexpr int MCH = 256, NCH = SEQ / MCH;
constexpr int WT_I1 = 16 * 112, WT_ITEMS = 28928, WT_UNITS = (WT_ITEMS - WT_I1) / 64;

constexpr size_t MiB = 1u << 20;
constexpr size_t WS_CTL = 0, CTL_ZERO_BYTES = 1 * MiB;
constexpr size_t WS_WT1 = 1 * MiB, WS_WT2 = 8 * MiB, WS_WT3 = 10 * MiB, WS_WT4 = 16 * MiB, WS_WGU = 18 * MiB, WS_WD = 82 * MiB;
constexpr size_t WS_GATES = 114 * MiB, WS_SA = 116 * MiB, WS_SAM = 117 * MiB, WS_SBA = 118 * MiB, WS_UN = 119 * MiB, WS_UR = 119 * MiB + 768 * 1024;
constexpr size_t WS_UT = 120 * MiB;
constexpr size_t WS_ROWTOK = 184 * MiB, WS_CWRAW = 188 * MiB, WS_TOKINFO = 192 * MiB, WS_RSTD = 193 * MiB;
constexpr size_t WS_H = 194 * MiB, WS_CAT = 322 * MiB, WS_P = 450 * MiB;
constexpr size_t WS_RSRAW = 120 * MiB;
constexpr size_t WS_XB8 = 720 * MiB;
constexpr size_t WS_XB = WS_H;
constexpr size_t WS_BG = WS_P, WS_Z = WS_P + 128 * MiB, WS_HM = WS_P, WS_YC = WS_P + 136 * MiB;
constexpr size_t WS_END = 898 * MiB;
constexpr int CW_BAR = 4096;
constexpr int CW_CNT = 16384;
constexpr int CW_QUEUE = 32768;

__device__ __forceinline__ unsigned cvt_pk_bf16(float lo, float hi) { unsigned r; asm volatile("v_cvt_pk_bf16_f32 %0, %1, %2" : "=v"(r) : "v"(lo), "v"(hi)); return r; }
__device__ __forceinline__ unsigned cvt_pk4_fp8(float a, float b, float c, float d) { unsigned w = 0; w = (unsigned)__builtin_amdgcn_cvt_pk_fp8_f32(a, b, (int)w, false); w = (unsigned)__builtin_amdgcn_cvt_pk_fp8_f32(c, d, (int)w, true); return w; }
#ifndef LATE_CV
#define LATE_CV 1
#endif
#ifndef G3_F8
#define G3_F8 1
#endif
constexpr float F8_WSCALE = 64.0f, F8_HSCALE = 16.0f, F8_YSCALE = 64.0f;
__device__ __forceinline__ float bf_lo(unsigned w) { return __uint_as_float(w << 16); }
__device__ __forceinline__ float bf_hi(unsigned w) { return __uint_as_float(w & 0xffff0000u); }
__device__ __forceinline__ float wave_sum(float v) {
#pragma unroll
    for (int o = 1; o < 64; o <<= 1) v += __shfl_xor(v, o);
    return v;
}
__device__ __forceinline__ float fast_exp2(float x) { return __builtin_amdgcn_exp2f(x); }
__device__ __forceinline__ float fast_rcp(float x) { return __builtin_amdgcn_rcpf(x); }
__device__ __forceinline__ int crow(int r, int hi) { return (r & 3) + 8 * (r >> 2) + 4 * hi; }
__device__ __forceinline__ unsigned off_b(unsigned row, unsigned ch) { return 256u * row + 16u * (ch ^ (((row & 3u) << 2) | ((row >> 2) & 3u))); }
__device__ __forceinline__ s16x4 vtr(const LAS unsigned char* p) { return __builtin_bit_cast(s16x4, __builtin_amdgcn_ds_read_tr16_b64_v4i16((LAS s16x4*)p)); }
__device__ __forceinline__ bf16x8 cat8(s16x4 a, s16x4 b) { return (bf16x8){a[0], a[1], a[2], a[3], b[0], b[1], b[2], b[3]}; }

#define XB_TMO      128
#define XB_XCNT(j)  (256  + 64 * (j))
#define XB_XSUB(j)  (1280 + 64 * (j))
#define XB_XGEN(j)  (2304 + 64 * (j))
#define XB_TOP      3328
#define XB_TOPGEN   3392
#define XCD_BAR_WORDS 3456
#define XB_SPIN_CAP (1u << 18)
__device__ __forceinline__ unsigned xb_ld(unsigned* p)              { return __hip_atomic_load(p, __ATOMIC_RELAXED, __HIP_MEMORY_SCOPE_AGENT); }
__device__ __forceinline__ unsigned xb_add(unsigned* p, unsigned v) { return __hip_atomic_fetch_add(p, v, __ATOMIC_RELAXED, __HIP_MEMORY_SCOPE_AGENT); }
__device__ __forceinline__ unsigned xb_xcc_id() { return (unsigned)__builtin_amdgcn_s_getreg((3 << 11) | 20) & 0xFu; }
#define XB_SPIN(cond, bar) do { unsigned _sp = 0; while (cond) { __builtin_amdgcn_s_sleep(1); \
    if ((++_sp & 255u) == 0u) { if (xb_ld(&(bar)[XB_TMO])) break; if (_sp > XB_SPIN_CAP) { atomicAdd(&(bar)[XB_TMO], 1u); break; } } } } while (0)
struct XcdBarrier { unsigned* bar; unsigned x; volatile LAS unsigned* st; };
__device__ __forceinline__ XcdBarrier xcd_barrier_post(unsigned* bar, volatile LAS unsigned* st) {
    XcdBarrier b; b.bar = bar; b.x = xb_xcc_id(); b.st = st;
    if (threadIdx.x == 0) (void)xb_add(&bar[XB_XCNT(b.x)], 1u);
    return b;
}
__device__ __forceinline__ void xcd_barrier_complete(unsigned* bar, unsigned x, unsigned& nloc, unsigned& nx) {
    const unsigned G = gridDim.x * gridDim.y * gridDim.z;
    unsigned sum, cnt, mine, sp = 0u;
    for (;;) {
        sum = 0u; cnt = 0u; mine = 0u;
#pragma unroll
        for (unsigned j = 0; j < 16; ++j) { const unsigned c = xb_ld(&bar[XB_XCNT(j)]); sum += c; cnt += (c > 0u) ? 1u : 0u; mine = (j == x) ? c : mine; }
        if (sum == G) break;
        __builtin_amdgcn_s_sleep(1);
        if ((++sp & 255u) == 0u) { if (xb_ld(&bar[XB_TMO])) break; if (sp > XB_SPIN_CAP) { atomicAdd(&bar[XB_TMO], 1u); break; } }
    }
    nloc = mine > 0u ? mine : 1u; nx = cnt > 0u ? cnt : 1u;
}
__device__ __forceinline__ void xcd_barrier(const XcdBarrier& b) {
    asm volatile("s_waitcnt vmcnt(0)" ::: "memory");
    __syncthreads();
    if (threadIdx.x == 0) {
        unsigned* bar = b.bar;
        __builtin_amdgcn_s_waitcnt(0);
        unsigned nloc = b.st[0], nx = b.st[1];
        if (nloc == 0u) { xcd_barrier_complete(bar, b.x, nloc, nx); b.st[0] = nloc; b.st[1] = nx; }
        const unsigned old = xb_add(&bar[XB_XSUB(b.x)], 1u);
        const unsigned gen = old / nloc;
        if (old + 1u == (gen + 1u) * nloc) {
            __builtin_amdgcn_fence(__ATOMIC_RELEASE, "agent");
            asm volatile("s_waitcnt vmcnt(0)" ::: "memory");
            const unsigned og = xb_add(&bar[XB_TOP], 1u);
            const unsigned tg = og / nx;
            if (og + 1u == (tg + 1u) * nx) xb_add(&bar[XB_TOPGEN], 1u);
            else XB_SPIN(xb_ld(&bar[XB_TOPGEN]) == tg, bar);
            __builtin_amdgcn_fence(__ATOMIC_ACQUIRE, "agent");
            xb_add(&bar[XB_XGEN(b.x)], 1u);
            asm volatile("s_waitcnt vmcnt(0)" ::: "memory");
        } else {
            XB_SPIN(xb_ld(&bar[XB_XGEN(b.x)]) == gen, bar);
            __builtin_amdgcn_fence(__ATOMIC_ACQUIRE, "agent");
            asm volatile("s_waitcnt vmcnt(0)" ::: "memory");
        }
    }
    __syncthreads();
}

namespace pg8 {
constexpr int BM = 256, BK = 64, HALF = 128, HTB = HALF * BK * 2, STAGE_BYTES = 8 * HTB, NXCD = 8, WGM = 8;
__device__ __forceinline__ int lds_byte(int r, int c) { const int st = (r >> 4) * 2 + (c >> 5), rr = r & 15, cc = c & 31, ob = rr * 64 + cc * 2; return st * 1024 + (ob ^ (((ob >> 9) & 1) << 5)); }
__device__ __forceinline__ void stage_rc(int b, int& R, int& C) { const int st = b / 1024, sb = b % 1024, swz = sb ^ (((sb >> 9) & 1) << 5); R = (st >> 1) * 16 + swz / 64; C = (st & 1) * 32 + (swz % 64) / 2; }
__device__ __forceinline__ int perm32(int rho) { const int n = rho >> 4, i = rho & 15; return 8 * (i >> 2) + 4 * n + (i & 3); }
struct Unit { int pm, pn; };

template <class Epi, class Sched, bool GATHER, bool F8 = false>
__device__ __forceinline__ void gemm_phase(LAS unsigned char* lds, const int K, const Sched& S, const Epi& E) {
    int tid = threadIdx.x; asm volatile("" : "+v"(tid));
    const int wid = __builtin_amdgcn_readfirstlane(tid >> 6), lane = tid & 63, wr = wid >> 2, wc = wid & 3, fr = lane & 15, fq = lane >> 4;
    const int nt = K / BK;
    int Rr[2], Cc[2]; unsigned voffB[2];
#pragma unroll
    for (int i = 0; i < 2; ++i) { stage_rc(tid * 16 + i * 8192, Rr[i], Cc[i]); const int Rb = Epi::PERM ? ((Rr[i] & ~31) + perm32(Rr[i] & 31)) : Rr[i];
        voffB[i] = (unsigned)(Rb * K + Cc[i]) * 2u; }
    const size_t kstep = (size_t)(BK * 2);
    const size_t hstep = (size_t)HALF * K * 2;
    const unsigned ldsw = (unsigned)wid * 1024u;
    const int aoff = lds_byte(wr * 64 + fr, fq * 8), boff = lds_byte(wc * 32 + fr, fq * 8);
#define PG8_SA(b, h) (((b) * 2 + (h)) * HTB)
#define PG8_SB(b, h) ((4 + (b) * 2 + (h)) * HTB)
#define PG8_STAGE(bufoff, gbase, voff) do { _Pragma("unroll") for (int _i = 0; _i < 2; ++_i) \
        __builtin_amdgcn_global_load_lds((const unsigned*)((const char*)(gbase) + (voff)[_i]), (LAS unsigned*)(lds + (bufoff) + ldsw + _i * 8192), 16, 0, 0); } while (0)
#define PG8_LD8(p) __builtin_shufflevector(*(const LAS i32x4*)(p), *(const LAS i32x4*)((p) + 1024), 0, 1, 2, 3, 4, 5, 6, 7)
#define PG8_LDA(dst, b, h) do { if constexpr (F8) { _Pragma("unroll") for (int m = 0; m < 4; ++m) dst##8[m] = PG8_LD8(lds + PG8_SA(b, h) + aoff + m * 2048); } \
        else { _Pragma("unroll") for (int m = 0; m < 4; ++m) _Pragma("unroll") for (int k = 0; k < 2; ++k) dst[m][k] = *(const LAS bf16x8*)(lds + PG8_SA(b, h) + aoff + m * 2048 + k * 1024); } } while (0)
#define PG8_LDB(dst, b, h) do { if constexpr (F8) { _Pragma("unroll") for (int n = 0; n < 2; ++n) dst##8[n] = PG8_LD8(lds + PG8_SB(b, h) + boff + n * 2048); } \
        else { _Pragma("unroll") for (int n = 0; n < 2; ++n) _Pragma("unroll") for (int k = 0; k < 2; ++k) dst[n][k] = *(const LAS bf16x8*)(lds + PG8_SB(b, h) + boff + n * 2048 + k * 1024); } } while (0)
#define PG8_CAT8(x0, x1) __builtin_shufflevector(__builtin_bit_cast(i32x4, x0), __builtin_bit_cast(i32x4, x1), 0, 1, 2, 3, 4, 5, 6, 7)
#define PG8_MMA(ai, bj, At, Bt) do { __builtin_amdgcn_s_setprio(1); _Pragma("unroll") for (int m = 0; m < 4; ++m) _Pragma("unroll") for (int n = 0; n < 2; ++n) { \
        if constexpr (F8) asm volatile("v_mfma_scale_f32_16x16x128_f8f6f4 %0, %1, %2, %0, %3, %3 op_sel_hi:[0,0,0]" : "+v"(acc[ai][bj][m][n]) : "v"(Bt##8[n]), "v"(At##8[m]), "v"(f8one)); \
        else { _Pragma("unroll") for (int k = 0; k < 2; ++k) acc[ai][bj][m][n] = __builtin_amdgcn_mfma_f32_16x16x32_bf16(Bt[n][k], At[m][k], acc[ai][bj][m][n], 0, 0, 0); } } __builtin_amdgcn_s_setprio(0); } while (0)
#define PG8_WAIT_V(n) asm volatile("s_waitcnt vmcnt(" #n ")" ::: "memory")
#define PG8_WAIT_L(n) asm volatile("s_waitcnt lgkmcnt(" #n ")" ::: "memory")
#define PG8_BAR __builtin_amdgcn_s_barrier()
#define PG8_SCHED __builtin_amdgcn_sched_barrier(0)
#define PG8_VOFF(dst, u) do { _Pragma("unroll") for (int _h = 0; _h < 2; ++_h) _Pragma("unroll") for (int _i = 0; _i < 2; ++_i) { \
        if constexpr (GATHER) dst[_h][_i] = S.arow(u, _h * HALF + Rr[_i]) * (unsigned)(K * 2) + (unsigned)(Cc[_i] * 2); \
        else dst[_h][_i] = (unsigned)((_h * HALF + Rr[_i]) * K + Cc[_i]) * 2u; } } while (0)
    Unit cur, nxt; int ui = 0;
    if (!S.next(0, cur)) return;
    f32x4 acc[2][2][4][2];
    if constexpr (Epi::PRELOAD) E.preload(acc, cur, wr, wc, fr, fq);
    else {
#pragma unroll
    for (int a = 0; a < 2; ++a)
#pragma unroll
        for (int b = 0; b < 2; ++b)
#pragma unroll
            for (int m = 0; m < 4; ++m)
#pragma unroll
                for (int n = 0; n < 2; ++n) acc[a][b][m][n] = (f32x4){0.f, 0.f, 0.f, 0.f};
    }
    float epf[2][4] = {{0.f, 0.f, 0.f, 0.f}, {0.f, 0.f, 0.f, 0.f}};
    bf16x8 At[4][2], B0[2][2], B1[2][2];
    i32x8 At8[4], B08[2], B18[2]; const unsigned f8one = 0x7f7f7f7fu;
    unsigned vA[2][2], vN[2][2];
    PG8_VOFF(vA, cur);
    if constexpr (Epi::PREFETCH) E.prefetch(epf, cur, wr, fr);
    const char* cA = S.abase(cur); const char* cB = S.bbase(cur);
    PG8_STAGE(PG8_SB(0, 0), cB, voffB); PG8_STAGE(PG8_SB(0, 1), cB + hstep, voffB); PG8_STAGE(PG8_SA(0, 0), cA, vA[0]); PG8_STAGE(PG8_SA(0, 1), cA, vA[1]);
    if (wr == 1) PG8_BAR;
    PG8_WAIT_V(2); PG8_BAR;
    PG8_STAGE(PG8_SB(1, 0), cB + kstep, voffB); PG8_STAGE(PG8_SA(1, 0), cA + kstep, vA[0]); PG8_STAGE(PG8_SB(1, 1), cB + hstep + kstep, voffB);
    PG8_WAIT_V(6); PG8_BAR;
    for (;;) {
        const bool has_next = S.next(ui + 1, nxt);
        const char* nA = has_next ? S.abase(nxt) : cA; const char* nB = has_next ? S.bbase(nxt) : cB;
        if constexpr (GATHER) { if (has_next) { PG8_VOFF(vN, nxt); } else {
#pragma unroll
            for (int h = 0; h < 2; ++h)
#pragma unroll
                for (int i = 0; i < 2; ++i) vN[h][i] = vA[h][i]; } }
#pragma unroll 1
        for (int t = 0; t < nt; t += 2) {
            const bool last = (t == nt - 2);
            const char* a1 = cA + (size_t)(t + 1) * kstep;
            const char* a2 = last ? nA : cA + (size_t)(t + 2) * kstep; const char* b2 = last ? nB : cB + (size_t)(t + 2) * kstep;
            const char* a3 = a2 + kstep; const char* b3 = b2 + kstep;
            unsigned v2[2][2]; const unsigned lmask = last ? 0xffffffffu : 0u;
#pragma unroll
            for (int h = 0; h < 2; ++h)
#pragma unroll
                for (int i = 0; i < 2; ++i) { if constexpr (GATHER) v2[h][i] = (vN[h][i] & lmask) | (vA[h][i] & ~lmask); else v2[h][i] = vA[h][i]; }
            PG8_LDB(B0, 0, 0); PG8_LDB(B1, 0, 1); PG8_SCHED; PG8_LDA(At, 0, 0); PG8_STAGE(PG8_SA(1, 1), a1, vA[1]);
            PG8_WAIT_V(8); PG8_WAIT_L(0); PG8_BAR; PG8_MMA(0, 0, At, B0); PG8_MMA(0, 1, At, B1); PG8_BAR; PG8_SCHED;
            PG8_LDA(At, 0, 1); PG8_STAGE(PG8_SB(0, 0), b2, voffB); PG8_STAGE(PG8_SB(0, 1), b2 + hstep, voffB); PG8_STAGE(PG8_SA(0, 0), a2, v2[0]);
            PG8_WAIT_V(8); PG8_WAIT_L(0); PG8_BAR; PG8_MMA(1, 0, At, B0); PG8_MMA(1, 1, At, B1); PG8_BAR; PG8_SCHED;
            PG8_LDB(B0, 1, 0); PG8_LDB(B1, 1, 1); PG8_SCHED; PG8_LDA(At, 1, 0); PG8_STAGE(PG8_SA(0, 1), a2, v2[1]);
            PG8_WAIT_V(8); PG8_WAIT_L(0); PG8_BAR; PG8_MMA(0, 0, At, B0); PG8_MMA(0, 1, At, B1); PG8_BAR; PG8_SCHED;
            PG8_LDA(At, 1, 1); PG8_STAGE(PG8_SB(1, 0), b3, voffB); PG8_STAGE(PG8_SB(1, 1), b3 + hstep, voffB); PG8_STAGE(PG8_SA(1, 0), a3, v2[0]);
            PG8_WAIT_V(8); PG8_WAIT_L(0); PG8_BAR; PG8_MMA(1, 0, At, B0); PG8_MMA(1, 1, At, B1); PG8_BAR; PG8_SCHED;
        }
        if (wr == 0) PG8_BAR;
        if constexpr (F8) asm volatile("s_nop 15\n\ts_nop 15" ::: "memory");
        if constexpr (Epi::PREFETCH) E(acc, cur, wr, wc, fr, fq, epf); else E(acc, cur, wr, wc, fr, fq);
        if (!has_next) break;
        if constexpr (Epi::PREFETCH) E.prefetch(epf, nxt, wr, fr);
        if constexpr (Epi::PRELOAD) E.preload(acc, nxt, wr, wc, fr, fq);
        else {
#pragma unroll
        for (int a = 0; a < 2; ++a)
#pragma unroll
            for (int b = 0; b < 2; ++b)
#pragma unroll
                for (int m = 0; m < 4; ++m)
#pragma unroll
                    for (int n = 0; n < 2; ++n) acc[a][b][m][n] = (f32x4){0.f, 0.f, 0.f, 0.f};
        }
        cur = nxt; cA = nA; cB = nB; ++ui;
        if constexpr (GATHER) {
#pragma unroll
        for (int h = 0; h < 2; ++h)
#pragma unroll
            for (int i = 0; i < 2; ++i) vA[h][i] = vN[h][i]; }
        if (wr == 1) PG8_BAR;
    }
    PG8_WAIT_V(0);
    PG8_BAR;
#undef PG8_SA
#undef PG8_SB
#undef PG8_STAGE
#undef PG8_LDA
#undef PG8_LD8
#undef PG8_LDB
#undef PG8_MMA
#undef PG8_CAT8
#undef PG8_WAIT_V
#undef PG8_WAIT_L
#undef PG8_BAR
#undef PG8_SCHED
#undef PG8_VOFF
}

struct DenseSched {
    const char* A; const char* Bt; int K; int nM, nN, nwg, G, c;
    __device__ __forceinline__ void init(const void* A_, const void* Bt_, int M, int N, int K_, int G_, int c_) { A = (const char*)A_; Bt = (const char*)Bt_; K = K_; nM = M / BM; nN = N / BM; nwg = nM * nN; G = G_; c = c_; }
    __device__ __forceinline__ bool next(int i, Unit& u) const {
        const long L = (long)i * G + c; if (L >= nwg) return false;
        int wgid = (int)L; { const int q = nwg / NXCD, r = nwg % NXCD, xcd = wgid % NXCD, off = wgid / NXCD; wgid = (xcd < r ? xcd * (q + 1) : r * (q + 1) + (xcd - r) * q) + off; }
        const int nig = WGM * nN, gid = wgid / nig, fm = gid * WGM, gsz = (nM - fm) < WGM ? (nM - fm) : WGM;
        u.pm = fm + ((wgid % nig) % gsz); u.pn = (wgid % nig) / gsz; return true;
    }
    __device__ __forceinline__ const char* abase(const Unit& u) const { return A + (size_t)u.pm * BM * K * 2; }
    __device__ __forceinline__ const char* bbase(const Unit& u) const { return Bt + (size_t)u.pn * BM * K * 2; }
    __device__ __forceinline__ unsigned arow(const Unit&, int) const { return 0u; }
};
template <bool GATHER_A>
struct MoeSched {
    const char* A; const char* W; int K; size_t wstride; const LAS int* tb; const LAS int* cn; const unsigned* rowtok; int ntot, vcu, G;
    __device__ __forceinline__ bool next(int i, Unit& u) const { const int L = i * G + vcu; if (L >= ntot * 4) return false; u.pm = L >> 2; u.pn = L & 3; return true; }
    __device__ __forceinline__ int expert(int pm) const { int e = 0;
#pragma unroll
        for (int j = 1; j < 16; ++j) e += (pm >= tb[j]) ? 1 : 0; return e; }
    __device__ __forceinline__ const char* abase(const Unit& u) const { return GATHER_A ? A : A + (size_t)u.pm * BM * K * 2; }
    __device__ __forceinline__ const char* bbase(const Unit& u) const { return W + (size_t)expert(u.pm) * wstride + (size_t)u.pn * BM * K * 2; }
    __device__ __forceinline__ unsigned arow(const Unit& u, int r) const { const int e = expert(u.pm); const int idx = (u.pm - tb[e]) * BM + r; return idx < cn[e] ? rowtok[(size_t)e * ECAP + idx] : 0u; }
};

__device__ __forceinline__ u32x4 widen16(u32x2 a, u32x2 b) {
    const auto rx = __builtin_amdgcn_permlane16_swap(a.x, b.x, false, false); const auto ry = __builtin_amdgcn_permlane16_swap(a.y, b.y, false, false);
    u32x4 o; o.x = rx[0]; o.y = ry[0]; o.z = rx[1]; o.w = ry[1]; return o; }
struct EpiBf16 {
    static constexpr bool PERM = true, PRELOAD = false, PREFETCH = false;
    bf16_t* O; int ldc;
    __device__ __forceinline__ void operator()(const f32x4 (&acc)[2][2][4][2], const Unit& u, int wr, int wc, int fr, int fq) const {
        const int row0 = u.pm * BM + wr * 64 + fr, col0 = u.pn * BM + wc * 32 + 8 * fq;
#pragma unroll
        for (int ai = 0; ai < 2; ++ai)
#pragma unroll
            for (int m = 0; m < 4; ++m) { bf16_t* rowp = O + (size_t)(row0 + ai * HALF + m * 16) * ldc + col0;
#pragma unroll
                for (int bj = 0; bj < 2; ++bj) { const f32x4 v0 = acc[ai][bj][m][0], v1 = acc[ai][bj][m][1];
                    u32x4 w; w.x = cvt_pk_bf16(v0[0], v0[1]); w.y = cvt_pk_bf16(v0[2], v0[3]); w.z = cvt_pk_bf16(v1[0], v1[1]); w.w = cvt_pk_bf16(v1[2], v1[3]);
#ifdef EPI_NT
                    __builtin_nontemporal_store(w, (u32x4*)(rowp + bj * HALF));
#else
                    *(u32x4*)(rowp + bj * HALF) = w;
#endif
                } }
    }
};
template <bool XF32>
struct EpiResid {
    static constexpr bool PERM = true, PRELOAD = true, PREFETCH = false;
    const float* xin; bf16_t* XB; unsigned char* XB8;
    __device__ __forceinline__ void preload(f32x4 (&acc)[2][2][4][2], const Unit& u, int wr, int wc, int fr, int fq) const {
        const int row0 = u.pm * BM + wr * 64 + fr, col0 = u.pn * BM + wc * 32 + 8 * fq;
#pragma unroll
        for (int ai = 0; ai < 2; ++ai)
#pragma unroll
            for (int m = 0; m < 4; ++m) { const size_t off = (size_t)(row0 + ai * HALF + m * 16) * D + col0;
#pragma unroll
                for (int bj = 0; bj < 2; ++bj) {
                    if (XF32) { acc[ai][bj][m][0] = *(const f32x4*)(xin + off + bj * HALF); acc[ai][bj][m][1] = *(const f32x4*)(xin + off + bj * HALF + 4); }
                    else { const u32x4 w = *(const u32x4*)(XB + off + bj * HALF); acc[ai][bj][m][0] = (f32x4){bf_lo(w.x), bf_hi(w.x), bf_lo(w.y), bf_hi(w.y)}; acc[ai][bj][m][1] = (f32x4){bf_lo(w.z), bf_hi(w.z), bf_lo(w.w), bf_hi(w.w)}; } } }
    }
    __device__ __forceinline__ void operator()(const f32x4 (&acc)[2][2][4][2], const Unit& u, int wr, int wc, int fr, int fq) const {
        const int row0 = u.pm * BM + wr * 64 + fr, col0 = u.pn * BM + wc * 32 + 8 * fq;
        const int colw = u.pn * BM + wc * 32 + 8 * (fq & ~1);
#pragma unroll
        for (int ai = 0; ai < 2; ++ai)
#pragma unroll
            for (int mp = 0; mp < 4; mp += 2)
#pragma unroll
                for (int bj = 0; bj < 2; ++bj) { u32x2 w8[2];
#pragma unroll
                    for (int h = 0; h < 2; ++h) { const int m = mp + h; bf16_t* rowp = XB + (size_t)(row0 + ai * HALF + m * 16) * D + col0;
                        const f32x4 v0 = acc[ai][bj][m][0], v1 = acc[ai][bj][m][1];
                        u32x4 w; w.x = cvt_pk_bf16(v0[0], v0[1]); w.y = cvt_pk_bf16(v0[2], v0[3]); w.z = cvt_pk_bf16(v1[0], v1[1]); w.w = cvt_pk_bf16(v1[2], v1[3]);
                        *(u32x4*)(rowp + bj * HALF) = w;
                        w8[h].x = cvt_pk4_fp8(bf_lo(w.x), bf_hi(w.x), bf_lo(w.y), bf_hi(w.y)); w8[h].y = cvt_pk4_fp8(bf_lo(w.z), bf_hi(w.z), bf_lo(w.w), bf_hi(w.w)); }
                    *(u32x4*)(XB8 + (size_t)(row0 + ai * HALF + (mp + (fq & 1)) * 16) * D + colw + bj * HALF) = widen16(w8[0], w8[1]); }
    }
};
template <int MODE  >
struct EpiPair {
    static constexpr bool PERM = true, PRELOAD = false, PREFETCH = true;
    bf16_t* O0; bf16_t* O1; int ld1;
    const float* rstd; const unsigned* rowtok; const LAS int* tb; const LAS int* cn;
    __device__ __forceinline__ void prefetch(float (&rs)[2][4], const Unit& u, int wr, int fr) const {
        const int row0 = u.pm * BM + wr * 64 + fr;
        if (MODE == 0) {
#pragma unroll
            for (int ai = 0; ai < 2; ++ai)
#pragma unroll
                for (int m = 0; m < 4; ++m) rs[ai][m] = rstd[row0 + ai * HALF + m * 16] * (G3_F8 ? 1.0f / F8_WSCALE : 1.0f);
        } else {
            int e = 0;
#pragma unroll
            for (int j = 1; j < 16; ++j) e += (u.pm >= tb[j]) ? 1 : 0;
            const int idx0 = (u.pm - tb[e]) * BM + wr * 64 + fr, cne = cn[e];
#pragma unroll
            for (int ai = 0; ai < 2; ++ai)
#pragma unroll
                for (int m = 0; m < 4; ++m) { const int idx = idx0 + ai * HALF + m * 16; rs[ai][m] = idx < cne ? rstd[(size_t)e * ECAP + idx] * (1.0f / F8_WSCALE) : 0.f; }
        }
    }
    __device__ __forceinline__ void operator()(const f32x4 (&acc)[2][2][4][2], const Unit& u, int wr, int wc, int fr, int fq, const float (&rs)[2][4]) const {
        const int row0 = u.pm * BM + wr * 64 + fr;
        if (MODE == 0 && u.pn < 4) {
            const int col0 = u.pn * BM + wc * 32 + 8 * fq;
#pragma unroll
            for (int ai = 0; ai < 2; ++ai)
#pragma unroll
                for (int m = 0; m < 4; ++m) { bf16_t* rowp = O0 + (size_t)(row0 + ai * HALF + m * 16) * D + col0;
#pragma unroll
                    for (int bj = 0; bj < 2; ++bj) { const f32x4 v0 = acc[ai][bj][m][0] * rs[ai][m], v1 = acc[ai][bj][m][1] * rs[ai][m];
                        u32x4 w; w.x = cvt_pk_bf16(v0[0], v0[1]); w.y = cvt_pk_bf16(v0[2], v0[3]); w.z = cvt_pk_bf16(v1[0], v1[1]); w.w = cvt_pk_bf16(v1[2], v1[3]);
                        *(u32x4*)(rowp + bj * HALF) = w; } }
        } else {
            const int pt = (MODE == 0) ? (u.pn - 4) : u.pn;
            const int col0 = pt * HALF + wc * 32 + 8 * fq;
#pragma unroll
            for (int ai = 0; ai < 2; ++ai) { u32x2 wkeep = {0u, 0u};
#pragma unroll
                for (int m = 0; m < 4; ++m) { bf16_t* rowp = O1 + (size_t)(row0 + ai * HALF + m * 16) * ld1 + col0;
                    f32x4 r[2];
#pragma unroll
                    for (int n = 0; n < 2; ++n) { const f32x4 g = acc[ai][0][m][n] * rs[ai][m], up = acc[ai][1][m][n] * rs[ai][m];
                        if (MODE == 0) r[n] = g * up;
                        else {
#pragma unroll
                            for (int j = 0; j < 4; ++j) r[n][j] = __builtin_amdgcn_fmed3f(g[j] * fast_rcp(1.0f + fast_exp2(-1.4426950408889634f * g[j])) * up[j] * F8_HSCALE, -448.0f, 448.0f); } }
                    if (MODE == 1) { u32x2 w; w.x = cvt_pk4_fp8(r[0][0], r[0][1], r[0][2], r[0][3]); w.y = cvt_pk4_fp8(r[1][0], r[1][1], r[1][2], r[1][3]);
                        if ((m & 1) == 0) wkeep = w;
                        else *(u32x4*)((unsigned char*)O1 + (size_t)(row0 + ai * HALF + (m - 1 + (fq & 1)) * 16) * ld1 + (pt * HALF + wc * 32 + 8 * (fq & ~1))) = widen16(wkeep, w); }
                    else { u32x4 w; w.x = cvt_pk_bf16(r[0][0], r[0][1]); w.y = cvt_pk_bf16(r[0][2], r[0][3]); w.z = cvt_pk_bf16(r[1][0], r[1][1]); w.w = cvt_pk_bf16(r[1][2], r[1][3]);
                        *(u32x4*)rowp = w; } } }
        }
    }
};
struct EpiDown {
    static constexpr bool PERM = true, PRELOAD = false, PREFETCH = true;
    unsigned char* O; const float* cwraw; const LAS int* tb; const LAS int* cn;
    __device__ __forceinline__ void prefetch(float (&cws)[2][4], const Unit& u, int wr, int fr) const {
        int e = 0;
#pragma unroll
        for (int j = 1; j < 16; ++j) e += (u.pm >= tb[j]) ? 1 : 0;
        const int idx0 = (u.pm - tb[e]) * BM + wr * 64 + fr, cne = cn[e];
#pragma unroll
        for (int ai = 0; ai < 2; ++ai)
#pragma unroll
            for (int m = 0; m < 4; ++m) { const int idx = idx0 + ai * HALF + m * 16; cws[ai][m] = idx < cne ? cwraw[(size_t)e * ECAP + idx] * (F8_YSCALE / (F8_WSCALE * F8_HSCALE)) : 0.f; }
    }
    __device__ __forceinline__ void operator()(const f32x4 (&acc)[2][2][4][2], const Unit& u, int wr, int wc, int fr, int fq, const float (&cws)[2][4]) const {
        const int row0 = u.pm * BM + wr * 64 + fr, col0 = u.pn * BM + wc * 32 + 8 * fq;
        const int colw = u.pn * BM + wc * 32 + 8 * (fq & ~1);
#pragma unroll
        for (int ai = 0; ai < 2; ++ai)
#pragma unroll
            for (int mp = 0; mp < 4; mp += 2) {
                unsigned char* rowp = O + (size_t)(row0 + ai * HALF + (mp + (fq & 1)) * 16) * D + colw;
#pragma unroll
                for (int bj = 0; bj < 2; ++bj) { u32x2 w[2];
#pragma unroll
                    for (int h = 0; h < 2; ++h) { const float cw = cws[ai][mp + h]; f32x4 v0 = acc[ai][bj][mp + h][0] * cw, v1 = acc[ai][bj][mp + h][1] * cw;
#pragma unroll
                        for (int j = 0; j < 4; ++j) { v0[j] = __builtin_amdgcn_fmed3f(v0[j], -448.0f, 448.0f); v1[j] = __builtin_amdgcn_fmed3f(v1[j], -448.0f, 448.0f); }
                        w[h].x = cvt_pk4_fp8(v0[0], v0[1], v0[2], v0[3]); w[h].y = cvt_pk4_fp8(v1[0], v1[1], v1[2], v1[3]); }
                    *(u32x4*)(rowp + bj * HALF) = widen16(w[0], w[1]); } }
    }
};
}

constexpr int RING_BYTES = 131072;
constexpr int MISC_OFF = RING_BYTES;
constexpr int LDS_BYTES = 163840;
constexpr int MW_BAR = 0;
constexpr int MW_TB = 16;
constexpr int MW_CN = 40;
constexpr int MW_Q = 60;
constexpr int MW_F = 64;

struct Params {
    const float* in[25]; float* out; unsigned char* ws;
};

constexpr float ATT_QSCALE = 0.125f * 1.4426950408889634f;
__device__ __forceinline__ void transpose_item(const float* W, int ld, int K, int k0, int srccol, bf16_t* WT, int dstrow, LAS float* scr, int lane, const float* gk = nullptr, float wsc = 1.0f) {
    float tv[32];
#pragma unroll
    for (int i = 0; i < 32; ++i) { const int kk = 2 * i + (lane >> 5); tv[i] = W[(size_t)(k0 + kk) * ld + srccol + (lane & 31)]; }
#pragma unroll
    for (int i = 0; i < 32; ++i) { const int kk = 2 * i + (lane >> 5); scr[kk * 33 + (lane & 31)] = (gk ? tv[i] * gk[k0 + kk] : tv[i]) * wsc; }
    asm volatile("s_waitcnt lgkmcnt(0)" ::: "memory");
    const int c = lane & 7;
#pragma unroll
    for (int j = 0; j < 4; ++j) { const int n = (lane >> 3) + 8 * j; const LAS float* s = scr + (8 * c) * 33 + n;
        u32x4 o; o.x = cvt_pk_bf16(s[0 * 33], s[1 * 33]); o.y = cvt_pk_bf16(s[2 * 33], s[3 * 33]); o.z = cvt_pk_bf16(s[4 * 33], s[5 * 33]); o.w = cvt_pk_bf16(s[6 * 33], s[7 * 33]);
        *(u32x4*)(WT + (size_t)(dstrow + n) * K + k0 + 8 * c) = o; }
    asm volatile("s_waitcnt lgkmcnt(0)" ::: "memory");
}
__device__ __forceinline__ void transpose_item_f8(const float* W, int ld, int K, int k0, int srccol, unsigned char* WT8, int dstrow, LAS float* scr, int lane, const float* gk, float scale) {
    float tv[32];
#pragma unroll
    for (int i = 0; i < 32; ++i) { const int kk = 2 * i + (lane >> 5); tv[i] = W[(size_t)(k0 + kk) * ld + srccol + (lane & 31)]; }
#pragma unroll
    for (int i = 0; i < 32; ++i) { const int kk = 2 * i + (lane >> 5); scr[kk * 33 + (lane & 31)] = (gk ? tv[i] * gk[k0 + kk] : tv[i]) * scale; }
    asm volatile("s_waitcnt lgkmcnt(0)" ::: "memory");
    const int c = lane & 3;
#pragma unroll
    for (int j = 0; j < 2; ++j) { const int n = (lane >> 2) + 16 * j; const LAS float* q = scr + (16 * c) * 33 + n;
        u32x4 o; o.x = cvt_pk4_fp8(q[0 * 33], q[1 * 33], q[2 * 33], q[3 * 33]); o.y = cvt_pk4_fp8(q[4 * 33], q[5 * 33], q[6 * 33], q[7 * 33]);
        o.z = cvt_pk4_fp8(q[8 * 33], q[9 * 33], q[10 * 33], q[11 * 33]); o.w = cvt_pk4_fp8(q[12 * 33], q[13 * 33], q[14 * 33], q[15 * 33]);
        *(u32x4*)(WT8 + (size_t)(dstrow + n) * K + k0 + 16 * c) = o; }
    asm volatile("s_waitcnt lgkmcnt(0)" ::: "memory");
}
__device__ __forceinline__ int pair_row(int ch, int up) { return (ch >> 7) * 256 + up * 128 + (ch & 127); }

__device__ __forceinline__ void phase_prologue_weights(const Params& p, LAS unsigned char* lds, int first, int last, int step, int wave, int lane_) {
    int lane = lane_; asm volatile("" : "+v"(lane));
    LAS float* scr = (LAS float*)(lds + wave * 16384);
    unsigned char* ws = p.ws;
    constexpr int I1 = 16 * 112, I2 = 16 * 32, I3 = 16 * 96, I4 = 16 * 32, IE = 768;
    constexpr int NITEMS = I1 + I2 + I3 + I4 + 32 * IE;
    static_assert(NITEMS == 28928, "item count");
    for (int it = first; it < last; it += step) {
        int r = it;
        if (r < I1) { const int kb = r / 112, nb = r % 112; const int sc = nb < 64 ? 32 * nb : 2056 + 32 * (nb - 64), dr = nb < 64 ? 32 * nb : 2048 + 32 * (nb - 64);
            transpose_item(p.in[5], EVEN_IN, 1024, 64 * kb, sc, (bf16_t*)(ws + WS_WT1), dr, scr, lane, nullptr, (dr >= P_DQ && dr < P_DK) ? ATT_QSCALE : 1.0f); continue; } r -= I1;
        if (r < I2) { const int kb = r / 32, nb = r % 32; transpose_item(p.in[6], 1024, 1024, 64 * kb, 32 * nb, (bf16_t*)(ws + WS_WT2), 32 * nb, scr, lane); continue; } r -= I2;
        if (r < I3) { const int kb = r / 96, nb = r % 96; int dr;
            if (nb < 32) dr = 32 * nb; else if (nb < 64) dr = 1024 + pair_row(32 * (nb - 32), 0); else dr = 1024 + pair_row(32 * (nb - 64), 1);
            if (G3_F8) transpose_item_f8(p.in[15], 3072, 1024, 64 * kb, 32 * nb, ws + WS_WT3, dr, scr, lane, p.in[2] + D, F8_WSCALE);
            else transpose_item(p.in[15], 3072, 1024, 64 * kb, 32 * nb, (bf16_t*)(ws + WS_WT3), dr, scr, lane, p.in[2] + D);
            continue; } r -= I3;
        if (r < I4) { const int kb = r / 32, nb = r % 32; transpose_item(p.in[17], 1024, 1024, 64 * kb, 32 * nb, (bf16_t*)(ws + WS_WT4), 32 * nb, scr, lane); continue; } r -= I4;
        const int le = r / IE; r %= IE;
        unsigned char* wgu = ws + WS_WGU + (size_t)le * 1024 * 1024; unsigned char* wd = ws + WS_WD + (size_t)le * 1024 * 512;
        if (r < 256) { const int kb = r / 16, nb = r % 16; transpose_item_f8(p.in[22] + (size_t)le * 1024 * 512, 512, 1024, 64 * kb, 32 * nb, wgu, pair_row(32 * nb, 0), scr, lane, p.in[3] + (le >> 4) * D, F8_WSCALE); continue; } r -= 256;
        if (r < 256) { const int kb = r / 16, nb = r % 16; transpose_item_f8(p.in[23] + (size_t)le * 1024 * 512, 512, 1024, 64 * kb, 32 * nb, wgu, pair_row(32 * nb, 1), scr, lane, p.in[3] + (le >> 4) * D, F8_WSCALE); continue; } r -= 256;
        { const int kb = r / 32, nb = r % 32; transpose_item_f8(p.in[24] + (size_t)le * 512 * 1024, 1024, 512, 64 * kb, 32 * nb, wd, 32 * nb, scr, lane, nullptr, F8_WSCALE); }
    }
}

struct RowV { f32x4 v[4]; };
__device__ __forceinline__ RowV row_load(const float* xr, int lane) { RowV r; const f32x4* p = (const f32x4*)xr + lane;
#pragma unroll
    for (int j = 0; j < 4; ++j) r.v[j] = p[64 * j]; return r; }
__device__ __forceinline__ void row_store(float* xr, int lane, const RowV& r) { f32x4* p = (f32x4*)xr + lane;
#pragma unroll
    for (int j = 0; j < 4; ++j) p[64 * j] = r.v[j]; }
__device__ __forceinline__ RowV row_load_bf16(const bf16_t* yr, int lane) { RowV r; const u32x2* p = (const u32x2*)yr + lane;
#pragma unroll
    for (int j = 0; j < 4; ++j) { const u32x2 w = p[64 * j]; r.v[j] = (f32x4){bf_lo(w.x), bf_hi(w.x), bf_lo(w.y), bf_hi(w.y)}; } return r; }
__device__ __forceinline__ RowV row_load_fp8(const unsigned char* yr, int lane, float sc) { RowV r; const unsigned* p = (const unsigned*)yr + lane;
#pragma unroll
    for (int j = 0; j < 4; ++j) { const unsigned w = p[64 * j]; const f32x2 lo = __builtin_amdgcn_cvt_pk_f32_fp8((int)w, false), hi = __builtin_amdgcn_cvt_pk_f32_fp8((int)w, true); r.v[j] = (f32x4){lo.x * sc, lo.y * sc, hi.x * sc, hi.y * sc}; } return r; }
__device__ __forceinline__ float row_rstd(const RowV& r) { float s = 0.f;
#pragma unroll
    for (int j = 0; j < 4; ++j) s += (r.v[j][0] * r.v[j][0] + r.v[j][1] * r.v[j][1]) + (r.v[j][2] * r.v[j][2] + r.v[j][3] * r.v[j][3]);
    return 1.0f / sqrtf(wave_sum(s) * (1.0f / D) + NORM_EPS); }
__device__ __forceinline__ void row_store_bf16(bf16_t* hr, int lane, const RowV& r) { u32x2* p = (u32x2*)hr + lane;
#pragma unroll
    for (int j = 0; j < 4; ++j) { u32x2 w; w.x = cvt_pk_bf16(r.v[j][0], r.v[j][1]); w.y = cvt_pk_bf16(r.v[j][2], r.v[j][3]); p[64 * j] = w; } }

__device__ __forceinline__ void phase_norm_gates(const Params& p, LAS unsigned char* lds, int tid, int gw, int NGW, int lane) {
    const float* x = p.in[0]; const float* g = p.in[2]; const float* win = p.in[5];
    bf16_t* H = (bf16_t*)(p.ws + WS_H); float* gates = (float*)(p.ws + WS_GATES);
    LAS float* wt = (LAS float*)lds;
    for (int i = tid; i < 8 * 1024; i += NTHR) { const int k = i >> 3, o = i & 7; wt[o * 1024 + k] = win[(size_t)k * EVEN_IN + 2048 + o] * g[k]; }
    __syncthreads();
    RowV gv = row_load(g, lane);
    for (int m0 = gw; m0 < T; m0 += 2 * NGW) {
      RowV rr[2];
#pragma unroll
      for (int u = 0; u < 2; ++u) { const int mm = m0 + u * NGW; rr[u] = row_load(x + (size_t)(mm < T ? mm : m0) * D, lane); }
#pragma unroll
      for (int u = 0; u < 2; ++u) {
        const int m = m0 + u * NGW; if (m >= T) break; RowV r = rr[u];
        const float rstd = row_rstd(r);
        float dots[8];
#pragma unroll
        for (int o = 0; o < 8; ++o) { float s = 0.f;
#pragma unroll
            for (int j = 0; j < 4; ++j) { const f32x4 w = *(const LAS f32x4*)(wt + o * 1024 + 4 * lane + 256 * j); s += (r.v[j][0] * w[0] + r.v[j][1] * w[1]) + (r.v[j][2] * w[2] + r.v[j][3] * w[3]); }
            dots[o] = s; }
        float gsum;
        { const bool b5 = (lane & 32) != 0, b4 = (lane & 16) != 0, b3 = (lane & 8) != 0;
          float k4[4];
#pragma unroll
          for (int i = 0; i < 4; ++i) { const float keep = b5 ? dots[4 + i] : dots[i], send = b5 ? dots[i] : dots[4 + i]; k4[i] = keep + __shfl_xor(send, 32); }
          float k2[2];
#pragma unroll
          for (int i = 0; i < 2; ++i) { const float keep = b4 ? k4[2 + i] : k4[i], send = b4 ? k4[i] : k4[2 + i]; k2[i] = keep + __shfl_xor(send, 16); }
          { const float keep = b3 ? k2[1] : k2[0], send = b3 ? k2[0] : k2[1]; gsum = keep + __shfl_xor(send, 8); }
          gsum += __shfl_xor(gsum, 4); gsum += __shfl_xor(gsum, 2); gsum += __shfl_xor(gsum, 1); }
#pragma unroll
        for (int j = 0; j < 4; ++j) r.v[j] = r.v[j] * rstd * gv.v[j];
        row_store_bf16(H + (size_t)m * D, lane, r);
        if ((lane & 7) == 0) gates[(size_t)m * 8 + ((lane >> 3) & 7)] = gsum * rstd;
      }
    }
    __syncthreads();
}

template <int MODE, bool COMBINE>
__device__ __forceinline__ void phase_rows(const Params& p, LAS unsigned char* lds, int tid_, int wave, int lane_, int G,
                                           const float* gvec, const float* wgr, const float* bgr, const float* wer, const float* ber, unsigned* cnt_prev, unsigned* cnt_cur) {
    int tid = tid_; asm volatile("" : "+v"(tid)); const int lane = tid & 63;
    float* OUT = p.out; bf16_t* XB = (bf16_t*)(p.ws + WS_XB); float* RSTD = (float*)(p.ws + WS_RSTD);
    const unsigned char* YC = (const unsigned char*)(p.ws + WS_YC); float* rsraw = (float*)(p.ws + WS_RSRAW);
    unsigned* tokinfo = (unsigned*)(p.ws + WS_TOKINFO);
    unsigned* rowtok = (unsigned*)(p.ws + WS_ROWTOK); float* cwraw = (float*)(p.ws + WS_CWRAW);
    LAS float* wt = (LAS float*)lds;
    LAS int* misc = (LAS int*)(lds + MISC_OFF);
    LAS int* tbp = misc + MW_TB;
    LAS int* te = misc + 1024;
    LAS float* tc = (LAS float*)(misc + 1536);
    LAS int* trank = misc + 2048;
    LAS int* ebase = misc + 2560;
    LAS float* trs = (LAS float*)(misc + 2600);
    if (COMBINE) { if (tid == 0) { int acc = 0; for (int e = 0; e < 16; ++e) { tbp[e] = acc; acc += ((int)__hip_atomic_load(cnt_prev + e * 64, __ATOMIC_RELAXED, __HIP_MEMORY_SCOPE_AGENT) + 255) >> 8; } tbp[16] = acc; } }
    if (MODE == 1) { for (int i = tid; i < 20 * 1024; i += NTHR) { const int o = i >> 10, k = i & 1023; wt[i] = (o < 4 ? wgr[(size_t)k * 4 + o] : wer[(size_t)k * 16 + (o - 4)]) * gvec[k]; } }
    __syncthreads();
    RowV gv; if (MODE == 2) gv = row_load(gvec, lane);
    for (int blk = blockIdx.x; blk < T / 256; blk += G) {
        for (int i2 = 0; i2 < 32; i2 += 2) {
          RowV rr[2];
#pragma unroll
          for (int u = 0; u < 2; ++u) {
            const int m = blk * 256 + wave * 32 + i2 + u;
            rr[u] = row_load_bf16(XB + (size_t)m * D, lane);
            if (COMBINE) {
                const unsigned i0 = tokinfo[(size_t)m * 2], i1 = tokinfo[(size_t)m * 2 + 1];
                const size_t s0 = (size_t)tbp[i0 >> 16] * 256 + (i0 & 0xffffu), s1 = (size_t)tbp[i1 >> 16] * 256 + (i1 & 0xffffu);
                const RowV y0 = row_load_fp8(YC + s0 * D, lane, 1.0f / F8_YSCALE), y1 = row_load_fp8(YC + s1 * D, lane, 1.0f / F8_YSCALE);
#pragma unroll
                for (int j = 0; j < 4; ++j) rr[u].v[j] = rr[u].v[j] + y0.v[j] + y1.v[j];
            }
          }
#pragma unroll
          for (int u = 0; u < 2; ++u) {
            const int i = i2 + u;
            const int rl = wave * 32 + i, m = blk * 256 + rl;
            RowV r = rr[u];
            if (MODE == 0) {
                u32x2* xp = (u32x2*)(XB + (size_t)m * D) + lane;
#pragma unroll
                for (int j = 0; j < 4; ++j) { u32x2 w; w.x = cvt_pk_bf16(r.v[j][0], r.v[j][1]); w.y = cvt_pk_bf16(r.v[j][2], r.v[j][3]); xp[64 * j] = w;
                    r.v[j] = (f32x4){bf_lo(w.x), bf_hi(w.x), bf_lo(w.y), bf_hi(w.y)}; }
            }
            const float rstd = row_rstd(r);
            if (MODE != 2) { if (lane == 0) RSTD[m] = rstd; }
            if (MODE == 1 || (MODE == 0 && G3_F8)) { unsigned* x8 = (unsigned*)(p.ws + WS_XB8 + (size_t)m * D) + lane;
#pragma unroll
                for (int j = 0; j < 4; ++j) x8[64 * j] = cvt_pk4_fp8(r.v[j][0], r.v[j][1], r.v[j][2], r.v[j][3]); }
            if (MODE == 1) {
                float lg[20];
#pragma unroll
                for (int o = 0; o < 20; ++o) { float s = 0.f;
#pragma unroll
                    for (int j = 0; j < 4; ++j) { const f32x4 w = *(const LAS f32x4*)(wt + o * 1024 + 4 * lane + 256 * j); s += (r.v[j][0] * w[0] + r.v[j][1] * w[1]) + (r.v[j][2] * w[2] + r.v[j][3] * w[3]); }
                    lg[o] = wave_sum(s) * rstd + (o < 4 ? bgr[o] : ber[o - 4]); }
                int gs = 0; float gm = lg[0];
#pragma unroll
                for (int o = 1; o < 4; ++o) if (lg[o] > gm) { gm = lg[o]; gs = o; }
                float den = 0.f;
#pragma unroll
                for (int o = 0; o < 4; ++o) den += __expf(lg[o] - gm);
                const float pg = 1.0f / den;
                float el[4];
#pragma unroll
                for (int o = 0; o < 4; ++o) { float v = lg[4 + o];
#pragma unroll
                    for (int g2 = 1; g2 < 4; ++g2) v = (gs == g2) ? lg[4 + 4 * g2 + o] : v;
                    el[o] = v; }
                int i0 = 0; float v0 = el[0];
#pragma unroll
                for (int o = 1; o < 4; ++o) if (el[o] > v0) { v0 = el[o]; i0 = o; }
                int i1 = -1; float v1 = -INFINITY;
#pragma unroll
                for (int o = 0; o < 4; ++o) if (o != i0 && el[o] > v1) { v1 = el[o]; i1 = o; }
                const float ex = __expf(v1 - v0); const float w0 = 1.0f / (1.0f + ex), w1 = ex * w0;
                if (lane == 0) { te[rl * 2] = gs * 4 + i0; te[rl * 2 + 1] = gs * 4 + i1; tc[rl * 2] = w0 * pg; tc[rl * 2 + 1] = w1 * pg; trs[rl] = rstd; }
            }
            if (MODE == 2) {
#pragma unroll
                for (int j = 0; j < 4; ++j) r.v[j] = r.v[j] * rstd * gv.v[j];
                row_store(OUT + (size_t)m * D, lane, r);
            }
          }
        }
        if (MODE == 1) {
            __syncthreads();
            if (tid < 16) { int c = 0; for (int q = 0; q < 512; ++q) if (te[q] == tid) { trank[q] = c; ++c; }
                ebase[tid] = c ? (int)__hip_atomic_fetch_add(cnt_cur + tid * 64, (unsigned)c, __ATOMIC_RELAXED, __HIP_MEMORY_SCOPE_AGENT) : 0; }
            __syncthreads();
            { const int q = tid, e = te[q], pos = ebase[e] + trank[q], tok = blk * 256 + (q >> 1);
              rowtok[(size_t)e * ECAP + pos] = (unsigned)tok; cwraw[(size_t)e * ECAP + pos] = tc[q]; rsraw[(size_t)e * ECAP + pos] = trs[q >> 1]; tokinfo[(size_t)tok * 2 + (q & 1)] = ((unsigned)e << 16) | (unsigned)pos; }
            __syncthreads();
        }
    }
    __syncthreads();
}

__device__ __forceinline__ void phase_router(const Params& p, LAS unsigned char* lds, int tid_, int wave, int G,
                                             const float* gvec, const float* wgr, const float* bgr, const float* wer, const float* ber, unsigned* cnt_cur) {
    int tid = tid_; asm volatile("" : "+v"(tid)); const int lane = tid & 63, r32 = lane & 31, hi = lane >> 5;
    const bf16_t* XB = (const bf16_t*)(p.ws + WS_XB); float* rsraw = (float*)(p.ws + WS_RSRAW);
    unsigned* tokinfo = (unsigned*)(p.ws + WS_TOKINFO);
    unsigned* rowtok = (unsigned*)(p.ws + WS_ROWTOK); float* cwraw = (float*)(p.ws + WS_CWRAW);
    constexpr int WROW = 2048 + 16;
    LAS unsigned char* Whi = lds; LAS unsigned char* Wlo = lds + 24 * WROW;
    LAS int* misc = (LAS int*)(lds + MISC_OFF);
    LAS int* te = misc + 1024; LAS float* tc = (LAS float*)(misc + 1536); LAS int* trank = misc + 2048; LAS int* ebase = misc + 2560; LAS float* trs = (LAS float*)(misc + 2600);
    auto put = [&](int sl, int k, float w) { const unsigned hb = cvt_pk_bf16(w, 0.f) & 0xffffu; const float wl = w - __uint_as_float(hb << 16); const unsigned lb = cvt_pk_bf16(wl, 0.f) & 0xffffu;
        *(LAS unsigned short*)(Whi + sl * WROW + k * 2) = (unsigned short)hb; *(LAS unsigned short*)(Wlo + sl * WROW + k * 2) = (unsigned short)lb; };
    for (int i = tid; i < 4 * 1024; i += NTHR) { const int k = i >> 2, eg = i & 3; const f32x4 w4 = *(const f32x4*)(wer + (size_t)k * 16 + 4 * eg); const float g = gvec[k];
#pragma unroll
        for (int j = 0; j < 4; ++j) { const int e = 4 * eg + j, q = (e & 3) + 4 * ((e >> 3) & 1) + 8 * ((e >> 2) & 1); put(8 + q, k, w4[j] * g); } }
    for (int k = tid; k < 1024; k += NTHR) { const f32x4 w4 = *(const f32x4*)(wgr + (size_t)k * 4); const float g = gvec[k];
#pragma unroll
        for (int j = 0; j < 4; ++j) { put(j, k, w4[j] * g); put(4 + j, k, w4[j] * g); } }
    __syncthreads();
    const int slot_row = r32 < 24 ? r32 : r32 - 8;
    const LAS unsigned char* wh = Whi + slot_row * WROW + hi * 16; const LAS unsigned char* wl_ = Wlo + slot_row * WROW + hi * 16;
    for (int blk = blockIdx.x; blk < T / 256; blk += G) {
        const int rl = wave * 32 + r32, m = blk * 256 + rl;
        const bf16_t* xr = XB + (size_t)m * D + hi * 8;
        f32x16 acc = (f32x16){}; float ss = 0.f;
        bf16x8 xa[4], xb[4];
#pragma unroll
        for (int q = 0; q < 4; ++q) xa[q] = *(const bf16x8*)(xr + q * 16);
#pragma unroll 1
        for (int t = 0; t < 16; t += 2) {
#pragma unroll
            for (int q = 0; q < 4; ++q) xb[q] = *(const bf16x8*)(xr + (t + 1) * 64 + q * 16);
#pragma unroll
            for (int q = 0; q < 4; ++q) { const bf16x8 ah = *(const LAS bf16x8*)(wh + t * 128 + q * 32), al = *(const LAS bf16x8*)(wl_ + t * 128 + q * 32);
                acc = __builtin_amdgcn_mfma_f32_32x32x16_bf16(ah, xa[q], acc, 0, 0, 0); acc = __builtin_amdgcn_mfma_f32_32x32x16_bf16(al, xa[q], acc, 0, 0, 0);
#pragma unroll
                for (int j = 0; j < 4; ++j) { const unsigned w = ((const unsigned*)&xa[q])[j]; const float a = bf_lo(w), b = bf_hi(w); ss += a * a + b * b; } }
            if (t + 2 < 16) {
#pragma unroll
                for (int q = 0; q < 4; ++q) xa[q] = *(const bf16x8*)(xr + (t + 2) * 64 + q * 16); }
#pragma unroll
            for (int q = 0; q < 4; ++q) { const bf16x8 ah = *(const LAS bf16x8*)(wh + (t + 1) * 128 + q * 32), al = *(const LAS bf16x8*)(wl_ + (t + 1) * 128 + q * 32);
                acc = __builtin_amdgcn_mfma_f32_32x32x16_bf16(ah, xb[q], acc, 0, 0, 0); acc = __builtin_amdgcn_mfma_f32_32x32x16_bf16(al, xb[q], acc, 0, 0, 0);
#pragma unroll
                for (int j = 0; j < 4; ++j) { const unsigned w = ((const unsigned*)&xb[q])[j]; const float a = bf_lo(w), b = bf_hi(w); ss += a * a + b * b; } }
        }
        ss += __shfl_xor(ss, 32);
        const float rstd = 1.0f / sqrtf(ss * (1.0f / D) + NORM_EPS);
        float lg[4];
#pragma unroll
        for (int o = 0; o < 4; ++o) lg[o] = acc[o] * rstd + bgr[o];
        int gs = 0; float gm = lg[0];
#pragma unroll
        for (int o = 1; o < 4; ++o) if (lg[o] > gm) { gm = lg[o]; gs = o; }
        float den = 0.f;
#pragma unroll
        for (int o = 0; o < 4; ++o) den += __expf(lg[o] - gm);
        const float pg = 1.0f / den;
        if ((gs >> 1) == hi) {
            float el[4];
#pragma unroll
            for (int o = 0; o < 4; ++o) el[o] = ((gs & 1) ? acc[8 + o] : acc[4 + o]) * rstd + ber[gs * 4 + o];
            int i0 = 0; float v0 = el[0];
#pragma unroll
            for (int o = 1; o < 4; ++o) if (el[o] > v0) { v0 = el[o]; i0 = o; }
            int i1 = -1; float v1 = -INFINITY;
#pragma unroll
            for (int o = 0; o < 4; ++o) if (o != i0 && el[o] > v1) { v1 = el[o]; i1 = o; }
            const float ex = __expf(v1 - v0); const float w0 = 1.0f / (1.0f + ex), w1 = ex * w0;
            te[rl * 2] = gs * 4 + i0; te[rl * 2 + 1] = gs * 4 + i1; tc[rl * 2] = w0 * pg; tc[rl * 2 + 1] = w1 * pg; trs[rl] = rstd;
        }
        __syncthreads();
        int myrank = 0; const int eq = te[tid];
        { LAS int* wcnt = misc + 3000;
#pragma unroll
          for (int ee = 0; ee < 16; ++ee) { const unsigned long long mk = __ballot(eq == ee); if (eq == ee) myrank = __popcll(mk & ((1ull << lane) - 1ull)); if (lane == 0) wcnt[wave * 16 + ee] = __popcll(mk); }
          __syncthreads();
          for (int w2 = 0; w2 < wave; ++w2) myrank += wcnt[w2 * 16 + eq];
          if (tid < 16) { int c = 0;
#pragma unroll
              for (int w2 = 0; w2 < 8; ++w2) c += wcnt[w2 * 16 + tid];
              ebase[tid] = c ? (int)__hip_atomic_fetch_add(cnt_cur + tid * 64, (unsigned)c, __ATOMIC_RELAXED, __HIP_MEMORY_SCOPE_AGENT) : 0; } }
        __syncthreads();
        { const int q = tid, e = eq, pos = ebase[e] + myrank, tok = blk * 256 + (q >> 1);
          rowtok[(size_t)e * ECAP + pos] = (unsigned)tok; cwraw[(size_t)e * ECAP + pos] = tc[q]; rsraw[(size_t)e * ECAP + pos] = trs[q >> 1]; tokinfo[(size_t)tok * 2 + (q & 1)] = ((unsigned)e << 16) | (unsigned)pos; }
        __syncthreads();
    }
    __syncthreads();
}

__device__ __forceinline__ void phase_conv(const Params& p, int gw, int NGW, int lane) {
    const bf16_t* BG = (const bf16_t*)(p.ws + WS_BG); const bf16_t* Z = (const bf16_t*)(p.ws + WS_Z); bf16_t* A2 = (bf16_t*)(p.ws + WS_CAT);
    const float* cw = p.in[16];
    float w0[16], w1[16], w2[16];
#pragma unroll
    for (int h = 0; h < 2; ++h)
#pragma unroll
        for (int j = 0; j < 8; ++j) { const int c = h * 512 + lane * 8 + j; w0[h * 8 + j] = cw[c]; w1[h * 8 + j] = cw[D + c]; w2[h * 8 + j] = cw[2 * D + c]; }
    for (int run = gw; run < T / 32; run += NGW) {
        const int t0 = run * 32;
        float zm1[16], zm2[16];
#pragma unroll
        for (int j = 0; j < 16; ++j) { zm1[j] = 0.f; zm2[j] = 0.f; }
        if ((t0 & (SEQ - 1)) != 0) {
#pragma unroll
            for (int h = 0; h < 2; ++h) { const u32x4 a = *(const u32x4*)(Z + (size_t)(t0 - 1) * D + h * 512 + lane * 8), b = *(const u32x4*)(Z + (size_t)(t0 - 2) * D + h * 512 + lane * 8);
#pragma unroll
                for (int q = 0; q < 4; ++q) { zm1[h * 8 + 2 * q] = bf_lo(a[q]); zm1[h * 8 + 2 * q + 1] = bf_hi(a[q]); zm2[h * 8 + 2 * q] = bf_lo(b[q]); zm2[h * 8 + 2 * q + 1] = bf_hi(b[q]); } }
        }
#pragma unroll 4
        for (int i = 0; i < 32; ++i) {
            const size_t rb = (size_t)(t0 + i) * D;
#pragma unroll
            for (int h = 0; h < 2; ++h) { const u32x4 zz = *(const u32x4*)(Z + rb + h * 512 + lane * 8), bb = *(const u32x4*)(BG + rb + h * 512 + lane * 8);
                float o[8];
#pragma unroll
                for (int q = 0; q < 4; ++q) {
#pragma unroll
                    for (int s = 0; s < 2; ++s) { const int j = h * 8 + 2 * q + s; const float zc = s ? bf_hi(zz[q]) : bf_lo(zz[q]), bg = s ? bf_hi(bb[q]) : bf_lo(bb[q]);
                        o[2 * q + s] = bg * (w0[j] * zm2[j] + w1[j] * zm1[j] + w2[j] * zc); zm2[j] = zm1[j]; zm1[j] = zc; } }
                u32x4 w; w.x = cvt_pk_bf16(o[0], o[1]); w.y = cvt_pk_bf16(o[2], o[3]); w.z = cvt_pk_bf16(o[4], o[5]); w.w = cvt_pk_bf16(o[6], o[7]);
                *(u32x4*)(A2 + rb + h * 512 + lane * 8) = w; }
        }
    }
}

__device__ __forceinline__ void phase_gate_scan(const Params& p, int gw, int NGW, int lane) {
    const float* gates = (const float*)(p.ws + WS_GATES);
    float* SA = (float*)(p.ws + WS_SA); float* SAM = (float*)(p.ws + WS_SAM); float* SBA = (float*)(p.ws + WS_SBA);
    for (int sq = gw; sq < NBATCH * 4; sq += NGW) {
        const int b = sq >> 2, hd = sq & 3; const float ib = p.in[7][hd], fb = p.in[8][hd];
        float carryB = 0.f, carryM = -INFINITY;
#pragma unroll 1
        for (int i0 = 0; i0 < 32; i0 += 8) {
            float lf[8], ig[8];
#pragma unroll
            for (int i = 0; i < 8; ++i) { const size_t t = (size_t)b * SEQ + 64 * (i0 + i) + lane; const float f = gates[t * 8 + 4 + hd] + fb; ig[i] = gates[t * 8 + hd] + ib;
                lf[i] = (f >= 0.f) ? -log1pf(expf(-f)) : (f - log1pf(expf(f))); }
#pragma unroll
            for (int i = 0; i < 8; ++i) {
                float sB = lf[i];
#pragma unroll
                for (int o = 1; o < 64; o <<= 1) { const float v = __shfl_up(sB, o); if (lane >= o) sB += v; }
                sB += carryB; carryB = __shfl(sB, 63);
                const float a = ig[i] - sB;
                float m = a;
#pragma unroll
                for (int o = 1; o < 64; o <<= 1) { const float v = __shfl_up(m, o); if (lane >= o) m = fmaxf(m, v); }
                m = fmaxf(m, carryM); carryM = __shfl(m, 63);
                const size_t o2 = (size_t)sq * SEQ + 64 * (i0 + i) + lane; SA[o2] = a; SAM[o2] = m; SBA[o2] = sB + m;
            }
        }
    }
}

struct TileRegs { u32x4 v[2]; };
__device__ __forceinline__ TileRegs tile_load(const bf16_t* src, int tid) { TileRegs r;
#pragma unroll
    for (int i = 0; i < 2; ++i) { const int n = tid + 512 * i, row = n >> 4, ch = n & 15; r.v[i] = *(const u32x4*)(src + (size_t)row * NP + ch * 8); } return r; }
__device__ __forceinline__ void tile_write(LAS unsigned char* dst, int tid, const TileRegs& r) {
#pragma unroll
    for (int i = 0; i < 2; ++i) { const int n = tid + 512 * i, row = n >> 4, ch = n & 15; *(LAS u32x4*)(dst + off_b(row, ch)) = r.v[i]; } }

__device__ __forceinline__ void glds16(const void* gsrc, unsigned lds_dst) { unsigned keep;
    asm volatile("s_mov_b32 %0, m0\n\ts_mov_b32 m0, %2\n\ts_nop 0\n\tglobal_load_lds_dwordx4 %1, off\n\ts_mov_b32 m0, %0" : "=&s"(keep) : "v"(gsrc), "s"(lds_dst) : "memory"); }
__device__ __forceinline__ void tile_dma(const bf16_t* src, LAS unsigned char* dst, int wave, int lane) {
#pragma unroll
    for (int i = 0; i < 2; ++i) { const int piece = 2 * wave + i, row = 4 * piece + (lane >> 4); const unsigned ch = (unsigned)(lane & 15) ^ ((((unsigned)lane >> 4) << 2) | ((unsigned)piece & 3u));
        glds16(src + (size_t)row * NP + ch * 8, (unsigned)__builtin_amdgcn_readfirstlane((int)(unsigned)(uintptr_t)(dst + piece * 1024))); }
}
#define WAIT_ALL_BAR() asm volatile("s_waitcnt vmcnt(0) lgkmcnt(0)\n\ts_barrier" ::: "memory")
__device__ __forceinline__ void attn_unit(const Params& p, LAS unsigned char* lds, int bh, int qblk, int tid_, int wave, int lane_) {
    int tid = tid_; asm volatile("" : "+v"(tid)); const int lane = tid & 63;
    const bf16_t* P = (const bf16_t*)(p.ws + WS_P); bf16_t* CAT = (bf16_t*)(p.ws + WS_CAT);
    const int b = bh >> 2, hd = bh & 3, map = wave >> 2, qs = wave & 3, r32 = lane & 31, hi = lane >> 5;
    const size_t rowbase = (size_t)b * SEQ;
    const int q0 = qblk * 128 + qs * 32, qrow = q0 + r32;
    LAS float* fs = (LAS float*)(lds + MISC_OFF) + MW_F;
    LAS float* tbl = fs;
    constexpr float LOG2E = 1.4426950408889634f;
    if (tid < 272) { const int n = tid - 64; int bk;
        if (n < 16) bk = n < 0 ? 0 : n; else { bk = 16; const int th[15] = {19, 21, 24, 27, 31, 35, 40, 46, 52, 59, 67, 77, 87, 99, 113};
#pragma unroll
            for (int j = 0; j < 15; ++j) bk += (n >= th[j]) ? 1 : 0; }
        tbl[tid] = n < 0 ? -INFINITY : p.in[1][bk * 4 + hd] * LOG2E; }
    bf16x8 qf[4];
    { const bf16_t* qp = P + (rowbase + qrow) * NP + P_DQ + hd * 128 + map * 64 + hi * 8;
#pragma unroll
      for (int ks = 0; ks < 4; ++ks) qf[ks] = *(const bf16x8*)(qp + ks * 16); }
    const bf16_t* Kg = P + rowbase * NP + P_DK + hd * 128; const bf16_t* Vg = P + rowbase * NP + P_DV + hd * 128;
    const int NS = qblk + 1;
    f32x16 o[4];
#pragma unroll
    for (int c = 0; c < 4; ++c) o[c] = (f32x16){};
    float mrun = -INFINITY, lrun = 0.f;
    const float bias_far = p.in[1][31 * 4 + hd] * LOG2E;
    const unsigned xr = ((unsigned)(r32 & 3) << 2) | ((unsigned)(r32 >> 2) & 3u);
    const unsigned q4 = (lane & 15) >> 2, pp = lane & 3, blk = (lane >> 4) & 1;
#ifndef ATT_DMA
#define ATT_DMA 5
#endif
#ifndef ATT_LATE_DMA
#define ATT_LATE_DMA 1
#endif
#if ATT_DMA == 2 || ATT_DMA == 4
#elif ATT_DMA
    WAIT_ALL_BAR();
    { tile_dma(Kg, lds, wave, lane); tile_dma(Vg, lds + 16384, wave, lane); tile_dma(Kg + (size_t)64 * NP, lds + 32768, wave, lane); tile_dma(Vg + (size_t)64 * NP, lds + 49152, wave, lane); }
#else
    { TileRegs a0 = tile_load(Kg, tid), a1 = tile_load(Vg, tid), a2 = tile_load(Kg + (size_t)64 * NP, tid), a3 = tile_load(Vg + (size_t)64 * NP, tid);
      tile_write(lds, tid, a0); tile_write(lds + 16384, tid, a1); tile_write(lds + 32768, tid, a2); tile_write(lds + 49152, tid, a3); }
#endif
#if ATT_DMA == 5
    WAIT_ALL_BAR();
#endif
    asm volatile("" :: "v"(qf[0]), "v"(qf[1]), "v"(qf[2]), "v"(qf[3]));
#pragma unroll 1
    for (int st = 0; st < NS; ++st) {
        WAIT_ALL_BAR();
#if ATT_DMA == 2
        { LAS unsigned char* nb = lds + (st & 1) * 65536; const size_t ro = (size_t)st * 128 * NP;
            tile_dma(Kg + ro, nb, wave, lane); tile_dma(Vg + ro, nb + 16384, wave, lane); tile_dma(Kg + ro + (size_t)64 * NP, nb + 32768, wave, lane); tile_dma(Vg + ro + (size_t)64 * NP, nb + 49152, wave, lane); }
        WAIT_ALL_BAR();
#elif ATT_DMA == 3
#elif ATT_DMA
#if ATT_DMA == 4
        if (st == 0) { tile_dma(Kg, lds, wave, lane); tile_dma(Vg, lds + 16384, wave, lane); tile_dma(Kg + (size_t)64 * NP, lds + 32768, wave, lane); tile_dma(Vg + (size_t)64 * NP, lds + 49152, wave, lane); WAIT_ALL_BAR(); }
#endif
        if (!ATT_LATE_DMA && st + 1 < NS) { LAS unsigned char* nb = lds + ((st + 1) & 1) * 65536; const size_t ro = (size_t)(st + 1) * 128 * NP;
            tile_dma(Kg + ro, nb, wave, lane); tile_dma(Vg + ro, nb + 16384, wave, lane); tile_dma(Kg + ro + (size_t)64 * NP, nb + 32768, wave, lane); tile_dma(Vg + ro + (size_t)64 * NP, nb + 49152, wave, lane); }
#else
        TileRegs a0, a1;
        if (st + 1 < NS) { const size_t ro = (size_t)(st + 1) * 128 * NP; a0 = tile_load(Kg + ro, tid); a1 = tile_load(Vg + ro, tid); }
#endif
#pragma unroll
        for (int half = 0; half < 2; ++half) {
            const int j = 2 * st + half;
            const LAS unsigned char* Kt = lds + (st & 1) * 65536 + half * 32768; const LAS unsigned char* Vt = Kt + 16384;
            if (64 * j <= q0 + 31) {
                const int nmin = q0 - (64 * j + 63);
                const bool first = (mrun == -INFINITY);
                const float cinit = first ? 0.f : (nmin >= 113 ? bias_far - mrun : -mrun);
                f32x16 p0, p1;
#pragma unroll
                for (int r = 0; r < 16; ++r) { p0[r] = cinit; p1[r] = cinit; }
#pragma unroll
                for (int ks = 0; ks < 4; ++ks) { const unsigned ch = (unsigned)(8 * map + 2 * ks + hi) ^ xr;
                    const bf16x8 k0 = *(const LAS bf16x8*)(Kt + 256u * r32 + 16u * ch), k1 = *(const LAS bf16x8*)(Kt + 256u * (32 + r32) + 16u * ch);
                    p0 = __builtin_amdgcn_mfma_f32_32x32x16_bf16(k0, qf[ks], p0, 0, 0, 0); p1 = __builtin_amdgcn_mfma_f32_32x32x16_bf16(k1, qf[ks], p1, 0, 0, 0); }
                __builtin_amdgcn_sched_barrier(0);
                float rm = -INFINITY;
                if (first) {
                    if (nmin >= 113) {
#pragma unroll
                        for (int r = 0; r < 16; ++r) { p0[r] = p0[r] + bias_far; p1[r] = p1[r] + bias_far; rm = fmaxf(rm, fmaxf(p0[r], p1[r])); }
                    } else {
                        const LAS float* tb = tbl + (qrow - 64 * j - 4 * hi + 5);
#pragma unroll
                        for (int r = 0; r < 16; ++r) { const int e = (r & 3) + 8 * (r >> 2);
                            p0[r] += tb[59 - e]; p1[r] += tb[27 - e];
                            rm = fmaxf(rm, fmaxf(p0[r], p1[r])); }
                    }
                    { auto rr = __builtin_amdgcn_permlane32_swap(__float_as_uint(rm), __float_as_uint(rm), false, false); rm = fmaxf(__uint_as_float(rr[0]), __uint_as_float(rr[1])); }
                    mrun = rm;
#pragma unroll
                    for (int r = 0; r < 16; ++r) { p0[r] -= mrun; p1[r] -= mrun; }
                } else {
                    if (nmin < 113) {
                        const LAS float* tb = tbl + (qrow - 64 * j - 4 * hi + 5);
                        float bv0[16], bv1[16];
#pragma unroll
                        for (int r = 0; r < 16; ++r) { const int e = (r & 3) + 8 * (r >> 2); bv0[r] = tb[59 - e]; bv1[r] = tb[27 - e]; }
#pragma unroll
                        for (int r = 0; r < 16; ++r) { p0[r] += bv0[r]; p1[r] += bv1[r]; }
                    }
                    { float m0 = fmaxf(p0[0], p1[0]), m1 = fmaxf(p0[1], p1[1]);
#pragma unroll
                      for (int r = 2; r < 16; r += 2) { m0 = __builtin_fmaxf(__builtin_fmaxf(m0, p0[r]), p1[r]); m1 = __builtin_fmaxf(__builtin_fmaxf(m1, p0[r + 1]), p1[r + 1]); }
                      rm = fmaxf(m0, m1); }
                    { auto rr = __builtin_amdgcn_permlane32_swap(__float_as_uint(rm), __float_as_uint(rm), false, false); rm = fmaxf(__uint_as_float(rr[0]), __uint_as_float(rr[1])); }
                    if (__any(rm > 8.0f)) {
                        const float dl = fmaxf(rm, 0.f); const float alpha = fast_exp2(-dl);
                        lrun *= alpha; mrun += dl;
#pragma unroll
                        for (int r = 0; r < 16; ++r) { p0[r] -= dl; p1[r] -= dl; }
#pragma unroll
                        for (int c = 0; c < 4; ++c)
#pragma unroll
                            for (int r = 0; r < 16; ++r) o[c][r] *= alpha;
                    }
                }
                float psa = 0.f, psb = 0.f;
                bf16x8 pf[4];
#define ATT_EXPK(ks_) do { u32x4 w_; _Pragma("unroll") for (int q = 0; q < 4; ++q) { const int r = 8 * ((ks_) & 1) + 2 * q; \
                        const float ea = fast_exp2((ks_) < 2 ? p0[r] : p1[r]), eb = fast_exp2((ks_) < 2 ? p0[r + 1] : p1[r + 1]); psa += ea; psb += eb; w_[q] = cvt_pk_bf16(ea, eb); } \
                    pf[ks_] = __builtin_bit_cast(bf16x8, w_); } while (0)
                bf16x8 vf[2][4];
#define ATT_LOADV(buf, ks_) do { _Pragma("unroll") for (int c = 0; c < 4; ++c) { const unsigned chv = (unsigned)(4 * c + 2 * blk + (pp >> 1)); const unsigned row0 = 16u * (ks_) + 4u * hi + q4; \
                        vf[buf][c] = cat8(vtr(Vt + off_b(row0, chv) + 8u * (pp & 1)), vtr(Vt + off_b(row0 + 8u, chv) + 8u * (pp & 1))); } } while (0)
                ATT_LOADV(0, 0);
                ATT_EXPK(0);
                if (ATT_LATE_DMA && half == 0 && st + 1 < NS) {
                    LAS unsigned char* nb = lds + ((st + 1) & 1) * 65536; const size_t ro = (size_t)(st + 1) * 128 * NP;
                    tile_dma(Kg + ro, nb, wave, lane); tile_dma(Vg + ro, nb + 16384, wave, lane); tile_dma(Kg + ro + (size_t)64 * NP, nb + 32768, wave, lane); tile_dma(Vg + ro + (size_t)64 * NP, nb + 49152, wave, lane); }
#pragma unroll
                for (int ks = 0; ks < 4; ++ks) {
                    if (ks < 3) ATT_LOADV((ks + 1) & 1, ks + 1);
                    __builtin_amdgcn_sched_barrier(0);
#pragma unroll
                    for (int c = 0; c < 4; ++c) o[c] = __builtin_amdgcn_mfma_f32_32x32x16_bf16(vf[ks & 1][c], pf[ks], o[c], 0, 0, 0);
                    if (ks < 3) { ATT_EXPK(ks + 1); asm volatile("" : "+v"(pf[(ks + 1) & 3]), "+v"(psa), "+v"(psb)); }
                    __builtin_amdgcn_sched_barrier(0);
                }
                lrun += psa + psb;
#undef ATT_EXPK
#undef ATT_LOADV
            }
#if ATT_DMA == 5
            if (half == 0) WAIT_ALL_BAR();
#endif
#if !ATT_DMA
            if (st + 1 < NS) { LAS unsigned char* nb = lds + ((st + 1) & 1) * 65536 + half * 32768; tile_write(nb, tid, a0); tile_write(nb + 16384, tid, a1);
                if (half == 0) { const size_t ro = (size_t)(st + 1) * 128 * NP + (size_t)64 * NP; a0 = tile_load(Kg + ro, tid); a1 = tile_load(Vg + ro, tid); } }
#endif
        }
#if ATT_DMA == 3
        WAIT_ALL_BAR();
        if (st + 1 < NS) { LAS unsigned char* nb = lds + ((st + 1) & 1) * 65536; const size_t ro = (size_t)(st + 1) * 128 * NP;
            tile_dma(Kg + ro, nb, wave, lane); tile_dma(Vg + ro, nb + 16384, wave, lane); tile_dma(Kg + ro + (size_t)64 * NP, nb + 32768, wave, lane); tile_dma(Vg + ro + (size_t)64 * NP, nb + 49152, wave, lane); }
#endif

    }
    WAIT_ALL_BAR();
    lrun += __shfl_xor(lrun, 32);
    const float inv = 1.0f / lrun;
    float lam;
    { float s1 = 0.f, s2 = 0.f; const float a1 = p.in[10][lane] * p.in[11][lane], a2 = p.in[12][lane] * p.in[13][lane]; s1 = wave_sum(a1); s2 = wave_sum(a2);
      const float lam_init = 0.8f - 0.6f * 1.0f;
      lam = expf(s1) - expf(s2) + lam_init; }
    LAS float* xch = (LAS float*)lds + qs * 4096;
    if (map == 1) {
#pragma unroll
        for (int c = 0; c < 4; ++c)
#pragma unroll
            for (int r = 0; r < 16; ++r) xch[(32 * c + crow(r, hi)) * 32 + r32] = o[c][r] * inv * lam;
    }
    __syncthreads();
    if (map == 0) {
        float ss = 0.f;
#pragma unroll
        for (int c = 0; c < 4; ++c)
#pragma unroll
            for (int r = 0; r < 16; ++r) { const float v = o[c][r] * inv - xch[(32 * c + crow(r, hi)) * 32 + r32]; o[c][r] = v; ss += v * v; }
        ss += __shfl_xor(ss, 32);
        const float rstd = 1.0f / sqrtf(ss * (1.0f / 128.0f) + NORM_EPS) * 0.8f;
        const float* sub = p.in[14];
        bf16_t* orow = CAT + (rowbase + qrow) * D + 512 + hd * 128;
#pragma unroll
        for (int c = 0; c < 4; ++c)
#pragma unroll
            for (int rqp = 0; rqp < 4; rqp += 2) { u32x2 w[2];
#pragma unroll
                for (int h = 0; h < 2; ++h) { const int rq = rqp + h; const int e0 = 32 * c + 8 * rq + 4 * hi; const f32x4 sv = *(const f32x4*)(sub + e0);
                    w[h].x = cvt_pk_bf16(o[c][4 * rq] * rstd * sv[0], o[c][4 * rq + 1] * rstd * sv[1]); w[h].y = cvt_pk_bf16(o[c][4 * rq + 2] * rstd * sv[2], o[c][4 * rq + 3] * rstd * sv[3]); }
                const auto rx = __builtin_amdgcn_permlane32_swap(w[0].x, w[1].x, false, false); const auto ry = __builtin_amdgcn_permlane32_swap(w[0].y, w[1].y, false, false);
                u32x4 ww; ww.x = rx[0]; ww.y = ry[0]; ww.z = rx[1]; ww.w = ry[1];
                *(u32x4*)(orow + 32 * c + 8 * (rqp + hi)) = ww; }
    }
    __syncthreads();
}

__device__ __forceinline__ void mlstm_s1_unit(const Params& p, LAS unsigned char* lds, int bh, int c, int tid_, int wave, int lane_) {
    int tid = tid_; asm volatile("" : "+v"(tid)); const int lane = tid & 63;
    const bf16_t* P = (const bf16_t*)(p.ws + WS_P);
    const int b = bh >> 2, hd = bh & 3, r32 = lane & 31, hi = lane >> 5;
    const size_t t0 = (size_t)b * SEQ + (size_t)c * MCH;
    const float* SA = (const float*)(p.ws + WS_SA) + (size_t)bh * SEQ + c * MCH;
    LAS float* fs = (LAS float*)(lds + MISC_OFF) + MW_F;
    LAS float* wsm = fs;
    LAS float* red = fs + 256;
    float av = (tid < 256) ? SA[tid] : -INFINITY;
    float mx = av;
#pragma unroll
    for (int o = 1; o < 64; o <<= 1) mx = fmaxf(mx, __shfl_xor(mx, o));
    if (lane == 0) red[wave] = mx;
    __syncthreads();
    float R = red[0];
#pragma unroll
    for (int w = 1; w < 4; ++w) R = fmaxf(R, red[w]);
    if (tid < 256) wsm[tid] = __expf(av - R) * 0.08838834764831845f;
    __syncthreads();
    LAS unsigned char* Kl = lds; LAS unsigned char* Vl = lds + 65536;
    const bf16_t* Kg = P + t0 * NP + P_MK + hd * 128; const bf16_t* Vg = P + t0 * NP + P_MV + hd * 128;
#pragma unroll
    for (int i = 0; i < 8; ++i) { const int n = tid + 512 * i, row = n >> 4, ch = n & 15;
        const u32x4 kv = *(const u32x4*)(Kg + (size_t)row * NP + ch * 8); const u32x4 vv = *(const u32x4*)(Vg + (size_t)row * NP + ch * 8);
        const float w = wsm[row]; u32x4 ks;
#pragma unroll
        for (int q = 0; q < 4; ++q) ks[q] = cvt_pk_bf16(bf_lo(kv[q]) * w, bf_hi(kv[q]) * w);
        *(LAS u32x4*)(Kl + off_b(row, ch)) = ks; *(LAS u32x4*)(Vl + off_b(row, ch)) = vv; }
    __syncthreads();
    const int eb = wave >> 1, dh = wave & 1;
    const unsigned q4 = (lane & 15) >> 2, pp = lane & 3, blk = (lane >> 4) & 1;
    f32x16 acc[2]; acc[0] = (f32x16){}; acc[1] = (f32x16){};
    for (int ks = 0; ks < 16; ++ks) {
        const unsigned row0 = 16u * ks + 8u * hi + q4, row1 = row0 + 4u;
        const unsigned cha = (unsigned)(4 * eb + 2 * blk + (pp >> 1));
        const bf16x8 af = cat8(vtr(Vl + off_b(row0, cha) + 8u * (pp & 1)), vtr(Vl + off_b(row1, cha) + 8u * (pp & 1)));
#pragma unroll
        for (int db = 0; db < 2; ++db) { const unsigned chb = (unsigned)(4 * (2 * dh + db) + 2 * blk + (pp >> 1));
            const bf16x8 bfr = cat8(vtr(Kl + off_b(row0, chb) + 8u * (pp & 1)), vtr(Kl + off_b(row1, chb) + 8u * (pp & 1)));
            acc[db] = __builtin_amdgcn_mfma_f32_32x32x16_bf16(af, bfr, acc[db], 0, 0, 0); }
    }
    const int unit = bh * NCH + c;
    float* UT = (float*)(p.ws + WS_UT) + (size_t)unit * 16384;
#pragma unroll
    for (int db = 0; db < 2; ++db)
#pragma unroll
        for (int r = 0; r < 16; ++r) UT[(32 * eb + crow(r, hi)) * 128 + 64 * dh + 32 * db + r32] = acc[db][r];
    if (tid < 128) { float s = 0.f; const int d = tid;
        for (int srow = 0; srow < 256; ++srow) { const unsigned short hv = *(const LAS unsigned short*)(Kl + off_b(srow, d >> 3) + (d & 7) * 2); s += __uint_as_float((unsigned)hv << 16); }
        ((float*)(p.ws + WS_UN))[(size_t)unit * 128 + d] = s; }
    if (tid == 0) ((float*)(p.ws + WS_UR))[unit] = R;
    __syncthreads();
}

__device__ __forceinline__ void mlstm_s3_unit(const Params& p, LAS unsigned char* lds, int bh, int c, int tid_, int wave, int lane_) {
    int tid = tid_; asm volatile("" : "+v"(tid)); const int lane = tid & 63;
    const bf16_t* P = (const bf16_t*)(p.ws + WS_P); bf16_t* CAT = (bf16_t*)(p.ws + WS_CAT);
    const int b = bh >> 2, hd = bh & 3, r32 = lane & 31, hi = lane >> 5;
    const size_t t0 = (size_t)b * SEQ + (size_t)c * MCH;
    const size_t so = (size_t)bh * SEQ + c * MCH;
    const float* SA = (const float*)(p.ws + WS_SA) + so; const float* SAM = (const float*)(p.ws + WS_SAM) + so; const float* SBA = (const float*)(p.ws + WS_SBA) + so;
    LAS float* fs = (LAS float*)(lds + MISC_OFF) + MW_F;
    LAS float* as = fs;
    LAS float* nC = fs + 256;
    LAS unsigned char* Ct = lds + 65536;
    const int qloc = 32 * wave + r32;
    const float Aq = SAM[qloc], BAq = SBA[qloc];
    if (tid < 256) as[tid] = SA[tid];
    bf16x8 qf[8];
    { const bf16_t* qp = P + (t0 + qloc) * NP + P_MQ + hd * 128 + hi * 8;
#pragma unroll
      for (int ks = 0; ks < 8; ++ks) qf[ks] = *(const bf16x8*)(qp + ks * 16); }
    const bf16_t* Kg = P + t0 * NP + P_MK + hd * 128; const bf16_t* Vg = P + t0 * NP + P_MV + hd * 128;
#if defined(S3_REGSTAGE)
    { TileRegs k0 = tile_load(Kg, tid), v0 = tile_load(Vg, tid); tile_write(lds, tid, k0); tile_write(lds + 16384, tid, v0); }
#elif !defined(S3_SERIAL)
    tile_dma(Kg, lds, wave, lane); tile_dma(Vg, lds + 16384, wave, lane);
#endif
    f32x16 o[4];
#pragma unroll
    for (int cb = 0; cb < 4; ++cb) o[cb] = (f32x16){};
    float den = 0.f, fst = 0.f;
    const unsigned xr = ((unsigned)(r32 & 3) << 2) | ((unsigned)(r32 >> 2) & 3u);
    if (c > 0) {
        const float* UR = (const float*)(p.ws + WS_UR) + bh * NCH; const float* UT = (const float*)(p.ws + WS_UT) + (size_t)bh * NCH * 16384; const float* UN = (const float*)(p.ws + WS_UN) + (size_t)bh * NCH * 128;
        float Pref = -INFINITY, ur[7];
#pragma unroll
        for (int j = 0; j < 7; ++j) { ur[j] = UR[j]; if (j < c) Pref = fmaxf(Pref, ur[j]); }
        float cf[7];
#pragma unroll
        for (int j = 0; j < 7; ++j) cf[j] = (j < c) ? __expf(ur[j] - Pref) : 0.f;
#pragma unroll 1
        for (int i = 0; i < 4; ++i) { const int n = tid + 512 * i, e = n >> 4, ch = n & 15; f32x4 u0[7], u1[7];
#pragma unroll
            for (int j = 0; j < 7; ++j) { const f32x4* up = (const f32x4*)(UT + (size_t)j * 16384 + e * 128 + ch * 8); u0[j] = up[0]; u1[j] = up[1]; }
            f32x4 s0 = (f32x4){0.f, 0.f, 0.f, 0.f}, s1 = s0;
#pragma unroll
            for (int j = 0; j < 7; ++j) { s0 += u0[j] * cf[j]; s1 += u1[j] * cf[j]; }
            u32x4 w; w.x = cvt_pk_bf16(s0[0], s0[1]); w.y = cvt_pk_bf16(s0[2], s0[3]); w.z = cvt_pk_bf16(s1[0], s1[1]); w.w = cvt_pk_bf16(s1[2], s1[3]);
            *(LAS u32x4*)(Ct + off_b(e, ch)) = w; }
        if (tid < 128) { float sN = 0.f;
#pragma unroll
            for (int j = 0; j < 7; ++j) sN += cf[j] * UN[j * 128 + tid];
            nC[tid] = sN; }
        fst = __expf(Pref - Aq);
    }
    asm volatile("" :: "v"(qf[0]), "v"(qf[1]), "v"(qf[2]), "v"(qf[3]), "v"(qf[4]), "v"(qf[5]), "v"(qf[6]), "v"(qf[7]), "v"(Aq), "v"(BAq));
    WAIT_ALL_BAR();
    if (c > 0) {
#pragma unroll
        for (int cb = 0; cb < 4; ++cb) {
#pragma unroll
            for (int ks = 0; ks < 8; ++ks) { const unsigned ch = (unsigned)(2 * ks + hi) ^ xr;
                const bf16x8 cfr = *(const LAS bf16x8*)(Ct + 256u * (32 * cb + r32) + 16u * ch);
                o[cb] = __builtin_amdgcn_mfma_f32_32x32x16_bf16(cfr, qf[ks], o[cb], 0, 0, 0); }
            __builtin_amdgcn_sched_barrier(0); }
#pragma unroll
        for (int cb = 0; cb < 4; ++cb)
#pragma unroll
            for (int r = 0; r < 16; ++r) o[cb][r] *= fst;
        float dq = 0.f;
#pragma unroll
        for (int ks = 0; ks < 8; ++ks)
#pragma unroll
            for (int q = 0; q < 4; ++q) { const unsigned w = ((const unsigned*)&qf[ks])[q]; const int d = 16 * ks + 8 * hi + 2 * q; dq += bf_lo(w) * nC[d] + bf_hi(w) * nC[d + 1]; }
        den = fst * dq;
    }
    const unsigned q4 = (lane & 15) >> 2, pp = lane & 3, blk = (lane >> 4) & 1;
#pragma unroll 1
    for (int j = 0; j < 4; ++j) {
        WAIT_ALL_BAR();
        const LAS unsigned char* Kt = lds + (j & 1) * 32768; const LAS unsigned char* Vt = Kt + 16384;
#if defined(S3_REGSTAGE)
        TileRegs kr, vr; if (j + 1 < 4) { kr = tile_load(Kg + (size_t)(j + 1) * 64 * NP, tid); vr = tile_load(Vg + (size_t)(j + 1) * 64 * NP, tid); }
#elif defined(S3_SERIAL)
        { LAS unsigned char* nb = lds + (j & 1) * 32768; tile_dma(Kg + (size_t)j * 64 * NP, nb, wave, lane); tile_dma(Vg + (size_t)j * 64 * NP, nb + 16384, wave, lane); }
        WAIT_ALL_BAR();
#else
        if (j + 1 < 4) { LAS unsigned char* nb = lds + ((j + 1) & 1) * 32768; tile_dma(Kg + (size_t)(j + 1) * 64 * NP, nb, wave, lane); tile_dma(Vg + (size_t)(j + 1) * 64 * NP, nb + 16384, wave, lane); }
#endif
        const bool doit = (64 * j <= 32 * wave + 31);
        bf16x8 pf[4];
        if (doit) {
            f32x16 p0 = (f32x16){}, p1 = (f32x16){};
#pragma unroll
            for (int ks = 0; ks < 8; ++ks) { const unsigned ch = (unsigned)(2 * ks + hi) ^ xr;
                const bf16x8 k0 = *(const LAS bf16x8*)(Kt + 256u * r32 + 16u * ch), k1 = *(const LAS bf16x8*)(Kt + 256u * (32 + r32) + 16u * ch);
                p0 = __builtin_amdgcn_mfma_f32_32x32x16_bf16(k0, qf[ks], p0, 0, 0, 0); p1 = __builtin_amdgcn_mfma_f32_32x32x16_bf16(k1, qf[ks], p1, 0, 0, 0); if ((ks & 3) == 3) __builtin_amdgcn_sched_barrier(0); }
            float ps = 0.f;
#pragma unroll
            for (int r = 0; r < 16; ++r) { const int kv = 64 * j + crow(r, hi);
                const float w0 = (kv <= qloc) ? __expf(as[kv] - Aq) * 0.08838834764831845f : 0.f, w1 = (kv + 32 <= qloc) ? __expf(as[kv + 32] - Aq) * 0.08838834764831845f : 0.f;
                p0[r] *= w0; p1[r] *= w1; ps += p0[r] + p1[r]; }
            den += ps;
#pragma unroll
            for (int ks = 0; ks < 4; ++ks) { u32x4 w;
#pragma unroll
                for (int q = 0; q < 4; ++q) { const int r = 8 * (ks & 1) + 2 * q; w[q] = (ks < 2) ? cvt_pk_bf16(p0[r], p0[r + 1]) : cvt_pk_bf16(p1[r], p1[r + 1]); }
                pf[ks] = __builtin_bit_cast(bf16x8, w); }
        }
        WAIT_ALL_BAR();
        if (doit) {
            bf16x8 vf[2][4];
#define S3_LOADV(buf, ks_) do { _Pragma("unroll") for (int cb = 0; cb < 4; ++cb) { const unsigned chv = (unsigned)(4 * cb + 2 * blk + (pp >> 1)); const unsigned row0 = 16u * (ks_) + 4u * hi + q4; \
                vf[buf][cb] = cat8(vtr(Vt + off_b(row0, chv) + 8u * (pp & 1)), vtr(Vt + off_b(row0 + 8u, chv) + 8u * (pp & 1))); } } while (0)
            S3_LOADV(0, 0);
#pragma unroll
            for (int ks = 0; ks < 4; ++ks) {
                if (ks < 3) S3_LOADV((ks + 1) & 1, ks + 1);
                __builtin_amdgcn_sched_barrier(0);
#pragma unroll
                for (int cb = 0; cb < 4; ++cb) o[cb] = __builtin_amdgcn_mfma_f32_32x32x16_bf16(vf[ks & 1][cb], pf[ks], o[cb], 0, 0, 0);
                __builtin_amdgcn_sched_barrier(0);
            }
#undef S3_LOADV
        }
#if defined(S3_REGSTAGE)
        if (j + 1 < 4) { LAS unsigned char* nb = lds + ((j + 1) & 1) * 32768; tile_write(nb, tid, kr); tile_write(nb + 16384, tid, vr); }
#endif
    }
    den += __shfl_xor(den, 32);
    const float dinv = 1.0f / fmaxf(fabsf(den), __expf(-BAq));
    float sm = 0.f;
#pragma unroll
    for (int cb = 0; cb < 4; ++cb)
#pragma unroll
        for (int r = 0; r < 16; ++r) { o[cb][r] *= dinv; sm += o[cb][r]; }
    sm += __shfl_xor(sm, 32);
    const float mu = sm * (1.0f / 128.0f);
    float vs = 0.f;
#pragma unroll
    for (int cb = 0; cb < 4; ++cb)
#pragma unroll
        for (int r = 0; r < 16; ++r) { o[cb][r] -= mu; vs += o[cb][r] * o[cb][r]; }
    vs += __shfl_xor(vs, 32);
    const float rstd = 1.0f / sqrtf(vs * (1.0f / 128.0f) + NORM_EPS);
    const float* hn = p.in[9] + hd * 128;
    const bf16_t* mo = P + (t0 + qloc) * NP + P_MO + hd * 128;
    bf16_t* orow = CAT + (t0 + qloc) * D + hd * 128;
    u32x2 mw[4][4];
#pragma unroll
    for (int cb = 0; cb < 4; ++cb)
#pragma unroll
        for (int rq = 0; rq < 4; ++rq) mw[cb][rq] = *(const u32x2*)(mo + 32 * cb + 8 * rq + 4 * hi);
#pragma unroll
    for (int cb = 0; cb < 4; ++cb)
#pragma unroll
        for (int rq = 0; rq < 4; ++rq) { const int e0 = 32 * cb + 8 * rq + 4 * hi; const f32x4 hv = *(const f32x4*)(hn + e0); const u32x2 m2 = mw[cb][rq];
            const float g0 = fast_rcp(1.0f + __expf(-bf_lo(m2.x))), g1 = fast_rcp(1.0f + __expf(-bf_hi(m2.x))), g2 = fast_rcp(1.0f + __expf(-bf_lo(m2.y))), g3 = fast_rcp(1.0f + __expf(-bf_hi(m2.y)));
            u32x2 w; w.x = cvt_pk_bf16(o[cb][4 * rq] * rstd * hv[0] * g0, o[cb][4 * rq + 1] * rstd * hv[1] * g1); w.y = cvt_pk_bf16(o[cb][4 * rq + 2] * rstd * hv[2] * g2, o[cb][4 * rq + 3] * rstd * hv[3] * g3);
            *(u32x2*)(orow + e0) = w; }
    WAIT_ALL_BAR();
}

__device__ __forceinline__ void mlstm_seq_unit(const Params& p, LAS unsigned char* lds, int bh, int tid_, int wave, int lane_) {
    int tid = tid_; asm volatile("" : "+v"(tid)); const int lane = tid & 63;
    const bf16_t* P = (const bf16_t*)(p.ws + WS_P); bf16_t* CAT = (bf16_t*)(p.ws + WS_CAT);
    const int b = bh >> 2, hd = bh & 3, r32 = lane & 31, hi = lane >> 5;
    LAS float* fs = (LAS float*)(lds + MISC_OFF) + MW_F;
    LAS float* as = fs;
    LAS float* nC = fs + 256;
    LAS float* wsc = fs + 384;
    LAS unsigned char* Ct = lds + 65536;
    const unsigned xr = ((unsigned)(r32 & 3) << 2) | ((unsigned)(r32 >> 2) & 3u);
    const unsigned q4 = (lane & 15) >> 2, pp = lane & 3, blk = (lane >> 4) & 1;
    const int eb = wave >> 1, dh = wave & 1;
    f32x16 cacc[2]; cacc[0] = (f32x16){}; cacc[1] = (f32x16){};
    float nrun = 0.f;
    float Prun = -INFINITY;
    LAS float* hnl = fs + 896;
    if (tid < 128) hnl[tid] = p.in[9][hd * 128 + tid];
#pragma unroll 1
    for (int c = 0; c < NCH; ++c) {
        const size_t t0 = (size_t)b * SEQ + (size_t)c * MCH;
        const size_t so = (size_t)bh * SEQ + c * MCH;
        const float* SA = (const float*)(p.ws + WS_SA) + so; const float* SAM = (const float*)(p.ws + WS_SAM) + so; const float* SBA = (const float*)(p.ws + WS_SBA) + so;
        const int qloc = 32 * wave + r32;
        const float Aq2 = SAM[qloc] * 1.4426950408889634f;
        if (tid < 256) as[tid] = SA[tid] * 1.4426950408889634f;
        bf16x8 qf[2];
        LAS bf16x8* qpark = (LAS bf16x8*)(lds + 98304 + tid * 64);
        LAS bf16x8* qpark2 = (LAS bf16x8*)(lds + 147456 + tid * 32);
        { const bf16_t* qp = P + (t0 + qloc) * NP + P_MQ + hd * 128 + hi * 8;
#pragma unroll
          for (int ks = 0; ks < 2; ++ks) qf[ks] = *(const bf16x8*)(qp + ks * 16);
#pragma unroll
          for (int ks = 2; ks < 6; ++ks) qpark[ks - 2] = *(const bf16x8*)(qp + ks * 16);
#pragma unroll
          for (int ks = 6; ks < 8; ++ks) qpark2[ks - 6] = *(const bf16x8*)(qp + ks * 16); }
#define QFRAG(ks) ((ks) < 2 ? qf[(ks) & 1] : ((ks) < 6 ? qpark[((ks) - 2) & 3] : qpark2[((ks) - 6) & 1]))
        const bf16_t* Kg = P + t0 * NP + P_MK + hd * 128; const bf16_t* Vg = P + t0 * NP + P_MV + hd * 128;
        tile_dma(Kg, lds, wave, lane); tile_dma(Vg, lds + 16384, wave, lane);
        asm volatile("" :: "v"(qf[0]), "v"(qf[1]), "v"(Aq2));
        WAIT_ALL_BAR();
        float R = fmaxf(fmaxf(as[lane], as[lane + 64]), fmaxf(as[lane + 128], as[lane + 192]));
#pragma unroll
        for (int o = 1; o < 64; o <<= 1) R = fmaxf(R, __shfl_xor(R, o));
        R *= (1.0f / 1.4426950408889634f);
        const float Pnew = fmaxf(Prun, R);
        const float scC = (c > 0) ? __expf(Prun - Pnew) : 0.f;
        if (tid < 256) wsc[tid] = fast_exp2(as[tid] - Pnew * 1.4426950408889634f) * 0.08838834764831845f;
        f32x16 o[4];
#pragma unroll
        for (int cb = 0; cb < 4; ++cb) o[cb] = (f32x16){};
        float den = 0.f;
        if (c > 0) {
#pragma unroll
            for (int cb = 0; cb < 4; ++cb) {
#pragma unroll
                for (int ks = 0; ks < 8; ++ks) { const unsigned ch = (unsigned)(2 * ks + hi) ^ xr;
                    const bf16x8 cfr = *(const LAS bf16x8*)(Ct + 256u * (32 * cb + r32) + 16u * ch);
                    const bf16x8 qv = QFRAG(ks);
                    o[cb] = __builtin_amdgcn_mfma_f32_32x32x16_bf16(cfr, qv, o[cb], 0, 0, 0); }
                __builtin_amdgcn_sched_barrier(0); }
            const float fst = fast_exp2(Prun * 1.4426950408889634f - Aq2);
#pragma unroll
            for (int cb = 0; cb < 4; ++cb)
#pragma unroll
                for (int r = 0; r < 16; ++r) o[cb][r] *= fst;
            float dq = 0.f;
#pragma unroll
            for (int ks = 0; ks < 8; ++ks) { const bf16x8 qv = QFRAG(ks);
#pragma unroll
                for (int q = 0; q < 4; ++q) { const unsigned w = ((const unsigned*)&qv)[q]; const int d = 16 * ks + 8 * hi + 2 * q; dq += bf_lo(w) * nC[d] + bf_hi(w) * nC[d + 1]; } }
            den = fst * dq;
#pragma unroll
            for (int r = 0; r < 16; ++r) { cacc[0][r] *= scC; cacc[1][r] *= scC; }
        }
        nrun *= scC;
#pragma unroll 1
        for (int j = 0; j < 4; ++j) {
            WAIT_ALL_BAR();
            const LAS unsigned char* Kt = lds + (j & 1) * 32768; const LAS unsigned char* Vt = Kt + 16384;
            if (j + 1 < 4) { LAS unsigned char* nb = lds + ((j + 1) & 1) * 32768; tile_dma(Kg + (size_t)(j + 1) * 64 * NP, nb, wave, lane); tile_dma(Vg + (size_t)(j + 1) * 64 * NP, nb + 16384, wave, lane); }
            const bool doit = (64 * j <= 32 * wave + 31);
            if (doit) {
                float ps = 0.f;
#pragma unroll
                for (int hf = 0; hf < 2; ++hf) {
                    f32x16 pp0 = (f32x16){};
#pragma unroll
                    for (int ks = 0; ks < 8; ++ks) { const unsigned ch = (unsigned)(2 * ks + hi) ^ xr;
                        const bf16x8 k0 = *(const LAS bf16x8*)(Kt + 256u * (32 * hf + r32) + 16u * ch);
                        const bf16x8 qv = QFRAG(ks);
                        pp0 = __builtin_amdgcn_mfma_f32_32x32x16_bf16(k0, qv, pp0, 0, 0, 0); }
#pragma unroll
                    for (int r = 0; r < 16; ++r) { const int kv = 64 * j + 32 * hf + crow(r, hi);
                        const float w0 = (kv <= qloc) ? fast_exp2(as[kv] - Aq2) * 0.08838834764831845f : 0.f;
                        pp0[r] *= w0; ps += pp0[r]; }
                    bf16x8 pfh[2];
#pragma unroll
                    for (int k2 = 0; k2 < 2; ++k2) { u32x4 w;
#pragma unroll
                        for (int q = 0; q < 4; ++q) { const int r = 8 * k2 + 2 * q; w[q] = cvt_pk_bf16(pp0[r], pp0[r + 1]); }
                        pfh[k2] = __builtin_bit_cast(bf16x8, w); }
                    __builtin_amdgcn_sched_barrier(0);
#pragma unroll
                    for (int k2 = 0; k2 < 2; ++k2)
#pragma unroll
                        for (int c2 = 0; c2 < 2; ++c2) {
                            bf16x8 vf[2];
#pragma unroll
                            for (int u = 0; u < 2; ++u) { const int cb = 2 * c2 + u; const unsigned chv = (unsigned)(4 * cb + 2 * blk + (pp >> 1)); const unsigned row0 = 16u * (2 * hf + k2) + 4u * hi + q4;
                                vf[u] = cat8(vtr(Vt + off_b(row0, chv) + 8u * (pp & 1)), vtr(Vt + off_b(row0 + 8u, chv) + 8u * (pp & 1))); }
                            o[2 * c2] = __builtin_amdgcn_mfma_f32_32x32x16_bf16(vf[0], pfh[k2], o[2 * c2], 0, 0, 0); o[2 * c2 + 1] = __builtin_amdgcn_mfma_f32_32x32x16_bf16(vf[1], pfh[k2], o[2 * c2 + 1], 0, 0, 0);
                            __builtin_amdgcn_sched_barrier(0);
                        }
                }
                den += ps;
            }
#pragma unroll
            for (int ks = 0; ks < 4; ++ks) {
                const unsigned row0 = 16u * ks + 8u * hi + q4, row1 = row0 + 4u;
                const unsigned cha = (unsigned)(4 * eb + 2 * blk + (pp >> 1));
                const bf16x8 af = cat8(vtr(Vt + off_b(row0, cha) + 8u * (pp & 1)), vtr(Vt + off_b(row1, cha) + 8u * (pp & 1)));
                const f32x4 wa = *(const LAS f32x4*)(wsc + 64 * j + 16 * ks + 8 * hi), wb = *(const LAS f32x4*)(wsc + 64 * j + 16 * ks + 8 * hi + 4);
#pragma unroll
                for (int db = 0; db < 2; ++db) { const unsigned chb = (unsigned)(4 * (2 * dh + db) + 2 * blk + (pp >> 1));
                    const s16x4 k0 = vtr(Kt + off_b(row0, chb) + 8u * (pp & 1)), k1 = vtr(Kt + off_b(row1, chb) + 8u * (pp & 1));
                    const u32x2 u0 = __builtin_bit_cast(u32x2, k0), u1 = __builtin_bit_cast(u32x2, k1);
                    u32x4 kw; kw.x = cvt_pk_bf16(bf_lo(u0.x) * wa[0], bf_hi(u0.x) * wa[1]); kw.y = cvt_pk_bf16(bf_lo(u0.y) * wa[2], bf_hi(u0.y) * wa[3]);
                    kw.z = cvt_pk_bf16(bf_lo(u1.x) * wb[0], bf_hi(u1.x) * wb[1]); kw.w = cvt_pk_bf16(bf_lo(u1.y) * wb[2], bf_hi(u1.y) * wb[3]);
                    cacc[db] = __builtin_amdgcn_mfma_f32_32x32x16_bf16(af, __builtin_bit_cast(bf16x8, kw), cacc[db], 0, 0, 0); }
                __builtin_amdgcn_sched_barrier(0);
            }
            { const int d = tid & 127, sq = tid >> 7; float sN = 0.f;
#pragma unroll 4
                for (int s2 = 0; s2 < 16; ++s2) { const int srow = 16 * sq + s2; const unsigned short hv = *(const LAS unsigned short*)(Kt + off_b(srow, d >> 3) + (d & 7) * 2); sN += __uint_as_float((unsigned)hv << 16) * wsc[64 * j + srow]; }
                nrun += sN; }
            WAIT_ALL_BAR();
        }
        int tid2 = tid_; asm volatile("" : "+v"(tid2));
        const int qloc2 = 32 * wave + (tid2 & 31), hi2 = (tid2 >> 5) & 1;
        const float BAq = SBA[qloc2];
        den += __shfl_xor(den, 32);
        const float dinv = 1.0f / fmaxf(fabsf(den), __expf(-BAq));
        float sm = 0.f;
#pragma unroll
        for (int cb = 0; cb < 4; ++cb)
#pragma unroll
            for (int r = 0; r < 16; ++r) { o[cb][r] *= dinv; sm += o[cb][r]; }
        sm += __shfl_xor(sm, 32);
        const float mu = sm * (1.0f / 128.0f);
        float vs = 0.f;
#pragma unroll
        for (int cb = 0; cb < 4; ++cb)
#pragma unroll
            for (int r = 0; r < 16; ++r) { o[cb][r] -= mu; vs += o[cb][r] * o[cb][r]; }
        vs += __shfl_xor(vs, 32);
        const float rstd = 1.0f / sqrtf(vs * (1.0f / 128.0f) + NORM_EPS);
        const bf16_t* mo = P + (t0 + qloc2) * NP + P_MO + hd * 128 + 4 * hi2;
        bf16_t* orow0 = CAT + (t0 + qloc2) * D + hd * 128;
#pragma unroll
        for (int c2 = 0; c2 < 2; ++c2) {
            u32x2 mw[8]; u32x2 wk = {0u, 0u};
#pragma unroll
            for (int u = 0; u < 8; u += 2) { const u32x4 g4 = *(const u32x4*)(mo - 4 * hi2 + 32 * (2 * c2 + (u >> 2)) + 8 * ((u & 3) + hi2));
                const auto rx = __builtin_amdgcn_permlane32_swap(g4.x, g4.z, false, false); const auto ry = __builtin_amdgcn_permlane32_swap(g4.y, g4.w, false, false);
                mw[u].x = rx[0]; mw[u].y = ry[0]; mw[u + 1].x = rx[1]; mw[u + 1].y = ry[1]; }
#pragma unroll
            for (int u = 0; u < 8; ++u) { const int cb = 2 * c2 + (u >> 2), rq = u & 3; const int e0 = 32 * cb + 8 * rq; const u32x2 m2 = mw[u]; const f32x4 hv = *(const LAS f32x4*)(hnl + e0 + 4 * hi2);
                const float g0 = fast_rcp(1.0f + fast_exp2(-1.4426950408889634f * bf_lo(m2.x))), g1 = fast_rcp(1.0f + fast_exp2(-1.4426950408889634f * bf_hi(m2.x))), g2 = fast_rcp(1.0f + fast_exp2(-1.4426950408889634f * bf_lo(m2.y))), g3 = fast_rcp(1.0f + fast_exp2(-1.4426950408889634f * bf_hi(m2.y)));
                u32x2 w; w.x = cvt_pk_bf16(o[cb][4 * rq] * rstd * hv[0] * g0, o[cb][4 * rq + 1] * rstd * hv[1] * g1); w.y = cvt_pk_bf16(o[cb][4 * rq + 2] * rstd * hv[2] * g2, o[cb][4 * rq + 3] * rstd * hv[3] * g3);
                if ((u & 1) == 0) wk = w;
                else { const auto sx = __builtin_amdgcn_permlane32_swap(wk.x, w.x, false, false); const auto sy = __builtin_amdgcn_permlane32_swap(wk.y, w.y, false, false);
                    u32x4 ww; ww.x = sx[0]; ww.y = sy[0]; ww.z = sx[1]; ww.w = sy[1];
                    *(u32x4*)(orow0 + 32 * cb + 8 * (rq - 1 + hi2)) = ww; } }
            __builtin_amdgcn_sched_barrier(0); }
        if (c + 1 < NCH) {
#pragma unroll
            for (int db = 0; db < 2; ++db)
#pragma unroll
                for (int r = 0; r < 16; ++r) { const int e = 32 * eb + crow(r, hi), d = 64 * dh + 32 * db + r32;
                    *(LAS unsigned short*)(Ct + off_b(e, d >> 3) + (d & 7) * 2) = (unsigned short)(cvt_pk_bf16(cacc[db][r], 0.f) & 0xffffu); }
            wsc[tid] = nrun;
        }
        Prun = Pnew;
        WAIT_ALL_BAR();
        if (c + 1 < NCH) { if (tid < 128) nC[tid] = (wsc[tid] + wsc[tid + 128]) + (wsc[tid + 256] + wsc[tid + 384]); }
    }
#undef QFRAG
}

__device__ __forceinline__ int moe_table(LAS unsigned char* lds, unsigned* cnt, int tid) {
    LAS int* misc = (LAS int*)(lds + MISC_OFF);
    __syncthreads();
    if (tid == 0) { int acc = 0; for (int e = 0; e < 16; ++e) { const int c = (int)__hip_atomic_load(cnt + e * 64, __ATOMIC_RELAXED, __HIP_MEMORY_SCOPE_AGENT); misc[MW_CN + e] = c; misc[MW_TB + e] = acc; acc += (c + 255) >> 8; } misc[MW_TB + 16] = acc; }
    __syncthreads();
    return misc[MW_TB + 16];
}

#ifndef STAGGER_MASK
#define STAGGER_MASK 0u
#endif
#ifndef STAGGER_GROUPS
#define STAGGER_GROUPS 4
#endif
#ifndef STAGGER_TICKS
#define STAGGER_TICKS 700
#endif
__device__ __forceinline__ void stagger(int vcu, int phase_bit) {
    if (!((STAGGER_MASK >> phase_bit) & 1u)) return;
    const int g = vcu & (STAGGER_GROUPS - 1); if (g == 0) return;
    const unsigned long long t0 = __builtin_amdgcn_s_memrealtime(); const unsigned long long w = (unsigned long long)g * STAGGER_TICKS;
    while (__builtin_amdgcn_s_memrealtime() - t0 < w) __builtin_amdgcn_s_sleep(8);
}
constexpr int LATE_UNITS = 224, LATE_UNITS_A = 160, LATE_UNITS_B = 64, CW_LATEQ = CW_QUEUE + 64 * 8;
template <int QID>
__device__ __forceinline__ void late_convert(const Params& p, LAS unsigned char* lds, unsigned* ctl, int quota, int tid, int wave, int lane) {
    volatile LAS unsigned* misc = (volatile LAS unsigned*)(lds + MISC_OFF);
    for (int k = 0; k < quota; ++k) {
        __syncthreads();
        if (tid == 0) misc[MW_Q] = __hip_atomic_fetch_add(ctl + CW_LATEQ + 64 * QID, 1u, __ATOMIC_RELAXED, __HIP_MEMORY_SCOPE_AGENT);
        __syncthreads();
        const int q = (int)misc[MW_Q];
        if (q >= 4 * (QID == 0 ? LATE_UNITS_A : LATE_UNITS_B)) break;
        const int c = q >> 2, sub = q & 3;
        const int v = QID == 0 ? (c < 32 ? 8 + c : 232 + 12 * ((c - 32) >> 3) + ((c - 32) & 7)) : 232 + 12 * (c >> 2) + 8 + (c & 3);
        const int f = WT_I1 + 64 * v + 16 * sub + 2 * wave;
        phase_prologue_weights(p, lds, f, f + 2, 1, wave, lane);
    }
    __syncthreads();
}
template <int LAYER>
__device__ __forceinline__ void moe_block(const Params& p, LAS unsigned char* lds, const XcdBarrier& bar, unsigned* ctl, int tid, int wave, int lane, int vcu, int G) {
    unsigned char* ws = p.ws;
    const LAS int* tb = (const LAS int*)(lds + MISC_OFF) + MW_TB; const LAS int* cn = (const LAS int*)(lds + MISC_OFF) + MW_CN;
    unsigned* cnt = ctl + CW_CNT + LAYER * 16 * 64;
    if (PH(12)) phase_router(p, lds, tid, wave, G, p.in[3] + LAYER * D, p.in[18] + (size_t)LAYER * D * 4, p.in[19] + LAYER * 4, p.in[20] + (size_t)LAYER * D * 16, p.in[21] + LAYER * 16, cnt);
    xcd_barrier(bar);
    const int ntot = moe_table(lds, cnt, tid);
    stagger(vcu, 13);
    for (int rep_ = 0; rep_ < REPS(13); ++rep_) if (PH(13)) { pg8::MoeSched<true> S{(const char*)(ws + WS_XB8), (const char*)(ws + WS_WGU) + (size_t)LAYER * 16 * 1024 * 1024, 512, (size_t)1024 * 1024, tb, cn, (const unsigned*)(ws + WS_ROWTOK), ntot, vcu, G};
      pg8::EpiPair<1> E{nullptr, (bf16_t*)(ws + WS_HM), FF, (const float*)(ws + WS_RSRAW), (const unsigned*)(ws + WS_ROWTOK), tb, cn};
      pg8::gemm_phase<pg8::EpiPair<1>, pg8::MoeSched<true>, true, true>(lds, 512, S, E); }
    const int nun = ntot * 4, rounds_max = (nun + G - 1) / G, rounds_mine = nun > vcu ? (nun - vcu + G - 1) / G : 0;
    if (LATE_CV && LAYER == 0 && PH(0)) late_convert<0>(p, lds, ctl, 2 * (rounds_max - rounds_mine), tid, wave, lane);
    if (LATE_CV && LAYER == 1 && PH(0)) { late_convert<1>(p, lds, ctl, 2 * (rounds_max - rounds_mine), tid, wave, lane); late_convert<1>(p, lds, ctl, 1 << 20, tid, wave, lane); }
    xcd_barrier(bar);
    stagger(vcu, 14);
    for (int rep_ = 0; rep_ < REPS(14); ++rep_) if (PH(14)) { pg8::MoeSched<false> S{(const char*)(ws + WS_HM), (const char*)(ws + WS_WD) + (size_t)LAYER * 16 * 1024 * 512, 256, (size_t)1024 * 512, tb, cn, nullptr, ntot, vcu, G};
      pg8::EpiDown E{(unsigned char*)(ws + WS_YC), (const float*)(ws + WS_CWRAW), tb, cn};
      pg8::gemm_phase<pg8::EpiDown, pg8::MoeSched<false>, false, true>(lds, 256, S, E); }
    if (LATE_CV && LAYER == 0 && PH(0)) { late_convert<0>(p, lds, ctl, rounds_max - rounds_mine, tid, wave, lane); late_convert<0>(p, lds, ctl, 1 << 20, tid, wave, lane); }
    xcd_barrier(bar);
}

__global__ void __launch_bounds__(NTHR, 2) fwd_kernel(Params p) {
    extern __shared__ __attribute__((aligned(16))) unsigned char lds_raw[];
    LAS unsigned char* lds = (LAS unsigned char*)lds_raw;
    const int tid = threadIdx.x, lane = tid & 63, wave = __builtin_amdgcn_readfirstlane(tid >> 6);
    const int G = gridDim.x; const int bx = blockIdx.x;
    const int vcu = (G % 8 == 0) ? (bx % 8) * (G / 8) + bx / 8 : bx;
    const int gw = vcu * NWAVES + wave, NGW = G * NWAVES;
    volatile LAS unsigned* misc = (volatile LAS unsigned*)(lds + MISC_OFF);
    for (int u = tid; u < (LDS_BYTES - MISC_OFF) / 4; u += NTHR) misc[u] = 0u;
    __syncthreads();
    unsigned* ctl = (unsigned*)(p.ws + WS_CTL);
    XcdBarrier bar = xcd_barrier_post(ctl + CW_BAR, misc + MW_BAR);
    unsigned char* ws = p.ws;

    for (int rep_ = 0; rep_ < REPS(0); ++rep_) if (PH(0)) phase_prologue_weights(p, lds, gw, WT_I1, NGW, wave, lane);
    __syncthreads();
    for (int rep_ = 0; rep_ < REPS(1); ++rep_) if (PH(1)) phase_norm_gates(p, lds, tid, gw, NGW, lane);
    xcd_barrier(bar);

    if (PH(2)) phase_gate_scan(p, gw, NGW, lane);
    stagger(vcu, 3);
    for (int rep_ = 0; rep_ < REPS(3); ++rep_) if (PH(3)) { pg8::DenseSched S; S.init(ws + WS_H, ws + WS_WT1, T, NP, 1024, G, bx); pg8::EpiBf16 E{(bf16_t*)(ws + WS_P), NP};
      pg8::gemm_phase<pg8::EpiBf16, pg8::DenseSched, false>(lds, 1024, S, E); }
    xcd_barrier(bar);

    {
        constexpr int NSEQ = NBATCH * 4, NAT = NBATCH * 4 * 16, NMEM = LATE_CV ? WT_UNITS - LATE_UNITS : WT_UNITS;
        for (int u = bx; u < NSEQ; u += G) { for (int r2 = 0; r2 < REPS(16); ++r2) if (PH(4)) mlstm_seq_unit(p, lds, u, tid, wave, lane); }
        for (int rep_ = 0; rep_ < REPS(4); ++rep_) {
            bool a_done = false, m_done = false; int sa_cnt = 0, sm_cnt = 0; (void)sa_cnt; (void)sm_cnt;
            for (int it = 0; !(a_done && m_done); ++it) {
                const int r5 = it % 5; bool want_mem = (r5 == 1 || r5 == 3);
                if (want_mem && m_done) want_mem = false; else if (!want_mem && a_done) want_mem = true;
                __syncthreads();
#ifdef STATIC_Q
                if (tid == 0) { misc[MW_Q] = (unsigned)((want_mem ? sm_cnt : sa_cnt) * G + bx); }
                if (want_mem) ++sm_cnt; else ++sa_cnt;
#else
                if (tid == 0) misc[MW_Q] = __hip_atomic_fetch_add(ctl + CW_QUEUE + 64 * (2 * rep_ + (want_mem ? 1 : 0)), 1u, __ATOMIC_RELAXED, __HIP_MEMORY_SCOPE_AGENT);
#endif
                __syncthreads();
                const int u = (int)misc[MW_Q];
                if (want_mem) {
                    if (u >= NMEM) { m_done = true; continue; }
                    { const int v = LATE_CV ? (u < 8 ? u : u + 32) : u;        for (int r2 = 0; r2 < REPS(18); ++r2) if (PH(0)) { const int f = WT_I1 + 64 * v + 8 * wave; phase_prologue_weights(p, lds, f, f + 8, 1, wave, lane); } }
                } else {
                    if (u >= NAT) { a_done = true; continue; }
                    for (int r2 = 0; r2 < REPS(17); ++r2) if (PH(5)) attn_unit(p, lds, u & 127, 15 - (u >> 7), tid, wave, lane);
                }
            }
        }
    }
    xcd_barrier(bar);

    for (int rep_ = 0; rep_ < REPS(7); ++rep_) if (PH(7)) { pg8::DenseSched S; S.init(ws + WS_CAT, ws + WS_WT2, T, 1024, 1024, G, bx); pg8::EpiResid<true> E{p.in[0], (bf16_t*)(ws + WS_XB), ws + WS_XB8};
      pg8::gemm_phase<pg8::EpiResid<true>, pg8::DenseSched, false>(lds, 1024, S, E); }
    xcd_barrier(bar);

    moe_block<0>(p, lds, bar, ctl, tid, wave, lane, vcu, G);
    if (PH(8)) phase_rows<0, true>(p, lds, tid, wave, lane, G, p.in[2] + D, nullptr, nullptr, nullptr, nullptr, ctl + CW_CNT, nullptr);
    xcd_barrier(bar);
    stagger(vcu, 9);
    for (int rep_ = 0; rep_ < REPS(9); ++rep_) if (PH(9)) { pg8::DenseSched S; S.init(G3_F8 ? ws + WS_XB8 : ws + WS_XB, ws + WS_WT3, T, 3072, G3_F8 ? 512 : 1024, G, bx); pg8::EpiPair<0> E{(bf16_t*)(ws + WS_BG), (bf16_t*)(ws + WS_Z), D, (const float*)(ws + WS_RSTD), nullptr, nullptr, nullptr};
      pg8::gemm_phase<pg8::EpiPair<0>, pg8::DenseSched, false, G3_F8 != 0>(lds, G3_F8 ? 512 : 1024, S, E); }
    xcd_barrier(bar);
    for (int rep_ = 0; rep_ < REPS(10); ++rep_) if (PH(10)) phase_conv(p, gw, NGW, lane);
    xcd_barrier(bar);
    if (PH(11)) { pg8::DenseSched S; S.init(ws + WS_CAT, ws + WS_WT4, T, 1024, 1024, G, bx); pg8::EpiResid<false> E{nullptr, (bf16_t*)(ws + WS_XB), ws + WS_XB8};
      pg8::gemm_phase<pg8::EpiResid<false>, pg8::DenseSched, false>(lds, 1024, S, E); }
    xcd_barrier(bar);
    moe_block<1>(p, lds, bar, ctl, tid, wave, lane, vcu, G);
    if (PH(15)) phase_rows<2, true>(p, lds, tid, wave, lane, G, p.in[4], nullptr, nullptr, nullptr, nullptr, ctl + CW_CNT + 16 * 64, nullptr);
}

extern "C" void kernel_launch(void* const* d_in, const int* in_sizes, int n_in, void* d_out, int out_size, void* d_ws, size_t ws_size, hipStream_t stream) {
    static int grid = 0;
    if (grid == 0) {
        if (n_in != 25 || in_sizes[0] != T * D || out_size != T * D || ws_size < WS_END) { fprintf(stderr, "kernel_launch: unexpected shapes (n_in %d, in0 %d, out %d, ws %zu)\n", n_in, n_in > 0 ? in_sizes[0] : -1, out_size, ws_size); grid = -1; return; }
        int dev = 0, cus = 0, per_cu = 0;
        if (hipGetDevice(&dev) != hipSuccess || hipDeviceGetAttribute(&cus, hipDeviceAttributeMultiprocessorCount, dev) != hipSuccess) { grid = -1; return; }
        if (hipFuncSetAttribute((const void*)fwd_kernel, hipFuncAttributeMaxDynamicSharedMemorySize, LDS_BYTES) != hipSuccess) { fprintf(stderr, "kernel_launch: hipFuncSetAttribute failed\n"); grid = -1; return; }
        if (hipOccupancyMaxActiveBlocksPerMultiprocessor(&per_cu, (const void*)fwd_kernel, NTHR, LDS_BYTES) != hipSuccess || per_cu < 1) fprintf(stderr, "kernel_launch: occupancy query reports %d\n", per_cu);
        (void)hipGetLastError();
        grid = cus;
    }
    if (grid < 0) return;
    hipMemsetAsync((char*)d_ws + WS_CTL, 0, CTL_ZERO_BYTES, stream);
    Params p{};
    for (int i = 0; i < 25; ++i) p.in[i] = (const float*)d_in[i];
    p.out = (float*)d_out; p.ws = (unsigned char*)d_ws;
    hipLaunchKernelGGL(fwd_kernel, dim3(grid), dim3(NTHR), LDS_BYTES, stream, p);
}
```

```cpp
#include <hip/hip_runtime.h>
#include <cstdio>
#include <cstdint>
#ifndef PHASE_MASK
#define PHASE_MASK 0xffffffffu
#endif
#define PH(k) (((PHASE_MASK) >> (k)) & 1u)
#ifndef PHASE_TWICE
#define PHASE_TWICE 0u
#endif
#define REPS(k) (1 + (int)(((PHASE_TWICE) >> (k)) & 1u))

#define LAS __attribute__((address_space(3)))
#define GAS __attribute__((address_space(1)))
typedef unsigned short bf16_t;
typedef short bf16x8 __attribute__((ext_vector_type(8)));
typedef short s16x4 __attribute__((ext_vector_type(4)));
typedef float f32x4 __attribute__((ext_vector_type(4)));
typedef float f32x2 __attribute__((ext_vector_type(2)));
typedef float f32x16 __attribute__((ext_vector_type(16)));
typedef unsigned u32x4 __attribute__((ext_vector_type(4)));
typedef unsigned u32x2 __attribute__((ext_vector_type(2)));
typedef GAS unsigned gu32;
typedef int i32x8 __attribute__((ext_vector_type(8)));
typedef int i32x4 __attribute__((ext_vector_type(4)));

constexpr int D = 1024, NBATCH = 32, SEQ = 2048, T = NBATCH * SEQ;
constexpr int EVEN_IN = 3592, NP = 3584;
constexpr int P_MQ = 0, P_MK = 512, P_MV = 1024, P_MO = 1536, P_DQ = 2048, P_DK = 2560, P_DV = 3072;
constexpr int NE = 16, FF = 512;
constexpr int ECAP = 65536;
constexpr float NORM_EPS = 1e-6f;
constexpr int NWAVES = 8, NTHR = 512;
constexpr int MCH = 256, NCH = SEQ / MCH;
constexpr int WT_I1 = 16 * 112, WT_ITEMS = 28928, WT_UNITS = (WT_ITEMS - WT_I1) / 64;

constexpr size_t MiB = 1u << 20;
constexpr size_t WS_CTL = 0, CTL_ZERO_BYTES = 1 * MiB;
constexpr size_t WS_WT1 = 1 * MiB, WS_WT2 = 8 * MiB, WS_WT3 = 10 * MiB, WS_WT4 = 16 * MiB, WS_WGU = 18 * MiB, WS_WD = 82 * MiB;
constexpr size_t WS_GATES = 114 * MiB, WS_SA = 116 * MiB, WS_SAM = 117 * MiB, WS_SBA = 118 * MiB, WS_UN = 119 * MiB, WS_UR = 119 * MiB + 768 * 1024;
constexpr size_t WS_UT = 120 * MiB;
constexpr size_t WS_ROWTOK = 184 * MiB, WS_CWRAW = 188 * MiB, WS_TOKINFO = 192 * MiB, WS_RSTD = 193 * MiB;
constexpr size_t WS_H = 194 * MiB, WS_CAT = 322 * MiB, WS_P = 450 * MiB;
constexpr size_t WS_RSRAW = 120 * MiB;
constexpr size_t WS_XB8 = 720 * MiB;
constexpr size_t WS_XB = WS_H;
constexpr size_t WS_BG = WS_P, WS_Z = WS_P + 128 * MiB, WS_HM = WS_P, WS_YC = WS_P + 136 * MiB;
constexpr size_t WS_END = 898 * MiB;
constexpr int CW_BAR = 4096;
constexpr int CW_CNT = 16384;
constexpr int CW_QUEUE = 32768;

__device__ __forceinline__ unsigned cvt_pk_bf16(float lo, float hi) { unsigned r; asm volatile("v_cvt_pk_bf16_f32 %0, %1, %2" : "=v"(r) : "v"(lo), "v"(hi)); return r; }
__device__ __forceinline__ unsigned cvt_pk4_fp8(float a, float b, float c, float d) { unsigned w = 0; w = (unsigned)__builtin_amdgcn_cvt_pk_fp8_f32(a, b, (int)w, false); w = (unsigned)__builtin_amdgcn_cvt_pk_fp8_f32(c, d, (int)w, true); return w; }
#ifndef LATE_CV
#define LATE_CV 1
#endif
#ifndef G3_F8
#define G3_F8 1
#endif
constexpr float F8_WSCALE = 64.0f, F8_HSCALE = 16.0f, F8_YSCALE = 64.0f;
__device__ __forceinline__ float bf_lo(unsigned w) { return __uint_as_float(w << 16); }
__device__ __forceinline__ float bf_hi(unsigned w) { return __uint_as_float(w & 0xffff0000u); }
__device__ __forceinline__ float wave_sum(float v) {
#pragma unroll
    for (int o = 1; o < 64; o <<= 1) v += __shfl_xor(v, o);
    return v;
}
__device__ __forceinline__ float fast_exp2(float x) { return __builtin_amdgcn_exp2f(x); }
__device__ __forceinline__ float fast_rcp(float x) { return __builtin_amdgcn_rcpf(x); }
__device__ __forceinline__ int crow(int r, int hi) { return (r & 3) + 8 * (r >> 2) + 4 * hi; }
__device__ __forceinline__ unsigned off_b(unsigned row, unsigned ch) { return 256u * row + 16u * (ch ^ (((row & 3u) << 2) | ((row >> 2) & 3u))); }
__device__ __forceinline__ s16x4 vtr(const LAS unsigned char* p) { return __builtin_bit_cast(s16x4, __builtin_amdgcn_ds_read_tr16_b64_v4i16((LAS s16x4*)p)); }
__device__ __forceinline__ bf16x8 cat8(s16x4 a, s16x4 b) { return (bf16x8){a[0], a[1], a[2], a[3], b[0], b[1], b[2], b[3]}; }

#define XB_TMO      128
#define XB_XCNT(j)  (256  + 64 * (j))
#define XB_XSUB(j)  (1280 + 64 * (j))
#define XB_XGEN(j)  (2304 + 64 * (j))
#define XB_TOP      3328
#define XB_TOPGEN   3392
#define XCD_BAR_WORDS 3456
#define XB_SPIN_CAP (1u << 18)
__device__ __forceinline__ unsigned xb_ld(unsigned* p)              { return __hip_atomic_load(p, __ATOMIC_RELAXED, __HIP_MEMORY_SCOPE_AGENT); }
__device__ __forceinline__ unsigned xb_add(unsigned* p, unsigned v) { return __hip_atomic_fetch_add(p, v, __ATOMIC_RELAXED, __HIP_MEMORY_SCOPE_AGENT); }
__device__ __forceinline__ unsigned xb_xcc_id() { return (unsigned)__builtin_amdgcn_s_getreg((3 << 11) | 20) & 0xFu; }
#define XB_SPIN(cond, bar) do { unsigned _sp = 0; while (cond) { __builtin_amdgcn_s_sleep(1); \
    if ((++_sp & 255u) == 0u) { if (xb_ld(&(bar)[XB_TMO])) break; if (_sp > XB_SPIN_CAP) { atomicAdd(&(bar)[XB_TMO], 1u); break; } } } } while (0)
struct XcdBarrier { unsigned* bar; unsigned x; volatile LAS unsigned* st; };
__device__ __forceinline__ XcdBarrier xcd_barrier_post(unsigned* bar, volatile LAS unsigned* st) {
    XcdBarrier b; b.bar = bar; b.x = xb_xcc_id(); b.st = st;
    if (threadIdx.x == 0) (void)xb_add(&bar[XB_XCNT(b.x)], 1u);
    return b;
}
__device__ __forceinline__ void xcd_barrier_complete(unsigned* bar, unsigned x, unsigned& nloc, unsigned& nx) {
    const unsigned G = gridDim.x * gridDim.y * gridDim.z;
    unsigned sum, cnt, mine, sp = 0u;
    for (;;) {
        sum = 0u; cnt = 0u; mine = 0u;
#pragma unroll
        for (unsigned j = 0; j < 16; ++j) { const unsigned c = xb_ld(&bar[XB_XCNT(j)]); sum += c; cnt += (c > 0u) ? 1u : 0u; mine = (j == x) ? c : mine; }
        if (sum == G) break;
        __builtin_amdgcn_s_sleep(1);
        if ((++sp & 255u) == 0u) { if (xb_ld(&bar[XB_TMO])) break; if (sp > XB_SPIN_CAP) { atomicAdd(&bar[XB_TMO], 1u); break; } }
    }
    nloc = mine > 0u ? mine : 1u; nx = cnt > 0u ? cnt : 1u;
}
__device__ __forceinline__ void xcd_barrier(const XcdBarrier& b) {
    asm volatile("s_waitcnt vmcnt(0)" ::: "memory");
    __syncthreads();
    if (threadIdx.x == 0) {
        unsigned* bar = b.bar;
        __builtin_amdgcn_s_waitcnt(0);
        unsigned nloc = b.st[0], nx = b.st[1];
        if (nloc == 0u) { xcd_barrier_complete(bar, b.x, nloc, nx); b.st[0] = nloc; b.st[1] = nx; }
        const unsigned old = xb_add(&bar[XB_XSUB(b.x)], 1u);
        const unsigned gen = old / nloc;
        if (old + 1u == (gen + 1u) * nloc) {
            __builtin_amdgcn_fence(__ATOMIC_RELEASE, "agent");
            asm volatile("s_waitcnt vmcnt(0)" ::: "memory");
            const unsigned og = xb_add(&bar[XB_TOP], 1u);
            const unsigned tg = og / nx;
            if (og + 1u == (tg + 1u) * nx) xb_add(&bar[XB_TOPGEN], 1u);
            else XB_SPIN(xb_ld(&bar[XB_TOPGEN]) == tg, bar);
            __builtin_amdgcn_fence(__ATOMIC_ACQUIRE, "agent");
            xb_add(&bar[XB_XGEN(b.x)], 1u);
            asm volatile("s_waitcnt vmcnt(0)" ::: "memory");
        } else {
            XB_SPIN(xb_ld(&bar[XB_XGEN(b.x)]) == gen, bar);
            __builtin_amdgcn_fence(__ATOMIC_ACQUIRE, "agent");
            asm volatile("s_waitcnt vmcnt(0)" ::: "memory");
        }
    }
    __syncthreads();
}

namespace pg8 {
constexpr int BM = 256, BK = 64, HALF = 128, HTB = HALF * BK * 2, STAGE_BYTES = 8 * HTB, NXCD = 8, WGM = 8;
__device__ __forceinline__ int lds_byte(int r, int c) { const int st = (r >> 4) * 2 + (c >> 5), rr = r & 15, cc = c & 31, ob = rr * 64 + cc * 2; return st * 1024 + (ob ^ (((ob >> 9) & 1) << 5)); }
__device__ __forceinline__ void stage_rc(int b, int& R, int& C) { const int st = b / 1024, sb = b % 1024, swz = sb ^ (((sb >> 9) & 1) << 5); R = (st >> 1) * 16 + swz / 64; C = (st & 1) * 32 + (swz % 64) / 2; }
__device__ __forceinline__ int perm32(int rho) { const int n = rho >> 4, i = rho & 15; return 8 * (i >> 2) + 4 * n + (i & 3); }
struct Unit { int pm, pn; };

template <class Epi, class Sched, bool GATHER, bool F8 = false>
__device__ __forceinline__ void gemm_phase(LAS unsigned char* lds, const int K, const Sched& S, const Epi& E) {
    int tid = threadIdx.x; asm volatile("" : "+v"(tid));
    const int wid = __builtin_amdgcn_readfirstlane(tid >> 6), lane = tid & 63, wr = wid >> 2, wc = wid & 3, fr = lane & 15, fq = lane >> 4;
    const int nt = K / BK;
    int Rr[2], Cc[2]; unsigned voffB[2];
#pragma unroll
    for (int i = 0; i < 2; ++i) { stage_rc(tid * 16 + i * 8192, Rr[i], Cc[i]); const int Rb = Epi::PERM ? ((Rr[i] & ~31) + perm32(Rr[i] & 31)) : Rr[i];
        voffB[i] = (unsigned)(Rb * K + Cc[i]) * 2u; }
    const size_t kstep = (size_t)(BK * 2);
    const size_t hstep = (size_t)HALF * K * 2;
    const unsigned ldsw = (unsigned)wid * 1024u;
    const int aoff = lds_byte(wr * 64 + fr, fq * 8), boff = lds_byte(wc * 32 + fr, fq * 8);
#define PG8_SA(b, h) (((b) * 2 + (h)) * HTB)
#define PG8_SB(b, h) ((4 + (b) * 2 + (h)) * HTB)
#define PG8_STAGE(bufoff, gbase, voff) do { _Pragma("unroll") for (int _i = 0; _i < 2; ++_i) \
        __builtin_amdgcn_global_load_lds((const unsigned*)((const char*)(gbase) + (voff)[_i]), (LAS unsigned*)(lds + (bufoff) + ldsw + _i * 8192), 16, 0, 0); } while (0)
#define PG8_LD8(p) __builtin_shufflevector(*(const LAS i32x4*)(p), *(const LAS i32x4*)((p) + 1024), 0, 1, 2, 3, 4, 5, 6, 7)
#define PG8_LDA(dst, b, h) do { if constexpr (F8) { _Pragma("unroll") for (int m = 0; m < 4; ++m) dst##8[m] = PG8_LD8(lds + PG8_SA(b, h) + aoff + m * 2048); } \
        else { _Pragma("unroll") for (int m = 0; m < 4; ++m) _Pragma("unroll") for (int k = 0; k < 2; ++k) dst[m][k] = *(const LAS bf16x8*)(lds + PG8_SA(b, h) + aoff + m * 2048 + k * 1024); } } while (0)
#define PG8_LDB(dst, b, h) do { if constexpr (F8) { _Pragma("unroll") for (int n = 0; n < 2; ++n) dst##8[n] = PG8_LD8(lds + PG8_SB(b, h) + boff + n * 2048); } \
        else { _Pragma("unroll") for (int n = 0; n < 2; ++n) _Pragma("unroll") for (int k = 0; k < 2; ++k) dst[n][k] = *(const LAS bf16x8*)(lds + PG8_SB(b, h) + boff + n * 2048 + k * 1024); } } while (0)
#define PG8_CAT8(x0, x1) __builtin_shufflevector(__builtin_bit_cast(i32x4, x0), __builtin_bit_cast(i32x4, x1), 0, 1, 2, 3, 4, 5, 6, 7)
#define PG8_MMA(ai, bj, At, Bt) do { __builtin_amdgcn_s_setprio(1); _Pragma("unroll") for (int m = 0; m < 4; ++m) _Pragma("unroll") for (int n = 0; n < 2; ++n) { \
        if constexpr (F8) asm volatile("v_mfma_scale_f32_16x16x128_f8f6f4 %0, %1, %2, %0, %3, %3 op_sel_hi:[0,0,0]" : "+v"(acc[ai][bj][m][n]) : "v"(Bt##8[n]), "v"(At##8[m]), "v"(f8one)); \
        else { _Pragma("unroll") for (int k = 0; k < 2; ++k) acc[ai][bj][m][n] = __builtin_amdgcn_mfma_f32_16x16x32_bf16(Bt[n][k], At[m][k], acc[ai][bj][m][n], 0, 0, 0); } } __builtin_amdgcn_s_setprio(0); } while (0)
#define PG8_WAIT_V(n) asm volatile("s_waitcnt vmcnt(" #n ")" ::: "memory")
#define PG8_WAIT_L(n) asm volatile("s_waitcnt lgkmcnt(" #n ")" ::: "memory")
#define PG8_BAR __builtin_amdgcn_s_barrier()
#define PG8_SCHED __builtin_amdgcn_sched_barrier(0)
#define PG8_VOFF(dst, u) do { _Pragma("unroll") for (int _h = 0; _h < 2; ++_h) _Pragma("unroll") for (int _i = 0; _i < 2; ++_i) { \
        if constexpr (GATHER) dst[_h][_i] = S.arow(u, _h * HALF + Rr[_i]) * (unsigned)(K * 2) + (unsigned)(Cc[_i] * 2); \
        else dst[_h][_i] = (unsigned)((_h * HALF + Rr[_i]) * K + Cc[_i]) * 2u; } } while (0)
    Unit cur, nxt; int ui = 0;
    if (!S.next(0, cur)) return;
    f32x4 acc[2][2][4][2];
    if constexpr (Epi::PRELOAD) E.preload(acc, cur, wr, wc, fr, fq);
    else {
#pragma unroll
    for (int a = 0; a < 2; ++a)
#pragma unroll
        for (int b = 0; b < 2; ++b)
#pragma unroll
            for (int m = 0; m < 4; ++m)
#pragma unroll
                for (int n = 0; n < 2; ++n) acc[a][b][m][n] = (f32x4){0.f, 0.f, 0.f, 0.f};
    }
    float epf[2][4] = {{0.f, 0.f, 0.f, 0.f}, {0.f, 0.f, 0.f, 0.f}};
    bf16x8 At[4][2], B0[2][2], B1[2][2];
    i32x8 At8[4], B08[2], B18[2]; const unsigned f8one = 0x7f7f7f7fu;
    unsigned vA[2][2], vN[2][2];
    PG8_VOFF(vA, cur);
    if constexpr (Epi::PREFETCH) E.prefetch(epf, cur, wr, fr);
    const char* cA = S.abase(cur); const char* cB = S.bbase(cur);
    PG8_STAGE(PG8_SB(0, 0), cB, voffB); PG8_STAGE(PG8_SB(0, 1), cB + hstep, voffB); PG8_STAGE(PG8_SA(0, 0), cA, vA[0]); PG8_STAGE(PG8_SA(0, 1), cA, vA[1]);
    if (wr == 1) PG8_BAR;
    PG8_WAIT_V(2); PG8_BAR;
    PG8_STAGE(PG8_SB(1, 0), cB + kstep, voffB); PG8_STAGE(PG8_SA(1, 0), cA + kstep, vA[0]); PG8_STAGE(PG8_SB(1, 1), cB + hstep + kstep, voffB);
    PG8_WAIT_V(6); PG8_BAR;
    for (;;) {
        const bool has_next = S.next(ui + 1, nxt);
        const char* nA = has_next ? S.abase(nxt) : cA; const char* nB = has_next ? S.bbase(nxt) : cB;
        if constexpr (GATHER) { if (has_next) { PG8_VOFF(vN, nxt); } else {
#pragma unroll
            for (int h = 0; h < 2; ++h)
#pragma unroll
                for (int i = 0; i < 2; ++i) vN[h][i] = vA[h][i]; } }
#pragma unroll 1
        for (int t = 0; t < nt; t += 2) {
            const bool last = (t == nt - 2);
            const char* a1 = cA + (size_t)(t + 1) * kstep;
            const char* a2 = last ? nA : cA + (size_t)(t + 2) * kstep; const char* b2 = last ? nB : cB + (size_t)(t + 2) * kstep;
            const char* a3 = a2 + kstep; const char* b3 = b2 + kstep;
            unsigned v2[2][2]; const unsigned lmask = last ? 0xffffffffu : 0u;
#pragma unroll
            for (int h = 0; h < 2; ++h)
#pragma unroll
                for (int i = 0; i < 2; ++i) { if constexpr (GATHER) v2[h][i] = (vN[h][i] & lmask) | (vA[h][i] & ~lmask); else v2[h][i] = vA[h][i]; }
            PG8_LDB(B0, 0, 0); PG8_LDB(B1, 0, 1); PG8_SCHED; PG8_LDA(At, 0, 0); PG8_STAGE(PG8_SA(1, 1), a1, vA[1]);
            PG8_WAIT_V(8); PG8_WAIT_L(0); PG8_BAR; PG8_MMA(0, 0, At, B0); PG8_MMA(0, 1, At, B1); PG8_BAR; PG8_SCHED;
            PG8_LDA(At, 0, 1); PG8_STAGE(PG8_SB(0, 0), b2, voffB); PG8_STAGE(PG8_SB(0, 1), b2 + hstep, voffB); PG8_STAGE(PG8_SA(0, 0), a2, v2[0]);
            PG8_WAIT_V(8); PG8_WAIT_L(0); PG8_BAR; PG8_MMA(1, 0, At, B0); PG8_MMA(1, 1, At, B1); PG8_BAR; PG8_SCHED;
            PG8_LDB(B0, 1, 0); PG8_LDB(B1, 1, 1); PG8_SCHED; PG8_LDA(At, 1, 0); PG8_STAGE(PG8_SA(0, 1), a2, v2[1]);
            PG8_WAIT_V(8); PG8_WAIT_L(0); PG8_BAR; PG8_MMA(0, 0, At, B0); PG8_MMA(0, 1, At, B1); PG8_BAR; PG8_SCHED;
            PG8_LDA(At, 1, 1); PG8_STAGE(PG8_SB(1, 0), b3, voffB); PG8_STAGE(PG8_SB(1, 1), b3 + hstep, voffB); PG8_STAGE(PG8_SA(1, 0), a3, v2[0]);
            PG8_WAIT_V(8); PG8_WAIT_L(0); PG8_BAR; PG8_MMA(1, 0, At, B0); PG8_MMA(1, 1, At, B1); PG8_BAR; PG8_SCHED;
        }
        if (wr == 0) PG8_BAR;
        if constexpr (F8) asm volatile("s_nop 15\n\ts_nop 15" ::: "memory");
        if constexpr (Epi::PREFETCH) E(acc, cur, wr, wc, fr, fq, epf); else E(acc, cur, wr, wc, fr, fq);
        if (!has_next) break;
        if constexpr (Epi::PREFETCH) E.prefetch(epf, nxt, wr, fr);
        if constexpr (Epi::PRELOAD) E.preload(acc, nxt, wr, wc, fr, fq);
        else {
#pragma unroll
        for (int a = 0; a < 2; ++a)
#pragma unroll
            for (int b = 0; b < 2; ++b)
#pragma unroll
                for (int m = 0; m < 4; ++m)
#pragma unroll
                    for (int n = 0; n < 2; ++n) acc[a][b][m][n] = (f32x4){0.f, 0.f, 0.f, 0.f};
        }
        cur = nxt; cA = nA; cB = nB; ++ui;
        if constexpr (GATHER) {
#pragma unroll
        for (int h = 0; h < 2; ++h)
#pragma unroll
            for (int i = 0; i < 2; ++i) vA[h][i] = vN[h][i]; }
        if (wr == 1) PG8_BAR;
    }
    PG8_WAIT_V(0);
    PG8_BAR;
#undef PG8_SA
#undef PG8_SB
#undef PG8_STAGE
#undef PG8_LDA
#undef PG8_LD8
#undef PG8_LDB
#undef PG8_MMA
#undef PG8_CAT8
#undef PG8_WAIT_V
#undef PG8_WAIT_L
#undef PG8_BAR
#undef PG8_SCHED
#undef PG8_VOFF
}

struct DenseSched {
    const char* A; const char* Bt; int K; int nM, nN, nwg, G, c;
    __device__ __forceinline__ void init(const void* A_, const void* Bt_, int M, int N, int K_, int G_, int c_) { A = (const char*)A_; Bt = (const char*)Bt_; K = K_; nM = M / BM; nN = N / BM; nwg = nM * nN; G = G_; c = c_; }
    __device__ __forceinline__ bool next(int i, Unit& u) const {
        const long L = (long)i * G + c; if (L >= nwg) return false;
        int wgid = (int)L; { const int q = nwg / NXCD, r = nwg % NXCD, xcd = wgid % NXCD, off = wgid / NXCD; wgid = (xcd < r ? xcd * (q + 1) : r * (q + 1) + (xcd - r) * q) + off; }
        const int nig = WGM * nN, gid = wgid / nig, fm = gid * WGM, gsz = (nM - fm) < WGM ? (nM - fm) : WGM;
        u.pm = fm + ((wgid % nig) % gsz); u.pn = (wgid % nig) / gsz; return true;
    }
    __device__ __forceinline__ const char* abase(const Unit& u) const { return A + (size_t)u.pm * BM * K * 2; }
    __device__ __forceinline__ const char* bbase(const Unit& u) const { return Bt + (size_t)u.pn * BM * K * 2; }
    __device__ __forceinline__ unsigned arow(const Unit&, int) const { return 0u; }
};
template <bool GATHER_A>
struct MoeSched {
    const char* A; const char* W; int K; size_t wstride; const LAS int* tb; const LAS int* cn; const unsigned* rowtok; int ntot, vcu, G;
    __device__ __forceinline__ bool next(int i, Unit& u) const { const int L = i * G + vcu; if (L >= ntot * 4) return false; u.pm = L >> 2; u.pn = L & 3; return true; }
    __device__ __forceinline__ int expert(int pm) const { int e = 0;
#pragma unroll
        for (int j = 1; j < 16; ++j) e += (pm >= tb[j]) ? 1 : 0; return e; }
    __device__ __forceinline__ const char* abase(const Unit& u) const { return GATHER_A ? A : A + (size_t)u.pm * BM * K * 2; }
    __device__ __forceinline__ const char* bbase(const Unit& u) const { return W + (size_t)expert(u.pm) * wstride + (size_t)u.pn * BM * K * 2; }
    __device__ __forceinline__ unsigned arow(const Unit& u, int r) const { const int e = expert(u.pm); const int idx = (u.pm - tb[e]) * BM + r; return idx < cn[e] ? rowtok[(size_t)e * ECAP + idx] : 0u; }
};

__device__ __forceinline__ u32x4 widen16(u32x2 a, u32x2 b) {
    const auto rx = __builtin_amdgcn_permlane16_swap(a.x, b.x, false, false); const auto ry = __builtin_amdgcn_permlane16_swap(a.y, b.y, false, false);
    u32x4 o; o.x = rx[0]; o.y = ry[0]; o.z = rx[1]; o.w = ry[1]; return o; }
struct EpiBf16 {
    static constexpr bool PERM = true, PRELOAD = false, PREFETCH = false;
    bf16_t* O; int ldc;
    __device__ __forceinline__ void operator()(const f32x4 (&acc)[2][2][4][2], const Unit& u, int wr, int wc, int fr, int fq) const {
        const int row0 = u.pm * BM + wr * 64 + fr, col0 = u.pn * BM + wc * 32 + 8 * fq;
#pragma unroll
        for (int ai = 0; ai < 2; ++ai)
#pragma unroll
            for (int m = 0; m < 4; ++m) { bf16_t* rowp = O + (size_t)(row0 + ai * HALF + m * 16) * ldc + col0;
#pragma unroll
                for (int bj = 0; bj < 2; ++bj) { const f32x4 v0 = acc[ai][bj][m][0], v1 = acc[ai][bj][m][1];
                    u32x4 w; w.x = cvt_pk_bf16(v0[0], v0[1]); w.y = cvt_pk_bf16(v0[2], v0[3]); w.z = cvt_pk_bf16(v1[0], v1[1]); w.w = cvt_pk_bf16(v1[2], v1[3]);
#ifdef EPI_NT
                    __builtin_nontemporal_store(w, (u32x4*)(rowp + bj * HALF));
#else
                    *(u32x4*)(rowp + bj * HALF) = w;
#endif
                } }
    }
};
template <bool XF32>
struct EpiResid {
    static constexpr bool PERM = true, PRELOAD = true, PREFETCH = false;
    const float* xin; bf16_t* XB; unsigned char* XB8;
    __device__ __forceinline__ void preload(f32x4 (&acc)[2][2][4][2], const Unit& u, int wr, int wc, int fr, int fq) const {
        const int row0 = u.pm * BM + wr * 64 + fr, col0 = u.pn * BM + wc * 32 + 8 * fq;
#pragma unroll
        for (int ai = 0; ai < 2; ++ai)
#pragma unroll
            for (int m = 0; m < 4; ++m) { const size_t off = (size_t)(row0 + ai * HALF + m * 16) * D + col0;
#pragma unroll
                for (int bj = 0; bj < 2; ++bj) {
                    if (XF32) { acc[ai][bj][m][0] = *(const f32x4*)(xin + off + bj * HALF); acc[ai][bj][m][1] = *(const f32x4*)(xin + off + bj * HALF + 4); }
                    else { const u32x4 w = *(const u32x4*)(XB + off + bj * HALF); acc[ai][bj][m][0] = (f32x4){bf_lo(w.x), bf_hi(w.x), bf_lo(w.y), bf_hi(w.y)}; acc[ai][bj][m][1] = (f32x4){bf_lo(w.z), bf_hi(w.z), bf_lo(w.w), bf_hi(w.w)}; } } }
    }
    __device__ __forceinline__ void operator()(const f32x4 (&acc)[2][2][4][2], const Unit& u, int wr, int wc, int fr, int fq) const {
        const int row0 = u.pm * BM + wr * 64 + fr, col0 = u.pn * BM + wc * 32 + 8 * fq;
        const int colw = u.pn * BM + wc * 32 + 8 * (fq & ~1);
#pragma unroll
        for (int ai = 0; ai < 2; ++ai)
#pragma unroll
            for (int mp = 0; mp < 4; mp += 2)
#pragma unroll
                for (int bj = 0; bj < 2; ++bj) { u32x2 w8[2];
#pragma unroll
                    for (int h = 0; h < 2; ++h) { const int m = mp + h; bf16_t* rowp = XB + (size_t)(row0 + ai * HALF + m * 16) * D + col0;
                        const f32x4 v0 = acc[ai][bj][m][0], v1 = acc[ai][bj][m][1];
                        u32x4 w; w.x = cvt_pk_bf16(v0[0], v0[1]); w.y = cvt_pk_bf16(v0[2], v0[3]); w.z = cvt_pk_bf16(v1[0], v1[1]); w.w = cvt_pk_bf16(v1[2], v1[3]);
                        *(u32x4*)(rowp + bj * HALF) = w;
                        w8[h].x = cvt_pk4_fp8(bf_lo(w.x), bf_hi(w.x), bf_lo(w.y), bf_hi(w.y)); w8[h].y = cvt_pk4_fp8(bf_lo(w.z), bf_hi(w.z), bf_lo(w.w), bf_hi(w.w)); }
                    *(u32x4*)(XB8 + (size_t)(row0 + ai * HALF + (mp + (fq & 1)) * 16) * D + colw + bj * HALF) = widen16(w8[0], w8[1]); }
    }
};
template <int MODE  >
struct EpiPair {
    static constexpr bool PERM = true, PRELOAD = false, PREFETCH = true;
    bf16_t* O0; bf16_t* O1; int ld1;
    const float* rstd; const unsigned* rowtok; const LAS int* tb; const LAS int* cn;
    __device__ __forceinline__ void prefetch(float (&rs)[2][4], const Unit& u, int wr, int fr) const {
        const int row0 = u.pm * BM + wr * 64 + fr;
        if (MODE == 0) {
#pragma unroll
            for (int ai = 0; ai < 2; ++ai)
#pragma unroll
                for (int m = 0; m < 4; ++m) rs[ai][m] = rstd[row0 + ai * HALF + m * 16] * (G3_F8 ? 1.0f / F8_WSCALE : 1.0f);
        } else {
            int e = 0;
#pragma unroll
            for (int j = 1; j < 16; ++j) e += (u.pm >= tb[j]) ? 1 : 0;
            const int idx0 = (u.pm - tb[e]) * BM + wr * 64 + fr, cne = cn[e];
#pragma unroll
            for (int ai = 0; ai < 2; ++ai)
#pragma unroll
                for (int m = 0; m < 4; ++m) { const int idx = idx0 + ai * HALF + m * 16; rs[ai][m] = idx < cne ? rstd[(size_t)e * ECAP + idx] * (1.0f / F8_WSCALE) : 0.f; }
        }
    }
    __device__ __forceinline__ void operator()(const f32x4 (&acc)[2][2][4][2], const Unit& u, int wr, int wc, int fr, int fq, const float (&rs)[2][4]) const {
        const int row0 = u.pm * BM + wr * 64 + fr;
        if (MODE == 0 && u.pn < 4) {
            const int col0 = u.pn * BM + wc * 32 + 8 * fq;
#pragma unroll
            for (int ai = 0; ai < 2; ++ai)
#pragma unroll
                for (int m = 0; m < 4; ++m) { bf16_t* rowp = O0 + (size_t)(row0 + ai * HALF + m * 16) * D + col0;
#pragma unroll
                    for (int bj = 0; bj < 2; ++bj) { const f32x4 v0 = acc[ai][bj][m][0] * rs[ai][m], v1 = acc[ai][bj][m][1] * rs[ai][m];
                        u32x4 w; w.x = cvt_pk_bf16(v0[0], v0[1]); w.y = cvt_pk_bf16(v0[2], v0[3]); w.z = cvt_pk_bf16(v1[0], v1[1]); w.w = cvt_pk_bf16(v1[2], v1[3]);
                        *(u32x4*)(rowp + bj * HALF) = w; } }
        } else {
            const int pt = (MODE == 0) ? (u.pn - 4) : u.pn;
            const int col0 = pt * HALF + wc * 32 + 8 * fq;
#pragma unroll
            for (int ai = 0; ai < 2; ++ai) { u32x2 wkeep = {0u, 0u};
#pragma unroll
                for (int m = 0; m < 4; ++m) { bf16_t* rowp = O1 + (size_t)(row0 + ai * HALF + m * 16) * ld1 + col0;
                    f32x4 r[2];
#pragma unroll
                    for (int n = 0; n < 2; ++n) { const f32x4 g = acc[ai][0][m][n] * rs[ai][m], up = acc[ai][1][m][n] * rs[ai][m];
                        if (MODE == 0) r[n] = g * up;
                        else {
#pragma unroll
                            for (int j = 0; j < 4; ++j) r[n][j] = __builtin_amdgcn_fmed3f(g[j] * fast_rcp(1.0f + fast_exp2(-1.4426950408889634f * g[j])) * up[j] * F8_HSCALE, -448.0f, 448.0f); } }
                    if (MODE == 1) { u32x2 w; w.x = cvt_pk4_fp8(r[0][0], r[0][1], r[0][2], r[0][3]); w.y = cvt_pk4_fp8(r[1][0], r[1][1], r[1][2], r[1][3]);
                        if ((m & 1) == 0) wkeep = w;
                        else *(u32x4*)((unsigned char*)O1 + (size_t)(row0 + ai * HALF + (m - 1 + (fq & 1)) * 16) * ld1 + (pt * HALF + wc * 32 + 8 * (fq & ~1))) = widen16(wkeep, w); }
                    else { u32x4 w; w.x = cvt_pk_bf16(r[0][0], r[0][1]); w.y = cvt_pk_bf16(r[0][2], r[0][3]); w.z = cvt_pk_bf16(r[1][0], r[1][1]); w.w = cvt_pk_bf16(r[1][2], r[1][3]);
                        *(u32x4*)rowp = w; } } }
        }
    }
};
struct EpiDown {
    static constexpr bool PERM = true, PRELOAD = false, PREFETCH = true;
    unsigned char* O; const float* cwraw; const LAS int* tb; const LAS int* cn;
    __device__ __forceinline__ void prefetch(float (&cws)[2][4], const Unit& u, int wr, int fr) const {
        int e = 0;
#pragma unroll
        for (int j = 1; j < 16; ++j) e += (u.pm >= tb[j]) ? 1 : 0;
        const int idx0 = (u.pm - tb[e]) * BM + wr * 64 + fr, cne = cn[e];
#pragma unroll
        for (int ai = 0; ai < 2; ++ai)
#pragma unroll
            for (int m = 0; m < 4; ++m) { const int idx = idx0 + ai * HALF + m * 16; cws[ai][m] = idx < cne ? cwraw[(size_t)e * ECAP + idx] * (F8_YSCALE / (F8_WSCALE * F8_HSCALE)) : 0.f; }
    }
    __device__ __forceinline__ void operator()(const f32x4 (&acc)[2][2][4][2], const Unit& u, int wr, int wc, int fr, int fq, const float (&cws)[2][4]) const {
        const int row0 = u.pm * BM + wr * 64 + fr, col0 = u.pn * BM + wc * 32 + 8 * fq;
        const int colw = u.pn * BM + wc * 32 + 8 * (fq & ~1);
#pragma unroll
        for (int ai = 0; ai < 2; ++ai)
#pragma unroll
            for (int mp = 0; mp < 4; mp += 2) {
                unsigned char* rowp = O + (size_t)(row0 + ai * HALF + (mp + (fq & 1)) * 16) * D + colw;
#pragma unroll
                for (int bj = 0; bj < 2; ++bj) { u32x2 w[2];
#pragma unroll
                    for (int h = 0; h < 2; ++h) { const float cw = cws[ai][mp + h]; f32x4 v0 = acc[ai][bj][mp + h][0] * cw, v1 = acc[ai][bj][mp + h][1] * cw;
#pragma unroll
                        for (int j = 0; j < 4; ++j) { v0[j] = __builtin_amdgcn_fmed3f(v0[j], -448.0f, 448.0f); v1[j] = __builtin_amdgcn_fmed3f(v1[j], -448.0f, 448.0f); }
                        w[h].x = cvt_pk4_fp8(v0[0], v0[1], v0[2], v0[3]); w[h].y = cvt_pk4_fp8(v1[0], v1[1], v1[2], v1[3]); }
                    *(u32x4*)(rowp + bj * HALF) = widen16(w[0], w[1]); } }
    }
};
}

constexpr int RING_BYTES = 131072;
constexpr int MISC_OFF = RING_BYTES;
constexpr int LDS_BYTES = 163840;
constexpr int MW_BAR = 0;
constexpr int MW_TB = 16;
constexpr int MW_CN = 40;
constexpr int MW_Q = 60;
constexpr int MW_F = 64;

struct Params {
    const float* in[25]; float* out; unsigned char* ws;
};

constexpr float ATT_QSCALE = 0.125f * 1.4426950408889634f;
__device__ __forceinline__ void transpose_item(const float* W, int ld, int K, int k0, int srccol, bf16_t* WT, int dstrow, LAS float* scr, int lane, const float* gk = nullptr, float wsc = 1.0f) {
    float tv[32];
#pragma unroll
    for (int i = 0; i < 32; ++i) { const int kk = 2 * i + (lane >> 5); tv[i] = W[(size_t)(k0 + kk) * ld + srccol + (lane & 31)]; }
#pragma unroll
    for (int i = 0; i < 32; ++i) { const int kk = 2 * i + (lane >> 5); scr[kk * 33 + (lane & 31)] = (gk ? tv[i] * gk[k0 + kk] : tv[i]) * wsc; }
    asm volatile("s_waitcnt lgkmcnt(0)" ::: "memory");
    const int c = lane & 7;
#pragma unroll
    for (int j = 0; j < 4; ++j) { const int n = (lane >> 3) + 8 * j; const LAS float* s = scr + (8 * c) * 33 + n;
        u32x4 o; o.x = cvt_pk_bf16(s[0 * 33], s[1 * 33]); o.y = cvt_pk_bf16(s[2 * 33], s[3 * 33]); o.z = cvt_pk_bf16(s[4 * 33], s[5 * 33]); o.w = cvt_pk_bf16(s[6 * 33], s[7 * 33]);
        *(u32x4*)(WT + (size_t)(dstrow + n) * K + k0 + 8 * c) = o; }
    asm volatile("s_waitcnt lgkmcnt(0)" ::: "memory");
}
__device__ __forceinline__ void transpose_item_f8(const float* W, int ld, int K, int k0, int srccol, unsigned char* WT8, int dstrow, LAS float* scr, int lane, const float* gk, float scale) {
    float tv[32];
#pragma unroll
    for (int i = 0; i < 32; ++i) { const int kk = 2 * i + (lane >> 5); tv[i] = W[(size_t)(k0 + kk) * ld + srccol + (lane & 31)]; }
#pragma unroll
    for (int i = 0; i < 32; ++i) { const int kk = 2 * i + (lane >> 5); scr[kk * 33 + (lane & 31)] = (gk ? tv[i] * gk[k0 + kk] : tv[i]) * scale; }
    asm volatile("s_waitcnt lgkmcnt(0)" ::: "memory");
    const int c = lane & 3;
#pragma unroll
    for (int j = 0; j < 2; ++j) { const int n = (lane >> 2) + 16 * j; const LAS float* q = scr + (16 * c) * 33 + n;
        u32x4 o; o.x = cvt_pk4_fp8(q[0 * 33], q[1 * 33], q[2 * 33], q[3 * 33]); o.y = cvt_pk4_fp8(q[4 * 33], q[5 * 33], q[6 * 33], q[7 * 33]);
        o.z = cvt_pk4_fp8(q[8 * 33], q[9 * 33], q[10 * 33], q[11 * 33]); o.w = cvt_pk4_fp8(q[12 * 33], q[13 * 33], q[14 * 33], q[15 * 33]);
        *(u32x4*)(WT8 + (size_t)(dstrow + n) * K + k0 + 16 * c) = o; }
    asm volatile("s_waitcnt lgkmcnt(0)" ::: "memory");
}
__device__ __forceinline__ int pair_row(int ch, int up) { return (ch >> 7) * 256 + up * 128 + (ch & 127); }

__device__ __forceinline__ void phase_prologue_weights(const Params& p, LAS unsigned char* lds, int first, int last, int step, int wave, int lane_) {
    int lane = lane_; asm volatile("" : "+v"(lane));
    LAS float* scr = (LAS float*)(lds + wave * 16384);
    unsigned char* ws = p.ws;
    constexpr int I1 = 16 * 112, I2 = 16 * 32, I3 = 16 * 96, I4 = 16 * 32, IE = 768;
    constexpr int NITEMS = I1 + I2 + I3 + I4 + 32 * IE;
    static_assert(NITEMS == 28928, "item count");
    for (int it = first; it < last; it += step) {
        int r = it;
        if (r < I1) { const int kb = r / 112, nb = r % 112; const int sc = nb < 64 ? 32 * nb : 2056 + 32 * (nb - 64), dr = nb < 64 ? 32 * nb : 2048 + 32 * (nb - 64);
            transpose_item(p.in[5], EVEN_IN, 1024, 64 * kb, sc, (bf16_t*)(ws + WS_WT1), dr, scr, lane, nullptr, (dr >= P_DQ && dr < P_DK) ? ATT_QSCALE : 1.0f); continue; } r -= I1;
        if (r < I2) { const int kb = r / 32, nb = r % 32; transpose_item(p.in[6], 1024, 1024, 64 * kb, 32 * nb, (bf16_t*)(ws + WS_WT2), 32 * nb, scr, lane); continue; } r -= I2;
        if (r < I3) { const int kb = r / 96, nb = r % 96; int dr;
            if (nb < 32) dr = 32 * nb; else if (nb < 64) dr = 1024 + pair_row(32 * (nb - 32), 0); else dr = 1024 + pair_row(32 * (nb - 64), 1);
            if (G3_F8) transpose_item_f8(p.in[15], 3072, 1024, 64 * kb, 32 * nb, ws + WS_WT3, dr, scr, lane, p.in[2] + D, F8_WSCALE);
            else transpose_item(p.in[15], 3072, 1024, 64 * kb, 32 * nb, (bf16_t*)(ws + WS_WT3), dr, scr, lane, p.in[2] + D);
            continue; } r -= I3;
        if (r < I4) { const int kb = r / 32, nb = r % 32; transpose_item(p.in[17], 1024, 1024, 64 * kb, 32 * nb, (bf16_t*)(ws + WS_WT4), 32 * nb, scr, lane); continue; } r -= I4;
        const int le = r / IE; r %= IE;
        unsigned char* wgu = ws + WS_WGU + (size_t)le * 1024 * 1024; unsigned char* wd = ws + WS_WD + (size_t)le * 1024 * 512;
        if (r < 256) { const int kb = r / 16, nb = r % 16; transpose_item_f8(p.in[22] + (size_t)le * 1024 * 512, 512, 1024, 64 * kb, 32 * nb, wgu, pair_row(32 * nb, 0), scr, lane, p.in[3] + (le >> 4) * D, F8_WSCALE); continue; } r -= 256;
        if (r < 256) { const int kb = r / 16, nb = r % 16; transpose_item_f8(p.in[23] + (size_t)le * 1024 * 512, 512, 1024, 64 * kb, 32 * nb, wgu, pair_row(32 * nb, 1), scr, lane, p.in[3] + (le >> 4) * D, F8_WSCALE); continue; } r -= 256;
        { const int kb = r / 32, nb = r % 32; transpose_item_f8(p.in[24] + (size_t)le * 512 * 1024, 1024, 512, 64 * kb, 32 * nb, wd, 32 * nb, scr, lane, nullptr, F8_WSCALE); }
    }
}

struct RowV { f32x4 v[4]; };
__device__ __forceinline__ RowV row_load(const float* xr, int lane) { RowV r; const f32x4* p = (const f32x4*)xr + lane;
#pragma unroll
    for (int j = 0; j < 4; ++j) r.v[j] = p[64 * j]; return r; }
__device__ __forceinline__ void row_store(float* xr, int lane, const RowV& r) { f32x4* p = (f32x4*)xr + lane;
#pragma unroll
    for (int j = 0; j < 4; ++j) p[64 * j] = r.v[j]; }
__device__ __forceinline__ RowV row_load_bf16(const bf16_t* yr, int lane) { RowV r; const u32x2* p = (const u32x2*)yr + lane;
#pragma unroll
    for (int j = 0; j < 4; ++j) { const u32x2 w = p[64 * j]; r.v[j] = (f32x4){bf_lo(w.x), bf_hi(w.x), bf_lo(w.y), bf_hi(w.y)}; } return r; }
__device__ __forceinline__ RowV row_load_fp8(const unsigned char* yr, int lane, float sc) { RowV r; const unsigned* p = (const unsigned*)yr + lane;
#pragma unroll
    for (int j = 0; j < 4; ++j) { const unsigned w = p[64 * j]; const f32x2 lo = __builtin_amdgcn_cvt_pk_f32_fp8((int)w, false), hi = __builtin_amdgcn_cvt_pk_f32_fp8((int)w, true); r.v[j] = (f32x4){lo.x * sc, lo.y * sc, hi.x * sc, hi.y * sc}; } return r; }
__device__ __forceinline__ float row_rstd(const RowV& r) { float s = 0.f;
#pragma unroll
    for (int j = 0; j < 4; ++j) s += (r.v[j][0] * r.v[j][0] + r.v[j][1] * r.v[j][1]) + (r.v[j][2] * r.v[j][2] + r.v[j][3] * r.v[j][3]);
    return 1.0f / sqrtf(wave_sum(s) * (1.0f / D) + NORM_EPS); }
__device__ __forceinline__ void row_store_bf16(bf16_t* hr, int lane, const RowV& r) { u32x2* p = (u32x2*)hr + lane;
#pragma unroll
    for (int j = 0; j < 4; ++j) { u32x2 w; w.x = cvt_pk_bf16(r.v[j][0], r.v[j][1]); w.y = cvt_pk_bf16(r.v[j][2], r.v[j][3]); p[64 * j] = w; } }

__device__ __forceinline__ void phase_norm_gates(const Params& p, LAS unsigned char* lds, int tid, int gw, int NGW, int lane) {
    const float* x = p.in[0]; const float* g = p.in[2]; const float* win = p.in[5];
    bf16_t* H = (bf16_t*)(p.ws + WS_H); float* gates = (float*)(p.ws + WS_GATES);
    LAS float* wt = (LAS float*)lds;
    for (int i = tid; i < 8 * 1024; i += NTHR) { const int k = i >> 3, o = i & 7; wt[o * 1024 + k] = win[(size_t)k * EVEN_IN + 2048 + o] * g[k]; }
    __syncthreads();
    RowV gv = row_load(g, lane);
    for (int m0 = gw; m0 < T; m0 += 2 * NGW) {
      RowV rr[2];
#pragma unroll
      for (int u = 0; u < 2; ++u) { const int mm = m0 + u * NGW; rr[u] = row_load(x + (size_t)(mm < T ? mm : m0) * D, lane); }
#pragma unroll
      for (int u = 0; u < 2; ++u) {
        const int m = m0 + u * NGW; if (m >= T) break; RowV r = rr[u];
        const float rstd = row_rstd(r);
        float dots[8];
#pragma unroll
        for (int o = 0; o < 8; ++o) { float s = 0.f;
#pragma unroll
            for (int j = 0; j < 4; ++j) { const f32x4 w = *(const LAS f32x4*)(wt + o * 1024 + 4 * lane + 256 * j); s += (r.v[j][0] * w[0] + r.v[j][1] * w[1]) + (r.v[j][2] * w[2] + r.v[j][3] * w[3]); }
            dots[o] = s; }
        float gsum;
        { const bool b5 = (lane & 32) != 0, b4 = (lane & 16) != 0, b3 = (lane & 8) != 0;
          float k4[4];
#pragma unroll
          for (int i = 0; i < 4; ++i) { const float keep = b5 ? dots[4 + i] : dots[i], send = b5 ? dots[i] : dots[4 + i]; k4[i] = keep + __shfl_xor(send, 32); }
          float k2[2];
#pragma unroll
          for (int i = 0; i < 2; ++i) { const float keep = b4 ? k4[2 + i] : k4[i], send = b4 ? k4[i] : k4[2 + i]; k2[i] = keep + __shfl_xor(send, 16); }
          { const float keep = b3 ? k2[1] : k2[0], send = b3 ? k2[0] : k2[1]; gsum = keep + __shfl_xor(send, 8); }
          gsum += __shfl_xor(gsum, 4); gsum += __shfl_xor(gsum, 2); gsum += __shfl_xor(gsum, 1); }
#pragma unroll
        for (int j = 0; j < 4; ++j) r.v[j] = r.v[j] * rstd * gv.v[j];
        row_store_bf16(H + (size_t)m * D, lane, r);
        if ((lane & 7) == 0) gates[(size_t)m * 8 + ((lane >> 3) & 7)] = gsum * rstd;
      }
    }
    __syncthreads();
}

template <int MODE, bool COMBINE>
__device__ __forceinline__ void phase_rows(const Params& p, LAS unsigned char* lds, int tid_, int wave, int lane_, int G,
                                           const float* gvec, const float* wgr, const float* bgr, const float* wer, const float* ber, unsigned* cnt_prev, unsigned* cnt_cur) {
    int tid = tid_; asm volatile("" : "+v"(tid)); const int lane = tid & 63;
    float* OUT = p.out; bf16_t* XB = (bf16_t*)(p.ws + WS_XB); float* RSTD = (float*)(p.ws + WS_RSTD);
    const unsigned char* YC = (const unsigned char*)(p.ws + WS_YC); float* rsraw = (float*)(p.ws + WS_RSRAW);
    unsigned* tokinfo = (unsigned*)(p.ws + WS_TOKINFO);
    unsigned* rowtok = (unsigned*)(p.ws + WS_ROWTOK); float* cwraw = (float*)(p.ws + WS_CWRAW);
    LAS float* wt = (LAS float*)lds;
    LAS int* misc = (LAS int*)(lds + MISC_OFF);
    LAS int* tbp = misc + MW_TB;
    LAS int* te = misc + 1024;
    LAS float* tc = (LAS float*)(misc + 1536);
    LAS int* trank = misc + 2048;
    LAS int* ebase = misc + 2560;
    LAS float* trs = (LAS float*)(misc + 2600);
    if (COMBINE) { if (tid == 0) { int acc = 0; for (int e = 0; e < 16; ++e) { tbp[e] = acc; acc += ((int)__hip_atomic_load(cnt_prev + e * 64, __ATOMIC_RELAXED, __HIP_MEMORY_SCOPE_AGENT) + 255) >> 8; } tbp[16] = acc; } }
    if (MODE == 1) { for (int i = tid; i < 20 * 1024; i += NTHR) { const int o = i >> 10, k = i & 1023; wt[i] = (o < 4 ? wgr[(size_t)k * 4 + o] : wer[(size_t)k * 16 + (o - 4)]) * gvec[k]; } }
    __syncthreads();
    RowV gv; if (MODE == 2) gv = row_load(gvec, lane);
    for (int blk = blockIdx.x; blk < T / 256; blk += G) {
        for (int i2 = 0; i2 < 32; i2 += 2) {
          RowV rr[2];
#pragma unroll
          for (int u = 0; u < 2; ++u) {
            const int m = blk * 256 + wave * 32 + i2 + u;
            rr[u] = row_load_bf16(XB + (size_t)m * D, lane);
            if (COMBINE) {
                const unsigned i0 = tokinfo[(size_t)m * 2], i1 = tokinfo[(size_t)m * 2 + 1];
                const size_t s0 = (size_t)tbp[i0 >> 16] * 256 + (i0 & 0xffffu), s1 = (size_t)tbp[i1 >> 16] * 256 + (i1 & 0xffffu);
                const RowV y0 = row_load_fp8(YC + s0 * D, lane, 1.0f / F8_YSCALE), y1 = row_load_fp8(YC + s1 * D, lane, 1.0f / F8_YSCALE);
#pragma unroll
                for (int j = 0; j < 4; ++j) rr[u].v[j] = rr[u].v[j] + y0.v[j] + y1.v[j];
            }
          }
#pragma unroll
          for (int u = 0; u < 2; ++u) {
            const int i = i2 + u;
            const int rl = wave * 32 + i, m = blk * 256 + rl;
            RowV r = rr[u];
            if (MODE == 0) {
                u32x2* xp = (u32x2*)(XB + (size_t)m * D) + lane;
#pragma unroll
                for (int j = 0; j < 4; ++j) { u32x2 w; w.x = cvt_pk_bf16(r.v[j][0], r.v[j][1]); w.y = cvt_pk_bf16(r.v[j][2], r.v[j][3]); xp[64 * j] = w;
                    r.v[j] = (f32x4){bf_lo(w.x), bf_hi(w.x), bf_lo(w.y), bf_hi(w.y)}; }
            }
            const float rstd = row_rstd(r);
            if (MODE != 2) { if (lane == 0) RSTD[m] = rstd; }
            if (MODE == 1 || (MODE == 0 && G3_F8)) { unsigned* x8 = (unsigned*)(p.ws + WS_XB8 + (size_t)m * D) + lane;
#pragma unroll
                for (int j = 0; j < 4; ++j) x8[64 * j] = cvt_pk4_fp8(r.v[j][0], r.v[j][1], r.v[j][2], r.v[j][3]); }
            if (MODE == 1) {
                float lg[20];
#pragma unroll
                for (int o = 0; o < 20; ++o) { float s = 0.f;
#pragma unroll
                    for (int j = 0; j < 4; ++j) { const f32x4 w = *(const LAS f32x4*)(wt + o * 1024 + 4 * lane + 256 * j); s += (r.v[j][0] * w[0] + r.v[j][1] * w[1]) + (r.v[j][2] * w[2] + r.v[j][3] * w[3]); }
                    lg[o] = wave_sum(s) * rstd + (o < 4 ? bgr[o] : ber[o - 4]); }
                int gs = 0; float gm = lg[0];
#pragma unroll
                for (int o = 1; o < 4; ++o) if (lg[o] > gm) { gm = lg[o]; gs = o; }
                float den = 0.f;
#pragma unroll
                for (int o = 0; o < 4; ++o) den += __expf(lg[o] - gm);
                const float pg = 1.0f / den;
                float el[4];
#pragma unroll
                for (int o = 0; o < 4; ++o) { float v = lg[4 + o];
#pragma unroll
                    for (int g2 = 1; g2 < 4; ++g2) v = (gs == g2) ? lg[4 + 4 * g2 + o] : v;
                    el[o] = v; }
                int i0 = 0; float v0 = el[0];
#pragma unroll
                for (int o = 1; o < 4; ++o) if (el[o] > v0) { v0 = el[o]; i0 = o; }
                int i1 = -1; float v1 = -INFINITY;
#pragma unroll
                for (int o = 0; o < 4; ++o) if (o != i0 && el[o] > v1) { v1 = el[o]; i1 = o; }
                const float ex = __expf(v1 - v0); const float w0 = 1.0f / (1.0f + ex), w1 = ex * w0;
                if (lane == 0) { te[rl * 2] = gs * 4 + i0; te[rl * 2 + 1] = gs * 4 + i1; tc[rl * 2] = w0 * pg; tc[rl * 2 + 1] = w1 * pg; trs[rl] = rstd; }
            }
            if (MODE == 2) {
#pragma unroll
                for (int j = 0; j < 4; ++j) r.v[j] = r.v[j] * rstd * gv.v[j];
                row_store(OUT + (size_t)m * D, lane, r);
            }
          }
        }
        if (MODE == 1) {
            __syncthreads();
            if (tid < 16) { int c = 0; for (int q = 0; q < 512; ++q) if (te[q] == tid) { trank[q] = c; ++c; }
                ebase[tid] = c ? (int)__hip_atomic_fetch_add(cnt_cur + tid * 64, (unsigned)c, __ATOMIC_RELAXED, __HIP_MEMORY_SCOPE_AGENT) : 0; }
            __syncthreads();
            { const int q = tid, e = te[q], pos = ebase[e] + trank[q], tok = blk * 256 + (q >> 1);
              rowtok[(size_t)e * ECAP + pos] = (unsigned)tok; cwraw[(size_t)e * ECAP + pos] = tc[q]; rsraw[(size_t)e * ECAP + pos] = trs[q >> 1]; tokinfo[(size_t)tok * 2 + (q & 1)] = ((unsigned)e << 16) | (unsigned)pos; }
            __syncthreads();
        }
    }
    __syncthreads();
}

__device__ __forceinline__ void phase_router(const Params& p, LAS unsigned char* lds, int tid_, int wave, int G,
                                             const float* gvec, const float* wgr, const float* bgr, const float* wer, const float* ber, unsigned* cnt_cur) {
    int tid = tid_; asm volatile("" : "+v"(tid)); const int lane = tid & 63, r32 = lane & 31, hi = lane >> 5;
    const bf16_t* XB = (const bf16_t*)(p.ws + WS_XB); float* rsraw = (float*)(p.ws + WS_RSRAW);
    unsigned* tokinfo = (unsigned*)(p.ws + WS_TOKINFO);
    unsigned* rowtok = (unsigned*)(p.ws + WS_ROWTOK); float* cwraw = (float*)(p.ws + WS_CWRAW);
    constexpr int WROW = 2048 + 16;
    LAS unsigned char* Whi = lds; LAS unsigned char* Wlo = lds + 24 * WROW;
    LAS int* misc = (LAS int*)(lds + MISC_OFF);
    LAS int* te = misc + 1024; LAS float* tc = (LAS float*)(misc + 1536); LAS int* trank = misc + 2048; LAS int* ebase = misc + 2560; LAS float* trs = (LAS float*)(misc + 2600);
    auto put = [&](int sl, int k, float w) { const unsigned hb = cvt_pk_bf16(w, 0.f) & 0xffffu; const float wl = w - __uint_as_float(hb << 16); const unsigned lb = cvt_pk_bf16(wl, 0.f) & 0xffffu;
        *(LAS unsigned short*)(Whi + sl * WROW + k * 2) = (unsigned short)hb; *(LAS unsigned short*)(Wlo + sl * WROW + k * 2) = (unsigned short)lb; };
    for (int i = tid; i < 4 * 1024; i += NTHR) { const int k = i >> 2, eg = i & 3; const f32x4 w4 = *(const f32x4*)(wer + (size_t)k * 16 + 4 * eg); const float g = gvec[k];
#pragma unroll
        for (int j = 0; j < 4; ++j) { const int e = 4 * eg + j, q = (e & 3) + 4 * ((e >> 3) & 1) + 8 * ((e >> 2) & 1); put(8 + q, k, w4[j] * g); } }
    for (int k = tid; k < 1024; k += NTHR) { const f32x4 w4 = *(const f32x4*)(wgr + (size_t)k * 4); const float g = gvec[k];
#pragma unroll
        for (int j = 0; j < 4; ++j) { put(j, k, w4[j] * g); put(4 + j, k, w4[j] * g); } }
    __syncthreads();
    const int slot_row = r32 < 24 ? r32 : r32 - 8;
    const LAS unsigned char* wh = Whi + slot_row * WROW + hi * 16; const LAS unsigned char* wl_ = Wlo + slot_row * WROW + hi * 16;
    for (int blk = blockIdx.x; blk < T / 256; blk += G) {
        const int rl = wave * 32 + r32, m = blk * 256 + rl;
        const bf16_t* xr = XB + (size_t)m * D + hi * 8;
        f32x16 acc = (f32x16){}; float ss = 0.f;
        bf16x8 xa[4], xb[4];
#pragma unroll
        for (int q = 0; q < 4; ++q) xa[q] = *(const bf16x8*)(xr + q * 16);
#pragma unroll 1
        for (int t = 0; t < 16; t += 2) {
#pragma unroll
            for (int q = 0; q < 4; ++q) xb[q] = *(const bf16x8*)(xr + (t + 1) * 64 + q * 16);
#pragma unroll
            for (int q = 0; q < 4; ++q) { const bf16x8 ah = *(const LAS bf16x8*)(wh + t * 128 + q * 32), al = *(const LAS bf16x8*)(wl_ + t * 128 + q * 32);
                acc = __builtin_amdgcn_mfma_f32_32x32x16_bf16(ah, xa[q], acc, 0, 0, 0); acc = __builtin_amdgcn_mfma_f32_32x32x16_bf16(al, xa[q], acc, 0, 0, 0);
#pragma unroll
                for (int j = 0; j < 4; ++j) { const unsigned w = ((const unsigned*)&xa[q])[j]; const float a = bf_lo(w), b = bf_hi(w); ss += a * a + b * b; } }
            if (t + 2 < 16) {
#pragma unroll
                for (int q = 0; q < 4; ++q) xa[q] = *(const bf16x8*)(xr + (t + 2) * 64 + q * 16); }
#pragma unroll
            for (int q = 0; q < 4; ++q) { const bf16x8 ah = *(const LAS bf16x8*)(wh + (t + 1) * 128 + q * 32), al = *(const LAS bf16x8*)(wl_ + (t + 1) * 128 + q * 32);
                acc = __builtin_amdgcn_mfma_f32_32x32x16_bf16(ah, xb[q], acc, 0, 0, 0); acc = __builtin_amdgcn_mfma_f32_32x32x16_bf16(al, xb[q], acc, 0, 0, 0);
#pragma unroll
                for (int j = 0; j < 4; ++j) { const unsigned w = ((const unsigned*)&xb[q])[j]; const float a = bf_lo(w), b = bf_hi(w); ss += a * a + b * b; } }
        }
        ss += __shfl_xor(ss, 32);
        const float rstd = 1.0f / sqrtf(ss * (1.0f / D) + NORM_EPS);
        float lg[4];
#pragma unroll
        for (int o = 0; o < 4; ++o) lg[o] = acc[o] * rstd + bgr[o];
        int gs = 0; float gm = lg[0];
#pragma unroll
        for (int o = 1; o < 4; ++o) if (lg[o] > gm) { gm = lg[o]; gs = o; }
        float den = 0.f;
#pragma unroll
        for (int o = 0; o < 4; ++o) den += __expf(lg[o] - gm);
        const float pg = 1.0f / den;
        if ((gs >> 1) == hi) {
            float el[4];
#pragma unroll
            for (int o = 0; o < 4; ++o) el[o] = ((gs & 1) ? acc[8 + o] : acc[4 + o]) * rstd + ber[gs * 4 + o];
            int i0 = 0; float v0 = el[0];
#pragma unroll
            for (int o = 1; o < 4; ++o) if (el[o] > v0) { v0 = el[o]; i0 = o; }
            int i1 = -1; float v1 = -INFINITY;
#pragma unroll
            for (int o = 0; o < 4; ++o) if (o != i0 && el[o] > v1) { v1 = el[o]; i1 = o; }
            const float ex = __expf(v1 - v0); const float w0 = 1.0f / (1.0f + ex), w1 = ex * w0;
            te[rl * 2] = gs * 4 + i0; te[rl * 2 + 1] = gs * 4 + i1; tc[rl * 2] = w0 * pg; tc[rl * 2 + 1] = w1 * pg; trs[rl] = rstd;
        }
        __syncthreads();
        int myrank = 0; const int eq = te[tid];
        { LAS int* wcnt = misc + 3000;
#pragma unroll
          for (int ee = 0; ee < 16; ++ee) { const unsigned long long mk = __ballot(eq == ee); if (eq == ee) myrank = __popcll(mk & ((1ull << lane) - 1ull)); if (lane == 0) wcnt[wave * 16 + ee] = __popcll(mk); }
          __syncthreads();
          for (int w2 = 0; w2 < wave; ++w2) myrank += wcnt[w2 * 16 + eq];
          if (tid < 16) { int c = 0;
#pragma unroll
              for (int w2 = 0; w2 < 8; ++w2) c += wcnt[w2 * 16 + tid];
              ebase[tid] = c ? (int)__hip_atomic_fetch_add(cnt_cur + tid * 64, (unsigned)c, __ATOMIC_RELAXED, __HIP_MEMORY_SCOPE_AGENT) : 0; } }
        __syncthreads();
        { const int q = tid, e = eq, pos = ebase[e] + myrank, tok = blk * 256 + (q >> 1);
          rowtok[(size_t)e * ECAP + pos] = (unsigned)tok; cwraw[(size_t)e * ECAP + pos] = tc[q]; rsraw[(size_t)e * ECAP + pos] = trs[q >> 1]; tokinfo[(size_t)tok * 2 + (q & 1)] = ((unsigned)e << 16) | (unsigned)pos; }
        __syncthreads();
    }
    __syncthreads();
}

__device__ __forceinline__ void phase_conv(const Params& p, int gw, int NGW, int lane) {
    const bf16_t* BG = (const bf16_t*)(p.ws + WS_BG); const bf16_t* Z = (const bf16_t*)(p.ws + WS_Z); bf16_t* A2 = (bf16_t*)(p.ws + WS_CAT);
    const float* cw = p.in[16];
    float w0[16], w1[16], w2[16];
#pragma unroll
    for (int h = 0; h < 2; ++h)
#pragma unroll
        for (int j = 0; j < 8; ++j) { const int c = h * 512 + lane * 8 + j; w0[h * 8 + j] = cw[c]; w1[h * 8 + j] = cw[D + c]; w2[h * 8 + j] = cw[2 * D + c]; }
    for (int run = gw; run < T / 32; run += NGW) {
        const int t0 = run * 32;
        float zm1[16], zm2[16];
#pragma unroll
        for (int j = 0; j < 16; ++j) { zm1[j] = 0.f; zm2[j] = 0.f; }
        if ((t0 & (SEQ - 1)) != 0) {
#pragma unroll
            for (int h = 0; h < 2; ++h) { const u32x4 a = *(const u32x4*)(Z + (size_t)(t0 - 1) * D + h * 512 + lane * 8), b = *(const u32x4*)(Z + (size_t)(t0 - 2) * D + h * 512 + lane * 8);
#pragma unroll
                for (int q = 0; q < 4; ++q) { zm1[h * 8 + 2 * q] = bf_lo(a[q]); zm1[h * 8 + 2 * q + 1] = bf_hi(a[q]); zm2[h * 8 + 2 * q] = bf_lo(b[q]); zm2[h * 8 + 2 * q + 1] = bf_hi(b[q]); } }
        }
#pragma unroll 4
        for (int i = 0; i < 32; ++i) {
            const size_t rb = (size_t)(t0 + i) * D;
#pragma unroll
            for (int h = 0; h < 2; ++h) { const u32x4 zz = *(const u32x4*)(Z + rb + h * 512 + lane * 8), bb = *(const u32x4*)(BG + rb + h * 512 + lane * 8);
                float o[8];
#pragma unroll
                for (int q = 0; q < 4; ++q) {
#pragma unroll
                    for (int s = 0; s < 2; ++s) { const int j = h * 8 + 2 * q + s; const float zc = s ? bf_hi(zz[q]) : bf_lo(zz[q]), bg = s ? bf_hi(bb[q]) : bf_lo(bb[q]);
                        o[2 * q + s] = bg * (w0[j] * zm2[j] + w1[j] * zm1[j] + w2[j] * zc); zm2[j] = zm1[j]; zm1[j] = zc; } }
                u32x4 w; w.x = cvt_pk_bf16(o[0], o[1]); w.y = cvt_pk_bf16(o[2], o[3]); w.z = cvt_pk_bf16(o[4], o[5]); w.w = cvt_pk_bf16(o[6], o[7]);
                *(u32x4*)(A2 + rb + h * 512 + lane * 8) = w; }
        }
    }
}

__device__ __forceinline__ void phase_gate_scan(const Params& p, int gw, int NGW, int lane) {
    const float* gates = (const float*)(p.ws + WS_GATES);
    float* SA = (float*)(p.ws + WS_SA); float* SAM = (float*)(p.ws + WS_SAM); float* SBA = (float*)(p.ws + WS_SBA);
    for (int sq = gw; sq < NBATCH * 4; sq += NGW) {
        const int b = sq >> 2, hd = sq & 3; const float ib = p.in[7][hd], fb = p.in[8][hd];
        float carryB = 0.f, carryM = -INFINITY;
#pragma unroll 1
        for (int i0 = 0; i0 < 32; i0 += 8) {
            float lf[8], ig[8];
#pragma unroll
            for (int i = 0; i < 8; ++i) { const size_t t = (size_t)b * SEQ + 64 * (i0 + i) + lane; const float f = gates[t * 8 + 4 + hd] + fb; ig[i] = gates[t * 8 + hd] + ib;
                lf[i] = (f >= 0.f) ? -log1pf(expf(-f)) : (f - log1pf(expf(f))); }
#pragma unroll
            for (int i = 0; i < 8; ++i) {
                float sB = lf[i];
#pragma unroll
                for (int o = 1; o < 64; o <<= 1) { const float v = __shfl_up(sB, o); if (lane >= o) sB += v; }
                sB += carryB; carryB = __shfl(sB, 63);
                const float a = ig[i] - sB;
                float m = a;
#pragma unroll
                for (int o = 1; o < 64; o <<= 1) { const float v = __shfl_up(m, o); if (lane >= o) m = fmaxf(m, v); }
                m = fmaxf(m, carryM); carryM = __shfl(m, 63);
                const size_t o2 = (size_t)sq * SEQ + 64 * (i0 + i) + lane; SA[o2] = a; SAM[o2] = m; SBA[o2] = sB + m;
            }
        }
    }
}

struct TileRegs { u32x4 v[2]; };
__device__ __forceinline__ TileRegs tile_load(const bf16_t* src, int tid) { TileRegs r;
#pragma unroll
    for (int i = 0; i < 2; ++i) { const int n = tid + 512 * i, row = n >> 4, ch = n & 15; r.v[i] = *(const u32x4*)(src + (size_t)row * NP + ch * 8); } return r; }
__device__ __forceinline__ void tile_write(LAS unsigned char* dst, int tid, const TileRegs& r) {
#pragma unroll
    for (int i = 0; i < 2; ++i) { const int n = tid + 512 * i, row = n >> 4, ch = n & 15; *(LAS u32x4*)(dst + off_b(row, ch)) = r.v[i]; } }

__device__ __forceinline__ void glds16(const void* gsrc, unsigned lds_dst) { unsigned keep;
    asm volatile("s_mov_b32 %0, m0\n\ts_mov_b32 m0, %2\n\ts_nop 0\n\tglobal_load_lds_dwordx4 %1, off\n\ts_mov_b32 m0, %0" : "=&s"(keep) : "v"(gsrc), "s"(lds_dst) : "memory"); }
__device__ __forceinline__ void tile_dma(const bf16_t* src, LAS unsigned char* dst, int wave, int lane) {
#pragma unroll
    for (int i = 0; i < 2; ++i) { const int piece = 2 * wave + i, row = 4 * piece + (lane >> 4); const unsigned ch = (unsigned)(lane & 15) ^ ((((unsigned)lane >> 4) << 2) | ((unsigned)piece & 3u));
        glds16(src + (size_t)row * NP + ch * 8, (unsigned)__builtin_amdgcn_readfirstlane((int)(unsigned)(uintptr_t)(dst + piece * 1024))); }
}
#define WAIT_ALL_BAR() asm volatile("s_waitcnt vmcnt(0) lgkmcnt(0)\n\ts_barrier" ::: "memory")
__device__ __forceinline__ void attn_unit(const Params& p, LAS unsigned char* lds, int bh, int qblk, int tid_, int wave, int lane_) {
    int tid = tid_; asm volatile("" : "+v"(tid)); const int lane = tid & 63;
    const bf16_t* P = (const bf16_t*)(p.ws + WS_P); bf16_t* CAT = (bf16_t*)(p.ws + WS_CAT);
    const int b = bh >> 2, hd = bh & 3, map = wave >> 2, qs = wave & 3, r32 = lane & 31, hi = lane >> 5;
    const size_t rowbase = (size_t)b * SEQ;
    const int q0 = qblk * 128 + qs * 32, qrow = q0 + r32;
    const bf16_t* Kg = P + rowbase * NP + P_DK + hd * 128; const bf16_t* Vg = P + rowbase * NP + P_DV + hd * 128;
    { tile_dma(Kg, lds, wave, lane); tile_dma(Vg, lds + 16384, wave, lane); tile_dma(Kg + (size_t)64 * NP, lds + 32768, wave, lane); tile_dma(Vg + (size_t)64 * NP, lds + 49152, wave, lane); }
    LAS float* fs = (LAS float*)(lds + MISC_OFF) + MW_F;
    LAS float* tbl = fs;
    constexpr float LOG2E = 1.4426950408889634f;
    if (tid < 272) { const int n = tid - 64; int bk;
        if (n < 16) bk = n < 0 ? 0 : n; else { bk = 16; const int th[15] = {19, 21, 24, 27, 31, 35, 40, 46, 52, 59, 67, 77, 87, 99, 113};
#pragma unroll
            for (int j = 0; j < 15; ++j) bk += (n >= th[j]) ? 1 : 0; }
        tbl[tid] = n < 0 ? -INFINITY : p.in[1][bk * 4 + hd] * LOG2E; }
    bf16x8 qf[4];
    { const bf16_t* qp = P + (rowbase + qrow) * NP + P_DQ + hd * 128 + map * 64 + hi * 8;
#pragma unroll
      for (int ks = 0; ks < 4; ++ks) qf[ks] = *(const bf16x8*)(qp + ks * 16); }
    const int NS = qblk + 1;
    f32x16 o[4];
#pragma unroll
    for (int c = 0; c < 4; ++c) o[c] = (f32x16){};
    float mrun = -INFINITY, lrun = 0.f;
    const float bias_far = p.in[1][31 * 4 + hd] * LOG2E;
    const unsigned xr = ((unsigned)(r32 & 3) << 2) | ((unsigned)(r32 >> 2) & 3u);
    const unsigned q4 = (lane & 15) >> 2, pp = lane & 3, blk = (lane >> 4) & 1;
#ifndef ATT_DMA
#define ATT_DMA 5
#endif
#ifndef ATT_LATE_DMA
#define ATT_LATE_DMA 1
#endif
#if ATT_DMA == 2 || ATT_DMA == 4
#elif ATT_DMA
#else
    { TileRegs a0 = tile_load(Kg, tid), a1 = tile_load(Vg, tid), a2 = tile_load(Kg + (size_t)64 * NP, tid), a3 = tile_load(Vg + (size_t)64 * NP, tid);
      tile_write(lds, tid, a0); tile_write(lds + 16384, tid, a1); tile_write(lds + 32768, tid, a2); tile_write(lds + 49152, tid, a3); }
#endif
#if ATT_DMA == 5
    WAIT_ALL_BAR();
#endif
    asm volatile("" :: "v"(qf[0]), "v"(qf[1]), "v"(qf[2]), "v"(qf[3]));
#pragma unroll 1
    for (int st = 0; st < NS; ++st) {
        WAIT_ALL_BAR();
#if ATT_DMA == 2
        { LAS unsigned char* nb = lds + (st & 1) * 65536; const size_t ro = (size_t)st * 128 * NP;
            tile_dma(Kg + ro, nb, wave, lane); tile_dma(Vg + ro, nb + 16384, wave, lane); tile_dma(Kg + ro + (size_t)64 * NP, nb + 32768, wave, lane); tile_dma(Vg + ro + (size_t)64 * NP, nb + 49152, wave, lane); }
        WAIT_ALL_BAR();
#elif ATT_DMA == 3
#elif ATT_DMA
#if ATT_DMA == 4
        if (st == 0) { tile_dma(Kg, lds, wave, lane); tile_dma(Vg, lds + 16384, wave, lane); tile_dma(Kg + (size_t)64 * NP, lds + 32768, wave, lane); tile_dma(Vg + (size_t)64 * NP, lds + 49152, wave, lane); WAIT_ALL_BAR(); }
#endif
        if (!ATT_LATE_DMA && st + 1 < NS) { LAS unsigned char* nb = lds + ((st + 1) & 1) * 65536; const size_t ro = (size_t)(st + 1) * 128 * NP;
            tile_dma(Kg + ro, nb, wave, lane); tile_dma(Vg + ro, nb + 16384, wave, lane); tile_dma(Kg + ro + (size_t)64 * NP, nb + 32768, wave, lane); tile_dma(Vg + ro + (size_t)64 * NP, nb + 49152, wave, lane); }
#else
        TileRegs a0, a1;
        if (st + 1 < NS) { const size_t ro = (size_t)(st + 1) * 128 * NP; a0 = tile_load(Kg + ro, tid); a1 = tile_load(Vg + ro, tid); }
#endif
#pragma unroll
        for (int half = 0; half < 2; ++half) {
            const int j = 2 * st + half;
            const LAS unsigned char* Kt = lds + (st & 1) * 65536 + half * 32768; const LAS unsigned char* Vt = Kt + 16384;
            if (64 * j <= q0 + 31) {
                const int nmin = q0 - (64 * j + 63);
                const bool first = (mrun == -INFINITY);
                const float cinit = first ? 0.f : (nmin >= 113 ? bias_far - mrun : -mrun);
                f32x16 p0, p1;
#pragma unroll
                for (int r = 0; r < 16; ++r) { p0[r] = cinit; p1[r] = cinit; }
#pragma unroll
                for (int ks = 0; ks < 4; ++ks) { const unsigned ch = (unsigned)(8 * map + 2 * ks + hi) ^ xr;
                    const bf16x8 k0 = *(const LAS bf16x8*)(Kt + 256u * r32 + 16u * ch), k1 = *(const LAS bf16x8*)(Kt + 256u * (32 + r32) + 16u * ch);
                    p0 = __builtin_amdgcn_mfma_f32_32x32x16_bf16(k0, qf[ks], p0, 0, 0, 0); p1 = __builtin_amdgcn_mfma_f32_32x32x16_bf16(k1, qf[ks], p1, 0, 0, 0); }
                __builtin_amdgcn_sched_barrier(0);
                float rm = -INFINITY;
                if (first) {
                    if (nmin >= 113) {
#pragma unroll
                        for (int r = 0; r < 16; ++r) { p0[r] = p0[r] + bias_far; p1[r] = p1[r] + bias_far; rm = fmaxf(rm, fmaxf(p0[r], p1[r])); }
                    } else {
                        const LAS float* tb = tbl + (qrow - 64 * j - 4 * hi + 5);
#pragma unroll
                        for (int r = 0; r < 16; ++r) { const int e = (r & 3) + 8 * (r >> 2);
                            p0[r] += tb[59 - e]; p1[r] += tb[27 - e];
                            rm = fmaxf(rm, fmaxf(p0[r], p1[r])); }
                    }
                    { auto rr = __builtin_amdgcn_permlane32_swap(__float_as_uint(rm), __float_as_uint(rm), false, false); rm = fmaxf(__uint_as_float(rr[0]), __uint_as_float(rr[1])); }
                    mrun = rm;
#pragma unroll
                    for (int r = 0; r < 16; ++r) { p0[r] -= mrun; p1[r] -= mrun; }
                } else {
                    if (nmin < 113) {
                        const LAS float* tb = tbl + (qrow - 64 * j - 4 * hi + 5);
                        float bv0[16], bv1[16];
#pragma unroll
                        for (int r = 0; r < 16; ++r) { const int e = (r & 3) + 8 * (r >> 2); bv0[r] = tb[59 - e]; bv1[r] = tb[27 - e]; }
#pragma unroll
                        for (int r = 0; r < 16; ++r) { p0[r] += bv0[r]; p1[r] += bv1[r]; }
                    }
                    { float m0 = fmaxf(p0[0], p1[0]), m1 = fmaxf(p0[1], p1[1]);
#pragma unroll
                      for (int r = 2; r < 16; r += 2) { m0 = __builtin_fmaxf(__builtin_fmaxf(m0, p0[r]), p1[r]); m1 = __builtin_fmaxf(__builtin_fmaxf(m1, p0[r + 1]), p1[r + 1]); }
                      rm = fmaxf(m0, m1); }
                    { auto rr = __builtin_amdgcn_permlane32_swap(__float_as_uint(rm), __float_as_uint(rm), false, false); rm = fmaxf(__uint_as_float(rr[0]), __uint_as_float(rr[1])); }
                    if (__any(rm > 8.0f)) {
                        const float dl = fmaxf(rm, 0.f); const float alpha = fast_exp2(-dl);
                        lrun *= alpha; mrun += dl;
#pragma unroll
                        for (int r = 0; r < 16; ++r) { p0[r] -= dl; p1[r] -= dl; }
#pragma unroll
                        for (int c = 0; c < 4; ++c)
#pragma unroll
                            for (int r = 0; r < 16; ++r) o[c][r] *= alpha;
                    }
                }
                float psa = 0.f, psb = 0.f;
                bf16x8 pf[4];
#define ATT_EXPK(ks_) do { u32x4 w_; _Pragma("unroll") for (int q = 0; q < 4; ++q) { const int r = 8 * ((ks_) & 1) + 2 * q; \
                        const float ea = fast_exp2((ks_) < 2 ? p0[r] : p1[r]), eb = fast_exp2((ks_) < 2 ? p0[r + 1] : p1[r + 1]); psa += ea; psb += eb; w_[q] = cvt_pk_bf16(ea, eb); } \
                    pf[ks_] = __builtin_bit_cast(bf16x8, w_); } while (0)
                bf16x8 vf[2][4];
#define ATT_LOADV(buf, ks_) do { _Pragma("unroll") for (int c = 0; c < 4; ++c) { const unsigned chv = (unsigned)(4 * c + 2 * blk + (pp >> 1)); const unsigned row0 = 16u * (ks_) + 4u * hi + q4; \
                        vf[buf][c] = cat8(vtr(Vt + off_b(row0, chv) + 8u * (pp & 1)), vtr(Vt + off_b(row0 + 8u, chv) + 8u * (pp & 1))); } } while (0)
                ATT_LOADV(0, 0);
                ATT_EXPK(0);
                if (ATT_LATE_DMA && half == 0 && st + 1 < NS) {
                    LAS unsigned char* nb = lds + ((st + 1) & 1) * 65536; const size_t ro = (size_t)(st + 1) * 128 * NP;
                    tile_dma(Kg + ro, nb, wave, lane); tile_dma(Vg + ro, nb + 16384, wave, lane); tile_dma(Kg + ro + (size_t)64 * NP, nb + 32768, wave, lane); tile_dma(Vg + ro + (size_t)64 * NP, nb + 49152, wave, lane); }
#pragma unroll
                for (int ks = 0; ks < 4; ++ks) {
                    if (ks < 3) ATT_LOADV((ks + 1) & 1, ks + 1);
                    __builtin_amdgcn_sched_barrier(0);
#pragma unroll
                    for (int c = 0; c < 4; ++c) o[c] = __builtin_amdgcn_mfma_f32_32x32x16_bf16(vf[ks & 1][c], pf[ks], o[c], 0, 0, 0);
                    if (ks < 3) { ATT_EXPK(ks + 1); asm volatile("" : "+v"(pf[(ks + 1) & 3]), "+v"(psa), "+v"(psb)); }
                    __builtin_amdgcn_sched_barrier(0);
                }
                lrun += psa + psb;
#undef ATT_EXPK
#undef ATT_LOADV
            }
#if ATT_DMA == 5
            if (half == 0) WAIT_ALL_BAR();
#endif
#if !ATT_DMA
            if (st + 1 < NS) { LAS unsigned char* nb = lds + ((st + 1) & 1) * 65536 + half * 32768; tile_write(nb, tid, a0); tile_write(nb + 16384, tid, a1);
                if (half == 0) { const size_t ro = (size_t)(st + 1) * 128 * NP + (size_t)64 * NP; a0 = tile_load(Kg + ro, tid); a1 = tile_load(Vg + ro, tid); } }
#endif
        }
#if ATT_DMA == 3
        WAIT_ALL_BAR();
        if (st + 1 < NS) { LAS unsigned char* nb = lds + ((st + 1) & 1) * 65536; const size_t ro = (size_t)(st + 1) * 128 * NP;
            tile_dma(Kg + ro, nb, wave, lane); tile_dma(Vg + ro, nb + 16384, wave, lane); tile_dma(Kg + ro + (size_t)64 * NP, nb + 32768, wave, lane); tile_dma(Vg + ro + (size_t)64 * NP, nb + 49152, wave, lane); }
#endif

    }
    WAIT_ALL_BAR();
    lrun += __shfl_xor(lrun, 32);
    const float inv = 1.0f / lrun;
    float lam;
    { float s1 = 0.f, s2 = 0.f; const float a1 = p.in[10][lane] * p.in[11][lane], a2 = p.in[12][lane] * p.in[13][lane]; s1 = wave_sum(a1); s2 = wave_sum(a2);
      const float lam_init = 0.8f - 0.6f * 1.0f;
      lam = expf(s1) - expf(s2) + lam_init; }
    LAS float* xch = (LAS float*)lds + qs * 4096;
    if (map == 1) {
#pragma unroll
        for (int c = 0; c < 4; ++c)
#pragma unroll
            for (int r = 0; r < 16; ++r) xch[(32 * c + crow(r, hi)) * 32 + r32] = o[c][r] * inv * lam;
    }
    __syncthreads();
    if (map == 0) {
        float ss = 0.f;
#pragma unroll
        for (int c = 0; c < 4; ++c)
#pragma unroll
            for (int r = 0; r < 16; ++r) { const float v = o[c][r] * inv - xch[(32 * c + crow(r, hi)) * 32 + r32]; o[c][r] = v; ss += v * v; }
        ss += __shfl_xor(ss, 32);
        const float rstd = 1.0f / sqrtf(ss * (1.0f / 128.0f) + NORM_EPS) * 0.8f;
        const float* sub = p.in[14];
        bf16_t* orow = CAT + (rowbase + qrow) * D + 512 + hd * 128;
#pragma unroll
        for (int c = 0; c < 4; ++c)
#pragma unroll
            for (int rqp = 0; rqp < 4; rqp += 2) { u32x2 w[2];
#pragma unroll
                for (int h = 0; h < 2; ++h) { const int rq = rqp + h; const int e0 = 32 * c + 8 * rq + 4 * hi; const f32x4 sv = *(const f32x4*)(sub + e0);
                    w[h].x = cvt_pk_bf16(o[c][4 * rq] * rstd * sv[0], o[c][4 * rq + 1] * rstd * sv[1]); w[h].y = cvt_pk_bf16(o[c][4 * rq + 2] * rstd * sv[2], o[c][4 * rq + 3] * rstd * sv[3]); }
                const auto rx = __builtin_amdgcn_permlane32_swap(w[0].x, w[1].x, false, false); const auto ry = __builtin_amdgcn_permlane32_swap(w[0].y, w[1].y, false, false);
                u32x4 ww; ww.x = rx[0]; ww.y = ry[0]; ww.z = rx[1]; ww.w = ry[1];
                *(u32x4*)(orow + 32 * c + 8 * (rqp + hi)) = ww; }
    }
    __syncthreads();
}

__device__ __forceinline__ void mlstm_s1_unit(const Params& p, LAS unsigned char* lds, int bh, int c, int tid_, int wave, int lane_) {
    int tid = tid_; asm volatile("" : "+v"(tid)); const int lane = tid & 63;
    const bf16_t* P = (const bf16_t*)(p.ws + WS_P);
    const int b = bh >> 2, hd = bh & 3, r32 = lane & 31, hi = lane >> 5;
    const size_t t0 = (size_t)b * SEQ + (size_t)c * MCH;
    const float* SA = (const float*)(p.ws + WS_SA) + (size_t)bh * SEQ + c * MCH;
    LAS float* fs = (LAS float*)(lds + MISC_OFF) + MW_F;
    LAS float* wsm = fs;
    LAS float* red = fs + 256;
    float av = (tid < 256) ? SA[tid] : -INFINITY;
    float mx = av;
#pragma unroll
    for (int o = 1; o < 64; o <<= 1) mx = fmaxf(mx, __shfl_xor(mx, o));
    if (lane == 0) red[wave] = mx;
    __syncthreads();
    float R = red[0];
#pragma unroll
    for (int w = 1; w < 4; ++w) R = fmaxf(R, red[w]);
    if (tid < 256) wsm[tid] = __expf(av - R) * 0.08838834764831845f;
    __syncthreads();
    LAS unsigned char* Kl = lds; LAS unsigned char* Vl = lds + 65536;
    const bf16_t* Kg = P + t0 * NP + P_MK + hd * 128; const bf16_t* Vg = P + t0 * NP + P_MV + hd * 128;
#pragma unroll
    for (int i = 0; i < 8; ++i) { const int n = tid + 512 * i, row = n >> 4, ch = n & 15;
        const u32x4 kv = *(const u32x4*)(Kg + (size_t)row * NP + ch * 8); const u32x4 vv = *(const u32x4*)(Vg + (size_t)row * NP + ch * 8);
        const float w = wsm[row]; u32x4 ks;
#pragma unroll
        for (int q = 0; q < 4; ++q) ks[q] = cvt_pk_bf16(bf_lo(kv[q]) * w, bf_hi(kv[q]) * w);
        *(LAS u32x4*)(Kl + off_b(row, ch)) = ks; *(LAS u32x4*)(Vl + off_b(row, ch)) = vv; }
    __syncthreads();
    const int eb = wave >> 1, dh = wave & 1;
    const unsigned q4 = (lane & 15) >> 2, pp = lane & 3, blk = (lane >> 4) & 1;
    f32x16 acc[2]; acc[0] = (f32x16){}; acc[1] = (f32x16){};
    for (int ks = 0; ks < 16; ++ks) {
        const unsigned row0 = 16u * ks + 8u * hi + q4, row1 = row0 + 4u;
        const unsigned cha = (unsigned)(4 * eb + 2 * blk + (pp >> 1));
        const bf16x8 af = cat8(vtr(Vl + off_b(row0, cha) + 8u * (pp & 1)), vtr(Vl + off_b(row1, cha) + 8u * (pp & 1)));
#pragma unroll
        for (int db = 0; db < 2; ++db) { const unsigned chb = (unsigned)(4 * (2 * dh + db) + 2 * blk + (pp >> 1));
            const bf16x8 bfr = cat8(vtr(Kl + off_b(row0, chb) + 8u * (pp & 1)), vtr(Kl + off_b(row1, chb) + 8u * (pp & 1)));
            acc[db] = __builtin_amdgcn_mfma_f32_32x32x16_bf16(af, bfr, acc[db], 0, 0, 0); }
    }
    const int unit = bh * NCH + c;
    float* UT = (float*)(p.ws + WS_UT) + (size_t)unit * 16384;
#pragma unroll
    for (int db = 0; db < 2; ++db)
#pragma unroll
        for (int r = 0; r < 16; ++r) UT[(32 * eb + crow(r, hi)) * 128 + 64 * dh + 32 * db + r32] = acc[db][r];
    if (tid < 128) { float s = 0.f; const int d = tid;
        for (int srow = 0; srow < 256; ++srow) { const unsigned short hv = *(const LAS unsigned short*)(Kl + off_b(srow, d >> 3) + (d & 7) * 2); s += __uint_as_float((unsigned)hv << 16); }
        ((float*)(p.ws + WS_UN))[(size_t)unit * 128 + d] = s; }
    if (tid == 0) ((float*)(p.ws + WS_UR))[unit] = R;
    __syncthreads();
}

__device__ __forceinline__ void mlstm_s3_unit(const Params& p, LAS unsigned char* lds, int bh, int c, int tid_, int wave, int lane_) {
    int tid = tid_; asm volatile("" : "+v"(tid)); const int lane = tid & 63;
    const bf16_t* P = (const bf16_t*)(p.ws + WS_P); bf16_t* CAT = (bf16_t*)(p.ws + WS_CAT);
    const int b = bh >> 2, hd = bh & 3, r32 = lane & 31, hi = lane >> 5;
    const size_t t0 = (size_t)b * SEQ + (size_t)c * MCH;
    const size_t so = (size_t)bh * SEQ + c * MCH;
    const float* SA = (const float*)(p.ws + WS_SA) + so; const float* SAM = (const float*)(p.ws + WS_SAM) + so; const float* SBA = (const float*)(p.ws + WS_SBA) + so;
    LAS float* fs = (LAS float*)(lds + MISC_OFF) + MW_F;
    LAS float* as = fs;
    LAS float* nC = fs + 256;
    LAS unsigned char* Ct = lds + 65536;
    const int qloc = 32 * wave + r32;
    const float Aq = SAM[qloc], BAq = SBA[qloc];
    if (tid < 256) as[tid] = SA[tid];
    bf16x8 qf[8];
    { const bf16_t* qp = P + (t0 + qloc) * NP + P_MQ + hd * 128 + hi * 8;
#pragma unroll
      for (int ks = 0; ks < 8; ++ks) qf[ks] = *(const bf16x8*)(qp + ks * 16); }
    const bf16_t* Kg = P + t0 * NP + P_MK + hd * 128; const bf16_t* Vg = P + t0 * NP + P_MV + hd * 128;
#if defined(S3_REGSTAGE)
    { TileRegs k0 = tile_load(Kg, tid), v0 = tile_load(Vg, tid); tile_write(lds, tid, k0); tile_write(lds + 16384, tid, v0); }
#elif !defined(S3_SERIAL)
    tile_dma(Kg, lds, wave, lane); tile_dma(Vg, lds + 16384, wave, lane);
#endif
    f32x16 o[4];
#pragma unroll
    for (int cb = 0; cb < 4; ++cb) o[cb] = (f32x16){};
    float den = 0.f, fst = 0.f;
    const unsigned xr = ((unsigned)(r32 & 3) << 2) | ((unsigned)(r32 >> 2) & 3u);
    if (c > 0) {
        const float* UR = (const float*)(p.ws + WS_UR) + bh * NCH; const float* UT = (const float*)(p.ws + WS_UT) + (size_t)bh * NCH * 16384; const float* UN = (const float*)(p.ws + WS_UN) + (size_t)bh * NCH * 128;
        float Pref = -INFINITY, ur[7];
#pragma unroll
        for (int j = 0; j < 7; ++j) { ur[j] = UR[j]; if (j < c) Pref = fmaxf(Pref, ur[j]); }
        float cf[7];
#pragma unroll
        for (int j = 0; j < 7; ++j) cf[j] = (j < c) ? __expf(ur[j] - Pref) : 0.f;
#pragma unroll 1
        for (int i = 0; i < 4; ++i) { const int n = tid + 512 * i, e = n >> 4, ch = n & 15; f32x4 u0[7], u1[7];
#pragma unroll
            for (int j = 0; j < 7; ++j) { const f32x4* up = (const f32x4*)(UT + (size_t)j * 16384 + e * 128 + ch * 8); u0[j] = up[0]; u1[j] = up[1]; }
            f32x4 s0 = (f32x4){0.f, 0.f, 0.f, 0.f}, s1 = s0;
#pragma unroll
            for (int j = 0; j < 7; ++j) { s0 += u0[j] * cf[j]; s1 += u1[j] * cf[j]; }
            u32x4 w; w.x = cvt_pk_bf16(s0[0], s0[1]); w.y = cvt_pk_bf16(s0[2], s0[3]); w.z = cvt_pk_bf16(s1[0], s1[1]); w.w = cvt_pk_bf16(s1[2], s1[3]);
            *(LAS u32x4*)(Ct + off_b(e, ch)) = w; }
        if (tid < 128) { float sN = 0.f;
#pragma unroll
            for (int j = 0; j < 7; ++j) sN += cf[j] * UN[j * 128 + tid];
            nC[tid] = sN; }
        fst = __expf(Pref - Aq);
    }
    asm volatile("" :: "v"(qf[0]), "v"(qf[1]), "v"(qf[2]), "v"(qf[3]), "v"(qf[4]), "v"(qf[5]), "v"(qf[6]), "v"(qf[7]), "v"(Aq), "v"(BAq));
    WAIT_ALL_BAR();
    if (c > 0) {
#pragma unroll
        for (int cb = 0; cb < 4; ++cb) {
#pragma unroll
            for (int ks = 0; ks < 8; ++ks) { const unsigned ch = (unsigned)(2 * ks + hi) ^ xr;
                const bf16x8 cfr = *(const LAS bf16x8*)(Ct + 256u * (32 * cb + r32) + 16u * ch);
                o[cb] = __builtin_amdgcn_mfma_f32_32x32x16_bf16(cfr, qf[ks], o[cb], 0, 0, 0); }
            __builtin_amdgcn_sched_barrier(0); }
#pragma unroll
        for (int cb = 0; cb < 4; ++cb)
#pragma unroll
            for (int r = 0; r < 16; ++r) o[cb][r] *= fst;
        float dq = 0.f;
#pragma unroll
        for (int ks = 0; ks < 8; ++ks)
#pragma unroll
            for (int q = 0; q < 4; ++q) { const unsigned w = ((const unsigned*)&qf[ks])[q]; const int d = 16 * ks + 8 * hi + 2 * q; dq += bf_lo(w) * nC[d] + bf_hi(w) * nC[d + 1]; }
        den = fst * dq;
    }
    const unsigned q4 = (lane & 15) >> 2, pp = lane & 3, blk = (lane >> 4) & 1;
#pragma unroll 1
    for (int j = 0; j < 4; ++j) {
        WAIT_ALL_BAR();
        const LAS unsigned char* Kt = lds + (j & 1) * 32768; const LAS unsigned char* Vt = Kt + 16384;
#if defined(S3_REGSTAGE)
        TileRegs kr, vr; if (j + 1 < 4) { kr = tile_load(Kg + (size_t)(j + 1) * 64 * NP, tid); vr = tile_load(Vg + (size_t)(j + 1) * 64 * NP, tid); }
#elif defined(S3_SERIAL)
        { LAS unsigned char* nb = lds + (j & 1) * 32768; tile_dma(Kg + (size_t)j * 64 * NP, nb, wave, lane); tile_dma(Vg + (size_t)j * 64 * NP, nb + 16384, wave, lane); }
        WAIT_ALL_BAR();
#else
        if (j + 1 < 4) { LAS unsigned char* nb = lds + ((j + 1) & 1) * 32768; tile_dma(Kg + (size_t)(j + 1) * 64 * NP, nb, wave, lane); tile_dma(Vg + (size_t)(j + 1) * 64 * NP, nb + 16384, wave, lane); }
#endif
        const bool doit = (64 * j <= 32 * wave + 31);
        bf16x8 pf[4];
        if (doit) {
            f32x16 p0 = (f32x16){}, p1 = (f32x16){};
#pragma unroll
            for (int ks = 0; ks < 8; ++ks) { const unsigned ch = (unsigned)(2 * ks + hi) ^ xr;
                const bf16x8 k0 = *(const LAS bf16x8*)(Kt + 256u * r32 + 16u * ch), k1 = *(const LAS bf16x8*)(Kt + 256u * (32 + r32) + 16u * ch);
                p0 = __builtin_amdgcn_mfma_f32_32x32x16_bf16(k0, qf[ks], p0, 0, 0, 0); p1 = __builtin_amdgcn_mfma_f32_32x32x16_bf16(k1, qf[ks], p1, 0, 0, 0); if ((ks & 3) == 3) __builtin_amdgcn_sched_barrier(0); }
            float ps = 0.f;
#pragma unroll
            for (int r = 0; r < 16; ++r) { const int kv = 64 * j + crow(r, hi);
                const float w0 = (kv <= qloc) ? __expf(as[kv] - Aq) * 0.08838834764831845f : 0.f, w1 = (kv + 32 <= qloc) ? __expf(as[kv + 32] - Aq) * 0.08838834764831845f : 0.f;
                p0[r] *= w0; p1[r] *= w1; ps += p0[r] + p1[r]; }
            den += ps;
#pragma unroll
            for (int ks = 0; ks < 4; ++ks) { u32x4 w;
#pragma unroll
                for (int q = 0; q < 4; ++q) { const int r = 8 * (ks & 1) + 2 * q; w[q] = (ks < 2) ? cvt_pk_bf16(p0[r], p0[r + 1]) : cvt_pk_bf16(p1[r], p1[r + 1]); }
                pf[ks] = __builtin_bit_cast(bf16x8, w); }
        }
        WAIT_ALL_BAR();
        if (doit) {
            bf16x8 vf[2][4];
#define S3_LOADV(buf, ks_) do { _Pragma("unroll") for (int cb = 0; cb < 4; ++cb) { const unsigned chv = (unsigned)(4 * cb + 2 * blk + (pp >> 1)); const unsigned row0 = 16u * (ks_) + 4u * hi + q4; \
                vf[buf][cb] = cat8(vtr(Vt + off_b(row0, chv) + 8u * (pp & 1)), vtr(Vt + off_b(row0 + 8u, chv) + 8u * (pp & 1))); } } while (0)
            S3_LOADV(0, 0);
#pragma unroll
            for (int ks = 0; ks < 4; ++ks) {
                if (ks < 3) S3_LOADV((ks + 1) & 1, ks + 1);
                __builtin_amdgcn_sched_barrier(0);
#pragma unroll
                for (int cb = 0; cb < 4; ++cb) o[cb] = __builtin_amdgcn_mfma_f32_32x32x16_bf16(vf[ks & 1][cb], pf[ks], o[cb], 0, 0, 0);
                __builtin_amdgcn_sched_barrier(0);
            }
#undef S3_LOADV
        }
#if defined(S3_REGSTAGE)
        if (j + 1 < 4) { LAS unsigned char* nb = lds + ((j + 1) & 1) * 32768; tile_write(nb, tid, kr); tile_write(nb + 16384, tid, vr); }
#endif
    }
    den += __shfl_xor(den, 32);
    const float dinv = 1.0f / fmaxf(fabsf(den), __expf(-BAq));
    float sm = 0.f;
#pragma unroll
    for (int cb = 0; cb < 4; ++cb)
#pragma unroll
        for (int r = 0; r < 16; ++r) { o[cb][r] *= dinv; sm += o[cb][r]; }
    sm += __shfl_xor(sm, 32);
    const float mu = sm * (1.0f / 128.0f);
    float vs = 0.f;
#pragma unroll
    for (int cb = 0; cb < 4; ++cb)
#pragma unroll
        for (int r = 0; r < 16; ++r) { o[cb][r] -= mu; vs += o[cb][r] * o[cb][r]; }
    vs += __shfl_xor(vs, 32);
    const float rstd = 1.0f / sqrtf(vs * (1.0f / 128.0f) + NORM_EPS);
    const float* hn = p.in[9] + hd * 128;
    const bf16_t* mo = P + (t0 + qloc) * NP + P_MO + hd * 128;
    bf16_t* orow = CAT + (t0 + qloc) * D + hd * 128;
    u32x2 mw[4][4];
#pragma unroll
    for (int cb = 0; cb < 4; ++cb)
#pragma unroll
        for (int rq = 0; rq < 4; ++rq) mw[cb][rq] = *(const u32x2*)(mo + 32 * cb + 8 * rq + 4 * hi);
#pragma unroll
    for (int cb = 0; cb < 4; ++cb)
#pragma unroll
        for (int rq = 0; rq < 4; ++rq) { const int e0 = 32 * cb + 8 * rq + 4 * hi; const f32x4 hv = *(const f32x4*)(hn + e0); const u32x2 m2 = mw[cb][rq];
            const float g0 = fast_rcp(1.0f + __expf(-bf_lo(m2.x))), g1 = fast_rcp(1.0f + __expf(-bf_hi(m2.x))), g2 = fast_rcp(1.0f + __expf(-bf_lo(m2.y))), g3 = fast_rcp(1.0f + __expf(-bf_hi(m2.y)));
            u32x2 w; w.x = cvt_pk_bf16(o[cb][4 * rq] * rstd * hv[0] * g0, o[cb][4 * rq + 1] * rstd * hv[1] * g1); w.y = cvt_pk_bf16(o[cb][4 * rq + 2] * rstd * hv[2] * g2, o[cb][4 * rq + 3] * rstd * hv[3] * g3);
            *(u32x2*)(orow + e0) = w; }
    WAIT_ALL_BAR();
}

__device__ __forceinline__ void mlstm_seq_unit(const Params& p, LAS unsigned char* lds, int bh, int tid_, int wave, int lane_) {
    int tid = tid_; asm volatile("" : "+v"(tid)); const int lane = tid & 63;
    const bf16_t* P = (const bf16_t*)(p.ws + WS_P); bf16_t* CAT = (bf16_t*)(p.ws + WS_CAT);
    const int b = bh >> 2, hd = bh & 3, r32 = lane & 31, hi = lane >> 5;
    LAS float* fs = (LAS float*)(lds + MISC_OFF) + MW_F;
    LAS float* as = fs;
    LAS float* nC = fs + 256;
    LAS float* wsc = fs + 384;
    LAS unsigned char* Ct = lds + 65536;
    const unsigned xr = ((unsigned)(r32 & 3) << 2) | ((unsigned)(r32 >> 2) & 3u);
    const unsigned q4 = (lane & 15) >> 2, pp = lane & 3, blk = (lane >> 4) & 1;
    const int eb = wave >> 1, dh = wave & 1;
    f32x16 cacc[2]; cacc[0] = (f32x16){}; cacc[1] = (f32x16){};
    float nrun = 0.f;
    float Prun = -INFINITY;
    LAS float* hnl = fs + 896;
    if (tid < 128) hnl[tid] = p.in[9][hd * 128 + tid];
#pragma unroll 1
    for (int c = 0; c < NCH; ++c) {
        const size_t t0 = (size_t)b * SEQ + (size_t)c * MCH;
        const size_t so = (size_t)bh * SEQ + c * MCH;
        const float* SA = (const float*)(p.ws + WS_SA) + so; const float* SAM = (const float*)(p.ws + WS_SAM) + so; const float* SBA = (const float*)(p.ws + WS_SBA) + so;
        const int qloc = 32 * wave + r32;
        const float Aq2 = SAM[qloc] * 1.4426950408889634f;
        if (tid < 256) as[tid] = SA[tid] * 1.4426950408889634f;
        bf16x8 qf[2];
        LAS bf16x8* qpark = (LAS bf16x8*)(lds + 98304 + tid * 64);
        LAS bf16x8* qpark2 = (LAS bf16x8*)(lds + 147456 + tid * 32);
        { const bf16_t* qp = P + (t0 + qloc) * NP + P_MQ + hd * 128 + hi * 8;
#pragma unroll
          for (int ks = 0; ks < 2; ++ks) qf[ks] = *(const bf16x8*)(qp + ks * 16);
#pragma unroll
          for (int ks = 2; ks < 6; ++ks) qpark[ks - 2] = *(const bf16x8*)(qp + ks * 16);
#pragma unroll
          for (int ks = 6; ks < 8; ++ks) qpark2[ks - 6] = *(const bf16x8*)(qp + ks * 16); }
#define QFRAG(ks) ((ks) < 2 ? qf[(ks) & 1] : ((ks) < 6 ? qpark[((ks) - 2) & 3] : qpark2[((ks) - 6) & 1]))
        const bf16_t* Kg = P + t0 * NP + P_MK + hd * 128; const bf16_t* Vg = P + t0 * NP + P_MV + hd * 128;
        tile_dma(Kg, lds, wave, lane); tile_dma(Vg, lds + 16384, wave, lane);
        asm volatile("" :: "v"(qf[0]), "v"(qf[1]), "v"(Aq2));
        WAIT_ALL_BAR();
        float R = fmaxf(fmaxf(as[lane], as[lane + 64]), fmaxf(as[lane + 128], as[lane + 192]));
#pragma unroll
        for (int o = 1; o < 64; o <<= 1) R = fmaxf(R, __shfl_xor(R, o));
        R *= (1.0f / 1.4426950408889634f);
        const float Pnew = fmaxf(Prun, R);
        const float scC = (c > 0) ? __expf(Prun - Pnew) : 0.f;
        if (tid < 256) wsc[tid] = fast_exp2(as[tid] - Pnew * 1.4426950408889634f) * 0.08838834764831845f;
        f32x16 o[4];
#pragma unroll
        for (int cb = 0; cb < 4; ++cb) o[cb] = (f32x16){};
        float den = 0.f;
        if (c > 0) {
#pragma unroll
            for (int cb = 0; cb < 4; ++cb) {
#pragma unroll
                for (int ks = 0; ks < 8; ++ks) { const unsigned ch = (unsigned)(2 * ks + hi) ^ xr;
                    const bf16x8 cfr = *(const LAS bf16x8*)(Ct + 256u * (32 * cb + r32) + 16u * ch);
                    const bf16x8 qv = QFRAG(ks);
                    o[cb] = __builtin_amdgcn_mfma_f32_32x32x16_bf16(cfr, qv, o[cb], 0, 0, 0); }
                __builtin_amdgcn_sched_barrier(0); }
            const float fst = fast_exp2(Prun * 1.4426950408889634f - Aq2);
#pragma unroll
            for (int cb = 0; cb < 4; ++cb)
#pragma unroll
                for (int r = 0; r < 16; ++r) o[cb][r] *= fst;
            float dq = 0.f;
#pragma unroll
            for (int ks = 0; ks < 8; ++ks) { const bf16x8 qv = QFRAG(ks);
#pragma unroll
                for (int q = 0; q < 4; ++q) { const unsigned w = ((const unsigned*)&qv)[q]; const int d = 16 * ks + 8 * hi + 2 * q; dq += bf_lo(w) * nC[d] + bf_hi(w) * nC[d + 1]; } }
            den = fst * dq;
#pragma unroll
            for (int r = 0; r < 16; ++r) { cacc[0][r] *= scC; cacc[1][r] *= scC; }
        }
        nrun *= scC;
#pragma unroll 1
        for (int j = 0; j < 4; ++j) {
            WAIT_ALL_BAR();
            const LAS unsigned char* Kt = lds + (j & 1) * 32768; const LAS unsigned char* Vt = Kt + 16384;
            if (j + 1 < 4) { LAS unsigned char* nb = lds + ((j + 1) & 1) * 32768; tile_dma(Kg + (size_t)(j + 1) * 64 * NP, nb, wave, lane); tile_dma(Vg + (size_t)(j + 1) * 64 * NP, nb + 16384, wave, lane); }
            const bool doit = (64 * j <= 32 * wave + 31);
            if (doit) {
                float ps = 0.f;
#pragma unroll
                for (int hf = 0; hf < 2; ++hf) {
                    f32x16 pp0 = (f32x16){};
#pragma unroll
                    for (int ks = 0; ks < 8; ++ks) { const unsigned ch = (unsigned)(2 * ks + hi) ^ xr;
                        const bf16x8 k0 = *(const LAS bf16x8*)(Kt + 256u * (32 * hf + r32) + 16u * ch);
                        const bf16x8 qv = QFRAG(ks);
                        pp0 = __builtin_amdgcn_mfma_f32_32x32x16_bf16(k0, qv, pp0, 0, 0, 0); }
#pragma unroll
                    for (int r = 0; r < 16; ++r) { const int kv = 64 * j + 32 * hf + crow(r, hi);
                        const float w0 = (kv <= qloc) ? fast_exp2(as[kv] - Aq2) * 0.08838834764831845f : 0.f;
                        pp0[r] *= w0; ps += pp0[r]; }
                    bf16x8 pfh[2];
#pragma unroll
                    for (int k2 = 0; k2 < 2; ++k2) { u32x4 w;
#pragma unroll
                        for (int q = 0; q < 4; ++q) { const int r = 8 * k2 + 2 * q; w[q] = cvt_pk_bf16(pp0[r], pp0[r + 1]); }
                        pfh[k2] = __builtin_bit_cast(bf16x8, w); }
                    __builtin_amdgcn_sched_barrier(0);
#pragma unroll
                    for (int k2 = 0; k2 < 2; ++k2)
#pragma unroll
                        for (int c2 = 0; c2 < 2; ++c2) {
                            bf16x8 vf[2];
#pragma unroll
                            for (int u = 0; u < 2; ++u) { const int cb = 2 * c2 + u; const unsigned chv = (unsigned)(4 * cb + 2 * blk + (pp >> 1)); const unsigned row0 = 16u * (2 * hf + k2) + 4u * hi + q4;
                                vf[u] = cat8(vtr(Vt + off_b(row0, chv) + 8u * (pp & 1)), vtr(Vt + off_b(row0 + 8u, chv) + 8u * (pp & 1))); }
                            o[2 * c2] = __builtin_amdgcn_mfma_f32_32x32x16_bf16(vf[0], pfh[k2], o[2 * c2], 0, 0, 0); o[2 * c2 + 1] = __builtin_amdgcn_mfma_f32_32x32x16_bf16(vf[1], pfh[k2], o[2 * c2 + 1], 0, 0, 0);
                            __builtin_amdgcn_sched_barrier(0);
                        }
                }
                den += ps;
            }
#pragma unroll
            for (int ks = 0; ks < 4; ++ks) {
                const unsigned row0 = 16u * ks + 8u * hi + q4, row1 = row0 + 4u;
                const unsigned cha = (unsigned)(4 * eb + 2 * blk + (pp >> 1));
                const bf16x8 af = cat8(vtr(Vt + off_b(row0, cha) + 8u * (pp & 1)), vtr(Vt + off_b(row1, cha) + 8u * (pp & 1)));
                const f32x4 wa = *(const LAS f32x4*)(wsc + 64 * j + 16 * ks + 8 * hi), wb = *(const LAS f32x4*)(wsc + 64 * j + 16 * ks + 8 * hi + 4);
#pragma unroll
                for (int db = 0; db < 2; ++db) { const unsigned chb = (unsigned)(4 * (2 * dh + db) + 2 * blk + (pp >> 1));
                    const s16x4 k0 = vtr(Kt + off_b(row0, chb) + 8u * (pp & 1)), k1 = vtr(Kt + off_b(row1, chb) + 8u * (pp & 1));
                    const u32x2 u0 = __builtin_bit_cast(u32x2, k0), u1 = __builtin_bit_cast(u32x2, k1);
                    u32x4 kw; kw.x = cvt_pk_bf16(bf_lo(u0.x) * wa[0], bf_hi(u0.x) * wa[1]); kw.y = cvt_pk_bf16(bf_lo(u0.y) * wa[2], bf_hi(u0.y) * wa[3]);
                    kw.z = cvt_pk_bf16(bf_lo(u1.x) * wb[0], bf_hi(u1.x) * wb[1]); kw.w = cvt_pk_bf16(bf_lo(u1.y) * wb[2], bf_hi(u1.y) * wb[3]);
                    cacc[db] = __builtin_amdgcn_mfma_f32_32x32x16_bf16(af, __builtin_bit_cast(bf16x8, kw), cacc[db], 0, 0, 0); }
                __builtin_amdgcn_sched_barrier(0);
            }
            { const int d = tid & 127, sq = tid >> 7; float sN = 0.f;
#pragma unroll 4
                for (int s2 = 0; s2 < 16; ++s2) { const int srow = 16 * sq + s2; const unsigned short hv = *(const LAS unsigned short*)(Kt + off_b(srow, d >> 3) + (d & 7) * 2); sN += __uint_as_float((unsigned)hv << 16) * wsc[64 * j + srow]; }
                nrun += sN; }
            WAIT_ALL_BAR();
        }
        int tid2 = tid_; asm volatile("" : "+v"(tid2));
        const int qloc2 = 32 * wave + (tid2 & 31), hi2 = (tid2 >> 5) & 1;
        const float BAq = SBA[qloc2];
        den += __shfl_xor(den, 32);
        const float dinv = 1.0f / fmaxf(fabsf(den), __expf(-BAq));
        float sm = 0.f;
#pragma unroll
        for (int cb = 0; cb < 4; ++cb)
#pragma unroll
            for (int r = 0; r < 16; ++r) { o[cb][r] *= dinv; sm += o[cb][r]; }
        sm += __shfl_xor(sm, 32);
        const float mu = sm * (1.0f / 128.0f);
        float vs = 0.f;
#pragma unroll
        for (int cb = 0; cb < 4; ++cb)
#pragma unroll
            for (int r = 0; r < 16; ++r) { o[cb][r] -= mu; vs += o[cb][r] * o[cb][r]; }
        vs += __shfl_xor(vs, 32);
        const float rstd = 1.0f / sqrtf(vs * (1.0f / 128.0f) + NORM_EPS);
        const bf16_t* mo = P + (t0 + qloc2) * NP + P_MO + hd * 128 + 4 * hi2;
        bf16_t* orow0 = CAT + (t0 + qloc2) * D + hd * 128;
#pragma unroll
        for (int c2 = 0; c2 < 2; ++c2) {
            u32x2 mw[8]; u32x2 wk = {0u, 0u};
#pragma unroll
            for (int u = 0; u < 8; u += 2) { const u32x4 g4 = *(const u32x4*)(mo - 4 * hi2 + 32 * (2 * c2 + (u >> 2)) + 8 * ((u & 3) + hi2));
                const auto rx = __builtin_amdgcn_permlane32_swap(g4.x, g4.z, false, false); const auto ry = __builtin_amdgcn_permlane32_swap(g4.y, g4.w, false, false);
                mw[u].x = rx[0]; mw[u].y = ry[0]; mw[u + 1].x = rx[1]; mw[u + 1].y = ry[1]; }
#pragma unroll
            for (int u = 0; u < 8; ++u) { const int cb = 2 * c2 + (u >> 2), rq = u & 3; const int e0 = 32 * cb + 8 * rq; const u32x2 m2 = mw[u]; const f32x4 hv = *(const LAS f32x4*)(hnl + e0 + 4 * hi2);
                const float g0 = fast_rcp(1.0f + fast_exp2(-1.4426950408889634f * bf_lo(m2.x))), g1 = fast_rcp(1.0f + fast_exp2(-1.4426950408889634f * bf_hi(m2.x))), g2 = fast_rcp(1.0f + fast_exp2(-1.4426950408889634f * bf_lo(m2.y))), g3 = fast_rcp(1.0f + fast_exp2(-1.4426950408889634f * bf_hi(m2.y)));
                u32x2 w; w.x = cvt_pk_bf16(o[cb][4 * rq] * rstd * hv[0] * g0, o[cb][4 * rq + 1] * rstd * hv[1] * g1); w.y = cvt_pk_bf16(o[cb][4 * rq + 2] * rstd * hv[2] * g2, o[cb][4 * rq + 3] * rstd * hv[3] * g3);
                if ((u & 1) == 0) wk = w;
                else { const auto sx = __builtin_amdgcn_permlane32_swap(wk.x, w.x, false, false); const auto sy = __builtin_amdgcn_permlane32_swap(wk.y, w.y, false, false);
                    u32x4 ww; ww.x = sx[0]; ww.y = sy[0]; ww.z = sx[1]; ww.w = sy[1];
                    *(u32x4*)(orow0 + 32 * cb + 8 * (rq - 1 + hi2)) = ww; } }
            __builtin_amdgcn_sched_barrier(0); }
        if (c + 1 < NCH) {
#pragma unroll
            for (int db = 0; db < 2; ++db)
#pragma unroll
                for (int r = 0; r < 16; ++r) { const int e = 32 * eb + crow(r, hi), d = 64 * dh + 32 * db + r32;
                    *(LAS unsigned short*)(Ct + off_b(e, d >> 3) + (d & 7) * 2) = (unsigned short)(cvt_pk_bf16(cacc[db][r], 0.f) & 0xffffu); }
            wsc[tid] = nrun;
        }
        Prun = Pnew;
        WAIT_ALL_BAR();
        if (c + 1 < NCH) { if (tid < 128) nC[tid] = (wsc[tid] + wsc[tid + 128]) + (wsc[tid + 256] + wsc[tid + 384]); }
    }
#undef QFRAG
}

__device__ __forceinline__ int moe_table(LAS unsigned char* lds, unsigned* cnt, int tid) {
    LAS int* misc = (LAS int*)(lds + MISC_OFF);
    __syncthreads();
    if (tid == 0) { int acc = 0; for (int e = 0; e < 16; ++e) { const int c = (int)__hip_atomic_load(cnt + e * 64, __ATOMIC_RELAXED, __HIP_MEMORY_SCOPE_AGENT); misc[MW_CN + e] = c; misc[MW_TB + e] = acc; acc += (c + 255) >> 8; } misc[MW_TB + 16] = acc; }
    __syncthreads();
    return misc[MW_TB + 16];
}

#ifndef STAGGER_MASK
#define STAGGER_MASK 0u
#endif
#ifndef STAGGER_GROUPS
#define STAGGER_GROUPS 4
#endif
#ifndef STAGGER_TICKS
#define STAGGER_TICKS 700
#endif
__device__ __forceinline__ void stagger(int vcu, int phase_bit) {
    if (!((STAGGER_MASK >> phase_bit) & 1u)) return;
    const int g = vcu & (STAGGER_GROUPS - 1); if (g == 0) return;
    const unsigned long long t0 = __builtin_amdgcn_s_memrealtime(); const unsigned long long w = (unsigned long long)g * STAGGER_TICKS;
    while (__builtin_amdgcn_s_memrealtime() - t0 < w) __builtin_amdgcn_s_sleep(8);
}
constexpr int LATE_UNITS = 224, LATE_UNITS_A = 160, LATE_UNITS_B = 64, CW_LATEQ = CW_QUEUE + 64 * 8;
template <int QID>
__device__ __forceinline__ void late_convert(const Params& p, LAS unsigned char* lds, unsigned* ctl, int quota, int tid, int wave, int lane) {
    volatile LAS unsigned* misc = (volatile LAS unsigned*)(lds + MISC_OFF);
    for (int k = 0; k < quota; ++k) {
        __syncthreads();
        if (tid == 0) misc[MW_Q] = __hip_atomic_fetch_add(ctl + CW_LATEQ + 64 * QID, 1u, __ATOMIC_RELAXED, __HIP_MEMORY_SCOPE_AGENT);
        __syncthreads();
        const int q = (int)misc[MW_Q];
        if (q >= 4 * (QID == 0 ? LATE_UNITS_A : LATE_UNITS_B)) break;
        const int c = q >> 2, sub = q & 3;
        const int v = QID == 0 ? (c < 32 ? 8 + c : 232 + 12 * ((c - 32) >> 3) + ((c - 32) & 7)) : 232 + 12 * (c >> 2) + 8 + (c & 3);
        const int f = WT_I1 + 64 * v + 16 * sub + 2 * wave;
        phase_prologue_weights(p, lds, f, f + 2, 1, wave, lane);
    }
    __syncthreads();
}
template <int LAYER>
__device__ __forceinline__ void moe_block(const Params& p, LAS unsigned char* lds, const XcdBarrier& bar, unsigned* ctl, int tid, int wave, int lane, int vcu, int G) {
    unsigned char* ws = p.ws;
    const LAS int* tb = (const LAS int*)(lds + MISC_OFF) + MW_TB; const LAS int* cn = (const LAS int*)(lds + MISC_OFF) + MW_CN;
    unsigned* cnt = ctl + CW_CNT + LAYER * 16 * 64;
    if (PH(12)) phase_router(p, lds, tid, wave, G, p.in[3] + LAYER * D, p.in[18] + (size_t)LAYER * D * 4, p.in[19] + LAYER * 4, p.in[20] + (size_t)LAYER * D * 16, p.in[21] + LAYER * 16, cnt);
    xcd_barrier(bar);
    const int ntot = moe_table(lds, cnt, tid);
    stagger(vcu, 13);
    for (int rep_ = 0; rep_ < REPS(13); ++rep_) if (PH(13)) { pg8::MoeSched<true> S{(const char*)(ws + WS_XB8), (const char*)(ws + WS_WGU) + (size_t)LAYER * 16 * 1024 * 1024, 512, (size_t)1024 * 1024, tb, cn, (const unsigned*)(ws + WS_ROWTOK), ntot, vcu, G};
      pg8::EpiPair<1> E{nullptr, (bf16_t*)(ws + WS_HM), FF, (const float*)(ws + WS_RSRAW), (const unsigned*)(ws + WS_ROWTOK), tb, cn};
      pg8::gemm_phase<pg8::EpiPair<1>, pg8::MoeSched<true>, true, true>(lds, 512, S, E); }
    const int nun = ntot * 4, rounds_max = (nun + G - 1) / G, rounds_mine = nun > vcu ? (nun - vcu + G - 1) / G : 0;
    if (LATE_CV && LAYER == 0 && PH(0)) late_convert<0>(p, lds, ctl, 2 * (rounds_max - rounds_mine), tid, wave, lane);
    if (LATE_CV && LAYER == 1 && PH(0)) { late_convert<1>(p, lds, ctl, 2 * (rounds_max - rounds_mine), tid, wave, lane); late_convert<1>(p, lds, ctl, 1 << 20, tid, wave, lane); }
    xcd_barrier(bar);
    stagger(vcu, 14);
    for (int rep_ = 0; rep_ < REPS(14); ++rep_) if (PH(14)) { pg8::MoeSched<false> S{(const char*)(ws + WS_HM), (const char*)(ws + WS_WD) + (size_t)LAYER * 16 * 1024 * 512, 256, (size_t)1024 * 512, tb, cn, nullptr, ntot, vcu, G};
      pg8::EpiDown E{(unsigned char*)(ws + WS_YC), (const float*)(ws + WS_CWRAW), tb, cn};
      pg8::gemm_phase<pg8::EpiDown, pg8::MoeSched<false>, false, true>(lds, 256, S, E); }
    if (LATE_CV && LAYER == 0 && PH(0)) { late_convert<0>(p, lds, ctl, rounds_max - rounds_mine, tid, wave, lane); late_convert<0>(p, lds, ctl, 1 << 20, tid, wave, lane); }
    xcd_barrier(bar);
}

__global__ void __launch_bounds__(NTHR, 2) fwd_kernel(Params p) {
    extern __shared__ __attribute__((aligned(16))) unsigned char lds_raw[];
    LAS unsigned char* lds = (LAS unsigned char*)lds_raw;
    const int tid = threadIdx.x, lane = tid & 63, wave = __builtin_amdgcn_readfirstlane(tid >> 6);
    const int G = gridDim.x; const int bx = blockIdx.x;
    const int vcu = (G % 8 == 0) ? (bx % 8) * (G / 8) + bx / 8 : bx;
    const int gw = vcu * NWAVES + wave, NGW = G * NWAVES;
    volatile LAS unsigned* misc = (volatile LAS unsigned*)(lds + MISC_OFF);
    for (int u = tid; u < (LDS_BYTES - MISC_OFF) / 4; u += NTHR) misc[u] = 0u;
    __syncthreads();
    unsigned* ctl = (unsigned*)(p.ws + WS_CTL);
    XcdBarrier bar = xcd_barrier_post(ctl + CW_BAR, misc + MW_BAR);
    unsigned char* ws = p.ws;

    for (int rep_ = 0; rep_ < REPS(0); ++rep_) if (PH(0)) phase_prologue_weights(p, lds, gw, WT_I1, NGW, wave, lane);
    __syncthreads();
    for (int rep_ = 0; rep_ < REPS(1); ++rep_) if (PH(1)) phase_norm_gates(p, lds, tid, gw, NGW, lane);
    xcd_barrier(bar);

    if (PH(2)) phase_gate_scan(p, gw, NGW, lane);
    stagger(vcu, 3);
    for (int rep_ = 0; rep_ < REPS(3); ++rep_) if (PH(3)) { pg8::DenseSched S; S.init(ws + WS_H, ws + WS_WT1, T, NP, 1024, G, bx); pg8::EpiBf16 E{(bf16_t*)(ws + WS_P), NP};
      pg8::gemm_phase<pg8::EpiBf16, pg8::DenseSched, false>(lds, 1024, S, E); }
    xcd_barrier(bar);

    {
        constexpr int NSEQ = NBATCH * 4, NAT = NBATCH * 4 * 16, NMEM = LATE_CV ? WT_UNITS - LATE_UNITS : WT_UNITS;
        for (int u = bx; u < NSEQ; u += G) { for (int r2 = 0; r2 < REPS(16); ++r2) if (PH(4)) mlstm_seq_unit(p, lds, u, tid, wave, lane); }
        for (int rep_ = 0; rep_ < REPS(4); ++rep_) {
            bool a_done = false, m_done = false; int sa_cnt = 0, sm_cnt = 0; (void)sa_cnt; (void)sm_cnt;
            for (int it = 0; !(a_done && m_done); ++it) {
                const int r5 = it % 5; bool want_mem = (r5 == 1 || r5 == 3);
                if (want_mem && m_done) want_mem = false; else if (!want_mem && a_done) want_mem = true;
                __syncthreads();
#ifdef STATIC_Q
                if (tid == 0) { misc[MW_Q] = (unsigned)((want_mem ? sm_cnt : sa_cnt) * G + bx); }
                if (want_mem) ++sm_cnt; else ++sa_cnt;
#else
                if (tid == 0) misc[MW_Q] = __hip_atomic_fetch_add(ctl + CW_QUEUE + 64 * (2 * rep_ + (want_mem ? 1 : 0)), 1u, __ATOMIC_RELAXED, __HIP_MEMORY_SCOPE_AGENT);
#endif
                __syncthreads();
                const int u = (int)misc[MW_Q];
                if (want_mem) {
                    if (u >= NMEM) { m_done = true; continue; }
                    { const int v = LATE_CV ? (u < 8 ? u : u + 32) : u;        for (int r2 = 0; r2 < REPS(18); ++r2) if (PH(0)) { const int f = WT_I1 + 64 * v + 8 * wave; phase_prologue_weights(p, lds, f, f + 8, 1, wave, lane); } }
                } else {
                    if (u >= NAT) { a_done = true; continue; }
                    for (int r2 = 0; r2 < REPS(17); ++r2) if (PH(5)) attn_unit(p, lds, u & 127, 15 - (u >> 7), tid, wave, lane);
                }
            }
        }
    }
    xcd_barrier(bar);

    for (int rep_ = 0; rep_ < REPS(7); ++rep_) if (PH(7)) { pg8::DenseSched S; S.init(ws + WS_CAT, ws + WS_WT2, T, 1024, 1024, G, bx); pg8::EpiResid<true> E{p.in[0], (bf16_t*)(ws + WS_XB), ws + WS_XB8};
      pg8::gemm_phase<pg8::EpiResid<true>, pg8::DenseSched, false>(lds, 1024, S, E); }
    xcd_barrier(bar);

    moe_block<0>(p, lds, bar, ctl, tid, wave, lane, vcu, G);
    if (PH(8)) phase_rows<0, true>(p, lds, tid, wave, lane, G, p.in[2] + D, nullptr, nullptr, nullptr, nullptr, ctl + CW_CNT, nullptr);
    xcd_barrier(bar);
    stagger(vcu, 9);
    for (int rep_ = 0; rep_ < REPS(9); ++rep_) if (PH(9)) { pg8::DenseSched S; S.init(G3_F8 ? ws + WS_XB8 : ws + WS_XB, ws + WS_WT3, T, 3072, G3_F8 ? 512 : 1024, G, bx); pg8::EpiPair<0> E{(bf16_t*)(ws + WS_BG), (bf16_t*)(ws + WS_Z), D, (const float*)(ws + WS_RSTD), nullptr, nullptr, nullptr};
      pg8::gemm_phase<pg8::EpiPair<0>, pg8::DenseSched, false, G3_F8 != 0>(lds, G3_F8 ? 512 : 1024, S, E); }
    xcd_barrier(bar);
    for (int rep_ = 0; rep_ < REPS(10); ++rep_) if (PH(10)) phase_conv(p, gw, NGW, lane);
    xcd_barrier(bar);
    if (PH(11)) { pg8::DenseSched S; S.init(ws + WS_CAT, ws + WS_WT4, T, 1024, 1024, G, bx); pg8::EpiResid<false> E{nullptr, (bf16_t*)(ws + WS_XB), ws + WS_XB8};
      pg8::gemm_phase<pg8::EpiResid<false>, pg8::DenseSched, false>(lds, 1024, S, E); }
    xcd_barrier(bar);
    moe_block<1>(p, lds, bar, ctl, tid, wave, lane, vcu, G);
    if (PH(15)) phase_rows<2, true>(p, lds, tid, wave, lane, G, p.in[4], nullptr, nullptr, nullptr, nullptr, ctl + CW_CNT + 16 * 64, nullptr);
}

extern "C" void kernel_launch(void* const* d_in, const int* in_sizes, int n_in, void* d_out, int out_size, void* d_ws, size_t ws_size, hipStream_t stream) {
    static int grid = 0;
    if (grid == 0) {
        if (n_in != 25 || in_sizes[0] != T * D || out_size != T * D || ws_size < WS_END) { fprintf(stderr, "kernel_launch: unexpected shapes (n_in %d, in0 %d, out %d, ws %zu)\n", n_in, n_in > 0 ? in_sizes[0] : -1, out_size, ws_size); grid = -1; return; }
        int dev = 0, cus = 0, per_cu = 0;
        if (hipGetDevice(&dev) != hipSuccess || hipDeviceGetAttribute(&cus, hipDeviceAttributeMultiprocessorCount, dev) != hipSuccess) { grid = -1; return; }
        if (hipFuncSetAttribute((const void*)fwd_kernel, hipFuncAttributeMaxDynamicSharedMemorySize, LDS_BYTES) != hipSuccess) { fprintf(stderr, "kernel_launch: hipFuncSetAttribute failed\n"); grid = -1; return; }
        if (hipOccupancyMaxActiveBlocksPerMultiprocessor(&per_cu, (const void*)fwd_kernel, NTHR, LDS_BYTES) != hipSuccess || per_cu < 1) fprintf(stderr, "kernel_launch: occupancy query reports %d\n", per_cu);
        (void)hipGetLastError();
        grid = cus;
    }
    if (grid < 0) return;
    hipMemsetAsync((char*)d_ws + WS_CTL, 0, CTL_ZERO_BYTES, stream);
    Params p{};
    for (int i = 0; i < 25; ++i) p.in[i] = (const float*)d_in[i];
    p.out = (float*)d_out; p.ws = (unsigned char*)d_ws;
    hipLaunchKernelGGL(fwd_kernel, dim3(grid), dim3(NTHR), LDS_BYTES, stream, p);
}
```
